# Optimizing an MI355X kernel written in HIP

```python
import math
import jax, jax.numpy as jnp
from jax import lax
import numpy as np

D_MODEL = 1024
BATCH = 8
SEQ = 8192
DEPTH = 4

GRID_W = 64
CTX_LEN = 256
EPS = 1e-6
N_MOD = 6

GLA_HEADS = 4
GLA_DK = 64
GLA_DV = 128
GLA_KW = GLA_HEADS * GLA_DK
GLA_VW = GLA_HEADS * GLA_DV
GATE_RANK = 16
GATE_TAU = 16.0
CHUNK = 64
ROPE_BASE = 10000.0

NA_HEADS = 8
NA_DH = 64
NA_W = NA_HEADS * NA_DH
NA_KH = 8
NA_KW = 16

N_BRANCH = 2
IN_SPLITS = (GLA_KW, GLA_KW, GLA_VW, 2 * GATE_RANK, GLA_VW, NA_W, NA_W, NA_W, N_BRANCH * D_MODEL)
IN_COLS = 2 * GLA_KW + 2 * GLA_VW + 2 * GATE_RANK + 3 * NA_W + N_BRANCH * D_MODEL

PEER_HEADS = 8
N_KEYS = 128
N_EXPERTS = N_KEYS * N_KEYS
PEER_DK = 256
PEER_TOPK = 16
TOKEN_BLOCK = 128

kernel_name = "hybrid_gla_natten_peer_dit"


def rmsnorm(x, g):
    xf = x.astype(jnp.float32)
    y = xf * lax.rsqrt(jnp.mean(xf * xf, axis=-1, keepdims=True) + EPS)
    return (y * g.astype(jnp.float32)).astype(x.dtype)


def split_cols(t, sizes):
    outs, start = [], 0
    for s in sizes:
        outs.append(t[..., start:start + s])
        start += s
    return outs


def heads(t, n_heads):
    return t.reshape(t.shape[:-1] + (n_heads, t.shape[-1] // n_heads))


def axial_rope(x):
    n = x.shape[1]
    t = jnp.arange(n, dtype=jnp.int32)
    pos = jnp.stack([t // GRID_W, t % GRID_W], axis=0).astype(jnp.float32)
    half = x.shape[-1] // 2
    quarter = half // 2
    freqs = ROPE_BASE ** (-jnp.arange(quarter, dtype=jnp.float32) / quarter)
    ang = pos[:, :, None] * freqs
    cos = jnp.cos(ang).astype(x.dtype)
    sin = jnp.sin(ang).astype(x.dtype)

    def rot(xs, cs, sn):
        x1, x2 = xs[..., :quarter], xs[..., quarter:]
        cs = cs[None, :, None, :]
        sn = sn[None, :, None, :]
        return jnp.concatenate([x1 * cs - x2 * sn, x1 * sn + x2 * cs], axis=-1)

    return jnp.concatenate([rot(x[..., :half], cos[0], sin[0]),
                            rot(x[..., half:], cos[1], sin[1])], axis=-1)


def gla_scan(q, k, v, log_a, s0):
    B, L, H, dk = q.shape
    dv = v.shape[-1]
    n = L // CHUNK

    def chunks(t):
        return t.astype(jnp.float32).reshape(B, n, CHUNK, H, t.shape[-1]).transpose(1, 0, 3, 2, 4)

    mask = jnp.tril(jnp.ones((CHUNK, CHUNK), dtype=bool))[:, :, None]

    def step(s, inp):
        qi, ki, vi, ai = inp
        b = jnp.cumsum(ai, axis=2)
        rel = b[:, :, :, None, :] - b[:, :, None, :, :]
        decay = jnp.where(mask, jnp.exp(jnp.minimum(rel, 0.0)), 0.0)
        attn = jnp.einsum('bhik,bhjk,bhijk->bhij', qi, ki, decay)
        o = (jnp.einsum('bhij,bhjv->bhiv', attn, vi)
             + jnp.einsum('bhik,bhkv->bhiv', qi * jnp.exp(b), s))
        b_end = b[:, :, -1, :]
        s = (jnp.exp(b_end)[..., None] * s
             + jnp.einsum('bhjk,bhjv->bhkv', ki * jnp.exp(b_end[:, :, None, :] - b), vi))
        return s, o

    s_fin, o = lax.scan(step, s0, (chunks(q), chunks(k), chunks(v), chunks(log_a)))
    o = o.transpose(1, 0, 3, 2, 4).reshape(B, L, H, dv)
    return o.astype(v.dtype), s_fin


def flip(t):
    return jnp.flip(t, axis=1)


def na_latent(q, k, v, k_ctx, v_ctx, rpb):
    B, L, H, dh = q.shape
    rows = L // GRID_W
    kh = min(NA_KH, rows)
    scale = NA_DH ** -0.5
    qg = q.reshape(B, rows, GRID_W, H, dh)
    kg = k.reshape(B, rows, GRID_W, H, dh)
    vg = v.reshape(B, rows, GRID_W, H, dh)
    col = jnp.arange(GRID_W, dtype=jnp.int32)
    c0 = jnp.clip(col - NA_KW // 2, 0, GRID_W - NA_KW)
    col_idx = c0[:, None] + jnp.arange(NA_KW, dtype=jnp.int32)[None, :]
    col_off = col_idx - col[:, None] + (NA_KW - 1)

    def one_row(r):
        r0 = jnp.clip(r - kh // 2, 0, rows - kh)
        k_rows = lax.dynamic_slice_in_dim(kg, r0, kh, axis=1)
        v_rows = lax.dynamic_slice_in_dim(vg, r0, kh, axis=1)
        k_win = k_rows[:, :, col_idx]
        v_win = v_rows[:, :, col_idx]
        q_r = lax.dynamic_index_in_dim(qg, r, axis=1, keepdims=False)
        row_off = r0 + jnp.arange(kh, dtype=jnp.int32) - r + (NA_KH - 1)
        bias = rpb[:, row_off[None, :, None], col_off[:, None, :]]
        s_win = (jnp.einsum('bwhd,bawihd->bhwai', q_r, k_win).astype(jnp.float32) * scale
                 + bias.astype(jnp.float32)[None])
        s_ctx = jnp.einsum('bwhd,bchd->bhwc', q_r, k_ctx).astype(jnp.float32) * scale
        s_all = jnp.concatenate([s_win.reshape(B, H, GRID_W, kh * NA_KW), s_ctx], axis=-1)
        p = jax.nn.softmax(s_all, axis=-1).astype(v.dtype)
        p_win = p[..., :kh * NA_KW].reshape(B, H, GRID_W, kh, NA_KW)
        p_ctx = p[..., kh * NA_KW:]
        return (jnp.einsum('bhwai,bawihd->bwhd', p_win, v_win)
                + jnp.einsum('bhwc,bchd->bwhd', p_ctx, v_ctx))

    out = lax.map(one_row, jnp.arange(rows, dtype=jnp.int32))
    return out.transpose(1, 0, 2, 3, 4).reshape(B, L, H * dh)


def na_context(q, k, v):
    B, Lc, H, dh = q.shape
    s = jnp.einsum('bqhd,bkhd->bhqk', q, k).astype(jnp.float32) * (NA_DH ** -0.5)
    p = jax.nn.softmax(s, axis=-1).astype(v.dtype)
    return jnp.einsum('bhqk,bkhd->bqhd', p, v).reshape(B, Lc, H * dh)


def gla_inputs(parts, rope, w_af, b_af, w_ab, b_ab):
    q, k, v, z, r = parts[:5]
    q = heads(q, GLA_HEADS)
    k = heads(k, GLA_HEADS)
    if rope:
        q, k = axial_rope(q), axial_rope(k)
    q = q * (GLA_DK ** -0.5)
    v = heads(v, GLA_HEADS)
    zf, zb = z[..., :GATE_RANK], z[..., GATE_RANK:]
    la_f = heads(jax.nn.log_sigmoid((zf @ w_af + b_af).astype(jnp.float32)) / GATE_TAU, GLA_HEADS)
    la_b = heads(jax.nn.log_sigmoid((zb @ w_ab + b_ab).astype(jnp.float32)) / GATE_TAU, GLA_HEADS)
    return q, k, v, la_f, la_b, r


def gla_out(o, r, g_gla, w_pg):
    o = rmsnorm(o, g_gla)
    o = o.reshape(o.shape[:2] + (GLA_VW,)) * jax.nn.silu(r)
    return o @ w_pg


def token_mixer(h, hc, w_in, w_af, b_af, w_ab, b_ab, g_gla, rpb, w_pg, w_pn, w_o, with_ctx_out):
    p = split_cols(h @ w_in, IN_SPLITS)
    pc = split_cols(hc @ w_in, IN_SPLITS)
    B = h.shape[0]

    qc, kc, vc, lafc, labc, rc = gla_inputs(pc, False, w_af, b_af, w_ab, b_ab)
    ql, kl, vl, lafl, labl, rl = gla_inputs(p, True, w_af, b_af, w_ab, b_ab)
    s0 = jnp.zeros((B, GLA_HEADS, GLA_DK, GLA_DV), jnp.float32)
    o_cf, s_cf = gla_scan(qc, kc, vc, lafc, s0)
    o_cb, s_cb = gla_scan(flip(qc), flip(kc), flip(vc), flip(labc), s0)
    o_lf, _ = gla_scan(ql, kl, vl, lafl, s_cf)
    o_lb, _ = gla_scan(flip(ql), flip(kl), flip(vl), flip(labl), s_cb)
    ya = gla_out(o_lf + flip(o_lb), rl, g_gla, w_pg)

    nq, nk, nv = (heads(t, NA_HEADS) for t in p[5:8])
    nkc, nvc = heads(pc[6], NA_HEADS), heads(pc[7], NA_HEADS)
    yb = na_latent(nq, nk, nv, nkc, nvc, rpb) @ w_pn

    gates = p[8]
    y = (jax.nn.sigmoid(gates[..., :D_MODEL]) * ya + jax.nn.sigmoid(gates[..., D_MODEL:]) * yb) @ w_o

    if not with_ctx_out:
        return y, None
    ya_c = gla_out(o_cf + flip(o_cb), rc, g_gla, w_pg)
    yb_c = na_context(heads(pc[5], NA_HEADS), nkc, nvc) @ w_pn
    gates_c = pc[8]
    yc = (jax.nn.sigmoid(gates_c[..., :D_MODEL]) * ya_c + jax.nn.sigmoid(gates_c[..., D_MODEL:]) * yb_c) @ w_o
    return y, yc


def peer(h, w_query, sub_keys, expert_u, expert_v):
    shape = h.shape
    tok = h.reshape(-1, TOKEN_BLOCK, shape[-1])

    def block(xb):
        tb = xb.shape[0]
        qb = (xb @ w_query).reshape(tb, PEER_HEADS, 2, PEER_DK // 2)
        s = jnp.einsum('thpd,hpnd->thpn', qb, sub_keys).astype(jnp.float32)
        s_top, i_top = lax.top_k(s, PEER_TOPK)
        cand = s_top[:, :, 0, :, None] + s_top[:, :, 1, None, :]
        cand_idx = i_top[:, :, 0, :, None] * N_KEYS + i_top[:, :, 1, None, :]
        best, pos = lax.top_k(cand.reshape(tb, PEER_HEADS, PEER_TOPK * PEER_TOPK), PEER_TOPK)
        experts = jnp.take_along_axis(cand_idx.reshape(tb, PEER_HEADS, PEER_TOPK * PEER_TOPK), pos, axis=-1)
        g = jax.nn.softmax(best, axis=-1).reshape(tb, PEER_HEADS * PEER_TOPK).astype(xb.dtype)
        experts = experts.reshape(tb, PEER_HEADS * PEER_TOPK)
        u = jnp.take(expert_u, experts, axis=0)
        v = jnp.take(expert_v, experts, axis=0)
        act = jax.nn.gelu(jnp.einsum('td,ted->te', xb, u))
        return jnp.einsum('te,ted->td', act * g, v)

    return lax.map(block, tok).reshape(shape)


def setup_inputs(seed: int = 0) -> dict:
    key = jax.random.key(seed)
    ks = jax.random.split(key, 32)
    D = D_MODEL
    f32 = jnp.float32

    def nrm(k, shape, s):
        return jax.random.normal(k, shape, f32) * s

    return {
        "x": nrm(ks[0], (BATCH, SEQ, D), 1.0),
        "c": nrm(ks[1], (BATCH, D), 1.0),
        "ctx": nrm(ks[2], (BATCH, CTX_LEN, D), 1.0),
        "c_ctx": nrm(ks[3], (D,), 1.0),
        "w_mod": nrm(ks[4], (DEPTH, D, N_MOD * D), 0.5 * D ** -0.5),
        "b_mod": nrm(ks[5], (DEPTH, N_MOD * D), 0.02),
        "g_norm1": 1.0 + nrm(ks[6], (DEPTH, D), 0.02),
        "w_in": nrm(ks[7], (DEPTH, D, IN_COLS), D ** -0.5),
        "w_alpha_f": nrm(ks[8], (DEPTH, GATE_RANK, GLA_KW), GATE_RANK ** -0.5),
        "b_alpha_f": nrm(ks[9], (DEPTH, GLA_KW), 0.1),
        "w_alpha_b": nrm(ks[10], (DEPTH, GATE_RANK, GLA_KW), GATE_RANK ** -0.5),
        "b_alpha_b": nrm(ks[11], (DEPTH, GLA_KW), 0.1),
        "g_gla": 1.0 + nrm(ks[12], (DEPTH, GLA_DV), 0.02),
        "rpb": nrm(ks[13], (DEPTH, NA_HEADS, 2 * NA_KH - 1, 2 * NA_KW - 1), 0.1),
        "w_proj_gla": nrm(ks[14], (DEPTH, GLA_VW, D), GLA_VW ** -0.5),
        "w_proj_na": nrm(ks[15], (DEPTH, NA_W, D), NA_W ** -0.5),
        "w_out": nrm(ks[16], (DEPTH, D, D), D ** -0.5),
        "g_norm2": 1.0 + nrm(ks[17], (DEPTH, D), 0.02),
        "w_query": nrm(ks[18], (DEPTH, D, PEER_HEADS * PEER_DK), D ** -0.5),
        "sub_keys": nrm(ks[19], (DEPTH, PEER_HEADS, 2, N_KEYS, PEER_DK // 2), (PEER_DK // 2) ** -0.5),
        "expert_u": nrm(ks[20], (DEPTH, N_EXPERTS, D), D ** -0.5),
        "expert_v": nrm(ks[21], (DEPTH, N_EXPERTS, D), PEER_HEADS ** -0.5),
        "g_final": 1.0 + nrm(ks[22], (D,), 0.02),
    }


def reference(x, c, ctx, c_ctx, w_mod, b_mod, g_norm1, w_in, w_alpha_f, b_alpha_f, w_alpha_b, b_alpha_b,
              g_gla, rpb, w_proj_gla, w_proj_na, w_out, g_norm2, w_query, sub_keys, expert_u, expert_v,
              g_final):
    c_act = jax.nn.silu(c)
    cc_act = jax.nn.silu(c_ctx)
    xc = ctx
    for i in range(DEPTH):
        last = i == DEPTH - 1
        mod = c_act @ w_mod[i] + b_mod[i]
        mod_c = cc_act @ w_mod[i] + b_mod[i]
        sh1, sc1, ga1, sh2, sc2, ga2 = jnp.split(mod[:, None, :], N_MOD, axis=-1)
        csh1, csc1, cga1, csh2, csc2, cga2 = jnp.split(mod_c, N_MOD, axis=-1)

        h = rmsnorm(x, g_norm1[i]) * (1 + sc1) + sh1
        hc = rmsnorm(xc, g_norm1[i]) * (1 + csc1) + csh1
        y, yc = token_mixer(h, hc, w_in[i], w_alpha_f[i], b_alpha_f[i], w_alpha_b[i], b_alpha_b[i],
                            g_gla[i], rpb[i], w_proj_gla[i], w_proj_na[i], w_out[i], not last)
        x = x + ga1 * y
        h2 = rmsnorm(x, g_norm2[i]) * (1 + sc2) + sh2
        x = x + ga2 * peer(h2, w_query[i], sub_keys[i], expert_u[i], expert_v[i])

        if not last:
            xc = xc + cga1 * yc
            hc2 = rmsnorm(xc, g_norm2[i]) * (1 + csc2) + csh2
            xc = xc + cga2 * peer(hc2, w_query[i], sub_keys[i], expert_u[i], expert_v[i])
    return rmsnorm(x, g_final)
```

```cpp
#include <hip/hip_runtime.h>
#include <cstdio>
#include <cstdint>

#ifndef MK_SINGLE
#define MK_SINGLE 1
#endif

namespace pg8 {
#define PG8_LAS __attribute__((address_space(3)))
typedef unsigned short bf16_t;
typedef short bf16x8 __attribute__((ext_vector_type(8)));
typedef float f32x4 __attribute__((ext_vector_type(4)));
typedef unsigned u32x4 __attribute__((ext_vector_type(4)));
constexpr int BM = 256, BK = 64, HALF = 128, HTB = HALF * BK * 2, STAGE_BYTES = 8 * HTB, NXCD = 8, WGM = 8;

__host__ __device__ __forceinline__ int lds_byte(int r, int c) { const int st = (r >> 4) * 2 + (c >> 5), rr = r & 15, cc = c & 31, ob = rr * 64 + cc * 2; return st * 1024 + (ob ^ (((ob >> 9) & 1) << 5)); }
__host__ __device__ __forceinline__ void stage_rc(int b, int& R, int& C) { const int st = b / 1024, sb = b % 1024, swz = sb ^ (((sb >> 9) & 1) << 5); R = (st >> 1) * 16 + swz / 64; C = (st & 1) * 32 + (swz % 64) / 2; }
__host__ __device__ __forceinline__ int perm32(int rho) { const int n = rho >> 4, i = rho & 15; return 8 * (i >> 2) + 4 * n + (i & 3); }

struct Unit { int pm, pn; };
struct Gemm { const bf16_t* A; const bf16_t* Bt; int M, N, K, lda; };

struct StaticOrder {
    int nM, nN, nwg, G, c;
    __host__ __device__ void init(int M, int N, int G_, int c_) { nM = M / BM; nN = N / BM; nwg = nM * nN; G = G_; c = c_; }
    __host__ __device__ bool next(int i, Unit& u) const {
        const long L = (long)i * G + c; if (L >= nwg) return false;
        int wgid = (int)L; { const int q = nwg / NXCD, r = nwg % NXCD, xcd = wgid % NXCD, off = wgid / NXCD; wgid = (xcd < r ? xcd * (q + 1) : r * (q + 1) + (xcd - r) * q) + off; }
        const int nig = WGM * nN, gid = wgid / nig, fm = gid * WGM, gsz = (nM - fm) < WGM ? (nM - fm) : WGM;
        u.pm = fm + ((wgid % nig) % gsz); u.pn = (wgid % nig) / gsz; return true;
    }
    __device__ __forceinline__ void a_ready(const Unit&) const {}
    __device__ __forceinline__ void done(const Unit&) const {}
};

__device__ __forceinline__ unsigned cvt_pk_bf16(float lo, float hi) { unsigned r; asm volatile("v_cvt_pk_bf16_f32 %0, %1, %2" : "=v"(r) : "v"(lo), "v"(hi)); return r; }

template <class Epi, class Sched, bool ALIGN_EPI = false, bool SP2 = false>
__device__ __forceinline__ void gemm_phase(PG8_LAS unsigned char* lds, const Gemm g, const Sched& S, const Epi& E) {
    int tid_ = threadIdx.x; asm volatile("" : "+v"(tid_));
    const int tid = tid_, wid = __builtin_amdgcn_readfirstlane(tid >> 6), lane = tid & 63, wr = wid >> 2, wc = wid & 3, fr = lane & 15, fq = lane >> 4;
    const int K = g.K, nt = K / BK, lda = g.lda;
    unsigned voffA[2], voffB[2];
#pragma unroll
    for (int i = 0; i < 2; ++i) { int R, C; stage_rc(tid * 16 + i * 8192, R, C); const int Rb = Epi::PERM ? ((R & ~31) + perm32(R & 31)) : R;
        voffA[i] = (unsigned)(R * lda + C) * 2u; voffB[i] = (unsigned)(Rb * K + C) * 2u; }
    const size_t kstep = (size_t)(BK * 2);
    const size_t hstepA = (size_t)HALF * lda * 2, hstepB = (size_t)HALF * K * 2;
    const size_t tstepA = 2 * hstepA, tstepB = 2 * hstepB;
    const unsigned ldsw = (unsigned)wid * 1024u;
    const int aoff = lds_byte(wr * 64 + fr, fq * 8), boff = lds_byte(wc * 32 + fr, fq * 8);
#define PG8_SA(b, h) (((b) * 2 + (h)) * HTB)
#define PG8_SB(b, h) ((4 + (b) * 2 + (h)) * HTB)
#define PG8_STAGE(bufoff, gbase, voff) do { _Pragma("unroll") for (int _i = 0; _i < 2; ++_i) \
        __builtin_amdgcn_global_load_lds((const unsigned*)((const char*)(gbase) + (voff)[_i]), (PG8_LAS unsigned*)(lds + (bufoff) + ldsw + _i * 8192), 16, 0, 0); } while (0)
#define PG8_LDA(dst, b, h) do { _Pragma("unroll") for (int m = 0; m < 4; ++m) _Pragma("unroll") for (int k = 0; k < 2; ++k) dst[m][k] = *(const PG8_LAS bf16x8*)(lds + PG8_SA(b, h) + aoff + m * 2048 + k * 1024); } while (0)
#define PG8_LDB(dst, b, h) do { _Pragma("unroll") for (int n = 0; n < 2; ++n) _Pragma("unroll") for (int k = 0; k < 2; ++k) dst[n][k] = *(const PG8_LAS bf16x8*)(lds + PG8_SB(b, h) + boff + n * 2048 + k * 1024); } while (0)
#define PG8_MMA(ai, bj, At, Bt) do { __builtin_amdgcn_s_setprio(1); _Pragma("unroll") for (int m = 0; m < 4; ++m) _Pragma("unroll") for (int n = 0; n < 2; ++n) _Pragma("unroll") for (int k = 0; k < 2; ++k) \
        acc[ai][bj][m][n] = __builtin_amdgcn_mfma_f32_16x16x32_bf16(Bt[n][k], At[m][k], acc[ai][bj][m][n], 0, 0, 0); __builtin_amdgcn_s_setprio(0); } while (0)
#define PG8_WAIT_V(n) asm volatile("s_waitcnt vmcnt(" #n ")" ::: "memory")
#define PG8_WAIT_L(n) asm volatile("s_waitcnt lgkmcnt(" #n ")" ::: "memory")
#define PG8_BAR __builtin_amdgcn_s_barrier()
#define PG8_SCHED __builtin_amdgcn_sched_barrier(0)
    Unit cur, nxt; int ui = 0;
    if (!S.next(0, cur)) return;
    f32x4 acc[2][2][4][2];
#pragma unroll
    for (int a = 0; a < 2; ++a)
#pragma unroll
        for (int b = 0; b < 2; ++b)
#pragma unroll
            for (int m = 0; m < 4; ++m)
#pragma unroll
                for (int n = 0; n < 2; ++n) acc[a][b][m][n] = (f32x4){0.f, 0.f, 0.f, 0.f};
    bf16x8 At[4][2], B0[2][2], B1[2][2];
    const char* cA = (const char*)g.A + (size_t)cur.pm * tstepA; const char* cB = (const char*)g.Bt + (size_t)cur.pn * tstepB;
    S.a_ready(cur);
    if constexpr (SP2) {
        PG8_STAGE(PG8_SB(0, 0), cB, voffB); PG8_STAGE(PG8_SB(0, 1), cB + hstepB, voffB); PG8_STAGE(PG8_SA(0, 0), cA, voffA); PG8_STAGE(PG8_SA(0, 1), cA + hstepA, voffA);
        if (wr == 1) PG8_BAR;
        PG8_WAIT_V(2); PG8_BAR;
        PG8_STAGE(PG8_SB(1, 0), cB + kstep, voffB); PG8_STAGE(PG8_SA(1, 0), cA + kstep, voffA); PG8_STAGE(PG8_SB(1, 1), cB + hstepB + kstep, voffB);
        PG8_WAIT_V(6); PG8_BAR;
    } else {
        PG8_STAGE(PG8_SB(0, 0), cB, voffB); PG8_STAGE(PG8_SA(0, 0), cA, voffA); PG8_STAGE(PG8_SB(0, 1), cB + hstepB, voffB); PG8_STAGE(PG8_SA(0, 1), cA + hstepA, voffA);
        if (wr == 1) PG8_BAR;
        PG8_WAIT_V(4); PG8_BAR;
        PG8_STAGE(PG8_SB(1, 0), cB + kstep, voffB); PG8_STAGE(PG8_SA(1, 0), cA + kstep, voffA); PG8_STAGE(PG8_SB(1, 1), cB + hstepB + kstep, voffB);
        PG8_WAIT_V(6); PG8_BAR;
    }
    for (;;) {
        const bool has_next = S.next(ui + 1, nxt);
        const char* nA = has_next ? (const char*)g.A + (size_t)nxt.pm * tstepA : cA; const char* nB = has_next ? (const char*)g.Bt + (size_t)nxt.pn * tstepB : cB;
        for (int t = 0; t < nt; t += 2) {
            const bool last = (t == nt - 2);
            const char* a1 = cA + (size_t)(t + 1) * kstep;
            const char* a2 = last ? nA : cA + (size_t)(t + 2) * kstep; const char* b2 = last ? nB : cB + (size_t)(t + 2) * kstep;
            const char* a3 = a2 + kstep; const char* b3 = b2 + kstep;
            if (last && has_next) S.a_ready(nxt);
            if constexpr (SP2) {
            PG8_LDB(B0, 0, 0); PG8_LDB(B1, 0, 1); PG8_SCHED; PG8_LDA(At, 0, 0); PG8_STAGE(PG8_SA(1, 1), a1 + hstepA, voffA);
            PG8_WAIT_V(8); PG8_WAIT_L(0); PG8_BAR; PG8_MMA(0, 0, At, B0); PG8_MMA(0, 1, At, B1); PG8_BAR; PG8_SCHED;
            PG8_LDA(At, 0, 1); PG8_STAGE(PG8_SB(0, 0), b2, voffB); PG8_STAGE(PG8_SB(0, 1), b2 + hstepB, voffB); PG8_STAGE(PG8_SA(0, 0), a2, voffA);
            PG8_WAIT_V(8); PG8_WAIT_L(0); PG8_BAR; PG8_MMA(1, 0, At, B0); PG8_MMA(1, 1, At, B1); PG8_BAR; PG8_SCHED;
            PG8_LDB(B0, 1, 0); PG8_LDB(B1, 1, 1); PG8_SCHED; PG8_LDA(At, 1, 0); PG8_STAGE(PG8_SA(0, 1), a2 + hstepA, voffA);
            PG8_WAIT_V(8); PG8_WAIT_L(0); PG8_BAR; PG8_MMA(0, 0, At, B0); PG8_MMA(0, 1, At, B1); PG8_BAR; PG8_SCHED;
            PG8_LDA(At, 1, 1); PG8_STAGE(PG8_SB(1, 0), b3, voffB); PG8_STAGE(PG8_SB(1, 1), b3 + hstepB, voffB); PG8_STAGE(PG8_SA(1, 0), a3, voffA);
            PG8_WAIT_V(8); PG8_WAIT_L(0); PG8_BAR; PG8_MMA(1, 0, At, B0); PG8_MMA(1, 1, At, B1); PG8_BAR; PG8_SCHED;
            } else {
            PG8_LDB(B0, 0, 0); PG8_SCHED; PG8_LDA(At, 0, 0); PG8_STAGE(PG8_SA(1, 1), a1 + hstepA, voffA);
            PG8_WAIT_L(8); PG8_BAR; PG8_WAIT_L(0); PG8_MMA(0, 0, At, B0); PG8_BAR; PG8_SCHED;
            PG8_LDB(B1, 0, 1); PG8_STAGE(PG8_SB(0, 0), b2, voffB);
            PG8_BAR; PG8_WAIT_L(0); PG8_MMA(0, 1, At, B1); PG8_BAR;
            PG8_LDA(At, 0, 1); PG8_STAGE(PG8_SA(0, 0), a2, voffA);
            PG8_BAR; PG8_WAIT_L(0); PG8_MMA(1, 0, At, B0); PG8_BAR; PG8_SCHED;
            PG8_STAGE(PG8_SB(0, 1), b2 + hstepB, voffB);
            PG8_WAIT_V(6); PG8_BAR; PG8_MMA(1, 1, At, B1); PG8_BAR;
            PG8_LDB(B0, 1, 0); PG8_SCHED; PG8_LDA(At, 1, 0); PG8_STAGE(PG8_SA(0, 1), a2 + hstepA, voffA);
            PG8_WAIT_L(8); PG8_BAR; PG8_WAIT_L(0); PG8_MMA(0, 0, At, B0); PG8_BAR; PG8_SCHED;
            PG8_LDB(B1, 1, 1); PG8_STAGE(PG8_SB(1, 0), b3, voffB);
            PG8_BAR; PG8_WAIT_L(0); PG8_MMA(0, 1, At, B1); PG8_BAR;
            PG8_LDA(At, 1, 1); PG8_STAGE(PG8_SA(1, 0), a3, voffA);
            PG8_BAR; PG8_WAIT_L(0); PG8_MMA(1, 0, At, B0); PG8_BAR; PG8_SCHED;
            PG8_STAGE(PG8_SB(1, 1), b3 + hstepB, voffB);
            PG8_WAIT_V(6); PG8_BAR; PG8_MMA(1, 1, At, B1); PG8_BAR;
            }
        }
        if constexpr (ALIGN_EPI) { if (wr == 0) PG8_BAR; }
        E(acc, cur, wr, wc, fr, fq); S.done(cur);
        if (!has_next) break;
#pragma unroll
        for (int a = 0; a < 2; ++a)
#pragma unroll
            for (int b = 0; b < 2; ++b)
#pragma unroll
                for (int m = 0; m < 4; ++m)
#pragma unroll
                    for (int n = 0; n < 2; ++n) acc[a][b][m][n] = (f32x4){0.f, 0.f, 0.f, 0.f};
        cur = nxt; cA = nA; cB = nB; ++ui;
        if constexpr (ALIGN_EPI) { if (wr == 1) PG8_BAR; }
    }
    PG8_WAIT_V(0);
    if constexpr (!ALIGN_EPI) { if (wr == 0) PG8_BAR; }
    PG8_BAR;
#undef PG8_SA
#undef PG8_SB
#undef PG8_STAGE
#undef PG8_LDA
#undef PG8_LDB
#undef PG8_MMA
#undef PG8_WAIT_V
#undef PG8_WAIT_L
#undef PG8_BAR
#undef PG8_SCHED
}
}

constexpr int D = 1024, BATCH = 8, SEQ = 8192, DEPTH = 4, CTXL = 256, GRIDW = 64;
constexpr int NCTX = BATCH * CTXL;
constexpr int NLAT = BATCH * SEQ;
constexpr int R = NCTX + NLAT;
constexpr int IN_COLS = 5152, NPAD = 5376;
constexpr int PA_LD = 3072, PG_LD = 2048;
constexpr int PA_Q = 0, PA_K = 256, PA_V = 512, PA_R = 1024, PA_NQ = 1536, PA_NK = 2048, PA_NV = 2560;
constexpr int NEXP = 16384;
constexpr float EPS = 1e-6f;
constexpr int NWAVES = 8, NT = 512;
constexpr int NPL = 10;
constexpr int NPHASE = 1 + DEPTH * NPL + 1;

constexpr size_t MiB = 1u << 20;
constexpr size_t WS_CTL = 0, CTL_ZERO_BYTES = 2 * MiB;
constexpr size_t WS_MOD = 1 * MiB;
constexpr size_t WS_ROPE = 2 * MiB;
constexpr size_t WS_WIN = 3 * MiB;
constexpr size_t WS_WPG = 45 * MiB, WS_WPN = 49 * MiB;
constexpr size_t WS_WO = 53 * MiB;
constexpr size_t WS_WS = 61 * MiB;
constexpr size_t WS_XC = 77 * MiB;
constexpr size_t WS_Z = 85 * MiB;
constexpr size_t WS_EU = 94 * MiB, WS_EV = 126 * MiB;
constexpr size_t WS_H = 158 * MiB;
constexpr size_t WS_PA = 290 * MiB;
constexpr size_t WS_PG = 686 * MiB;
constexpr size_t WS_SC = 290 * MiB;
constexpr size_t WS_EI = 818 * MiB, WS_EG = 851 * MiB;
constexpr size_t WS_END = 950 * MiB;
static_assert(WS_SC + (size_t)R * 2048 * 4 <= WS_EI && WS_EG + (size_t)R * 128 * 4 <= WS_END && WS_PG + (size_t)R * PG_LD * 2 <= WS_END, "ws map");
static_assert(WS_H + (size_t)R * 1024 * 2 <= WS_PA && WS_PA + (size_t)R * PA_LD * 2 <= WS_PG && WS_Z + (size_t)R * 32 * 4 <= WS_EU, "ws map");
constexpr int CW_BAR = 4096;

constexpr int RING_BYTES = 131072, LDSCTL_OFF = RING_BYTES, MISC_OFF = LDSCTL_OFF + 320, LDS_BYTES = 147456;

#define GAS __attribute__((address_space(1)))
#define LAS __attribute__((address_space(3)))
typedef unsigned short bf16;
typedef unsigned v4u __attribute__((ext_vector_type(4)));
typedef unsigned v2u __attribute__((ext_vector_type(2)));
typedef int v4i __attribute__((ext_vector_type(4)));
typedef float f32x4 __attribute__((ext_vector_type(4)));
typedef __bf16 bf16x2_t __attribute__((ext_vector_type(2)));
#define LDS_WAIT() asm volatile("s_waitcnt lgkmcnt(0)" ::: "memory")
#define VM_WAIT() asm volatile("s_waitcnt vmcnt(0)" ::: "memory")
__device__ __forceinline__ unsigned f2bf(float f) { unsigned u = __builtin_bit_cast(unsigned, f); return (u + 0x7fffu + ((u >> 16) & 1u)) >> 16; }
__device__ __forceinline__ unsigned pk2(float lo, float hi) { return f2bf(lo) | (f2bf(hi) << 16); }
__device__ __forceinline__ float bflo(unsigned w) { return __builtin_bit_cast(float, w << 16); }
__device__ __forceinline__ float bfhi(unsigned w) { return __builtin_bit_cast(float, w & 0xffff0000u); }
__device__ __forceinline__ float bf1(bf16 h) { return __builtin_bit_cast(float, ((unsigned)h) << 16); }
__device__ __forceinline__ float dot2(unsigned a, unsigned b, float acc) { return __builtin_amdgcn_fdot2_f32_bf16(__builtin_bit_cast(bf16x2_t, a), __builtin_bit_cast(bf16x2_t, b), acc, false); }
__device__ __forceinline__ float wave_sum(float v) {
#pragma unroll
    for (int o = 1; o < 64; o <<= 1) v += __shfl_xor(v, o);
    return v;
}
__device__ __forceinline__ float wave_max(float v) {
#pragma unroll
    for (int o = 1; o < 64; o <<= 1) v = fmaxf(v, __shfl_xor(v, o));
    return v;
}
__device__ __forceinline__ float sigmoidf_(float x) { return 1.f / (1.f + __expf(-x)); }

#define XB_TMO      128
#define XB_XCNT(j)  (256  + 64 * (j))
#define XB_XSUB(j)  (1280 + 64 * (j))
#define XB_XGEN(j)  (2304 + 64 * (j))
#define XB_TOP      3328
#define XB_TOPGEN   3392
#define XCD_BAR_WORDS 3456
#define XB_SPIN_CAP (1u << 18)
__device__ __forceinline__ unsigned xb_ld(unsigned* p)              { return __hip_atomic_load(p, __ATOMIC_RELAXED, __HIP_MEMORY_SCOPE_AGENT); }
__device__ __forceinline__ unsigned xb_add(unsigned* p, unsigned v) { return __hip_atomic_fetch_add(p, v, __ATOMIC_RELAXED, __HIP_MEMORY_SCOPE_AGENT); }
__device__ __forceinline__ unsigned xb_xcc_id() { return (unsigned)__builtin_amdgcn_s_getreg((3 << 11) | 20) & 0xFu; }
#define XB_SPIN(cond, bar) do { unsigned _sp = 0; while (cond) { __builtin_amdgcn_s_sleep(1); \
    if ((++_sp & 255u) == 0u) { if (xb_ld(&(bar)[XB_TMO])) break; if (_sp > XB_SPIN_CAP) { atomicAdd(&(bar)[XB_TMO], 1u); break; } } } } while (0)
struct XcdBarrier { unsigned* bar; unsigned x; volatile LAS unsigned* st; };
__device__ __forceinline__ XcdBarrier xcd_barrier_post(unsigned* bar, volatile LAS unsigned* st) {
    XcdBarrier b; b.bar = bar; b.x = xb_xcc_id(); b.st = st;
    if (threadIdx.x == 0) (void)xb_add(&bar[XB_XCNT(b.x)], 1u);
    return b;
}
__device__ __forceinline__ void xcd_barrier_complete(unsigned* bar, unsigned x, unsigned& nloc, unsigned& nx) {
    const unsigned G = gridDim.x * gridDim.y * gridDim.z;
    unsigned sum, cnt, mine, sp = 0u;
    for (;;) {
        sum = 0u; cnt = 0u; mine = 0u;
#pragma unroll
        for (unsigned j = 0; j < 16; ++j) { const unsigned c = xb_ld(&bar[XB_XCNT(j)]); sum += c; cnt += (c > 0u) ? 1u : 0u; mine = (j == x) ? c : mine; }
        if (sum == G) break;
        __builtin_amdgcn_s_sleep(1);
        if ((++sp & 255u) == 0u) { if (xb_ld(&bar[XB_TMO])) break; if (sp > XB_SPIN_CAP) { atomicAdd(&bar[XB_TMO], 1u); break; } }
    }
    nloc = mine > 0u ? mine : 1u; nx = cnt > 0u ? cnt : 1u;
}
__device__ __forceinline__ void xcd_barrier(const XcdBarrier& b) {
    asm volatile("s_waitcnt vmcnt(0)" ::: "memory");
    __syncthreads();
    if (threadIdx.x == 0) {
        unsigned* bar = b.bar;
        __builtin_amdgcn_s_waitcnt(0);
        unsigned nloc = b.st[0], nx = b.st[1];
        if (nloc == 0u) { xcd_barrier_complete(bar, b.x, nloc, nx); b.st[0] = nloc; b.st[1] = nx; }
        const unsigned old = xb_add(&bar[XB_XSUB(b.x)], 1u);
        const unsigned gen = old / nloc;
        if (old + 1u == (gen + 1u) * nloc) {
            __builtin_amdgcn_fence(__ATOMIC_RELEASE, "agent");
            asm volatile("s_waitcnt vmcnt(0)" ::: "memory");
            const unsigned og = xb_add(&bar[XB_TOP], 1u);
            const unsigned tg = og / nx;
            if (og + 1u == (tg + 1u) * nx) xb_add(&bar[XB_TOPGEN], 1u);
            else XB_SPIN(xb_ld(&bar[XB_TOPGEN]) == tg, bar);
            __builtin_amdgcn_fence(__ATOMIC_ACQUIRE, "agent");
            xb_add(&bar[XB_XGEN(b.x)], 1u);
            asm volatile("s_waitcnt vmcnt(0)" ::: "memory");
        } else {
            XB_SPIN(xb_ld(&bar[XB_XGEN(b.x)]) == gen, bar);
            __builtin_amdgcn_fence(__ATOMIC_ACQUIRE, "agent");
            asm volatile("s_waitcnt vmcnt(0)" ::: "memory");
        }
    }
    __syncthreads();
}

struct Args { const float* in[23]; float* out; unsigned char* ws; int ph_lo, ph_hi, li, pad; };
enum { I_X = 0, I_C, I_CTX, I_CCTX, I_WMOD, I_BMOD, I_GN1, I_WIN, I_WAF, I_BAF, I_WAB, I_BAB, I_GGLA, I_RPB, I_WPG, I_WPN, I_WO, I_GN2, I_WQ, I_SK, I_EU, I_EV, I_GF };

struct Frame {
    LAS unsigned char* lds;
    int tid, lane, wave, vcu, G;
};
typedef const __attribute__((address_space(4))) Args* CArgsP;
__device__ __forceinline__ CArgsP kargs() { CArgsP p = (CArgsP)__builtin_amdgcn_kernarg_segment_ptr(); asm volatile("" : "+s"(p)); return p; }
__device__ __forceinline__ const float* xrow_in(CArgsP a, int r) { return r < NCTX ? a->in[I_CTX] + (size_t)r * D : a->in[I_X] + (size_t)(r - NCTX) * D; }
__device__ __forceinline__ float* xrow_cur(CArgsP a, int r) { return r < NCTX ? (float*)(a->ws + WS_XC) + (size_t)r * D : a->out + (size_t)(r - NCTX) * D; }
__device__ __forceinline__ int row_slot(int r) { return r < NCTX ? 8 : ((r - NCTX) >> 13); }

using pg8::f32x4; using pg8::u32x4; using pg8::Unit; using pg8::cvt_pk_bf16;
struct EpiIn {
    static constexpr bool PERM = true;
    bf16* PA; bf16* PG; float* Z; const float* rope;
    __device__ __forceinline__ void operator()(const f32x4 (&acc)[2][2][4][2], const Unit& u, int wr, int wc, int fr, int fq) const {
        const int pn = u.pn, row0 = u.pm * 256 + wr * 64 + fr;
        if (pn == 20) {
            if (wc == 0) {
#pragma unroll
                for (int ai = 0; ai < 2; ++ai)
#pragma unroll
                    for (int m = 0; m < 4; ++m) { float* zp = Z + (size_t)(row0 + ai * 128 + m * 16) * 32 + 8 * fq; *(f32x4*)zp = acc[ai][0][m][0]; *(f32x4*)(zp + 4) = acc[ai][0][m][1]; }
            }
            return;
        }
        bf16* base; int ldc, colt;
        if (pn < 12) { base = PA; ldc = PA_LD; colt = pn * 256; } else { base = PG; ldc = PG_LD; colt = (pn - 12) * 256; }
        const int col0 = colt + wc * 32 + 8 * fq;
        const bool do_rope = (pn < 2) && (u.pm >= 8);
        const float sc = (pn == 0 || pn == 6 || pn == 7) ? 0.125f : 1.f;
#pragma unroll
        for (int ai = 0; ai < 2; ++ai)
#pragma unroll
            for (int m = 0; m < 4; ++m) {
                const int row = row0 + ai * 128 + m * 16;
                bf16* rowp = base + (size_t)row * ldc + col0;
                f32x4 cs[4];
                if (do_rope) { const int t = (row - NCTX) & (SEQ - 1); const int pos = (wc & 1) ? (t & 63) : (t >> 6);
                    const f32x4* cp = (const f32x4*)(rope + (size_t)(pos * 16 + 8 * (fq & 1)) * 2);
                    cs[0] = cp[0]; cs[1] = cp[1]; cs[2] = cp[2]; cs[3] = cp[3]; }
#pragma unroll
                for (int bj = 0; bj < 2; ++bj) {
                    f32x4 v0 = acc[ai][bj][m][0], v1 = acc[ai][bj][m][1];
                    if (do_rope) {
                        float x[8] = {v0[0], v0[1], v0[2], v0[3], v1[0], v1[1], v1[2], v1[3]};
#pragma unroll
                        for (int e = 0; e < 8; ++e) { const float p = __shfl_xor(x[e], 32); const float c = cs[e >> 1][(e & 1) * 2], s = cs[e >> 1][(e & 1) * 2 + 1];
                            x[e] = (fq < 2) ? (x[e] * c - p * s) : (p * s + x[e] * c); }
                        v0 = (f32x4){x[0], x[1], x[2], x[3]}; v1 = (f32x4){x[4], x[5], x[6], x[7]};
                    }
                    v0 = v0 * sc; v1 = v1 * sc;
                    u32x4 w; w.x = cvt_pk_bf16(v0[0], v0[1]); w.y = cvt_pk_bf16(v0[2], v0[3]); w.z = cvt_pk_bf16(v1[0], v1[1]); w.w = cvt_pk_bf16(v1[2], v1[3]);
                    *(u32x4*)(rowp + bj * 128) = w;
                }
                asm volatile("" ::: "memory");
            }
    }
};
template <int SECOND> struct EpiMerge {
    static constexpr bool PERM = true;
    bf16* MG; const bf16* PG;
    __device__ __forceinline__ void operator()(const f32x4 (&acc)[2][2][4][2], const Unit& u, int wr, int wc, int fr, int fq) const {
        const int row0 = u.pm * 256 + wr * 64 + fr, col0 = u.pn * 256 + wc * 32 + 8 * fq;
#pragma unroll
        for (int ai = 0; ai < 2; ++ai)
#pragma unroll
            for (int m = 0; m < 4; ++m) {
                const int row = row0 + ai * 128 + m * 16;
#pragma unroll
                for (int bj = 0; bj < 2; ++bj) {
                    const int c = col0 + bj * 128;
                    const u32x4 g = *(const u32x4*)(PG + (size_t)row * PG_LD + SECOND * 1024 + c);
                    const f32x4 v0 = acc[ai][bj][m][0], v1 = acc[ai][bj][m][1];
                    float o[8];
                    o[0] = sigmoidf_(bflo(g.x)) * v0[0]; o[1] = sigmoidf_(bfhi(g.x)) * v0[1]; o[2] = sigmoidf_(bflo(g.y)) * v0[2]; o[3] = sigmoidf_(bfhi(g.y)) * v0[3];
                    o[4] = sigmoidf_(bflo(g.z)) * v1[0]; o[5] = sigmoidf_(bfhi(g.z)) * v1[1]; o[6] = sigmoidf_(bflo(g.w)) * v1[2]; o[7] = sigmoidf_(bfhi(g.w)) * v1[3];
                    bf16* mp = MG + (size_t)row * D + c;
                    if (SECOND) { const u32x4 old = *(const u32x4*)mp;
                        o[0] += bflo(old.x); o[1] += bfhi(old.x); o[2] += bflo(old.y); o[3] += bfhi(old.y); o[4] += bflo(old.z); o[5] += bfhi(old.z); o[6] += bflo(old.w); o[7] += bfhi(old.w); }
                    u32x4 w; w.x = cvt_pk_bf16(o[0], o[1]); w.y = cvt_pk_bf16(o[2], o[3]); w.z = cvt_pk_bf16(o[4], o[5]); w.w = cvt_pk_bf16(o[6], o[7]);
                    *(u32x4*)mp = w;
                }
                asm volatile("" ::: "memory");
            }
    }
};
struct EpiRes {
    static constexpr bool PERM = false;
    const float* src_c; const float* src_l; float* dst_c; float* dst_l; const float* mod;
    __device__ __forceinline__ void operator()(const f32x4 (&acc)[2][2][4][2], const Unit& u, int wr, int wc, int fr, int fq) const {
        const bool isctx = u.pm < 8;
        const int slot = isctx ? 8 : ((u.pm - 8) >> 5);
        const float* src = isctx ? src_c : src_l;
        float* dst = isctx ? dst_c : dst_l;
        const int rbase = (isctx ? u.pm * 256 : (u.pm - 8) * 256) + wr * 64 + fr;
        const int col0 = u.pn * 256 + wc * 32 + 4 * fq;
        const float* ga = mod + slot * 6144 + 2048;
        f32x4 gv[2][2];
#pragma unroll
        for (int bj = 0; bj < 2; ++bj)
#pragma unroll
            for (int n = 0; n < 2; ++n) gv[bj][n] = *(const f32x4*)(ga + col0 + bj * 128 + n * 16);
#pragma unroll
        for (int ai = 0; ai < 2; ++ai)
#pragma unroll
            for (int m = 0; m < 4; ++m) {
                const size_t off = (size_t)(rbase + ai * 128 + m * 16) * D + col0;
#pragma unroll
                for (int bj = 0; bj < 2; ++bj)
#pragma unroll
                    for (int n = 0; n < 2; ++n) { const f32x4 x = *(const f32x4*)(src + off + bj * 128 + n * 16); *(f32x4*)(dst + off + bj * 128 + n * 16) = x + gv[bj][n] * acc[ai][bj][m][n]; }
                asm volatile("" ::: "memory");
            }
    }
};
struct EpiF32 {
    static constexpr bool PERM = false;
    float* C; int ldc;
    __device__ __forceinline__ void operator()(const f32x4 (&acc)[2][2][4][2], const Unit& u, int wr, int wc, int fr, int fq) const {
        const int row0 = u.pm * 256 + wr * 64 + fr, col0 = u.pn * 256 + wc * 32 + 4 * fq;
#pragma unroll
        for (int ai = 0; ai < 2; ++ai)
#pragma unroll
            for (int m = 0; m < 4; ++m) { float* rowp = C + (size_t)(row0 + ai * 128 + m * 16) * ldc + col0;
#pragma unroll
                for (int bj = 0; bj < 2; ++bj)
#pragma unroll
                    for (int n = 0; n < 2; ++n) *(f32x4*)(rowp + bj * 128 + n * 16) = acc[ai][bj][m][n]; }
    }
};

__device__ __forceinline__ void p0_transpose_item(const float* W, int K, int N, bf16* WT, int dst_row0, LAS float* scr, int k0, int n0, int lane) {
#pragma unroll 8
    for (int i = 0; i < 32; ++i) { const int kk = 2 * i + (lane >> 5); scr[kk * 33 + (lane & 31)] = W[(size_t)(k0 + kk) * N + n0 + (lane & 31)]; }
    LDS_WAIT(); asm volatile("" ::: "memory");
    const int c = lane & 7;
#pragma unroll
    for (int j = 0; j < 4; ++j) { const int n = (lane >> 3) + 8 * j; const LAS float* s = scr + (8 * c) * 33 + n;
        v4u o; o.x = pk2(s[0 * 33], s[1 * 33]); o.y = pk2(s[2 * 33], s[3 * 33]); o.z = pk2(s[4 * 33], s[5 * 33]); o.w = pk2(s[6 * 33], s[7 * 33]);
        *(v4u*)(WT + (size_t)(dst_row0 + n) * K + k0 + 8 * c) = o; }
    LDS_WAIT(); asm volatile("" ::: "memory");
}
__device__ __forceinline__ int win_map(int n0) { return n0 < 1024 ? n0 : (n0 < 1056 ? 5120 + (n0 - 1024) : n0 - 32); }

__device__ __forceinline__ void p0_prologue(const Frame& F) {
    CArgsP a = kargs(); unsigned char* const ws = a->ws;
    const int gw = F.vcu * NWAVES + F.wave, NGW = F.G * NWAVES;
    const int gtid = F.vcu * NT + F.tid, GT = F.G * NT;
    {
        LAS float* scr = (LAS float*)(F.lds + F.wave * 16384);
        constexpr int I_IN = 16 * 161, I_P = 8 * 32, I_O = 16 * 32, PER_L = I_IN + 2 * I_P + I_O;
        for (int it = gw; it < DEPTH * PER_L; it += NGW) {
            const int l = it / PER_L; int r = it % PER_L;
            if (r < I_IN) { const int kb = r / 161, nb = r % 161; p0_transpose_item(a->in[I_WIN] + (size_t)l * D * IN_COLS, D, IN_COLS, (bf16*)(ws + WS_WIN) + (size_t)l * NPAD * D, win_map(nb * 32), scr, kb * 64, nb * 32, F.lane); continue; }
            r -= I_IN;
            if (r < I_P) { const int kb = r / 32, nb = r % 32; p0_transpose_item(a->in[I_WPG] + (size_t)l * 512 * D, 512, D, (bf16*)(ws + WS_WPG) + (size_t)l * D * 512, nb * 32, scr, kb * 64, nb * 32, F.lane); continue; }
            r -= I_P;
            if (r < I_P) { const int kb = r / 32, nb = r % 32; p0_transpose_item(a->in[I_WPN] + (size_t)l * 512 * D, 512, D, (bf16*)(ws + WS_WPN) + (size_t)l * D * 512, nb * 32, scr, kb * 64, nb * 32, F.lane); continue; }
            r -= I_P;
            { const int kb = r / 32, nb = r % 32; p0_transpose_item(a->in[I_WO] + (size_t)l * D * D, D, D, (bf16*)(ws + WS_WO) + (size_t)l * D * D, nb * 32, scr, kb * 64, nb * 32, F.lane); }
        }
        constexpr int PADV = (NPAD - IN_COLS) * D / 8;
        for (int i = gtid; i < DEPTH * PADV; i += GT) { const int l = i / PADV, j = i % PADV; *((v4u*)((bf16*)(ws + WS_WIN) + ((size_t)l * NPAD + IN_COLS) * D) + j) = (v4u){0u, 0u, 0u, 0u}; }
    }
    __syncthreads();
    if (gtid < 128 * 16) { const int pos = gtid >> 4, j = gtid & 15; const float freq = powf(10000.f, -(float)j / 16.f); const float ang = (float)pos * freq;
        float* cs = (float*)(ws + WS_ROPE); cs[2 * gtid] = cosf(ang); cs[2 * gtid + 1] = sinf(ang); }
    {
        LAS float* LSK = (LAS float*)F.lds;
        LAS float* LQ = (LAS float*)(F.lds + 128 * 132 * 4);
        for (int unit = F.vcu; unit < DEPTH * 16 * 16; unit += F.G) {
            const int l = unit >> 8, hp = (unit >> 4) & 15, d0 = (unit & 15) * 64;
            const float* sk = a->in[I_SK] + ((size_t)l * 16 + hp) * 16384;
            const float* wq = a->in[I_WQ] + (size_t)l * D * 2048 + hp * 128;
            __syncthreads();
            for (int i = F.tid; i < 16384; i += NT) LSK[(i >> 7) * 132 + (i & 127)] = sk[i];
            for (int i = F.tid; i < 8192; i += NT) LQ[(i >> 7) * 132 + (i & 127)] = wq[(size_t)(d0 + (i >> 7)) * 2048 + (i & 127)];
            __syncthreads();
            const int dd = F.tid & 63, kg = F.tid >> 6;
            float acc[16];
#pragma unroll
            for (int k = 0; k < 16; ++k) acc[k] = 0.f;
            for (int j = 0; j < 128; j += 4) {
                const f32x4 q = *(const LAS f32x4*)(LQ + dd * 132 + j);
#pragma unroll
                for (int k = 0; k < 16; ++k) { const f32x4 s = *(const LAS f32x4*)(LSK + (kg * 16 + k) * 132 + j); acc[k] += q[0] * s[0] + q[1] * s[1] + q[2] * s[2] + q[3] * s[3]; }
            }
            bf16* o = (bf16*)(ws + WS_WS) + ((size_t)l * 2048 + hp * 128 + kg * 16) * D + d0 + dd;
#pragma unroll
            for (int k = 0; k < 16; ++k) o[(size_t)k * D] = (bf16)f2bf(acc[k]);
        }
    }
    __syncthreads();
    {
        LAS float* ca = (LAS float*)F.lds;
        LAS float* red = (LAS float*)(F.lds + 9 * D * 4);
        for (int i = F.tid; i < 9 * D; i += NT) { const float v = i < 8 * D ? a->in[I_C][i] : a->in[I_CCTX][i - 8 * D]; ca[i] = v / (1.f + __expf(-v)); }
        __syncthreads();
        float* MOD = (float*)(ws + WS_MOD);
        for (int unit = F.vcu; unit < DEPTH * 96; unit += F.G) {
            const int l = unit / 96, cb = unit % 96, dc = F.tid >> 6;
            const int col = cb * 64 + (F.tid & 63);
            const float* w = a->in[I_WMOD] + ((size_t)l * D + dc * 128) * 6144 + col;
            float acc[9];
#pragma unroll
            for (int b = 0; b < 9; ++b) acc[b] = 0.f;
#pragma unroll 8
            for (int d = 0; d < 128; ++d) { const float wv = w[(size_t)d * 6144];
#pragma unroll
                for (int b = 0; b < 9; ++b) acc[b] += ca[b * D + dc * 128 + d] * wv; }
#pragma unroll
            for (int b = 0; b < 9; ++b) red[(dc * 9 + b) * 64 + (F.tid & 63)] = acc[b];
            __syncthreads();
            for (int i = F.tid; i < 9 * 64; i += NT) { const int b = i >> 6, c = i & 63; float sum = a->in[I_BMOD][l * 6144 + cb * 64 + c];
#pragma unroll
                for (int k = 0; k < 8; ++k) sum += red[(k * 9 + b) * 64 + c];
                MOD[((size_t)l * 9 + b) * 6144 + cb * 64 + c] = sum; }
            __syncthreads();
        }
    }
    __syncthreads();
}

__device__ __forceinline__ void convert_experts(const Frame& F, int layer) {
    CArgsP a = kargs(); unsigned char* const ws = a->ws;
    const int gtid = F.vcu * NT + F.tid, GT = F.G * NT;
    const f32x4* su = (const f32x4*)(a->in[I_EU] + (size_t)layer * NEXP * D);
    const f32x4* sv = (const f32x4*)(a->in[I_EV] + (size_t)layer * NEXP * D);
    v4u* du = (v4u*)(ws + WS_EU); v4u* dv = (v4u*)(ws + WS_EV);
    constexpr int NV = NEXP * D / 8;
    for (int i = gtid; i < NV; i += GT) {
        const f32x4 a0 = su[2 * i], a1 = su[2 * i + 1], b0 = sv[2 * i], b1 = sv[2 * i + 1];
        du[i] = (v4u){pk2(a0[0], a0[1]), pk2(a0[2], a0[3]), pk2(a1[0], a1[1]), pk2(a1[2], a1[3])};
        dv[i] = (v4u){pk2(b0[0], b0[1]), pk2(b0[2], b0[3]), pk2(b1[0], b1[1]), pk2(b1[2], b1[3])};
    }
}

__device__ __forceinline__ void norm_phase(const Frame& F, int layer, int which) {
    CArgsP a = kargs(); unsigned char* const ws = a->ws;
    const int gw = F.vcu * NWAVES + F.wave, NGW = F.G * NWAVES;
    const float* g = (which ? a->in[I_GN2] : a->in[I_GN1]) + layer * D;
    const float* MOD = (const float*)(ws + WS_MOD) + (size_t)layer * 9 * 6144 + (which ? 3072 : 0);
    bf16* H = (bf16*)(ws + WS_H);
    f32x4 gv[4];
#pragma unroll
    for (int j = 0; j < 4; ++j) gv[j] = *((const f32x4*)g + F.lane + 64 * j);
    for (int r = gw; r < R; r += NGW) {
        const float* xr = (which == 0 && layer == 0) ? xrow_in(a, r) : xrow_cur(a, r);
        const float* sh = MOD + row_slot(r) * 6144; const float* sc = sh + D;
        f32x4 v[4]; float ss = 0.f;
#pragma unroll
        for (int j = 0; j < 4; ++j) { v[j] = *((const GAS f32x4*)xr + F.lane + 64 * j); ss += (v[j][0] * v[j][0] + v[j][1] * v[j][1]) + (v[j][2] * v[j][2] + v[j][3] * v[j][3]); }
        const float rs = rsqrtf(wave_sum(ss) * (1.f / D) + EPS);
        unsigned long long* o8 = (unsigned long long*)(H + (size_t)r * D) + F.lane;
#pragma unroll
        for (int j = 0; j < 4; ++j) {
            const f32x4 s1 = *((const f32x4*)sc + F.lane + 64 * j), s0 = *((const f32x4*)sh + F.lane + 64 * j);
            const f32x4 y = v[j] * rs * gv[j] * (s1 + 1.f) + s0;
            o8[64 * j] = (unsigned long long)pk2(y[0], y[1]) | ((unsigned long long)pk2(y[2], y[3]) << 32);
        }
    }
}

__device__ __forceinline__ void gla_naive_phase(const Frame& F, int layer) {
    CArgsP a = kargs(); unsigned char* const ws = a->ws;
    const int gw = F.vcu * NWAVES + F.wave, NGW = F.G * NWAVES;
    const bf16* PA = (const bf16*)(ws + WS_PA);
    const float* Z = (const float*)(ws + WS_Z);
    for (int task = gw; task < 2048; task += NGW) {
        const int slice = task & 31, dir = (task >> 5) & 1, h = (task >> 6) & 3, b = task >> 8;
        const float* wa = (dir ? a->in[I_WAB] : a->in[I_WAF]) + layer * 16 * 256 + h * 64 + F.lane;
        const float ba = (dir ? a->in[I_BAB] : a->in[I_BAF])[layer * 256 + h * 64 + F.lane];
        float wv[16];
#pragma unroll
        for (int j = 0; j < 16; ++j) wv[j] = wa[j * 256];
        bf16* O = (bf16*)(ws + WS_H) + (size_t)dir * R * 512;
        float S0 = 0.f, S1 = 0.f, S2 = 0.f, S3 = 0.f;
        int lz = 0; asm volatile("" : "+v"(lz));
        for (int s = 0; s < CTXL + SEQ; ++s) {
            int r;
            if (s < CTXL) r = b * CTXL + (dir ? CTXL - 1 - s : s);
            else { const int t = s - CTXL; r = NCTX + b * SEQ + (dir ? SEQ - 1 - t : t); }
            const f32x4* zp = (const f32x4*)(Z + (size_t)r * 32 + dir * 16 + lz);
            const f32x4 z0 = zp[0], z1 = zp[1], z2 = zp[2], z3 = zp[3];
            const bf16* pr = PA + (size_t)r * PA_LD;
            const float q = bf1(pr[PA_Q + h * 64 + F.lane]), k = bf1(pr[PA_K + h * 64 + F.lane]);
            const v2u vv = *(const v2u*)(pr + PA_V + h * 128 + slice * 4 + lz);
            float zz = ba;
            zz += z0[0] * wv[0] + z0[1] * wv[1] + z0[2] * wv[2] + z0[3] * wv[3];
            zz += z1[0] * wv[4] + z1[1] * wv[5] + z1[2] * wv[6] + z1[3] * wv[7];
            zz += z2[0] * wv[8] + z2[1] * wv[9] + z2[2] * wv[10] + z2[3] * wv[11];
            zz += z3[0] * wv[12] + z3[1] * wv[13] + z3[2] * wv[14] + z3[3] * wv[15];
            const float ls = fminf(zz, 0.f) - log1pf(__expf(-fabsf(zz)));
            const float al = __expf(ls * (1.f / 16.f));
            S0 = al * S0 + k * bflo(vv.x); S1 = al * S1 + k * bfhi(vv.x); S2 = al * S2 + k * bflo(vv.y); S3 = al * S3 + k * bfhi(vv.y);
            float o0 = q * S0, o1 = q * S1, o2 = q * S2, o3 = q * S3;
#pragma unroll
            for (int o = 1; o < 64; o <<= 1) { o0 += __shfl_xor(o0, o); o1 += __shfl_xor(o1, o); o2 += __shfl_xor(o2, o); o3 += __shfl_xor(o3, o); }
            if (F.lane == 0) *(v2u*)(O + (size_t)r * 512 + h * 128 + slice * 4) = (v2u){pk2(o0, o1), pk2(o2, o3)};
        }
    }
}
__device__ __forceinline__ void gla_finalize_phase(const Frame& F, int layer) {
    CArgsP a = kargs(); unsigned char* const ws = a->ws;
    const int gw = F.vcu * NWAVES + F.wave, NGW = F.G * NWAVES;
    bf16* PA = (bf16*)(ws + WS_PA);
    const bf16* OF = (const bf16*)(ws + WS_H); const bf16* OB = OF + (size_t)R * 512;
    const float* gg = a->in[I_GGLA] + layer * 128 + ((8 * F.lane) & 127);
    const f32x4 g0 = *(const f32x4*)gg, g1 = *(const f32x4*)(gg + 4);
    for (int r = gw; r < R; r += NGW) {
        const v4u f = *(const v4u*)(OF + (size_t)r * 512 + 8 * F.lane), bb = *(const v4u*)(OB + (size_t)r * 512 + 8 * F.lane);
        bf16* rp = PA + (size_t)r * PA_LD + PA_R + 8 * F.lane;
        const v4u rr = *(const v4u*)rp;
        float o[8] = {bflo(f.x) + bflo(bb.x), bfhi(f.x) + bfhi(bb.x), bflo(f.y) + bflo(bb.y), bfhi(f.y) + bfhi(bb.y), bflo(f.z) + bflo(bb.z), bfhi(f.z) + bfhi(bb.z), bflo(f.w) + bflo(bb.w), bfhi(f.w) + bfhi(bb.w)};
        float ss = 0.f;
#pragma unroll
        for (int e = 0; e < 8; ++e) ss += o[e] * o[e];
        ss += __shfl_xor(ss, 1); ss += __shfl_xor(ss, 2); ss += __shfl_xor(ss, 4); ss += __shfl_xor(ss, 8);
        const float rs = rsqrtf(ss * (1.f / 128.f) + EPS);
        const float rv[8] = {bflo(rr.x), bfhi(rr.x), bflo(rr.y), bfhi(rr.y), bflo(rr.z), bfhi(rr.z), bflo(rr.w), bfhi(rr.w)};
        const float gv[8] = {g0[0], g0[1], g0[2], g0[3], g1[0], g1[1], g1[2], g1[3]};
        float y[8];
#pragma unroll
        for (int e = 0; e < 8; ++e) y[e] = o[e] * rs * gv[e] * (rv[e] / (1.f + __expf(-rv[e])));
        *(v4u*)rp = (v4u){pk2(y[0], y[1]), pk2(y[2], y[3]), pk2(y[4], y[5]), pk2(y[6], y[7])};
    }
}

__device__ __forceinline__ void na_naive_phase(const Frame& F, int layer) {
    CArgsP a = kargs(); unsigned char* const ws = a->ws;
    const int gw = F.vcu * NWAVES + F.wave, NGW = F.G * NWAVES;
    bf16* PA = (bf16*)(ws + WS_PA);
    LAS float* pl = (LAS float*)(F.lds + F.wave * 2048);
    const int lane = F.lane;
    for (int task = gw; task < R * 8; task += NGW) {
        const int r = task >> 3, hd = task & 7;
        const bool lat = r >= NCTX;
        const int b = lat ? ((r - NCTX) >> 13) : (r >> 8);
        int row = 0, col = 0, r0 = 0, c0 = 0;
        if (lat) { const int t = (r - NCTX) & (SEQ - 1); row = t >> 6; col = t & 63; r0 = min(max(row - 4, 0), 120); c0 = min(max(col - 8, 0), 48); }
        const int latbase = NCTX + b * SEQ, ctxbase = b * CTXL;
        bf16* qp = PA + (size_t)r * PA_LD + PA_NQ + hd * 64;
        v4u q[8];
#pragma unroll
        for (int i = 0; i < 8; ++i) q[i] = *((const v4u*)qp + i);
        float s[6];
#pragma unroll
        for (int j = 0; j < 6; ++j) {
            int kr; float bias = 0.f; bool valid = true;
            if (j < 2) { const int w = lane + 64 * j, wa = w >> 4, wi = w & 15; kr = latbase + (r0 + wa) * 64 + c0 + wi; valid = lat;
                if (lat) bias = a->in[I_RPB][((size_t)(layer * 8 + hd) * 15 + (r0 + wa - row + 7)) * 31 + (c0 + wi - col + 15)]; }
            else kr = ctxbase + lane + 64 * (j - 2);
            if (!valid) kr = ctxbase;
            const v4u* kp = (const v4u*)(PA + (size_t)kr * PA_LD + PA_NK + hd * 64);
            float d0 = 0.f, d1 = 0.f;
#pragma unroll
            for (int i = 0; i < 8; ++i) { const v4u kk = kp[i]; d0 = dot2(kk.x, q[i].x, d0); d1 = dot2(kk.y, q[i].y, d1); d0 = dot2(kk.z, q[i].z, d0); d1 = dot2(kk.w, q[i].w, d1); }
            s[j] = valid ? (d0 + d1 + bias) : -3.0e38f;
        }
        float mx = fmaxf(fmaxf(fmaxf(s[0], s[1]), fmaxf(s[2], s[3])), fmaxf(s[4], s[5]));
        mx = wave_max(mx);
        float p[6], sum = 0.f;
#pragma unroll
        for (int j = 0; j < 6; ++j) { p[j] = (j < 2 && !lat) ? 0.f : __expf(s[j] - mx); sum += p[j]; }
        sum = wave_sum(sum);
        const float inv = 1.f / sum;
#pragma unroll
        for (int j = 0; j < 6; ++j) pl[lane + 64 * j] = p[j] * inv;
        LDS_WAIT();
        const int g = lane >> 4, dq = lane & 15;
        float o0 = 0.f, o1 = 0.f, o2 = 0.f, o3 = 0.f;
        for (int jj = lat ? 0 : 32; jj < 96; ++jj) {
            const int key = jj * 4 + g;
            int kr;
            if (key < 128) kr = latbase + (r0 + (key >> 4)) * 64 + c0 + (key & 15); else kr = ctxbase + key - 128;
            const v2u vv = *(const v2u*)(PA + (size_t)kr * PA_LD + PA_NV + hd * 64 + dq * 4);
            const float pp = pl[key];
            o0 += pp * bflo(vv.x); o1 += pp * bfhi(vv.x); o2 += pp * bflo(vv.y); o3 += pp * bfhi(vv.y);
        }
        o0 += __shfl_xor(o0, 16); o1 += __shfl_xor(o1, 16); o2 += __shfl_xor(o2, 16); o3 += __shfl_xor(o3, 16);
        o0 += __shfl_xor(o0, 32); o1 += __shfl_xor(o1, 32); o2 += __shfl_xor(o2, 32); o3 += __shfl_xor(o3, 32);
        if (lane < 16) *(v2u*)(qp + dq * 4) = (v2u){pk2(o0, o1), pk2(o2, o3)};
        LDS_WAIT();
    }
}

__device__ __forceinline__ float pack_key(float v, int idx) { return __builtin_bit_cast(float, (__builtin_bit_cast(unsigned, v) & ~127u) | (unsigned)idx); }
__device__ __forceinline__ void topk_phase(const Frame& F) {
    CArgsP a = kargs(); unsigned char* const ws = a->ws;
    const int gtid = F.vcu * NT + F.tid, GT = F.G * NT;
    const float* SC = (const float*)(ws + WS_SC);
    int* EI = (int*)(ws + WS_EI); float* EG = (float*)(ws + WS_EG);
    LAS unsigned* myl = (LAS unsigned*)F.lds + F.tid * 9;
    for (int id = gtid; id < R * 8; id += GT) {
        const int r = id >> 3, hd = id & 7;
        const f32x4* sp = (const f32x4*)(SC + (size_t)r * 2048 + hd * 256);
        float t0[16], t1[16];
#pragma unroll
        for (int j = 0; j < 16; ++j) { t0[j] = -3.0e38f; t1[j] = -3.0e38f; }
        for (int i = 0; i < 32; ++i) {
            const f32x4 va = sp[i], vb = sp[32 + i];
#pragma unroll
            for (int e = 0; e < 4; ++e) {
                float x = pack_key(va[e], i * 4 + e), y = pack_key(vb[e], i * 4 + e);
#pragma unroll
                for (int j = 0; j < 16; ++j) { const float tx = fmaxf(t0[j], x); x = fminf(t0[j], x); t0[j] = tx; const float ty = fmaxf(t1[j], y); y = fminf(t1[j], y); t1[j] = ty; }
            }
        }
        float best[16];
#pragma unroll
        for (int j = 0; j < 16; ++j) best[j] = -3.0e38f;
#pragma unroll
        for (int ia = 0; ia < 16; ++ia)
#pragma unroll
            for (int ib = 0; ib < 16; ++ib)
                if ((ia + 1) * (ib + 1) <= 16) {
                    float x = __builtin_bit_cast(float, (__builtin_bit_cast(unsigned, t0[ia] + t1[ib]) & ~255u) | (unsigned)(ia * 16 + ib));
#pragma unroll
                    for (int j = 0; j < 16; ++j) { const float tb = fmaxf(best[j], x); x = fminf(best[j], x); best[j] = tb; }
                }
        {
            unsigned w0[4], w1[4];
#pragma unroll
            for (int q = 0; q < 4; ++q) {
                w0[q] = (__builtin_bit_cast(unsigned, t0[4 * q]) & 127u) | ((__builtin_bit_cast(unsigned, t0[4 * q + 1]) & 127u) << 8) | ((__builtin_bit_cast(unsigned, t0[4 * q + 2]) & 127u) << 16) | ((__builtin_bit_cast(unsigned, t0[4 * q + 3]) & 127u) << 24);
                w1[q] = (__builtin_bit_cast(unsigned, t1[4 * q]) & 127u) | ((__builtin_bit_cast(unsigned, t1[4 * q + 1]) & 127u) << 8) | ((__builtin_bit_cast(unsigned, t1[4 * q + 2]) & 127u) << 16) | ((__builtin_bit_cast(unsigned, t1[4 * q + 3]) & 127u) << 24);
            }
#pragma unroll
            for (int q = 0; q < 4; ++q) { myl[q] = w0[q]; myl[4 + q] = w1[q]; }
            LDS_WAIT();
        }
        int eid[16];
#pragma unroll
        for (int j = 0; j < 16; ++j) { const unsigned code = __builtin_bit_cast(unsigned, best[j]) & 255u; const LAS unsigned char* mb = (const LAS unsigned char*)myl;
            eid[j] = (int)mb[code >> 4] * 128 + (int)mb[16 + (code & 15u)]; }
        LDS_WAIT();
        float sum = 0.f; const float bmax = best[0];
#pragma unroll
        for (int j = 0; j < 16; ++j) { best[j] = __expf(best[j] - bmax); sum += best[j]; }
        const float inv = 1.f / sum;
        v4i* ei = (v4i*)(EI + (size_t)r * 128 + hd * 16); f32x4* eg = (f32x4*)(EG + (size_t)r * 128 + hd * 16);
#pragma unroll
        for (int j = 0; j < 4; ++j) { ei[j] = (v4i){eid[4 * j], eid[4 * j + 1], eid[4 * j + 2], eid[4 * j + 3]}; eg[j] = (f32x4){best[4 * j] * inv, best[4 * j + 1] * inv, best[4 * j + 2] * inv, best[4 * j + 3] * inv}; }
    }
}

__device__ __forceinline__ float gelu_tanh(float x) { const float u = 0.7978845608f * (x + 0.044715f * x * x * x); const float t = 1.f - 2.f / (1.f + __expf(2.f * u)); return 0.5f * x * (1.f + t); }
__device__ __forceinline__ void peer_phase(const Frame& F, int layer) {
    CArgsP a = kargs(); unsigned char* const ws = a->ws;
    const int gw = F.vcu * NWAVES + F.wave, NGW = F.G * NWAVES;
    const bf16* H = (const bf16*)(ws + WS_H);
    const bf16* EU = (const bf16*)(ws + WS_EU); const bf16* EV = (const bf16*)(ws + WS_EV);
    const int* EI = (const int*)(ws + WS_EI); const float* EG = (const float*)(ws + WS_EG);
    const float* MOD = (const float*)(ws + WS_MOD) + (size_t)layer * 9 * 6144 + 5 * D;
    LAS unsigned char* xl = F.lds + F.wave * 4096;
    const int lane = F.lane, e16 = lane & 15, g = lane >> 4;
    for (int r = gw; r < R; r += NGW) {
        { const v4u* hp = (const v4u*)(H + (size_t)r * D) + 2 * lane; const v4u h0 = hp[0], h1 = hp[1]; *(LAS v4u*)(xl + lane * 32) = h0; *(LAS v4u*)(xl + lane * 32 + 16) = h1; }
        const int idA = EI[(size_t)r * 128 + lane], idB = EI[(size_t)r * 128 + 64 + lane];
        LDS_WAIT();
        float actA = 0.f, actB = 0.f;
#pragma unroll 1
        for (int eg = 0; eg < 8; ++eg) {
            const int id = EI[(size_t)r * 128 + eg * 16 + e16]; const float gate = EG[(size_t)r * 128 + eg * 16 + e16];
            const v4u* up = (const v4u*)(EU + (size_t)id * D + g * 8);
            float d0 = 0.f, d1 = 0.f;
#pragma unroll
            for (int c = 0; c < 32; ++c) { const v4u w = up[c * 4]; const v4u xx = *(const LAS v4u*)(xl + (c * 32 + g * 8) * 2);
                d0 = dot2(w.x, xx.x, d0); d1 = dot2(w.y, xx.y, d1); d0 = dot2(w.z, xx.z, d0); d1 = dot2(w.w, xx.w, d1); }
            float dsum = d0 + d1;
            dsum += __shfl_xor(dsum, 16); dsum += __shfl_xor(dsum, 32);
            const float act = gelu_tanh(dsum) * gate;
            if (eg < 4) { if (g == eg) actA = act; } else { if (g == eg - 4) actB = act; }
        }
        float o[16];
#pragma unroll
        for (int k = 0; k < 16; ++k) o[k] = 0.f;
#pragma unroll 4
        for (int e = 0; e < 128; ++e) {
            const int id = __builtin_amdgcn_readlane(e < 64 ? idA : idB, e & 63);
            const float av = __builtin_bit_cast(float, __builtin_amdgcn_readlane(__builtin_bit_cast(int, e < 64 ? actA : actB), e & 63));
            const v4u* vp = (const v4u*)(EV + (size_t)id * D + lane * 16);
            const v4u w0 = vp[0], w1 = vp[1];
            o[0] += av * bflo(w0.x); o[1] += av * bfhi(w0.x); o[2] += av * bflo(w0.y); o[3] += av * bfhi(w0.y); o[4] += av * bflo(w0.z); o[5] += av * bfhi(w0.z); o[6] += av * bflo(w0.w); o[7] += av * bfhi(w0.w);
            o[8] += av * bflo(w1.x); o[9] += av * bfhi(w1.x); o[10] += av * bflo(w1.y); o[11] += av * bfhi(w1.y); o[12] += av * bflo(w1.z); o[13] += av * bfhi(w1.z); o[14] += av * bflo(w1.w); o[15] += av * bfhi(w1.w);
        }
        float* xp = xrow_cur(a, r) + lane * 16;
        const float* ga = MOD + row_slot(r) * 6144 + lane * 16;
#pragma unroll
        for (int j = 0; j < 4; ++j) { const f32x4 x = *(const f32x4*)(xp + 4 * j), gq = *(const f32x4*)(ga + 4 * j); *(f32x4*)(xp + 4 * j) = x + gq * (f32x4){o[4 * j], o[4 * j + 1], o[4 * j + 2], o[4 * j + 3]}; }
        LDS_WAIT();
    }
}

__device__ __forceinline__ void final_phase(const Frame& F) {
    CArgsP a = kargs(); unsigned char* const ws = a->ws;
    const int gw = F.vcu * NWAVES + F.wave, NGW = F.G * NWAVES;
    f32x4 gv[4];
#pragma unroll
    for (int j = 0; j < 4; ++j) gv[j] = *((const f32x4*)a->in[I_GF] + F.lane + 64 * j);
    for (int r = gw; r < NLAT; r += NGW) {
        f32x4* xr = (f32x4*)(a->out + (size_t)r * D) + F.lane;
        f32x4 v[4]; float ss = 0.f;
#pragma unroll
        for (int j = 0; j < 4; ++j) { v[j] = xr[64 * j]; ss += (v[j][0] * v[j][0] + v[j][1] * v[j][1]) + (v[j][2] * v[j][2] + v[j][3] * v[j][3]); }
        const float rs = rsqrtf(wave_sum(ss) * (1.f / D) + EPS);
#pragma unroll
        for (int j = 0; j < 4; ++j) xr[64 * j] = v[j] * rs * gv[j];
    }
}

__global__ void __launch_bounds__(NT, 2) fwd_kernel(Args args) {
    extern __shared__ __attribute__((aligned(16))) unsigned char lds[];
    Frame F;
    F.lds = (LAS unsigned char*)lds;
    F.tid = threadIdx.x; F.lane = F.tid & 63; F.wave = __builtin_amdgcn_readfirstlane(F.tid >> 6);
    F.G = gridDim.x; { const int bx = blockIdx.x; F.vcu = (F.G % 8 == 0) ? (bx % 8) * (F.G / 8) + bx / 8 : bx; }
    volatile LAS unsigned* MISC = (volatile LAS unsigned*)(F.lds + MISC_OFF);
    for (int u = F.tid; u < (LDS_BYTES - LDSCTL_OFF) / 4; u += NT) ((LAS unsigned*)(F.lds + LDSCTL_OFF))[u] = 0u;
    __syncthreads();
    XcdBarrier bar; bar.bar = (unsigned*)(args.ws + WS_CTL) + CW_BAR; bar.x = 0; bar.st = nullptr;
    if (MK_SINGLE) bar = xcd_barrier_post((unsigned*)(args.ws + WS_CTL) + CW_BAR, MISC + 8);
    const int lo = args.ph_lo, hi = args.ph_hi;
#define IN(k) (lo <= (k) && (k) < hi)
#define PF Frame Fp = F; asm volatile("" : "+v"(Fp.tid), "+v"(Fp.lane))
#define SEAM(k) do { if (MK_SINGLE && IN(k) && IN((k) + 1)) { xcd_barrier(bar); } } while (0)

    if (IN(0)) { PF; p0_prologue(Fp); SEAM(0); }

    for (int l = 0; l < DEPTH; ++l) {
        const int pb = 1 + l * NPL;
        if (IN(pb + 0)) { { PF; norm_phase(Fp, l, 0); } { PF; convert_experts(Fp, l); } SEAM(pb + 0); }
        if (IN(pb + 1)) {
            CArgsP ap = kargs(); unsigned char* const ws = ap->ws; bf16* Hb = (bf16*)(ws + WS_H); bf16* PA = (bf16*)(ws + WS_PA); bf16* PG = (bf16*)(ws + WS_PG);
            pg8::Gemm g{Hb, (const bf16*)(ws + WS_WIN) + (size_t)l * NPAD * D, R, NPAD, D, D}; pg8::StaticOrder S; S.init(R, NPAD, F.G, (int)blockIdx.x);
            EpiIn E{PA, PG, (float*)(ws + WS_Z), (const float*)(ws + WS_ROPE)};
            pg8::gemm_phase<EpiIn, pg8::StaticOrder, true, true>(F.lds, g, S, E);
            SEAM(pb + 1);
        }
        if (IN(pb + 2)) { { PF; gla_naive_phase(Fp, l); } { PF; na_naive_phase(Fp, l); } SEAM(pb + 2); }
        if (IN(pb + 3)) { PF; gla_finalize_phase(Fp, l); SEAM(pb + 3); }
        if (IN(pb + 4)) {
            CArgsP ap = kargs(); unsigned char* const ws = ap->ws; bf16* Hb = (bf16*)(ws + WS_H); bf16* PA = (bf16*)(ws + WS_PA); bf16* PG = (bf16*)(ws + WS_PG);
            pg8::StaticOrder S; S.init(R, D, F.G, (int)blockIdx.x);
            { pg8::Gemm g{PA + PA_R, (const bf16*)(ws + WS_WPG) + (size_t)l * D * 512, R, D, 512, PA_LD}; EpiMerge<0> E{Hb, PG}; pg8::gemm_phase<EpiMerge<0>, pg8::StaticOrder, true, true>(F.lds, g, S, E); }
            { pg8::Gemm g{PA + PA_NQ, (const bf16*)(ws + WS_WPN) + (size_t)l * D * 512, R, D, 512, PA_LD}; EpiMerge<1> E{Hb, PG}; pg8::gemm_phase<EpiMerge<1>, pg8::StaticOrder, true, true>(F.lds, g, S, E); }
            SEAM(pb + 4);
        }
        if (IN(pb + 5)) {
            CArgsP ap = kargs(); unsigned char* const ws = ap->ws; bf16* Hb = (bf16*)(ws + WS_H);
            pg8::Gemm g{Hb, (const bf16*)(ws + WS_WO) + (size_t)l * D * D, R, D, D, D}; pg8::StaticOrder S; S.init(R, D, F.G, (int)blockIdx.x);
            EpiRes E{l == 0 ? ap->in[I_CTX] : (const float*)(ws + WS_XC), l == 0 ? ap->in[I_X] : (const float*)ap->out, (float*)(ws + WS_XC), ap->out, (const float*)(ws + WS_MOD) + (size_t)l * 9 * 6144};
            pg8::gemm_phase<EpiRes, pg8::StaticOrder, true, true>(F.lds, g, S, E);
            SEAM(pb + 5);
        }
        if (IN(pb + 6)) { PF; norm_phase(Fp, l, 1); SEAM(pb + 6); }
        if (IN(pb + 7)) {
            CArgsP ap = kargs(); unsigned char* const ws = ap->ws; bf16* Hb = (bf16*)(ws + WS_H);
            pg8::Gemm g{Hb, (const bf16*)(ws + WS_WS) + (size_t)l * 2048 * D, R, 2048, D, D}; pg8::StaticOrder S; S.init(R, 2048, F.G, (int)blockIdx.x);
            EpiF32 E{(float*)(ws + WS_SC), 2048};
            pg8::gemm_phase<EpiF32, pg8::StaticOrder, true, true>(F.lds, g, S, E);
            SEAM(pb + 7);
        }
        if (IN(pb + 8)) { PF; topk_phase(Fp); SEAM(pb + 8); }
        if (IN(pb + 9)) { PF; peer_phase(Fp, l); SEAM(pb + 9); }
    }
    if (IN(NPHASE - 1)) { PF; final_phase(Fp); }
#undef IN
#undef SEAM
}

extern "C" void kernel_launch(void* const* d_in, const int* in_sizes, int n_in, void* d_out, int out_size, void* d_ws, size_t ws_size, hipStream_t stream) {
    static int grid = 0;
    if (grid == 0) {
        if (n_in != 23 || in_sizes[0] != NLAT * D || out_size != NLAT * D || ws_size < WS_END) { fprintf(stderr, "kernel_launch: unexpected shapes (n_in %d, in0 %d, out %d, ws %zu); nothing launched\n", n_in, n_in > 0 ? in_sizes[0] : -1, out_size, ws_size); grid = -1; return; }
        int dev = 0, cus = 0, per_cu = 0;
        if (hipGetDevice(&dev) != hipSuccess || hipDeviceGetAttribute(&cus, hipDeviceAttributeMultiprocessorCount, dev) != hipSuccess) { grid = -1; return; }
        if (hipFuncSetAttribute((const void*)fwd_kernel, hipFuncAttributeMaxDynamicSharedMemorySize, LDS_BYTES) != hipSuccess) { fprintf(stderr, "kernel_launch: hipFuncSetAttribute failed\n"); grid = -1; return; }
        if (hipOccupancyMaxActiveBlocksPerMultiprocessor(&per_cu, (const void*)fwd_kernel, NT, LDS_BYTES) != hipSuccess || per_cu < 1) { fprintf(stderr, "kernel_launch: occupancy query says %d blocks per CU\n", per_cu); }
        (void)hipGetLastError();
        grid = cus;
    }
    if (grid < 0) return;
    if (hipMemsetAsync((char*)d_ws + WS_CTL, 0, CTL_ZERO_BYTES, stream) != hipSuccess) return;
    Args a{};
    for (int i = 0; i < 23; ++i) a.in[i] = (const float*)d_in[i];
    a.out = (float*)d_out; a.ws = (unsigned char*)d_ws; a.pad = 0;
    if (MK_SINGLE) {
        a.ph_lo = 0; a.ph_hi = NPHASE; a.li = 0;
        hipLaunchKernelGGL(fwd_kernel, dim3(grid), dim3(NT), LDS_BYTES, stream, a);
    } else {
        for (int p = 0; p < NPHASE; ++p) { a.ph_lo = p; a.ph_hi = p + 1; a.li = p; hipLaunchKernelGGL(fwd_kernel, dim3(grid), dim3(NT), LDS_BYTES, stream, a); }
    }
}
```

```cpp
#include <hip/hip_runtime.h>
#include <cstdio>
#include <cstdint>

#ifndef MK_SINGLE
#define MK_SINGLE 1
#endif

namespace pg8 {
#define PG8_LAS __attribute__((address_space(3)))
typedef unsigned short bf16_t;
typedef short bf16x8 __attribute__((ext_vector_type(8)));
typedef float f32x4 __attribute__((ext_vector_type(4)));
typedef unsigned u32x4 __attribute__((ext_vector_type(4)));
constexpr int BM = 256, BK = 64, HALF = 128, HTB = HALF * BK * 2, STAGE_BYTES = 8 * HTB, NXCD = 8, WGM = 8;

__host__ __device__ __forceinline__ int lds_byte(int r, int c) { const int st = (r >> 4) * 2 + (c >> 5), rr = r & 15, cc = c & 31, ob = rr * 64 + cc * 2; return st * 1024 + (ob ^ (((ob >> 9) & 1) << 5)); }
__host__ __device__ __forceinline__ void stage_rc(int b, int& R, int& C) { const int st = b / 1024, sb = b % 1024, swz = sb ^ (((sb >> 9) & 1) << 5); R = (st >> 1) * 16 + swz / 64; C = (st & 1) * 32 + (swz % 64) / 2; }
__host__ __device__ __forceinline__ int perm32(int rho) { const int n = rho >> 4, i = rho & 15; return 8 * (i >> 2) + 4 * n + (i & 3); }

struct Unit { int pm, pn; };
struct Gemm { const bf16_t* A; const bf16_t* Bt; int M, N, K, lda; };

struct StaticOrder {
    int nM, nN, nwg, G, c;
    __host__ __device__ void init(int M, int N, int G_, int c_) { nM = M / BM; nN = N / BM; nwg = nM * nN; G = G_; c = c_; }
    __host__ __device__ bool next(int i, Unit& u) const {
        const long L = (long)i * G + c; if (L >= nwg) return false;
        int wgid = (int)L; { const int q = nwg / NXCD, r = nwg % NXCD, xcd = wgid % NXCD, off = wgid / NXCD; wgid = (xcd < r ? xcd * (q + 1) : r * (q + 1) + (xcd - r) * q) + off; }
        const int nig = WGM * nN, gid = wgid / nig, fm = gid * WGM, gsz = (nM - fm) < WGM ? (nM - fm) : WGM;
        u.pm = fm + ((wgid % nig) % gsz); u.pn = (wgid % nig) / gsz; return true;
    }
    __device__ __forceinline__ void a_ready(const Unit&) const {}
    __device__ __forceinline__ void done(const Unit&) const {}
};

__device__ __forceinline__ unsigned cvt_pk_bf16(float lo, float hi) { unsigned r; asm volatile("v_cvt_pk_bf16_f32 %0, %1, %2" : "=v"(r) : "v"(lo), "v"(hi)); return r; }

template <class Epi, class Sched, bool ALIGN_EPI = false, bool SP2 = false>
__device__ __forceinline__ void gemm_phase(PG8_LAS unsigned char* lds, const Gemm g, const Sched& S, const Epi& E) {
    int tid_ = threadIdx.x; asm volatile("" : "+v"(tid_));
    const int tid = tid_, wid = __builtin_amdgcn_readfirstlane(tid >> 6), lane = tid & 63, wr = wid >> 2, wc = wid & 3, fr = lane & 15, fq = lane >> 4;
    const int K = g.K, nt = K / BK, lda = g.lda;
    unsigned voffA[2], voffB[2];
#pragma unroll
    for (int i = 0; i < 2; ++i) { int R, C; stage_rc(tid * 16 + i * 8192, R, C); const int Rb = Epi::PERM ? ((R & ~31) + perm32(R & 31)) : R;
        voffA[i] = (unsigned)(R * lda + C) * 2u; voffB[i] = (unsigned)(Rb * K + C) * 2u; }
    const size_t kstep = (size_t)(BK * 2);
    const size_t hstepA = (size_t)HALF * lda * 2, hstepB = (size_t)HALF * K * 2;
    const size_t tstepA = 2 * hstepA, tstepB = 2 * hstepB;
    const unsigned ldsw = (unsigned)wid * 1024u;
    const int aoff = lds_byte(wr * 64 + fr, fq * 8), boff = lds_byte(wc * 32 + fr, fq * 8);
#define PG8_SA(b, h) (((b) * 2 + (h)) * HTB)
#define PG8_SB(b, h) ((4 + (b) * 2 + (h)) * HTB)
#define PG8_STAGE(bufoff, gbase, voff) do { _Pragma("unroll") for (int _i = 0; _i < 2; ++_i) \
        __builtin_amdgcn_global_load_lds((const unsigned*)((const char*)(gbase) + (voff)[_i]), (PG8_LAS unsigned*)(lds + (bufoff) + ldsw + _i * 8192), 16, 0, 0); } while (0)
#define PG8_LDA(dst, b, h) do { _Pragma("unroll") for (int m = 0; m < 4; ++m) _Pragma("unroll") for (int k = 0; k < 2; ++k) dst[m][k] = *(const PG8_LAS bf16x8*)(lds + PG8_SA(b, h) + aoff + m * 2048 + k * 1024); } while (0)
#define PG8_LDB(dst, b, h) do { _Pragma("unroll") for (int n = 0; n < 2; ++n) _Pragma("unroll") for (int k = 0; k < 2; ++k) dst[n][k] = *(const PG8_LAS bf16x8*)(lds + PG8_SB(b, h) + boff + n * 2048 + k * 1024); } while (0)
#define PG8_MMA(ai, bj, At, Bt) do { __builtin_amdgcn_s_setprio(1); _Pragma("unroll") for (int m = 0; m < 4; ++m) _Pragma("unroll") for (int n = 0; n < 2; ++n) _Pragma("unroll") for (int k = 0; k < 2; ++k) \
        acc[ai][bj][m][n] = __builtin_amdgcn_mfma_f32_16x16x32_bf16(Bt[n][k], At[m][k], acc[ai][bj][m][n], 0, 0, 0); __builtin_amdgcn_s_setprio(0); } while (0)
#define PG8_WAIT_V(n) asm volatile("s_waitcnt vmcnt(" #n ")" ::: "memory")
#define PG8_WAIT_L(n) asm volatile("s_waitcnt lgkmcnt(" #n ")" ::: "memory")
#define PG8_BAR __builtin_amdgcn_s_barrier()
#define PG8_SCHED __builtin_amdgcn_sched_barrier(0)
    Unit cur, nxt; int ui = 0;
    if (!S.next(0, cur)) return;
    f32x4 acc[2][2][4][2];
#pragma unroll
    for (int a = 0; a < 2; ++a)
#pragma unroll
        for (int b = 0; b < 2; ++b)
#pragma unroll
            for (int m = 0; m < 4; ++m)
#pragma unroll
                for (int n = 0; n < 2; ++n) acc[a][b][m][n] = (f32x4){0.f, 0.f, 0.f, 0.f};
    bf16x8 At[4][2], B0[2][2], B1[2][2];
    const char* cA = (const char*)g.A + (size_t)cur.pm * tstepA; const char* cB = (const char*)g.Bt + (size_t)cur.pn * tstepB;
    S.a_ready(cur);
    if constexpr (SP2) {
        PG8_STAGE(PG8_SB(0, 0), cB, voffB); PG8_STAGE(PG8_SB(0, 1), cB + hstepB, voffB); PG8_STAGE(PG8_SA(0, 0), cA, voffA); PG8_STAGE(PG8_SA(0, 1), cA + hstepA, voffA);
        if (wr == 1) PG8_BAR;
        PG8_WAIT_V(2); PG8_BAR;
        PG8_STAGE(PG8_SB(1, 0), cB + kstep, voffB); PG8_STAGE(PG8_SA(1, 0), cA + kstep, voffA); PG8_STAGE(PG8_SB(1, 1), cB + hstepB + kstep, voffB);
        PG8_WAIT_V(6); PG8_BAR;
    } else {
        PG8_STAGE(PG8_SB(0, 0), cB, voffB); PG8_STAGE(PG8_SA(0, 0), cA, voffA); PG8_STAGE(PG8_SB(0, 1), cB + hstepB, voffB); PG8_STAGE(PG8_SA(0, 1), cA + hstepA, voffA);
        if (wr == 1) PG8_BAR;
        PG8_WAIT_V(4); PG8_BAR;
        PG8_STAGE(PG8_SB(1, 0), cB + kstep, voffB); PG8_STAGE(PG8_SA(1, 0), cA + kstep, voffA); PG8_STAGE(PG8_SB(1, 1), cB + hstepB + kstep, voffB);
        PG8_WAIT_V(6); PG8_BAR;
    }
    for (;;) {
        const bool has_next = S.next(ui + 1, nxt);
        const char* nA = has_next ? (const char*)g.A + (size_t)nxt.pm * tstepA : cA; const char* nB = has_next ? (const char*)g.Bt + (size_t)nxt.pn * tstepB : cB;
        for (int t = 0; t < nt; t += 2) {
            const bool last = (t == nt - 2);
            const char* a1 = cA + (size_t)(t + 1) * kstep;
            const char* a2 = last ? nA : cA + (size_t)(t + 2) * kstep; const char* b2 = last ? nB : cB + (size_t)(t + 2) * kstep;
            const char* a3 = a2 + kstep; const char* b3 = b2 + kstep;
            if (last && has_next) S.a_ready(nxt);
            if constexpr (SP2) {
            PG8_LDB(B0, 0, 0); PG8_LDB(B1, 0, 1); PG8_SCHED; PG8_LDA(At, 0, 0); PG8_STAGE(PG8_SA(1, 1), a1 + hstepA, voffA);
            PG8_WAIT_V(8); PG8_WAIT_L(0); PG8_BAR; PG8_MMA(0, 0, At, B0); PG8_MMA(0, 1, At, B1); PG8_BAR; PG8_SCHED;
            PG8_LDA(At, 0, 1); PG8_STAGE(PG8_SB(0, 0), b2, voffB); PG8_STAGE(PG8_SB(0, 1), b2 + hstepB, voffB); PG8_STAGE(PG8_SA(0, 0), a2, voffA);
            PG8_WAIT_V(8); PG8_WAIT_L(0); PG8_BAR; PG8_MMA(1, 0, At, B0); PG8_MMA(1, 1, At, B1); PG8_BAR; PG8_SCHED;
            PG8_LDB(B0, 1, 0); PG8_LDB(B1, 1, 1); PG8_SCHED; PG8_LDA(At, 1, 0); PG8_STAGE(PG8_SA(0, 1), a2 + hstepA, voffA);
            PG8_WAIT_V(8); PG8_WAIT_L(0); PG8_BAR; PG8_MMA(0, 0, At, B0); PG8_MMA(0, 1, At, B1); PG8_BAR; PG8_SCHED;
            PG8_LDA(At, 1, 1); PG8_STAGE(PG8_SB(1, 0), b3, voffB); PG8_STAGE(PG8_SB(1, 1), b3 + hstepB, voffB); PG8_STAGE(PG8_SA(1, 0), a3, voffA);
            PG8_WAIT_V(8); PG8_WAIT_L(0); PG8_BAR; PG8_MMA(1, 0, At, B0); PG8_MMA(1, 1, At, B1); PG8_BAR; PG8_SCHED;
            } else {
            PG8_LDB(B0, 0, 0); PG8_SCHED; PG8_LDA(At, 0, 0); PG8_STAGE(PG8_SA(1, 1), a1 + hstepA, voffA);
            PG8_WAIT_L(8); PG8_BAR; PG8_WAIT_L(0); PG8_MMA(0, 0, At, B0); PG8_BAR; PG8_SCHED;
            PG8_LDB(B1, 0, 1); PG8_STAGE(PG8_SB(0, 0), b2, voffB);
            PG8_BAR; PG8_WAIT_L(0); PG8_MMA(0, 1, At, B1); PG8_BAR;
            PG8_LDA(At, 0, 1); PG8_STAGE(PG8_SA(0, 0), a2, voffA);
            PG8_BAR; PG8_WAIT_L(0); PG8_MMA(1, 0, At, B0); PG8_BAR; PG8_SCHED;
            PG8_STAGE(PG8_SB(0, 1), b2 + hstepB, voffB);
            PG8_WAIT_V(6); PG8_BAR; PG8_MMA(1, 1, At, B1); PG8_BAR;
            PG8_LDB(B0, 1, 0); PG8_SCHED; PG8_LDA(At, 1, 0); PG8_STAGE(PG8_SA(0, 1), a2 + hstepA, voffA);
            PG8_WAIT_L(8); PG8_BAR; PG8_WAIT_L(0); PG8_MMA(0, 0, At, B0); PG8_BAR; PG8_SCHED;
            PG8_LDB(B1, 1, 1); PG8_STAGE(PG8_SB(1, 0), b3, voffB);
            PG8_BAR; PG8_WAIT_L(0); PG8_MMA(0, 1, At, B1); PG8_BAR;
            PG8_LDA(At, 1, 1); PG8_STAGE(PG8_SA(1, 0), a3, voffA);
            PG8_BAR; PG8_WAIT_L(0); PG8_MMA(1, 0, At, B0); PG8_BAR; PG8_SCHED;
            PG8_STAGE(PG8_SB(1, 1), b3 + hstepB, voffB);
            PG8_WAIT_V(6); PG8_BAR; PG8_MMA(1, 1, At, B1); PG8_BAR;
            }
        }
        if constexpr (ALIGN_EPI) { if (wr == 0) PG8_BAR; }
        E(acc, cur, wr, wc, fr, fq); S.done(cur);
        if (!has_next) break;
#pragma unroll
        for (int a = 0; a < 2; ++a)
#pragma unroll
            for (int b = 0; b < 2; ++b)
#pragma unroll
                for (int m = 0; m < 4; ++m)
#pragma unroll
                    for (int n = 0; n < 2; ++n) acc[a][b][m][n] = (f32x4){0.f, 0.f, 0.f, 0.f};
        cur = nxt; cA = nA; cB = nB; ++ui;
        if constexpr (ALIGN_EPI) { if (wr == 1) PG8_BAR; }
    }
    PG8_WAIT_V(0);
    if constexpr (!ALIGN_EPI) { if (wr == 0) PG8_BAR; }
    PG8_BAR;
#undef PG8_SA
#undef PG8_SB
#undef PG8_STAGE
#undef PG8_LDA
#undef PG8_LDB
#undef PG8_MMA
#undef PG8_WAIT_V
#undef PG8_WAIT_L
#undef PG8_BAR
#undef PG8_SCHED
}
}

constexpr int D = 1024, BATCH = 8, SEQ = 8192, DEPTH = 4, CTXL = 256, GRIDW = 64;
constexpr int NCTX = BATCH * CTXL;
constexpr int NLAT = BATCH * SEQ;
constexpr int R = NCTX + NLAT;
constexpr int IN_COLS = 5152, NPAD = 5376;
constexpr int PA_LD = 2048, PG_LD = 2048;
constexpr int PA_Q = 0, PA_K = 256, PA_R = 512, PA_NQ = 1024, PA_NK = 1536;
constexpr int NCHUNK = 132;
constexpr int NEXP = 16384;
constexpr float EPS = 1e-6f;
constexpr int NWAVES = 8, NT = 512;
constexpr int NPL = 11;
constexpr int NPHASE = 1 + DEPTH * NPL + 1;

constexpr size_t MiB = 1u << 20;
constexpr size_t WS_CTL = 0, CTL_ZERO_BYTES = 2 * MiB;
constexpr size_t WS_MOD = 1 * MiB;
constexpr size_t WS_ROPE = 2 * MiB;
constexpr size_t WS_WIN = 3 * MiB;
constexpr size_t WS_WPG = 45 * MiB, WS_WPN = 49 * MiB;
constexpr size_t WS_WO = 53 * MiB;
constexpr size_t WS_WS = 61 * MiB;
constexpr size_t WS_XC = 77 * MiB;
constexpr size_t WS_Z = 85 * MiB;
constexpr size_t WS_EU = 94 * MiB, WS_EV = 126 * MiB;
constexpr size_t WS_H = 158 * MiB;
constexpr size_t WS_PA = 290 * MiB;
constexpr size_t WS_VT = 554 * MiB, WS_NVT = 620 * MiB;
constexpr size_t WS_DEC = 950 * MiB;
constexpr size_t WS_PG = 686 * MiB;
constexpr size_t WS_SC = 290 * MiB;
constexpr size_t WS_EI = 818 * MiB, WS_EG = 851 * MiB;
constexpr size_t WS_END = 953 * MiB;
static_assert(WS_SC + (size_t)R * 2048 * 4 <= WS_EI && WS_EG + (size_t)R * 128 * 4 <= WS_DEC && WS_PG + (size_t)R * PG_LD * 2 <= WS_DEC && WS_DEC + 64 * 132 * 64 * 4 <= WS_END, "ws map");
static_assert(WS_H + (size_t)R * 1024 * 2 <= WS_PA && WS_PA + (size_t)R * PA_LD * 2 <= WS_VT && WS_VT + (size_t)R * 512 * 2 <= WS_NVT && WS_NVT + (size_t)R * 512 * 2 <= WS_PG && WS_Z + (size_t)R * 32 * 4 <= WS_EU, "ws map");
constexpr int CW_BAR = 4096;

constexpr int RING_BYTES = 131072, LDSCTL_OFF = RING_BYTES, MISC_OFF = LDSCTL_OFF + 320, LDS_BYTES = 147456;

#define GAS __attribute__((address_space(1)))
#define LAS __attribute__((address_space(3)))
typedef unsigned short bf16;
typedef unsigned v4u __attribute__((ext_vector_type(4)));
typedef unsigned v2u __attribute__((ext_vector_type(2)));
typedef int v4i __attribute__((ext_vector_type(4)));
typedef float f32x4 __attribute__((ext_vector_type(4)));
typedef __bf16 bf16x2_t __attribute__((ext_vector_type(2)));
#define LDS_WAIT() asm volatile("s_waitcnt lgkmcnt(0)" ::: "memory")
#define VM_WAIT() asm volatile("s_waitcnt vmcnt(0)" ::: "memory")
__device__ __forceinline__ unsigned f2bf(float f) { unsigned u = __builtin_bit_cast(unsigned, f); return (u + 0x7fffu + ((u >> 16) & 1u)) >> 16; }
__device__ __forceinline__ unsigned pk2(float lo, float hi) { return f2bf(lo) | (f2bf(hi) << 16); }
__device__ __forceinline__ float bflo(unsigned w) { return __builtin_bit_cast(float, w << 16); }
__device__ __forceinline__ float bfhi(unsigned w) { return __builtin_bit_cast(float, w & 0xffff0000u); }
__device__ __forceinline__ float bf1(bf16 h) { return __builtin_bit_cast(float, ((unsigned)h) << 16); }
__device__ __forceinline__ float dot2(unsigned a, unsigned b, float acc) { return __builtin_amdgcn_fdot2_f32_bf16(__builtin_bit_cast(bf16x2_t, a), __builtin_bit_cast(bf16x2_t, b), acc, false); }
__device__ __forceinline__ float wave_sum(float v) {
#pragma unroll
    for (int o = 1; o < 64; o <<= 1) v += __shfl_xor(v, o);
    return v;
}
__device__ __forceinline__ float wave_max(float v) {
#pragma unroll
    for (int o = 1; o < 64; o <<= 1) v = fmaxf(v, __shfl_xor(v, o));
    return v;
}
__device__ __forceinline__ float sigmoidf_(float x) { return 1.f / (1.f + __expf(-x)); }

#define XB_TMO      128
#define XB_XCNT(j)  (256  + 64 * (j))
#define XB_XSUB(j)  (1280 + 64 * (j))
#define XB_XGEN(j)  (2304 + 64 * (j))
#define XB_TOP      3328
#define XB_TOPGEN   3392
#define XCD_BAR_WORDS 3456
#define XB_SPIN_CAP (1u << 18)
__device__ __forceinline__ unsigned xb_ld(unsigned* p)              { return __hip_atomic_load(p, __ATOMIC_RELAXED, __HIP_MEMORY_SCOPE_AGENT); }
__device__ __forceinline__ unsigned xb_add(unsigned* p, unsigned v) { return __hip_atomic_fetch_add(p, v, __ATOMIC_RELAXED, __HIP_MEMORY_SCOPE_AGENT); }
__device__ __forceinline__ unsigned xb_xcc_id() { return (unsigned)__builtin_amdgcn_s_getreg((3 << 11) | 20) & 0xFu; }
#define XB_SPIN(cond, bar) do { unsigned _sp = 0; while (cond) { __builtin_amdgcn_s_sleep(1); \
    if ((++_sp & 255u) == 0u) { if (xb_ld(&(bar)[XB_TMO])) break; if (_sp > XB_SPIN_CAP) { atomicAdd(&(bar)[XB_TMO], 1u); break; } } } } while (0)
struct XcdBarrier { unsigned* bar; unsigned x; volatile LAS unsigned* st; };
__device__ __forceinline__ XcdBarrier xcd_barrier_post(unsigned* bar, volatile LAS unsigned* st) {
    XcdBarrier b; b.bar = bar; b.x = xb_xcc_id(); b.st = st;
    if (threadIdx.x == 0) (void)xb_add(&bar[XB_XCNT(b.x)], 1u);
    return b;
}
__device__ __forceinline__ void xcd_barrier_complete(unsigned* bar, unsigned x, unsigned& nloc, unsigned& nx) {
    const unsigned G = gridDim.x * gridDim.y * gridDim.z;
    unsigned sum, cnt, mine, sp = 0u;
    for (;;) {
        sum = 0u; cnt = 0u; mine = 0u;
#pragma unroll
        for (unsigned j = 0; j < 16; ++j) { const unsigned c = xb_ld(&bar[XB_XCNT(j)]); sum += c; cnt += (c > 0u) ? 1u : 0u; mine = (j == x) ? c : mine; }
        if (sum == G) break;
        __builtin_amdgcn_s_sleep(1);
        if ((++sp & 255u) == 0u) { if (xb_ld(&bar[XB_TMO])) break; if (sp > XB_SPIN_CAP) { atomicAdd(&bar[XB_TMO], 1u); break; } }
    }
    nloc = mine > 0u ? mine : 1u; nx = cnt > 0u ? cnt : 1u;
}
__device__ __forceinline__ void xcd_barrier(const XcdBarrier& b) {
    asm volatile("s_waitcnt vmcnt(0)" ::: "memory");
    __syncthreads();
    if (threadIdx.x == 0) {
        unsigned* bar = b.bar;
        __builtin_amdgcn_s_waitcnt(0);
        unsigned nloc = b.st[0], nx = b.st[1];
        if (nloc == 0u) { xcd_barrier_complete(bar, b.x, nloc, nx); b.st[0] = nloc; b.st[1] = nx; }
        const unsigned old = xb_add(&bar[XB_XSUB(b.x)], 1u);
        const unsigned gen = old / nloc;
        if (old + 1u == (gen + 1u) * nloc) {
            __builtin_amdgcn_fence(__ATOMIC_RELEASE, "agent");
            asm volatile("s_waitcnt vmcnt(0)" ::: "memory");
            const unsigned og = xb_add(&bar[XB_TOP], 1u);
            const unsigned tg = og / nx;
            if (og + 1u == (tg + 1u) * nx) xb_add(&bar[XB_TOPGEN], 1u);
            else XB_SPIN(xb_ld(&bar[XB_TOPGEN]) == tg, bar);
            __builtin_amdgcn_fence(__ATOMIC_ACQUIRE, "agent");
            xb_add(&bar[XB_XGEN(b.x)], 1u);
            asm volatile("s_waitcnt vmcnt(0)" ::: "memory");
        } else {
            XB_SPIN(xb_ld(&bar[XB_XGEN(b.x)]) == gen, bar);
            __builtin_amdgcn_fence(__ATOMIC_ACQUIRE, "agent");
            asm volatile("s_waitcnt vmcnt(0)" ::: "memory");
        }
    }
    __syncthreads();
}

struct Args { const float* in[23]; float* out; unsigned char* ws; int ph_lo, ph_hi, li, pad; };
enum { I_X = 0, I_C, I_CTX, I_CCTX, I_WMOD, I_BMOD, I_GN1, I_WIN, I_WAF, I_BAF, I_WAB, I_BAB, I_GGLA, I_RPB, I_WPG, I_WPN, I_WO, I_GN2, I_WQ, I_SK, I_EU, I_EV, I_GF };

struct Frame {
    LAS unsigned char* lds;
    int tid, lane, wave, vcu, G;
};
typedef const __attribute__((address_space(4))) Args* CArgsP;
__device__ __forceinline__ CArgsP kargs() { CArgsP p = (CArgsP)__builtin_amdgcn_kernarg_segment_ptr(); asm volatile("" : "+s"(p)); return p; }
__device__ __forceinline__ const float* xrow_in(CArgsP a, int r) { return r < NCTX ? a->in[I_CTX] + (size_t)r * D : a->in[I_X] + (size_t)(r - NCTX) * D; }
__device__ __forceinline__ float* xrow_cur(CArgsP a, int r) { return r < NCTX ? (float*)(a->ws + WS_XC) + (size_t)r * D : a->out + (size_t)(r - NCTX) * D; }
__device__ __forceinline__ int row_slot(int r) { return r < NCTX ? 8 : ((r - NCTX) >> 13); }

using pg8::f32x4; using pg8::u32x4; using pg8::Unit; using pg8::cvt_pk_bf16;
struct EpiIn {
    static constexpr bool PERM = true;
    bf16* PA; bf16* PG; float* Z; const float* rope; bf16* VT; bf16* NVT;
    __device__ __forceinline__ void operator()(const f32x4 (&acc)[2][2][4][2], const Unit& u, int wr, int wc, int fr, int fq) const {
        const int pn = u.pn, row0 = u.pm * 256 + wr * 64 + fr;
        if (pn == 20) {
            if (wc == 0) {
#pragma unroll
                for (int ai = 0; ai < 2; ++ai)
#pragma unroll
                    for (int m = 0; m < 4; ++m) { float* zp = Z + (size_t)(row0 + ai * 128 + m * 16) * 32 + 8 * fq; *(f32x4*)zp = acc[ai][0][m][0]; *(f32x4*)(zp + 4) = acc[ai][0][m][1]; }
            }
            return;
        }
        if (pn >= 8 && pn < 12) {
            bf16* T = (pn < 10 ? VT : NVT) + (size_t)(((pn - 8) & 1) * 256 + wc * 32 + 8 * fq) * R;
#pragma unroll
            for (int ai = 0; ai < 2; ++ai)
#pragma unroll
                for (int m = 0; m < 4; ++m) {
                    const int row = row0 + ai * 128 + m * 16;
#pragma unroll
                    for (int bj = 0; bj < 2; ++bj) {
                        const f32x4 v0 = acc[ai][bj][m][0], v1 = acc[ai][bj][m][1];
                        bf16* tp = T + (size_t)(bj * 128) * R + row;
                        tp[0 * (size_t)R] = (bf16)f2bf(v0[0]); tp[1 * (size_t)R] = (bf16)f2bf(v0[1]); tp[2 * (size_t)R] = (bf16)f2bf(v0[2]); tp[3 * (size_t)R] = (bf16)f2bf(v0[3]);
                        tp[4 * (size_t)R] = (bf16)f2bf(v1[0]); tp[5 * (size_t)R] = (bf16)f2bf(v1[1]); tp[6 * (size_t)R] = (bf16)f2bf(v1[2]); tp[7 * (size_t)R] = (bf16)f2bf(v1[3]);
                    }
                }
            return;
        }
        bf16* base; int ldc, colt;
        if (pn < 8) { base = PA; ldc = PA_LD; colt = pn * 256; } else { base = PG; ldc = PG_LD; colt = (pn - 12) * 256; }
        const int col0 = colt + wc * 32 + 8 * fq;
        const bool do_rope = (pn < 2) && (u.pm >= 8);
        const float sc = (pn == 0 || pn == 4 || pn == 5) ? 0.125f : 1.f;
#pragma unroll
        for (int ai = 0; ai < 2; ++ai)
#pragma unroll
            for (int m = 0; m < 4; ++m) {
                const int row = row0 + ai * 128 + m * 16;
                bf16* rowp = base + (size_t)row * ldc + col0;
                f32x4 cs[4];
                if (do_rope) { const int t = (row - NCTX) & (SEQ - 1); const int pos = (wc & 1) ? (t & 63) : (t >> 6);
                    const f32x4* cp = (const f32x4*)(rope + (size_t)(pos * 16 + 8 * (fq & 1)) * 2);
                    cs[0] = cp[0]; cs[1] = cp[1]; cs[2] = cp[2]; cs[3] = cp[3]; }
#pragma unroll
                for (int bj = 0; bj < 2; ++bj) {
                    f32x4 v0 = acc[ai][bj][m][0], v1 = acc[ai][bj][m][1];
                    if (do_rope) {
                        float x[8] = {v0[0], v0[1], v0[2], v0[3], v1[0], v1[1], v1[2], v1[3]};
#pragma unroll
                        for (int e = 0; e < 8; ++e) { const float p = __shfl_xor(x[e], 32); const float c = cs[e >> 1][(e & 1) * 2], s = cs[e >> 1][(e & 1) * 2 + 1];
                            x[e] = (fq < 2) ? (x[e] * c - p * s) : (p * s + x[e] * c); }
                        v0 = (f32x4){x[0], x[1], x[2], x[3]}; v1 = (f32x4){x[4], x[5], x[6], x[7]};
                    }
                    v0 = v0 * sc; v1 = v1 * sc;
                    u32x4 w; w.x = cvt_pk_bf16(v0[0], v0[1]); w.y = cvt_pk_bf16(v0[2], v0[3]); w.z = cvt_pk_bf16(v1[0], v1[1]); w.w = cvt_pk_bf16(v1[2], v1[3]);
                    *(u32x4*)(rowp + bj * 128) = w;
                }
                asm volatile("" ::: "memory");
            }
    }
};
template <int SECOND> struct EpiMerge {
    static constexpr bool PERM = true;
    bf16* MG; const bf16* PG;
    __device__ __forceinline__ void operator()(const f32x4 (&acc)[2][2][4][2], const Unit& u, int wr, int wc, int fr, int fq) const {
        const int row0 = u.pm * 256 + wr * 64 + fr, col0 = u.pn * 256 + wc * 32 + 8 * fq;
#pragma unroll
        for (int ai = 0; ai < 2; ++ai)
#pragma unroll
            for (int m = 0; m < 4; ++m) {
                const int row = row0 + ai * 128 + m * 16;
#pragma unroll
                for (int bj = 0; bj < 2; ++bj) {
                    const int c = col0 + bj * 128;
                    const u32x4 g = *(const u32x4*)(PG + (size_t)row * PG_LD + SECOND * 1024 + c);
                    const f32x4 v0 = acc[ai][bj][m][0], v1 = acc[ai][bj][m][1];
                    float o[8];
                    o[0] = sigmoidf_(bflo(g.x)) * v0[0]; o[1] = sigmoidf_(bfhi(g.x)) * v0[1]; o[2] = sigmoidf_(bflo(g.y)) * v0[2]; o[3] = sigmoidf_(bfhi(g.y)) * v0[3];
                    o[4] = sigmoidf_(bflo(g.z)) * v1[0]; o[5] = sigmoidf_(bfhi(g.z)) * v1[1]; o[6] = sigmoidf_(bflo(g.w)) * v1[2]; o[7] = sigmoidf_(bfhi(g.w)) * v1[3];
                    bf16* mp = MG + (size_t)row * D + c;
                    if (SECOND) { const u32x4 old = *(const u32x4*)mp;
                        o[0] += bflo(old.x); o[1] += bfhi(old.x); o[2] += bflo(old.y); o[3] += bfhi(old.y); o[4] += bflo(old.z); o[5] += bfhi(old.z); o[6] += bflo(old.w); o[7] += bfhi(old.w); }
                    u32x4 w; w.x = cvt_pk_bf16(o[0], o[1]); w.y = cvt_pk_bf16(o[2], o[3]); w.z = cvt_pk_bf16(o[4], o[5]); w.w = cvt_pk_bf16(o[6], o[7]);
                    *(u32x4*)mp = w;
                }
                asm volatile("" ::: "memory");
            }
    }
};
struct EpiRes {
    static constexpr bool PERM = false;
    const float* src_c; const float* src_l; float* dst_c; float* dst_l; const float* mod;
    __device__ __forceinline__ void operator()(const f32x4 (&acc)[2][2][4][2], const Unit& u, int wr, int wc, int fr, int fq) const {
        const bool isctx = u.pm < 8;
        const int slot = isctx ? 8 : ((u.pm - 8) >> 5);
        const float* src = isctx ? src_c : src_l;
        float* dst = isctx ? dst_c : dst_l;
        const int rbase = (isctx ? u.pm * 256 : (u.pm - 8) * 256) + wr * 64 + fr;
        const int col0 = u.pn * 256 + wc * 32 + 4 * fq;
        const float* ga = mod + slot * 6144 + 2048;
        f32x4 gv[2][2];
#pragma unroll
        for (int bj = 0; bj < 2; ++bj)
#pragma unroll
            for (int n = 0; n < 2; ++n) gv[bj][n] = *(const f32x4*)(ga + col0 + bj * 128 + n * 16);
#pragma unroll
        for (int ai = 0; ai < 2; ++ai)
#pragma unroll
            for (int m = 0; m < 4; ++m) {
                const size_t off = (size_t)(rbase + ai * 128 + m * 16) * D + col0;
#pragma unroll
                for (int bj = 0; bj < 2; ++bj)
#pragma unroll
                    for (int n = 0; n < 2; ++n) { const f32x4 x = *(const f32x4*)(src + off + bj * 128 + n * 16); *(f32x4*)(dst + off + bj * 128 + n * 16) = x + gv[bj][n] * acc[ai][bj][m][n]; }
                asm volatile("" ::: "memory");
            }
    }
};
struct EpiF32 {
    static constexpr bool PERM = false;
    float* C; int ldc;
    __device__ __forceinline__ void operator()(const f32x4 (&acc)[2][2][4][2], const Unit& u, int wr, int wc, int fr, int fq) const {
        const int row0 = u.pm * 256 + wr * 64 + fr, col0 = u.pn * 256 + wc * 32 + 4 * fq;
#pragma unroll
        for (int ai = 0; ai < 2; ++ai)
#pragma unroll
            for (int m = 0; m < 4; ++m) { float* rowp = C + (size_t)(row0 + ai * 128 + m * 16) * ldc + col0;
#pragma unroll
                for (int bj = 0; bj < 2; ++bj)
#pragma unroll
                    for (int n = 0; n < 2; ++n) *(f32x4*)(rowp + bj * 128 + n * 16) = acc[ai][bj][m][n]; }
    }
};

__device__ __forceinline__ void p0_transpose_item(const float* W, int K, int N, bf16* WT, int dst_row0, LAS float* scr, int k0, int n0, int lane) {
#pragma unroll 8
    for (int i = 0; i < 32; ++i) { const int kk = 2 * i + (lane >> 5); scr[kk * 33 + (lane & 31)] = W[(size_t)(k0 + kk) * N + n0 + (lane & 31)]; }
    LDS_WAIT(); asm volatile("" ::: "memory");
    const int c = lane & 7;
#pragma unroll
    for (int j = 0; j < 4; ++j) { const int n = (lane >> 3) + 8 * j; const LAS float* s = scr + (8 * c) * 33 + n;
        v4u o; o.x = pk2(s[0 * 33], s[1 * 33]); o.y = pk2(s[2 * 33], s[3 * 33]); o.z = pk2(s[4 * 33], s[5 * 33]); o.w = pk2(s[6 * 33], s[7 * 33]);
        *(v4u*)(WT + (size_t)(dst_row0 + n) * K + k0 + 8 * c) = o; }
    LDS_WAIT(); asm volatile("" ::: "memory");
}
__device__ __forceinline__ int win_map(int n0) {
    if (n0 < 512) return n0;
    if (n0 < 1024) return 2048 + (n0 - 512);
    if (n0 < 1056) return 5120 + (n0 - 1024);
    if (n0 < 1568) return 512 + (n0 - 1056);
    if (n0 < 2080) return 1024 + (n0 - 1568);
    if (n0 < 2592) return 1536 + (n0 - 2080);
    if (n0 < 3104) return 2560 + (n0 - 2592);
    return 3072 + (n0 - 3104);
}

__device__ __forceinline__ void p0_prologue(const Frame& F) {
    CArgsP a = kargs(); unsigned char* const ws = a->ws;
    const int gw = F.vcu * NWAVES + F.wave, NGW = F.G * NWAVES;
    const int gtid = F.vcu * NT + F.tid, GT = F.G * NT;
    {
        LAS float* scr = (LAS float*)(F.lds + F.wave * 16384);
        constexpr int I_IN = 16 * 161, I_P = 8 * 32, I_O = 16 * 32, PER_L = I_IN + 2 * I_P + I_O;
        for (int it = gw; it < DEPTH * PER_L; it += NGW) {
            const int l = it / PER_L; int r = it % PER_L;
            if (r < I_IN) { const int kb = r / 161, nb = r % 161; p0_transpose_item(a->in[I_WIN] + (size_t)l * D * IN_COLS, D, IN_COLS, (bf16*)(ws + WS_WIN) + (size_t)l * NPAD * D, win_map(nb * 32), scr, kb * 64, nb * 32, F.lane); continue; }
            r -= I_IN;
            if (r < I_P) { const int kb = r / 32, nb = r % 32; p0_transpose_item(a->in[I_WPG] + (size_t)l * 512 * D, 512, D, (bf16*)(ws + WS_WPG) + (size_t)l * D * 512, nb * 32, scr, kb * 64, nb * 32, F.lane); continue; }
            r -= I_P;
            if (r < I_P) { const int kb = r / 32, nb = r % 32; p0_transpose_item(a->in[I_WPN] + (size_t)l * 512 * D, 512, D, (bf16*)(ws + WS_WPN) + (size_t)l * D * 512, nb * 32, scr, kb * 64, nb * 32, F.lane); continue; }
            r -= I_P;
            { const int kb = r / 32, nb = r % 32; p0_transpose_item(a->in[I_WO] + (size_t)l * D * D, D, D, (bf16*)(ws + WS_WO) + (size_t)l * D * D, nb * 32, scr, kb * 64, nb * 32, F.lane); }
        }
        constexpr int PADV = (NPAD - IN_COLS) * D / 8;
        for (int i = gtid; i < DEPTH * PADV; i += GT) { const int l = i / PADV, j = i % PADV; *((v4u*)((bf16*)(ws + WS_WIN) + ((size_t)l * NPAD + IN_COLS) * D) + j) = (v4u){0u, 0u, 0u, 0u}; }
    }
    __syncthreads();
    if (gtid < 128 * 16) { const int pos = gtid >> 4, j = gtid & 15; const float freq = powf(10000.f, -(float)j / 16.f); const float ang = (float)pos * freq;
        float* cs = (float*)(ws + WS_ROPE); cs[2 * gtid] = cosf(ang); cs[2 * gtid + 1] = sinf(ang); }
    {
        LAS float* LSK = (LAS float*)F.lds;
        LAS float* LQ = (LAS float*)(F.lds + 128 * 132 * 4);
        for (int unit = F.vcu; unit < DEPTH * 16 * 16; unit += F.G) {
            const int l = unit >> 8, hp = (unit >> 4) & 15, d0 = (unit & 15) * 64;
            const float* sk = a->in[I_SK] + ((size_t)l * 16 + hp) * 16384;
            const float* wq = a->in[I_WQ] + (size_t)l * D * 2048 + hp * 128;
            __syncthreads();
            for (int i = F.tid; i < 16384; i += NT) LSK[(i >> 7) * 132 + (i & 127)] = sk[i];
            for (int i = F.tid; i < 8192; i += NT) LQ[(i >> 7) * 132 + (i & 127)] = wq[(size_t)(d0 + (i >> 7)) * 2048 + (i & 127)];
            __syncthreads();
            const int dd = F.tid & 63, kg = F.tid >> 6;
            float acc[16];
#pragma unroll
            for (int k = 0; k < 16; ++k) acc[k] = 0.f;
            for (int j = 0; j < 128; j += 4) {
                const f32x4 q = *(const LAS f32x4*)(LQ + dd * 132 + j);
#pragma unroll
                for (int k = 0; k < 16; ++k) { const f32x4 s = *(const LAS f32x4*)(LSK + (kg * 16 + k) * 132 + j); acc[k] += q[0] * s[0] + q[1] * s[1] + q[2] * s[2] + q[3] * s[3]; }
            }
            bf16* o = (bf16*)(ws + WS_WS) + ((size_t)l * 2048 + hp * 128 + kg * 16) * D + d0 + dd;
#pragma unroll
            for (int k = 0; k < 16; ++k) o[(size_t)k * D] = (bf16)f2bf(acc[k]);
        }
    }
    __syncthreads();
    {
        LAS float* ca = (LAS float*)F.lds;
        LAS float* red = (LAS float*)(F.lds + 9 * D * 4);
        for (int i = F.tid; i < 9 * D; i += NT) { const float v = i < 8 * D ? a->in[I_C][i] : a->in[I_CCTX][i - 8 * D]; ca[i] = v / (1.f + __expf(-v)); }
        __syncthreads();
        float* MOD = (float*)(ws + WS_MOD);
        for (int unit = F.vcu; unit < DEPTH * 96; unit += F.G) {
            const int l = unit / 96, cb = unit % 96, dc = F.tid >> 6;
            const int col = cb * 64 + (F.tid & 63);
            const float* w = a->in[I_WMOD] + ((size_t)l * D + dc * 128) * 6144 + col;
            float acc[9];
#pragma unroll
            for (int b = 0; b < 9; ++b) acc[b] = 0.f;
#pragma unroll 8
            for (int d = 0; d < 128; ++d) { const float wv = w[(size_t)d * 6144];
#pragma unroll
                for (int b = 0; b < 9; ++b) acc[b] += ca[b * D + dc * 128 + d] * wv; }
#pragma unroll
            for (int b = 0; b < 9; ++b) red[(dc * 9 + b) * 64 + (F.tid & 63)] = acc[b];
            __syncthreads();
            for (int i = F.tid; i < 9 * 64; i += NT) { const int b = i >> 6, c = i & 63; float sum = a->in[I_BMOD][l * 6144 + cb * 64 + c];
#pragma unroll
                for (int k = 0; k < 8; ++k) sum += red[(k * 9 + b) * 64 + c];
                MOD[((size_t)l * 9 + b) * 6144 + cb * 64 + c] = sum; }
            __syncthreads();
        }
    }
    __syncthreads();
}

__device__ __forceinline__ void convert_experts(const Frame& F, int layer) {
    CArgsP a = kargs(); unsigned char* const ws = a->ws;
    const int gtid = F.vcu * NT + F.tid, GT = F.G * NT;
    const f32x4* su = (const f32x4*)(a->in[I_EU] + (size_t)layer * NEXP * D);
    const f32x4* sv = (const f32x4*)(a->in[I_EV] + (size_t)layer * NEXP * D);
    v4u* du = (v4u*)(ws + WS_EU); v4u* dv = (v4u*)(ws + WS_EV);
    constexpr int NV = NEXP * D / 8;
    for (int i = gtid; i < NV; i += GT) {
        const f32x4 a0 = su[2 * i], a1 = su[2 * i + 1], b0 = sv[2 * i], b1 = sv[2 * i + 1];
        du[i] = (v4u){pk2(a0[0], a0[1]), pk2(a0[2], a0[3]), pk2(a1[0], a1[1]), pk2(a1[2], a1[3])};
        dv[i] = (v4u){pk2(b0[0], b0[1]), pk2(b0[2], b0[3]), pk2(b1[0], b1[1]), pk2(b1[2], b1[3])};
    }
}

__device__ __forceinline__ void norm_phase(const Frame& F, int layer, int which) {
    CArgsP a = kargs(); unsigned char* const ws = a->ws;
    const int gw = F.vcu * NWAVES + F.wave, NGW = F.G * NWAVES;
    const float* g = (which ? a->in[I_GN2] : a->in[I_GN1]) + layer * D;
    const float* MOD = (const float*)(ws + WS_MOD) + (size_t)layer * 9 * 6144 + (which ? 3072 : 0);
    bf16* H = (bf16*)(ws + WS_H);
    f32x4 gv[4];
#pragma unroll
    for (int j = 0; j < 4; ++j) gv[j] = *((const f32x4*)g + F.lane + 64 * j);
    for (int r = gw; r < R; r += NGW) {
        const float* xr = (which == 0 && layer == 0) ? xrow_in(a, r) : xrow_cur(a, r);
        const float* sh = MOD + row_slot(r) * 6144; const float* sc = sh + D;
        f32x4 v[4]; float ss = 0.f;
#pragma unroll
        for (int j = 0; j < 4; ++j) { v[j] = *((const GAS f32x4*)xr + F.lane + 64 * j); ss += (v[j][0] * v[j][0] + v[j][1] * v[j][1]) + (v[j][2] * v[j][2] + v[j][3] * v[j][3]); }
        const float rs = rsqrtf(wave_sum(ss) * (1.f / D) + EPS);
        unsigned long long* o8 = (unsigned long long*)(H + (size_t)r * D) + F.lane;
#pragma unroll
        for (int j = 0; j < 4; ++j) {
            const f32x4 s1 = *((const f32x4*)sc + F.lane + 64 * j), s0 = *((const f32x4*)sh + F.lane + 64 * j);
            const f32x4 y = v[j] * rs * gv[j] * (s1 + 1.f) + s0;
            o8[64 * j] = (unsigned long long)pk2(y[0], y[1]) | ((unsigned long long)pk2(y[2], y[3]) << 32);
        }
    }
}

constexpr int GL_TOT = 0, GL_IMG = 4096, GL_PITCH = 144, GL_IMGB = 64 * GL_PITCH, GL_SSX = GL_IMG + 4 * GL_IMGB;
typedef short bf16x8_t __attribute__((ext_vector_type(8)));
__device__ __forceinline__ int chunk_row0(int b, int tc) { return tc < 4 ? b * CTXL + tc * 64 : NCTX + b * SEQ + (tc - 4) * 64; }
__device__ __forceinline__ int chunk_pos(int tc, int dir) { return dir == 0 ? tc : (tc < 4 ? 3 - tc : 135 - tc); }
__device__ __forceinline__ float logsig16(float x) { return (fminf(x, 0.f) - log1pf(__expf(-fabsf(x)))) * (1.f / 16.f); }
__device__ __forceinline__ void gla_scan(const Frame& F, CArgsP a, const float* Z, int layer, int h, int row0, int lz, float (&Bf)[8], float (&Bb)[8], float& endf, float& endb) {
    const float* waf = a->in[I_WAF] + layer * 4096 + h * 64 + F.lane; const float* wab = a->in[I_WAB] + layer * 4096 + h * 64 + F.lane;
    float wf[16], wb[16];
#pragma unroll
    for (int j = 0; j < 16; ++j) { wf[j] = waf[j * 256]; wb[j] = wab[j * 256]; }
    const float baf = a->in[I_BAF][layer * 256 + h * 64 + F.lane], bab = a->in[I_BAB][layer * 256 + h * 64 + F.lane];
    const int t0 = 8 * F.wave;
#pragma unroll
    for (int i = 0; i < 8; ++i) {
        const f32x4* zp = (const f32x4*)(Z + (size_t)(row0 + t0 + i) * 32 + lz);
        float zf = baf, zb = bab;
#pragma unroll
        for (int q = 0; q < 4; ++q) { const f32x4 z0 = zp[q], z1 = zp[4 + q];
            zf += z0[0] * wf[4 * q] + z0[1] * wf[4 * q + 1] + z0[2] * wf[4 * q + 2] + z0[3] * wf[4 * q + 3];
            zb += z1[0] * wb[4 * q] + z1[1] * wb[4 * q + 1] + z1[2] * wb[4 * q + 2] + z1[3] * wb[4 * q + 3]; }
        Bf[i] = logsig16(zf); Bb[i] = logsig16(zb);
    }
#pragma unroll
    for (int i = 1; i < 8; ++i) Bf[i] += Bf[i - 1];
#pragma unroll
    for (int i = 6; i >= 0; --i) Bb[i] += Bb[i + 1];
    LAS float* TOT = (LAS float*)(F.lds + GL_TOT);
    TOT[(0 * 8 + F.wave) * 64 + F.lane] = Bf[7]; TOT[(1 * 8 + F.wave) * 64 + F.lane] = Bb[0];
    __syncthreads();
    float offf = 0.f, offb = 0.f; endf = 0.f; endb = 0.f;
#pragma unroll
    for (int w = 0; w < 8; ++w) { const float tf = TOT[(0 * 8 + w) * 64 + F.lane], tb = TOT[(1 * 8 + w) * 64 + F.lane]; endf += tf; endb += tb; offf += (w < F.wave) ? tf : 0.f; offb += (w > F.wave) ? tb : 0.f; }
#pragma unroll
    for (int i = 0; i < 8; ++i) { Bf[i] += offf; Bb[i] += offb; }
}
__device__ __forceinline__ void gla_a_phase(const Frame& F, int layer) {
    CArgsP a = kargs(); unsigned char* const ws = a->ws;
    const bf16* PA = (const bf16*)(ws + WS_PA); const bf16* VT = (const bf16*)(ws + WS_VT);
    const float* Z = (const float*)(ws + WS_Z); bf16* SST = (bf16*)(ws + WS_H); float* DEC = (float*)(ws + WS_DEC);
    int lz = 0; asm volatile("" : "+v"(lz));
    const int lane = F.lane, l16 = lane & 15, g = lane >> 4, t0 = 8 * F.wave;
    for (int unit = F.vcu; unit < BATCH * 4 * NCHUNK; unit += F.G) {
        const int b = unit / (4 * NCHUNK), h = (unit / NCHUNK) & 3, tc = unit % NCHUNK, row0 = chunk_row0(b, tc);
        float Bf[8], Bb[8], endf, endb;
        gla_scan(F, a, Z, layer, h, row0, lz, Bf, Bb, endf, endb);
        float kk[8];
#pragma unroll
        for (int i = 0; i < 8; ++i) kk[i] = bf1(PA[(size_t)(row0 + t0 + i) * PA_LD + PA_K + h * 64 + lane]);
        float kf[8], kb[8];
#pragma unroll
        for (int i = 0; i < 8; ++i) { kf[i] = kk[i] * __expf(endf - Bf[i]); kb[i] = kk[i] * __expf(endb - Bb[i]); }
        *(LAS v4u*)(F.lds + GL_IMG + 0 * GL_IMGB + lane * GL_PITCH + t0 * 2) = (v4u){pk2(kf[0], kf[1]), pk2(kf[2], kf[3]), pk2(kf[4], kf[5]), pk2(kf[6], kf[7])};
        *(LAS v4u*)(F.lds + GL_IMG + 1 * GL_IMGB + lane * GL_PITCH + t0 * 2) = (v4u){pk2(kb[0], kb[1]), pk2(kb[2], kb[3]), pk2(kb[4], kb[5]), pk2(kb[6], kb[7])};
        const int seq0 = (b * 4 + h) * 2;
        if (F.wave == 0) { DEC[((size_t)(seq0 + 0) * NCHUNK + chunk_pos(tc, 0)) * 64 + lane] = __expf(endf); DEC[((size_t)(seq0 + 1) * NCHUNK + chunk_pos(tc, 1)) * 64 + lane] = __expf(endb); }
        __syncthreads();
        const int dir = F.wave >> 2, ntp = F.wave & 3;
        const LAS unsigned char* img = F.lds + GL_IMG + dir * GL_IMGB;
        bf16x8_t afr[4][2];
#pragma unroll
        for (int mt = 0; mt < 4; ++mt)
#pragma unroll
            for (int kt = 0; kt < 2; ++kt) afr[mt][kt] = *(const LAS bf16x8_t*)(img + (16 * mt + l16) * GL_PITCH + (32 * kt + 8 * g) * 2);
        bf16* slot = SST + ((size_t)(seq0 + dir) * NCHUNK + chunk_pos(tc, dir)) * 8192;
#pragma unroll
        for (int n2 = 0; n2 < 2; ++n2) {
            const int nt = 2 * ntp + n2;
            const bf16* vp = VT + (size_t)(h * 128 + 16 * nt + l16) * R + row0 + 8 * g;
            const bf16x8_t b0 = *(const bf16x8_t*)vp, b1 = *(const bf16x8_t*)(vp + 32);
#pragma unroll
            for (int mt = 0; mt < 4; ++mt) {
                f32x4 acc = (f32x4){0.f, 0.f, 0.f, 0.f};
                acc = __builtin_amdgcn_mfma_f32_16x16x32_bf16(afr[mt][0], b0, acc, 0, 0, 0);
                acc = __builtin_amdgcn_mfma_f32_16x16x32_bf16(afr[mt][1], b1, acc, 0, 0, 0);
                *(v2u*)(slot + (16 * nt + l16) * 64 + 16 * mt + 4 * g) = (v2u){pk2(acc[0], acc[1]), pk2(acc[2], acc[3])};
            }
        }
        __syncthreads();
    }
}
__device__ __forceinline__ void gla_b_phase(const Frame& F) {
    CArgsP a = kargs(); unsigned char* const ws = a->ws;
    bf16* SST = (bf16*)(ws + WS_H); const float* DEC = (const float*)(ws + WS_DEC);
    const int gtid = F.vcu * NT + F.tid, GT = F.G * NT;
    for (int id = gtid; id < 64 * 2048; id += GT) {
        const int seq = id >> 11, e = (id & 2047) * 4, k4 = e & 63;
        float s0 = 0.f, s1 = 0.f, s2 = 0.f, s3 = 0.f;
        bf16* p = SST + (size_t)seq * NCHUNK * 8192 + e; const float* dp = DEC + (size_t)seq * NCHUNK * 64 + k4;
#pragma unroll 4
        for (int c = 0; c < NCHUNK; ++c) {
            const v2u t = *(const v2u*)(p + (size_t)c * 8192); const f32x4 d = *(const f32x4*)(dp + c * 64);
            *(v2u*)(p + (size_t)c * 8192) = (v2u){pk2(s0, s1), pk2(s2, s3)};
            s0 = d[0] * s0 + bflo(t.x); s1 = d[1] * s1 + bfhi(t.x); s2 = d[2] * s2 + bflo(t.y); s3 = d[3] * s3 + bfhi(t.y);
        }
    }
}
__device__ __forceinline__ void gla_c_phase(const Frame& F, int layer) {
    CArgsP a = kargs(); unsigned char* const ws = a->ws;
    bf16* PA = (bf16*)(ws + WS_PA); const bf16* VT = (const bf16*)(ws + WS_VT);
    const float* Z = (const float*)(ws + WS_Z); const bf16* SST = (const bf16*)(ws + WS_H);
    int lz = 0; asm volatile("" : "+v"(lz));
    const int lane = F.lane, l16 = lane & 15, g = lane >> 4, t0 = 8 * F.wave;
    const int tt = F.wave & 3, vh = F.wave >> 2;
    LAS float* SSX = (LAS float*)(F.lds + GL_SSX);
    for (int unit = F.vcu; unit < BATCH * 4 * NCHUNK; unit += F.G) {
        const int b = unit / (4 * NCHUNK), h = (unit / NCHUNK) & 3, tc = unit % NCHUNK, row0 = chunk_row0(b, tc);
        float Bf[8], Bb[8], endf, endb;
        gla_scan(F, a, Z, layer, h, row0, lz, Bf, Bb, endf, endb);
#pragma unroll
        for (int i = 0; i < 8; ++i) {
            const bf16* pr = PA + (size_t)(row0 + t0 + i) * PA_LD + h * 64 + lane;
            const float qq = bf1(pr[PA_Q]), kk = bf1(pr[PA_K]);
            const float ef = __expf(Bf[i]), eb = __expf(Bb[i]);
            LAS bf16* ip = (LAS bf16*)(F.lds + GL_IMG + (t0 + i) * GL_PITCH) + lane;
            ip[0] = (bf16)f2bf(qq * ef); ip[GL_IMGB / 2] = (bf16)f2bf(kk / ef); ip[GL_IMGB] = (bf16)f2bf(qq * eb); ip[3 * GL_IMGB / 2] = (bf16)f2bf(kk / eb);
        }
        __syncthreads();
        f32x4 O[4];
#pragma unroll
        for (int mt = 0; mt < 4; ++mt) O[mt] = (f32x4){0.f, 0.f, 0.f, 0.f};
        const int tq = 16 * tt + l16;
#pragma unroll
        for (int dir = 0; dir < 2; ++dir) {
            const LAS unsigned char* Qimg = F.lds + GL_IMG + (2 * dir) * GL_IMGB; const LAS unsigned char* Kimg = Qimg + GL_IMGB;
            bf16x8_t qf[2];
#pragma unroll
            for (int kt = 0; kt < 2; ++kt) qf[kt] = *(const LAS bf16x8_t*)(Qimg + tq * GL_PITCH + (32 * kt + 8 * g) * 2);
            f32x4 P[4];
#pragma unroll
            for (int mt = 0; mt < 4; ++mt) {
                P[mt] = (f32x4){0.f, 0.f, 0.f, 0.f};
#pragma unroll
                for (int kt = 0; kt < 2; ++kt) { const bf16x8_t kf = *(const LAS bf16x8_t*)(Kimg + (16 * mt + l16) * GL_PITCH + (32 * kt + 8 * g) * 2); P[mt] = __builtin_amdgcn_mfma_f32_16x16x32_bf16(kf, qf[kt], P[mt], 0, 0, 0); }
#pragma unroll
                for (int rg = 0; rg < 4; ++rg) { const int tp = 16 * mt + 4 * g + rg; const bool valid = dir == 0 ? (tp <= tq) : (tp >= tq); P[mt][rg] = valid ? P[mt][rg] : 0.f; }
            }
            bf16x8_t pa[2];
#pragma unroll
            for (int k2 = 0; k2 < 2; ++k2) { const v4u w = (v4u){pk2(P[2 * k2][0], P[2 * k2][1]), pk2(P[2 * k2][2], P[2 * k2][3]), pk2(P[2 * k2 + 1][0], P[2 * k2 + 1][1]), pk2(P[2 * k2 + 1][2], P[2 * k2 + 1][3])}; pa[k2] = __builtin_bit_cast(bf16x8_t, w); }
            const bf16* slot = SST + ((size_t)((b * 4 + h) * 2 + dir) * NCHUNK + chunk_pos(tc, dir)) * 8192;
#pragma unroll
            for (int mt = 0; mt < 4; ++mt) {
                const int v = 64 * vh + 16 * mt + l16;
                const bf16* vp = VT + (size_t)(h * 128 + v) * R + row0 + 4 * g;
#pragma unroll
                for (int k2 = 0; k2 < 2; ++k2) { const v2u lo = *(const v2u*)(vp + 32 * k2), hi = *(const v2u*)(vp + 32 * k2 + 16); const v4u w = (v4u){lo.x, lo.y, hi.x, hi.y};
                    O[mt] = __builtin_amdgcn_mfma_f32_16x16x32_bf16(__builtin_bit_cast(bf16x8_t, w), pa[k2], O[mt], 0, 0, 0); }
#pragma unroll
                for (int kt = 0; kt < 2; ++kt) { const bf16x8_t sf = *(const bf16x8_t*)(slot + v * 64 + 32 * kt + 8 * g); O[mt] = __builtin_amdgcn_mfma_f32_16x16x32_bf16(sf, qf[kt], O[mt], 0, 0, 0); }
            }
        }
        float ss = 0.f;
#pragma unroll
        for (int mt = 0; mt < 4; ++mt) ss += (O[mt][0] * O[mt][0] + O[mt][1] * O[mt][1]) + (O[mt][2] * O[mt][2] + O[mt][3] * O[mt][3]);
        ss += __shfl_xor(ss, 16); ss += __shfl_xor(ss, 32);
        if (g == 0) SSX[F.wave * 16 + l16] = ss;
        __syncthreads();
        const float rs = rsqrtf((ss + SSX[(F.wave ^ 4) * 16 + l16]) * (1.f / 128.f) + EPS);
        bf16* rp0 = PA + (size_t)(row0 + tq) * PA_LD + PA_R + h * 128 + 64 * vh + 4 * g;
        const float* gp = a->in[I_GGLA] + layer * 128 + 64 * vh + 4 * g;
#pragma unroll
        for (int mt = 0; mt < 4; ++mt) {
            const f32x4 gg = *(const f32x4*)(gp + 16 * mt); const v2u rr = *(const v2u*)(rp0 + 16 * mt);
            const float r0 = bflo(rr.x), r1 = bfhi(rr.x), r2 = bflo(rr.y), r3 = bfhi(rr.y);
            const float y0 = O[mt][0] * rs * gg[0] * (r0 / (1.f + __expf(-r0))), y1 = O[mt][1] * rs * gg[1] * (r1 / (1.f + __expf(-r1)));
            const float y2 = O[mt][2] * rs * gg[2] * (r2 / (1.f + __expf(-r2))), y3 = O[mt][3] * rs * gg[3] * (r3 / (1.f + __expf(-r3)));
            *(v2u*)(rp0 + 16 * mt) = (v2u){pk2(y0, y1), pk2(y2, y3)};
        }
        __syncthreads();
    }
}

__device__ __forceinline__ void na_unit(bf16* PA, const bf16* NVT, const float* rpb_l, int b, int hd, bool lat, int qr, int nt, int lane) {
    const int l16 = lane & 15, g = lane >> 4;
    const int latbase = NCTX + b * SEQ, ctxbase = b * CTXL;
    const int tq_row = lat ? latbase + qr * 64 + 16 * nt + l16 : ctxbase + 16 * nt + l16;
    bf16* qp = PA + (size_t)tq_row * PA_LD + PA_NQ + hd * 64;
    bf16x8_t qf[2];
    qf[0] = *(const bf16x8_t*)(qp + 8 * g); qf[1] = *(const bf16x8_t*)(qp + 32 + 8 * g);
    const int qc = 16 * nt + l16, c0 = min(max(qc - 8, 0), 48), r0 = min(max(qr - 4, 0), 120), ct0 = nt < 2 ? 0 : 1;
    const float* rpb = rpb_l + hd * 465;
    float m = -3.0e38f, lsum = 0.f;
    f32x4 O[4];
#pragma unroll
    for (int mt = 0; mt < 4; ++mt) O[mt] = (f32x4){0.f, 0.f, 0.f, 0.f};
    const bf16* kbase = PA + PA_NK + hd * 64 + 8 * g;
    const bf16* vbase = NVT + (size_t)(hd * 64 + l16) * R + 4 * g;
#pragma unroll 1
    for (int grp = lat ? 0 : 6; grp < 10; ++grp) {
        int base[4]; f32x4 S[4];
#pragma unroll
        for (int j = 0; j < 4; ++j) {
            const int ti = grp * 4 + j;
            if (ti < 24) { const int wa = ti / 3, ct = ct0 + ti % 3; base[j] = latbase + (r0 + wa) * 64 + 16 * ct; } else base[j] = ctxbase + (ti - 24) * 16;
            const bf16* kp = kbase + (size_t)(base[j] + l16) * PA_LD;
            const bf16x8_t k0 = *(const bf16x8_t*)kp, k1 = *(const bf16x8_t*)(kp + 32);
            S[j] = (f32x4){0.f, 0.f, 0.f, 0.f};
            S[j] = __builtin_amdgcn_mfma_f32_16x16x32_bf16(k0, qf[0], S[j], 0, 0, 0);
            S[j] = __builtin_amdgcn_mfma_f32_16x16x32_bf16(k1, qf[1], S[j], 0, 0, 0);
        }
        bool valid[4][4];
        float mloc = -3.0e38f;
#pragma unroll
        for (int j = 0; j < 4; ++j) {
            const int ti = grp * 4 + j;
            if (ti < 24) {
                const int wa = ti / 3, ct = ct0 + ti % 3;
                const float* bp = rpb + (r0 + wa - qr + 7) * 31;
#pragma unroll
                for (int rg = 0; rg < 4; ++rg) { const int kc = 16 * ct + 4 * g + rg; valid[j][rg] = (kc >= c0) && (kc <= c0 + 15);
                    const float bias = bp[min(max(kc - qc + 15, 0), 30)]; S[j][rg] = valid[j][rg] ? S[j][rg] + bias : -3.0e38f; }
            } else {
#pragma unroll
                for (int rg = 0; rg < 4; ++rg) valid[j][rg] = true;
            }
            mloc = fmaxf(mloc, fmaxf(fmaxf(S[j][0], S[j][1]), fmaxf(S[j][2], S[j][3])));
        }
        mloc = fmaxf(mloc, __shfl_xor(mloc, 16)); mloc = fmaxf(mloc, __shfl_xor(mloc, 32));
        const float mnew = fmaxf(m, mloc), alpha = __expf(m - mnew);
        m = mnew;
        float psum = 0.f;
#pragma unroll
        for (int j = 0; j < 4; ++j)
#pragma unroll
            for (int rg = 0; rg < 4; ++rg) { const float p = valid[j][rg] ? __expf(S[j][rg] - m) : 0.f; S[j][rg] = p; psum += p; }
        lsum = lsum * alpha + psum;
#pragma unroll
        for (int mt = 0; mt < 4; ++mt) O[mt] = O[mt] * alpha;
#pragma unroll
        for (int k2 = 0; k2 < 2; ++k2) {
            const v4u pw = (v4u){pk2(S[2 * k2][0], S[2 * k2][1]), pk2(S[2 * k2][2], S[2 * k2][3]), pk2(S[2 * k2 + 1][0], S[2 * k2 + 1][1]), pk2(S[2 * k2 + 1][2], S[2 * k2 + 1][3])};
            const bf16x8_t pa = __builtin_bit_cast(bf16x8_t, pw);
#pragma unroll
            for (int mt = 0; mt < 4; ++mt) {
                const bf16* vp = vbase + (size_t)(16 * mt) * R;
                const v2u lo = *(const v2u*)(vp + base[2 * k2]), hi = *(const v2u*)(vp + base[2 * k2 + 1]);
                const v4u vw = (v4u){lo.x, lo.y, hi.x, hi.y};
                O[mt] = __builtin_amdgcn_mfma_f32_16x16x32_bf16(__builtin_bit_cast(bf16x8_t, vw), pa, O[mt], 0, 0, 0);
            }
        }
    }
    lsum += __shfl_xor(lsum, 16); lsum += __shfl_xor(lsum, 32);
    const float inv = 1.f / lsum;
#pragma unroll
    for (int mt = 0; mt < 4; ++mt) *(v2u*)(qp + 16 * mt + 4 * g) = (v2u){pk2(O[mt][0] * inv, O[mt][1] * inv), pk2(O[mt][2] * inv, O[mt][3] * inv)};
}
__device__ __forceinline__ void na_phase(const Frame& F, int layer) {
    CArgsP a = kargs(); unsigned char* const ws = a->ws;
    bf16* PA = (bf16*)(ws + WS_PA); const bf16* NVT = (const bf16*)(ws + WS_NVT);
    const float* rpb_l = a->in[I_RPB] + (size_t)layer * 8 * 465;
    const int nt = F.wave & 3, sub = F.wave >> 2;
    for (int gi = F.vcu; gi < BATCH * 8 * 64; gi += F.G) {
        const int b = gi >> 9, hd = (gi >> 6) & 7, qr = 2 * (gi & 63) + sub;
        na_unit(PA, NVT, rpb_l, b, hd, true, qr, nt, F.lane);
    }
    for (int u = F.vcu * NWAVES + F.wave; u < BATCH * 8 * 16; u += F.G * NWAVES) {
        const int b = u >> 7, hd = (u >> 4) & 7, qt = u & 15;
        na_unit(PA, NVT, rpb_l, b, hd, false, 0, qt, F.lane);
    }
}

__device__ __forceinline__ float pack_key(float v, int idx) { return __builtin_bit_cast(float, (__builtin_bit_cast(unsigned, v) & ~127u) | (unsigned)idx); }
__device__ __forceinline__ void topk_phase(const Frame& F) {
    CArgsP a = kargs(); unsigned char* const ws = a->ws;
    const int gtid = F.vcu * NT + F.tid, GT = F.G * NT;
    const float* SC = (const float*)(ws + WS_SC);
    int* EI = (int*)(ws + WS_EI); float* EG = (float*)(ws + WS_EG);
    LAS unsigned* myl = (LAS unsigned*)F.lds + F.tid * 9;
    for (int id = gtid; id < R * 8; id += GT) {
        const int r = id >> 3, hd = id & 7;
        const f32x4* sp = (const f32x4*)(SC + (size_t)r * 2048 + hd * 256);
        float t0[16], t1[16];
#pragma unroll
        for (int j = 0; j < 16; ++j) { t0[j] = -3.0e38f; t1[j] = -3.0e38f; }
        for (int i = 0; i < 32; ++i) {
            const f32x4 va = sp[i], vb = sp[32 + i];
#pragma unroll
            for (int e = 0; e < 4; ++e) {
                float x = pack_key(va[e], i * 4 + e), y = pack_key(vb[e], i * 4 + e);
#pragma unroll
                for (int j = 0; j < 16; ++j) { const float tx = fmaxf(t0[j], x); x = fminf(t0[j], x); t0[j] = tx; const float ty = fmaxf(t1[j], y); y = fminf(t1[j], y); t1[j] = ty; }
            }
        }
        float best[16];
#pragma unroll
        for (int j = 0; j < 16; ++j) best[j] = -3.0e38f;
#pragma unroll
        for (int ia = 0; ia < 16; ++ia)
#pragma unroll
            for (int ib = 0; ib < 16; ++ib)
                if ((ia + 1) * (ib + 1) <= 16) {
                    float x = __builtin_bit_cast(float, (__builtin_bit_cast(unsigned, t0[ia] + t1[ib]) & ~255u) | (unsigned)(ia * 16 + ib));
#pragma unroll
                    for (int j = 0; j < 16; ++j) { const float tb = fmaxf(best[j], x); x = fminf(best[j], x); best[j] = tb; }
                }
        {
            unsigned w0[4], w1[4];
#pragma unroll
            for (int q = 0; q < 4; ++q) {
                w0[q] = (__builtin_bit_cast(unsigned, t0[4 * q]) & 127u) | ((__builtin_bit_cast(unsigned, t0[4 * q + 1]) & 127u) << 8) | ((__builtin_bit_cast(unsigned, t0[4 * q + 2]) & 127u) << 16) | ((__builtin_bit_cast(unsigned, t0[4 * q + 3]) & 127u) << 24);
                w1[q] = (__builtin_bit_cast(unsigned, t1[4 * q]) & 127u) | ((__builtin_bit_cast(unsigned, t1[4 * q + 1]) & 127u) << 8) | ((__builtin_bit_cast(unsigned, t1[4 * q + 2]) & 127u) << 16) | ((__builtin_bit_cast(unsigned, t1[4 * q + 3]) & 127u) << 24);
            }
#pragma unroll
            for (int q = 0; q < 4; ++q) { myl[q] = w0[q]; myl[4 + q] = w1[q]; }
            LDS_WAIT();
        }
        int eid[16];
#pragma unroll
        for (int j = 0; j < 16; ++j) { const unsigned code = __builtin_bit_cast(unsigned, best[j]) & 255u; const LAS unsigned char* mb = (const LAS unsigned char*)myl;
            eid[j] = (int)mb[code >> 4] * 128 + (int)mb[16 + (code & 15u)]; }
        LDS_WAIT();
        float sum = 0.f; const float bmax = best[0];
#pragma unroll
        for (int j = 0; j < 16; ++j) { best[j] = __expf(best[j] - bmax); sum += best[j]; }
        const float inv = 1.f / sum;
        v4i* ei = (v4i*)(EI + (size_t)r * 128 + hd * 16); f32x4* eg = (f32x4*)(EG + (size_t)r * 128 + hd * 16);
#pragma unroll
        for (int j = 0; j < 4; ++j) { ei[j] = (v4i){eid[4 * j], eid[4 * j + 1], eid[4 * j + 2], eid[4 * j + 3]}; eg[j] = (f32x4){best[4 * j] * inv, best[4 * j + 1] * inv, best[4 * j + 2] * inv, best[4 * j + 3] * inv}; }
    }
}

__device__ __forceinline__ float gelu_tanh(float x) { const float u = 0.7978845608f * (x + 0.044715f * x * x * x); const float t = 1.f - 2.f / (1.f + __expf(2.f * u)); return 0.5f * x * (1.f + t); }
__device__ __forceinline__ void peer_phase(const Frame& F, int layer) {
    CArgsP a = kargs(); unsigned char* const ws = a->ws;
    const int gw = F.vcu * NWAVES + F.wave, NGW = F.G * NWAVES;
    const bf16* H = (const bf16*)(ws + WS_H);
    const bf16* EU = (const bf16*)(ws + WS_EU); const bf16* EV = (const bf16*)(ws + WS_EV);
    const int* EI = (const int*)(ws + WS_EI); const float* EG = (const float*)(ws + WS_EG);
    const float* MOD = (const float*)(ws + WS_MOD) + (size_t)layer * 9 * 6144 + 5 * D;
    LAS unsigned char* xl = F.lds + F.wave * 4096;
    const int lane = F.lane, e16 = lane & 15, g = lane >> 4;
    for (int r = gw; r < R; r += NGW) {
        { const v4u* hp = (const v4u*)(H + (size_t)r * D) + 2 * lane; const v4u h0 = hp[0], h1 = hp[1]; *(LAS v4u*)(xl + lane * 32) = h0; *(LAS v4u*)(xl + lane * 32 + 16) = h1; }
        const int idA = EI[(size_t)r * 128 + lane], idB = EI[(size_t)r * 128 + 64 + lane];
        LDS_WAIT();
        float actA = 0.f, actB = 0.f;
#pragma unroll 1
        for (int eg = 0; eg < 8; ++eg) {
            const int id = EI[(size_t)r * 128 + eg * 16 + e16]; const float gate = EG[(size_t)r * 128 + eg * 16 + e16];
            const v4u* up = (const v4u*)(EU + (size_t)id * D + g * 8);
            float d0 = 0.f, d1 = 0.f;
#pragma unroll
            for (int c = 0; c < 32; ++c) { const v4u w = up[c * 4]; const v4u xx = *(const LAS v4u*)(xl + (c * 32 + g * 8) * 2);
                d0 = dot2(w.x, xx.x, d0); d1 = dot2(w.y, xx.y, d1); d0 = dot2(w.z, xx.z, d0); d1 = dot2(w.w, xx.w, d1); }
            float dsum = d0 + d1;
            dsum += __shfl_xor(dsum, 16); dsum += __shfl_xor(dsum, 32);
            const float act = gelu_tanh(dsum) * gate;
            if (eg < 4) { if (g == eg) actA = act; } else { if (g == eg - 4) actB = act; }
        }
        float o[16];
#pragma unroll
        for (int k = 0; k < 16; ++k) o[k] = 0.f;
#pragma unroll 4
        for (int e = 0; e < 128; ++e) {
            const int id = __builtin_amdgcn_readlane(e < 64 ? idA : idB, e & 63);
            const float av = __builtin_bit_cast(float, __builtin_amdgcn_readlane(__builtin_bit_cast(int, e < 64 ? actA : actB), e & 63));
            const v4u* vp = (const v4u*)(EV + (size_t)id * D + lane * 16);
            const v4u w0 = vp[0], w1 = vp[1];
            o[0] += av * bflo(w0.x); o[1] += av * bfhi(w0.x); o[2] += av * bflo(w0.y); o[3] += av * bfhi(w0.y); o[4] += av * bflo(w0.z); o[5] += av * bfhi(w0.z); o[6] += av * bflo(w0.w); o[7] += av * bfhi(w0.w);
            o[8] += av * bflo(w1.x); o[9] += av * bfhi(w1.x); o[10] += av * bflo(w1.y); o[11] += av * bfhi(w1.y); o[12] += av * bflo(w1.z); o[13] += av * bfhi(w1.z); o[14] += av * bflo(w1.w); o[15] += av * bfhi(w1.w);
        }
        float* xp = xrow_cur(a, r) + lane * 16;
        const float* ga = MOD + row_slot(r) * 6144 + lane * 16;
#pragma unroll
        for (int j = 0; j < 4; ++j) { const f32x4 x = *(const f32x4*)(xp + 4 * j), gq = *(const f32x4*)(ga + 4 * j); *(f32x4*)(xp + 4 * j) = x + gq * (f32x4){o[4 * j], o[4 * j + 1], o[4 * j + 2], o[4 * j + 3]}; }
        LDS_WAIT();
    }
}

__device__ __forceinline__ void final_phase(const Frame& F) {
    CArgsP a = kargs(); unsigned char* const ws = a->ws;
    const int gw = F.vcu * NWAVES + F.wave, NGW = F.G * NWAVES;
    f32x4 gv[4];
#pragma unroll
    for (int j = 0; j < 4; ++j) gv[j] = *((const f32x4*)a->in[I_GF] + F.lane + 64 * j);
    for (int r = gw; r < NLAT; r += NGW) {
        f32x4* xr = (f32x4*)(a->out + (size_t)r * D) + F.lane;
        f32x4 v[4]; float ss = 0.f;
#pragma unroll
        for (int j = 0; j < 4; ++j) { v[j] = xr[64 * j]; ss += (v[j][0] * v[j][0] + v[j][1] * v[j][1]) + (v[j][2] * v[j][2] + v[j][3] * v[j][3]); }
        const float rs = rsqrtf(wave_sum(ss) * (1.f / D) + EPS);
#pragma unroll
        for (int j = 0; j < 4; ++j) xr[64 * j] = v[j] * rs * gv[j];
    }
}

__global__ void __launch_bounds__(NT, 2) fwd_kernel(Args args) {
    extern __shared__ __attribute__((aligned(16))) unsigned char lds[];
    Frame F;
    F.lds = (LAS unsigned char*)lds;
    F.tid = threadIdx.x; F.lane = F.tid & 63; F.wave = __builtin_amdgcn_readfirstlane(F.tid >> 6);
    F.G = gridDim.x; { const int bx = blockIdx.x; F.vcu = (F.G % 8 == 0) ? (bx % 8) * (F.G / 8) + bx / 8 : bx; }
    volatile LAS unsigned* MISC = (volatile LAS unsigned*)(F.lds + MISC_OFF);
    for (int u = F.tid; u < (LDS_BYTES - LDSCTL_OFF) / 4; u += NT) ((LAS unsigned*)(F.lds + LDSCTL_OFF))[u] = 0u;
    __syncthreads();
    XcdBarrier bar; bar.bar = (unsigned*)(args.ws + WS_CTL) + CW_BAR; bar.x = 0; bar.st = nullptr;
    if (MK_SINGLE) bar = xcd_barrier_post((unsigned*)(args.ws + WS_CTL) + CW_BAR, MISC + 8);
    const int lo = args.ph_lo, hi = args.ph_hi;
#define IN(k) (lo <= (k) && (k) < hi)
#define PF Frame Fp = F; asm volatile("" : "+v"(Fp.tid), "+v"(Fp.lane))
#define SEAM(k) do { if (MK_SINGLE && IN(k) && IN((k) + 1)) { xcd_barrier(bar); } } while (0)

    if (IN(0)) { PF; p0_prologue(Fp); SEAM(0); }

    for (int l = 0; l < DEPTH; ++l) {
        const int pb = 1 + l * NPL;
        if (IN(pb + 0)) { { PF; norm_phase(Fp, l, 0); } { PF; convert_experts(Fp, l); } SEAM(pb + 0); }
        if (IN(pb + 1)) {
            CArgsP ap = kargs(); unsigned char* const ws = ap->ws; bf16* Hb = (bf16*)(ws + WS_H); bf16* PA = (bf16*)(ws + WS_PA); bf16* PG = (bf16*)(ws + WS_PG);
            pg8::Gemm g{Hb, (const bf16*)(ws + WS_WIN) + (size_t)l * NPAD * D, R, NPAD, D, D}; pg8::StaticOrder S; S.init(R, NPAD, F.G, (int)blockIdx.x);
            EpiIn E{PA, PG, (float*)(ws + WS_Z), (const float*)(ws + WS_ROPE), (bf16*)(ws + WS_VT), (bf16*)(ws + WS_NVT)};
            pg8::gemm_phase<EpiIn, pg8::StaticOrder, true, true>(F.lds, g, S, E);
            SEAM(pb + 1);
        }
        if (IN(pb + 2)) { { PF; gla_a_phase(Fp, l); } { PF; na_phase(Fp, l); } SEAM(pb + 2); }
        if (IN(pb + 3)) { PF; gla_b_phase(Fp); SEAM(pb + 3); }
        if (IN(pb + 4)) { PF; gla_c_phase(Fp, l); SEAM(pb + 4); }
        if (IN(pb + 5)) {
            CArgsP ap = kargs(); unsigned char* const ws = ap->ws; bf16* Hb = (bf16*)(ws + WS_H); bf16* PA = (bf16*)(ws + WS_PA); bf16* PG = (bf16*)(ws + WS_PG);
            pg8::StaticOrder S; S.init(R, D, F.G, (int)blockIdx.x);
            { pg8::Gemm g{PA + PA_R, (const bf16*)(ws + WS_WPG) + (size_t)l * D * 512, R, D, 512, PA_LD}; EpiMerge<0> E{Hb, PG}; pg8::gemm_phase<EpiMerge<0>, pg8::StaticOrder, true, true>(F.lds, g, S, E); }
            { pg8::Gemm g{PA + PA_NQ, (const bf16*)(ws + WS_WPN) + (size_t)l * D * 512, R, D, 512, PA_LD}; EpiMerge<1> E{Hb, PG}; pg8::gemm_phase<EpiMerge<1>, pg8::StaticOrder, true, true>(F.lds, g, S, E); }
            SEAM(pb + 5);
        }
        if (IN(pb + 6)) {
            CArgsP ap = kargs(); unsigned char* const ws = ap->ws; bf16* Hb = (bf16*)(ws + WS_H);
            pg8::Gemm g{Hb, (const bf16*)(ws + WS_WO) + (size_t)l * D * D, R, D, D, D}; pg8::StaticOrder S; S.init(R, D, F.G, (int)blockIdx.x);
            EpiRes E{l == 0 ? ap->in[I_CTX] : (const float*)(ws + WS_XC), l == 0 ? ap->in[I_X] : (const float*)ap->out, (float*)(ws + WS_XC), ap->out, (const float*)(ws + WS_MOD) + (size_t)l * 9 * 6144};
            pg8::gemm_phase<EpiRes, pg8::StaticOrder, true, true>(F.lds, g, S, E);
            SEAM(pb + 6);
        }
        if (IN(pb + 7)) { PF; norm_phase(Fp, l, 1); SEAM(pb + 7); }
        if (IN(pb + 8)) {
            CArgsP ap = kargs(); unsigned char* const ws = ap->ws; bf16* Hb = (bf16*)(ws + WS_H);
            pg8::Gemm g{Hb, (const bf16*)(ws + WS_WS) + (size_t)l * 2048 * D, R, 2048, D, D}; pg8::StaticOrder S; S.init(R, 2048, F.G, (int)blockIdx.x);
            EpiF32 E{(float*)(ws + WS_SC), 2048};
            pg8::gemm_phase<EpiF32, pg8::StaticOrder, true, true>(F.lds, g, S, E);
            SEAM(pb + 8);
        }
        if (IN(pb + 9)) { PF; topk_phase(Fp); SEAM(pb + 9); }
        if (IN(pb + 10)) { PF; peer_phase(Fp, l); SEAM(pb + 10); }
    }
    if (IN(NPHASE - 1)) { PF; final_phase(Fp); }
#undef IN
#undef SEAM
}

extern "C" void kernel_launch(void* const* d_in, const int* in_sizes, int n_in, void* d_out, int out_size, void* d_ws, size_t ws_size, hipStream_t stream) {
    static int grid = 0;
    if (grid == 0) {
        if (n_in != 23 || in_sizes[0] != NLAT * D || out_size != NLAT * D || ws_size < WS_END) { fprintf(stderr, "kernel_launch: unexpected shapes (n_in %d, in0 %d, out %d, ws %zu); nothing launched\n", n_in, n_in > 0 ? in_sizes[0] : -1, out_size, ws_size); grid = -1; return; }
        int dev = 0, cus = 0, per_cu = 0;
        if (hipGetDevice(&dev) != hipSuccess || hipDeviceGetAttribute(&cus, hipDeviceAttributeMultiprocessorCount, dev) != hipSuccess) { grid = -1; return; }
        if (hipFuncSetAttribute((const void*)fwd_kernel, hipFuncAttributeMaxDynamicSharedMemorySize, LDS_BYTES) != hipSuccess) { fprintf(stderr, "kernel_launch: hipFuncSetAttribute failed\n"); grid = -1; return; }
        if (hipOccupancyMaxActiveBlocksPerMultiprocessor(&per_cu, (const void*)fwd_kernel, NT, LDS_BYTES) != hipSuccess || per_cu < 1) { fprintf(stderr, "kernel_launch: occupancy query says %d blocks per CU\n", per_cu); }
        (void)hipGetLastError();
        grid = cus;
    }
    if (grid < 0) return;
    if (hipMemsetAsync((char*)d_ws + WS_CTL, 0, CTL_ZERO_BYTES, stream) != hipSuccess) return;
    Args a{};
    for (int i = 0; i < 23; ++i) a.in[i] = (const float*)d_in[i];
    a.out = (float*)d_out; a.ws = (unsigned char*)d_ws; a.pad = 0;
    if (MK_SINGLE) {
        a.ph_lo = 0; a.ph_hi = NPHASE; a.li = 0;
        hipLaunchKernelGGL(fwd_kernel, dim3(grid), dim3(NT), LDS_BYTES, stream, a);
    } else {
        for (int p = 0; p < NPHASE; ++p) { a.ph_lo = p; a.ph_hi = p + 1; a.li = p; hipLaunchKernelGGL(fwd_kernel, dim3(grid), dim3(NT), LDS_BYTES, stream, a); }
    }
}
```

```cpp
#include <hip/hip_runtime.h>
#include <cstdio>
#include <cstdint>

#ifndef PROBE
#define PROBE 0
#endif
#ifndef MK_SINGLE
#define MK_SINGLE 1
#endif

namespace pg8 {
#define PG8_LAS __attribute__((address_space(3)))
typedef unsigned short bf16_t;
typedef short bf16x8 __attribute__((ext_vector_type(8)));
typedef float f32x4 __attribute__((ext_vector_type(4)));
typedef unsigned u32x4 __attribute__((ext_vector_type(4)));
constexpr int BM = 256, BK = 64, HALF = 128, HTB = HALF * BK * 2, STAGE_BYTES = 8 * HTB, NXCD = 8, WGM = 8;

__host__ __device__ __forceinline__ int lds_byte(int r, int c) { const int st = (r >> 4) * 2 + (c >> 5), rr = r & 15, cc = c & 31, ob = rr * 64 + cc * 2; return st * 1024 + (ob ^ (((ob >> 9) & 1) << 5)); }
__host__ __device__ __forceinline__ void stage_rc(int b, int& R, int& C) { const int st = b / 1024, sb = b % 1024, swz = sb ^ (((sb >> 9) & 1) << 5); R = (st >> 1) * 16 + swz / 64; C = (st & 1) * 32 + (swz % 64) / 2; }
__host__ __device__ __forceinline__ int perm32(int rho) { const int n = rho >> 4, i = rho & 15; return 8 * (i >> 2) + 4 * n + (i & 3); }

struct Unit { int pm, pn; };
struct Gemm { const bf16_t* A; const bf16_t* Bt; int M, N, K, lda; };

struct StaticOrder {
    int nM, nN, nwg, G, c;
    __host__ __device__ void init(int M, int N, int G_, int c_) { nM = M / BM; nN = N / BM; nwg = nM * nN; G = G_; c = c_; }
    __host__ __device__ bool next(int i, Unit& u) const {
        const long L = (long)i * G + c; if (L >= nwg) return false;
        int wgid = (int)L; { const int q = nwg / NXCD, r = nwg % NXCD, xcd = wgid % NXCD, off = wgid / NXCD; wgid = (xcd < r ? xcd * (q + 1) : r * (q + 1) + (xcd - r) * q) + off; }
        const int nig = WGM * nN, gid = wgid / nig, fm = gid * WGM, gsz = (nM - fm) < WGM ? (nM - fm) : WGM;
        u.pm = fm + ((wgid % nig) % gsz); u.pn = (wgid % nig) / gsz; return true;
    }
    __device__ __forceinline__ void a_ready(const Unit&) const {}
    __device__ __forceinline__ void done(const Unit&) const {}
};

__device__ __forceinline__ unsigned cvt_pk_bf16(float lo, float hi) { unsigned r; asm volatile("v_cvt_pk_bf16_f32 %0, %1, %2" : "=v"(r) : "v"(lo), "v"(hi)); return r; }

template <class Epi, class Sched, bool ALIGN_EPI = false, bool SP2 = false>
__device__ __forceinline__ void gemm_phase(PG8_LAS unsigned char* lds, const Gemm g, const Sched& S, const Epi& E) {
    int tid_ = threadIdx.x; asm volatile("" : "+v"(tid_));
    const int tid = tid_, wid = __builtin_amdgcn_readfirstlane(tid >> 6), lane = tid & 63, wr = wid >> 2, wc = wid & 3, fr = lane & 15, fq = lane >> 4;
    const int K = g.K, nt = K / BK, lda = g.lda;
    unsigned voffA[2], voffB[2];
#pragma unroll
    for (int i = 0; i < 2; ++i) { int R, C; stage_rc(tid * 16 + i * 8192, R, C); const int Rb = Epi::PERM ? ((R & ~31) + perm32(R & 31)) : R;
        voffA[i] = (unsigned)(R * lda + C) * 2u; voffB[i] = (unsigned)(Rb * K + C) * 2u; }
    const size_t kstep = (size_t)(BK * 2);
    const size_t hstepA = (size_t)HALF * lda * 2, hstepB = (size_t)HALF * K * 2;
    const size_t tstepA = 2 * hstepA, tstepB = 2 * hstepB;
    const unsigned ldsw = (unsigned)wid * 1024u;
    const int aoff = lds_byte(wr * 64 + fr, fq * 8), boff = lds_byte(wc * 32 + fr, fq * 8);
#define PG8_SA(b, h) (((b) * 2 + (h)) * HTB)
#define PG8_SB(b, h) ((4 + (b) * 2 + (h)) * HTB)
#define PG8_STAGE(bufoff, gbase, voff) do { _Pragma("unroll") for (int _i = 0; _i < 2; ++_i) \
        __builtin_amdgcn_global_load_lds((const unsigned*)((const char*)(gbase) + (voff)[_i]), (PG8_LAS unsigned*)(lds + (bufoff) + ldsw + _i * 8192), 16, 0, 0); } while (0)
#define PG8_LDA(dst, b, h) do { _Pragma("unroll") for (int m = 0; m < 4; ++m) _Pragma("unroll") for (int k = 0; k < 2; ++k) dst[m][k] = *(const PG8_LAS bf16x8*)(lds + PG8_SA(b, h) + aoff + m * 2048 + k * 1024); } while (0)
#define PG8_LDB(dst, b, h) do { _Pragma("unroll") for (int n = 0; n < 2; ++n) _Pragma("unroll") for (int k = 0; k < 2; ++k) dst[n][k] = *(const PG8_LAS bf16x8*)(lds + PG8_SB(b, h) + boff + n * 2048 + k * 1024); } while (0)
#define PG8_MMA(ai, bj, At, Bt) do { __builtin_amdgcn_s_setprio(1); _Pragma("unroll") for (int m = 0; m < 4; ++m) _Pragma("unroll") for (int n = 0; n < 2; ++n) _Pragma("unroll") for (int k = 0; k < 2; ++k) \
        acc[ai][bj][m][n] = __builtin_amdgcn_mfma_f32_16x16x32_bf16(Bt[n][k], At[m][k], acc[ai][bj][m][n], 0, 0, 0); __builtin_amdgcn_s_setprio(0); } while (0)
#define PG8_WAIT_V(n) asm volatile("s_waitcnt vmcnt(" #n ")" ::: "memory")
#define PG8_WAIT_L(n) asm volatile("s_waitcnt lgkmcnt(" #n ")" ::: "memory")
#define PG8_BAR __builtin_amdgcn_s_barrier()
#define PG8_SCHED __builtin_amdgcn_sched_barrier(0)
    Unit cur, nxt; int ui = 0;
    if (!S.next(0, cur)) return;
    f32x4 acc[2][2][4][2];
#pragma unroll
    for (int a = 0; a < 2; ++a)
#pragma unroll
        for (int b = 0; b < 2; ++b)
#pragma unroll
            for (int m = 0; m < 4; ++m)
#pragma unroll
                for (int n = 0; n < 2; ++n) acc[a][b][m][n] = (f32x4){0.f, 0.f, 0.f, 0.f};
    bf16x8 At[4][2], B0[2][2], B1[2][2];
    const char* cA = (const char*)g.A + (size_t)cur.pm * tstepA; const char* cB = (const char*)g.Bt + (size_t)cur.pn * tstepB;
    S.a_ready(cur);
    if constexpr (SP2) {
        PG8_STAGE(PG8_SB(0, 0), cB, voffB); PG8_STAGE(PG8_SB(0, 1), cB + hstepB, voffB); PG8_STAGE(PG8_SA(0, 0), cA, voffA); PG8_STAGE(PG8_SA(0, 1), cA + hstepA, voffA);
        if (wr == 1) PG8_BAR;
        PG8_WAIT_V(2); PG8_BAR;
        PG8_STAGE(PG8_SB(1, 0), cB + kstep, voffB); PG8_STAGE(PG8_SA(1, 0), cA + kstep, voffA); PG8_STAGE(PG8_SB(1, 1), cB + hstepB + kstep, voffB);
        PG8_WAIT_V(6); PG8_BAR;
    } else {
        PG8_STAGE(PG8_SB(0, 0), cB, voffB); PG8_STAGE(PG8_SA(0, 0), cA, voffA); PG8_STAGE(PG8_SB(0, 1), cB + hstepB, voffB); PG8_STAGE(PG8_SA(0, 1), cA + hstepA, voffA);
        if (wr == 1) PG8_BAR;
        PG8_WAIT_V(4); PG8_BAR;
        PG8_STAGE(PG8_SB(1, 0), cB + kstep, voffB); PG8_STAGE(PG8_SA(1, 0), cA + kstep, voffA); PG8_STAGE(PG8_SB(1, 1), cB + hstepB + kstep, voffB);
        PG8_WAIT_V(6); PG8_BAR;
    }
    for (;;) {
        const bool has_next = S.next(ui + 1, nxt);
        const char* nA = has_next ? (const char*)g.A + (size_t)nxt.pm * tstepA : cA; const char* nB = has_next ? (const char*)g.Bt + (size_t)nxt.pn * tstepB : cB;
        for (int t = 0; t < nt; t += 2) {
            const bool last = (t == nt - 2);
            const char* a1 = cA + (size_t)(t + 1) * kstep;
            const char* a2 = last ? nA : cA + (size_t)(t + 2) * kstep; const char* b2 = last ? nB : cB + (size_t)(t + 2) * kstep;
            const char* a3 = a2 + kstep; const char* b3 = b2 + kstep;
            if (last && has_next) S.a_ready(nxt);
            if constexpr (SP2) {
            PG8_LDB(B0, 0, 0); PG8_LDB(B1, 0, 1); PG8_SCHED; PG8_LDA(At, 0, 0); PG8_STAGE(PG8_SA(1, 1), a1 + hstepA, voffA);
            PG8_WAIT_V(8); PG8_WAIT_L(0); PG8_BAR; PG8_MMA(0, 0, At, B0); PG8_MMA(0, 1, At, B1); PG8_BAR; PG8_SCHED;
            PG8_LDA(At, 0, 1); PG8_STAGE(PG8_SB(0, 0), b2, voffB); PG8_STAGE(PG8_SB(0, 1), b2 + hstepB, voffB); PG8_STAGE(PG8_SA(0, 0), a2, voffA);
            PG8_WAIT_V(8); PG8_WAIT_L(0); PG8_BAR; PG8_MMA(1, 0, At, B0); PG8_MMA(1, 1, At, B1); PG8_BAR; PG8_SCHED;
            PG8_LDB(B0, 1, 0); PG8_LDB(B1, 1, 1); PG8_SCHED; PG8_LDA(At, 1, 0); PG8_STAGE(PG8_SA(0, 1), a2 + hstepA, voffA);
            PG8_WAIT_V(8); PG8_WAIT_L(0); PG8_BAR; PG8_MMA(0, 0, At, B0); PG8_MMA(0, 1, At, B1); PG8_BAR; PG8_SCHED;
            PG8_LDA(At, 1, 1); PG8_STAGE(PG8_SB(1, 0), b3, voffB); PG8_STAGE(PG8_SB(1, 1), b3 + hstepB, voffB); PG8_STAGE(PG8_SA(1, 0), a3, voffA);
            PG8_WAIT_V(8); PG8_WAIT_L(0); PG8_BAR; PG8_MMA(1, 0, At, B0); PG8_MMA(1, 1, At, B1); PG8_BAR; PG8_SCHED;
            } else {
            PG8_LDB(B0, 0, 0); PG8_SCHED; PG8_LDA(At, 0, 0); PG8_STAGE(PG8_SA(1, 1), a1 + hstepA, voffA);
            PG8_WAIT_L(8); PG8_BAR; PG8_WAIT_L(0); PG8_MMA(0, 0, At, B0); PG8_BAR; PG8_SCHED;
            PG8_LDB(B1, 0, 1); PG8_STAGE(PG8_SB(0, 0), b2, voffB);
            PG8_BAR; PG8_WAIT_L(0); PG8_MMA(0, 1, At, B1); PG8_BAR;
            PG8_LDA(At, 0, 1); PG8_STAGE(PG8_SA(0, 0), a2, voffA);
            PG8_BAR; PG8_WAIT_L(0); PG8_MMA(1, 0, At, B0); PG8_BAR; PG8_SCHED;
            PG8_STAGE(PG8_SB(0, 1), b2 + hstepB, voffB);
            PG8_WAIT_V(6); PG8_BAR; PG8_MMA(1, 1, At, B1); PG8_BAR;
            PG8_LDB(B0, 1, 0); PG8_SCHED; PG8_LDA(At, 1, 0); PG8_STAGE(PG8_SA(0, 1), a2 + hstepA, voffA);
            PG8_WAIT_L(8); PG8_BAR; PG8_WAIT_L(0); PG8_MMA(0, 0, At, B0); PG8_BAR; PG8_SCHED;
            PG8_LDB(B1, 1, 1); PG8_STAGE(PG8_SB(1, 0), b3, voffB);
            PG8_BAR; PG8_WAIT_L(0); PG8_MMA(0, 1, At, B1); PG8_BAR;
            PG8_LDA(At, 1, 1); PG8_STAGE(PG8_SA(1, 0), a3, voffA);
            PG8_BAR; PG8_WAIT_L(0); PG8_MMA(1, 0, At, B0); PG8_BAR; PG8_SCHED;
            PG8_STAGE(PG8_SB(1, 1), b3 + hstepB, voffB);
            PG8_WAIT_V(6); PG8_BAR; PG8_MMA(1, 1, At, B1); PG8_BAR;
            }
        }
        if constexpr (ALIGN_EPI) { if (wr == 0) PG8_BAR; }
        E(acc, cur, wr, wc, fr, fq); S.done(cur);
        if (!has_next) break;
#pragma unroll
        for (int a = 0; a < 2; ++a)
#pragma unroll
            for (int b = 0; b < 2; ++b)
#pragma unroll
                for (int m = 0; m < 4; ++m)
#pragma unroll
                    for (int n = 0; n < 2; ++n) acc[a][b][m][n] = (f32x4){0.f, 0.f, 0.f, 0.f};
        cur = nxt; cA = nA; cB = nB; ++ui;
        if constexpr (ALIGN_EPI) { if (wr == 1) PG8_BAR; }
    }
    PG8_WAIT_V(0);
    if constexpr (!ALIGN_EPI) { if (wr == 0) PG8_BAR; }
    PG8_BAR;
#undef PG8_SA
#undef PG8_SB
#undef PG8_STAGE
#undef PG8_LDA
#undef PG8_LDB
#undef PG8_MMA
#undef PG8_WAIT_V
#undef PG8_WAIT_L
#undef PG8_BAR
#undef PG8_SCHED
}
}

constexpr int D = 1024, BATCH = 8, SEQ = 8192, DEPTH = 4, CTXL = 256, GRIDW = 64;
constexpr int NCTX = BATCH * CTXL;
constexpr int NLAT = BATCH * SEQ;
constexpr int R = NCTX + NLAT;
constexpr int IN_COLS = 5152, NPAD = 5376;
constexpr int PA_LD = 2048, PG_LD = 2048;
constexpr int PA_Q = 0, PA_K = 256, PA_R = 512, PA_NQ = 1024, PA_NK = 1536;
constexpr int NCHUNK = 132;
constexpr int NEXP = 16384;
constexpr float EPS = 1e-6f;
constexpr int NWAVES = 8, NT = 512;
constexpr int NPL = 13;
constexpr int NPHASE = 1 + DEPTH * NPL + 1;

constexpr size_t MiB = 1u << 20;
constexpr size_t WS_CTL = 0, CTL_ZERO_BYTES = 2 * MiB;
constexpr size_t WS_MOD = 1 * MiB;
constexpr size_t WS_ROPE = 2 * MiB;
constexpr size_t WS_WIN = 3 * MiB;
constexpr size_t WS_WPG = 45 * MiB, WS_WPN = 49 * MiB;
constexpr size_t WS_WO = 53 * MiB;
constexpr size_t WS_WS = 61 * MiB;
constexpr size_t WS_XC = 77 * MiB;
constexpr size_t WS_Z = 85 * MiB;
constexpr size_t WS_EU = 94 * MiB, WS_EV = 110 * MiB;
constexpr size_t WS_SU = 126 * MiB, WS_SV = WS_SU + 65536, WS_SX = WS_SV + 65536;
constexpr size_t WS_H8 = 884 * MiB;
constexpr size_t WS_PART = 290 * MiB;
constexpr size_t WS_ACT = 554 * MiB;
constexpr size_t WS_H = 158 * MiB;
constexpr size_t WS_PA = 290 * MiB;
constexpr size_t WS_VT = 554 * MiB, WS_NVT = 620 * MiB;
constexpr size_t WS_DEC = 950 * MiB;
constexpr size_t WS_PG = 686 * MiB;
constexpr size_t WS_SC = 290 * MiB;
constexpr size_t WS_EI = 818 * MiB, WS_EG = 851 * MiB;
constexpr size_t WS_END = 953 * MiB;
static_assert(WS_SC + (size_t)R * 2048 * 4 <= WS_EI && WS_EG + (size_t)R * 128 * 4 <= WS_DEC && WS_PG + (size_t)R * PG_LD * 2 <= WS_DEC && WS_DEC + 64 * 132 * 64 * 4 <= WS_END, "ws map");
static_assert(WS_H + (size_t)R * 1024 * 2 <= WS_PA && WS_PA + (size_t)R * PA_LD * 2 <= WS_VT && WS_VT + (size_t)R * 512 * 2 <= WS_NVT && WS_NVT + (size_t)R * 512 * 2 <= WS_PG && WS_Z + (size_t)R * 32 * 4 <= WS_EU, "ws map");
constexpr int CW_BAR = 4096;

constexpr int RING_BYTES = 131072, LDSCTL_OFF = RING_BYTES, MISC_OFF = LDSCTL_OFF + 320, LDS_BYTES = 147456;

#define GAS __attribute__((address_space(1)))
#define LAS __attribute__((address_space(3)))
typedef unsigned short bf16;
typedef unsigned v4u __attribute__((ext_vector_type(4)));
typedef unsigned v2u __attribute__((ext_vector_type(2)));
typedef int v4i __attribute__((ext_vector_type(4)));
typedef float f32x4 __attribute__((ext_vector_type(4)));
typedef __bf16 bf16x2_t __attribute__((ext_vector_type(2)));
#define LDS_WAIT() asm volatile("s_waitcnt lgkmcnt(0)" ::: "memory")
#define VM_WAIT() asm volatile("s_waitcnt vmcnt(0)" ::: "memory")
__device__ __forceinline__ unsigned f2bf(float f) { unsigned u = __builtin_bit_cast(unsigned, f); return (u + 0x7fffu + ((u >> 16) & 1u)) >> 16; }
__device__ __forceinline__ unsigned pk2(float lo, float hi) { return f2bf(lo) | (f2bf(hi) << 16); }
__device__ __forceinline__ float bflo(unsigned w) { return __builtin_bit_cast(float, w << 16); }
__device__ __forceinline__ float bfhi(unsigned w) { return __builtin_bit_cast(float, w & 0xffff0000u); }
__device__ __forceinline__ float bf1(bf16 h) { return __builtin_bit_cast(float, ((unsigned)h) << 16); }
__device__ __forceinline__ float dot2(unsigned a, unsigned b, float acc) { return __builtin_amdgcn_fdot2_f32_bf16(__builtin_bit_cast(bf16x2_t, a), __builtin_bit_cast(bf16x2_t, b), acc, false); }
__device__ __forceinline__ float wave_sum(float v) {
#pragma unroll
    for (int o = 1; o < 64; o <<= 1) v += __shfl_xor(v, o);
    return v;
}
__device__ __forceinline__ float wave_max(float v) {
#pragma unroll
    for (int o = 1; o < 64; o <<= 1) v = fmaxf(v, __shfl_xor(v, o));
    return v;
}
__device__ __forceinline__ float sigmoidf_(float x) { return 1.f / (1.f + __expf(-x)); }

#define XB_TMO      128
#define XB_XCNT(j)  (256  + 64 * (j))
#define XB_XSUB(j)  (1280 + 64 * (j))
#define XB_XGEN(j)  (2304 + 64 * (j))
#define XB_TOP      3328
#define XB_TOPGEN   3392
#define XCD_BAR_WORDS 3456
#define XB_SPIN_CAP (1u << 18)
__device__ __forceinline__ unsigned xb_ld(unsigned* p)              { return __hip_atomic_load(p, __ATOMIC_RELAXED, __HIP_MEMORY_SCOPE_AGENT); }
__device__ __forceinline__ unsigned xb_add(unsigned* p, unsigned v) { return __hip_atomic_fetch_add(p, v, __ATOMIC_RELAXED, __HIP_MEMORY_SCOPE_AGENT); }
__device__ __forceinline__ unsigned xb_xcc_id() { return (unsigned)__builtin_amdgcn_s_getreg((3 << 11) | 20) & 0xFu; }
#define XB_SPIN(cond, bar) do { unsigned _sp = 0; while (cond) { __builtin_amdgcn_s_sleep(1); \
    if ((++_sp & 255u) == 0u) { if (xb_ld(&(bar)[XB_TMO])) break; if (_sp > XB_SPIN_CAP) { atomicAdd(&(bar)[XB_TMO], 1u); break; } } } } while (0)
struct XcdBarrier { unsigned* bar; unsigned x; volatile LAS unsigned* st; };
__device__ __forceinline__ XcdBarrier xcd_barrier_post(unsigned* bar, volatile LAS unsigned* st) {
    XcdBarrier b; b.bar = bar; b.x = xb_xcc_id(); b.st = st;
    if (threadIdx.x == 0) (void)xb_add(&bar[XB_XCNT(b.x)], 1u);
    return b;
}
__device__ __forceinline__ void xcd_barrier_complete(unsigned* bar, unsigned x, unsigned& nloc, unsigned& nx) {
    const unsigned G = gridDim.x * gridDim.y * gridDim.z;
    unsigned sum, cnt, mine, sp = 0u;
    for (;;) {
        sum = 0u; cnt = 0u; mine = 0u;
#pragma unroll
        for (unsigned j = 0; j < 16; ++j) { const unsigned c = xb_ld(&bar[XB_XCNT(j)]); sum += c; cnt += (c > 0u) ? 1u : 0u; mine = (j == x) ? c : mine; }
        if (sum == G) break;
        __builtin_amdgcn_s_sleep(1);
        if ((++sp & 255u) == 0u) { if (xb_ld(&bar[XB_TMO])) break; if (sp > XB_SPIN_CAP) { atomicAdd(&bar[XB_TMO], 1u); break; } }
    }
    nloc = mine > 0u ? mine : 1u; nx = cnt > 0u ? cnt : 1u;
}
__device__ __forceinline__ void xcd_barrier(const XcdBarrier& b) {
    asm volatile("s_waitcnt vmcnt(0)" ::: "memory");
    __syncthreads();
    if (threadIdx.x == 0) {
        unsigned* bar = b.bar;
        __builtin_amdgcn_s_waitcnt(0);
        unsigned nloc = b.st[0], nx = b.st[1];
        if (nloc == 0u) { xcd_barrier_complete(bar, b.x, nloc, nx); b.st[0] = nloc; b.st[1] = nx; }
        const unsigned old = xb_add(&bar[XB_XSUB(b.x)], 1u);
        const unsigned gen = old / nloc;
        if (old + 1u == (gen + 1u) * nloc) {
            __builtin_amdgcn_fence(__ATOMIC_RELEASE, "agent");
            asm volatile("s_waitcnt vmcnt(0)" ::: "memory");
            const unsigned og = xb_add(&bar[XB_TOP], 1u);
            const unsigned tg = og / nx;
            if (og + 1u == (tg + 1u) * nx) xb_add(&bar[XB_TOPGEN], 1u);
            else XB_SPIN(xb_ld(&bar[XB_TOPGEN]) == tg, bar);
            __builtin_amdgcn_fence(__ATOMIC_ACQUIRE, "agent");
            xb_add(&bar[XB_XGEN(b.x)], 1u);
            asm volatile("s_waitcnt vmcnt(0)" ::: "memory");
        } else {
            XB_SPIN(xb_ld(&bar[XB_XGEN(b.x)]) == gen, bar);
            __builtin_amdgcn_fence(__ATOMIC_ACQUIRE, "agent");
            asm volatile("s_waitcnt vmcnt(0)" ::: "memory");
        }
    }
    __syncthreads();
}

struct Args { const float* in[23]; float* out; unsigned char* ws; int ph_lo, ph_hi, li, pad; };
enum { I_X = 0, I_C, I_CTX, I_CCTX, I_WMOD, I_BMOD, I_GN1, I_WIN, I_WAF, I_BAF, I_WAB, I_BAB, I_GGLA, I_RPB, I_WPG, I_WPN, I_WO, I_GN2, I_WQ, I_SK, I_EU, I_EV, I_GF };

struct Frame {
    LAS unsigned char* lds;
    int tid, lane, wave, vcu, G;
};
typedef const __attribute__((address_space(4))) Args* CArgsP;
__device__ __forceinline__ CArgsP kargs() { CArgsP p = (CArgsP)__builtin_amdgcn_kernarg_segment_ptr(); asm volatile("" : "+s"(p)); return p; }
__device__ __forceinline__ const float* xrow_in(CArgsP a, int r) { return r < NCTX ? a->in[I_CTX] + (size_t)r * D : a->in[I_X] + (size_t)(r - NCTX) * D; }
__device__ __forceinline__ float* xrow_cur(CArgsP a, int r) { return r < NCTX ? (float*)(a->ws + WS_XC) + (size_t)r * D : a->out + (size_t)(r - NCTX) * D; }
__device__ __forceinline__ int row_slot(int r) { return r < NCTX ? 8 : ((r - NCTX) >> 13); }

using pg8::f32x4; using pg8::u32x4; using pg8::Unit; using pg8::cvt_pk_bf16;
struct EpiIn {
    static constexpr bool PERM = true;
    bf16* PA; bf16* PG; float* Z; const float* rope; bf16* VT; bf16* NVT;
    __device__ __forceinline__ void operator()(const f32x4 (&acc)[2][2][4][2], const Unit& u, int wr, int wc, int fr, int fq) const {
        const int pn = u.pn, row0 = u.pm * 256 + wr * 64 + fr;
        if (pn == 20) {
            if (wc == 0) {
#pragma unroll
                for (int ai = 0; ai < 2; ++ai)
#pragma unroll
                    for (int m = 0; m < 4; ++m) { float* zp = Z + (size_t)(row0 + ai * 128 + m * 16) * 32 + 8 * fq; *(f32x4*)zp = acc[ai][0][m][0]; *(f32x4*)(zp + 4) = acc[ai][0][m][1]; }
            }
            return;
        }
        if (pn >= 8 && pn < 12) {
            bf16* T = (pn < 10 ? VT : NVT) + (size_t)(((pn - 8) & 1) * 256 + wc * 32 + 8 * fq) * R;
#pragma unroll
            for (int ai = 0; ai < 2; ++ai)
#pragma unroll
                for (int m = 0; m < 4; ++m) {
                    const int row = row0 + ai * 128 + m * 16;
#pragma unroll
                    for (int bj = 0; bj < 2; ++bj) {
                        const f32x4 v0 = acc[ai][bj][m][0], v1 = acc[ai][bj][m][1];
                        bf16* tp = T + (size_t)(bj * 128) * R + row;
                        tp[0 * (size_t)R] = (bf16)f2bf(v0[0]); tp[1 * (size_t)R] = (bf16)f2bf(v0[1]); tp[2 * (size_t)R] = (bf16)f2bf(v0[2]); tp[3 * (size_t)R] = (bf16)f2bf(v0[3]);
                        tp[4 * (size_t)R] = (bf16)f2bf(v1[0]); tp[5 * (size_t)R] = (bf16)f2bf(v1[1]); tp[6 * (size_t)R] = (bf16)f2bf(v1[2]); tp[7 * (size_t)R] = (bf16)f2bf(v1[3]);
                    }
                }
            return;
        }
        bf16* base; int ldc, colt;
        if (pn < 8) { base = PA; ldc = PA_LD; colt = pn * 256; } else { base = PG; ldc = PG_LD; colt = (pn - 12) * 256; }
        const int col0 = colt + wc * 32 + 8 * fq;
        const bool do_rope = (pn < 2) && (u.pm >= 8);
        const float sc = (pn == 0 || pn == 4 || pn == 5) ? 0.125f : 1.f;
#pragma unroll
        for (int ai = 0; ai < 2; ++ai)
#pragma unroll
            for (int m = 0; m < 4; ++m) {
                const int row = row0 + ai * 128 + m * 16;
                bf16* rowp = base + (size_t)row * ldc + col0;
                f32x4 cs[4];
                if (do_rope) { const int t = (row - NCTX) & (SEQ - 1); const int pos = (wc & 1) ? (t & 63) : (t >> 6);
                    const f32x4* cp = (const f32x4*)(rope + (size_t)(pos * 16 + 8 * (fq & 1)) * 2);
                    cs[0] = cp[0]; cs[1] = cp[1]; cs[2] = cp[2]; cs[3] = cp[3]; }
#pragma unroll
                for (int bj = 0; bj < 2; ++bj) {
                    f32x4 v0 = acc[ai][bj][m][0], v1 = acc[ai][bj][m][1];
                    if (do_rope) {
                        float x[8] = {v0[0], v0[1], v0[2], v0[3], v1[0], v1[1], v1[2], v1[3]};
#pragma unroll
                        for (int e = 0; e < 8; ++e) { const float p = __shfl_xor(x[e], 32); const float c = cs[e >> 1][(e & 1) * 2], s = cs[e >> 1][(e & 1) * 2 + 1];
                            x[e] = (fq < 2) ? (x[e] * c - p * s) : (p * s + x[e] * c); }
                        v0 = (f32x4){x[0], x[1], x[2], x[3]}; v1 = (f32x4){x[4], x[5], x[6], x[7]};
                    }
                    v0 = v0 * sc; v1 = v1 * sc;
                    u32x4 w; w.x = cvt_pk_bf16(v0[0], v0[1]); w.y = cvt_pk_bf16(v0[2], v0[3]); w.z = cvt_pk_bf16(v1[0], v1[1]); w.w = cvt_pk_bf16(v1[2], v1[3]);
                    *(u32x4*)(rowp + bj * 128) = w;
                }
                asm volatile("" ::: "memory");
            }
    }
};
template <int SECOND> struct EpiMerge {
    static constexpr bool PERM = true;
    bf16* MG; const bf16* PG;
    __device__ __forceinline__ void operator()(const f32x4 (&acc)[2][2][4][2], const Unit& u, int wr, int wc, int fr, int fq) const {
        const int row0 = u.pm * 256 + wr * 64 + fr, col0 = u.pn * 256 + wc * 32 + 8 * fq;
#pragma unroll
        for (int ai = 0; ai < 2; ++ai)
#pragma unroll
            for (int m = 0; m < 4; ++m) {
                const int row = row0 + ai * 128 + m * 16;
#pragma unroll
                for (int bj = 0; bj < 2; ++bj) {
                    const int c = col0 + bj * 128;
                    const u32x4 g = *(const u32x4*)(PG + (size_t)row * PG_LD + SECOND * 1024 + c);
                    const f32x4 v0 = acc[ai][bj][m][0], v1 = acc[ai][bj][m][1];
                    float o[8];
                    o[0] = sigmoidf_(bflo(g.x)) * v0[0]; o[1] = sigmoidf_(bfhi(g.x)) * v0[1]; o[2] = sigmoidf_(bflo(g.y)) * v0[2]; o[3] = sigmoidf_(bfhi(g.y)) * v0[3];
                    o[4] = sigmoidf_(bflo(g.z)) * v1[0]; o[5] = sigmoidf_(bfhi(g.z)) * v1[1]; o[6] = sigmoidf_(bflo(g.w)) * v1[2]; o[7] = sigmoidf_(bfhi(g.w)) * v1[3];
                    bf16* mp = MG + (size_t)row * D + c;
                    if (SECOND) { const u32x4 old = *(const u32x4*)mp;
                        o[0] += bflo(old.x); o[1] += bfhi(old.x); o[2] += bflo(old.y); o[3] += bfhi(old.y); o[4] += bflo(old.z); o[5] += bfhi(old.z); o[6] += bflo(old.w); o[7] += bfhi(old.w); }
                    u32x4 w; w.x = cvt_pk_bf16(o[0], o[1]); w.y = cvt_pk_bf16(o[2], o[3]); w.z = cvt_pk_bf16(o[4], o[5]); w.w = cvt_pk_bf16(o[6], o[7]);
                    *(u32x4*)mp = w;
                }
                asm volatile("" ::: "memory");
            }
    }
};
struct EpiRes {
    static constexpr bool PERM = false;
    const float* src_c; const float* src_l; float* dst_c; float* dst_l; const float* mod;
    __device__ __forceinline__ void operator()(const f32x4 (&acc)[2][2][4][2], const Unit& u, int wr, int wc, int fr, int fq) const {
        const bool isctx = u.pm < 8;
        const int slot = isctx ? 8 : ((u.pm - 8) >> 5);
        const float* src = isctx ? src_c : src_l;
        float* dst = isctx ? dst_c : dst_l;
        const int rbase = (isctx ? u.pm * 256 : (u.pm - 8) * 256) + wr * 64 + fr;
        const int col0 = u.pn * 256 + wc * 32 + 4 * fq;
        const float* ga = mod + slot * 6144 + 2048;
        f32x4 gv[2][2];
#pragma unroll
        for (int bj = 0; bj < 2; ++bj)
#pragma unroll
            for (int n = 0; n < 2; ++n) gv[bj][n] = *(const f32x4*)(ga + col0 + bj * 128 + n * 16);
#pragma unroll
        for (int ai = 0; ai < 2; ++ai)
#pragma unroll
            for (int m = 0; m < 4; ++m) {
                const size_t off = (size_t)(rbase + ai * 128 + m * 16) * D + col0;
#pragma unroll
                for (int bj = 0; bj < 2; ++bj)
#pragma unroll
                    for (int n = 0; n < 2; ++n) { const f32x4 x = *(const f32x4*)(src + off + bj * 128 + n * 16); *(f32x4*)(dst + off + bj * 128 + n * 16) = x + gv[bj][n] * acc[ai][bj][m][n]; }
                asm volatile("" ::: "memory");
            }
    }
};
struct EpiF32 {
    static constexpr bool PERM = false;
    float* C; int ldc;
    __device__ __forceinline__ void operator()(const f32x4 (&acc)[2][2][4][2], const Unit& u, int wr, int wc, int fr, int fq) const {
        const int row0 = u.pm * 256 + wr * 64 + fr, col0 = u.pn * 256 + wc * 32 + 4 * fq;
#pragma unroll
        for (int ai = 0; ai < 2; ++ai)
#pragma unroll
            for (int m = 0; m < 4; ++m) { float* rowp = C + (size_t)(row0 + ai * 128 + m * 16) * ldc + col0;
#pragma unroll
                for (int bj = 0; bj < 2; ++bj)
#pragma unroll
                    for (int n = 0; n < 2; ++n) *(f32x4*)(rowp + bj * 128 + n * 16) = acc[ai][bj][m][n]; }
    }
};

__device__ __forceinline__ void p0_transpose_item(const float* W, int K, int N, bf16* WT, int dst_row0, LAS float* scr, int k0, int n0, int lane) {
#pragma unroll 8
    for (int i = 0; i < 32; ++i) { const int kk = 2 * i + (lane >> 5); scr[kk * 33 + (lane & 31)] = W[(size_t)(k0 + kk) * N + n0 + (lane & 31)]; }
    LDS_WAIT(); asm volatile("" ::: "memory");
    const int c = lane & 7;
#pragma unroll
    for (int j = 0; j < 4; ++j) { const int n = (lane >> 3) + 8 * j; const LAS float* s = scr + (8 * c) * 33 + n;
        v4u o; o.x = pk2(s[0 * 33], s[1 * 33]); o.y = pk2(s[2 * 33], s[3 * 33]); o.z = pk2(s[4 * 33], s[5 * 33]); o.w = pk2(s[6 * 33], s[7 * 33]);
        *(v4u*)(WT + (size_t)(dst_row0 + n) * K + k0 + 8 * c) = o; }
    LDS_WAIT(); asm volatile("" ::: "memory");
}
__device__ __forceinline__ int win_map(int n0) {
    if (n0 < 512) return n0;
    if (n0 < 1024) return 2048 + (n0 - 512);
    if (n0 < 1056) return 5120 + (n0 - 1024);
    if (n0 < 1568) return 512 + (n0 - 1056);
    if (n0 < 2080) return 1024 + (n0 - 1568);
    if (n0 < 2592) return 1536 + (n0 - 2080);
    if (n0 < 3104) return 2560 + (n0 - 2592);
    return 3072 + (n0 - 3104);
}

__device__ __forceinline__ void p0_prologue(const Frame& F) {
    CArgsP a = kargs(); unsigned char* const ws = a->ws;
    const int gw = F.vcu * NWAVES + F.wave, NGW = F.G * NWAVES;
    const int gtid = F.vcu * NT + F.tid, GT = F.G * NT;
    {
        LAS float* scr = (LAS float*)(F.lds + F.wave * 16384);
        constexpr int I_IN = 16 * 161, I_P = 8 * 32, I_O = 16 * 32, PER_L = I_IN + 2 * I_P + I_O;
        for (int it = gw; it < DEPTH * PER_L; it += NGW) {
            const int l = it / PER_L; int r = it % PER_L;
            if (r < I_IN) { const int kb = r / 161, nb = r % 161; p0_transpose_item(a->in[I_WIN] + (size_t)l * D * IN_COLS, D, IN_COLS, (bf16*)(ws + WS_WIN) + (size_t)l * NPAD * D, win_map(nb * 32), scr, kb * 64, nb * 32, F.lane); continue; }
            r -= I_IN;
            if (r < I_P) { const int kb = r / 32, nb = r % 32; p0_transpose_item(a->in[I_WPG] + (size_t)l * 512 * D, 512, D, (bf16*)(ws + WS_WPG) + (size_t)l * D * 512, nb * 32, scr, kb * 64, nb * 32, F.lane); continue; }
            r -= I_P;
            if (r < I_P) { const int kb = r / 32, nb = r % 32; p0_transpose_item(a->in[I_WPN] + (size_t)l * 512 * D, 512, D, (bf16*)(ws + WS_WPN) + (size_t)l * D * 512, nb * 32, scr, kb * 64, nb * 32, F.lane); continue; }
            r -= I_P;
            { const int kb = r / 32, nb = r % 32; p0_transpose_item(a->in[I_WO] + (size_t)l * D * D, D, D, (bf16*)(ws + WS_WO) + (size_t)l * D * D, nb * 32, scr, kb * 64, nb * 32, F.lane); }
        }
        constexpr int PADV = (NPAD - IN_COLS) * D / 8;
        for (int i = gtid; i < DEPTH * PADV; i += GT) { const int l = i / PADV, j = i % PADV; *((v4u*)((bf16*)(ws + WS_WIN) + ((size_t)l * NPAD + IN_COLS) * D) + j) = (v4u){0u, 0u, 0u, 0u}; }
    }
    __syncthreads();
    if (gtid < 128 * 16) { const int pos = gtid >> 4, j = gtid & 15; const float freq = powf(10000.f, -(float)j / 16.f); const float ang = (float)pos * freq;
        float* cs = (float*)(ws + WS_ROPE); cs[2 * gtid] = cosf(ang); cs[2 * gtid + 1] = sinf(ang); }
    {
        LAS float* LSK = (LAS float*)F.lds;
        LAS float* LQ = (LAS float*)(F.lds + 128 * 132 * 4);
        for (int unit = F.vcu; unit < DEPTH * 16 * 16; unit += F.G) {
            const int l = unit >> 8, hp = (unit >> 4) & 15, d0 = (unit & 15) * 64;
            const float* sk = a->in[I_SK] + ((size_t)l * 16 + hp) * 16384;
            const float* wq = a->in[I_WQ] + (size_t)l * D * 2048 + hp * 128;
            __syncthreads();
            for (int i = F.tid; i < 16384; i += NT) LSK[(i >> 7) * 132 + (i & 127)] = sk[i];
            for (int i = F.tid; i < 8192; i += NT) LQ[(i >> 7) * 132 + (i & 127)] = wq[(size_t)(d0 + (i >> 7)) * 2048 + (i & 127)];
            __syncthreads();
            const int dd = F.tid & 63, kg = F.tid >> 6;
            float acc[16];
#pragma unroll
            for (int k = 0; k < 16; ++k) acc[k] = 0.f;
            for (int j = 0; j < 128; j += 4) {
                const f32x4 q = *(const LAS f32x4*)(LQ + dd * 132 + j);
#pragma unroll
                for (int k = 0; k < 16; ++k) { const f32x4 s = *(const LAS f32x4*)(LSK + (kg * 16 + k) * 132 + j); acc[k] += q[0] * s[0] + q[1] * s[1] + q[2] * s[2] + q[3] * s[3]; }
            }
            bf16* o = (bf16*)(ws + WS_WS) + ((size_t)l * 2048 + hp * 128 + kg * 16) * D + d0 + dd;
#pragma unroll
            for (int k = 0; k < 16; ++k) o[(size_t)k * D] = (bf16)f2bf(acc[k]);
        }
    }
    __syncthreads();
    {
        LAS float* ca = (LAS float*)F.lds;
        LAS float* red = (LAS float*)(F.lds + 9 * D * 4);
        for (int i = F.tid; i < 9 * D; i += NT) { const float v = i < 8 * D ? a->in[I_C][i] : a->in[I_CCTX][i - 8 * D]; ca[i] = v / (1.f + __expf(-v)); }
        __syncthreads();
        float* MOD = (float*)(ws + WS_MOD);
        for (int unit = F.vcu; unit < DEPTH * 96; unit += F.G) {
            const int l = unit / 96, cb = unit % 96, dc = F.tid >> 6;
            const int col = cb * 64 + (F.tid & 63);
            const float* w = a->in[I_WMOD] + ((size_t)l * D + dc * 128) * 6144 + col;
            float acc[9];
#pragma unroll
            for (int b = 0; b < 9; ++b) acc[b] = 0.f;
#pragma unroll 8
            for (int d = 0; d < 128; ++d) { const float wv = w[(size_t)d * 6144];
#pragma unroll
                for (int b = 0; b < 9; ++b) acc[b] += ca[b * D + dc * 128 + d] * wv; }
#pragma unroll
            for (int b = 0; b < 9; ++b) red[(dc * 9 + b) * 64 + (F.tid & 63)] = acc[b];
            __syncthreads();
            for (int i = F.tid; i < 9 * 64; i += NT) { const int b = i >> 6, c = i & 63; float sum = a->in[I_BMOD][l * 6144 + cb * 64 + c];
#pragma unroll
                for (int k = 0; k < 8; ++k) sum += red[(k * 9 + b) * 64 + c];
                MOD[((size_t)l * 9 + b) * 6144 + cb * 64 + c] = sum; }
            __syncthreads();
        }
    }
    __syncthreads();
}

__device__ __forceinline__ unsigned pk4_fp8(float a, float b, float c, float d) { int p = __builtin_amdgcn_cvt_pk_fp8_f32(a, b, 0, false); p = __builtin_amdgcn_cvt_pk_fp8_f32(c, d, p, true); return (unsigned)p; }
__device__ __forceinline__ void convert_row_fp8(const float* src, unsigned char* dst_tab, float* scale_out, int e, int lane) {
    const f32x4* sp = (const f32x4*)(src + (size_t)e * D) + 4 * lane;
    const f32x4 a0 = sp[0], a1 = sp[1], a2 = sp[2], a3 = sp[3];
    float mx = fmaxf(fmaxf(fmaxf(fabsf(a0[0]), fabsf(a0[1])), fmaxf(fabsf(a0[2]), fabsf(a0[3]))), fmaxf(fmaxf(fabsf(a1[0]), fabsf(a1[1])), fmaxf(fabsf(a1[2]), fabsf(a1[3]))));
    mx = fmaxf(mx, fmaxf(fmaxf(fmaxf(fabsf(a2[0]), fabsf(a2[1])), fmaxf(fabsf(a2[2]), fabsf(a2[3]))), fmaxf(fmaxf(fabsf(a3[0]), fabsf(a3[1])), fmaxf(fabsf(a3[2]), fabsf(a3[3])))));
    mx = fmaxf(wave_max(mx), 1e-30f);
    const float sc = 256.f / mx;
    const v4u w = (v4u){pk4_fp8(a0[0] * sc, a0[1] * sc, a0[2] * sc, a0[3] * sc), pk4_fp8(a1[0] * sc, a1[1] * sc, a1[2] * sc, a1[3] * sc), pk4_fp8(a2[0] * sc, a2[1] * sc, a2[2] * sc, a2[3] * sc), pk4_fp8(a3[0] * sc, a3[1] * sc, a3[2] * sc, a3[3] * sc)};
    *(v4u*)(dst_tab + ((size_t)(lane >> 3) * NEXP + e) * 128 + 16 * (lane & 7)) = w;
    if (lane == 0) scale_out[e] = mx * (1.f / 256.f);
}
__device__ __forceinline__ void convert_experts(const Frame& F, int layer) {
    CArgsP a = kargs(); unsigned char* const ws = a->ws;
    const int gw = F.vcu * NWAVES + F.wave, NGW = F.G * NWAVES;
    const float* su = a->in[I_EU] + (size_t)layer * NEXP * D; const float* sv = a->in[I_EV] + (size_t)layer * NEXP * D;
    for (int e = gw; e < NEXP; e += NGW) { convert_row_fp8(su, ws + WS_EU, (float*)(ws + WS_SU), e, F.lane); convert_row_fp8(sv, ws + WS_EV, (float*)(ws + WS_SV), e, F.lane); }
}

__device__ __forceinline__ void norm_phase(const Frame& F, int layer, int which) {
    CArgsP a = kargs(); unsigned char* const ws = a->ws;
    const int gw = F.vcu * NWAVES + F.wave, NGW = F.G * NWAVES;
    const float* g = (which ? a->in[I_GN2] : a->in[I_GN1]) + layer * D;
    const float* MOD = (const float*)(ws + WS_MOD) + (size_t)layer * 9 * 6144 + (which ? 3072 : 0);
    bf16* H = (bf16*)(ws + WS_H);
    f32x4 gv[4];
#pragma unroll
    for (int j = 0; j < 4; ++j) gv[j] = *((const f32x4*)g + F.lane + 64 * j);
    for (int r = gw; r < R; r += NGW) {
        const float* xr = (which == 0 && layer == 0) ? xrow_in(a, r) : xrow_cur(a, r);
        const float* sh = MOD + row_slot(r) * 6144; const float* sc = sh + D;
        f32x4 v[4]; float ss = 0.f;
#pragma unroll
        for (int j = 0; j < 4; ++j) { v[j] = *((const GAS f32x4*)xr + F.lane + 64 * j); ss += (v[j][0] * v[j][0] + v[j][1] * v[j][1]) + (v[j][2] * v[j][2] + v[j][3] * v[j][3]); }
        const float rs = rsqrtf(wave_sum(ss) * (1.f / D) + EPS);
        unsigned long long* o8 = (unsigned long long*)(H + (size_t)r * D) + F.lane;
        float mx = 0.f;
#pragma unroll
        for (int j = 0; j < 4; ++j) {
            const f32x4 s1 = *((const f32x4*)sc + F.lane + 64 * j), s0 = *((const f32x4*)sh + F.lane + 64 * j);
            const f32x4 y = v[j] * rs * gv[j] * (s1 + 1.f) + s0;
            o8[64 * j] = (unsigned long long)pk2(y[0], y[1]) | ((unsigned long long)pk2(y[2], y[3]) << 32);
            v[j] = y; mx = fmaxf(mx, fmaxf(fmaxf(fabsf(y[0]), fabsf(y[1])), fmaxf(fabsf(y[2]), fabsf(y[3]))));
        }
        if (which) {
            mx = fmaxf(wave_max(mx), 1e-30f); const float q8 = 256.f / mx;
            unsigned* h8 = (unsigned*)(ws + WS_H8 + (size_t)r * D) + F.lane;
#pragma unroll
            for (int j = 0; j < 4; ++j) h8[64 * j] = pk4_fp8(v[j][0] * q8, v[j][1] * q8, v[j][2] * q8, v[j][3] * q8);
            if (F.lane == 0) ((float*)(ws + WS_SX))[r] = mx * (1.f / 256.f);
        }
    }
}

constexpr int GL_TOT = 0, GL_IMG = 4096, GL_PITCH = 144, GL_IMGB = 64 * GL_PITCH, GL_SSX = GL_IMG + 4 * GL_IMGB;
typedef short bf16x8_t __attribute__((ext_vector_type(8)));
__device__ __forceinline__ int chunk_row0(int b, int tc) { return tc < 4 ? b * CTXL + tc * 64 : NCTX + b * SEQ + (tc - 4) * 64; }
__device__ __forceinline__ int chunk_pos(int tc, int dir) { return dir == 0 ? tc : (tc < 4 ? 3 - tc : 135 - tc); }
__device__ __forceinline__ float logsig16(float x) { return (fminf(x, 0.f) - log1pf(__expf(-fabsf(x)))) * (1.f / 16.f); }
__device__ __forceinline__ void gla_scan(const Frame& F, CArgsP a, const float* Z, int layer, int h, int row0, int lz, float (&Bf)[8], float (&Bb)[8], float& endf, float& endb) {
    const float* waf = a->in[I_WAF] + layer * 4096 + h * 64 + F.lane; const float* wab = a->in[I_WAB] + layer * 4096 + h * 64 + F.lane;
    float wf[16], wb[16];
#pragma unroll
    for (int j = 0; j < 16; ++j) { wf[j] = waf[j * 256]; wb[j] = wab[j * 256]; }
    const float baf = a->in[I_BAF][layer * 256 + h * 64 + F.lane], bab = a->in[I_BAB][layer * 256 + h * 64 + F.lane];
    const int t0 = 8 * F.wave;
#pragma unroll
    for (int i = 0; i < 8; ++i) {
        const f32x4* zp = (const f32x4*)(Z + (size_t)(row0 + t0 + i) * 32 + lz);
        float zf = baf, zb = bab;
#pragma unroll
        for (int q = 0; q < 4; ++q) { const f32x4 z0 = zp[q], z1 = zp[4 + q];
            zf += z0[0] * wf[4 * q] + z0[1] * wf[4 * q + 1] + z0[2] * wf[4 * q + 2] + z0[3] * wf[4 * q + 3];
            zb += z1[0] * wb[4 * q] + z1[1] * wb[4 * q + 1] + z1[2] * wb[4 * q + 2] + z1[3] * wb[4 * q + 3]; }
        Bf[i] = logsig16(zf); Bb[i] = logsig16(zb);
    }
#pragma unroll
    for (int i = 1; i < 8; ++i) Bf[i] += Bf[i - 1];
#pragma unroll
    for (int i = 6; i >= 0; --i) Bb[i] += Bb[i + 1];
    LAS float* TOT = (LAS float*)(F.lds + GL_TOT);
    TOT[(0 * 8 + F.wave) * 64 + F.lane] = Bf[7]; TOT[(1 * 8 + F.wave) * 64 + F.lane] = Bb[0];
    __syncthreads();
    float offf = 0.f, offb = 0.f; endf = 0.f; endb = 0.f;
#pragma unroll
    for (int w = 0; w < 8; ++w) { const float tf = TOT[(0 * 8 + w) * 64 + F.lane], tb = TOT[(1 * 8 + w) * 64 + F.lane]; endf += tf; endb += tb; offf += (w < F.wave) ? tf : 0.f; offb += (w > F.wave) ? tb : 0.f; }
#pragma unroll
    for (int i = 0; i < 8; ++i) { Bf[i] += offf; Bb[i] += offb; }
}
__device__ __forceinline__ void gla_a_phase(const Frame& F, int layer) {
    CArgsP a = kargs(); unsigned char* const ws = a->ws;
    const bf16* PA = (const bf16*)(ws + WS_PA); const bf16* VT = (const bf16*)(ws + WS_VT);
    const float* Z = (const float*)(ws + WS_Z); bf16* SST = (bf16*)(ws + WS_H); float* DEC = (float*)(ws + WS_DEC);
    int lz = 0; asm volatile("" : "+v"(lz));
    const int lane = F.lane, l16 = lane & 15, g = lane >> 4, t0 = 8 * F.wave;
    for (int unit = F.vcu; unit < BATCH * 4 * NCHUNK; unit += F.G) {
        const int b = unit / (4 * NCHUNK), h = (unit / NCHUNK) & 3, tc = unit % NCHUNK, row0 = chunk_row0(b, tc);
        float Bf[8], Bb[8], endf, endb;
        gla_scan(F, a, Z, layer, h, row0, lz, Bf, Bb, endf, endb);
        float kk[8];
#pragma unroll
        for (int i = 0; i < 8; ++i) kk[i] = bf1(PA[(size_t)(row0 + t0 + i) * PA_LD + PA_K + h * 64 + lane]);
        float kf[8], kb[8];
#pragma unroll
        for (int i = 0; i < 8; ++i) { kf[i] = kk[i] * __expf(endf - Bf[i]); kb[i] = kk[i] * __expf(endb - Bb[i]); }
        *(LAS v4u*)(F.lds + GL_IMG + 0 * GL_IMGB + lane * GL_PITCH + t0 * 2) = (v4u){pk2(kf[0], kf[1]), pk2(kf[2], kf[3]), pk2(kf[4], kf[5]), pk2(kf[6], kf[7])};
        *(LAS v4u*)(F.lds + GL_IMG + 1 * GL_IMGB + lane * GL_PITCH + t0 * 2) = (v4u){pk2(kb[0], kb[1]), pk2(kb[2], kb[3]), pk2(kb[4], kb[5]), pk2(kb[6], kb[7])};
        const int seq0 = (b * 4 + h) * 2;
        if (F.wave == 0) { DEC[((size_t)(seq0 + 0) * NCHUNK + chunk_pos(tc, 0)) * 64 + lane] = __expf(endf); DEC[((size_t)(seq0 + 1) * NCHUNK + chunk_pos(tc, 1)) * 64 + lane] = __expf(endb); }
        __syncthreads();
        const int dir = F.wave >> 2, ntp = F.wave & 3;
        const LAS unsigned char* img = F.lds + GL_IMG + dir * GL_IMGB;
        bf16x8_t afr[4][2];
#pragma unroll
        for (int mt = 0; mt < 4; ++mt)
#pragma unroll
            for (int kt = 0; kt < 2; ++kt) afr[mt][kt] = *(const LAS bf16x8_t*)(img + (16 * mt + l16) * GL_PITCH + (32 * kt + 8 * g) * 2);
        bf16* slot = SST + ((size_t)(seq0 + dir) * NCHUNK + chunk_pos(tc, dir)) * 8192;
#pragma unroll
        for (int n2 = 0; n2 < 2; ++n2) {
            const int nt = 2 * ntp + n2;
            const bf16* vp = VT + (size_t)(h * 128 + 16 * nt + l16) * R + row0 + 8 * g;
            const bf16x8_t b0 = *(const bf16x8_t*)vp, b1 = *(const bf16x8_t*)(vp + 32);
#pragma unroll
            for (int mt = 0; mt < 4; ++mt) {
                f32x4 acc = (f32x4){0.f, 0.f, 0.f, 0.f};
                acc = __builtin_amdgcn_mfma_f32_16x16x32_bf16(afr[mt][0], b0, acc, 0, 0, 0);
                acc = __builtin_amdgcn_mfma_f32_16x16x32_bf16(afr[mt][1], b1, acc, 0, 0, 0);
                *(v2u*)(slot + (16 * nt + l16) * 64 + 16 * mt + 4 * g) = (v2u){pk2(acc[0], acc[1]), pk2(acc[2], acc[3])};
            }
        }
        __syncthreads();
    }
}
__device__ __forceinline__ void gla_b_phase(const Frame& F, bool dry) {
    CArgsP a = kargs(); unsigned char* const ws = a->ws; const bool wr = !dry || a->pad == 12345;
    bf16* SST = (bf16*)(ws + WS_H); const float* DEC = (const float*)(ws + WS_DEC);
    const int gtid = F.vcu * NT + F.tid, GT = F.G * NT;
    for (int id = gtid; id < 64 * 2048; id += GT) {
        const int seq = id >> 11, e = (id & 2047) * 4, k4 = e & 63;
        float s0 = 0.f, s1 = 0.f, s2 = 0.f, s3 = 0.f;
        bf16* p = SST + (size_t)seq * NCHUNK * 8192 + e; const float* dp = DEC + (size_t)seq * NCHUNK * 64 + k4;
#pragma unroll 4
        for (int c = 0; c < NCHUNK; ++c) {
            const v2u t = *(const v2u*)(p + (size_t)c * 8192); const f32x4 d = *(const f32x4*)(dp + c * 64);
            if (wr) *(v2u*)(p + (size_t)c * 8192) = (v2u){pk2(s0, s1), pk2(s2, s3)};
            s0 = d[0] * s0 + bflo(t.x); s1 = d[1] * s1 + bfhi(t.x); s2 = d[2] * s2 + bflo(t.y); s3 = d[3] * s3 + bfhi(t.y);
        }
    }
}
__device__ __forceinline__ void gla_c_phase(const Frame& F, int layer, bool dry) {
    CArgsP a = kargs(); unsigned char* const ws = a->ws; const bool wr = !dry || a->pad == 12345;
    bf16* PA = (bf16*)(ws + WS_PA); const bf16* VT = (const bf16*)(ws + WS_VT);
    const float* Z = (const float*)(ws + WS_Z); const bf16* SST = (const bf16*)(ws + WS_H);
    int lz = 0; asm volatile("" : "+v"(lz));
    const int lane = F.lane, l16 = lane & 15, g = lane >> 4, t0 = 8 * F.wave;
    const int tt = F.wave & 3, vh = F.wave >> 2;
    LAS float* SSX = (LAS float*)(F.lds + GL_SSX);
    for (int unit = F.vcu; unit < BATCH * 4 * NCHUNK; unit += F.G) {
        const int b = unit / (4 * NCHUNK), h = (unit / NCHUNK) & 3, tc = unit % NCHUNK, row0 = chunk_row0(b, tc);
        float Bf[8], Bb[8], endf, endb;
        gla_scan(F, a, Z, layer, h, row0, lz, Bf, Bb, endf, endb);
#pragma unroll
        for (int i = 0; i < 8; ++i) {
            const bf16* pr = PA + (size_t)(row0 + t0 + i) * PA_LD + h * 64 + lane;
            const float qq = bf1(pr[PA_Q]), kk = bf1(pr[PA_K]);
            const float ef = __expf(Bf[i]), eb = __expf(Bb[i]);
            LAS bf16* ip = (LAS bf16*)(F.lds + GL_IMG + (t0 + i) * GL_PITCH) + lane;
            ip[0] = (bf16)f2bf(qq * ef); ip[GL_IMGB / 2] = (bf16)f2bf(kk / ef); ip[GL_IMGB] = (bf16)f2bf(qq * eb); ip[3 * GL_IMGB / 2] = (bf16)f2bf(kk / eb);
        }
        __syncthreads();
        f32x4 O[4];
#pragma unroll
        for (int mt = 0; mt < 4; ++mt) O[mt] = (f32x4){0.f, 0.f, 0.f, 0.f};
        const int tq = 16 * tt + l16;
#pragma unroll
        for (int dir = 0; dir < 2; ++dir) {
            const LAS unsigned char* Qimg = F.lds + GL_IMG + (2 * dir) * GL_IMGB; const LAS unsigned char* Kimg = Qimg + GL_IMGB;
            bf16x8_t qf[2];
#pragma unroll
            for (int kt = 0; kt < 2; ++kt) qf[kt] = *(const LAS bf16x8_t*)(Qimg + tq * GL_PITCH + (32 * kt + 8 * g) * 2);
            f32x4 P[4];
#pragma unroll
            for (int mt = 0; mt < 4; ++mt) {
                P[mt] = (f32x4){0.f, 0.f, 0.f, 0.f};
#pragma unroll
                for (int kt = 0; kt < 2; ++kt) { const bf16x8_t kf = *(const LAS bf16x8_t*)(Kimg + (16 * mt + l16) * GL_PITCH + (32 * kt + 8 * g) * 2); P[mt] = __builtin_amdgcn_mfma_f32_16x16x32_bf16(kf, qf[kt], P[mt], 0, 0, 0); }
#pragma unroll
                for (int rg = 0; rg < 4; ++rg) { const int tp = 16 * mt + 4 * g + rg; const bool valid = dir == 0 ? (tp <= tq) : (tp >= tq); P[mt][rg] = valid ? P[mt][rg] : 0.f; }
            }
            bf16x8_t pa[2];
#pragma unroll
            for (int k2 = 0; k2 < 2; ++k2) { const v4u w = (v4u){pk2(P[2 * k2][0], P[2 * k2][1]), pk2(P[2 * k2][2], P[2 * k2][3]), pk2(P[2 * k2 + 1][0], P[2 * k2 + 1][1]), pk2(P[2 * k2 + 1][2], P[2 * k2 + 1][3])}; pa[k2] = __builtin_bit_cast(bf16x8_t, w); }
            const bf16* slot = SST + ((size_t)((b * 4 + h) * 2 + dir) * NCHUNK + chunk_pos(tc, dir)) * 8192;
#pragma unroll
            for (int mt = 0; mt < 4; ++mt) {
                const int v = 64 * vh + 16 * mt + l16;
                const bf16* vp = VT + (size_t)(h * 128 + v) * R + row0 + 4 * g;
#pragma unroll
                for (int k2 = 0; k2 < 2; ++k2) { const v2u lo = *(const v2u*)(vp + 32 * k2), hi = *(const v2u*)(vp + 32 * k2 + 16); const v4u w = (v4u){lo.x, lo.y, hi.x, hi.y};
                    O[mt] = __builtin_amdgcn_mfma_f32_16x16x32_bf16(__builtin_bit_cast(bf16x8_t, w), pa[k2], O[mt], 0, 0, 0); }
#pragma unroll
                for (int kt = 0; kt < 2; ++kt) { const bf16x8_t sf = *(const bf16x8_t*)(slot + v * 64 + 32 * kt + 8 * g); O[mt] = __builtin_amdgcn_mfma_f32_16x16x32_bf16(sf, qf[kt], O[mt], 0, 0, 0); }
            }
        }
        float ss = 0.f;
#pragma unroll
        for (int mt = 0; mt < 4; ++mt) ss += (O[mt][0] * O[mt][0] + O[mt][1] * O[mt][1]) + (O[mt][2] * O[mt][2] + O[mt][3] * O[mt][3]);
        ss += __shfl_xor(ss, 16); ss += __shfl_xor(ss, 32);
        if (g == 0) SSX[F.wave * 16 + l16] = ss;
        __syncthreads();
        const float rs = rsqrtf((ss + SSX[(F.wave ^ 4) * 16 + l16]) * (1.f / 128.f) + EPS);
        bf16* rp0 = PA + (size_t)(row0 + tq) * PA_LD + PA_R + h * 128 + 64 * vh + 4 * g;
        const float* gp = a->in[I_GGLA] + layer * 128 + 64 * vh + 4 * g;
#pragma unroll
        for (int mt = 0; mt < 4; ++mt) {
            const f32x4 gg = *(const f32x4*)(gp + 16 * mt); const v2u rr = *(const v2u*)(rp0 + 16 * mt);
            const float r0 = bflo(rr.x), r1 = bfhi(rr.x), r2 = bflo(rr.y), r3 = bfhi(rr.y);
            const float y0 = O[mt][0] * rs * gg[0] * (r0 / (1.f + __expf(-r0))), y1 = O[mt][1] * rs * gg[1] * (r1 / (1.f + __expf(-r1)));
            const float y2 = O[mt][2] * rs * gg[2] * (r2 / (1.f + __expf(-r2))), y3 = O[mt][3] * rs * gg[3] * (r3 / (1.f + __expf(-r3)));
            if (wr) *(v2u*)(rp0 + 16 * mt) = (v2u){pk2(y0, y1), pk2(y2, y3)};
        }
        __syncthreads();
    }
}

__device__ __forceinline__ void na_unit(bf16* PA, const bf16* NVT, const float* rpb_l, int b, int hd, bool lat, int qr, int nt, int lane, bool wr) {
    const int l16 = lane & 15, g = lane >> 4;
    const int latbase = NCTX + b * SEQ, ctxbase = b * CTXL;
    const int tq_row = lat ? latbase + qr * 64 + 16 * nt + l16 : ctxbase + 16 * nt + l16;
    bf16* qp = PA + (size_t)tq_row * PA_LD + PA_NQ + hd * 64;
    bf16x8_t qf[2];
    qf[0] = *(const bf16x8_t*)(qp + 8 * g); qf[1] = *(const bf16x8_t*)(qp + 32 + 8 * g);
    const int qc = 16 * nt + l16, c0 = min(max(qc - 8, 0), 48), r0 = min(max(qr - 4, 0), 120), ct0 = nt < 2 ? 0 : 1;
    const float* rpb = rpb_l + hd * 465;
    float m = -3.0e38f, lsum = 0.f;
    f32x4 O[4];
#pragma unroll
    for (int mt = 0; mt < 4; ++mt) O[mt] = (f32x4){0.f, 0.f, 0.f, 0.f};
    const bf16* kbase = PA + PA_NK + hd * 64 + 8 * g;
    const bf16* vbase = NVT + (size_t)(hd * 64 + l16) * R + 4 * g;
#pragma unroll 1
    for (int grp = lat ? 0 : 6; grp < 10; ++grp) {
        int base[4]; f32x4 S[4];
#pragma unroll
        for (int j = 0; j < 4; ++j) {
            const int ti = grp * 4 + j;
            if (ti < 24) { const int wa = ti / 3, ct = ct0 + ti % 3; base[j] = latbase + (r0 + wa) * 64 + 16 * ct; } else base[j] = ctxbase + (ti - 24) * 16;
            const bf16* kp = kbase + (size_t)(base[j] + l16) * PA_LD;
            const bf16x8_t k0 = *(const bf16x8_t*)kp, k1 = *(const bf16x8_t*)(kp + 32);
            S[j] = (f32x4){0.f, 0.f, 0.f, 0.f};
            S[j] = __builtin_amdgcn_mfma_f32_16x16x32_bf16(k0, qf[0], S[j], 0, 0, 0);
            S[j] = __builtin_amdgcn_mfma_f32_16x16x32_bf16(k1, qf[1], S[j], 0, 0, 0);
        }
        bool valid[4][4];
        float mloc = -3.0e38f;
#pragma unroll
        for (int j = 0; j < 4; ++j) {
            const int ti = grp * 4 + j;
            if (ti < 24) {
                const int wa = ti / 3, ct = ct0 + ti % 3;
                const float* bp = rpb + (r0 + wa - qr + 7) * 31;
#pragma unroll
                for (int rg = 0; rg < 4; ++rg) { const int kc = 16 * ct + 4 * g + rg; valid[j][rg] = (kc >= c0) && (kc <= c0 + 15);
                    const float bias = bp[min(max(kc - qc + 15, 0), 30)]; S[j][rg] = valid[j][rg] ? S[j][rg] + bias : -3.0e38f; }
            } else {
#pragma unroll
                for (int rg = 0; rg < 4; ++rg) valid[j][rg] = true;
            }
            mloc = fmaxf(mloc, fmaxf(fmaxf(S[j][0], S[j][1]), fmaxf(S[j][2], S[j][3])));
        }
        mloc = fmaxf(mloc, __shfl_xor(mloc, 16)); mloc = fmaxf(mloc, __shfl_xor(mloc, 32));
        const float mnew = fmaxf(m, mloc), alpha = __expf(m - mnew);
        m = mnew;
        float psum = 0.f;
#pragma unroll
        for (int j = 0; j < 4; ++j)
#pragma unroll
            for (int rg = 0; rg < 4; ++rg) { const float p = valid[j][rg] ? __expf(S[j][rg] - m) : 0.f; S[j][rg] = p; psum += p; }
        lsum = lsum * alpha + psum;
#pragma unroll
        for (int mt = 0; mt < 4; ++mt) O[mt] = O[mt] * alpha;
#pragma unroll
        for (int k2 = 0; k2 < 2; ++k2) {
            const v4u pw = (v4u){pk2(S[2 * k2][0], S[2 * k2][1]), pk2(S[2 * k2][2], S[2 * k2][3]), pk2(S[2 * k2 + 1][0], S[2 * k2 + 1][1]), pk2(S[2 * k2 + 1][2], S[2 * k2 + 1][3])};
            const bf16x8_t pa = __builtin_bit_cast(bf16x8_t, pw);
#pragma unroll
            for (int mt = 0; mt < 4; ++mt) {
                const bf16* vp = vbase + (size_t)(16 * mt) * R;
                const v2u lo = *(const v2u*)(vp + base[2 * k2]), hi = *(const v2u*)(vp + base[2 * k2 + 1]);
                const v4u vw = (v4u){lo.x, lo.y, hi.x, hi.y};
                O[mt] = __builtin_amdgcn_mfma_f32_16x16x32_bf16(__builtin_bit_cast(bf16x8_t, vw), pa, O[mt], 0, 0, 0);
            }
        }
    }
    lsum += __shfl_xor(lsum, 16); lsum += __shfl_xor(lsum, 32);
    const float inv = 1.f / lsum;
#pragma unroll
    for (int mt = 0; mt < 4; ++mt) if (wr) *(v2u*)(qp + 16 * mt + 4 * g) = (v2u){pk2(O[mt][0] * inv, O[mt][1] * inv), pk2(O[mt][2] * inv, O[mt][3] * inv)};
}
__device__ __forceinline__ void na_unit4(bf16* PA, const bf16* NVT, const float* rpb_l, int b, int hd, bool lat, int qr0, int nt, int lane, bool wr) {
    const int l16 = lane & 15, g = lane >> 4;
    const int latbase = NCTX + b * SEQ, ctxbase = b * CTXL;
    bf16* qp[4]; bf16x8_t qf[4][2];
#pragma unroll
    for (int j = 0; j < 4; ++j) {
        const int row = lat ? latbase + (qr0 + j) * 64 + 16 * nt + l16 : ctxbase + 64 * nt + 16 * j + l16;
        qp[j] = PA + (size_t)row * PA_LD + PA_NQ + hd * 64;
        qf[j][0] = *(const bf16x8_t*)(qp[j] + 8 * g); qf[j][1] = *(const bf16x8_t*)(qp[j] + 32 + 8 * g);
    }
    const int qc = 16 * nt + l16, c0 = min(max(qc - 8, 0), 48), R0 = min(max(qr0 - 4, 0), 120);
    const float* rpb = rpb_l + hd * 465;
    const bf16* kbase = PA + PA_NK + hd * 64 + 8 * g;
    const bf16* vbase = NVT + (size_t)(hd * 64 + l16) * R + 4 * g;
    const int npair = lat ? 30 : 8;
    float mx[4] = {-3.0e38f, -3.0e38f, -3.0e38f, -3.0e38f};
#pragma unroll 1
    for (int pi = lat ? 0 : 22; pi < 30; ++pi) {
        int base0; unsigned jmask = 15u;
        if (pi < 22) { const int wa = pi >> 1, pr = pi & 1, krow = R0 + wa;
            if ((pr == 0 && nt == 3) || (pr == 1 && nt == 0)) continue;
            jmask = 0u;
#pragma unroll
            for (int j = 0; j < 4; ++j) { const int r0j = min(max(qr0 + j - 4, 0), 120); if (krow >= r0j && krow < r0j + 8 && krow <= 127) jmask |= 1u << j; }
            if (jmask == 0u) continue;
            base0 = latbase + min(krow, 127) * 64 + 32 * pr;
        } else base0 = ctxbase + (pi - 22) * 32;
#pragma unroll
        for (int t = 0; t < 2; ++t) {
            const bf16* kp = kbase + (size_t)(base0 + 16 * t + l16) * PA_LD;
            const bf16x8_t k0 = *(const bf16x8_t*)kp, k1 = *(const bf16x8_t*)(kp + 32);
#pragma unroll
            for (int j = 0; j < 4; ++j) if (jmask & (1u << j)) {
                f32x4 S = (f32x4){0.f, 0.f, 0.f, 0.f};
                S = __builtin_amdgcn_mfma_f32_16x16x32_bf16(k0, qf[j][0], S, 0, 0, 0);
                S = __builtin_amdgcn_mfma_f32_16x16x32_bf16(k1, qf[j][1], S, 0, 0, 0);
                mx[j] = fmaxf(mx[j], fmaxf(fmaxf(S[0], S[1]), fmaxf(S[2], S[3])));
            }
        }
    }
#pragma unroll
    for (int j = 0; j < 4; ++j) { mx[j] = fmaxf(mx[j], __shfl_xor(mx[j], 16)); mx[j] = fmaxf(mx[j], __shfl_xor(mx[j], 32)); }
    float ls[4] = {0.f, 0.f, 0.f, 0.f};
    f32x4 O[4][4];
#pragma unroll
    for (int j = 0; j < 4; ++j)
#pragma unroll
        for (int mt = 0; mt < 4; ++mt) O[j][mt] = (f32x4){0.f, 0.f, 0.f, 0.f};
#pragma unroll 1
    for (int pi = lat ? 0 : 22; pi < 30; ++pi) {
        int base0, krow = 0, pr = 0; unsigned jmask = 15u; const bool win = pi < 22;
        if (win) { const int wa = pi >> 1; pr = pi & 1; krow = R0 + wa;
            if ((pr == 0 && nt == 3) || (pr == 1 && nt == 0)) continue;
            jmask = 0u;
#pragma unroll
            for (int j = 0; j < 4; ++j) { const int r0j = min(max(qr0 + j - 4, 0), 120); if (krow >= r0j && krow < r0j + 8 && krow <= 127) jmask |= 1u << j; }
            if (jmask == 0u) continue;
            base0 = latbase + min(krow, 127) * 64 + 32 * pr;
        } else base0 = ctxbase + (pi - 22) * 32;
        bf16x8_t kf[2][2];
#pragma unroll
        for (int t = 0; t < 2; ++t) { const bf16* kp = kbase + (size_t)(base0 + 16 * t + l16) * PA_LD; kf[t][0] = *(const bf16x8_t*)kp; kf[t][1] = *(const bf16x8_t*)(kp + 32); }
        bf16x8_t vf[4];
#pragma unroll
        for (int mt = 0; mt < 4; ++mt) { const bf16* vp = vbase + (size_t)(16 * mt) * R + base0; const v2u lo = *(const v2u*)vp, hi = *(const v2u*)(vp + 16); vf[mt] = __builtin_bit_cast(bf16x8_t, (v4u){lo.x, lo.y, hi.x, hi.y}); }
        bool cv[2][4]; int co[2][4];
#pragma unroll
        for (int t = 0; t < 2; ++t)
#pragma unroll
            for (int rg = 0; rg < 4; ++rg) { const int kc = 32 * pr + 16 * t + 4 * g + rg; cv[t][rg] = !win || ((kc >= c0) && (kc <= c0 + 15)); co[t][rg] = min(max(kc - qc + 15, 0), 30); }
#pragma unroll
        for (int j = 0; j < 4; ++j) if (jmask & (1u << j)) {
            f32x4 S[2];
#pragma unroll
            for (int t = 0; t < 2; ++t) { S[t] = (f32x4){0.f, 0.f, 0.f, 0.f};
                S[t] = __builtin_amdgcn_mfma_f32_16x16x32_bf16(kf[t][0], qf[j][0], S[t], 0, 0, 0);
                S[t] = __builtin_amdgcn_mfma_f32_16x16x32_bf16(kf[t][1], qf[j][1], S[t], 0, 0, 0); }
            const float* bp = rpb + (win ? (krow - (qr0 + j) + 7) * 31 : 0);
            float psum = 0.f;
#pragma unroll
            for (int t = 0; t < 2; ++t)
#pragma unroll
                for (int rg = 0; rg < 4; ++rg) { const float bias = win ? bp[co[t][rg]] : 0.f; const float p = cv[t][rg] ? __expf(S[t][rg] + bias - mx[j]) : 0.f; S[t][rg] = p; psum += p; }
            ls[j] += psum;
            const bf16x8_t pa = __builtin_bit_cast(bf16x8_t, (v4u){pk2(S[0][0], S[0][1]), pk2(S[0][2], S[0][3]), pk2(S[1][0], S[1][1]), pk2(S[1][2], S[1][3])});
#pragma unroll
            for (int mt = 0; mt < 4; ++mt) O[j][mt] = __builtin_amdgcn_mfma_f32_16x16x32_bf16(vf[mt], pa, O[j][mt], 0, 0, 0);
        }
    }
#pragma unroll
    for (int j = 0; j < 4; ++j) {
        float l = ls[j]; l += __shfl_xor(l, 16); l += __shfl_xor(l, 32);
        const float inv = 1.f / l;
#pragma unroll
        for (int mt = 0; mt < 4; ++mt) if (wr) *(v2u*)(qp[j] + 16 * mt + 4 * g) = (v2u){pk2(O[j][mt][0] * inv, O[j][mt][1] * inv), pk2(O[j][mt][2] * inv, O[j][mt][3] * inv)};
    }
}
__device__ __forceinline__ void na_phase(const Frame& F, int layer, bool dry) {
    CArgsP a = kargs(); unsigned char* const ws = a->ws; const bool wr = !dry || a->pad == 12345;
    bf16* PA = (bf16*)(ws + WS_PA); const bf16* NVT = (const bf16*)(ws + WS_NVT);
    const float* rpb_l = a->in[I_RPB] + (size_t)layer * 8 * 465;
    const int gw = F.vcu * NWAVES + F.wave, NGW = F.G * NWAVES;
    for (int u = gw; u < BATCH * 8 * 32 * 4 + BATCH * 8 * 4; u += NGW) {
        if (u < BATCH * 8 * 32 * 4) { const int nt = u & 3, qg = (u >> 2) & 31, hd = (u >> 7) & 7, b = u >> 10; na_unit4(PA, NVT, rpb_l, b, hd, true, 4 * qg, nt, F.lane, wr); }
        else { const int v = u - BATCH * 8 * 32 * 4; const int nt = v & 3, hd = (v >> 2) & 7, b = v >> 5; na_unit4(PA, NVT, rpb_l, b, hd, false, 0, nt, F.lane, wr); }
    }
}

__device__ __forceinline__ float pack_key(float v, int idx) { return __builtin_bit_cast(float, (__builtin_bit_cast(unsigned, v) & ~127u) | (unsigned)idx); }
__device__ __forceinline__ void topk_phase(const Frame& F) {
    CArgsP a = kargs(); unsigned char* const ws = a->ws;
    const int gtid = F.vcu * NT + F.tid, GT = F.G * NT;
    const float* SC = (const float*)(ws + WS_SC);
    int* EI = (int*)(ws + WS_EI); float* EG = (float*)(ws + WS_EG);
    LAS unsigned* myl = (LAS unsigned*)F.lds + F.tid * 9;
    for (int id = gtid; id < R * 8; id += GT) {
        const int r = id >> 3, hd = id & 7;
        const f32x4* sp = (const f32x4*)(SC + (size_t)r * 2048 + hd * 256);
        float t0[16], t1[16];
#pragma unroll
        for (int j = 0; j < 16; ++j) { t0[j] = -3.0e38f; t1[j] = -3.0e38f; }
        for (int i = 0; i < 32; ++i) {
            const f32x4 va = sp[i], vb = sp[32 + i];
#pragma unroll
            for (int e = 0; e < 4; ++e) {
                float x = pack_key(va[e], i * 4 + e), y = pack_key(vb[e], i * 4 + e);
#pragma unroll
                for (int j = 0; j < 16; ++j) { const float tx = fmaxf(t0[j], x); x = fminf(t0[j], x); t0[j] = tx; const float ty = fmaxf(t1[j], y); y = fminf(t1[j], y); t1[j] = ty; }
            }
        }
        float best[16];
#pragma unroll
        for (int j = 0; j < 16; ++j) best[j] = -3.0e38f;
#pragma unroll
        for (int ia = 0; ia < 16; ++ia)
#pragma unroll
            for (int ib = 0; ib < 16; ++ib)
                if ((ia + 1) * (ib + 1) <= 16) {
                    float x = __builtin_bit_cast(float, (__builtin_bit_cast(unsigned, t0[ia] + t1[ib]) & ~255u) | (unsigned)(ia * 16 + ib));
#pragma unroll
                    for (int j = 0; j < 16; ++j) { const float tb = fmaxf(best[j], x); x = fminf(best[j], x); best[j] = tb; }
                }
        {
            unsigned w0[4], w1[4];
#pragma unroll
            for (int q = 0; q < 4; ++q) {
                w0[q] = (__builtin_bit_cast(unsigned, t0[4 * q]) & 127u) | ((__builtin_bit_cast(unsigned, t0[4 * q + 1]) & 127u) << 8) | ((__builtin_bit_cast(unsigned, t0[4 * q + 2]) & 127u) << 16) | ((__builtin_bit_cast(unsigned, t0[4 * q + 3]) & 127u) << 24);
                w1[q] = (__builtin_bit_cast(unsigned, t1[4 * q]) & 127u) | ((__builtin_bit_cast(unsigned, t1[4 * q + 1]) & 127u) << 8) | ((__builtin_bit_cast(unsigned, t1[4 * q + 2]) & 127u) << 16) | ((__builtin_bit_cast(unsigned, t1[4 * q + 3]) & 127u) << 24);
            }
#pragma unroll
            for (int q = 0; q < 4; ++q) { myl[q] = w0[q]; myl[4 + q] = w1[q]; }
            LDS_WAIT();
        }
        int eid[16];
#pragma unroll
        for (int j = 0; j < 16; ++j) { const unsigned code = __builtin_bit_cast(unsigned, best[j]) & 255u; const LAS unsigned char* mb = (const LAS unsigned char*)myl;
            eid[j] = (int)mb[code >> 4] * 128 + (int)mb[16 + (code & 15u)]; }
        LDS_WAIT();
        float sum = 0.f; const float bmax = best[0];
#pragma unroll
        for (int j = 0; j < 16; ++j) { best[j] = __expf(best[j] - bmax); sum += best[j]; }
        const float inv = 1.f / sum;
        v4i* ei = (v4i*)(EI + (size_t)r * 128 + hd * 16); f32x4* eg = (f32x4*)(EG + (size_t)r * 128 + hd * 16);
#pragma unroll
        for (int j = 0; j < 4; ++j) { ei[j] = (v4i){eid[4 * j], eid[4 * j + 1], eid[4 * j + 2], eid[4 * j + 3]}; eg[j] = (f32x4){best[4 * j] * inv, best[4 * j + 1] * inv, best[4 * j + 2] * inv, best[4 * j + 3] * inv}; }
    }
}

__device__ __forceinline__ float gelu_tanh(float x) { const float u = 0.7978845608f * (x + 0.044715f * x * x * x); const float t = 1.f - 2.f / (1.f + __expf(2.f * u)); return 0.5f * x * (1.f + t); }
typedef float f32x2_t __attribute__((ext_vector_type(2)));
__device__ __forceinline__ void peer1_phase(const Frame& F) {
    CArgsP a = kargs(); unsigned char* const ws = a->ws;
    const unsigned char* EU8 = ws + WS_EU; const unsigned char* H8 = ws + WS_H8;
    const int* EI = (const int*)(ws + WS_EI); float* PART = (float*)(ws + WS_PART);
    const int per = F.G >> 3, s = F.vcu / per, rank = F.vcu % per, stride = per * NWAVES;
    const int lane = F.lane, m = lane & 15, g = lane >> 4;
    const unsigned char* tab = EU8 + (size_t)s * NEXP * 128 + 16 * g;
    int r = rank * NWAVES + F.wave;
    int id[2][8];
#pragma unroll
    for (int u = 0; u < 2; ++u)
#pragma unroll
        for (int T = 0; T < 8; ++T) id[u][T] = EI[(size_t)min(r + u * stride, R - 1) * 128 + 16 * T + m];
    for (; r < R; r += 2 * stride) {
        v4u w[2][8][2]; v4u x[2][2];
#pragma unroll
        for (int u = 0; u < 2; ++u) {
            const int ru = min(r + u * stride, R - 1);
            const unsigned char* xp = H8 + (size_t)ru * D + 128 * s + 16 * g;
            x[u][0] = *(const v4u*)xp; x[u][1] = *(const v4u*)(xp + 64);
#pragma unroll
            for (int T = 0; T < 8; ++T) { const unsigned char* wp = tab + (size_t)id[u][T] * 128; w[u][T][0] = *(const v4u*)wp; w[u][T][1] = *(const v4u*)(wp + 64); }
        }
        const int rn = r + 2 * stride;
#pragma unroll
        for (int u = 0; u < 2; ++u)
#pragma unroll
            for (int T = 0; T < 8; ++T) id[u][T] = EI[(size_t)min(rn + u * stride, R - 1) * 128 + 16 * T + m];
#pragma unroll
        for (int u = 0; u < 2; ++u) {
            f32x4 sel = (f32x4){0.f, 0.f, 0.f, 0.f};
#pragma unroll
            for (int T = 0; T < 8; ++T) {
                f32x4 acc = (f32x4){0.f, 0.f, 0.f, 0.f};
                acc = __builtin_amdgcn_mfma_f32_16x16x32_fp8_fp8((long)(((unsigned long long)w[u][T][0].y << 32) | w[u][T][0].x), (long)(((unsigned long long)x[u][0].y << 32) | x[u][0].x), acc, 0, 0, 0);
                acc = __builtin_amdgcn_mfma_f32_16x16x32_fp8_fp8((long)(((unsigned long long)w[u][T][0].w << 32) | w[u][T][0].z), (long)(((unsigned long long)x[u][0].w << 32) | x[u][0].z), acc, 0, 0, 0);
                acc = __builtin_amdgcn_mfma_f32_16x16x32_fp8_fp8((long)(((unsigned long long)w[u][T][1].y << 32) | w[u][T][1].x), (long)(((unsigned long long)x[u][1].y << 32) | x[u][1].x), acc, 0, 0, 0);
                acc = __builtin_amdgcn_mfma_f32_16x16x32_fp8_fp8((long)(((unsigned long long)w[u][T][1].w << 32) | w[u][T][1].z), (long)(((unsigned long long)x[u][1].w << 32) | x[u][1].z), acc, 0, 0, 0);
                sel = (m == T) ? acc : sel;
            }
            const int ru = r + u * stride;
            if (m < 8 && ru < R) *(f32x4*)(PART + ((size_t)s * R + ru) * 128 + 16 * m + 4 * g) = sel;
        }
    }
}
__device__ __forceinline__ void peer_act_phase(const Frame& F) {
    CArgsP a = kargs(); unsigned char* const ws = a->ws;
    const int gtid = F.vcu * NT + F.tid, GT = F.G * NT;
    const float* PART = (const float*)(ws + WS_PART); const int* EI = (const int*)(ws + WS_EI); const float* EG = (const float*)(ws + WS_EG);
    const float* SU = (const float*)(ws + WS_SU); const float* SV = (const float*)(ws + WS_SV); const float* SX = (const float*)(ws + WS_SX);
    float* ACT = (float*)(ws + WS_ACT);
    for (int i = gtid; i < R * 32; i += GT) {
        const int r = i >> 5;
        f32x4 sum = (f32x4){0.f, 0.f, 0.f, 0.f};
#pragma unroll
        for (int q = 0; q < 8; ++q) sum += *(const f32x4*)(PART + (size_t)q * R * 128 + (size_t)i * 4);
        const v4i id = *(const v4i*)(EI + (size_t)i * 4); const f32x4 gt = *(const f32x4*)(EG + (size_t)i * 4);
        const float sx = SX[r];
        f32x4 o;
#pragma unroll
        for (int k = 0; k < 4; ++k) o[k] = gelu_tanh(sum[k] * sx * SU[id[k]]) * gt[k] * SV[id[k]];
        *(f32x4*)(ACT + (size_t)i * 4) = o;
    }
}
__device__ __forceinline__ void peer2_phase(const Frame& F, int layer, bool dry) {
    CArgsP a = kargs(); unsigned char* const ws = a->ws; const bool wr = !dry || a->pad == 12345;
    const unsigned char* EV8 = ws + WS_EV; const int* EI = (const int*)(ws + WS_EI); const float* ACT = (const float*)(ws + WS_ACT);
    const float* MOD = (const float*)(ws + WS_MOD) + (size_t)layer * 9 * 6144 + 5 * D;
    const int per = F.G >> 3, s = F.vcu / per, rank = F.vcu % per, stride = per * NWAVES;
    const int lane = F.lane, part = lane & 7, e8 = lane >> 3;
    const unsigned char* tab = EV8 + (size_t)s * NEXP * 128 + 16 * part;
    const bool b5 = (lane & 32) != 0, b4 = (lane & 16) != 0, b3 = (lane & 8) != 0;
    const int dimoff = 128 * s + 16 * part + (b5 ? 8 : 0) + (b4 ? 4 : 0) + (b3 ? 2 : 0);
    int r = rank * NWAVES + F.wave;
    v4i id4[2][4];
#pragma unroll
    for (int u = 0; u < 2; ++u)
#pragma unroll
        for (int q = 0; q < 4; ++q) id4[u][q] = *(const v4i*)(EI + (size_t)min(r + u * stride, R - 1) * 128 + 16 * e8 + 4 * q);
    for (; r < R; r += 2 * stride) {
        v4u w[2][16]; f32x4 a4[2][4];
#pragma unroll
        for (int u = 0; u < 2; ++u) {
            const int ru = min(r + u * stride, R - 1);
#pragma unroll
            for (int j = 0; j < 16; ++j) w[u][j] = *(const v4u*)(tab + (size_t)id4[u][j >> 2][j & 3] * 128);
#pragma unroll
            for (int q = 0; q < 4; ++q) a4[u][q] = *(const f32x4*)(ACT + (size_t)ru * 128 + 16 * e8 + 4 * q);
        }
        const int rn = r + 2 * stride;
#pragma unroll
        for (int u = 0; u < 2; ++u)
#pragma unroll
            for (int q = 0; q < 4; ++q) id4[u][q] = *(const v4i*)(EI + (size_t)min(rn + u * stride, R - 1) * 128 + 16 * e8 + 4 * q);
#pragma unroll
        for (int u = 0; u < 2; ++u) {
            f32x2_t o[8];
#pragma unroll
            for (int k = 0; k < 8; ++k) o[k] = (f32x2_t){0.f, 0.f};
#pragma unroll
            for (int j = 0; j < 16; ++j) {
                const v4u ww = w[u][j];
                const float av = a4[u][j >> 2][j & 3]; const f32x2_t av2 = (f32x2_t){av, av};
                o[0] += av2 * __builtin_amdgcn_cvt_pk_f32_fp8((int)ww.x, false); o[1] += av2 * __builtin_amdgcn_cvt_pk_f32_fp8((int)ww.x, true);
                o[2] += av2 * __builtin_amdgcn_cvt_pk_f32_fp8((int)ww.y, false); o[3] += av2 * __builtin_amdgcn_cvt_pk_f32_fp8((int)ww.y, true);
                o[4] += av2 * __builtin_amdgcn_cvt_pk_f32_fp8((int)ww.z, false); o[5] += av2 * __builtin_amdgcn_cvt_pk_f32_fp8((int)ww.z, true);
                o[6] += av2 * __builtin_amdgcn_cvt_pk_f32_fp8((int)ww.w, false); o[7] += av2 * __builtin_amdgcn_cvt_pk_f32_fp8((int)ww.w, true);
            }
            f32x2_t v4[4], v2[2], v1;
#pragma unroll
            for (int k = 0; k < 4; ++k) { const f32x2_t snd = b5 ? o[k] : o[k + 4], kp = b5 ? o[k + 4] : o[k]; f32x2_t rc; rc.x = __shfl_xor(snd.x, 32); rc.y = __shfl_xor(snd.y, 32); v4[k] = kp + rc; }
#pragma unroll
            for (int k = 0; k < 2; ++k) { const f32x2_t snd = b4 ? v4[k] : v4[k + 2], kp = b4 ? v4[k + 2] : v4[k]; f32x2_t rc; rc.x = __shfl_xor(snd.x, 16); rc.y = __shfl_xor(snd.y, 16); v2[k] = kp + rc; }
            { const f32x2_t snd = b3 ? v2[0] : v2[1], kp = b3 ? v2[1] : v2[0]; f32x2_t rc; rc.x = __shfl_xor(snd.x, 8); rc.y = __shfl_xor(snd.y, 8); v1 = kp + rc; }
            const int ru = r + u * stride;
            if (ru < R) {
                float* xq = xrow_cur(a, ru) + dimoff;
                const f32x2_t ga = *(const f32x2_t*)(MOD + row_slot(ru) * 6144 + dimoff), xx = *(const f32x2_t*)xq;
                if (wr) *(f32x2_t*)xq = xx + ga * v1;
            }
        }
    }
}

__device__ __forceinline__ void final_phase(const Frame& F) {
    CArgsP a = kargs(); unsigned char* const ws = a->ws;
    const int gw = F.vcu * NWAVES + F.wave, NGW = F.G * NWAVES;
    f32x4 gv[4];
#pragma unroll
    for (int j = 0; j < 4; ++j) gv[j] = *((const f32x4*)a->in[I_GF] + F.lane + 64 * j);
    for (int r = gw; r < NLAT; r += NGW) {
        f32x4* xr = (f32x4*)(a->out + (size_t)r * D) + F.lane;
        f32x4 v[4]; float ss = 0.f;
#pragma unroll
        for (int j = 0; j < 4; ++j) { v[j] = xr[64 * j]; ss += (v[j][0] * v[j][0] + v[j][1] * v[j][1]) + (v[j][2] * v[j][2] + v[j][3] * v[j][3]); }
        const float rs = rsqrtf(wave_sum(ss) * (1.f / D) + EPS);
#pragma unroll
        for (int j = 0; j < 4; ++j) xr[64 * j] = v[j] * rs * gv[j];
    }
}

__global__ void __launch_bounds__(NT, 2) fwd_kernel(Args args) {
    extern __shared__ __attribute__((aligned(16))) unsigned char lds[];
    Frame F;
    F.lds = (LAS unsigned char*)lds;
    F.tid = threadIdx.x; F.lane = F.tid & 63; F.wave = __builtin_amdgcn_readfirstlane(F.tid >> 6);
    F.G = gridDim.x; { const int bx = blockIdx.x; F.vcu = (F.G % 8 == 0) ? (bx % 8) * (F.G / 8) + bx / 8 : bx; }
    volatile LAS unsigned* MISC = (volatile LAS unsigned*)(F.lds + MISC_OFF);
    for (int u = F.tid; u < (LDS_BYTES - LDSCTL_OFF) / 4; u += NT) ((LAS unsigned*)(F.lds + LDSCTL_OFF))[u] = 0u;
    __syncthreads();
    XcdBarrier bar; bar.bar = (unsigned*)(args.ws + WS_CTL) + CW_BAR; bar.x = 0; bar.st = nullptr;
    if (MK_SINGLE) bar = xcd_barrier_post((unsigned*)(args.ws + WS_CTL) + CW_BAR, MISC + 8);
    const int lo = args.ph_lo, hi = args.ph_hi;
#define IN(k) (lo <= (k) && (k) < hi)
#define PF Frame Fp = F; asm volatile("" : "+v"(Fp.tid), "+v"(Fp.lane))
#define SEAM(k) do { if (MK_SINGLE && IN(k) && IN((k) + 1)) { xcd_barrier(bar); } } while (0)

    if (IN(0)) { PF; p0_prologue(Fp); SEAM(0); }

    for (int l = 0; l < DEPTH; ++l) {
        const int pb = 1 + l * NPL;
        if (IN(pb + 0)) { { PF; norm_phase(Fp, l, 0); } { PF; convert_experts(Fp, l); } if (PROBE == 30) { PF; convert_experts(Fp, l); } SEAM(pb + 0); }
        if (IN(pb + 1)) {
            CArgsP ap = kargs(); unsigned char* const ws = ap->ws; bf16* Hb = (bf16*)(ws + WS_H); bf16* PA = (bf16*)(ws + WS_PA); bf16* PG = (bf16*)(ws + WS_PG);
            pg8::Gemm g{Hb, (const bf16*)(ws + WS_WIN) + (size_t)l * NPAD * D, R, NPAD, D, D}; pg8::StaticOrder S; S.init(R, NPAD, F.G, (int)blockIdx.x);
            EpiIn E{PA, PG, (float*)(ws + WS_Z), (const float*)(ws + WS_ROPE), (bf16*)(ws + WS_VT), (bf16*)(ws + WS_NVT)};
            for (int rep = 0; rep < (PROBE == 1 ? 2 : 1); ++rep) pg8::gemm_phase<EpiIn, pg8::StaticOrder, true, true>(F.lds, g, S, E);
            SEAM(pb + 1);
        }
        if (IN(pb + 2)) { { PF; gla_a_phase(Fp, l); } if (PROBE == 2) { PF; gla_a_phase(Fp, l); } if (PROBE == 20) { PF; na_phase(Fp, l, true); } { PF; na_phase(Fp, l, false); } SEAM(pb + 2); }
        if (IN(pb + 3)) { if (PROBE == 3) { PF; gla_b_phase(Fp, true); } { PF; gla_b_phase(Fp, false); } SEAM(pb + 3); }
        if (IN(pb + 4)) { if (PROBE == 4) { PF; gla_c_phase(Fp, l, true); } { PF; gla_c_phase(Fp, l, false); } SEAM(pb + 4); }
        if (IN(pb + 5)) {
            CArgsP ap = kargs(); unsigned char* const ws = ap->ws; bf16* Hb = (bf16*)(ws + WS_H); bf16* PA = (bf16*)(ws + WS_PA); bf16* PG = (bf16*)(ws + WS_PG);
            pg8::StaticOrder S; S.init(R, D, F.G, (int)blockIdx.x);
            for (int rep = 0; rep < (PROBE == 5 ? 2 : 1); ++rep) {
            { pg8::Gemm g{PA + PA_R, (const bf16*)(ws + WS_WPG) + (size_t)l * D * 512, R, D, 512, PA_LD}; EpiMerge<0> E{Hb, PG}; pg8::gemm_phase<EpiMerge<0>, pg8::StaticOrder, true, true>(F.lds, g, S, E); }
            { pg8::Gemm g{PA + PA_NQ, (const bf16*)(ws + WS_WPN) + (size_t)l * D * 512, R, D, 512, PA_LD}; EpiMerge<1> E{Hb, PG}; pg8::gemm_phase<EpiMerge<1>, pg8::StaticOrder, true, true>(F.lds, g, S, E); }
            }
            SEAM(pb + 5);
        }
        if (IN(pb + 6)) {
            CArgsP ap = kargs(); unsigned char* const ws = ap->ws; bf16* Hb = (bf16*)(ws + WS_H);
            pg8::Gemm g{Hb, (const bf16*)(ws + WS_WO) + (size_t)l * D * D, R, D, D, D}; pg8::StaticOrder S; S.init(R, D, F.G, (int)blockIdx.x);
            EpiRes E{l == 0 ? ap->in[I_CTX] : (const float*)(ws + WS_XC), l == 0 ? ap->in[I_X] : (const float*)ap->out, (float*)(ws + WS_XC), ap->out, (const float*)(ws + WS_MOD) + (size_t)l * 9 * 6144};
            pg8::gemm_phase<EpiRes, pg8::StaticOrder, true, true>(F.lds, g, S, E);
            SEAM(pb + 6);
        }
        if (IN(pb + 7)) { if (PROBE == 7) { PF; norm_phase(Fp, l, 1); } { PF; norm_phase(Fp, l, 1); } SEAM(pb + 7); }
        if (IN(pb + 8)) {
            CArgsP ap = kargs(); unsigned char* const ws = ap->ws; bf16* Hb = (bf16*)(ws + WS_H);
            pg8::Gemm g{Hb, (const bf16*)(ws + WS_WS) + (size_t)l * 2048 * D, R, 2048, D, D}; pg8::StaticOrder S; S.init(R, 2048, F.G, (int)blockIdx.x);
            EpiF32 E{(float*)(ws + WS_SC), 2048};
            for (int rep = 0; rep < (PROBE == 8 ? 2 : 1); ++rep) pg8::gemm_phase<EpiF32, pg8::StaticOrder, true, true>(F.lds, g, S, E);
            SEAM(pb + 8);
        }
        if (IN(pb + 9)) { if (PROBE == 9) { PF; topk_phase(Fp); } { PF; topk_phase(Fp); } SEAM(pb + 9); }
        if (IN(pb + 10)) { if (PROBE == 10) { PF; peer1_phase(Fp); } { PF; peer1_phase(Fp); } SEAM(pb + 10); }
        if (IN(pb + 11)) { if (PROBE == 11) { PF; peer_act_phase(Fp); } { PF; peer_act_phase(Fp); } SEAM(pb + 11); }
        if (IN(pb + 12)) { if (PROBE == 12) { PF; peer2_phase(Fp, l, true); } { PF; peer2_phase(Fp, l, false); } SEAM(pb + 12); }
    }
    if (IN(NPHASE - 1)) { PF; final_phase(Fp); }
#undef IN
#undef SEAM
}

extern "C" void kernel_launch(void* const* d_in, const int* in_sizes, int n_in, void* d_out, int out_size, void* d_ws, size_t ws_size, hipStream_t stream) {
    static int grid = 0;
    if (grid == 0) {
        if (n_in != 23 || in_sizes[0] != NLAT * D || out_size != NLAT * D || ws_size < WS_END) { fprintf(stderr, "kernel_launch: unexpected shapes (n_in %d, in0 %d, out %d, ws %zu); nothing launched\n", n_in, n_in > 0 ? in_sizes[0] : -1, out_size, ws_size); grid = -1; return; }
        int dev = 0, cus = 0, per_cu = 0;
        if (hipGetDevice(&dev) != hipSuccess || hipDeviceGetAttribute(&cus, hipDeviceAttributeMultiprocessorCount, dev) != hipSuccess) { grid = -1; return; }
        if (hipFuncSetAttribute((const void*)fwd_kernel, hipFuncAttributeMaxDynamicSharedMemorySize, LDS_BYTES) != hipSuccess) { fprintf(stderr, "kernel_launch: hipFuncSetAttribute failed\n"); grid = -1; return; }
        if (hipOccupancyMaxActiveBlocksPerMultiprocessor(&per_cu, (const void*)fwd_kernel, NT, LDS_BYTES) != hipSuccess || per_cu < 1) { fprintf(stderr, "kernel_launch: occupancy query says %d blocks per CU\n", per_cu); }
        (void)hipGetLastError();
        grid = cus;
    }
    if (grid < 0) return;
    if (hipMemsetAsync((char*)d_ws + WS_CTL, 0, CTL_ZERO_BYTES, stream) != hipSuccess) return;
    Args a{};
    for (int i = 0; i < 23; ++i) a.in[i] = (const float*)d_in[i];
    a.out = (float*)d_out; a.ws = (unsigned char*)d_ws; a.pad = 0;
    if (MK_SINGLE) {
        a.ph_lo = 0; a.ph_hi = NPHASE; a.li = 0;
        hipLaunchKernelGGL(fwd_kernel, dim3(grid), dim3(NT), LDS_BYTES, stream, a);
    } else {
        for (int p = 0; p < NPHASE; ++p) { a.ph_lo = p; a.ph_hi = p + 1; a.li = p; hipLaunchKernelGGL(fwd_kernel, dim3(grid), dim3(NT), LDS_BYTES, stream, a); }
    }
}
```

```cpp
#include <hip/hip_runtime.h>
#include <cstdio>
#include <cstdint>

#ifndef PROBE
#define PROBE 0
#endif
#ifndef MK_SINGLE
#define MK_SINGLE 1
#endif

namespace pg8 {
#define PG8_LAS __attribute__((address_space(3)))
typedef unsigned short bf16_t;
typedef short bf16x8 __attribute__((ext_vector_type(8)));
typedef float f32x4 __attribute__((ext_vector_type(4)));
typedef unsigned u32x4 __attribute__((ext_vector_type(4)));
constexpr int BM = 256, BK = 64, HALF = 128, HTB = HALF * BK * 2, STAGE_BYTES = 8 * HTB, NXCD = 8, WGM = 8;

__host__ __device__ __forceinline__ int lds_byte(int r, int c) { const int st = (r >> 4) * 2 + (c >> 5), rr = r & 15, cc = c & 31, ob = rr * 64 + cc * 2; return st * 1024 + (ob ^ (((ob >> 9) & 1) << 5)); }
__host__ __device__ __forceinline__ void stage_rc(int b, int& R, int& C) { const int st = b / 1024, sb = b % 1024, swz = sb ^ (((sb >> 9) & 1) << 5); R = (st >> 1) * 16 + swz / 64; C = (st & 1) * 32 + (swz % 64) / 2; }
__host__ __device__ __forceinline__ int perm32(int rho) { const int n = rho >> 4, i = rho & 15; return 8 * (i >> 2) + 4 * n + (i & 3); }

struct Unit { int pm, pn; };
struct Gemm { const bf16_t* A; const bf16_t* Bt; int M, N, K, lda; };

struct StaticOrder {
    int nM, nN, nwg, G, c;
    __host__ __device__ void init(int M, int N, int G_, int c_) { nM = M / BM; nN = N / BM; nwg = nM * nN; G = G_; c = c_; }
    __host__ __device__ bool next(int i, Unit& u) const {
        const long L = (long)i * G + c; if (L >= nwg) return false;
        int wgid = (int)L; { const int q = nwg / NXCD, r = nwg % NXCD, xcd = wgid % NXCD, off = wgid / NXCD; wgid = (xcd < r ? xcd * (q + 1) : r * (q + 1) + (xcd - r) * q) + off; }
        const int nig = WGM * nN, gid = wgid / nig, fm = gid * WGM, gsz = (nM - fm) < WGM ? (nM - fm) : WGM;
        u.pm = fm + ((wgid % nig) % gsz); u.pn = (wgid % nig) / gsz; return true;
    }
    __device__ __forceinline__ void a_ready(const Unit&) const {}
    __device__ __forceinline__ void done(const Unit&) const {}
};
struct ShiftOrder : StaticOrder { int pm0; __host__ __device__ bool next(int i, Unit& u) const { if (!StaticOrder::next(i, u)) return false; u.pm += pm0; return true; } };

__device__ __forceinline__ unsigned cvt_pk_bf16(float lo, float hi) { unsigned r; asm volatile("v_cvt_pk_bf16_f32 %0, %1, %2" : "=v"(r) : "v"(lo), "v"(hi)); return r; }

template <class Epi, class Sched, bool ALIGN_EPI = false, bool SP2 = false>
__device__ __forceinline__ void gemm_phase(PG8_LAS unsigned char* lds, const Gemm g, const Sched& S, const Epi& E) {
    int tid_ = threadIdx.x; asm volatile("" : "+v"(tid_));
    const int tid = tid_, wid = __builtin_amdgcn_readfirstlane(tid >> 6), lane = tid & 63, wr = wid >> 2, wc = wid & 3, fr = lane & 15, fq = lane >> 4;
    const int K = g.K, nt = K / BK, lda = g.lda;
    unsigned voffA[2], voffB[2];
#pragma unroll
    for (int i = 0; i < 2; ++i) { int R, C; stage_rc(tid * 16 + i * 8192, R, C); const int Rb = Epi::PERM ? ((R & ~31) + perm32(R & 31)) : R;
        voffA[i] = (unsigned)(R * lda + C) * 2u; voffB[i] = (unsigned)(Rb * K + C) * 2u; }
    const size_t kstep = (size_t)(BK * 2);
    const size_t hstepA = (size_t)HALF * lda * 2, hstepB = (size_t)HALF * K * 2;
    const size_t tstepA = 2 * hstepA, tstepB = 2 * hstepB;
    const unsigned ldsw = (unsigned)wid * 1024u;
    const int aoff = lds_byte(wr * 64 + fr, fq * 8), boff = lds_byte(wc * 32 + fr, fq * 8);
#define PG8_SA(b, h) (((b) * 2 + (h)) * HTB)
#define PG8_SB(b, h) ((4 + (b) * 2 + (h)) * HTB)
#define PG8_STAGE(bufoff, gbase, voff) do { _Pragma("unroll") for (int _i = 0; _i < 2; ++_i) \
        __builtin_amdgcn_global_load_lds((const unsigned*)((const char*)(gbase) + (voff)[_i]), (PG8_LAS unsigned*)(lds + (bufoff) + ldsw + _i * 8192), 16, 0, 0); } while (0)
#define PG8_LDA(dst, b, h) do { _Pragma("unroll") for (int m = 0; m < 4; ++m) _Pragma("unroll") for (int k = 0; k < 2; ++k) dst[m][k] = *(const PG8_LAS bf16x8*)(lds + PG8_SA(b, h) + aoff + m * 2048 + k * 1024); } while (0)
#define PG8_LDB(dst, b, h) do { _Pragma("unroll") for (int n = 0; n < 2; ++n) _Pragma("unroll") for (int k = 0; k < 2; ++k) dst[n][k] = *(const PG8_LAS bf16x8*)(lds + PG8_SB(b, h) + boff + n * 2048 + k * 1024); } while (0)
#define PG8_MMA(ai, bj, At, Bt) do { __builtin_amdgcn_s_setprio(1); _Pragma("unroll") for (int m = 0; m < 4; ++m) _Pragma("unroll") for (int n = 0; n < 2; ++n) _Pragma("unroll") for (int k = 0; k < 2; ++k) \
        acc[ai][bj][m][n] = __builtin_amdgcn_mfma_f32_16x16x32_bf16(Bt[n][k], At[m][k], acc[ai][bj][m][n], 0, 0, 0); __builtin_amdgcn_s_setprio(0); } while (0)
#define PG8_WAIT_V(n) asm volatile("s_waitcnt vmcnt(" #n ")" ::: "memory")
#define PG8_WAIT_L(n) asm volatile("s_waitcnt lgkmcnt(" #n ")" ::: "memory")
#define PG8_BAR __builtin_amdgcn_s_barrier()
#define PG8_SCHED __builtin_amdgcn_sched_barrier(0)
    Unit cur, nxt; int ui = 0;
    if (!S.next(0, cur)) return;
    f32x4 acc[2][2][4][2];
#pragma unroll
    for (int a = 0; a < 2; ++a)
#pragma unroll
        for (int b = 0; b < 2; ++b)
#pragma unroll
            for (int m = 0; m < 4; ++m)
#pragma unroll
                for (int n = 0; n < 2; ++n) acc[a][b][m][n] = (f32x4){0.f, 0.f, 0.f, 0.f};
    bf16x8 At[4][2], B0[2][2], B1[2][2];
    const char* cA = (const char*)g.A + (size_t)cur.pm * tstepA; const char* cB = (const char*)g.Bt + (size_t)cur.pn * tstepB;
    S.a_ready(cur);
    if constexpr (SP2) {
        PG8_STAGE(PG8_SB(0, 0), cB, voffB); PG8_STAGE(PG8_SB(0, 1), cB + hstepB, voffB); PG8_STAGE(PG8_SA(0, 0), cA, voffA); PG8_STAGE(PG8_SA(0, 1), cA + hstepA, voffA);
        if (wr == 1) PG8_BAR;
        PG8_WAIT_V(2); PG8_BAR;
        PG8_STAGE(PG8_SB(1, 0), cB + kstep, voffB); PG8_STAGE(PG8_SA(1, 0), cA + kstep, voffA); PG8_STAGE(PG8_SB(1, 1), cB + hstepB + kstep, voffB);
        PG8_WAIT_V(6); PG8_BAR;
    } else {
        PG8_STAGE(PG8_SB(0, 0), cB, voffB); PG8_STAGE(PG8_SA(0, 0), cA, voffA); PG8_STAGE(PG8_SB(0, 1), cB + hstepB, voffB); PG8_STAGE(PG8_SA(0, 1), cA + hstepA, voffA);
        if (wr == 1) PG8_BAR;
        PG8_WAIT_V(4); PG8_BAR;
        PG8_STAGE(PG8_SB(1, 0), cB + kstep, voffB); PG8_STAGE(PG8_SA(1, 0), cA + kstep, voffA); PG8_STAGE(PG8_SB(1, 1), cB + hstepB + kstep, voffB);
        PG8_WAIT_V(6); PG8_BAR;
    }
    for (;;) {
        const bool has_next = S.next(ui + 1, nxt);
        const char* nA = has_next ? (const char*)g.A + (size_t)nxt.pm * tstepA : cA; const char* nB = has_next ? (const char*)g.Bt + (size_t)nxt.pn * tstepB : cB;
        for (int t = 0; t < nt; t += 2) {
            const bool last = (t == nt - 2);
            const char* a1 = cA + (size_t)(t + 1) * kstep;
            const char* a2 = last ? nA : cA + (size_t)(t + 2) * kstep; const char* b2 = last ? nB : cB + (size_t)(t + 2) * kstep;
            const char* a3 = a2 + kstep; const char* b3 = b2 + kstep;
            if (last && has_next) S.a_ready(nxt);
            if constexpr (SP2) {
            PG8_LDB(B0, 0, 0); PG8_LDB(B1, 0, 1); PG8_SCHED; PG8_LDA(At, 0, 0); PG8_STAGE(PG8_SA(1, 1), a1 + hstepA, voffA);
            PG8_WAIT_V(8); PG8_WAIT_L(0); PG8_BAR; PG8_MMA(0, 0, At, B0); PG8_MMA(0, 1, At, B1); PG8_BAR; PG8_SCHED;
            PG8_LDA(At, 0, 1); PG8_STAGE(PG8_SB(0, 0), b2, voffB); PG8_STAGE(PG8_SB(0, 1), b2 + hstepB, voffB); PG8_STAGE(PG8_SA(0, 0), a2, voffA);
            PG8_WAIT_V(8); PG8_WAIT_L(0); PG8_BAR; PG8_MMA(1, 0, At, B0); PG8_MMA(1, 1, At, B1); PG8_BAR; PG8_SCHED;
            PG8_LDB(B0, 1, 0); PG8_LDB(B1, 1, 1); PG8_SCHED; PG8_LDA(At, 1, 0); PG8_STAGE(PG8_SA(0, 1), a2 + hstepA, voffA);
            PG8_WAIT_V(8); PG8_WAIT_L(0); PG8_BAR; PG8_MMA(0, 0, At, B0); PG8_MMA(0, 1, At, B1); PG8_BAR; PG8_SCHED;
            PG8_LDA(At, 1, 1); PG8_STAGE(PG8_SB(1, 0), b3, voffB); PG8_STAGE(PG8_SB(1, 1), b3 + hstepB, voffB); PG8_STAGE(PG8_SA(1, 0), a3, voffA);
            PG8_WAIT_V(8); PG8_WAIT_L(0); PG8_BAR; PG8_MMA(1, 0, At, B0); PG8_MMA(1, 1, At, B1); PG8_BAR; PG8_SCHED;
            } else {
            PG8_LDB(B0, 0, 0); PG8_SCHED; PG8_LDA(At, 0, 0); PG8_STAGE(PG8_SA(1, 1), a1 + hstepA, voffA);
            PG8_WAIT_L(8); PG8_BAR; PG8_WAIT_L(0); PG8_MMA(0, 0, At, B0); PG8_BAR; PG8_SCHED;
            PG8_LDB(B1, 0, 1); PG8_STAGE(PG8_SB(0, 0), b2, voffB);
            PG8_BAR; PG8_WAIT_L(0); PG8_MMA(0, 1, At, B1); PG8_BAR;
            PG8_LDA(At, 0, 1); PG8_STAGE(PG8_SA(0, 0), a2, voffA);
            PG8_BAR; PG8_WAIT_L(0); PG8_MMA(1, 0, At, B0); PG8_BAR; PG8_SCHED;
            PG8_STAGE(PG8_SB(0, 1), b2 + hstepB, voffB);
            PG8_WAIT_V(6); PG8_BAR; PG8_MMA(1, 1, At, B1); PG8_BAR;
            PG8_LDB(B0, 1, 0); PG8_SCHED; PG8_LDA(At, 1, 0); PG8_STAGE(PG8_SA(0, 1), a2 + hstepA, voffA);
            PG8_WAIT_L(8); PG8_BAR; PG8_WAIT_L(0); PG8_MMA(0, 0, At, B0); PG8_BAR; PG8_SCHED;
            PG8_LDB(B1, 1, 1); PG8_STAGE(PG8_SB(1, 0), b3, voffB);
            PG8_BAR; PG8_WAIT_L(0); PG8_MMA(0, 1, At, B1); PG8_BAR;
            PG8_LDA(At, 1, 1); PG8_STAGE(PG8_SA(1, 0), a3, voffA);
            PG8_BAR; PG8_WAIT_L(0); PG8_MMA(1, 0, At, B0); PG8_BAR; PG8_SCHED;
            PG8_STAGE(PG8_SB(1, 1), b3 + hstepB, voffB);
            PG8_WAIT_V(6); PG8_BAR; PG8_MMA(1, 1, At, B1); PG8_BAR;
            }
        }
        if constexpr (ALIGN_EPI) { if (wr == 0) PG8_BAR; }
        E(acc, cur, wr, wc, fr, fq); S.done(cur);
        if (!has_next) break;
#pragma unroll
        for (int a = 0; a < 2; ++a)
#pragma unroll
            for (int b = 0; b < 2; ++b)
#pragma unroll
                for (int m = 0; m < 4; ++m)
#pragma unroll
                    for (int n = 0; n < 2; ++n) acc[a][b][m][n] = (f32x4){0.f, 0.f, 0.f, 0.f};
        cur = nxt; cA = nA; cB = nB; ++ui;
        if constexpr (ALIGN_EPI) { if (wr == 1) PG8_BAR; }
    }
    PG8_WAIT_V(0);
    if constexpr (!ALIGN_EPI) { if (wr == 0) PG8_BAR; }
    PG8_BAR;
#undef PG8_SA
#undef PG8_SB
#undef PG8_STAGE
#undef PG8_LDA
#undef PG8_LDB
#undef PG8_MMA
#undef PG8_WAIT_V
#undef PG8_WAIT_L
#undef PG8_BAR
#undef PG8_SCHED
}
}

constexpr int D = 1024, BATCH = 8, SEQ = 8192, DEPTH = 4, CTXL = 256, GRIDW = 64;
constexpr int NCTX = BATCH * CTXL;
constexpr int NLAT = BATCH * SEQ;
constexpr int R = NCTX + NLAT;
constexpr int IN_COLS = 5152, NPAD = 5376;
constexpr int PA_LD = 2048, PG_LD = 2048;
constexpr int PA_Q = 0, PA_K = 256, PA_R = 512, PA_NQ = 1024, PA_NK = 1536;
constexpr int NCHUNK = 132;
constexpr int NEXP = 16384;
constexpr float EPS = 1e-6f;
constexpr int NWAVES = 8, NT = 512;
constexpr int NPL = 13;
constexpr int NPHASE = 1 + DEPTH * NPL + 1;

constexpr size_t MiB = 1u << 20;
constexpr size_t WS_CTL = 0, CTL_ZERO_BYTES = 2 * MiB;
constexpr size_t WS_MOD = 1 * MiB;
constexpr size_t WS_ROPE = 2 * MiB;
constexpr size_t WS_WIN = 3 * MiB;
constexpr size_t WS_WPG = 45 * MiB, WS_WPN = 49 * MiB;
constexpr size_t WS_WO = 53 * MiB;
constexpr size_t WS_WS = 61 * MiB;
constexpr size_t WS_XC = 77 * MiB;
constexpr size_t WS_Z = 85 * MiB;
constexpr size_t WS_EU = 94 * MiB, WS_EV = 110 * MiB;
constexpr size_t WS_SU = 126 * MiB, WS_SV = WS_SU + 65536, WS_SX = WS_SV + 65536;
constexpr size_t WS_H8 = 884 * MiB;
constexpr size_t WS_PART = 290 * MiB;
constexpr size_t WS_ACT = 554 * MiB;
constexpr size_t WS_H = 158 * MiB;
constexpr size_t WS_PA = 290 * MiB;
constexpr size_t WS_VT = 554 * MiB, WS_NVT = 620 * MiB;
constexpr size_t WS_DEC = 950 * MiB;
constexpr size_t WS_PG = 686 * MiB;
constexpr size_t WS_SC = 290 * MiB;
constexpr size_t WS_EI = 818 * MiB, WS_EG = 851 * MiB;
constexpr size_t WS_END = 953 * MiB;
static_assert(WS_SC + (size_t)R * 2048 * 4 <= WS_EI && WS_EG + (size_t)R * 128 * 4 <= WS_DEC && WS_PG + (size_t)R * PG_LD * 2 <= WS_DEC && WS_DEC + 64 * 132 * 64 * 4 <= WS_END, "ws map");
static_assert(WS_H + (size_t)R * 1024 * 2 <= WS_PA && WS_PA + (size_t)R * PA_LD * 2 <= WS_VT && WS_VT + (size_t)R * 512 * 2 <= WS_NVT && WS_NVT + (size_t)R * 512 * 2 <= WS_PG && WS_Z + (size_t)R * 32 * 4 <= WS_EU, "ws map");
constexpr int CW_BAR = 4096;

constexpr int RING_BYTES = 131072, LDSCTL_OFF = RING_BYTES, MISC_OFF = LDSCTL_OFF + 320, LDS_BYTES = 147456;

#define GAS __attribute__((address_space(1)))
#define LAS __attribute__((address_space(3)))
typedef unsigned short bf16;
typedef unsigned v4u __attribute__((ext_vector_type(4)));
typedef unsigned v2u __attribute__((ext_vector_type(2)));
typedef int v4i __attribute__((ext_vector_type(4)));
typedef float f32x4 __attribute__((ext_vector_type(4)));
typedef __bf16 bf16x2_t __attribute__((ext_vector_type(2)));
#define LDS_WAIT() asm volatile("s_waitcnt lgkmcnt(0)" ::: "memory")
#define VM_WAIT() asm volatile("s_waitcnt vmcnt(0)" ::: "memory")
__device__ __forceinline__ unsigned f2bf(float f) { unsigned u = __builtin_bit_cast(unsigned, f); return (u + 0x7fffu + ((u >> 16) & 1u)) >> 16; }
__device__ __forceinline__ unsigned pk2(float lo, float hi) { return f2bf(lo) | (f2bf(hi) << 16); }
__device__ __forceinline__ float bflo(unsigned w) { return __builtin_bit_cast(float, w << 16); }
__device__ __forceinline__ float bfhi(unsigned w) { return __builtin_bit_cast(float, w & 0xffff0000u); }
__device__ __forceinline__ float bf1(bf16 h) { return __builtin_bit_cast(float, ((unsigned)h) << 16); }
__device__ __forceinline__ float dot2(unsigned a, unsigned b, float acc) { return __builtin_amdgcn_fdot2_f32_bf16(__builtin_bit_cast(bf16x2_t, a), __builtin_bit_cast(bf16x2_t, b), acc, false); }
__device__ __forceinline__ float shx(float v, int mask, int lane) { return __builtin_bit_cast(float, __builtin_amdgcn_ds_bpermute((lane ^ mask) << 2, __builtin_bit_cast(int, v))); }
__device__ __forceinline__ float wave_sum(float v, int lane) {
#pragma unroll
    for (int o = 1; o < 64; o <<= 1) v += shx(v, o, lane);
    return v;
}
__device__ __forceinline__ float wave_max(float v, int lane) {
#pragma unroll
    for (int o = 1; o < 64; o <<= 1) v = fmaxf(v, shx(v, o, lane));
    return v;
}
__device__ __forceinline__ float sigmoidf_(float x) { return __builtin_amdgcn_rcpf(1.f + __expf(-x)); }

#define XB_TMO      128
#define XB_XCNT(j)  (256  + 64 * (j))
#define XB_XSUB(j)  (1280 + 64 * (j))
#define XB_XGEN(j)  (2304 + 64 * (j))
#define XB_TOP      3328
#define XB_TOPGEN   3392
#define XCD_BAR_WORDS 3456
#define XB_SPIN_CAP (1u << 18)
__device__ __forceinline__ unsigned xb_ld(unsigned* p)              { return __hip_atomic_load(p, __ATOMIC_RELAXED, __HIP_MEMORY_SCOPE_AGENT); }
__device__ __forceinline__ unsigned xb_add(unsigned* p, unsigned v) { return __hip_atomic_fetch_add(p, v, __ATOMIC_RELAXED, __HIP_MEMORY_SCOPE_AGENT); }
__device__ __forceinline__ unsigned xb_xcc_id() { return (unsigned)__builtin_amdgcn_s_getreg((3 << 11) | 20) & 0xFu; }
#define XB_SPIN(cond, bar) do { unsigned _sp = 0; while (cond) { __builtin_amdgcn_s_sleep(1); \
    if ((++_sp & 255u) == 0u) { if (xb_ld(&(bar)[XB_TMO])) break; if (_sp > XB_SPIN_CAP) { atomicAdd(&(bar)[XB_TMO], 1u); break; } } } } while (0)
struct XcdBarrier { unsigned* bar; unsigned x; volatile LAS unsigned* st; };
__device__ __forceinline__ XcdBarrier xcd_barrier_post(unsigned* bar, volatile LAS unsigned* st) {
    XcdBarrier b; b.bar = bar; b.x = xb_xcc_id(); b.st = st;
    if (threadIdx.x == 0) (void)xb_add(&bar[XB_XCNT(b.x)], 1u);
    return b;
}
__device__ __forceinline__ void xcd_barrier_complete(unsigned* bar, unsigned x, unsigned& nloc, unsigned& nx) {
    const unsigned G = gridDim.x * gridDim.y * gridDim.z;
    unsigned sum, cnt, mine, sp = 0u;
    for (;;) {
        sum = 0u; cnt = 0u; mine = 0u;
#pragma unroll
        for (unsigned j = 0; j < 16; ++j) { const unsigned c = xb_ld(&bar[XB_XCNT(j)]); sum += c; cnt += (c > 0u) ? 1u : 0u; mine = (j == x) ? c : mine; }
        if (sum == G) break;
        __builtin_amdgcn_s_sleep(1);
        if ((++sp & 255u) == 0u) { if (xb_ld(&bar[XB_TMO])) break; if (sp > XB_SPIN_CAP) { atomicAdd(&bar[XB_TMO], 1u); break; } }
    }
    nloc = mine > 0u ? mine : 1u; nx = cnt > 0u ? cnt : 1u;
}
__device__ __forceinline__ void xcd_barrier(const XcdBarrier& b) {
    asm volatile("s_waitcnt vmcnt(0)" ::: "memory");
    __syncthreads();
    int tid0_ = threadIdx.x; asm volatile("" : "+v"(tid0_));
    if (tid0_ == 0) {
        unsigned* bar = b.bar;
        __builtin_amdgcn_s_waitcnt(0);
        unsigned nloc = b.st[0], nx = b.st[1];
        if (nloc == 0u) { xcd_barrier_complete(bar, b.x, nloc, nx); b.st[0] = nloc; b.st[1] = nx; }
        const unsigned old = xb_add(&bar[XB_XSUB(b.x)], 1u);
        const unsigned gen = old / nloc;
        if (old + 1u == (gen + 1u) * nloc) {
            __builtin_amdgcn_fence(__ATOMIC_RELEASE, "agent");
            asm volatile("s_waitcnt vmcnt(0)" ::: "memory");
            const unsigned og = xb_add(&bar[XB_TOP], 1u);
            const unsigned tg = og / nx;
            if (og + 1u == (tg + 1u) * nx) xb_add(&bar[XB_TOPGEN], 1u);
            else XB_SPIN(xb_ld(&bar[XB_TOPGEN]) == tg, bar);
            __builtin_amdgcn_fence(__ATOMIC_ACQUIRE, "agent");
            xb_add(&bar[XB_XGEN(b.x)], 1u);
            asm volatile("s_waitcnt vmcnt(0)" ::: "memory");
        } else {
            XB_SPIN(xb_ld(&bar[XB_XGEN(b.x)]) == gen, bar);
            __builtin_amdgcn_fence(__ATOMIC_ACQUIRE, "agent");
            asm volatile("s_waitcnt vmcnt(0)" ::: "memory");
        }
    }
    __syncthreads();
}

struct Args { const float* in[23]; float* out; unsigned char* ws; int ph_lo, ph_hi, li, pad; };
enum { I_X = 0, I_C, I_CTX, I_CCTX, I_WMOD, I_BMOD, I_GN1, I_WIN, I_WAF, I_BAF, I_WAB, I_BAB, I_GGLA, I_RPB, I_WPG, I_WPN, I_WO, I_GN2, I_WQ, I_SK, I_EU, I_EV, I_GF };

struct Frame {
    LAS unsigned char* lds;
    int tid, lane, wave, vcu, G;
};
typedef const __attribute__((address_space(4))) Args* CArgsP;
__device__ __forceinline__ CArgsP kargs() { CArgsP p = (CArgsP)__builtin_amdgcn_kernarg_segment_ptr(); asm volatile("" : "+s"(p)); return p; }
__device__ __forceinline__ const float* xrow_in(CArgsP a, int r) { return r < NCTX ? a->in[I_CTX] + (size_t)r * D : a->in[I_X] + (size_t)(r - NCTX) * D; }
__device__ __forceinline__ float* xrow_cur(CArgsP a, int r) { return r < NCTX ? (float*)(a->ws + WS_XC) + (size_t)r * D : a->out + (size_t)(r - NCTX) * D; }
__device__ __forceinline__ int row_slot(int r) { return r < NCTX ? 8 : ((r - NCTX) >> 13); }

using pg8::f32x4; using pg8::u32x4; using pg8::Unit; using pg8::cvt_pk_bf16;
struct EpiIn {
    static constexpr bool PERM = true;
    bf16* PA; bf16* PG; float* Z; const float* rope; bf16* VT; bf16* NVT;
    __device__ __forceinline__ void operator()(const f32x4 (&acc)[2][2][4][2], const Unit& u, int wr, int wc, int fr, int fq) const {
        const int pn = u.pn, row0 = u.pm * 256 + wr * 64 + fr;
        if (pn == 20) {
            if (wc == 0) {
#pragma unroll
                for (int ai = 0; ai < 2; ++ai)
#pragma unroll
                    for (int m = 0; m < 4; ++m) { float* zp = Z + (size_t)(row0 + ai * 128 + m * 16) * 32 + 8 * fq; *(f32x4*)zp = acc[ai][0][m][0]; *(f32x4*)(zp + 4) = acc[ai][0][m][1]; }
            }
            return;
        }
        if (pn >= 8 && pn < 12) {
            bf16* T = (pn < 10 ? VT : NVT) + (size_t)(((pn - 8) & 1) * 256 + wc * 32 + 8 * fq) * R;
#pragma unroll
            for (int ai = 0; ai < 2; ++ai)
#pragma unroll
                for (int m = 0; m < 4; ++m) {
                    const int row = row0 + ai * 128 + m * 16;
#pragma unroll
                    for (int bj = 0; bj < 2; ++bj) {
                        const f32x4 v0 = acc[ai][bj][m][0], v1 = acc[ai][bj][m][1];
                        bf16* tp = T + (size_t)(bj * 128) * R + row;
                        tp[0 * (size_t)R] = (bf16)f2bf(v0[0]); tp[1 * (size_t)R] = (bf16)f2bf(v0[1]); tp[2 * (size_t)R] = (bf16)f2bf(v0[2]); tp[3 * (size_t)R] = (bf16)f2bf(v0[3]);
                        tp[4 * (size_t)R] = (bf16)f2bf(v1[0]); tp[5 * (size_t)R] = (bf16)f2bf(v1[1]); tp[6 * (size_t)R] = (bf16)f2bf(v1[2]); tp[7 * (size_t)R] = (bf16)f2bf(v1[3]);
                    }
                }
            return;
        }
        bf16* base; int ldc, colt;
        if (pn < 8) { base = PA; ldc = PA_LD; colt = pn * 256; } else { base = PG; ldc = PG_LD; colt = (pn - 12) * 256; }
        const int col0 = colt + wc * 32 + 8 * fq;
        const bool do_rope = (pn < 2) && (u.pm >= 8);
        const float sc = (pn == 0 || pn == 4 || pn == 5) ? 0.125f : 1.f;
#pragma unroll
        for (int ai = 0; ai < 2; ++ai)
#pragma unroll
            for (int m = 0; m < 4; ++m) {
                const int row = row0 + ai * 128 + m * 16;
                bf16* rowp = base + (size_t)row * ldc + col0;
                f32x4 cs[4];
                if (do_rope) { const int t = (row - NCTX) & (SEQ - 1); const int pos = (wc & 1) ? (t & 63) : (t >> 6);
                    const f32x4* cp = (const f32x4*)(rope + (size_t)(pos * 16 + 8 * (fq & 1)) * 2);
                    cs[0] = cp[0]; cs[1] = cp[1]; cs[2] = cp[2]; cs[3] = cp[3]; }
#pragma unroll
                for (int bj = 0; bj < 2; ++bj) {
                    f32x4 v0 = acc[ai][bj][m][0], v1 = acc[ai][bj][m][1];
                    if (do_rope) {
                        float x[8] = {v0[0], v0[1], v0[2], v0[3], v1[0], v1[1], v1[2], v1[3]};
#pragma unroll
                        for (int e = 0; e < 8; ++e) { const float p = shx(x[e], 32, fr + 16 * fq); const float c = cs[e >> 1][(e & 1) * 2], s = cs[e >> 1][(e & 1) * 2 + 1];
                            x[e] = (fq < 2) ? (x[e] * c - p * s) : (p * s + x[e] * c); }
                        v0 = (f32x4){x[0], x[1], x[2], x[3]}; v1 = (f32x4){x[4], x[5], x[6], x[7]};
                    }
                    v0 = v0 * sc; v1 = v1 * sc;
                    u32x4 w; w.x = cvt_pk_bf16(v0[0], v0[1]); w.y = cvt_pk_bf16(v0[2], v0[3]); w.z = cvt_pk_bf16(v1[0], v1[1]); w.w = cvt_pk_bf16(v1[2], v1[3]);
                    *(u32x4*)(rowp + bj * 128) = w;
                }
                asm volatile("" ::: "memory");
            }
    }
};
template <int SECOND> struct EpiMerge {
    static constexpr bool PERM = true;
    bf16* MG; const bf16* PG;
    __device__ __forceinline__ void operator()(const f32x4 (&acc)[2][2][4][2], const Unit& u, int wr, int wc, int fr, int fq) const {
        const int row0 = u.pm * 256 + wr * 64 + fr, col0 = u.pn * 256 + wc * 32 + 8 * fq;
#pragma unroll
        for (int ai = 0; ai < 2; ++ai)
#pragma unroll
            for (int m = 0; m < 4; ++m) {
                const int row = row0 + ai * 128 + m * 16;
#pragma unroll
                for (int bj = 0; bj < 2; ++bj) {
                    const int c = col0 + bj * 128;
                    const u32x4 g = *(const u32x4*)(PG + (size_t)row * PG_LD + SECOND * 1024 + c);
                    const f32x4 v0 = acc[ai][bj][m][0], v1 = acc[ai][bj][m][1];
                    float o[8];
                    o[0] = sigmoidf_(bflo(g.x)) * v0[0]; o[1] = sigmoidf_(bfhi(g.x)) * v0[1]; o[2] = sigmoidf_(bflo(g.y)) * v0[2]; o[3] = sigmoidf_(bfhi(g.y)) * v0[3];
                    o[4] = sigmoidf_(bflo(g.z)) * v1[0]; o[5] = sigmoidf_(bfhi(g.z)) * v1[1]; o[6] = sigmoidf_(bflo(g.w)) * v1[2]; o[7] = sigmoidf_(bfhi(g.w)) * v1[3];
                    bf16* mp = MG + (size_t)row * D + c;
                    if (SECOND) { const u32x4 old = *(const u32x4*)mp;
                        o[0] += bflo(old.x); o[1] += bfhi(old.x); o[2] += bflo(old.y); o[3] += bfhi(old.y); o[4] += bflo(old.z); o[5] += bfhi(old.z); o[6] += bflo(old.w); o[7] += bfhi(old.w); }
                    u32x4 w; w.x = cvt_pk_bf16(o[0], o[1]); w.y = cvt_pk_bf16(o[2], o[3]); w.z = cvt_pk_bf16(o[4], o[5]); w.w = cvt_pk_bf16(o[6], o[7]);
                    *(u32x4*)mp = w;
                }
                asm volatile("" ::: "memory");
            }
    }
};
struct EpiRes {
    static constexpr bool PERM = false;
    const float* src_c; const float* src_l; float* dst_c; float* dst_l; const float* mod;
    __device__ __forceinline__ void operator()(const f32x4 (&acc)[2][2][4][2], const Unit& u, int wr, int wc, int fr, int fq) const {
        const bool isctx = u.pm < 8;
        const int slot = isctx ? 8 : ((u.pm - 8) >> 5);
        const float* src = isctx ? src_c : src_l;
        float* dst = isctx ? dst_c : dst_l;
        const int rbase = (isctx ? u.pm * 256 : (u.pm - 8) * 256) + wr * 64 + fr;
        const int col0 = u.pn * 256 + wc * 32 + 4 * fq;
        const float* ga = mod + slot * 6144 + 2048;
        f32x4 gv[2][2];
#pragma unroll
        for (int bj = 0; bj < 2; ++bj)
#pragma unroll
            for (int n = 0; n < 2; ++n) gv[bj][n] = *(const f32x4*)(ga + col0 + bj * 128 + n * 16);
#pragma unroll
        for (int ai = 0; ai < 2; ++ai)
#pragma unroll
            for (int m = 0; m < 4; ++m) {
                const size_t off = (size_t)(rbase + ai * 128 + m * 16) * D + col0;
#pragma unroll
                for (int bj = 0; bj < 2; ++bj)
#pragma unroll
                    for (int n = 0; n < 2; ++n) { const f32x4 x = *(const f32x4*)(src + off + bj * 128 + n * 16); *(f32x4*)(dst + off + bj * 128 + n * 16) = x + gv[bj][n] * acc[ai][bj][m][n]; }
                asm volatile("" ::: "memory");
            }
    }
};
struct EpiB16 {
    static constexpr bool PERM = true;
    bf16* C; int ldc;
    __device__ __forceinline__ void operator()(const f32x4 (&acc)[2][2][4][2], const Unit& u, int wr, int wc, int fr, int fq) const {
        const int row0 = u.pm * 256 + wr * 64 + fr, col0 = u.pn * 256 + wc * 32 + 8 * fq;
#pragma unroll
        for (int ai = 0; ai < 2; ++ai)
#pragma unroll
            for (int m = 0; m < 4; ++m) { bf16* rowp = C + (size_t)(row0 + ai * 128 + m * 16) * ldc + col0;
#pragma unroll
                for (int bj = 0; bj < 2; ++bj) { const f32x4 v0 = acc[ai][bj][m][0], v1 = acc[ai][bj][m][1];
                    u32x4 w; w.x = cvt_pk_bf16(v0[0], v0[1]); w.y = cvt_pk_bf16(v0[2], v0[3]); w.z = cvt_pk_bf16(v1[0], v1[1]); w.w = cvt_pk_bf16(v1[2], v1[3]);
                    *(u32x4*)(rowp + bj * 128) = w; } }
    }
};
struct EpiF32 {
    static constexpr bool PERM = false;
    float* C; int ldc;
    __device__ __forceinline__ void operator()(const f32x4 (&acc)[2][2][4][2], const Unit& u, int wr, int wc, int fr, int fq) const {
        const int row0 = u.pm * 256 + wr * 64 + fr, col0 = u.pn * 256 + wc * 32 + 4 * fq;
#pragma unroll
        for (int ai = 0; ai < 2; ++ai)
#pragma unroll
            for (int m = 0; m < 4; ++m) { float* rowp = C + (size_t)(row0 + ai * 128 + m * 16) * ldc + col0;
#pragma unroll
                for (int bj = 0; bj < 2; ++bj)
#pragma unroll
                    for (int n = 0; n < 2; ++n) *(f32x4*)(rowp + bj * 128 + n * 16) = acc[ai][bj][m][n]; }
    }
};

__device__ __forceinline__ void p0_transpose_item(const float* W, int K, int N, bf16* WT, int dst_row0, LAS float* scr, int k0, int n0, int lane) {
#pragma unroll 8
    for (int i = 0; i < 32; ++i) { const int kk = 2 * i + (lane >> 5); scr[kk * 33 + (lane & 31)] = W[(size_t)(k0 + kk) * N + n0 + (lane & 31)]; }
    LDS_WAIT(); asm volatile("" ::: "memory");
    const int c = lane & 7;
#pragma unroll
    for (int j = 0; j < 4; ++j) { const int n = (lane >> 3) + 8 * j; const LAS float* s = scr + (8 * c) * 33 + n;
        v4u o; o.x = pk2(s[0 * 33], s[1 * 33]); o.y = pk2(s[2 * 33], s[3 * 33]); o.z = pk2(s[4 * 33], s[5 * 33]); o.w = pk2(s[6 * 33], s[7 * 33]);
        *(v4u*)(WT + (size_t)(dst_row0 + n) * K + k0 + 8 * c) = o; }
    LDS_WAIT(); asm volatile("" ::: "memory");
}
__device__ __forceinline__ int win_map(int n0) {
    if (n0 < 512) return n0;
    if (n0 < 1024) return 2048 + (n0 - 512);
    if (n0 < 1056) return 5120 + (n0 - 1024);
    if (n0 < 1568) return 512 + (n0 - 1056);
    if (n0 < 2080) return 1024 + (n0 - 1568);
    if (n0 < 2592) return 1536 + (n0 - 2080);
    if (n0 < 3104) return 2560 + (n0 - 2592);
    return 3072 + (n0 - 3104);
}

__device__ __forceinline__ void p0_prologue(const Frame& F) {
    CArgsP a = kargs(); unsigned char* const ws = a->ws;
    const int gw = F.vcu * NWAVES + F.wave, NGW = F.G * NWAVES;
    const int gtid = F.vcu * NT + F.tid, GT = F.G * NT;
    {
        LAS float* scr = (LAS float*)(F.lds + F.wave * 16384);
        constexpr int I_IN = 16 * 161, I_P = 8 * 32, I_O = 16 * 32, PER_L = I_IN + 2 * I_P + I_O;
        for (int it = gw; it < DEPTH * PER_L; it += NGW) {
            const int l = it / PER_L; int r = it % PER_L;
            if (r < I_IN) { const int kb = r / 161, nb = r % 161; p0_transpose_item(a->in[I_WIN] + (size_t)l * D * IN_COLS, D, IN_COLS, (bf16*)(ws + WS_WIN) + (size_t)l * NPAD * D, win_map(nb * 32), scr, kb * 64, nb * 32, F.lane); continue; }
            r -= I_IN;
            if (r < I_P) { const int kb = r / 32, nb = r % 32; p0_transpose_item(a->in[I_WPG] + (size_t)l * 512 * D, 512, D, (bf16*)(ws + WS_WPG) + (size_t)l * D * 512, nb * 32, scr, kb * 64, nb * 32, F.lane); continue; }
            r -= I_P;
            if (r < I_P) { const int kb = r / 32, nb = r % 32; p0_transpose_item(a->in[I_WPN] + (size_t)l * 512 * D, 512, D, (bf16*)(ws + WS_WPN) + (size_t)l * D * 512, nb * 32, scr, kb * 64, nb * 32, F.lane); continue; }
            r -= I_P;
            { const int kb = r / 32, nb = r % 32; p0_transpose_item(a->in[I_WO] + (size_t)l * D * D, D, D, (bf16*)(ws + WS_WO) + (size_t)l * D * D, nb * 32, scr, kb * 64, nb * 32, F.lane); }
        }
        constexpr int PADV = (NPAD - IN_COLS) * D / 8;
        for (int i = gtid; i < DEPTH * PADV; i += GT) { const int l = i / PADV, j = i % PADV; *((v4u*)((bf16*)(ws + WS_WIN) + ((size_t)l * NPAD + IN_COLS) * D) + j) = (v4u){0u, 0u, 0u, 0u}; }
    }
    __syncthreads();
    if (gtid < 128 * 16) { const int pos = gtid >> 4, j = gtid & 15; const float freq = powf(10000.f, -(float)j / 16.f); const float ang = (float)pos * freq;
        float* cs = (float*)(ws + WS_ROPE); cs[2 * gtid] = cosf(ang); cs[2 * gtid + 1] = sinf(ang); }
    {
        LAS float* LSK = (LAS float*)F.lds;
        LAS float* LQ = (LAS float*)(F.lds + 128 * 132 * 4);
        for (int unit = F.vcu; unit < DEPTH * 16 * 16; unit += F.G) {
            const int l = unit >> 8, hp = (unit >> 4) & 15, d0 = (unit & 15) * 64;
            const float* sk = a->in[I_SK] + ((size_t)l * 16 + hp) * 16384;
            const float* wq = a->in[I_WQ] + (size_t)l * D * 2048 + hp * 128;
            __syncthreads();
            for (int i = F.tid; i < 16384; i += NT) LSK[(i >> 7) * 132 + (i & 127)] = sk[i];
            for (int i = F.tid; i < 8192; i += NT) LQ[(i >> 7) * 132 + (i & 127)] = wq[(size_t)(d0 + (i >> 7)) * 2048 + (i & 127)];
            __syncthreads();
            const int dd = F.tid & 63, kg = F.tid >> 6;
            float acc[16];
#pragma unroll
            for (int k = 0; k < 16; ++k) acc[k] = 0.f;
            for (int j = 0; j < 128; j += 4) {
                const f32x4 q = *(const LAS f32x4*)(LQ + dd * 132 + j);
#pragma unroll
                for (int k = 0; k < 16; ++k) { const f32x4 s = *(const LAS f32x4*)(LSK + (kg * 16 + k) * 132 + j); acc[k] += q[0] * s[0] + q[1] * s[1] + q[2] * s[2] + q[3] * s[3]; }
            }
            bf16* o = (bf16*)(ws + WS_WS) + ((size_t)l * 2048 + hp * 128 + kg * 16) * D + d0 + dd;
#pragma unroll
            for (int k = 0; k < 16; ++k) o[(size_t)k * D] = (bf16)f2bf(acc[k]);
        }
    }
    __syncthreads();
    {
        LAS float* ca = (LAS float*)F.lds;
        LAS float* red = (LAS float*)(F.lds + 9 * D * 4);
        for (int i = F.tid; i < 9 * D; i += NT) { const float v = i < 8 * D ? a->in[I_C][i] : a->in[I_CCTX][i - 8 * D]; ca[i] = v / (1.f + __expf(-v)); }
        __syncthreads();
        float* MOD = (float*)(ws + WS_MOD);
        for (int unit = F.vcu; unit < DEPTH * 96; unit += F.G) {
            const int l = unit / 96, cb = unit % 96, dc = F.tid >> 6;
            const int col = cb * 64 + (F.tid & 63);
            const float* w = a->in[I_WMOD] + ((size_t)l * D + dc * 128) * 6144 + col;
            float acc[9];
#pragma unroll
            for (int b = 0; b < 9; ++b) acc[b] = 0.f;
#pragma unroll 8
            for (int d = 0; d < 128; ++d) { const float wv = w[(size_t)d * 6144];
#pragma unroll
                for (int b = 0; b < 9; ++b) acc[b] += ca[b * D + dc * 128 + d] * wv; }
#pragma unroll
            for (int b = 0; b < 9; ++b) red[(dc * 9 + b) * 64 + (F.tid & 63)] = acc[b];
            __syncthreads();
            for (int i = F.tid; i < 9 * 64; i += NT) { const int b = i >> 6, c = i & 63; float sum = a->in[I_BMOD][l * 6144 + cb * 64 + c];
#pragma unroll
                for (int k = 0; k < 8; ++k) sum += red[(k * 9 + b) * 64 + c];
                MOD[((size_t)l * 9 + b) * 6144 + cb * 64 + c] = sum; }
            __syncthreads();
        }
    }
    __syncthreads();
}

__device__ __forceinline__ unsigned pk4_fp8(float a, float b, float c, float d) { int p = __builtin_amdgcn_cvt_pk_fp8_f32(a, b, 0, false); p = __builtin_amdgcn_cvt_pk_fp8_f32(c, d, p, true); return (unsigned)p; }
__device__ __forceinline__ void convert_row_fp8(const float* src, unsigned char* dst_tab, float* scale_out, int e, int lane) {
    const f32x4* sp = (const f32x4*)(src + (size_t)e * D) + 4 * lane;
    const f32x4 a0 = sp[0], a1 = sp[1], a2 = sp[2], a3 = sp[3];
    float mx = fmaxf(fmaxf(fmaxf(fabsf(a0[0]), fabsf(a0[1])), fmaxf(fabsf(a0[2]), fabsf(a0[3]))), fmaxf(fmaxf(fabsf(a1[0]), fabsf(a1[1])), fmaxf(fabsf(a1[2]), fabsf(a1[3]))));
    mx = fmaxf(mx, fmaxf(fmaxf(fmaxf(fabsf(a2[0]), fabsf(a2[1])), fmaxf(fabsf(a2[2]), fabsf(a2[3]))), fmaxf(fmaxf(fabsf(a3[0]), fabsf(a3[1])), fmaxf(fabsf(a3[2]), fabsf(a3[3])))));
    mx = fmaxf(wave_max(mx, lane), 1e-30f);
    const float sc = 256.f / mx;
    const v4u w = (v4u){pk4_fp8(a0[0] * sc, a0[1] * sc, a0[2] * sc, a0[3] * sc), pk4_fp8(a1[0] * sc, a1[1] * sc, a1[2] * sc, a1[3] * sc), pk4_fp8(a2[0] * sc, a2[1] * sc, a2[2] * sc, a2[3] * sc), pk4_fp8(a3[0] * sc, a3[1] * sc, a3[2] * sc, a3[3] * sc)};
    *(v4u*)(dst_tab + ((size_t)(lane >> 3) * NEXP + e) * 128 + 16 * (lane & 7)) = w;
    if (lane == 0) scale_out[e] = mx * (1.f / 256.f);
}
__device__ __forceinline__ void convert_experts(const Frame& F, int layer) {
    CArgsP a = kargs(); unsigned char* const ws = a->ws;
    const int gw = F.vcu * NWAVES + F.wave, NGW = F.G * NWAVES;
    const float* su = a->in[I_EU] + (size_t)layer * NEXP * D; const float* sv = a->in[I_EV] + (size_t)layer * NEXP * D;
    for (int e = gw; e < NEXP; e += NGW) { convert_row_fp8(su, ws + WS_EU, (float*)(ws + WS_SU), e, F.lane); convert_row_fp8(sv, ws + WS_EV, (float*)(ws + WS_SV), e, F.lane); }
}

__device__ __forceinline__ void norm_phase(const Frame& F, int layer, int which, int rbeg) {
    CArgsP a = kargs(); unsigned char* const ws = a->ws;
    const int gw = F.vcu * NWAVES + F.wave, NGW = F.G * NWAVES;
    const float* g = (which ? a->in[I_GN2] : a->in[I_GN1]) + layer * D;
    const float* MOD = (const float*)(ws + WS_MOD) + (size_t)layer * 9 * 6144 + (which ? 3072 : 0);
    bf16* H = (bf16*)(ws + WS_H);
    f32x4 gv[4];
#pragma unroll
    for (int j = 0; j < 4; ++j) gv[j] = *((const f32x4*)g + F.lane + 64 * j);
    for (int r = rbeg + gw; r < R; r += NGW) {
        const float* xr = (which == 0 && layer == 0) ? xrow_in(a, r) : xrow_cur(a, r);
        const float* sh = MOD + row_slot(r) * 6144; const float* sc = sh + D;
        f32x4 v[4]; float ss = 0.f;
#pragma unroll
        for (int j = 0; j < 4; ++j) { v[j] = *((const GAS f32x4*)xr + F.lane + 64 * j); ss += (v[j][0] * v[j][0] + v[j][1] * v[j][1]) + (v[j][2] * v[j][2] + v[j][3] * v[j][3]); }
        const float rs = rsqrtf(wave_sum(ss, F.lane) * (1.f / D) + EPS);
        unsigned long long* o8 = (unsigned long long*)(H + (size_t)r * D) + F.lane;
        float mx = 0.f;
#pragma unroll
        for (int j = 0; j < 4; ++j) {
            const f32x4 s1 = *((const f32x4*)sc + F.lane + 64 * j), s0 = *((const f32x4*)sh + F.lane + 64 * j);
            const f32x4 y = v[j] * rs * gv[j] * (s1 + 1.f) + s0;
            o8[64 * j] = (unsigned long long)pk2(y[0], y[1]) | ((unsigned long long)pk2(y[2], y[3]) << 32);
            v[j] = y; mx = fmaxf(mx, fmaxf(fmaxf(fabsf(y[0]), fabsf(y[1])), fmaxf(fabsf(y[2]), fabsf(y[3]))));
        }
        if (which) {
            mx = fmaxf(wave_max(mx, F.lane), 1e-30f); const float q8 = 256.f / mx;
            unsigned* h8 = (unsigned*)(ws + WS_H8 + (size_t)r * D) + F.lane;
#pragma unroll
            for (int j = 0; j < 4; ++j) h8[64 * j] = pk4_fp8(v[j][0] * q8, v[j][1] * q8, v[j][2] * q8, v[j][3] * q8);
            if (F.lane == 0) ((float*)(ws + WS_SX))[r] = mx * (1.f / 256.f);
        }
    }
}

constexpr int GL_TOT = 0, GL_IMG = 4096, GL_PITCH = 144, GL_IMGB = 64 * GL_PITCH, GL_SSX = GL_IMG + 4 * GL_IMGB;
typedef short bf16x8_t __attribute__((ext_vector_type(8)));
__device__ __forceinline__ int chunk_row0(int b, int tc) { return tc < 4 ? b * CTXL + tc * 64 : NCTX + b * SEQ + (tc - 4) * 64; }
__device__ __forceinline__ int chunk_pos(int tc, int dir) { return dir == 0 ? tc : (tc < 4 ? 3 - tc : 135 - tc); }
__device__ __forceinline__ float logsig16(float x) { return (fminf(x, 0.f) - 0.69314718f * __builtin_amdgcn_logf(1.f + __builtin_amdgcn_exp2f(-1.44269504f * fabsf(x)))) * (1.f / 16.f); }
constexpr int GL_HALF = 40960;
__device__ __forceinline__ void gla_scan(LAS unsigned char* hl, int w4, int lane, CArgsP a, const float* Z, int layer, int h, int row0, int lz, float (&Bf)[16], float (&Bb)[16], float& endf, float& endb) {
    const float* waf = a->in[I_WAF] + layer * 4096 + h * 64 + lane; const float* wab = a->in[I_WAB] + layer * 4096 + h * 64 + lane;
    float wf[16], wb[16];
#pragma unroll
    for (int j = 0; j < 16; ++j) { wf[j] = waf[j * 256]; wb[j] = wab[j * 256]; }
    const float baf = a->in[I_BAF][layer * 256 + h * 64 + lane], bab = a->in[I_BAB][layer * 256 + h * 64 + lane];
    const int t0 = 16 * w4;
#pragma unroll
    for (int i = 0; i < 16; ++i) {
        const f32x4* zp = (const f32x4*)(Z + (size_t)(row0 + t0 + i) * 32 + lz);
        float zf = baf, zb = bab;
#pragma unroll
        for (int q = 0; q < 4; ++q) { const f32x4 z0 = zp[q], z1 = zp[4 + q];
            zf += z0[0] * wf[4 * q] + z0[1] * wf[4 * q + 1] + z0[2] * wf[4 * q + 2] + z0[3] * wf[4 * q + 3];
            zb += z1[0] * wb[4 * q] + z1[1] * wb[4 * q + 1] + z1[2] * wb[4 * q + 2] + z1[3] * wb[4 * q + 3]; }
        Bf[i] = logsig16(zf); Bb[i] = logsig16(zb);
    }
#pragma unroll
    for (int i = 1; i < 16; ++i) Bf[i] += Bf[i - 1];
#pragma unroll
    for (int i = 14; i >= 0; --i) Bb[i] += Bb[i + 1];
    LAS float* TOT = (LAS float*)(hl + GL_TOT);
    TOT[(0 * 4 + w4) * 64 + lane] = Bf[15]; TOT[(1 * 4 + w4) * 64 + lane] = Bb[0];
    __syncthreads();
    float offf = 0.f, offb = 0.f; endf = 0.f; endb = 0.f;
#pragma unroll
    for (int w = 0; w < 4; ++w) { const float tf = TOT[(0 * 4 + w) * 64 + lane], tb = TOT[(1 * 4 + w) * 64 + lane]; endf += tf; endb += tb; offf += (w < w4) ? tf : 0.f; offb += (w > w4) ? tb : 0.f; }
#pragma unroll
    for (int i = 0; i < 16; ++i) { Bf[i] += offf; Bb[i] += offb; }
}
constexpr int GLA_UNITS = BATCH * 4 * NCHUNK;
__device__ __forceinline__ void gla_a_phase(const Frame& F, int layer) {
    CArgsP a = kargs(); unsigned char* const ws = a->ws;
    const bf16* PA = (const bf16*)(ws + WS_PA); const bf16* VT = (const bf16*)(ws + WS_VT);
    const float* Z = (const float*)(ws + WS_Z); bf16* SST = (bf16*)(ws + WS_H); float* DEC = (float*)(ws + WS_DEC);
    int lz = 0; asm volatile("" : "+v"(lz));
    const int lane = F.lane, l16 = lane & 15, g = lane >> 4, hw = F.wave >> 2, w4 = F.wave & 3, t0 = 16 * w4;
    LAS unsigned char* hl = F.lds + hw * GL_HALF;
    for (int up = F.vcu; up < GLA_UNITS / 2; up += F.G) {
        const int unit = 2 * up + hw;
        const int b = unit / (4 * NCHUNK), h = (unit / NCHUNK) & 3, tc = unit % NCHUNK, row0 = chunk_row0(b, tc);
        float Bf[16], Bb[16], endf, endb;
        gla_scan(hl, w4, lane, a, Z, layer, h, row0, lz, Bf, Bb, endf, endb);
        float kf[16], kb[16];
#pragma unroll
        for (int i = 0; i < 16; ++i) { const float kk = bf1(PA[(size_t)(row0 + t0 + i) * PA_LD + PA_K + h * 64 + lane]); kf[i] = kk * __expf(endf - Bf[i]); kb[i] = kk * __expf(endb - Bb[i]); }
#pragma unroll
        for (int q = 0; q < 2; ++q) {
            *(LAS v4u*)(hl + GL_IMG + 0 * GL_IMGB + lane * GL_PITCH + (t0 + 8 * q) * 2) = (v4u){pk2(kf[8 * q], kf[8 * q + 1]), pk2(kf[8 * q + 2], kf[8 * q + 3]), pk2(kf[8 * q + 4], kf[8 * q + 5]), pk2(kf[8 * q + 6], kf[8 * q + 7])};
            *(LAS v4u*)(hl + GL_IMG + 1 * GL_IMGB + lane * GL_PITCH + (t0 + 8 * q) * 2) = (v4u){pk2(kb[8 * q], kb[8 * q + 1]), pk2(kb[8 * q + 2], kb[8 * q + 3]), pk2(kb[8 * q + 4], kb[8 * q + 5]), pk2(kb[8 * q + 6], kb[8 * q + 7])};
        }
        const int seq0 = (b * 4 + h) * 2;
        if (w4 == 0) { DEC[((size_t)(seq0 + 0) * NCHUNK + chunk_pos(tc, 0)) * 64 + lane] = __expf(endf); DEC[((size_t)(seq0 + 1) * NCHUNK + chunk_pos(tc, 1)) * 64 + lane] = __expf(endb); }
        __syncthreads();
        const int dir = w4 >> 1, nth = w4 & 1;
        const LAS unsigned char* img = hl + GL_IMG + dir * GL_IMGB;
        bf16x8_t afr[4][2];
#pragma unroll
        for (int mt = 0; mt < 4; ++mt)
#pragma unroll
            for (int kt = 0; kt < 2; ++kt) afr[mt][kt] = *(const LAS bf16x8_t*)(img + (16 * mt + l16) * GL_PITCH + (32 * kt + 8 * g) * 2);
        bf16* slot = SST + ((size_t)(seq0 + dir) * NCHUNK + chunk_pos(tc, dir)) * 8192;
#pragma unroll
        for (int n4 = 0; n4 < 4; ++n4) {
            const int nt = 4 * nth + n4;
            const bf16* vp = VT + (size_t)(h * 128 + 16 * nt + l16) * R + row0 + 8 * g;
            const bf16x8_t b0 = *(const bf16x8_t*)vp, b1 = *(const bf16x8_t*)(vp + 32);
#pragma unroll
            for (int mt = 0; mt < 4; ++mt) {
                f32x4 acc = (f32x4){0.f, 0.f, 0.f, 0.f};
                acc = __builtin_amdgcn_mfma_f32_16x16x32_bf16(afr[mt][0], b0, acc, 0, 0, 0);
                acc = __builtin_amdgcn_mfma_f32_16x16x32_bf16(afr[mt][1], b1, acc, 0, 0, 0);
                *(v2u*)(slot + (16 * nt + l16) * 64 + 16 * mt + 4 * g) = (v2u){pk2(acc[0], acc[1]), pk2(acc[2], acc[3])};
            }
        }
        __syncthreads();
    }
}
__device__ __forceinline__ void gla_b_phase(const Frame& F, bool dry) {
    CArgsP a = kargs(); unsigned char* const ws = a->ws; const bool wr = !dry || a->pad == 12345;
    bf16* SST = (bf16*)(ws + WS_H); const float* DEC = (const float*)(ws + WS_DEC);
    const int gtid = F.vcu * NT + F.tid, GT = F.G * NT;
    for (int id = gtid; id < 64 * 2048; id += GT) {
        const int seq = id >> 11, e = (id & 2047) * 4, k4 = e & 63;
        float s0 = 0.f, s1 = 0.f, s2 = 0.f, s3 = 0.f;
        bf16* p = SST + (size_t)seq * NCHUNK * 8192 + e; const float* dp = DEC + (size_t)seq * NCHUNK * 64 + k4;
#pragma unroll 4
        for (int c = 0; c < NCHUNK; ++c) {
            const v2u t = *(const v2u*)(p + (size_t)c * 8192); const f32x4 d = *(const f32x4*)(dp + c * 64);
            if (wr) *(v2u*)(p + (size_t)c * 8192) = (v2u){pk2(s0, s1), pk2(s2, s3)};
            s0 = d[0] * s0 + bflo(t.x); s1 = d[1] * s1 + bfhi(t.x); s2 = d[2] * s2 + bflo(t.y); s3 = d[3] * s3 + bfhi(t.y);
        }
    }
}
__device__ __forceinline__ void gla_c_phase(const Frame& F, int layer, bool dry) {
    CArgsP a = kargs(); unsigned char* const ws = a->ws; const bool wr = !dry || a->pad == 12345;
    bf16* PA = (bf16*)(ws + WS_PA); const bf16* VT = (const bf16*)(ws + WS_VT);
    const float* Z = (const float*)(ws + WS_Z); const bf16* SST = (const bf16*)(ws + WS_H);
    int lz = 0; asm volatile("" : "+v"(lz));
    const int lane = F.lane, l16 = lane & 15, g = lane >> 4, hw = F.wave >> 2, w4 = F.wave & 3, t0 = 16 * w4;
    LAS unsigned char* hl = F.lds + hw * GL_HALF;
    for (int up = F.vcu; up < GLA_UNITS / 2; up += F.G) {
        const int unit = 2 * up + hw;
        const int b = unit / (4 * NCHUNK), h = (unit / NCHUNK) & 3, tc = unit % NCHUNK, row0 = chunk_row0(b, tc);
        {
            float Bf[16], Bb[16], endf, endb;
            gla_scan(hl, w4, lane, a, Z, layer, h, row0, lz, Bf, Bb, endf, endb);
#pragma unroll
            for (int i = 0; i < 16; ++i) {
                const bf16* pr = PA + (size_t)(row0 + t0 + i) * PA_LD + h * 64 + lane;
                const float qq = bf1(pr[PA_Q]), kk = bf1(pr[PA_K]);
                const float ef = __expf(Bf[i]), eb = __expf(Bb[i]);
                LAS bf16* ip = (LAS bf16*)(hl + GL_IMG + (t0 + i) * GL_PITCH) + lane;
                ip[0] = (bf16)f2bf(qq * ef); ip[GL_IMGB / 2] = (bf16)f2bf(kk * __builtin_amdgcn_rcpf(ef)); ip[GL_IMGB] = (bf16)f2bf(qq * eb); ip[3 * GL_IMGB / 2] = (bf16)f2bf(kk * __builtin_amdgcn_rcpf(eb));
            }
        }
        __syncthreads();
        f32x4 O[8];
#pragma unroll
        for (int mt = 0; mt < 8; ++mt) O[mt] = (f32x4){0.f, 0.f, 0.f, 0.f};
        const int tq = 16 * w4 + l16;
#pragma unroll
        for (int dir = 0; dir < 2; ++dir) {
            const LAS unsigned char* Qimg = hl + GL_IMG + (2 * dir) * GL_IMGB; const LAS unsigned char* Kimg = Qimg + GL_IMGB;
            bf16x8_t qf[2];
#pragma unroll
            for (int kt = 0; kt < 2; ++kt) qf[kt] = *(const LAS bf16x8_t*)(Qimg + tq * GL_PITCH + (32 * kt + 8 * g) * 2);
            f32x4 P[4];
#pragma unroll
            for (int mt = 0; mt < 4; ++mt) {
                P[mt] = (f32x4){0.f, 0.f, 0.f, 0.f};
#pragma unroll
                for (int kt = 0; kt < 2; ++kt) { const bf16x8_t kf = *(const LAS bf16x8_t*)(Kimg + (16 * mt + l16) * GL_PITCH + (32 * kt + 8 * g) * 2); P[mt] = __builtin_amdgcn_mfma_f32_16x16x32_bf16(kf, qf[kt], P[mt], 0, 0, 0); }
#pragma unroll
                for (int rg = 0; rg < 4; ++rg) { const int tp = 16 * mt + 4 * g + rg; const bool valid = dir == 0 ? (tp <= tq) : (tp >= tq); P[mt][rg] = valid ? P[mt][rg] : 0.f; }
            }
            bf16x8_t pa[2];
#pragma unroll
            for (int k2 = 0; k2 < 2; ++k2) { const v4u w = (v4u){pk2(P[2 * k2][0], P[2 * k2][1]), pk2(P[2 * k2][2], P[2 * k2][3]), pk2(P[2 * k2 + 1][0], P[2 * k2 + 1][1]), pk2(P[2 * k2 + 1][2], P[2 * k2 + 1][3])}; pa[k2] = __builtin_bit_cast(bf16x8_t, w); }
            const bf16* slot = SST + ((size_t)((b * 4 + h) * 2 + dir) * NCHUNK + chunk_pos(tc, dir)) * 8192;
#pragma unroll
            for (int mt = 0; mt < 8; ++mt) {
                const int v = 16 * mt + l16;
                const bf16* vp = VT + (size_t)(h * 128 + v) * R + row0 + 4 * g;
#pragma unroll
                for (int k2 = 0; k2 < 2; ++k2) { const v2u lo = *(const v2u*)(vp + 32 * k2), hi = *(const v2u*)(vp + 32 * k2 + 16); const v4u w = (v4u){lo.x, lo.y, hi.x, hi.y};
                    O[mt] = __builtin_amdgcn_mfma_f32_16x16x32_bf16(__builtin_bit_cast(bf16x8_t, w), pa[k2], O[mt], 0, 0, 0); }
#pragma unroll
                for (int kt = 0; kt < 2; ++kt) { const bf16x8_t sf = *(const bf16x8_t*)(slot + v * 64 + 32 * kt + 8 * g); O[mt] = __builtin_amdgcn_mfma_f32_16x16x32_bf16(sf, qf[kt], O[mt], 0, 0, 0); }
            }
        }
        float ss = 0.f;
#pragma unroll
        for (int mt = 0; mt < 8; ++mt) ss += (O[mt][0] * O[mt][0] + O[mt][1] * O[mt][1]) + (O[mt][2] * O[mt][2] + O[mt][3] * O[mt][3]);
        ss += shx(ss, 16, lane); ss += shx(ss, 32, lane);
        const float rs = rsqrtf(ss * (1.f / 128.f) + EPS);
        bf16* rp0 = PA + (size_t)(row0 + tq) * PA_LD + PA_R + h * 128 + 4 * g;
        const float* gp = a->in[I_GGLA] + layer * 128 + 4 * g;
#pragma unroll
        for (int mt = 0; mt < 8; ++mt) {
            const f32x4 gg = *(const f32x4*)(gp + 16 * mt); const v2u rr = *(const v2u*)(rp0 + 16 * mt);
            const float r0 = bflo(rr.x), r1 = bfhi(rr.x), r2 = bflo(rr.y), r3 = bfhi(rr.y);
            const float y0 = O[mt][0] * rs * gg[0] * (r0 * sigmoidf_(r0)), y1 = O[mt][1] * rs * gg[1] * (r1 * sigmoidf_(r1));
            const float y2 = O[mt][2] * rs * gg[2] * (r2 * sigmoidf_(r2)), y3 = O[mt][3] * rs * gg[3] * (r3 * sigmoidf_(r3));
            if (wr) *(v2u*)(rp0 + 16 * mt) = (v2u){pk2(y0, y1), pk2(y2, y3)};
        }
        __syncthreads();
    }
}

__device__ __forceinline__ void na_unit(bf16* PA, const bf16* NVT, const float* rpb_l, int b, int hd, bool lat, int qr, int nt, int lane, bool wr) {
    const int l16 = lane & 15, g = lane >> 4;
    const int latbase = NCTX + b * SEQ, ctxbase = b * CTXL;
    const int tq_row = lat ? latbase + qr * 64 + 16 * nt + l16 : ctxbase + 16 * nt + l16;
    bf16* qp = PA + (size_t)tq_row * PA_LD + PA_NQ + hd * 64;
    bf16x8_t qf[2];
    qf[0] = *(const bf16x8_t*)(qp + 8 * g); qf[1] = *(const bf16x8_t*)(qp + 32 + 8 * g);
    const int qc = 16 * nt + l16, c0 = min(max(qc - 8, 0), 48), r0 = min(max(qr - 4, 0), 120), ct0 = nt < 2 ? 0 : 1;
    const float* rpb = rpb_l + hd * 465;
    float m = -3.0e38f, lsum = 0.f;
    f32x4 O[4];
#pragma unroll
    for (int mt = 0; mt < 4; ++mt) O[mt] = (f32x4){0.f, 0.f, 0.f, 0.f};
    const bf16* kbase = PA + PA_NK + hd * 64 + 8 * g;
    const bf16* vbase = NVT + (size_t)(hd * 64 + l16) * R + 4 * g;
#pragma unroll 1
    for (int grp = lat ? 0 : 6; grp < 10; ++grp) {
        int base[4]; f32x4 S[4];
#pragma unroll
        for (int j = 0; j < 4; ++j) {
            const int ti = grp * 4 + j;
            if (ti < 24) { const int wa = ti / 3, ct = ct0 + ti % 3; base[j] = latbase + (r0 + wa) * 64 + 16 * ct; } else base[j] = ctxbase + (ti - 24) * 16;
            const bf16* kp = kbase + (size_t)(base[j] + l16) * PA_LD;
            const bf16x8_t k0 = *(const bf16x8_t*)kp, k1 = *(const bf16x8_t*)(kp + 32);
            S[j] = (f32x4){0.f, 0.f, 0.f, 0.f};
            S[j] = __builtin_amdgcn_mfma_f32_16x16x32_bf16(k0, qf[0], S[j], 0, 0, 0);
            S[j] = __builtin_amdgcn_mfma_f32_16x16x32_bf16(k1, qf[1], S[j], 0, 0, 0);
        }
        bool valid[4][4];
        float mloc = -3.0e38f;
#pragma unroll
        for (int j = 0; j < 4; ++j) {
            const int ti = grp * 4 + j;
            if (ti < 24) {
                const int wa = ti / 3, ct = ct0 + ti % 3;
                const float* bp = rpb + (r0 + wa - qr + 7) * 31;
#pragma unroll
                for (int rg = 0; rg < 4; ++rg) { const int kc = 16 * ct + 4 * g + rg; valid[j][rg] = (kc >= c0) && (kc <= c0 + 15);
                    const float bias = bp[min(max(kc - qc + 15, 0), 30)]; S[j][rg] = valid[j][rg] ? S[j][rg] + bias : -3.0e38f; }
            } else {
#pragma unroll
                for (int rg = 0; rg < 4; ++rg) valid[j][rg] = true;
            }
            mloc = fmaxf(mloc, fmaxf(fmaxf(S[j][0], S[j][1]), fmaxf(S[j][2], S[j][3])));
        }
        mloc = fmaxf(mloc, shx(mloc, 16, lane)); mloc = fmaxf(mloc, shx(mloc, 32, lane));
        const float mnew = fmaxf(m, mloc), alpha = __expf(m - mnew);
        m = mnew;
        float psum = 0.f;
#pragma unroll
        for (int j = 0; j < 4; ++j)
#pragma unroll
            for (int rg = 0; rg < 4; ++rg) { const float p = valid[j][rg] ? __expf(S[j][rg] - m) : 0.f; S[j][rg] = p; psum += p; }
        lsum = lsum * alpha + psum;
#pragma unroll
        for (int mt = 0; mt < 4; ++mt) O[mt] = O[mt] * alpha;
#pragma unroll
        for (int k2 = 0; k2 < 2; ++k2) {
            const v4u pw = (v4u){pk2(S[2 * k2][0], S[2 * k2][1]), pk2(S[2 * k2][2], S[2 * k2][3]), pk2(S[2 * k2 + 1][0], S[2 * k2 + 1][1]), pk2(S[2 * k2 + 1][2], S[2 * k2 + 1][3])};
            const bf16x8_t pa = __builtin_bit_cast(bf16x8_t, pw);
#pragma unroll
            for (int mt = 0; mt < 4; ++mt) {
                const bf16* vp = vbase + (size_t)(16 * mt) * R;
                const v2u lo = *(const v2u*)(vp + base[2 * k2]), hi = *(const v2u*)(vp + base[2 * k2 + 1]);
                const v4u vw = (v4u){lo.x, lo.y, hi.x, hi.y};
                O[mt] = __builtin_amdgcn_mfma_f32_16x16x32_bf16(__builtin_bit_cast(bf16x8_t, vw), pa, O[mt], 0, 0, 0);
            }
        }
    }
    lsum += shx(lsum, 16, lane); lsum += shx(lsum, 32, lane);
    const float inv = 1.f / lsum;
#pragma unroll
    for (int mt = 0; mt < 4; ++mt) if (wr) *(v2u*)(qp + 16 * mt + 4 * g) = (v2u){pk2(O[mt][0] * inv, O[mt][1] * inv), pk2(O[mt][2] * inv, O[mt][3] * inv)};
}
__device__ __forceinline__ void na_unit4(bf16* PA, const bf16* NVT, const float* rpb_l, LAS float* lb, int b, int hd, bool lat, int qr0, int nt, int lane, bool wr) {
    const int l16 = lane & 15, g = lane >> 4;
    const int latbase = NCTX + b * SEQ, ctxbase = b * CTXL;
    bf16* qp[4]; bf16x8_t qf[4][2];
#pragma unroll
    for (int j = 0; j < 4; ++j) {
        const int row = lat ? latbase + (qr0 + j) * 64 + 16 * nt + l16 : ctxbase + 64 * nt + 16 * j + l16;
        qp[j] = PA + (size_t)row * PA_LD + PA_NQ + hd * 64;
        qf[j][0] = *(const bf16x8_t*)(qp[j] + 8 * g); qf[j][1] = *(const bf16x8_t*)(qp[j] + 32 + 8 * g);
    }
    const int qc = 16 * nt + l16, c0 = min(max(qc - 8, 0), 48), R0 = min(max(qr0 - 4, 0), 120);
    if (lat) {
#pragma unroll
        for (int i = 0; i < 8; ++i) { const int idx = lane + 64 * i; if (idx < 465) lb[idx] = rpb_l[hd * 465 + idx]; }
        LDS_WAIT();
    }
    const bf16* kbase = PA + PA_NK + hd * 64 + 8 * g;
    const bf16* vbase = NVT + (size_t)(hd * 64 + l16) * R + 4 * g;
    float mx[4] = {-3.0e38f, -3.0e38f, -3.0e38f, -3.0e38f};
    const int nrows = lat ? ((qr0 == 0 || qr0 == 124) ? 8 : 11) : 0, cs = (nt == 0) ? 0 : (nt == 1 ? 8 : (nt == 2 ? 24 : 32));
    const int nwin = nrows, nslot = nwin + 8;
#define NA_SLOT(si, jmask, krow, pr, base0, win) do { const int s_ = min((si), nslot - 1); win = s_ < nwin; pr = 0; \
        if (win) { krow = R0 + s_; jmask = 0u; \
            _Pragma("unroll") for (int j_ = 0; j_ < 4; ++j_) { const int r0j = min(max(qr0 + j_ - 4, 0), 120); if (krow >= r0j && krow < r0j + 8) jmask |= 1u << j_; } \
            base0 = latbase + krow * 64 + cs; } else { jmask = 15u; krow = 0; base0 = ctxbase + (s_ - nwin) * 32; } } while (0)
#define NA_LDK(dst, base0) do { _Pragma("unroll") for (int t_ = 0; t_ < 2; ++t_) { const bf16* kp_ = kbase + (size_t)((base0) + 16 * t_ + l16) * PA_LD; dst[t_][0] = *(const bf16x8_t*)kp_; dst[t_][1] = *(const bf16x8_t*)(kp_ + 32); } } while (0)
#define NA_LDV(dst, base0) do { _Pragma("unroll") for (int mt_ = 0; mt_ < 4; ++mt_) { const bf16* vp_ = vbase + (size_t)(16 * mt_) * R + (base0); const v2u lo_ = *(const v2u*)vp_, hi_ = *(const v2u*)(vp_ + 16); dst[mt_] = __builtin_bit_cast(bf16x8_t, (v4u){lo_.x, lo_.y, hi_.x, hi_.y}); } } while (0)
#pragma unroll 1
    for (int s0 = 0; s0 < nslot; s0 += 4) {
        bf16x8_t kc[4][2][2]; unsigned jm[4];
#pragma unroll
        for (int q = 0; q < 4; ++q) { int krow, pr, base0; bool win; NA_SLOT(s0 + q, jm[q], krow, pr, base0, win); if (s0 + q >= nslot) jm[q] = 0u; NA_LDK(kc[q], base0); }
#pragma unroll
        for (int q = 0; q < 4; ++q)
#pragma unroll
            for (int t = 0; t < 2; ++t)
#pragma unroll
                for (int j = 0; j < 4; ++j) {
                    f32x4 S = (f32x4){0.f, 0.f, 0.f, 0.f};
                    S = __builtin_amdgcn_mfma_f32_16x16x32_bf16(kc[q][t][0], qf[j][0], S, 0, 0, 0);
                    S = __builtin_amdgcn_mfma_f32_16x16x32_bf16(kc[q][t][1], qf[j][1], S, 0, 0, 0);
                    mx[j] = fmaxf(mx[j], fmaxf(fmaxf(S[0], S[1]), fmaxf(S[2], S[3])));
                }
    }
#pragma unroll
    for (int j = 0; j < 4; ++j) { mx[j] = fmaxf(mx[j], shx(mx[j], 16, lane)); mx[j] = fmaxf(mx[j], shx(mx[j], 32, lane)); }
    float ls[4] = {0.f, 0.f, 0.f, 0.f};
    f32x4 O[4][4];
#pragma unroll
    for (int j = 0; j < 4; ++j)
#pragma unroll
        for (int mt = 0; mt < 4; ++mt) O[j][mt] = (f32x4){0.f, 0.f, 0.f, 0.f};
#pragma unroll 1
    for (int s0 = 0; s0 < nslot; s0 += 2) {
        bf16x8_t kf[2][2][2], vf[2][4]; unsigned jm[2]; int krw[2], prr[2]; bool wn[2];
#pragma unroll
        for (int q = 0; q < 2; ++q) { int base0; NA_SLOT(s0 + q, jm[q], krw[q], prr[q], base0, wn[q]); if (s0 + q >= nslot) jm[q] = 0u; NA_LDK(kf[q], base0); NA_LDV(vf[q], base0); }
#pragma unroll
        for (int q = 0; q < 2; ++q) {
            const bool win = wn[q]; const int pr = prr[q], krow = krw[q];
            bool cv[2][4]; int co[2][4];
#pragma unroll
            for (int t = 0; t < 2; ++t)
#pragma unroll
                for (int rg = 0; rg < 4; ++rg) { const int kcol = cs + 16 * t + 4 * g + rg; cv[t][rg] = !win || ((kcol >= c0) && (kcol <= c0 + 15)); co[t][rg] = min(max(kcol - qc + 15, 0), 30); }
#pragma unroll
            for (int j = 0; j < 4; ++j) {
                const bool rv = (jm[q] >> j) & 1u;
                f32x4 S[2];
#pragma unroll
                for (int t = 0; t < 2; ++t) { S[t] = (f32x4){0.f, 0.f, 0.f, 0.f};
                    S[t] = __builtin_amdgcn_mfma_f32_16x16x32_bf16(kf[q][t][0], qf[j][0], S[t], 0, 0, 0);
                    S[t] = __builtin_amdgcn_mfma_f32_16x16x32_bf16(kf[q][t][1], qf[j][1], S[t], 0, 0, 0); }
                const LAS float* bp = lb + (win ? min(max(krow - (qr0 + j) + 7, 0), 14) * 31 : 0);
                float psum = 0.f;
#pragma unroll
                for (int t = 0; t < 2; ++t)
#pragma unroll
                    for (int rg = 0; rg < 4; ++rg) { const float bias = win ? bp[co[t][rg]] : 0.f; const float p = (cv[t][rg] && rv) ? __expf(S[t][rg] + bias - mx[j]) : 0.f; S[t][rg] = p; psum += p; }
                ls[j] += psum;
                const bf16x8_t pa = __builtin_bit_cast(bf16x8_t, (v4u){pk2(S[0][0], S[0][1]), pk2(S[0][2], S[0][3]), pk2(S[1][0], S[1][1]), pk2(S[1][2], S[1][3])});
#pragma unroll
                for (int mt = 0; mt < 4; ++mt) O[j][mt] = __builtin_amdgcn_mfma_f32_16x16x32_bf16(vf[q][mt], pa, O[j][mt], 0, 0, 0);
            }
        }
    }
#undef NA_SLOT
#undef NA_LDK
#undef NA_LDV
#pragma unroll
    for (int j = 0; j < 4; ++j) {
        float l = ls[j]; l += shx(l, 16, lane); l += shx(l, 32, lane);
        const float inv = 1.f / l;
#pragma unroll
        for (int mt = 0; mt < 4; ++mt) if (wr) *(v2u*)(qp[j] + 16 * mt + 4 * g) = (v2u){pk2(O[j][mt][0] * inv, O[j][mt][1] * inv), pk2(O[j][mt][2] * inv, O[j][mt][3] * inv)};
    }
}
__device__ __forceinline__ void na_phase(const Frame& F, int layer, bool dry, bool skip_ctx) {
    CArgsP a = kargs(); unsigned char* const ws = a->ws; const bool wr = !dry || a->pad == 12345;
    bf16* PA = (bf16*)(ws + WS_PA); const bf16* NVT = (const bf16*)(ws + WS_NVT);
    const float* rpb_l = a->in[I_RPB] + (size_t)layer * 8 * 465;
    const int gw = F.vcu * NWAVES + F.wave, NGW = F.G * NWAVES;
    LAS float* lb = (LAS float*)(F.lds + F.wave * 2048);
    for (int u = gw; u < BATCH * 8 * 32 * 4 + (skip_ctx ? 0 : BATCH * 8 * 4); u += NGW) {
        if (u < BATCH * 8 * 32 * 4) { const int nt = u & 3, qg = (u >> 2) & 31, hd = (u >> 7) & 7, b = u >> 10; na_unit4(PA, NVT, rpb_l, lb, b, hd, true, 4 * qg, nt, F.lane, wr); }
        else { const int v = u - BATCH * 8 * 32 * 4; const int nt = v & 3, hd = (v >> 2) & 7, b = v >> 5; na_unit4(PA, NVT, rpb_l, lb, b, hd, false, 0, nt, F.lane, wr); }
    }
}

__device__ __forceinline__ float pack_key(float v, int idx) { unsigned t = __builtin_bit_cast(unsigned, v) & ~127u; asm("" : "+v"(t)); return __builtin_bit_cast(float, t | (unsigned)idx); }
__device__ __forceinline__ void topk_phase(const Frame& F, int rbeg) {
    CArgsP a = kargs(); unsigned char* const ws = a->ws;
    const int gtid = F.vcu * NT + F.tid, GT = F.G * NT;
    const bf16* SC = (const bf16*)(ws + WS_SC);
    int* EI = (int*)(ws + WS_EI); float* EG = (float*)(ws + WS_EG);
    LAS unsigned* myl = (LAS unsigned*)F.lds + F.tid * 9;
    for (int id = rbeg * 8 + gtid; id < R * 8; id += GT) {
        const int r = id >> 3, hd = id & 7;
        const v4u* sp = (const v4u*)(SC + (size_t)r * 2048 + hd * 256);
        float t0[16], t1[16];
#pragma unroll
        for (int blk = 0; blk < 8; ++blk) {
            float n0[16], n1[16];
#pragma unroll
            for (int q = 0; q < 2; ++q) { const v4u va = sp[blk * 2 + q], vb = sp[16 + blk * 2 + q];
                const unsigned wa[4] = {va.x, va.y, va.z, va.w}, wb[4] = {vb.x, vb.y, vb.z, vb.w};
#pragma unroll
                for (int e = 0; e < 4; ++e) { const int i0 = blk * 16 + 8 * q + 2 * e;
                    n0[8 * q + 2 * e] = pack_key(bflo(wa[e]), i0); n0[8 * q + 2 * e + 1] = pack_key(bfhi(wa[e]), i0 + 1);
                    n1[8 * q + 2 * e] = pack_key(bflo(wb[e]), i0); n1[8 * q + 2 * e + 1] = pack_key(bfhi(wb[e]), i0 + 1); } }
#pragma unroll
            for (int k = 2; k <= 16; k <<= 1)
#pragma unroll
                for (int j = k >> 1; j > 0; j >>= 1)
#pragma unroll
                    for (int i = 0; i < 16; ++i) { const int l = i ^ j; if (l > i) { const bool desc = (i & k) == 0;
                        const float a0 = n0[i], b0 = n0[l], a1 = n1[i], b1 = n1[l];
                        n0[i] = desc ? fmaxf(a0, b0) : fminf(a0, b0); n0[l] = desc ? fminf(a0, b0) : fmaxf(a0, b0);
                        n1[i] = desc ? fmaxf(a1, b1) : fminf(a1, b1); n1[l] = desc ? fminf(a1, b1) : fmaxf(a1, b1); } }
            if (blk == 0) {
#pragma unroll
                for (int i = 0; i < 16; ++i) { t0[i] = n0[i]; t1[i] = n1[i]; }
            } else {
#pragma unroll
                for (int i = 0; i < 16; ++i) { t0[i] = fmaxf(t0[i], n0[15 - i]); t1[i] = fmaxf(t1[i], n1[15 - i]); }
#pragma unroll
                for (int j = 8; j > 0; j >>= 1)
#pragma unroll
                    for (int i = 0; i < 16; ++i) { const int l = i ^ j; if (l > i) { const float a0 = t0[i], b0 = t0[l], a1 = t1[i], b1 = t1[l];
                        t0[i] = fmaxf(a0, b0); t0[l] = fminf(a0, b0); t1[i] = fmaxf(a1, b1); t1[l] = fminf(a1, b1); } }
            }
        }
        float best[16];
#pragma unroll
        for (int j = 0; j < 16; ++j) best[j] = -3.0e38f;
#pragma unroll
        for (int ia = 0; ia < 16; ++ia)
#pragma unroll
            for (int ib = 0; ib < 16; ++ib)
                if ((ia + 1) * (ib + 1) <= 16) {
                    float x = __builtin_bit_cast(float, (__builtin_bit_cast(unsigned, t0[ia] + t1[ib]) & ~255u) | (unsigned)(ia * 16 + ib));
#pragma unroll
                    for (int j = 0; j < 16; ++j) { const float tb = fmaxf(best[j], x); x = fminf(best[j], x); best[j] = tb; }
                }
        {
            unsigned w0[4], w1[4];
#pragma unroll
            for (int q = 0; q < 4; ++q) {
                w0[q] = (__builtin_bit_cast(unsigned, t0[4 * q]) & 127u) | ((__builtin_bit_cast(unsigned, t0[4 * q + 1]) & 127u) << 8) | ((__builtin_bit_cast(unsigned, t0[4 * q + 2]) & 127u) << 16) | ((__builtin_bit_cast(unsigned, t0[4 * q + 3]) & 127u) << 24);
                w1[q] = (__builtin_bit_cast(unsigned, t1[4 * q]) & 127u) | ((__builtin_bit_cast(unsigned, t1[4 * q + 1]) & 127u) << 8) | ((__builtin_bit_cast(unsigned, t1[4 * q + 2]) & 127u) << 16) | ((__builtin_bit_cast(unsigned, t1[4 * q + 3]) & 127u) << 24);
            }
#pragma unroll
            for (int q = 0; q < 4; ++q) { myl[q] = w0[q]; myl[4 + q] = w1[q]; }
            LDS_WAIT();
        }
        int eid[16];
#pragma unroll
        for (int j = 0; j < 16; ++j) { const unsigned code = __builtin_bit_cast(unsigned, best[j]) & 255u; const LAS unsigned char* mb = (const LAS unsigned char*)myl;
            eid[j] = (int)mb[code >> 4] * 128 + (int)mb[16 + (code & 15u)]; }
        LDS_WAIT();
        float sum = 0.f; const float bmax = best[0];
#pragma unroll
        for (int j = 0; j < 16; ++j) { best[j] = __expf(best[j] - bmax); sum += best[j]; }
        const float inv = 1.f / sum;
        v4i* ei = (v4i*)(EI + (size_t)r * 128 + hd * 16); f32x4* eg = (f32x4*)(EG + (size_t)r * 128 + hd * 16);
#pragma unroll
        for (int j = 0; j < 4; ++j) { ei[j] = (v4i){eid[4 * j], eid[4 * j + 1], eid[4 * j + 2], eid[4 * j + 3]}; eg[j] = (f32x4){best[4 * j] * inv, best[4 * j + 1] * inv, best[4 * j + 2] * inv, best[4 * j + 3] * inv}; }
    }
}

__device__ __forceinline__ float gelu_tanh(float x) { const float u = 0.7978845608f * (x + 0.044715f * x * x * x); return x * __builtin_amdgcn_rcpf(1.f + __expf(-2.f * u)); }
typedef float f32x2_t __attribute__((ext_vector_type(2)));
__device__ __forceinline__ void peer1_phase(const Frame& F, int rbeg) {
    CArgsP a = kargs(); unsigned char* const ws = a->ws;
    const unsigned char* EU8 = ws + WS_EU; const unsigned char* H8 = ws + WS_H8;
    const int* EI = (const int*)(ws + WS_EI); float* PART = (float*)(ws + WS_PART);
    const int per = F.G >> 3, s = F.vcu / per, rank = F.vcu % per, stride = per * NWAVES;
    const int lane = F.lane, m = lane & 15, g = lane >> 4, row8 = lane >> 3, part = lane & 7;
    const unsigned char* tab = EU8 + (size_t)s * NEXP * 128 + 16 * part;
    LAS unsigned char* wl = F.lds + F.wave * 4608;
    const int wofs = row8 * 144 + part * 16, rofs = m * 144 + 16 * g;
    int r = rbeg + rank * NWAVES + F.wave;
    int id[2][16];
#pragma unroll
    for (int u = 0; u < 2; ++u)
#pragma unroll
        for (int j = 0; j < 16; ++j) id[u][j] = EI[(size_t)min(r + u * stride, R - 1) * 128 + 8 * j + row8];
    for (; r < R; r += 2 * stride) {
        v4u w[2][16]; v4u x[2][2];
#pragma unroll
        for (int u = 0; u < 2; ++u) {
            const int ru = min(r + u * stride, R - 1);
            const unsigned char* xp = H8 + (size_t)ru * D + 128 * s + 16 * g;
            x[u][0] = *(const v4u*)xp; x[u][1] = *(const v4u*)(xp + 64);
#pragma unroll
            for (int j = 0; j < 16; ++j) w[u][j] = *(const v4u*)(tab + (size_t)id[u][j] * 128);
        }
        const int rn = r + 2 * stride;
#pragma unroll
        for (int u = 0; u < 2; ++u)
#pragma unroll
            for (int j = 0; j < 16; ++j) id[u][j] = EI[(size_t)min(rn + u * stride, R - 1) * 128 + 8 * j + row8];
#pragma unroll
        for (int u = 0; u < 2; ++u) {
            f32x4 sel = (f32x4){0.f, 0.f, 0.f, 0.f};
#pragma unroll
            for (int T = 0; T < 8; ++T) {
                LAS unsigned char* buf = wl + (T & 1) * 2304;
                *(LAS v4u*)(buf + wofs) = w[u][2 * T]; *(LAS v4u*)(buf + 8 * 144 + wofs) = w[u][2 * T + 1];
                const v4u a0 = *(const LAS v4u*)(buf + rofs), a1 = *(const LAS v4u*)(buf + rofs + 64);
                f32x4 acc = (f32x4){0.f, 0.f, 0.f, 0.f};
                acc = __builtin_amdgcn_mfma_f32_16x16x32_fp8_fp8((long)(((unsigned long long)a0.y << 32) | a0.x), (long)(((unsigned long long)x[u][0].y << 32) | x[u][0].x), acc, 0, 0, 0);
                acc = __builtin_amdgcn_mfma_f32_16x16x32_fp8_fp8((long)(((unsigned long long)a0.w << 32) | a0.z), (long)(((unsigned long long)x[u][0].w << 32) | x[u][0].z), acc, 0, 0, 0);
                acc = __builtin_amdgcn_mfma_f32_16x16x32_fp8_fp8((long)(((unsigned long long)a1.y << 32) | a1.x), (long)(((unsigned long long)x[u][1].y << 32) | x[u][1].x), acc, 0, 0, 0);
                acc = __builtin_amdgcn_mfma_f32_16x16x32_fp8_fp8((long)(((unsigned long long)a1.w << 32) | a1.z), (long)(((unsigned long long)x[u][1].w << 32) | x[u][1].z), acc, 0, 0, 0);
                sel = (m == T) ? acc : sel;
            }
            const int ru = r + u * stride;
            if (m < 8 && ru < R) *(f32x4*)(PART + ((size_t)s * R + ru) * 128 + 16 * m + 4 * g) = sel;
        }
    }
}
__device__ __forceinline__ void peer_act_phase(const Frame& F, int rbeg) {
    CArgsP a = kargs(); unsigned char* const ws = a->ws;
    const int gtid = F.vcu * NT + F.tid, GT = F.G * NT;
    const float* PART = (const float*)(ws + WS_PART); const int* EI = (const int*)(ws + WS_EI); const float* EG = (const float*)(ws + WS_EG);
    const float* SU = (const float*)(ws + WS_SU); const float* SV = (const float*)(ws + WS_SV); const float* SX = (const float*)(ws + WS_SX);
    float* ACT = (float*)(ws + WS_ACT);
    for (int i = rbeg * 32 + gtid; i < R * 32; i += GT) {
        const int r = i >> 5;
        f32x4 sum = (f32x4){0.f, 0.f, 0.f, 0.f};
#pragma unroll
        for (int q = 0; q < 8; ++q) sum += *(const f32x4*)(PART + (size_t)q * R * 128 + (size_t)i * 4);
        const v4i id = *(const v4i*)(EI + (size_t)i * 4); const f32x4 gt = *(const f32x4*)(EG + (size_t)i * 4);
        const float sx = SX[r];
        f32x4 o;
#pragma unroll
        for (int k = 0; k < 4; ++k) o[k] = gelu_tanh(sum[k] * sx * SU[id[k]]) * gt[k] * SV[id[k]];
        *(f32x4*)(ACT + (size_t)i * 4) = o;
    }
}
__device__ __forceinline__ void peer2_phase(const Frame& F, int layer, bool dry, int rbeg) {
    CArgsP a = kargs(); unsigned char* const ws = a->ws; const bool wr = !dry || a->pad == 12345;
    const unsigned char* EV8 = ws + WS_EV; const int* EI = (const int*)(ws + WS_EI); const float* ACT = (const float*)(ws + WS_ACT);
    const float* MOD = (const float*)(ws + WS_MOD) + (size_t)layer * 9 * 6144 + 5 * D;
    const int per = F.G >> 3, s = F.vcu / per, rank = F.vcu % per, stride = per * NWAVES;
    const int lane = F.lane, part = lane & 7, e8 = lane >> 3;
    const unsigned char* tab = EV8 + (size_t)s * NEXP * 128 + 16 * part;
    const bool b5 = (lane & 32) != 0, b4 = (lane & 16) != 0, b3 = (lane & 8) != 0;
    const int dimoff = 128 * s + 16 * part + (b5 ? 8 : 0) + (b4 ? 4 : 0) + (b3 ? 2 : 0);
    int r = rbeg + rank * NWAVES + F.wave;
    v4i id4[2][4];
#pragma unroll
    for (int u = 0; u < 2; ++u)
#pragma unroll
        for (int q = 0; q < 4; ++q) id4[u][q] = *(const v4i*)(EI + (size_t)min(r + u * stride, R - 1) * 128 + 16 * e8 + 4 * q);
    for (; r < R; r += 2 * stride) {
        v4u w[2][16]; f32x4 a4[2][4];
#pragma unroll
        for (int u = 0; u < 2; ++u) {
            const int ru = min(r + u * stride, R - 1);
#pragma unroll
            for (int j = 0; j < 16; ++j) w[u][j] = *(const v4u*)(tab + (size_t)id4[u][j >> 2][j & 3] * 128);
#pragma unroll
            for (int q = 0; q < 4; ++q) a4[u][q] = *(const f32x4*)(ACT + (size_t)ru * 128 + 16 * e8 + 4 * q);
        }
        const int rn = r + 2 * stride;
#pragma unroll
        for (int u = 0; u < 2; ++u)
#pragma unroll
            for (int q = 0; q < 4; ++q) id4[u][q] = *(const v4i*)(EI + (size_t)min(rn + u * stride, R - 1) * 128 + 16 * e8 + 4 * q);
#pragma unroll
        for (int u = 0; u < 2; ++u) {
            f32x2_t o[8];
#pragma unroll
            for (int k = 0; k < 8; ++k) o[k] = (f32x2_t){0.f, 0.f};
#pragma unroll
            for (int j = 0; j < 16; ++j) {
                const v4u ww = w[u][j];
                const float av = a4[u][j >> 2][j & 3]; const f32x2_t av2 = (f32x2_t){av, av};
                o[0] += av2 * __builtin_amdgcn_cvt_pk_f32_fp8((int)ww.x, false); o[1] += av2 * __builtin_amdgcn_cvt_pk_f32_fp8((int)ww.x, true);
                o[2] += av2 * __builtin_amdgcn_cvt_pk_f32_fp8((int)ww.y, false); o[3] += av2 * __builtin_amdgcn_cvt_pk_f32_fp8((int)ww.y, true);
                o[4] += av2 * __builtin_amdgcn_cvt_pk_f32_fp8((int)ww.z, false); o[5] += av2 * __builtin_amdgcn_cvt_pk_f32_fp8((int)ww.z, true);
                o[6] += av2 * __builtin_amdgcn_cvt_pk_f32_fp8((int)ww.w, false); o[7] += av2 * __builtin_amdgcn_cvt_pk_f32_fp8((int)ww.w, true);
            }
            f32x2_t v4[4], v2[2], v1;
#pragma unroll
            for (int k = 0; k < 4; ++k) { const f32x2_t snd = b5 ? o[k] : o[k + 4], kp = b5 ? o[k + 4] : o[k]; f32x2_t rc; rc.x = shx(snd.x, 32, lane); rc.y = shx(snd.y, 32, lane); v4[k] = kp + rc; }
#pragma unroll
            for (int k = 0; k < 2; ++k) { const f32x2_t snd = b4 ? v4[k] : v4[k + 2], kp = b4 ? v4[k + 2] : v4[k]; f32x2_t rc; rc.x = shx(snd.x, 16, lane); rc.y = shx(snd.y, 16, lane); v2[k] = kp + rc; }
            { const f32x2_t snd = b3 ? v2[0] : v2[1], kp = b3 ? v2[1] : v2[0]; f32x2_t rc; rc.x = shx(snd.x, 8, lane); rc.y = shx(snd.y, 8, lane); v1 = kp + rc; }
            const int ru = r + u * stride;
            if (ru < R) {
                float* xq = xrow_cur(a, ru) + dimoff;
                const f32x2_t ga = *(const f32x2_t*)(MOD + row_slot(ru) * 6144 + dimoff), xx = *(const f32x2_t*)xq;
                if (wr) *(f32x2_t*)xq = xx + ga * v1;
            }
        }
    }
}

__device__ __forceinline__ void final_phase(const Frame& F) {
    CArgsP a = kargs(); unsigned char* const ws = a->ws;
    const int gw = F.vcu * NWAVES + F.wave, NGW = F.G * NWAVES;
    f32x4 gv[4];
#pragma unroll
    for (int j = 0; j < 4; ++j) gv[j] = *((const f32x4*)a->in[I_GF] + F.lane + 64 * j);
    for (int r = gw; r < NLAT; r += NGW) {
        f32x4* xr = (f32x4*)(a->out + (size_t)r * D) + F.lane;
        f32x4 v[4]; float ss = 0.f;
#pragma unroll
        for (int j = 0; j < 4; ++j) { v[j] = xr[64 * j]; ss += (v[j][0] * v[j][0] + v[j][1] * v[j][1]) + (v[j][2] * v[j][2] + v[j][3] * v[j][3]); }
        const float rs = rsqrtf(wave_sum(ss, F.lane) * (1.f / D) + EPS);
#pragma unroll
        for (int j = 0; j < 4; ++j) xr[64 * j] = v[j] * rs * gv[j];
    }
}

__global__ void __launch_bounds__(NT, 2) fwd_kernel(Args args) {
    extern __shared__ __attribute__((aligned(16))) unsigned char lds[];
    Frame F;
    F.lds = (LAS unsigned char*)lds;
    F.tid = 0; F.lane = 0; F.wave = __builtin_amdgcn_readfirstlane((int)threadIdx.x >> 6);
    F.G = gridDim.x; { const int bx = blockIdx.x; F.vcu = (F.G % 8 == 0) ? (bx % 8) * (F.G / 8) + bx / 8 : bx; }
    volatile LAS unsigned* MISC = (volatile LAS unsigned*)(F.lds + MISC_OFF);
    for (int u = threadIdx.x; u < (LDS_BYTES - LDSCTL_OFF) / 4; u += NT) ((LAS unsigned*)(F.lds + LDSCTL_OFF))[u] = 0u;
    __syncthreads();
    XcdBarrier bar; bar.bar = (unsigned*)(args.ws + WS_CTL) + CW_BAR; bar.x = 0; bar.st = nullptr;
    if (MK_SINGLE) bar = xcd_barrier_post((unsigned*)(args.ws + WS_CTL) + CW_BAR, MISC + 8);
    const int lo = args.ph_lo, hi = args.ph_hi;
#define IN(k) (lo <= (k) && (k) < hi)
#define OPQ_BX ({ int bx_ = (int)blockIdx.x; asm volatile("" : "+s"(bx_)); bx_; })
#define PF Frame Fp = F; { int t_ = threadIdx.x; asm volatile("" : "+v"(t_), "+s"(Fp.vcu), "+s"(Fp.wave), "+s"(Fp.G)); Fp.tid = t_; Fp.lane = t_ & 63; }
#define SEAM(k) do { if (MK_SINGLE && IN(k) && IN((k) + 1)) { XcdBarrier b2_ = bar; asm volatile("" : "+s"(b2_.bar));     \
        xcd_barrier(b2_); if (PROBE == 50) xcd_barrier(b2_); } } while (0)

    if (IN(0)) { if (PROBE == 99) { PF; p0_prologue(Fp); } { PF; p0_prologue(Fp); } SEAM(0); }

    for (int l = 0; l < DEPTH; ++l) {
        const int pb = 1 + l * NPL;
        const int pm0 = (l == DEPTH - 1) ? 8 : 0, rbeg = pm0 * 256;
        if (IN(pb + 0)) { { PF; norm_phase(Fp, l, 0, 0); } { PF; convert_experts(Fp, l); } if (PROBE == 30) { PF; convert_experts(Fp, l); } SEAM(pb + 0); }
        if (IN(pb + 1)) {
            CArgsP ap = kargs(); unsigned char* const ws = ap->ws; bf16* Hb = (bf16*)(ws + WS_H); bf16* PA = (bf16*)(ws + WS_PA); bf16* PG = (bf16*)(ws + WS_PG);
            pg8::Gemm g{Hb, (const bf16*)(ws + WS_WIN) + (size_t)l * NPAD * D, R, NPAD, D, D}; pg8::StaticOrder S; S.init(R, NPAD, F.G, OPQ_BX);
            EpiIn E{PA, PG, (float*)(ws + WS_Z), (const float*)(ws + WS_ROPE), (bf16*)(ws + WS_VT), (bf16*)(ws + WS_NVT)};
            for (int rep = 0; rep < (PROBE == 1 ? 2 : 1); ++rep) pg8::gemm_phase<EpiIn, pg8::StaticOrder, true, true>(F.lds, g, S, E);
            SEAM(pb + 1);
        }
        if (IN(pb + 2)) { { PF; gla_a_phase(Fp, l); } if (PROBE == 2) { PF; gla_a_phase(Fp, l); } { const int nrep = (PROBE == 20 ? 2 : 1) + (kargs()->pad != 0 ? 1 : 0); for (int rep = 0; rep < nrep; ++rep) { PF; na_phase(Fp, l, rep + 1 < nrep, l == DEPTH - 1); } } SEAM(pb + 2); }
        if (IN(pb + 3)) { if (PROBE == 3) { PF; gla_b_phase(Fp, true); } { PF; gla_b_phase(Fp, false); } SEAM(pb + 3); }
        if (IN(pb + 4)) { if (PROBE == 4) { PF; gla_c_phase(Fp, l, true); } { PF; gla_c_phase(Fp, l, false); } SEAM(pb + 4); }
        if (IN(pb + 5)) {
            CArgsP ap = kargs(); unsigned char* const ws = ap->ws; bf16* Hb = (bf16*)(ws + WS_H); bf16* PA = (bf16*)(ws + WS_PA); bf16* PG = (bf16*)(ws + WS_PG);
            pg8::ShiftOrder S; S.init(R - rbeg, D, F.G, OPQ_BX); S.pm0 = pm0;
            for (int rep = 0; rep < (PROBE == 5 ? 2 : 1); ++rep) {
            { pg8::Gemm g{PA + PA_R, (const bf16*)(ws + WS_WPG) + (size_t)l * D * 512, R, D, 512, PA_LD}; EpiMerge<0> E{Hb, PG}; pg8::gemm_phase<EpiMerge<0>, pg8::ShiftOrder, true, true>(F.lds, g, S, E); }
            { pg8::Gemm g{PA + PA_NQ, (const bf16*)(ws + WS_WPN) + (size_t)l * D * 512, R, D, 512, PA_LD}; EpiMerge<1> E{Hb, PG}; pg8::gemm_phase<EpiMerge<1>, pg8::ShiftOrder, true, true>(F.lds, g, S, E); }
            }
            SEAM(pb + 5);
        }
        if (IN(pb + 6)) {
            CArgsP ap = kargs(); unsigned char* const ws = ap->ws; bf16* Hb = (bf16*)(ws + WS_H);
            pg8::Gemm g{Hb, (const bf16*)(ws + WS_WO) + (size_t)l * D * D, R, D, D, D}; pg8::ShiftOrder S; S.init(R - rbeg, D, F.G, OPQ_BX); S.pm0 = pm0;
            EpiRes E{l == 0 ? ap->in[I_CTX] : (const float*)(ws + WS_XC), l == 0 ? ap->in[I_X] : (const float*)ap->out, (float*)(ws + WS_XC), ap->out, (const float*)(ws + WS_MOD) + (size_t)l * 9 * 6144};
            pg8::gemm_phase<EpiRes, pg8::ShiftOrder, true, true>(F.lds, g, S, E);
            SEAM(pb + 6);
        }
        if (IN(pb + 7)) { if (PROBE == 7) { PF; norm_phase(Fp, l, 1, rbeg); } { PF; norm_phase(Fp, l, 1, rbeg); } SEAM(pb + 7); }
        if (IN(pb + 8)) {
            CArgsP ap = kargs(); unsigned char* const ws = ap->ws; bf16* Hb = (bf16*)(ws + WS_H);
            pg8::Gemm g{Hb, (const bf16*)(ws + WS_WS) + (size_t)l * 2048 * D, R, 2048, D, D}; pg8::ShiftOrder S; S.init(R - rbeg, 2048, F.G, OPQ_BX); S.pm0 = pm0;
            EpiB16 E{(bf16*)(ws + WS_SC), 2048};
            for (int rep = 0; rep < (PROBE == 8 ? 2 : 1); ++rep) pg8::gemm_phase<EpiB16, pg8::ShiftOrder, true, true>(F.lds, g, S, E);
            SEAM(pb + 8);
        }
        if (IN(pb + 9)) { if (PROBE == 9) { PF; topk_phase(Fp, rbeg); } { PF; topk_phase(Fp, rbeg); } SEAM(pb + 9); }
        if (IN(pb + 10)) { if (PROBE == 10) { PF; peer1_phase(Fp, rbeg); } { PF; peer1_phase(Fp, rbeg); } SEAM(pb + 10); }
        if (IN(pb + 11)) { if (PROBE == 11) { PF; peer_act_phase(Fp, rbeg); } { PF; peer_act_phase(Fp, rbeg); } SEAM(pb + 11); }
        if (IN(pb + 12)) { if (PROBE == 12) { PF; peer2_phase(Fp, l, true, rbeg); } { PF; peer2_phase(Fp, l, false, rbeg); } SEAM(pb + 12); }
    }
    if (IN(NPHASE - 1)) { PF; final_phase(Fp); }
#undef IN
#undef SEAM
}

extern "C" void kernel_launch(void* const* d_in, const int* in_sizes, int n_in, void* d_out, int out_size, void* d_ws, size_t ws_size, hipStream_t stream) {
    static int grid = 0;
    if (grid == 0) {
        if (n_in != 23 || in_sizes[0] != NLAT * D || out_size != NLAT * D || ws_size < WS_END) { fprintf(stderr, "kernel_launch: unexpected shapes (n_in %d, in0 %d, out %d, ws %zu); nothing launched\n", n_in, n_in > 0 ? in_sizes[0] : -1, out_size, ws_size); grid = -1; return; }
        int dev = 0, cus = 0, per_cu = 0;
        if (hipGetDevice(&dev) != hipSuccess || hipDeviceGetAttribute(&cus, hipDeviceAttributeMultiprocessorCount, dev) != hipSuccess) { grid = -1; return; }
        if (hipFuncSetAttribute((const void*)fwd_kernel, hipFuncAttributeMaxDynamicSharedMemorySize, LDS_BYTES) != hipSuccess) { fprintf(stderr, "kernel_launch: hipFuncSetAttribute failed\n"); grid = -1; return; }
        if (hipOccupancyMaxActiveBlocksPerMultiprocessor(&per_cu, (const void*)fwd_kernel, NT, LDS_BYTES) != hipSuccess || per_cu < 1) { fprintf(stderr, "kernel_launch: occupancy query says %d blocks per CU\n", per_cu); }
        (void)hipGetLastError();
        grid = cus;
    }
    if (grid < 0) return;
    if (hipMemsetAsync((char*)d_ws + WS_CTL, 0, CTL_ZERO_BYTES, stream) != hipSuccess) return;
    Args a{};
    for (int i = 0; i < 23; ++i) a.in[i] = (const float*)d_in[i];
    a.out = (float*)d_out; a.ws = (unsigned char*)d_ws; a.pad = 0;
    if (MK_SINGLE) {
        a.ph_lo = 0; a.ph_hi = NPHASE; a.li = 0;
        hipLaunchKernelGGL(fwd_kernel, dim3(grid), dim3(NT), LDS_BYTES, stream, a);
    } else {
        for (int p = 0; p < NPHASE; ++p) { a.ph_lo = p; a.ph_hi = p + 1; a.li = p; hipLaunchKernelGGL(fwd_kernel, dim3(grid), dim3(NT), LDS_BYTES, stream, a); }
    }
}
```

```cpp
#include <hip/hip_runtime.h>
#include <cstdio>
#include <cstdint>

#ifndef PROBE
#define PROBE 0
#endif
#ifndef MK_SINGLE
#define MK_SINGLE 1
#endif

namespace pg8 {
#define PG8_LAS __attribute__((address_space(3)))
typedef unsigned short bf16_t;
typedef short bf16x8 __attribute__((ext_vector_type(8)));
typedef float f32x4 __attribute__((ext_vector_type(4)));
typedef unsigned u32x4 __attribute__((ext_vector_type(4)));
constexpr int BM = 256, BK = 64, HALF = 128, HTB = HALF * BK * 2, STAGE_BYTES = 8 * HTB, NXCD = 8, WGM = 8;

__host__ __device__ __forceinline__ int lds_byte(int r, int c) { const int st = (r >> 4) * 2 + (c >> 5), rr = r & 15, cc = c & 31, ob = rr * 64 + cc * 2; return st * 1024 + (ob ^ (((ob >> 9) & 1) << 5)); }
__host__ __device__ __forceinline__ void stage_rc(int b, int& R, int& C) { const int st = b / 1024, sb = b % 1024, swz = sb ^ (((sb >> 9) & 1) << 5); R = (st >> 1) * 16 + swz / 64; C = (st & 1) * 32 + (swz % 64) / 2; }
__host__ __device__ __forceinline__ int perm32(int rho) { const int n = rho >> 4, i = rho & 15; return 8 * (i >> 2) + 4 * n + (i & 3); }

struct Unit { int pm, pn; };
struct Gemm { const bf16_t* A; const bf16_t* Bt; int M, N, K, lda; };

struct StaticOrder {
    int nM, nN, nwg, G, c;
    __host__ __device__ void init(int M, int N, int G_, int c_) { nM = M / BM; nN = N / BM; nwg = nM * nN; G = G_; c = c_; }
    __host__ __device__ bool next(int i, Unit& u) const {
        const long L = (long)i * G + c; if (L >= nwg) return false;
        int wgid = (int)L; { const int q = nwg / NXCD, r = nwg % NXCD, xcd = wgid % NXCD, off = wgid / NXCD; wgid = (xcd < r ? xcd * (q + 1) : r * (q + 1) + (xcd - r) * q) + off; }
        const int nig = WGM * nN, gid = wgid / nig, fm = gid * WGM, gsz = (nM - fm) < WGM ? (nM - fm) : WGM;
        u.pm = fm + ((wgid % nig) % gsz); u.pn = (wgid % nig) / gsz; return true;
    }
    __device__ __forceinline__ void a_ready(const Unit&) const {}
    __device__ __forceinline__ void done(const Unit&) const {}
};
struct ShiftOrder : StaticOrder { int pm0; __host__ __device__ bool next(int i, Unit& u) const { if (!StaticOrder::next(i, u)) return false; u.pm += pm0; return true; } };

__device__ __forceinline__ unsigned cvt_pk_bf16(float lo, float hi) { unsigned r; asm volatile("v_cvt_pk_bf16_f32 %0, %1, %2" : "=v"(r) : "v"(lo), "v"(hi)); return r; }

template <class Epi, class Sched, bool ALIGN_EPI = false, bool SP2 = false>
__device__ __forceinline__ void gemm_phase(PG8_LAS unsigned char* lds, const Gemm g, const Sched& S, const Epi& E) {
    int tid_ = threadIdx.x; asm volatile("" : "+v"(tid_));
    const int tid = tid_, wid = __builtin_amdgcn_readfirstlane(tid >> 6), lane = tid & 63, wr = wid >> 2, wc = wid & 3, fr = lane & 15, fq = lane >> 4;
    const int K = g.K, nt = K / BK, lda = g.lda;
    unsigned voffA[2], voffB[2];
#pragma unroll
    for (int i = 0; i < 2; ++i) { int R, C; stage_rc(tid * 16 + i * 8192, R, C); const int Rb = Epi::PERM ? ((R & ~31) + perm32(R & 31)) : R;
        voffA[i] = (unsigned)(R * lda + C) * 2u; voffB[i] = (unsigned)(Rb * K + C) * 2u; }
    const size_t kstep = (size_t)(BK * 2);
    const size_t hstepA = (size_t)HALF * lda * 2, hstepB = (size_t)HALF * K * 2;
    const size_t tstepA = 2 * hstepA, tstepB = 2 * hstepB;
    const unsigned ldsw = (unsigned)wid * 1024u;
    const int aoff = lds_byte(wr * 64 + fr, fq * 8), boff = lds_byte(wc * 32 + fr, fq * 8);
#define PG8_SA(b, h) (((b) * 2 + (h)) * HTB)
#define PG8_SB(b, h) ((4 + (b) * 2 + (h)) * HTB)
#define PG8_STAGE(bufoff, gbase, voff) do { _Pragma("unroll") for (int _i = 0; _i < 2; ++_i) \
        __builtin_amdgcn_global_load_lds((const unsigned*)((const char*)(gbase) + (voff)[_i]), (PG8_LAS unsigned*)(lds + (bufoff) + ldsw + _i * 8192), 16, 0, 0); } while (0)
#define PG8_LDA(dst, b, h) do { _Pragma("unroll") for (int m = 0; m < 4; ++m) _Pragma("unroll") for (int k = 0; k < 2; ++k) dst[m][k] = *(const PG8_LAS bf16x8*)(lds + PG8_SA(b, h) + aoff + m * 2048 + k * 1024); } while (0)
#define PG8_LDB(dst, b, h) do { _Pragma("unroll") for (int n = 0; n < 2; ++n) _Pragma("unroll") for (int k = 0; k < 2; ++k) dst[n][k] = *(const PG8_LAS bf16x8*)(lds + PG8_SB(b, h) + boff + n * 2048 + k * 1024); } while (0)
#define PG8_MMA(ai, bj, At, Bt) do { __builtin_amdgcn_s_setprio(1); _Pragma("unroll") for (int m = 0; m < 4; ++m) _Pragma("unroll") for (int n = 0; n < 2; ++n) _Pragma("unroll") for (int k = 0; k < 2; ++k) \
        acc[ai][bj][m][n] = __builtin_amdgcn_mfma_f32_16x16x32_bf16(Bt[n][k], At[m][k], acc[ai][bj][m][n], 0, 0, 0); __builtin_amdgcn_s_setprio(0); } while (0)
#define PG8_WAIT_V(n) asm volatile("s_waitcnt vmcnt(" #n ")" ::: "memory")
#define PG8_WAIT_L(n) asm volatile("s_waitcnt lgkmcnt(" #n ")" ::: "memory")
#define PG8_BAR __builtin_amdgcn_s_barrier()
#define PG8_SCHED __builtin_amdgcn_sched_barrier(0)
    Unit cur, nxt; int ui = 0;
    if (!S.next(0, cur)) return;
    f32x4 acc[2][2][4][2];
#pragma unroll
    for (int a = 0; a < 2; ++a)
#pragma unroll
        for (int b = 0; b < 2; ++b)
#pragma unroll
            for (int m = 0; m < 4; ++m)
#pragma unroll
                for (int n = 0; n < 2; ++n) acc[a][b][m][n] = (f32x4){0.f, 0.f, 0.f, 0.f};
    bf16x8 At[4][2], B0[2][2], B1[2][2];
    const char* cA = (const char*)g.A + (size_t)cur.pm * tstepA; const char* cB = (const char*)g.Bt + (size_t)cur.pn * tstepB;
    S.a_ready(cur);
    if constexpr (SP2) {
        PG8_STAGE(PG8_SB(0, 0), cB, voffB); PG8_STAGE(PG8_SB(0, 1), cB + hstepB, voffB); PG8_STAGE(PG8_SA(0, 0), cA, voffA); PG8_STAGE(PG8_SA(0, 1), cA + hstepA, voffA);
        if (wr == 1) PG8_BAR;
        PG8_WAIT_V(2); PG8_BAR;
        PG8_STAGE(PG8_SB(1, 0), cB + kstep, voffB); PG8_STAGE(PG8_SA(1, 0), cA + kstep, voffA); PG8_STAGE(PG8_SB(1, 1), cB + hstepB + kstep, voffB);
        PG8_WAIT_V(6); PG8_BAR;
    } else {
        PG8_STAGE(PG8_SB(0, 0), cB, voffB); PG8_STAGE(PG8_SA(0, 0), cA, voffA); PG8_STAGE(PG8_SB(0, 1), cB + hstepB, voffB); PG8_STAGE(PG8_SA(0, 1), cA + hstepA, voffA);
        if (wr == 1) PG8_BAR;
        PG8_WAIT_V(4); PG8_BAR;
        PG8_STAGE(PG8_SB(1, 0), cB + kstep, voffB); PG8_STAGE(PG8_SA(1, 0), cA + kstep, voffA); PG8_STAGE(PG8_SB(1, 1), cB + hstepB + kstep, voffB);
        PG8_WAIT_V(6); PG8_BAR;
    }
    for (;;) {
        const bool has_next = S.next(ui + 1, nxt);
        const char* nA = has_next ? (const char*)g.A + (size_t)nxt.pm * tstepA : cA; const char* nB = has_next ? (const char*)g.Bt + (size_t)nxt.pn * tstepB : cB;
        for (int t = 0; t < nt; t += 2) {
            const bool last = (t == nt - 2);
            const char* a1 = cA + (size_t)(t + 1) * kstep;
            const char* a2 = last ? nA : cA + (size_t)(t + 2) * kstep; const char* b2 = last ? nB : cB + (size_t)(t + 2) * kstep;
            const char* a3 = a2 + kstep; const char* b3 = b2 + kstep;
            if (last && has_next) S.a_ready(nxt);
            if constexpr (Epi::HAS_MID) { if (t == nt / 2) E.mid(acc, cur, wr, wc, fr, fq); }
            if constexpr (SP2) {
            PG8_LDB(B0, 0, 0); PG8_LDB(B1, 0, 1); PG8_SCHED; PG8_LDA(At, 0, 0); PG8_STAGE(PG8_SA(1, 1), a1 + hstepA, voffA);
            PG8_WAIT_V(8); PG8_WAIT_L(0); PG8_BAR; PG8_MMA(0, 0, At, B0); PG8_MMA(0, 1, At, B1); PG8_BAR; PG8_SCHED;
            PG8_LDA(At, 0, 1); PG8_STAGE(PG8_SB(0, 0), b2, voffB); PG8_STAGE(PG8_SB(0, 1), b2 + hstepB, voffB); PG8_STAGE(PG8_SA(0, 0), a2, voffA);
            PG8_WAIT_V(8); PG8_WAIT_L(0); PG8_BAR; PG8_MMA(1, 0, At, B0); PG8_MMA(1, 1, At, B1); PG8_BAR; PG8_SCHED;
            PG8_LDB(B0, 1, 0); PG8_LDB(B1, 1, 1); PG8_SCHED; PG8_LDA(At, 1, 0); PG8_STAGE(PG8_SA(0, 1), a2 + hstepA, voffA);
            PG8_WAIT_V(8); PG8_WAIT_L(0); PG8_BAR; PG8_MMA(0, 0, At, B0); PG8_MMA(0, 1, At, B1); PG8_BAR; PG8_SCHED;
            PG8_LDA(At, 1, 1); PG8_STAGE(PG8_SB(1, 0), b3, voffB); PG8_STAGE(PG8_SB(1, 1), b3 + hstepB, voffB); PG8_STAGE(PG8_SA(1, 0), a3, voffA);
            PG8_WAIT_V(8); PG8_WAIT_L(0); PG8_BAR; PG8_MMA(1, 0, At, B0); PG8_MMA(1, 1, At, B1); PG8_BAR; PG8_SCHED;
            } else {
            PG8_LDB(B0, 0, 0); PG8_SCHED; PG8_LDA(At, 0, 0); PG8_STAGE(PG8_SA(1, 1), a1 + hstepA, voffA);
            PG8_WAIT_L(8); PG8_BAR; PG8_WAIT_L(0); PG8_MMA(0, 0, At, B0); PG8_BAR; PG8_SCHED;
            PG8_LDB(B1, 0, 1); PG8_STAGE(PG8_SB(0, 0), b2, voffB);
            PG8_BAR; PG8_WAIT_L(0); PG8_MMA(0, 1, At, B1); PG8_BAR;
            PG8_LDA(At, 0, 1); PG8_STAGE(PG8_SA(0, 0), a2, voffA);
            PG8_BAR; PG8_WAIT_L(0); PG8_MMA(1, 0, At, B0); PG8_BAR; PG8_SCHED;
            PG8_STAGE(PG8_SB(0, 1), b2 + hstepB, voffB);
            PG8_WAIT_V(6); PG8_BAR; PG8_MMA(1, 1, At, B1); PG8_BAR;
            PG8_LDB(B0, 1, 0); PG8_SCHED; PG8_LDA(At, 1, 0); PG8_STAGE(PG8_SA(0, 1), a2 + hstepA, voffA);
            PG8_WAIT_L(8); PG8_BAR; PG8_WAIT_L(0); PG8_MMA(0, 0, At, B0); PG8_BAR; PG8_SCHED;
            PG8_LDB(B1, 1, 1); PG8_STAGE(PG8_SB(1, 0), b3, voffB);
            PG8_BAR; PG8_WAIT_L(0); PG8_MMA(0, 1, At, B1); PG8_BAR;
            PG8_LDA(At, 1, 1); PG8_STAGE(PG8_SA(1, 0), a3, voffA);
            PG8_BAR; PG8_WAIT_L(0); PG8_MMA(1, 0, At, B0); PG8_BAR; PG8_SCHED;
            PG8_STAGE(PG8_SB(1, 1), b3 + hstepB, voffB);
            PG8_WAIT_V(6); PG8_BAR; PG8_MMA(1, 1, At, B1); PG8_BAR;
            }
        }
        if constexpr (ALIGN_EPI) { if (wr == 0) PG8_BAR; }
        E(acc, cur, wr, wc, fr, fq); S.done(cur);
        if (!has_next) break;
#pragma unroll
        for (int a = 0; a < 2; ++a)
#pragma unroll
            for (int b = 0; b < 2; ++b)
#pragma unroll
                for (int m = 0; m < 4; ++m)
#pragma unroll
                    for (int n = 0; n < 2; ++n) acc[a][b][m][n] = (f32x4){0.f, 0.f, 0.f, 0.f};
        cur = nxt; cA = nA; cB = nB; ++ui;
        if constexpr (ALIGN_EPI) { if (wr == 1) PG8_BAR; }
    }
    PG8_WAIT_V(0);
    if constexpr (!ALIGN_EPI) { if (wr == 0) PG8_BAR; }
    PG8_BAR;
#undef PG8_SA
#undef PG8_SB
#undef PG8_STAGE
#undef PG8_LDA
#undef PG8_LDB
#undef PG8_MMA
#undef PG8_WAIT_V
#undef PG8_WAIT_L
#undef PG8_BAR
#undef PG8_SCHED
}
}

constexpr int D = 1024, BATCH = 8, SEQ = 8192, DEPTH = 4, CTXL = 256, GRIDW = 64;
constexpr int NCTX = BATCH * CTXL;
constexpr int NLAT = BATCH * SEQ;
constexpr int R = NCTX + NLAT;
constexpr int IN_COLS = 5152, NPAD = 5376;
constexpr int PA_LD = 2048, PG_LD = 2048;
constexpr int PA_Q = 0, PA_K = 256, PA_R = 512, PA_NQ = 1024, PA_NK = 1536;
constexpr int NCHUNK = 132;
constexpr int NEXP = 16384;
constexpr float EPS = 1e-6f;
constexpr int NWAVES = 8, NT = 512;
constexpr int NPL = 13;
constexpr int NPHASE = 1 + DEPTH * NPL + 1;

constexpr size_t MiB = 1u << 20;
constexpr size_t WS_CTL = 0, CTL_ZERO_BYTES = 2 * MiB;
constexpr size_t WS_MOD = 1 * MiB;
constexpr size_t WS_ROPE = 2 * MiB;
constexpr size_t WS_WIN = 3 * MiB;
constexpr size_t WS_WPG = 45 * MiB, WS_WPN = 49 * MiB;
constexpr size_t WS_WO = 53 * MiB;
constexpr size_t WS_WS = 61 * MiB;
constexpr size_t WS_XC = 77 * MiB;
constexpr size_t WS_Z = 85 * MiB;
constexpr size_t WS_EU = 94 * MiB, WS_EV = 110 * MiB;
constexpr size_t WS_SU = 126 * MiB, WS_SV = WS_SU + 65536, WS_SX = WS_SV + 65536;
constexpr size_t WS_H8 = 884 * MiB;
constexpr size_t WS_PART = 290 * MiB;
constexpr size_t WS_ACT = 554 * MiB;
constexpr size_t WS_H = 158 * MiB;
constexpr size_t WS_PA = 290 * MiB;
constexpr size_t WS_VT = 554 * MiB, WS_NVT = 620 * MiB;
constexpr size_t WS_DEC = 950 * MiB;
constexpr size_t WS_PG = 686 * MiB;
constexpr size_t WS_SC = 290 * MiB;
constexpr size_t WS_EI = 818 * MiB, WS_EG = 851 * MiB;
constexpr size_t WS_END = 953 * MiB;
static_assert(WS_SC + (size_t)R * 2048 * 4 <= WS_EI && WS_EG + (size_t)R * 128 * 4 <= WS_DEC && WS_PG + (size_t)R * PG_LD * 2 <= WS_DEC && WS_DEC + 64 * 132 * 64 * 4 <= WS_END, "ws map");
static_assert(WS_H + (size_t)R * 1024 * 2 <= WS_PA && WS_PA + (size_t)R * PA_LD * 2 <= WS_VT && WS_VT + (size_t)R * 512 * 2 <= WS_NVT && WS_NVT + (size_t)R * 512 * 2 <= WS_PG && WS_Z + (size_t)R * 32 * 4 <= WS_EU, "ws map");
constexpr int CW_BAR = 4096;

constexpr int RING_BYTES = 131072, LDSCTL_OFF = RING_BYTES, MISC_OFF = LDSCTL_OFF + 320, LDS_BYTES = 147456;

#define GAS __attribute__((address_space(1)))
#define LAS __attribute__((address_space(3)))
typedef unsigned short bf16;
typedef unsigned v4u __attribute__((ext_vector_type(4)));
typedef unsigned v2u __attribute__((ext_vector_type(2)));
typedef int v4i __attribute__((ext_vector_type(4)));
typedef float f32x4 __attribute__((ext_vector_type(4)));
typedef __bf16 bf16x2_t __attribute__((ext_vector_type(2)));
#define LDS_WAIT() asm volatile("s_waitcnt lgkmcnt(0)" ::: "memory")
#define VM_WAIT() asm volatile("s_waitcnt vmcnt(0)" ::: "memory")
__device__ __forceinline__ unsigned f2bf(float f) { unsigned u = __builtin_bit_cast(unsigned, f); return (u + 0x7fffu + ((u >> 16) & 1u)) >> 16; }
__device__ __forceinline__ unsigned pk2(float lo, float hi) { return f2bf(lo) | (f2bf(hi) << 16); }
__device__ __forceinline__ float bflo(unsigned w) { return __builtin_bit_cast(float, w << 16); }
__device__ __forceinline__ float bfhi(unsigned w) { return __builtin_bit_cast(float, w & 0xffff0000u); }
__device__ __forceinline__ float bf1(bf16 h) { return __builtin_bit_cast(float, ((unsigned)h) << 16); }
__device__ __forceinline__ float dot2(unsigned a, unsigned b, float acc) { return __builtin_amdgcn_fdot2_f32_bf16(__builtin_bit_cast(bf16x2_t, a), __builtin_bit_cast(bf16x2_t, b), acc, false); }
__device__ __forceinline__ float shx(float v, int mask, int lane) { return __builtin_bit_cast(float, __builtin_amdgcn_ds_bpermute((lane ^ mask) << 2, __builtin_bit_cast(int, v))); }
__device__ __forceinline__ float wave_sum(float v, int lane) {
#pragma unroll
    for (int o = 1; o < 64; o <<= 1) v += shx(v, o, lane);
    return v;
}
__device__ __forceinline__ float wave_max(float v, int lane) {
#pragma unroll
    for (int o = 1; o < 64; o <<= 1) v = fmaxf(v, shx(v, o, lane));
    return v;
}
__device__ __forceinline__ float sigmoidf_(float x) { return __builtin_amdgcn_rcpf(1.f + __expf(-x)); }

#define XB_TMO      128
#define XB_XCNT(j)  (256  + 64 * (j))
#define XB_XSUB(j)  (1280 + 64 * (j))
#define XB_XGEN(j)  (2304 + 64 * (j))
#define XB_TOP      3328
#define XB_TOPGEN   3392
#define XCD_BAR_WORDS 3456
#define XB_SPIN_CAP (1u << 18)
__device__ __forceinline__ unsigned xb_ld(unsigned* p)              { return __hip_atomic_load(p, __ATOMIC_RELAXED, __HIP_MEMORY_SCOPE_AGENT); }
__device__ __forceinline__ unsigned xb_add(unsigned* p, unsigned v) { return __hip_atomic_fetch_add(p, v, __ATOMIC_RELAXED, __HIP_MEMORY_SCOPE_AGENT); }
__device__ __forceinline__ unsigned xb_xcc_id() { return (unsigned)__builtin_amdgcn_s_getreg((3 << 11) | 20) & 0xFu; }
#define XB_SPIN(cond, bar) do { unsigned _sp = 0; while (cond) { __builtin_amdgcn_s_sleep(1); \
    if ((++_sp & 255u) == 0u) { if (xb_ld(&(bar)[XB_TMO])) break; if (_sp > XB_SPIN_CAP) { atomicAdd(&(bar)[XB_TMO], 1u); break; } } } } while (0)
struct XcdBarrier { unsigned* bar; unsigned x; volatile LAS unsigned* st; };
__device__ __forceinline__ XcdBarrier xcd_barrier_post(unsigned* bar, volatile LAS unsigned* st) {
    XcdBarrier b; b.bar = bar; b.x = xb_xcc_id(); b.st = st;
    if (threadIdx.x == 0) (void)xb_add(&bar[XB_XCNT(b.x)], 1u);
    return b;
}
__device__ __forceinline__ void xcd_barrier_complete(unsigned* bar, unsigned x, unsigned& nloc, unsigned& nx) {
    const unsigned G = gridDim.x * gridDim.y * gridDim.z;
    unsigned sum, cnt, mine, sp = 0u;
    for (;;) {
        sum = 0u; cnt = 0u; mine = 0u;
#pragma unroll
        for (unsigned j = 0; j < 16; ++j) { const unsigned c = xb_ld(&bar[XB_XCNT(j)]); sum += c; cnt += (c > 0u) ? 1u : 0u; mine = (j == x) ? c : mine; }
        if (sum == G) break;
        __builtin_amdgcn_s_sleep(1);
        if ((++sp & 255u) == 0u) { if (xb_ld(&bar[XB_TMO])) break; if (sp > XB_SPIN_CAP) { atomicAdd(&bar[XB_TMO], 1u); break; } }
    }
    nloc = mine > 0u ? mine : 1u; nx = cnt > 0u ? cnt : 1u;
}
__device__ __forceinline__ void xcd_barrier(const XcdBarrier& b) {
    asm volatile("s_waitcnt vmcnt(0)" ::: "memory");
    __syncthreads();
    int tid0_ = threadIdx.x; asm volatile("" : "+v"(tid0_));
    if (tid0_ == 0) {
        unsigned* bar = b.bar;
        __builtin_amdgcn_s_waitcnt(0);
        unsigned nloc = b.st[0], nx = b.st[1];
        if (nloc == 0u) { xcd_barrier_complete(bar, b.x, nloc, nx); b.st[0] = nloc; b.st[1] = nx; }
        const unsigned old = xb_add(&bar[XB_XSUB(b.x)], 1u);
        const unsigned gen = old / nloc;
        if (old + 1u == (gen + 1u) * nloc) {
            __builtin_amdgcn_fence(__ATOMIC_RELEASE, "agent");
            asm volatile("s_waitcnt vmcnt(0)" ::: "memory");
            const unsigned og = xb_add(&bar[XB_TOP], 1u);
            const unsigned tg = og / nx;
            if (og + 1u == (tg + 1u) * nx) xb_add(&bar[XB_TOPGEN], 1u);
            else XB_SPIN(xb_ld(&bar[XB_TOPGEN]) == tg, bar);
            __builtin_amdgcn_fence(__ATOMIC_ACQUIRE, "agent");
            xb_add(&bar[XB_XGEN(b.x)], 1u);
            asm volatile("s_waitcnt vmcnt(0)" ::: "memory");
        } else {
            XB_SPIN(xb_ld(&bar[XB_XGEN(b.x)]) == gen, bar);
            __builtin_amdgcn_fence(__ATOMIC_ACQUIRE, "agent");
            asm volatile("s_waitcnt vmcnt(0)" ::: "memory");
        }
    }
    __syncthreads();
}

struct Args { const float* in[23]; float* out; unsigned char* ws; int ph_lo, ph_hi, li, pad; };
enum { I_X = 0, I_C, I_CTX, I_CCTX, I_WMOD, I_BMOD, I_GN1, I_WIN, I_WAF, I_BAF, I_WAB, I_BAB, I_GGLA, I_RPB, I_WPG, I_WPN, I_WO, I_GN2, I_WQ, I_SK, I_EU, I_EV, I_GF };

struct Frame {
    LAS unsigned char* lds;
    int tid, lane, wave, vcu, G;
};
typedef const __attribute__((address_space(4))) Args* CArgsP;
__device__ __forceinline__ CArgsP kargs() { CArgsP p = (CArgsP)__builtin_amdgcn_kernarg_segment_ptr(); asm volatile("" : "+s"(p)); return p; }
__device__ __forceinline__ const float* xrow_in(CArgsP a, int r) { return r < NCTX ? a->in[I_CTX] + (size_t)r * D : a->in[I_X] + (size_t)(r - NCTX) * D; }
constexpr int XL_LD = 2048;
__device__ __forceinline__ float* xc_row(CArgsP a, int r) { return (float*)(a->ws + WS_XC) + (size_t)r * D; }
__device__ __forceinline__ bf16* xl_row(CArgsP a, int r) { return (bf16*)a->out + (size_t)(r - NCTX) * XL_LD; }
__device__ __forceinline__ int row_slot(int r) { return r < NCTX ? 8 : ((r - NCTX) >> 13); }

using pg8::f32x4; using pg8::u32x4; using pg8::Unit; using pg8::cvt_pk_bf16;
struct EpiIn {
    static constexpr bool HAS_MID = false, PERM = true;
    bf16* PA; bf16* PG; float* Z; const float* rope; bf16* VT; bf16* NVT;
    __device__ __forceinline__ void operator()(const f32x4 (&acc)[2][2][4][2], const Unit& u, int wr, int wc, int fr, int fq) const {
        const int pn = u.pn, row0 = u.pm * 256 + wr * 64 + fr;
        if (pn == 20) {
            if (wc == 0) {
#pragma unroll
                for (int ai = 0; ai < 2; ++ai)
#pragma unroll
                    for (int m = 0; m < 4; ++m) { float* zp = Z + (size_t)(row0 + ai * 128 + m * 16) * 32 + 8 * fq; *(f32x4*)zp = acc[ai][0][m][0]; *(f32x4*)(zp + 4) = acc[ai][0][m][1]; }
            }
            return;
        }
        if (pn >= 8 && pn < 12) {
            bf16* T = (pn < 10 ? VT : NVT) + (size_t)(((pn - 8) & 1) * 256 + wc * 32 + 8 * fq) * R;
#pragma unroll
            for (int ai = 0; ai < 2; ++ai)
#pragma unroll
                for (int m = 0; m < 4; ++m) {
                    const int row = row0 + ai * 128 + m * 16;
#pragma unroll
                    for (int bj = 0; bj < 2; ++bj) {
                        const f32x4 v0 = acc[ai][bj][m][0], v1 = acc[ai][bj][m][1];
                        bf16* tp = T + (size_t)(bj * 128) * R + row;
                        tp[0 * (size_t)R] = (bf16)f2bf(v0[0]); tp[1 * (size_t)R] = (bf16)f2bf(v0[1]); tp[2 * (size_t)R] = (bf16)f2bf(v0[2]); tp[3 * (size_t)R] = (bf16)f2bf(v0[3]);
                        tp[4 * (size_t)R] = (bf16)f2bf(v1[0]); tp[5 * (size_t)R] = (bf16)f2bf(v1[1]); tp[6 * (size_t)R] = (bf16)f2bf(v1[2]); tp[7 * (size_t)R] = (bf16)f2bf(v1[3]);
                    }
                }
            return;
        }
        bf16* base; int ldc, colt;
        if (pn < 8) { base = PA; ldc = PA_LD; colt = pn * 256; } else { base = PG; ldc = PG_LD; colt = (pn - 12) * 256; }
        const int col0 = colt + wc * 32 + 8 * fq;
        const bool do_rope = (pn < 2) && (u.pm >= 8);
        const float sc = (pn == 0 || pn == 4 || pn == 5) ? 0.125f : 1.f;
#pragma unroll
        for (int ai = 0; ai < 2; ++ai)
#pragma unroll
            for (int m = 0; m < 4; ++m) {
                const int row = row0 + ai * 128 + m * 16;
                bf16* rowp = base + (size_t)row * ldc + col0;
                f32x4 cs[4];
                if (do_rope) { const int t = (row - NCTX) & (SEQ - 1); const int pos = (wc & 1) ? (t & 63) : (t >> 6);
                    const f32x4* cp = (const f32x4*)(rope + (size_t)(pos * 16 + 8 * (fq & 1)) * 2);
                    cs[0] = cp[0]; cs[1] = cp[1]; cs[2] = cp[2]; cs[3] = cp[3]; }
#pragma unroll
                for (int bj = 0; bj < 2; ++bj) {
                    f32x4 v0 = acc[ai][bj][m][0], v1 = acc[ai][bj][m][1];
                    if (do_rope) {
                        float x[8] = {v0[0], v0[1], v0[2], v0[3], v1[0], v1[1], v1[2], v1[3]};
#pragma unroll
                        for (int e = 0; e < 8; ++e) { const float p = shx(x[e], 32, fr + 16 * fq); const float c = cs[e >> 1][(e & 1) * 2], s = cs[e >> 1][(e & 1) * 2 + 1];
                            x[e] = (fq < 2) ? (x[e] * c - p * s) : (p * s + x[e] * c); }
                        v0 = (f32x4){x[0], x[1], x[2], x[3]}; v1 = (f32x4){x[4], x[5], x[6], x[7]};
                    }
                    v0 = v0 * sc; v1 = v1 * sc;
                    u32x4 w; w.x = cvt_pk_bf16(v0[0], v0[1]); w.y = cvt_pk_bf16(v0[2], v0[3]); w.z = cvt_pk_bf16(v1[0], v1[1]); w.w = cvt_pk_bf16(v1[2], v1[3]);
                    *(u32x4*)(rowp + bj * 128) = w;
                }
                asm volatile("" ::: "memory");
            }
    }
};
struct EpiMergeK {
    static constexpr bool HAS_MID = true, PERM = true;
    bf16* MG; const bf16* PG;
    __device__ __forceinline__ void mid(f32x4 (&acc)[2][2][4][2], const Unit& u, int wr, int wc, int fr, int fq) const {
        int row0 = u.pm * 256 + wr * 64 + fr, col0 = u.pn * 256 + wc * 32 + 8 * fq;
        asm volatile("" : "+v"(row0), "+v"(col0));
#pragma unroll
        for (int ai = 0; ai < 2; ++ai)
#pragma unroll
            for (int m = 0; m < 4; ++m) {
                const bf16* gp = PG + (size_t)(row0 + ai * 128 + m * 16) * PG_LD + col0;
#pragma unroll
                for (int bj = 0; bj < 2; ++bj) {
                    const u32x4 g1 = *(const u32x4*)(gp + bj * 128), g2 = *(const u32x4*)(gp + 1024 + bj * 128);
                    const unsigned a1[4] = {g1.x, g1.y, g1.z, g1.w}, a2[4] = {g2.x, g2.y, g2.z, g2.w};
#pragma unroll
                    for (int q = 0; q < 4; ++q) {
                        const float r0 = (1.f + __expf(-bflo(a2[q]))) * __builtin_amdgcn_rcpf(1.f + __expf(-bflo(a1[q])));
                        const float r1 = (1.f + __expf(-bfhi(a2[q]))) * __builtin_amdgcn_rcpf(1.f + __expf(-bfhi(a1[q])));
                        acc[ai][bj][m][q >> 1][(q & 1) * 2] *= r0; acc[ai][bj][m][q >> 1][(q & 1) * 2 + 1] *= r1;
                    }
                }
                asm volatile("" ::: "memory");
            }
    }
    __device__ __forceinline__ void operator()(const f32x4 (&acc)[2][2][4][2], const Unit& u, int wr, int wc, int fr, int fq) const {
        int row0 = u.pm * 256 + wr * 64 + fr, col0 = u.pn * 256 + wc * 32 + 8 * fq;
        asm volatile("" : "+v"(row0), "+v"(col0));
#pragma unroll
        for (int ai = 0; ai < 2; ++ai)
#pragma unroll
            for (int m = 0; m < 4; ++m) {
                const int row = row0 + ai * 128 + m * 16;
#pragma unroll
                for (int bj = 0; bj < 2; ++bj) {
                    const int c = col0 + bj * 128;
                    const u32x4 g = *(const u32x4*)(PG + (size_t)row * PG_LD + 1024 + c);
                    const f32x4 v0 = acc[ai][bj][m][0], v1 = acc[ai][bj][m][1];
                    u32x4 w; w.x = cvt_pk_bf16(sigmoidf_(bflo(g.x)) * v0[0], sigmoidf_(bfhi(g.x)) * v0[1]); w.y = cvt_pk_bf16(sigmoidf_(bflo(g.y)) * v0[2], sigmoidf_(bfhi(g.y)) * v0[3]);
                    w.z = cvt_pk_bf16(sigmoidf_(bflo(g.z)) * v1[0], sigmoidf_(bfhi(g.z)) * v1[1]); w.w = cvt_pk_bf16(sigmoidf_(bflo(g.w)) * v1[2], sigmoidf_(bfhi(g.w)) * v1[3]);
                    *(u32x4*)(MG + (size_t)row * D + c) = w;
                }
                asm volatile("" ::: "memory");
            }
    }
};
struct EpiRes {
    static constexpr bool HAS_MID = false, PERM = true;
    const float* src_c; const float* src_l; float* dst_c; bf16* dst_l; const float* mod; int first;
    __device__ __forceinline__ void operator()(const f32x4 (&acc)[2][2][4][2], const Unit& u, int wr, int wc, int fr, int fq) const {
        const bool isctx = u.pm < 8;
        const int slot = isctx ? 8 : ((u.pm - 8) >> 5);
        int rbase = (isctx ? u.pm * 256 : (u.pm - 8) * 256) + wr * 64 + fr, col0 = u.pn * 256 + wc * 32 + 8 * fq;
        asm volatile("" : "+v"(rbase), "+v"(col0));
        const float* ga = mod + slot * 6144 + 2048;
        f32x4 gv[2][2];
#pragma unroll
        for (int bj = 0; bj < 2; ++bj)
#pragma unroll
            for (int n = 0; n < 2; ++n) gv[bj][n] = *(const f32x4*)(ga + col0 + bj * 128 + 4 * n);
#pragma unroll
        for (int ai = 0; ai < 2; ++ai)
#pragma unroll
            for (int m = 0; m < 4; ++m) {
                const int row = rbase + ai * 128 + m * 16;
#pragma unroll
                for (int bj = 0; bj < 2; ++bj) {
                    const int c = col0 + bj * 128;
                    f32x4 x0, x1;
                    if (isctx || first) { const float* sp = (isctx ? src_c : src_l) + (size_t)row * D + c; x0 = *(const f32x4*)sp; x1 = *(const f32x4*)(sp + 4); }
                    else { const u32x4 w = *(const u32x4*)(dst_l + (size_t)row * XL_LD + c); x0 = (f32x4){bflo(w.x), bfhi(w.x), bflo(w.y), bfhi(w.y)}; x1 = (f32x4){bflo(w.z), bfhi(w.z), bflo(w.w), bfhi(w.w)}; }
                    x0 = x0 + gv[bj][0] * acc[ai][bj][m][0]; x1 = x1 + gv[bj][1] * acc[ai][bj][m][1];
                    if (isctx) { float* dp = dst_c + (size_t)row * D + c; *(f32x4*)dp = x0; *(f32x4*)(dp + 4) = x1; }
                    else { u32x4 w; w.x = cvt_pk_bf16(x0[0], x0[1]); w.y = cvt_pk_bf16(x0[2], x0[3]); w.z = cvt_pk_bf16(x1[0], x1[1]); w.w = cvt_pk_bf16(x1[2], x1[3]); *(u32x4*)(dst_l + (size_t)row * XL_LD + c) = w; }
                }
                asm volatile("" ::: "memory");
            }
    }
};
struct EpiB16 {
    static constexpr bool HAS_MID = false, PERM = true;
    bf16* C; int ldc;
    __device__ __forceinline__ void operator()(const f32x4 (&acc)[2][2][4][2], const Unit& u, int wr, int wc, int fr, int fq) const {
        const int row0 = u.pm * 256 + wr * 64 + fr, col0 = u.pn * 256 + wc * 32 + 8 * fq;
#pragma unroll
        for (int ai = 0; ai < 2; ++ai)
#pragma unroll
            for (int m = 0; m < 4; ++m) { bf16* rowp = C + (size_t)(row0 + ai * 128 + m * 16) * ldc + col0;
#pragma unroll
                for (int bj = 0; bj < 2; ++bj) { const f32x4 v0 = acc[ai][bj][m][0], v1 = acc[ai][bj][m][1];
                    u32x4 w; w.x = cvt_pk_bf16(v0[0], v0[1]); w.y = cvt_pk_bf16(v0[2], v0[3]); w.z = cvt_pk_bf16(v1[0], v1[1]); w.w = cvt_pk_bf16(v1[2], v1[3]);
                    *(u32x4*)(rowp + bj * 128) = w; } }
    }
};
struct EpiF32 {
    static constexpr bool HAS_MID = false, PERM = false;
    float* C; int ldc;
    __device__ __forceinline__ void operator()(const f32x4 (&acc)[2][2][4][2], const Unit& u, int wr, int wc, int fr, int fq) const {
        const int row0 = u.pm * 256 + wr * 64 + fr, col0 = u.pn * 256 + wc * 32 + 4 * fq;
#pragma unroll
        for (int ai = 0; ai < 2; ++ai)
#pragma unroll
            for (int m = 0; m < 4; ++m) { float* rowp = C + (size_t)(row0 + ai * 128 + m * 16) * ldc + col0;
#pragma unroll
                for (int bj = 0; bj < 2; ++bj)
#pragma unroll
                    for (int n = 0; n < 2; ++n) *(f32x4*)(rowp + bj * 128 + n * 16) = acc[ai][bj][m][n]; }
    }
};

__device__ __forceinline__ void p0_transpose_item(const float* W, int K, int N, bf16* WT, int dst_row0, LAS float* scr, int k0, int n0, int lane) {
#pragma unroll 8
    for (int i = 0; i < 32; ++i) { const int kk = 2 * i + (lane >> 5); scr[kk * 33 + (lane & 31)] = W[(size_t)(k0 + kk) * N + n0 + (lane & 31)]; }
    LDS_WAIT(); asm volatile("" ::: "memory");
    const int c = lane & 7;
#pragma unroll
    for (int j = 0; j < 4; ++j) { const int n = (lane >> 3) + 8 * j; const LAS float* s = scr + (8 * c) * 33 + n;
        v4u o; o.x = pk2(s[0 * 33], s[1 * 33]); o.y = pk2(s[2 * 33], s[3 * 33]); o.z = pk2(s[4 * 33], s[5 * 33]); o.w = pk2(s[6 * 33], s[7 * 33]);
        *(v4u*)(WT + (size_t)(dst_row0 + n) * K + k0 + 8 * c) = o; }
    LDS_WAIT(); asm volatile("" ::: "memory");
}
__device__ __forceinline__ int win_map(int n0) {
    if (n0 < 512) return n0;
    if (n0 < 1024) return 2048 + (n0 - 512);
    if (n0 < 1056) return 5120 + (n0 - 1024);
    if (n0 < 1568) return 512 + (n0 - 1056);
    if (n0 < 2080) return 1024 + (n0 - 1568);
    if (n0 < 2592) return 1536 + (n0 - 2080);
    if (n0 < 3104) return 2560 + (n0 - 2592);
    return 3072 + (n0 - 3104);
}

__device__ __forceinline__ void p0_prologue(const Frame& F) {
    CArgsP a = kargs(); unsigned char* const ws = a->ws;
    const int gw = F.vcu * NWAVES + F.wave, NGW = F.G * NWAVES;
    const int gtid = F.vcu * NT + F.tid, GT = F.G * NT;
    {
        LAS float* scr = (LAS float*)(F.lds + F.wave * 16384);
        constexpr int I_IN = 16 * 161, I_P = 8 * 32, I_O = 16 * 32, PER_L = I_IN + 2 * I_P + I_O;
        for (int it = gw; it < DEPTH * PER_L; it += NGW) {
            const int l = it / PER_L; int r = it % PER_L;
            if (r < I_IN) { const int kb = r / 161, nb = r % 161; p0_transpose_item(a->in[I_WIN] + (size_t)l * D * IN_COLS, D, IN_COLS, (bf16*)(ws + WS_WIN) + (size_t)l * NPAD * D, win_map(nb * 32), scr, kb * 64, nb * 32, F.lane); continue; }
            r -= I_IN;
            if (r < I_P) { const int kb = r / 32, nb = r % 32; p0_transpose_item(a->in[I_WPG] + (size_t)l * 512 * D, D, D, (bf16*)(ws + WS_WPG) + (size_t)l * D * D, nb * 32, scr, kb * 64, nb * 32, F.lane); continue; }
            r -= I_P;
            if (r < I_P) { const int kb = r / 32, nb = r % 32; p0_transpose_item(a->in[I_WPN] + (size_t)l * 512 * D, D, D, (bf16*)(ws + WS_WPG) + (size_t)l * D * D + 512, nb * 32, scr, kb * 64, nb * 32, F.lane); continue; }
            r -= I_P;
            { const int kb = r / 32, nb = r % 32; p0_transpose_item(a->in[I_WO] + (size_t)l * D * D, D, D, (bf16*)(ws + WS_WO) + (size_t)l * D * D, nb * 32, scr, kb * 64, nb * 32, F.lane); }
        }
        constexpr int PADV = (NPAD - IN_COLS) * D / 8;
        for (int i = gtid; i < DEPTH * PADV; i += GT) { const int l = i / PADV, j = i % PADV; *((v4u*)((bf16*)(ws + WS_WIN) + ((size_t)l * NPAD + IN_COLS) * D) + j) = (v4u){0u, 0u, 0u, 0u}; }
    }
    __syncthreads();
    if (gtid < 128 * 16) { const int pos = gtid >> 4, j = gtid & 15; const float freq = powf(10000.f, -(float)j / 16.f); const float ang = (float)pos * freq;
        float* cs = (float*)(ws + WS_ROPE); cs[2 * gtid] = cosf(ang); cs[2 * gtid + 1] = sinf(ang); }
    {
        LAS float* LSK = (LAS float*)F.lds;
        LAS float* LQ = (LAS float*)(F.lds + 128 * 132 * 4);
        for (int unit = F.vcu; unit < DEPTH * 16 * 16; unit += F.G) {
            const int l = unit >> 8, hp = (unit >> 4) & 15, d0 = (unit & 15) * 64;
            const float* sk = a->in[I_SK] + ((size_t)l * 16 + hp) * 16384;
            const float* wq = a->in[I_WQ] + (size_t)l * D * 2048 + hp * 128;
            __syncthreads();
            for (int i = F.tid; i < 16384; i += NT) LSK[(i >> 7) * 132 + (i & 127)] = sk[i];
            for (int i = F.tid; i < 8192; i += NT) LQ[(i >> 7) * 132 + (i & 127)] = wq[(size_t)(d0 + (i >> 7)) * 2048 + (i & 127)];
            __syncthreads();
            const int dd = F.tid & 63, kg = F.tid >> 6;
            float acc[16];
#pragma unroll
            for (int k = 0; k < 16; ++k) acc[k] = 0.f;
            for (int j = 0; j < 128; j += 4) {
                const f32x4 q = *(const LAS f32x4*)(LQ + dd * 132 + j);
#pragma unroll
                for (int k = 0; k < 16; ++k) { const f32x4 s = *(const LAS f32x4*)(LSK + (kg * 16 + k) * 132 + j); acc[k] += q[0] * s[0] + q[1] * s[1] + q[2] * s[2] + q[3] * s[3]; }
            }
            bf16* o = (bf16*)(ws + WS_WS) + ((size_t)l * 2048 + hp * 128 + kg * 16) * D + d0 + dd;
#pragma unroll
            for (int k = 0; k < 16; ++k) o[(size_t)k * D] = (bf16)f2bf(acc[k]);
        }
    }
    __syncthreads();
    {
        LAS float* ca = (LAS float*)F.lds;
        LAS float* red = (LAS float*)(F.lds + 9 * D * 4);
        for (int i = F.tid; i < 9 * D; i += NT) { const float v = i < 8 * D ? a->in[I_C][i] : a->in[I_CCTX][i - 8 * D]; ca[i] = v / (1.f + __expf(-v)); }
        __syncthreads();
        float* MOD = (float*)(ws + WS_MOD);
        for (int unit = F.vcu; unit < DEPTH * 96; unit += F.G) {
            const int l = unit / 96, cb = unit % 96, dc = F.tid >> 6;
            const int col = cb * 64 + (F.tid & 63);
            const float* w = a->in[I_WMOD] + ((size_t)l * D + dc * 128) * 6144 + col;
            float acc[9];
#pragma unroll
            for (int b = 0; b < 9; ++b) acc[b] = 0.f;
#pragma unroll 8
            for (int d = 0; d < 128; ++d) { const float wv = w[(size_t)d * 6144];
#pragma unroll
                for (int b = 0; b < 9; ++b) acc[b] += ca[b * D + dc * 128 + d] * wv; }
#pragma unroll
            for (int b = 0; b < 9; ++b) red[(dc * 9 + b) * 64 + (F.tid & 63)] = acc[b];
            __syncthreads();
            for (int i = F.tid; i < 9 * 64; i += NT) { const int b = i >> 6, c = i & 63; float sum = a->in[I_BMOD][l * 6144 + cb * 64 + c];
#pragma unroll
                for (int k = 0; k < 8; ++k) sum += red[(k * 9 + b) * 64 + c];
                MOD[((size_t)l * 9 + b) * 6144 + cb * 64 + c] = sum; }
            __syncthreads();
        }
    }
    __syncthreads();
}

__device__ __forceinline__ unsigned pk4_fp8(float a, float b, float c, float d) { int p = __builtin_amdgcn_cvt_pk_fp8_f32(a, b, 0, false); p = __builtin_amdgcn_cvt_pk_fp8_f32(c, d, p, true); return (unsigned)p; }
__device__ __forceinline__ void convert_row_fp8(const float* src, unsigned char* dst_tab, float* scale_out, int e, int lane) {
    const f32x4* sp = (const f32x4*)(src + (size_t)e * D) + 4 * lane;
    const f32x4 a0 = sp[0], a1 = sp[1], a2 = sp[2], a3 = sp[3];
    float mx = fmaxf(fmaxf(fmaxf(fabsf(a0[0]), fabsf(a0[1])), fmaxf(fabsf(a0[2]), fabsf(a0[3]))), fmaxf(fmaxf(fabsf(a1[0]), fabsf(a1[1])), fmaxf(fabsf(a1[2]), fabsf(a1[3]))));
    mx = fmaxf(mx, fmaxf(fmaxf(fmaxf(fabsf(a2[0]), fabsf(a2[1])), fmaxf(fabsf(a2[2]), fabsf(a2[3]))), fmaxf(fmaxf(fabsf(a3[0]), fabsf(a3[1])), fmaxf(fabsf(a3[2]), fabsf(a3[3])))));
    mx = fmaxf(wave_max(mx, lane), 1e-30f);
    const float sc = 256.f / mx;
    const v4u w = (v4u){pk4_fp8(a0[0] * sc, a0[1] * sc, a0[2] * sc, a0[3] * sc), pk4_fp8(a1[0] * sc, a1[1] * sc, a1[2] * sc, a1[3] * sc), pk4_fp8(a2[0] * sc, a2[1] * sc, a2[2] * sc, a2[3] * sc), pk4_fp8(a3[0] * sc, a3[1] * sc, a3[2] * sc, a3[3] * sc)};
    *(v4u*)(dst_tab + ((size_t)(lane >> 3) * NEXP + e) * 128 + 16 * (lane & 7)) = w;
    if (lane == 0) scale_out[e] = mx * (1.f / 256.f);
}
__device__ __forceinline__ void convert_experts(const Frame& F, int layer) {
    CArgsP a = kargs(); unsigned char* const ws = a->ws;
    const int gw = F.vcu * NWAVES + F.wave, NGW = F.G * NWAVES;
    const float* su = a->in[I_EU] + (size_t)layer * NEXP * D; const float* sv = a->in[I_EV] + (size_t)layer * NEXP * D;
    for (int e = gw; e < NEXP; e += NGW) { convert_row_fp8(su, ws + WS_EU, (float*)(ws + WS_SU), e, F.lane); convert_row_fp8(sv, ws + WS_EV, (float*)(ws + WS_SV), e, F.lane); }
}

__device__ __forceinline__ void norm_phase(const Frame& F, int layer, int which, int rbeg) {
    CArgsP a = kargs(); unsigned char* const ws = a->ws;
    const int gw = F.vcu * NWAVES + F.wave, NGW = F.G * NWAVES;
    const float* g = (which ? a->in[I_GN2] : a->in[I_GN1]) + layer * D;
    const float* MOD = (const float*)(ws + WS_MOD) + (size_t)layer * 9 * 6144 + (which ? 3072 : 0);
    bf16* H = (bf16*)(ws + WS_H);
    f32x4 gv[4];
#pragma unroll
    for (int j = 0; j < 4; ++j) gv[j] = *((const f32x4*)g + F.lane + 64 * j);
    for (int r = rbeg + gw; r < R; r += NGW) {
        const float* sh = MOD + row_slot(r) * 6144; const float* sc = sh + D;
        f32x4 v[4]; float ss = 0.f;
        if ((which == 0 && layer == 0) || r < NCTX) {
            const float* xr = (which == 0 && layer == 0) ? xrow_in(a, r) : xc_row(a, r);
#pragma unroll
            for (int j = 0; j < 4; ++j) v[j] = *((const GAS f32x4*)xr + F.lane + 64 * j);
        } else {
            const v2u* xb = (const v2u*)xl_row(a, r) + F.lane;
#pragma unroll
            for (int j = 0; j < 4; ++j) { const v2u w = xb[64 * j]; v[j] = (f32x4){bflo(w.x), bfhi(w.x), bflo(w.y), bfhi(w.y)}; }
        }
#pragma unroll
        for (int j = 0; j < 4; ++j) ss += (v[j][0] * v[j][0] + v[j][1] * v[j][1]) + (v[j][2] * v[j][2] + v[j][3] * v[j][3]);
        const float rs = rsqrtf(wave_sum(ss, F.lane) * (1.f / D) + EPS);
        unsigned long long* o8 = (unsigned long long*)(H + (size_t)r * D) + F.lane;
        float mx = 0.f;
#pragma unroll
        for (int j = 0; j < 4; ++j) {
            const f32x4 s1 = *((const f32x4*)sc + F.lane + 64 * j), s0 = *((const f32x4*)sh + F.lane + 64 * j);
            const f32x4 y = v[j] * rs * gv[j] * (s1 + 1.f) + s0;
            o8[64 * j] = (unsigned long long)pk2(y[0], y[1]) | ((unsigned long long)pk2(y[2], y[3]) << 32);
            v[j] = y; mx = fmaxf(mx, fmaxf(fmaxf(fabsf(y[0]), fabsf(y[1])), fmaxf(fabsf(y[2]), fabsf(y[3]))));
        }
        if (which) {
            mx = fmaxf(wave_max(mx, F.lane), 1e-30f); const float q8 = 256.f / mx;
            unsigned* h8 = (unsigned*)(ws + WS_H8 + (size_t)r * D) + F.lane;
#pragma unroll
            for (int j = 0; j < 4; ++j) h8[64 * j] = pk4_fp8(v[j][0] * q8, v[j][1] * q8, v[j][2] * q8, v[j][3] * q8);
            if (F.lane == 0) ((float*)(ws + WS_SX))[r] = mx * (1.f / 256.f);
        }
    }
}

constexpr int GL_TOT = 0, GL_IMG = 4096, GL_PITCH = 144, GL_IMGB = 64 * GL_PITCH, GL_SSX = GL_IMG + 4 * GL_IMGB;
typedef short bf16x8_t __attribute__((ext_vector_type(8)));
__device__ __forceinline__ int chunk_row0(int b, int tc) { return tc < 4 ? b * CTXL + tc * 64 : NCTX + b * SEQ + (tc - 4) * 64; }
__device__ __forceinline__ int chunk_pos(int tc, int dir) { return dir == 0 ? tc : (tc < 4 ? 3 - tc : 135 - tc); }
__device__ __forceinline__ float logsig16(float x) { return (fminf(x, 0.f) - 0.69314718f * __builtin_amdgcn_logf(1.f + __builtin_amdgcn_exp2f(-1.44269504f * fabsf(x)))) * (1.f / 16.f); }
constexpr int GL_HALF = 40960;
__device__ __forceinline__ void gla_scan(LAS unsigned char* hl, int w4, int lane, CArgsP a, const float* Z, int layer, int h, int row0, int lz, float (&Bf)[16], float (&Bb)[16], float& endf, float& endb) {
    const float* waf = a->in[I_WAF] + layer * 4096 + h * 64 + lane; const float* wab = a->in[I_WAB] + layer * 4096 + h * 64 + lane;
    float wf[16], wb[16];
#pragma unroll
    for (int j = 0; j < 16; ++j) { wf[j] = waf[j * 256]; wb[j] = wab[j * 256]; }
    const float baf = a->in[I_BAF][layer * 256 + h * 64 + lane], bab = a->in[I_BAB][layer * 256 + h * 64 + lane];
    const int t0 = 16 * w4;
#pragma unroll
    for (int i = 0; i < 16; ++i) {
        const f32x4* zp = (const f32x4*)(Z + (size_t)(row0 + t0 + i) * 32 + lz);
        float zf = baf, zb = bab;
#pragma unroll
        for (int q = 0; q < 4; ++q) { const f32x4 z0 = zp[q], z1 = zp[4 + q];
            zf += z0[0] * wf[4 * q] + z0[1] * wf[4 * q + 1] + z0[2] * wf[4 * q + 2] + z0[3] * wf[4 * q + 3];
            zb += z1[0] * wb[4 * q] + z1[1] * wb[4 * q + 1] + z1[2] * wb[4 * q + 2] + z1[3] * wb[4 * q + 3]; }
        Bf[i] = logsig16(zf); Bb[i] = logsig16(zb);
    }
#pragma unroll
    for (int i = 1; i < 16; ++i) Bf[i] += Bf[i - 1];
#pragma unroll
    for (int i = 14; i >= 0; --i) Bb[i] += Bb[i + 1];
    LAS float* TOT = (LAS float*)(hl + GL_TOT);
    TOT[(0 * 4 + w4) * 64 + lane] = Bf[15]; TOT[(1 * 4 + w4) * 64 + lane] = Bb[0];
    __syncthreads();
    float offf = 0.f, offb = 0.f; endf = 0.f; endb = 0.f;
#pragma unroll
    for (int w = 0; w < 4; ++w) { const float tf = TOT[(0 * 4 + w) * 64 + lane], tb = TOT[(1 * 4 + w) * 64 + lane]; endf += tf; endb += tb; offf += (w < w4) ? tf : 0.f; offb += (w > w4) ? tb : 0.f; }
#pragma unroll
    for (int i = 0; i < 16; ++i) { Bf[i] += offf; Bb[i] += offb; }
}
constexpr int GLA_UNITS = BATCH * 4 * NCHUNK;
__device__ __forceinline__ void gla_a_phase(const Frame& F, int layer) {
    CArgsP a = kargs(); unsigned char* const ws = a->ws;
    const bf16* PA = (const bf16*)(ws + WS_PA); const bf16* VT = (const bf16*)(ws + WS_VT);
    const float* Z = (const float*)(ws + WS_Z); bf16* SST = (bf16*)(ws + WS_H); float* DEC = (float*)(ws + WS_DEC);
    int lz = 0; asm volatile("" : "+v"(lz));
    const int lane = F.lane, l16 = lane & 15, g = lane >> 4, hw = F.wave >> 2, w4 = F.wave & 3, t0 = 16 * w4;
    LAS unsigned char* hl = F.lds + hw * GL_HALF;
    for (int up = F.vcu; up < GLA_UNITS / 2; up += F.G) {
        const int unit = 2 * up + hw;
        const int b = unit / (4 * NCHUNK), h = (unit / NCHUNK) & 3, tc = unit % NCHUNK, row0 = chunk_row0(b, tc);
        float Bf[16], Bb[16], endf, endb;
        gla_scan(hl, w4, lane, a, Z, layer, h, row0, lz, Bf, Bb, endf, endb);
        float kf[16], kb[16];
#pragma unroll
        for (int i = 0; i < 16; ++i) { const float kk = bf1(PA[(size_t)(row0 + t0 + i) * PA_LD + PA_K + h * 64 + lane]); kf[i] = kk * __expf(endf - Bf[i]); kb[i] = kk * __expf(endb - Bb[i]); }
#pragma unroll
        for (int q = 0; q < 2; ++q) {
            *(LAS v4u*)(hl + GL_IMG + 0 * GL_IMGB + lane * GL_PITCH + (t0 + 8 * q) * 2) = (v4u){pk2(kf[8 * q], kf[8 * q + 1]), pk2(kf[8 * q + 2], kf[8 * q + 3]), pk2(kf[8 * q + 4], kf[8 * q + 5]), pk2(kf[8 * q + 6], kf[8 * q + 7])};
            *(LAS v4u*)(hl + GL_IMG + 1 * GL_IMGB + lane * GL_PITCH + (t0 + 8 * q) * 2) = (v4u){pk2(kb[8 * q], kb[8 * q + 1]), pk2(kb[8 * q + 2], kb[8 * q + 3]), pk2(kb[8 * q + 4], kb[8 * q + 5]), pk2(kb[8 * q + 6], kb[8 * q + 7])};
        }
        const int seq0 = (b * 4 + h) * 2;
        if (w4 == 0) { DEC[((size_t)(seq0 + 0) * NCHUNK + chunk_pos(tc, 0)) * 64 + lane] = __expf(endf); DEC[((size_t)(seq0 + 1) * NCHUNK + chunk_pos(tc, 1)) * 64 + lane] = __expf(endb); }
        __syncthreads();
        const int dir = w4 >> 1, nth = w4 & 1;
        const LAS unsigned char* img = hl + GL_IMG + dir * GL_IMGB;
        bf16x8_t afr[4][2];
#pragma unroll
        for (int mt = 0; mt < 4; ++mt)
#pragma unroll
            for (int kt = 0; kt < 2; ++kt) afr[mt][kt] = *(const LAS bf16x8_t*)(img + (16 * mt + l16) * GL_PITCH + (32 * kt + 8 * g) * 2);
        bf16* slot = SST + ((size_t)(seq0 + dir) * NCHUNK + chunk_pos(tc, dir)) * 8192;
#pragma unroll
        for (int n4 = 0; n4 < 4; ++n4) {
            const int nt = 4 * nth + n4;
            const bf16* vp = VT + (size_t)(h * 128 + 16 * nt + l16) * R + row0 + 8 * g;
            const bf16x8_t b0 = *(const bf16x8_t*)vp, b1 = *(const bf16x8_t*)(vp + 32);
#pragma unroll
            for (int mt = 0; mt < 4; ++mt) {
                f32x4 acc = (f32x4){0.f, 0.f, 0.f, 0.f};
                acc = __builtin_amdgcn_mfma_f32_16x16x32_bf16(afr[mt][0], b0, acc, 0, 0, 0);
                acc = __builtin_amdgcn_mfma_f32_16x16x32_bf16(afr[mt][1], b1, acc, 0, 0, 0);
                *(v2u*)(slot + (16 * nt + l16) * 64 + 16 * mt + 4 * g) = (v2u){pk2(acc[0], acc[1]), pk2(acc[2], acc[3])};
            }
        }
        __syncthreads();
    }
}
__device__ __forceinline__ void gla_b_phase(const Frame& F, bool dry) {
    CArgsP a = kargs(); unsigned char* const ws = a->ws; const bool wr = !dry || a->pad == 12345;
    bf16* SST = (bf16*)(ws + WS_H); const float* DEC = (const float*)(ws + WS_DEC);
    const int gtid = F.vcu * NT + F.tid, GT = F.G * NT;
    for (int id = gtid; id < 64 * 2048; id += GT) {
        const int seq = id >> 11, e = (id & 2047) * 4, k4 = e & 63;
        float s0 = 0.f, s1 = 0.f, s2 = 0.f, s3 = 0.f;
        bf16* p = SST + (size_t)seq * NCHUNK * 8192 + e; const float* dp = DEC + (size_t)seq * NCHUNK * 64 + k4;
#pragma unroll 4
        for (int c = 0; c < NCHUNK; ++c) {
            const v2u t = *(const v2u*)(p + (size_t)c * 8192); const f32x4 d = *(const f32x4*)(dp + c * 64);
            if (wr) *(v2u*)(p + (size_t)c * 8192) = (v2u){pk2(s0, s1), pk2(s2, s3)};
            s0 = d[0] * s0 + bflo(t.x); s1 = d[1] * s1 + bfhi(t.x); s2 = d[2] * s2 + bflo(t.y); s3 = d[3] * s3 + bfhi(t.y);
        }
    }
}
__device__ __forceinline__ void gla_c_phase(const Frame& F, int layer, bool dry) {
    CArgsP a = kargs(); unsigned char* const ws = a->ws; const bool wr = !dry || a->pad == 12345;
    bf16* PA = (bf16*)(ws + WS_PA); const bf16* VT = (const bf16*)(ws + WS_VT);
    const float* Z = (const float*)(ws + WS_Z); const bf16* SST = (const bf16*)(ws + WS_H);
    int lz = 0; asm volatile("" : "+v"(lz));
    const int lane = F.lane, l16 = lane & 15, g = lane >> 4, hw = F.wave >> 2, w4 = F.wave & 3, t0 = 16 * w4;
    LAS unsigned char* hl = F.lds + hw * GL_HALF;
    for (int up = F.vcu; up < GLA_UNITS / 2; up += F.G) {
        const int unit = 2 * up + hw;
        const int b = unit / (4 * NCHUNK), h = (unit / NCHUNK) & 3, tc = unit % NCHUNK, row0 = chunk_row0(b, tc);
        {
            float Bf[16], Bb[16], endf, endb;
            gla_scan(hl, w4, lane, a, Z, layer, h, row0, lz, Bf, Bb, endf, endb);
#pragma unroll
            for (int i = 0; i < 16; ++i) {
                const bf16* pr = PA + (size_t)(row0 + t0 + i) * PA_LD + h * 64 + lane;
                const float qq = bf1(pr[PA_Q]), kk = bf1(pr[PA_K]);
                const float ef = __expf(Bf[i]), eb = __expf(Bb[i]);
                LAS bf16* ip = (LAS bf16*)(hl + GL_IMG + (t0 + i) * GL_PITCH) + lane;
                ip[0] = (bf16)f2bf(qq * ef); ip[GL_IMGB / 2] = (bf16)f2bf(kk * __builtin_amdgcn_rcpf(ef)); ip[GL_IMGB] = (bf16)f2bf(qq * eb); ip[3 * GL_IMGB / 2] = (bf16)f2bf(kk * __builtin_amdgcn_rcpf(eb));
            }
        }
        __syncthreads();
        f32x4 O[8];
#pragma unroll
        for (int mt = 0; mt < 8; ++mt) O[mt] = (f32x4){0.f, 0.f, 0.f, 0.f};
        const int tq = 16 * w4 + l16;
#pragma unroll
        for (int dir = 0; dir < 2; ++dir) {
            const LAS unsigned char* Qimg = hl + GL_IMG + (2 * dir) * GL_IMGB; const LAS unsigned char* Kimg = Qimg + GL_IMGB;
            bf16x8_t qf[2];
#pragma unroll
            for (int kt = 0; kt < 2; ++kt) qf[kt] = *(const LAS bf16x8_t*)(Qimg + tq * GL_PITCH + (32 * kt + 8 * g) * 2);
            f32x4 P[4];
#pragma unroll
            for (int mt = 0; mt < 4; ++mt) {
                P[mt] = (f32x4){0.f, 0.f, 0.f, 0.f};
#pragma unroll
                for (int kt = 0; kt < 2; ++kt) { const bf16x8_t kf = *(const LAS bf16x8_t*)(Kimg + (16 * mt + l16) * GL_PITCH + (32 * kt + 8 * g) * 2); P[mt] = __builtin_amdgcn_mfma_f32_16x16x32_bf16(kf, qf[kt], P[mt], 0, 0, 0); }
#pragma unroll
                for (int rg = 0; rg < 4; ++rg) { const int tp = 16 * mt + 4 * g + rg; const bool valid = dir == 0 ? (tp <= tq) : (tp >= tq); P[mt][rg] = valid ? P[mt][rg] : 0.f; }
            }
            bf16x8_t pa[2];
#pragma unroll
            for (int k2 = 0; k2 < 2; ++k2) { const v4u w = (v4u){pk2(P[2 * k2][0], P[2 * k2][1]), pk2(P[2 * k2][2], P[2 * k2][3]), pk2(P[2 * k2 + 1][0], P[2 * k2 + 1][1]), pk2(P[2 * k2 + 1][2], P[2 * k2 + 1][3])}; pa[k2] = __builtin_bit_cast(bf16x8_t, w); }
            const bf16* slot = SST + ((size_t)((b * 4 + h) * 2 + dir) * NCHUNK + chunk_pos(tc, dir)) * 8192;
#pragma unroll
            for (int mt = 0; mt < 8; ++mt) {
                const int v = 16 * mt + l16;
                const bf16* vp = VT + (size_t)(h * 128 + v) * R + row0 + 4 * g;
#pragma unroll
                for (int k2 = 0; k2 < 2; ++k2) { const v2u lo = *(const v2u*)(vp + 32 * k2), hi = *(const v2u*)(vp + 32 * k2 + 16); const v4u w = (v4u){lo.x, lo.y, hi.x, hi.y};
                    O[mt] = __builtin_amdgcn_mfma_f32_16x16x32_bf16(__builtin_bit_cast(bf16x8_t, w), pa[k2], O[mt], 0, 0, 0); }
#pragma unroll
                for (int kt = 0; kt < 2; ++kt) { const bf16x8_t sf = *(const bf16x8_t*)(slot + v * 64 + 32 * kt + 8 * g); O[mt] = __builtin_amdgcn_mfma_f32_16x16x32_bf16(sf, qf[kt], O[mt], 0, 0, 0); }
            }
        }
        float ss = 0.f;
#pragma unroll
        for (int mt = 0; mt < 8; ++mt) ss += (O[mt][0] * O[mt][0] + O[mt][1] * O[mt][1]) + (O[mt][2] * O[mt][2] + O[mt][3] * O[mt][3]);
        ss += shx(ss, 16, lane); ss += shx(ss, 32, lane);
        const float rs = rsqrtf(ss * (1.f / 128.f) + EPS);
        bf16* rp0 = PA + (size_t)(row0 + tq) * PA_LD + PA_R + h * 128 + 4 * g;
        const float* gp = a->in[I_GGLA] + layer * 128 + 4 * g;
#pragma unroll
        for (int mt = 0; mt < 8; ++mt) {
            const f32x4 gg = *(const f32x4*)(gp + 16 * mt); const v2u rr = *(const v2u*)(rp0 + 16 * mt);
            const float r0 = bflo(rr.x), r1 = bfhi(rr.x), r2 = bflo(rr.y), r3 = bfhi(rr.y);
            const float y0 = O[mt][0] * rs * gg[0] * (r0 * sigmoidf_(r0)), y1 = O[mt][1] * rs * gg[1] * (r1 * sigmoidf_(r1));
            const float y2 = O[mt][2] * rs * gg[2] * (r2 * sigmoidf_(r2)), y3 = O[mt][3] * rs * gg[3] * (r3 * sigmoidf_(r3));
            if (wr) *(v2u*)(rp0 + 16 * mt) = (v2u){pk2(y0, y1), pk2(y2, y3)};
        }
        __syncthreads();
    }
}

__device__ __forceinline__ void na_unit(bf16* PA, const bf16* NVT, const float* rpb_l, int b, int hd, bool lat, int qr, int nt, int lane, bool wr) {
    const int l16 = lane & 15, g = lane >> 4;
    const int latbase = NCTX + b * SEQ, ctxbase = b * CTXL;
    const int tq_row = lat ? latbase + qr * 64 + 16 * nt + l16 : ctxbase + 16 * nt + l16;
    bf16* qp = PA + (size_t)tq_row * PA_LD + PA_NQ + hd * 64;
    bf16x8_t qf[2];
    qf[0] = *(const bf16x8_t*)(qp + 8 * g); qf[1] = *(const bf16x8_t*)(qp + 32 + 8 * g);
    const int qc = 16 * nt + l16, c0 = min(max(qc - 8, 0), 48), r0 = min(max(qr - 4, 0), 120), ct0 = nt < 2 ? 0 : 1;
    const float* rpb = rpb_l + hd * 465;
    float m = -3.0e38f, lsum = 0.f;
    f32x4 O[4];
#pragma unroll
    for (int mt = 0; mt < 4; ++mt) O[mt] = (f32x4){0.f, 0.f, 0.f, 0.f};
    const bf16* kbase = PA + PA_NK + hd * 64 + 8 * g;
    const bf16* vbase = NVT + (size_t)(hd * 64 + l16) * R + 4 * g;
#pragma unroll 1
    for (int grp = lat ? 0 : 6; grp < 10; ++grp) {
        int base[4]; f32x4 S[4];
#pragma unroll
        for (int j = 0; j < 4; ++j) {
            const int ti = grp * 4 + j;
            if (ti < 24) { const int wa = ti / 3, ct = ct0 + ti % 3; base[j] = latbase + (r0 + wa) * 64 + 16 * ct; } else base[j] = ctxbase + (ti - 24) * 16;
            const bf16* kp = kbase + (size_t)(base[j] + l16) * PA_LD;
            const bf16x8_t k0 = *(const bf16x8_t*)kp, k1 = *(const bf16x8_t*)(kp + 32);
            S[j] = (f32x4){0.f, 0.f, 0.f, 0.f};
            S[j] = __builtin_amdgcn_mfma_f32_16x16x32_bf16(k0, qf[0], S[j], 0, 0, 0);
            S[j] = __builtin_amdgcn_mfma_f32_16x16x32_bf16(k1, qf[1], S[j], 0, 0, 0);
        }
        bool valid[4][4];
        float mloc = -3.0e38f;
#pragma unroll
        for (int j = 0; j < 4; ++j) {
            const int ti = grp * 4 + j;
            if (ti < 24) {
                const int wa = ti / 3, ct = ct0 + ti % 3;
                const float* bp = rpb + (r0 + wa - qr + 7) * 31;
#pragma unroll
                for (int rg = 0; rg < 4; ++rg) { const int kc = 16 * ct + 4 * g + rg; valid[j][rg] = (kc >= c0) && (kc <= c0 + 15);
                    const float bias = bp[min(max(kc - qc + 15, 0), 30)]; S[j][rg] = valid[j][rg] ? S[j][rg] + bias : -3.0e38f; }
            } else {
#pragma unroll
                for (int rg = 0; rg < 4; ++rg) valid[j][rg] = true;
            }
            mloc = fmaxf(mloc, fmaxf(fmaxf(S[j][0], S[j][1]), fmaxf(S[j][2], S[j][3])));
        }
        mloc = fmaxf(mloc, shx(mloc, 16, lane)); mloc = fmaxf(mloc, shx(mloc, 32, lane));
        const float mnew = fmaxf(m, mloc), alpha = __expf(m - mnew);
        m = mnew;
        float psum = 0.f;
#pragma unroll
        for (int j = 0; j < 4; ++j)
#pragma unroll
            for (int rg = 0; rg < 4; ++rg) { const float p = valid[j][rg] ? __expf(S[j][rg] - m) : 0.f; S[j][rg] = p; psum += p; }
        lsum = lsum * alpha + psum;
#pragma unroll
        for (int mt = 0; mt < 4; ++mt) O[mt] = O[mt] * alpha;
#pragma unroll
        for (int k2 = 0; k2 < 2; ++k2) {
            const v4u pw = (v4u){pk2(S[2 * k2][0], S[2 * k2][1]), pk2(S[2 * k2][2], S[2 * k2][3]), pk2(S[2 * k2 + 1][0], S[2 * k2 + 1][1]), pk2(S[2 * k2 + 1][2], S[2 * k2 + 1][3])};
            const bf16x8_t pa = __builtin_bit_cast(bf16x8_t, pw);
#pragma unroll
            for (int mt = 0; mt < 4; ++mt) {
                const bf16* vp = vbase + (size_t)(16 * mt) * R;
                const v2u lo = *(const v2u*)(vp + base[2 * k2]), hi = *(const v2u*)(vp + base[2 * k2 + 1]);
                const v4u vw = (v4u){lo.x, lo.y, hi.x, hi.y};
                O[mt] = __builtin_amdgcn_mfma_f32_16x16x32_bf16(__builtin_bit_cast(bf16x8_t, vw), pa, O[mt], 0, 0, 0);
            }
        }
    }
    lsum += shx(lsum, 16, lane); lsum += shx(lsum, 32, lane);
    const float inv = 1.f / lsum;
#pragma unroll
    for (int mt = 0; mt < 4; ++mt) if (wr) *(v2u*)(qp + 16 * mt + 4 * g) = (v2u){pk2(O[mt][0] * inv, O[mt][1] * inv), pk2(O[mt][2] * inv, O[mt][3] * inv)};
}
__device__ __forceinline__ void na_unit4(bf16* PA, const bf16* NVT, const float* rpb_l, LAS float* lb, int b, int hd, bool lat, int qr0, int nt, int lane, bool wr) {
    const int l16 = lane & 15, g = lane >> 4;
    const int latbase = NCTX + b * SEQ, ctxbase = b * CTXL;
    bf16* qp[4]; bf16x8_t qf[4][2];
#pragma unroll
    for (int j = 0; j < 4; ++j) {
        const int row = lat ? latbase + (qr0 + j) * 64 + 16 * nt + l16 : ctxbase + 64 * nt + 16 * j + l16;
        qp[j] = PA + (size_t)row * PA_LD + PA_NQ + hd * 64;
        qf[j][0] = *(const bf16x8_t*)(qp[j] + 8 * g); qf[j][1] = *(const bf16x8_t*)(qp[j] + 32 + 8 * g);
    }
    const int qc = 16 * nt + l16, c0 = min(max(qc - 8, 0), 48), R0 = min(max(qr0 - 4, 0), 120);
    if (lat) {
#pragma unroll
        for (int i = 0; i < 8; ++i) { const int idx = lane + 64 * i; if (idx < 465) lb[idx] = rpb_l[hd * 465 + idx]; }
        LDS_WAIT();
    }
    const bf16* kbase = PA + PA_NK + hd * 64 + 8 * g;
    const bf16* vbase = NVT + (size_t)(hd * 64 + l16) * R + 4 * g;
    float mx[4] = {-3.0e38f, -3.0e38f, -3.0e38f, -3.0e38f};
    const int nrows = lat ? ((qr0 == 0 || qr0 == 124) ? 8 : 11) : 0, cs = (nt == 0) ? 0 : (nt == 1 ? 8 : (nt == 2 ? 24 : 32));
    const int nwin = nrows, nslot = nwin + 8;
#define NA_SLOT(si, jmask, krow, pr, base0, win) do { const int s_ = min((si), nslot - 1); win = s_ < nwin; pr = 0; \
        if (win) { krow = R0 + s_; jmask = 0u; \
            _Pragma("unroll") for (int j_ = 0; j_ < 4; ++j_) { const int r0j = min(max(qr0 + j_ - 4, 0), 120); if (krow >= r0j && krow < r0j + 8) jmask |= 1u << j_; } \
            base0 = latbase + krow * 64 + cs; } else { jmask = 15u; krow = 0; base0 = ctxbase + (s_ - nwin) * 32; } } while (0)
#define NA_LDK(dst, base0) do { _Pragma("unroll") for (int t_ = 0; t_ < 2; ++t_) { const bf16* kp_ = kbase + (size_t)((base0) + 16 * t_ + l16) * PA_LD; dst[t_][0] = *(const bf16x8_t*)kp_; dst[t_][1] = *(const bf16x8_t*)(kp_ + 32); } } while (0)
#define NA_LDV(dst, base0) do { _Pragma("unroll") for (int mt_ = 0; mt_ < 4; ++mt_) { const bf16* vp_ = vbase + (size_t)(16 * mt_) * R + (base0); const v2u lo_ = *(const v2u*)vp_, hi_ = *(const v2u*)(vp_ + 16); dst[mt_] = __builtin_bit_cast(bf16x8_t, (v4u){lo_.x, lo_.y, hi_.x, hi_.y}); } } while (0)
#pragma unroll 1
    for (int s0 = 0; s0 < nslot; s0 += 4) {
        bf16x8_t kc[4][2][2]; unsigned jm[4];
#pragma unroll
        for (int q = 0; q < 4; ++q) { int krow, pr, base0; bool win; NA_SLOT(s0 + q, jm[q], krow, pr, base0, win); if (s0 + q >= nslot) jm[q] = 0u; NA_LDK(kc[q], base0); }
#pragma unroll
        for (int q = 0; q < 4; ++q)
#pragma unroll
            for (int t = 0; t < 2; ++t)
#pragma unroll
                for (int j = 0; j < 4; ++j) {
                    f32x4 S = (f32x4){0.f, 0.f, 0.f, 0.f};
                    S = __builtin_amdgcn_mfma_f32_16x16x32_bf16(kc[q][t][0], qf[j][0], S, 0, 0, 0);
                    S = __builtin_amdgcn_mfma_f32_16x16x32_bf16(kc[q][t][1], qf[j][1], S, 0, 0, 0);
                    mx[j] = fmaxf(mx[j], fmaxf(fmaxf(S[0], S[1]), fmaxf(S[2], S[3])));
                }
    }
#pragma unroll
    for (int j = 0; j < 4; ++j) { mx[j] = fmaxf(mx[j], shx(mx[j], 16, lane)); mx[j] = fmaxf(mx[j], shx(mx[j], 32, lane)); }
    float ls[4] = {0.f, 0.f, 0.f, 0.f};
    f32x4 O[4][4];
#pragma unroll
    for (int j = 0; j < 4; ++j)
#pragma unroll
        for (int mt = 0; mt < 4; ++mt) O[j][mt] = (f32x4){0.f, 0.f, 0.f, 0.f};
#pragma unroll 1
    for (int s0 = 0; s0 < nslot; s0 += 2) {
        bf16x8_t kf[2][2][2], vf[2][4]; unsigned jm[2]; int krw[2], prr[2]; bool wn[2];
#pragma unroll
        for (int q = 0; q < 2; ++q) { int base0; NA_SLOT(s0 + q, jm[q], krw[q], prr[q], base0, wn[q]); if (s0 + q >= nslot) jm[q] = 0u; NA_LDK(kf[q], base0); NA_LDV(vf[q], base0); }
#pragma unroll
        for (int q = 0; q < 2; ++q) {
            const bool win = wn[q]; const int pr = prr[q], krow = krw[q];
            bool cv[2][4]; int co[2][4];
#pragma unroll
            for (int t = 0; t < 2; ++t)
#pragma unroll
                for (int rg = 0; rg < 4; ++rg) { const int kcol = cs + 16 * t + 4 * g + rg; cv[t][rg] = !win || ((kcol >= c0) && (kcol <= c0 + 15)); co[t][rg] = min(max(kcol - qc + 15, 0), 30); }
#pragma unroll
            for (int j = 0; j < 4; ++j) {
                const bool rv = (jm[q] >> j) & 1u;
                f32x4 S[2];
#pragma unroll
                for (int t = 0; t < 2; ++t) { S[t] = (f32x4){0.f, 0.f, 0.f, 0.f};
                    S[t] = __builtin_amdgcn_mfma_f32_16x16x32_bf16(kf[q][t][0], qf[j][0], S[t], 0, 0, 0);
                    S[t] = __builtin_amdgcn_mfma_f32_16x16x32_bf16(kf[q][t][1], qf[j][1], S[t], 0, 0, 0); }
                const LAS float* bp = lb + (win ? min(max(krow - (qr0 + j) + 7, 0), 14) * 31 : 0);
                float psum = 0.f;
#pragma unroll
                for (int t = 0; t < 2; ++t)
#pragma unroll
                    for (int rg = 0; rg < 4; ++rg) { const float bias = win ? bp[co[t][rg]] : 0.f; const float p = (cv[t][rg] && rv) ? __expf(S[t][rg] + bias - mx[j]) : 0.f; S[t][rg] = p; psum += p; }
                ls[j] += psum;
                const bf16x8_t pa = __builtin_bit_cast(bf16x8_t, (v4u){pk2(S[0][0], S[0][1]), pk2(S[0][2], S[0][3]), pk2(S[1][0], S[1][1]), pk2(S[1][2], S[1][3])});
#pragma unroll
                for (int mt = 0; mt < 4; ++mt) O[j][mt] = __builtin_amdgcn_mfma_f32_16x16x32_bf16(vf[q][mt], pa, O[j][mt], 0, 0, 0);
            }
        }
    }
#undef NA_SLOT
#undef NA_LDK
#undef NA_LDV
#pragma unroll
    for (int j = 0; j < 4; ++j) {
        float l = ls[j]; l += shx(l, 16, lane); l += shx(l, 32, lane);
        const float inv = 1.f / l;
#pragma unroll
        for (int mt = 0; mt < 4; ++mt) if (wr) *(v2u*)(qp[j] + 16 * mt + 4 * g) = (v2u){pk2(O[j][mt][0] * inv, O[j][mt][1] * inv), pk2(O[j][mt][2] * inv, O[j][mt][3] * inv)};
    }
}
__device__ __forceinline__ void na_phase(const Frame& F, int layer, bool dry, bool skip_ctx) {
    CArgsP a = kargs(); unsigned char* const ws = a->ws; const bool wr = !dry || a->pad == 12345;
    bf16* PA = (bf16*)(ws + WS_PA); const bf16* NVT = (const bf16*)(ws + WS_NVT);
    const float* rpb_l = a->in[I_RPB] + (size_t)layer * 8 * 465;
    const int gw = F.vcu * NWAVES + F.wave, NGW = F.G * NWAVES;
    LAS float* lb = (LAS float*)(F.lds + F.wave * 2048);
    for (int u = gw; u < BATCH * 8 * 32 * 4 + (skip_ctx ? 0 : BATCH * 8 * 4); u += NGW) {
        if (u < BATCH * 8 * 32 * 4) { const int nt = u & 3, qg = (u >> 2) & 31, hd = (u >> 7) & 7, b = u >> 10; na_unit4(PA, NVT, rpb_l, lb, b, hd, true, 4 * qg, nt, F.lane, wr); }
        else { const int v = u - BATCH * 8 * 32 * 4; const int nt = v & 3, hd = (v >> 2) & 7, b = v >> 5; na_unit4(PA, NVT, rpb_l, lb, b, hd, false, 0, nt, F.lane, wr); }
    }
}

__device__ __forceinline__ float pack_key(float v, int idx) { unsigned t = __builtin_bit_cast(unsigned, v) & ~127u; asm("" : "+v"(t)); return __builtin_bit_cast(float, t | (unsigned)idx); }
__device__ __forceinline__ void topk_phase(const Frame& F, int rbeg) {
    CArgsP a = kargs(); unsigned char* const ws = a->ws;
    const int gtid = F.vcu * NT + F.tid, GT = F.G * NT;
    const bf16* SC = (const bf16*)(ws + WS_SC);
    int* EI = (int*)(ws + WS_EI); float* EG = (float*)(ws + WS_EG);
    LAS unsigned* myl = (LAS unsigned*)F.lds + F.tid * 9;
    for (int id = rbeg * 8 + gtid; id < R * 8; id += GT) {
        const int r = id >> 3, hd = id & 7;
        const v4u* sp = (const v4u*)(SC + (size_t)r * 2048 + hd * 256);
        float t0[16], t1[16];
#pragma unroll
        for (int blk = 0; blk < 8; ++blk) {
            float n0[16], n1[16];
#pragma unroll
            for (int q = 0; q < 2; ++q) { const v4u va = sp[blk * 2 + q], vb = sp[16 + blk * 2 + q];
                const unsigned wa[4] = {va.x, va.y, va.z, va.w}, wb[4] = {vb.x, vb.y, vb.z, vb.w};
#pragma unroll
                for (int e = 0; e < 4; ++e) { const int i0 = blk * 16 + 8 * q + 2 * e;
                    n0[8 * q + 2 * e] = pack_key(bflo(wa[e]), i0); n0[8 * q + 2 * e + 1] = pack_key(bfhi(wa[e]), i0 + 1);
                    n1[8 * q + 2 * e] = pack_key(bflo(wb[e]), i0); n1[8 * q + 2 * e + 1] = pack_key(bfhi(wb[e]), i0 + 1); } }
#pragma unroll
            for (int k = 2; k <= 16; k <<= 1)
#pragma unroll
                for (int j = k >> 1; j > 0; j >>= 1)
#pragma unroll
                    for (int i = 0; i < 16; ++i) { const int l = i ^ j; if (l > i) { const bool desc = (i & k) == 0;
                        const float a0 = n0[i], b0 = n0[l], a1 = n1[i], b1 = n1[l];
                        n0[i] = desc ? fmaxf(a0, b0) : fminf(a0, b0); n0[l] = desc ? fminf(a0, b0) : fmaxf(a0, b0);
                        n1[i] = desc ? fmaxf(a1, b1) : fminf(a1, b1); n1[l] = desc ? fminf(a1, b1) : fmaxf(a1, b1); } }
            if (blk == 0) {
#pragma unroll
                for (int i = 0; i < 16; ++i) { t0[i] = n0[i]; t1[i] = n1[i]; }
            } else {
#pragma unroll
                for (int i = 0; i < 16; ++i) { t0[i] = fmaxf(t0[i], n0[15 - i]); t1[i] = fmaxf(t1[i], n1[15 - i]); }
#pragma unroll
                for (int j = 8; j > 0; j >>= 1)
#pragma unroll
                    for (int i = 0; i < 16; ++i) { const int l = i ^ j; if (l > i) { const float a0 = t0[i], b0 = t0[l], a1 = t1[i], b1 = t1[l];
                        t0[i] = fmaxf(a0, b0); t0[l] = fminf(a0, b0); t1[i] = fmaxf(a1, b1); t1[l] = fminf(a1, b1); } }
            }
        }
        float best[16];
#pragma unroll
        for (int j = 0; j < 16; ++j) best[j] = -3.0e38f;
#pragma unroll
        for (int ia = 0; ia < 16; ++ia)
#pragma unroll
            for (int ib = 0; ib < 16; ++ib)
                if ((ia + 1) * (ib + 1) <= 16) {
                    float x = __builtin_bit_cast(float, (__builtin_bit_cast(unsigned, t0[ia] + t1[ib]) & ~255u) | (unsigned)(ia * 16 + ib));
#pragma unroll
                    for (int j = 0; j < 16; ++j) { const float tb = fmaxf(best[j], x); x = fminf(best[j], x); best[j] = tb; }
                }
        {
            unsigned w0[4], w1[4];
#pragma unroll
            for (int q = 0; q < 4; ++q) {
                w0[q] = (__builtin_bit_cast(unsigned, t0[4 * q]) & 127u) | ((__builtin_bit_cast(unsigned, t0[4 * q + 1]) & 127u) << 8) | ((__builtin_bit_cast(unsigned, t0[4 * q + 2]) & 127u) << 16) | ((__builtin_bit_cast(unsigned, t0[4 * q + 3]) & 127u) << 24);
                w1[q] = (__builtin_bit_cast(unsigned, t1[4 * q]) & 127u) | ((__builtin_bit_cast(unsigned, t1[4 * q + 1]) & 127u) << 8) | ((__builtin_bit_cast(unsigned, t1[4 * q + 2]) & 127u) << 16) | ((__builtin_bit_cast(unsigned, t1[4 * q + 3]) & 127u) << 24);
            }
#pragma unroll
            for (int q = 0; q < 4; ++q) { myl[q] = w0[q]; myl[4 + q] = w1[q]; }
            LDS_WAIT();
        }
        int eid[16];
#pragma unroll
        for (int j = 0; j < 16; ++j) { const unsigned code = __builtin_bit_cast(unsigned, best[j]) & 255u; const LAS unsigned char* mb = (const LAS unsigned char*)myl;
            eid[j] = (int)mb[code >> 4] * 128 + (int)mb[16 + (code & 15u)]; }
        LDS_WAIT();
        float sum = 0.f; const float bmax = best[0];
#pragma unroll
        for (int j = 0; j < 16; ++j) { best[j] = __expf(best[j] - bmax); sum += best[j]; }
        const float inv = 1.f / sum;
        v4i* ei = (v4i*)(EI + (size_t)r * 128 + hd * 16); f32x4* eg = (f32x4*)(EG + (size_t)r * 128 + hd * 16);
#pragma unroll
        for (int j = 0; j < 4; ++j) { ei[j] = (v4i){eid[4 * j], eid[4 * j + 1], eid[4 * j + 2], eid[4 * j + 3]}; eg[j] = (f32x4){best[4 * j] * inv, best[4 * j + 1] * inv, best[4 * j + 2] * inv, best[4 * j + 3] * inv}; }
    }
}

__device__ __forceinline__ float gelu_tanh(float x) { const float u = 0.7978845608f * (x + 0.044715f * x * x * x); return x * __builtin_amdgcn_rcpf(1.f + __expf(-2.f * u)); }
typedef float f32x2_t __attribute__((ext_vector_type(2)));
__device__ __forceinline__ void peer1_phase(const Frame& F, int rbeg) {
    CArgsP a = kargs(); unsigned char* const ws = a->ws;
    const unsigned char* EU8 = ws + WS_EU; const unsigned char* H8 = ws + WS_H8;
    const int* EI = (const int*)(ws + WS_EI); bf16* PART = (bf16*)(ws + WS_PART);
    const int per = F.G >> 3, s = F.vcu / per, rank = F.vcu % per, stride = per * NWAVES;
    const int lane = F.lane, m = lane & 15, g = lane >> 4, row8 = lane >> 3, part = lane & 7;
    const unsigned char* tab = EU8 + (size_t)s * NEXP * 128 + 16 * part;
    LAS unsigned char* wl = F.lds + F.wave * 4608;
    const int wofs = row8 * 144 + part * 16, rofs = m * 144 + 16 * g;
    int r = rbeg + rank * NWAVES + F.wave;
    int id[2][16];
#pragma unroll
    for (int u = 0; u < 2; ++u)
#pragma unroll
        for (int j = 0; j < 16; ++j) id[u][j] = EI[(size_t)min(r + u * stride, R - 1) * 128 + 8 * j + row8];
    for (; r < R; r += 2 * stride) {
        v4u w[2][16]; v4u x[2][2];
#pragma unroll
        for (int u = 0; u < 2; ++u) {
            const int ru = min(r + u * stride, R - 1);
            const unsigned char* xp = H8 + (size_t)ru * D + 128 * s + 16 * g;
            x[u][0] = *(const v4u*)xp; x[u][1] = *(const v4u*)(xp + 64);
#pragma unroll
            for (int j = 0; j < 16; ++j) w[u][j] = *(const v4u*)(tab + (size_t)id[u][j] * 128);
        }
        const int rn = r + 2 * stride;
#pragma unroll
        for (int u = 0; u < 2; ++u)
#pragma unroll
            for (int j = 0; j < 16; ++j) id[u][j] = EI[(size_t)min(rn + u * stride, R - 1) * 128 + 8 * j + row8];
#pragma unroll
        for (int u = 0; u < 2; ++u) {
            f32x4 sel = (f32x4){0.f, 0.f, 0.f, 0.f};
#pragma unroll
            for (int T = 0; T < 8; ++T) {
                LAS unsigned char* buf = wl + (T & 1) * 2304;
                *(LAS v4u*)(buf + wofs) = w[u][2 * T]; *(LAS v4u*)(buf + 8 * 144 + wofs) = w[u][2 * T + 1];
                const v4u a0 = *(const LAS v4u*)(buf + rofs), a1 = *(const LAS v4u*)(buf + rofs + 64);
                f32x4 acc = (f32x4){0.f, 0.f, 0.f, 0.f};
                acc = __builtin_amdgcn_mfma_f32_16x16x32_fp8_fp8((long)(((unsigned long long)a0.y << 32) | a0.x), (long)(((unsigned long long)x[u][0].y << 32) | x[u][0].x), acc, 0, 0, 0);
                acc = __builtin_amdgcn_mfma_f32_16x16x32_fp8_fp8((long)(((unsigned long long)a0.w << 32) | a0.z), (long)(((unsigned long long)x[u][0].w << 32) | x[u][0].z), acc, 0, 0, 0);
                acc = __builtin_amdgcn_mfma_f32_16x16x32_fp8_fp8((long)(((unsigned long long)a1.y << 32) | a1.x), (long)(((unsigned long long)x[u][1].y << 32) | x[u][1].x), acc, 0, 0, 0);
                acc = __builtin_amdgcn_mfma_f32_16x16x32_fp8_fp8((long)(((unsigned long long)a1.w << 32) | a1.z), (long)(((unsigned long long)x[u][1].w << 32) | x[u][1].z), acc, 0, 0, 0);
                sel = (m == T) ? acc : sel;
            }
            const int ru = r + u * stride;
            if (m < 8 && ru < R) *(v2u*)(PART + ((size_t)s * R + ru) * 128 + 16 * m + 4 * g) = (v2u){pk2(sel[0], sel[1]), pk2(sel[2], sel[3])};
        }
    }
}
__device__ __forceinline__ void peer_act_phase(const Frame& F, int rbeg) {
    CArgsP a = kargs(); unsigned char* const ws = a->ws;
    const int gtid = F.vcu * NT + F.tid, GT = F.G * NT;
    const bf16* PART = (const bf16*)(ws + WS_PART); const int* EI = (const int*)(ws + WS_EI); const float* EG = (const float*)(ws + WS_EG);
    const float* SU = (const float*)(ws + WS_SU); const float* SV = (const float*)(ws + WS_SV); const float* SX = (const float*)(ws + WS_SX);
    float* ACT = (float*)(ws + WS_ACT);
    for (int i = rbeg * 32 + gtid; i < R * 32; i += GT) {
        const int r = i >> 5;
        f32x4 sum = (f32x4){0.f, 0.f, 0.f, 0.f};
#pragma unroll
        for (int q = 0; q < 8; ++q) { const v2u w = *(const v2u*)(PART + (size_t)q * R * 128 + (size_t)i * 4); sum += (f32x4){bflo(w.x), bfhi(w.x), bflo(w.y), bfhi(w.y)}; }
        const v4i id = *(const v4i*)(EI + (size_t)i * 4); const f32x4 gt = *(const f32x4*)(EG + (size_t)i * 4);
        const float sx = SX[r];
        f32x4 o;
#pragma unroll
        for (int k = 0; k < 4; ++k) o[k] = gelu_tanh(sum[k] * sx * SU[id[k]]) * gt[k] * SV[id[k]];
        *(f32x4*)(ACT + (size_t)i * 4) = o;
    }
}
__device__ __forceinline__ void peer2_phase(const Frame& F, int layer, bool dry, int rbeg) {
    CArgsP a = kargs(); unsigned char* const ws = a->ws; const bool wr = !dry || a->pad == 12345;
    const unsigned char* EV8 = ws + WS_EV; const int* EI = (const int*)(ws + WS_EI); const float* ACT = (const float*)(ws + WS_ACT);
    const float* MOD = (const float*)(ws + WS_MOD) + (size_t)layer * 9 * 6144 + 5 * D;
    const int per = F.G >> 3, s = F.vcu / per, rank = F.vcu % per, stride = per * NWAVES;
    const int lane = F.lane, part = lane & 7, e8 = lane >> 3;
    const unsigned char* tab = EV8 + (size_t)s * NEXP * 128 + 16 * part;
    const bool b5 = (lane & 32) != 0, b4 = (lane & 16) != 0, b3 = (lane & 8) != 0;
    const int dimoff = 128 * s + 16 * part + (b5 ? 8 : 0) + (b4 ? 4 : 0) + (b3 ? 2 : 0);
    int r = rbeg + rank * NWAVES + F.wave;
    v4i id4[2][4];
#pragma unroll
    for (int u = 0; u < 2; ++u)
#pragma unroll
        for (int q = 0; q < 4; ++q) id4[u][q] = *(const v4i*)(EI + (size_t)min(r + u * stride, R - 1) * 128 + 16 * e8 + 4 * q);
    for (; r < R; r += 2 * stride) {
        v4u w[2][16]; f32x4 a4[2][4];
#pragma unroll
        for (int u = 0; u < 2; ++u) {
            const int ru = min(r + u * stride, R - 1);
#pragma unroll
            for (int j = 0; j < 16; ++j) w[u][j] = *(const v4u*)(tab + (size_t)id4[u][j >> 2][j & 3] * 128);
#pragma unroll
            for (int q = 0; q < 4; ++q) a4[u][q] = *(const f32x4*)(ACT + (size_t)ru * 128 + 16 * e8 + 4 * q);
        }
        const int rn = r + 2 * stride;
#pragma unroll
        for (int u = 0; u < 2; ++u)
#pragma unroll
            for (int q = 0; q < 4; ++q) id4[u][q] = *(const v4i*)(EI + (size_t)min(rn + u * stride, R - 1) * 128 + 16 * e8 + 4 * q);
#pragma unroll
        for (int u = 0; u < 2; ++u) {
            f32x2_t o[8];
#pragma unroll
            for (int k = 0; k < 8; ++k) o[k] = (f32x2_t){0.f, 0.f};
#pragma unroll
            for (int j = 0; j < 16; ++j) {
                const v4u ww = w[u][j];
                const float av = a4[u][j >> 2][j & 3]; const f32x2_t av2 = (f32x2_t){av, av};
                o[0] += av2 * __builtin_amdgcn_cvt_pk_f32_fp8((int)ww.x, false); o[1] += av2 * __builtin_amdgcn_cvt_pk_f32_fp8((int)ww.x, true);
                o[2] += av2 * __builtin_amdgcn_cvt_pk_f32_fp8((int)ww.y, false); o[3] += av2 * __builtin_amdgcn_cvt_pk_f32_fp8((int)ww.y, true);
                o[4] += av2 * __builtin_amdgcn_cvt_pk_f32_fp8((int)ww.z, false); o[5] += av2 * __builtin_amdgcn_cvt_pk_f32_fp8((int)ww.z, true);
                o[6] += av2 * __builtin_amdgcn_cvt_pk_f32_fp8((int)ww.w, false); o[7] += av2 * __builtin_amdgcn_cvt_pk_f32_fp8((int)ww.w, true);
            }
            f32x2_t v4[4], v2[2], v1;
#pragma unroll
            for (int k = 0; k < 4; ++k) { const f32x2_t snd = b5 ? o[k] : o[k + 4], kp = b5 ? o[k + 4] : o[k]; f32x2_t rc; rc.x = shx(snd.x, 32, lane); rc.y = shx(snd.y, 32, lane); v4[k] = kp + rc; }
#pragma unroll
            for (int k = 0; k < 2; ++k) { const f32x2_t snd = b4 ? v4[k] : v4[k + 2], kp = b4 ? v4[k + 2] : v4[k]; f32x2_t rc; rc.x = shx(snd.x, 16, lane); rc.y = shx(snd.y, 16, lane); v2[k] = kp + rc; }
            { const f32x2_t snd = b3 ? v2[0] : v2[1], kp = b3 ? v2[1] : v2[0]; f32x2_t rc; rc.x = shx(snd.x, 8, lane); rc.y = shx(snd.y, 8, lane); v1 = kp + rc; }
            const int ru = r + u * stride;
            if (ru < R) {
                const f32x2_t ga = *(const f32x2_t*)(MOD + row_slot(ru) * 6144 + dimoff);
                if (ru < NCTX) { float* xq = xc_row(a, ru) + dimoff; const f32x2_t xx = *(const f32x2_t*)xq; if (wr) *(f32x2_t*)xq = xx + ga * v1; }
                else { unsigned* xq = (unsigned*)(xl_row(a, ru) + dimoff); const unsigned w = *xq; const f32x2_t y = (f32x2_t){bflo(w), bfhi(w)} + ga * v1; if (wr) *xq = pk2(y.x, y.y); }
            }
        }
    }
}

__device__ __forceinline__ void final_phase(const Frame& F) {
    CArgsP a = kargs(); unsigned char* const ws = a->ws;
    const int gw = F.vcu * NWAVES + F.wave, NGW = F.G * NWAVES;
    f32x4 gv[4];
#pragma unroll
    for (int j = 0; j < 4; ++j) gv[j] = *((const f32x4*)a->in[I_GF] + F.lane + 64 * j);
    for (int r = gw; r < NLAT; r += NGW) {
        const v2u* xb = (const v2u*)((const bf16*)a->out + (size_t)r * XL_LD) + F.lane;
        f32x4* xr = (f32x4*)(a->out + (size_t)r * D) + F.lane;
        f32x4 v[4]; float ss = 0.f;
#pragma unroll
        for (int j = 0; j < 4; ++j) { const v2u w = xb[64 * j]; v[j] = (f32x4){bflo(w.x), bfhi(w.x), bflo(w.y), bfhi(w.y)}; ss += (v[j][0] * v[j][0] + v[j][1] * v[j][1]) + (v[j][2] * v[j][2] + v[j][3] * v[j][3]); }
        const float rs = rsqrtf(wave_sum(ss, F.lane) * (1.f / D) + EPS);
        asm volatile("s_waitcnt vmcnt(0)" ::: "memory");
#pragma unroll
        for (int j = 0; j < 4; ++j) xr[64 * j] = v[j] * rs * gv[j];
    }
}

__global__ void __launch_bounds__(NT, 2) fwd_kernel(Args args) {
    extern __shared__ __attribute__((aligned(16))) unsigned char lds[];
    Frame F;
    F.lds = (LAS unsigned char*)lds;
    F.tid = 0; F.lane = 0; F.wave = __builtin_amdgcn_readfirstlane((int)threadIdx.x >> 6);
    F.G = gridDim.x; { const int bx = blockIdx.x; F.vcu = (F.G % 8 == 0) ? (bx % 8) * (F.G / 8) + bx / 8 : bx; }
    volatile LAS unsigned* MISC = (volatile LAS unsigned*)(F.lds + MISC_OFF);
    for (int u = threadIdx.x; u < (LDS_BYTES - LDSCTL_OFF) / 4; u += NT) ((LAS unsigned*)(F.lds + LDSCTL_OFF))[u] = 0u;
    __syncthreads();
    XcdBarrier bar; bar.bar = (unsigned*)(args.ws + WS_CTL) + CW_BAR; bar.x = 0; bar.st = nullptr;
    if (MK_SINGLE) bar = xcd_barrier_post((unsigned*)(args.ws + WS_CTL) + CW_BAR, MISC + 8);
    const int lo = args.ph_lo, hi = args.ph_hi;
#define IN(k) (lo <= (k) && (k) < hi)
#define OPQ_BX ({ int bx_ = (int)blockIdx.x; asm volatile("" : "+s"(bx_)); bx_; })
#define PF Frame Fp = F; { int t_ = threadIdx.x; asm volatile("" : "+v"(t_), "+s"(Fp.vcu), "+s"(Fp.wave), "+s"(Fp.G)); Fp.tid = t_; Fp.lane = t_ & 63; }
#define SEAM(k) do { if (MK_SINGLE && IN(k) && IN((k) + 1)) { XcdBarrier b2_ = bar; asm volatile("" : "+s"(b2_.bar));     \
        xcd_barrier(b2_); if (PROBE == 50) xcd_barrier(b2_); } } while (0)

    if (IN(0)) { if (PROBE == 99) { PF; p0_prologue(Fp); } { PF; p0_prologue(Fp); } SEAM(0); }

    for (int l = 0; l < DEPTH; ++l) {
        const int pb = 1 + l * NPL;
        const int pm0 = (l == DEPTH - 1) ? 8 : 0, rbeg = pm0 * 256;
        if (IN(pb + 0)) { { PF; norm_phase(Fp, l, 0, 0); } { PF; convert_experts(Fp, l); } if (PROBE == 30) { PF; convert_experts(Fp, l); } SEAM(pb + 0); }
        if (IN(pb + 1)) {
            CArgsP ap = kargs(); unsigned char* const ws = ap->ws; bf16* Hb = (bf16*)(ws + WS_H); bf16* PA = (bf16*)(ws + WS_PA); bf16* PG = (bf16*)(ws + WS_PG);
            pg8::Gemm g{Hb, (const bf16*)(ws + WS_WIN) + (size_t)l * NPAD * D, R, NPAD, D, D}; pg8::StaticOrder S; S.init(R, NPAD, F.G, OPQ_BX);
            EpiIn E{PA, PG, (float*)(ws + WS_Z), (const float*)(ws + WS_ROPE), (bf16*)(ws + WS_VT), (bf16*)(ws + WS_NVT)};
            for (int rep = 0; rep < (PROBE == 1 ? 2 : 1); ++rep) pg8::gemm_phase<EpiIn, pg8::StaticOrder, true, true>(F.lds, g, S, E);
            SEAM(pb + 1);
        }
        if (IN(pb + 2)) { { PF; gla_a_phase(Fp, l); } if (PROBE == 2) { PF; gla_a_phase(Fp, l); } { const int nrep = (PROBE == 20 ? 2 : 1) + (kargs()->pad != 0 ? 1 : 0); for (int rep = 0; rep < nrep; ++rep) { PF; na_phase(Fp, l, rep + 1 < nrep, l == DEPTH - 1); } } SEAM(pb + 2); }
        if (IN(pb + 3)) { if (PROBE == 3) { PF; gla_b_phase(Fp, true); } { PF; gla_b_phase(Fp, false); } SEAM(pb + 3); }
        if (IN(pb + 4)) { if (PROBE == 4) { PF; gla_c_phase(Fp, l, true); } { PF; gla_c_phase(Fp, l, false); } SEAM(pb + 4); }
        if (IN(pb + 5)) {
            CArgsP ap = kargs(); unsigned char* const ws = ap->ws; bf16* Hb = (bf16*)(ws + WS_H); bf16* PA = (bf16*)(ws + WS_PA); bf16* PG = (bf16*)(ws + WS_PG);
            pg8::ShiftOrder S; S.init(R - rbeg, D, F.G, OPQ_BX); S.pm0 = pm0;
            { pg8::Gemm g{PA + PA_R, (const bf16*)(ws + WS_WPG) + (size_t)l * D * D, R, D, D, PA_LD}; EpiMergeK E{Hb, PG}; for (int rep = 0; rep < (PROBE == 5 ? 2 : 1); ++rep) pg8::gemm_phase<EpiMergeK, pg8::ShiftOrder, true, true>(F.lds, g, S, E); }
            SEAM(pb + 5);
        }
        if (IN(pb + 6)) {
            CArgsP ap = kargs(); unsigned char* const ws = ap->ws; bf16* Hb = (bf16*)(ws + WS_H);
            pg8::Gemm g{Hb, (const bf16*)(ws + WS_WO) + (size_t)l * D * D, R, D, D, D}; pg8::ShiftOrder S; S.init(R - rbeg, D, F.G, OPQ_BX); S.pm0 = pm0;
            EpiRes E{l == 0 ? ap->in[I_CTX] : (const float*)(ws + WS_XC), ap->in[I_X], (float*)(ws + WS_XC), (bf16*)ap->out, (const float*)(ws + WS_MOD) + (size_t)l * 9 * 6144, l == 0 ? 1 : 0};
            pg8::gemm_phase<EpiRes, pg8::ShiftOrder, true, true>(F.lds, g, S, E);
            SEAM(pb + 6);
        }
        if (IN(pb + 7)) { if (PROBE == 7) { PF; norm_phase(Fp, l, 1, rbeg); } { PF; norm_phase(Fp, l, 1, rbeg); } SEAM(pb + 7); }
        if (IN(pb + 8)) {
            CArgsP ap = kargs(); unsigned char* const ws = ap->ws; bf16* Hb = (bf16*)(ws + WS_H);
            pg8::Gemm g{Hb, (const bf16*)(ws + WS_WS) + (size_t)l * 2048 * D, R, 2048, D, D}; pg8::ShiftOrder S; S.init(R - rbeg, 2048, F.G, OPQ_BX); S.pm0 = pm0;
            EpiB16 E{(bf16*)(ws + WS_SC), 2048};
            for (int rep = 0; rep < (PROBE == 8 ? 2 : 1); ++rep) pg8::gemm_phase<EpiB16, pg8::ShiftOrder, true, true>(F.lds, g, S, E);
            SEAM(pb + 8);
        }
        if (IN(pb + 9)) { if (PROBE == 9) { PF; topk_phase(Fp, rbeg); } { PF; topk_phase(Fp, rbeg); } SEAM(pb + 9); }
        if (IN(pb + 10)) { if (PROBE == 10) { PF; peer1_phase(Fp, rbeg); } { PF; peer1_phase(Fp, rbeg); } SEAM(pb + 10); }
        if (IN(pb + 11)) { if (PROBE == 11) { PF; peer_act_phase(Fp, rbeg); } { PF; peer_act_phase(Fp, rbeg); } SEAM(pb + 11); }
        if (IN(pb + 12)) { if (PROBE == 12) { PF; peer2_phase(Fp, l, true, rbeg); } { PF; peer2_phase(Fp, l, false, rbeg); } SEAM(pb + 12); }
    }
    if (IN(NPHASE - 1)) { PF; final_phase(Fp); }
#undef IN
#undef SEAM
}

extern "C" void kernel_launch(void* const* d_in, const int* in_sizes, int n_in, void* d_out, int out_size, void* d_ws, size_t ws_size, hipStream_t stream) {
    static int grid = 0;
    if (grid == 0) {
        if (n_in != 23 || in_sizes[0] != NLAT * D || out_size != NLAT * D || ws_size < WS_END) { fprintf(stderr, "kernel_launch: unexpected shapes (n_in %d, in0 %d, out %d, ws %zu); nothing launched\n", n_in, n_in > 0 ? in_sizes[0] : -1, out_size, ws_size); grid = -1; return; }
        int dev = 0, cus = 0, per_cu = 0;
        if (hipGetDevice(&dev) != hipSuccess || hipDeviceGetAttribute(&cus, hipDeviceAttributeMultiprocessorCount, dev) != hipSuccess) { grid = -1; return; }
        if (hipFuncSetAttribute((const void*)fwd_kernel, hipFuncAttributeMaxDynamicSharedMemorySize, LDS_BYTES) != hipSuccess) { fprintf(stderr, "kernel_launch: hipFuncSetAttribute failed\n"); grid = -1; return; }
        if (hipOccupancyMaxActiveBlocksPerMultiprocessor(&per_cu, (const void*)fwd_kernel, NT, LDS_BYTES) != hipSuccess || per_cu < 1) { fprintf(stderr, "kernel_launch: occupancy query says %d blocks per CU\n", per_cu); }
        (void)hipGetLastError();
        grid = cus;
    }
    if (grid < 0) return;
    if (hipMemsetAsync((char*)d_ws + WS_CTL, 0, CTL_ZERO_BYTES, stream) != hipSuccess) return;
    Args a{};
    for (int i = 0; i < 23; ++i) a.in[i] = (const float*)d_in[i];
    a.out = (float*)d_out; a.ws = (unsigned char*)d_ws; a.pad = 0;
    if (MK_SINGLE) {
        a.ph_lo = 0; a.ph_hi = NPHASE; a.li = 0;
        hipLaunchKernelGGL(fwd_kernel, dim3(grid), dim3(NT), LDS_BYTES, stream, a);
    } else {
        for (int p = 0; p < NPHASE; ++p) { a.ph_lo = p; a.ph_hi = p + 1; a.li = p; hipLaunchKernelGGL(fwd_kernel, dim3(grid), dim3(NT), LDS_BYTES, stream, a); }
    }
}
```

```cpp
#include <hip/hip_runtime.h>
#include <cstdio>
#include <cstdint>

#ifndef PROBE
#define PROBE 0
#endif
#ifndef MK_SINGLE
#define MK_SINGLE 1
#endif

namespace pg8 {
#define PG8_LAS __attribute__((address_space(3)))
typedef unsigned short bf16_t;
typedef short bf16x8 __attribute__((ext_vector_type(8)));
typedef float f32x4 __attribute__((ext_vector_type(4)));
typedef unsigned u32x4 __attribute__((ext_vector_type(4)));
constexpr int BM = 256, BK = 64, HALF = 128, HTB = HALF * BK * 2, STAGE_BYTES = 8 * HTB, NXCD = 8, WGM = 8;

__host__ __device__ __forceinline__ int lds_byte(int r, int c) { const int st = (r >> 4) * 2 + (c >> 5), rr = r & 15, cc = c & 31, ob = rr * 64 + cc * 2; return st * 1024 + (ob ^ (((ob >> 9) & 1) << 5)); }
__host__ __device__ __forceinline__ void stage_rc(int b, int& R, int& C) { const int st = b / 1024, sb = b % 1024, swz = sb ^ (((sb >> 9) & 1) << 5); R = (st >> 1) * 16 + swz / 64; C = (st & 1) * 32 + (swz % 64) / 2; }
__host__ __device__ __forceinline__ int perm32(int rho) { const int n = rho >> 4, i = rho & 15; return 8 * (i >> 2) + 4 * n + (i & 3); }

struct Unit { int pm, pn; };
struct Gemm { const bf16_t* A; const bf16_t* Bt; int M, N, K, lda; };

struct StaticOrder {
    int nM, nN, nwg, G, c;
    __host__ __device__ void init(int M, int N, int G_, int c_) { nM = M / BM; nN = N / BM; nwg = nM * nN; G = G_; c = c_; }
    __host__ __device__ bool next(int i, Unit& u) const {
        const long L = (long)i * G + c; if (L >= nwg) return false;
        int wgid = (int)L; { const int q = nwg / NXCD, r = nwg % NXCD, xcd = wgid % NXCD, off = wgid / NXCD; wgid = (xcd < r ? xcd * (q + 1) : r * (q + 1) + (xcd - r) * q) + off; }
        const int nig = WGM * nN, gid = wgid / nig, fm = gid * WGM, gsz = (nM - fm) < WGM ? (nM - fm) : WGM;
        u.pm = fm + ((wgid % nig) % gsz); u.pn = (wgid % nig) / gsz; return true;
    }
    __device__ __forceinline__ void a_ready(const Unit&) const {}
    __device__ __forceinline__ void done(const Unit&) const {}
};
struct ShiftOrder : StaticOrder { int pm0; __host__ __device__ bool next(int i, Unit& u) const { if (!StaticOrder::next(i, u)) return false; u.pm += pm0; return true; } };

__device__ __forceinline__ unsigned cvt_pk_bf16(float lo, float hi) { unsigned r; asm volatile("v_cvt_pk_bf16_f32 %0, %1, %2" : "=v"(r) : "v"(lo), "v"(hi)); return r; }

template <class Epi, class Sched, bool ALIGN_EPI = false, bool SP2 = false>
__device__ __forceinline__ void gemm_phase(PG8_LAS unsigned char* lds, const Gemm g, const Sched& S, const Epi& E) {
    int tid_ = threadIdx.x; asm volatile("" : "+v"(tid_));
    const int tid = tid_, wid = __builtin_amdgcn_readfirstlane(tid >> 6), lane = tid & 63, wr = wid >> 2, wc = wid & 3, fr = lane & 15, fq = lane >> 4;
    const int K = g.K, nt = K / BK, lda = g.lda;
    unsigned voffA[2], voffB[2];
#pragma unroll
    for (int i = 0; i < 2; ++i) { int R, C; stage_rc(tid * 16 + i * 8192, R, C); const int Rb = Epi::PERM ? ((R & ~31) + perm32(R & 31)) : R;
        voffA[i] = (unsigned)(R * lda + C) * 2u; voffB[i] = (unsigned)(Rb * K + C) * 2u; }
    const size_t kstep = (size_t)(BK * 2);
    const size_t hstepA = (size_t)HALF * lda * 2, hstepB = (size_t)HALF * K * 2;
    const size_t tstepA = 2 * hstepA, tstepB = 2 * hstepB;
    const unsigned ldsw = (unsigned)wid * 1024u;
    const int aoff = lds_byte(wr * 64 + fr, fq * 8), boff = lds_byte(wc * 32 + fr, fq * 8);
#define PG8_SA(b, h) (((b) * 2 + (h)) * HTB)
#define PG8_SB(b, h) ((4 + (b) * 2 + (h)) * HTB)
#define PG8_STAGE(bufoff, gbase, voff) do { _Pragma("unroll") for (int _i = 0; _i < 2; ++_i) \
        __builtin_amdgcn_global_load_lds((const unsigned*)((const char*)(gbase) + (voff)[_i]), (PG8_LAS unsigned*)(lds + (bufoff) + ldsw + _i * 8192), 16, 0, 0); } while (0)
#define PG8_LDA(dst, b, h) do { _Pragma("unroll") for (int m = 0; m < 4; ++m) _Pragma("unroll") for (int k = 0; k < 2; ++k) dst[m][k] = *(const PG8_LAS bf16x8*)(lds + PG8_SA(b, h) + aoff + m * 2048 + k * 1024); } while (0)
#define PG8_LDB(dst, b, h) do { _Pragma("unroll") for (int n = 0; n < 2; ++n) _Pragma("unroll") for (int k = 0; k < 2; ++k) dst[n][k] = *(const PG8_LAS bf16x8*)(lds + PG8_SB(b, h) + boff + n * 2048 + k * 1024); } while (0)
#define PG8_MMA(ai, bj, At, Bt) do { __builtin_amdgcn_s_setprio(1); _Pragma("unroll") for (int m = 0; m < 4; ++m) _Pragma("unroll") for (int n = 0; n < 2; ++n) _Pragma("unroll") for (int k = 0; k < 2; ++k) \
        acc[ai][bj][m][n] = __builtin_amdgcn_mfma_f32_16x16x32_bf16(Bt[n][k], At[m][k], acc[ai][bj][m][n], 0, 0, 0); __builtin_amdgcn_s_setprio(0); } while (0)
#define PG8_WAIT_V(n) asm volatile("s_waitcnt vmcnt(" #n ")" ::: "memory")
#define PG8_WAIT_L(n) asm volatile("s_waitcnt lgkmcnt(" #n ")" ::: "memory")
#define PG8_BAR __builtin_amdgcn_s_barrier()
#define PG8_SCHED __builtin_amdgcn_sched_barrier(0)
    Unit cur, nxt; int ui = 0;
    if (!S.next(0, cur)) return;
    f32x4 acc[2][2][4][2];
#pragma unroll
    for (int a = 0; a < 2; ++a)
#pragma unroll
        for (int b = 0; b < 2; ++b)
#pragma unroll
            for (int m = 0; m < 4; ++m)
#pragma unroll
                for (int n = 0; n < 2; ++n) acc[a][b][m][n] = (f32x4){0.f, 0.f, 0.f, 0.f};
    bf16x8 At[4][2], B0[2][2], B1[2][2];
    const char* cA = (const char*)g.A + (size_t)cur.pm * tstepA; const char* cB = (const char*)g.Bt + (size_t)cur.pn * tstepB;
    S.a_ready(cur);
    if constexpr (SP2) {
        PG8_STAGE(PG8_SB(0, 0), cB, voffB); PG8_STAGE(PG8_SB(0, 1), cB + hstepB, voffB); PG8_STAGE(PG8_SA(0, 0), cA, voffA); PG8_STAGE(PG8_SA(0, 1), cA + hstepA, voffA);
        if (wr == 1) PG8_BAR;
        PG8_WAIT_V(2); PG8_BAR;
        PG8_STAGE(PG8_SB(1, 0), cB + kstep, voffB); PG8_STAGE(PG8_SA(1, 0), cA + kstep, voffA); PG8_STAGE(PG8_SB(1, 1), cB + hstepB + kstep, voffB);
        PG8_WAIT_V(6); PG8_BAR;
    } else {
        PG8_STAGE(PG8_SB(0, 0), cB, voffB); PG8_STAGE(PG8_SA(0, 0), cA, voffA); PG8_STAGE(PG8_SB(0, 1), cB + hstepB, voffB); PG8_STAGE(PG8_SA(0, 1), cA + hstepA, voffA);
        if (wr == 1) PG8_BAR;
        PG8_WAIT_V(4); PG8_BAR;
        PG8_STAGE(PG8_SB(1, 0), cB + kstep, voffB); PG8_STAGE(PG8_SA(1, 0), cA + kstep, voffA); PG8_STAGE(PG8_SB(1, 1), cB + hstepB + kstep, voffB);
        PG8_WAIT_V(6); PG8_BAR;
    }
    for (;;) {
        const bool has_next = S.next(ui + 1, nxt);
        const char* nA = has_next ? (const char*)g.A + (size_t)nxt.pm * tstepA : cA; const char* nB = has_next ? (const char*)g.Bt + (size_t)nxt.pn * tstepB : cB;
        for (int t = 0; t < nt; t += 2) {
            const bool last = (t == nt - 2);
            const char* a1 = cA + (size_t)(t + 1) * kstep;
            const char* a2 = last ? nA : cA + (size_t)(t + 2) * kstep; const char* b2 = last ? nB : cB + (size_t)(t + 2) * kstep;
            const char* a3 = a2 + kstep; const char* b3 = b2 + kstep;
            if (last && has_next) S.a_ready(nxt);
            if constexpr (Epi::HAS_MID) { if (t == nt / 2) E.mid(acc, cur, wr, wc, fr, fq); }
            if constexpr (SP2) {
            PG8_LDB(B0, 0, 0); PG8_LDB(B1, 0, 1); PG8_SCHED; PG8_LDA(At, 0, 0); PG8_STAGE(PG8_SA(1, 1), a1 + hstepA, voffA);
            PG8_WAIT_V(8); PG8_WAIT_L(0); PG8_BAR; PG8_MMA(0, 0, At, B0); PG8_MMA(0, 1, At, B1); PG8_BAR; PG8_SCHED;
            PG8_LDA(At, 0, 1); PG8_STAGE(PG8_SB(0, 0), b2, voffB); PG8_STAGE(PG8_SB(0, 1), b2 + hstepB, voffB); PG8_STAGE(PG8_SA(0, 0), a2, voffA);
            PG8_WAIT_V(8); PG8_WAIT_L(0); PG8_BAR; PG8_MMA(1, 0, At, B0); PG8_MMA(1, 1, At, B1); PG8_BAR; PG8_SCHED;
            PG8_LDB(B0, 1, 0); PG8_LDB(B1, 1, 1); PG8_SCHED; PG8_LDA(At, 1, 0); PG8_STAGE(PG8_SA(0, 1), a2 + hstepA, voffA);
            PG8_WAIT_V(8); PG8_WAIT_L(0); PG8_BAR; PG8_MMA(0, 0, At, B0); PG8_MMA(0, 1, At, B1); PG8_BAR; PG8_SCHED;
            PG8_LDA(At, 1, 1); PG8_STAGE(PG8_SB(1, 0), b3, voffB); PG8_STAGE(PG8_SB(1, 1), b3 + hstepB, voffB); PG8_STAGE(PG8_SA(1, 0), a3, voffA);
            PG8_WAIT_V(8); PG8_WAIT_L(0); PG8_BAR; PG8_MMA(1, 0, At, B0); PG8_MMA(1, 1, At, B1); PG8_BAR; PG8_SCHED;
            } else {
            PG8_LDB(B0, 0, 0); PG8_SCHED; PG8_LDA(At, 0, 0); PG8_STAGE(PG8_SA(1, 1), a1 + hstepA, voffA);
            PG8_WAIT_L(8); PG8_BAR; PG8_WAIT_L(0); PG8_MMA(0, 0, At, B0); PG8_BAR; PG8_SCHED;
            PG8_LDB(B1, 0, 1); PG8_STAGE(PG8_SB(0, 0), b2, voffB);
            PG8_BAR; PG8_WAIT_L(0); PG8_MMA(0, 1, At, B1); PG8_BAR;
            PG8_LDA(At, 0, 1); PG8_STAGE(PG8_SA(0, 0), a2, voffA);
            PG8_BAR; PG8_WAIT_L(0); PG8_MMA(1, 0, At, B0); PG8_BAR; PG8_SCHED;
            PG8_STAGE(PG8_SB(0, 1), b2 + hstepB, voffB);
            PG8_WAIT_V(6); PG8_BAR; PG8_MMA(1, 1, At, B1); PG8_BAR;
            PG8_LDB(B0, 1, 0); PG8_SCHED; PG8_LDA(At, 1, 0); PG8_STAGE(PG8_SA(0, 1), a2 + hstepA, voffA);
            PG8_WAIT_L(8); PG8_BAR; PG8_WAIT_L(0); PG8_MMA(0, 0, At, B0); PG8_BAR; PG8_SCHED;
            PG8_LDB(B1, 1, 1); PG8_STAGE(PG8_SB(1, 0), b3, voffB);
            PG8_BAR; PG8_WAIT_L(0); PG8_MMA(0, 1, At, B1); PG8_BAR;
            PG8_LDA(At, 1, 1); PG8_STAGE(PG8_SA(1, 0), a3, voffA);
            PG8_BAR; PG8_WAIT_L(0); PG8_MMA(1, 0, At, B0); PG8_BAR; PG8_SCHED;
            PG8_STAGE(PG8_SB(1, 1), b3 + hstepB, voffB);
            PG8_WAIT_V(6); PG8_BAR; PG8_MMA(1, 1, At, B1); PG8_BAR;
            }
        }
        if constexpr (ALIGN_EPI) { if (wr == 0) PG8_BAR; }
        E(acc, cur, wr, wc, fr, fq); S.done(cur);
        if (!has_next) break;
#pragma unroll
        for (int a = 0; a < 2; ++a)
#pragma unroll
            for (int b = 0; b < 2; ++b)
#pragma unroll
                for (int m = 0; m < 4; ++m)
#pragma unroll
                    for (int n = 0; n < 2; ++n) acc[a][b][m][n] = (f32x4){0.f, 0.f, 0.f, 0.f};
        cur = nxt; cA = nA; cB = nB; ++ui;
        if constexpr (ALIGN_EPI) { if (wr == 1) PG8_BAR; }
    }
    PG8_WAIT_V(0);
    if constexpr (!ALIGN_EPI) { if (wr == 0) PG8_BAR; }
    PG8_BAR;
#undef PG8_SA
#undef PG8_SB
#undef PG8_STAGE
#undef PG8_LDA
#undef PG8_LDB
#undef PG8_MMA
#undef PG8_WAIT_V
#undef PG8_WAIT_L
#undef PG8_BAR
#undef PG8_SCHED
}
}

constexpr int D = 1024, BATCH = 8, SEQ = 8192, DEPTH = 4, CTXL = 256, GRIDW = 64;
constexpr int NCTX = BATCH * CTXL;
constexpr int NLAT = BATCH * SEQ;
constexpr int R = NCTX + NLAT;
constexpr int IN_COLS = 5152, NPAD = 5376;
constexpr int PA_LD = 2048, PG_LD = 2048;
constexpr int PA_Q = 0, PA_K = 256, PA_R = 512, PA_NQ = 1024, PA_NK = 1536;
constexpr int NCHUNK = 132;
constexpr int NEXP = 16384;
constexpr float EPS = 1e-6f;
constexpr int NWAVES = 8, NT = 512;
constexpr int NPL = 13;
constexpr int NPHASE = 1 + DEPTH * NPL + 1;

constexpr size_t MiB = 1u << 20;
constexpr size_t WS_CTL = 0, CTL_ZERO_BYTES = 2 * MiB;
constexpr size_t WS_MOD = 1 * MiB;
constexpr size_t WS_ROPE = 2 * MiB;
constexpr size_t WS_WIN = 3 * MiB;
constexpr size_t WS_WPG = 45 * MiB, WS_WPN = 49 * MiB;
constexpr size_t WS_WO = 53 * MiB;
constexpr size_t WS_WS = 61 * MiB;
constexpr size_t WS_XC = 77 * MiB;
constexpr size_t WS_Z = 85 * MiB;
constexpr size_t WS_EU = 94 * MiB, WS_EV = 110 * MiB;
constexpr size_t WS_SU = 126 * MiB, WS_SV = WS_SU + 65536, WS_SX = WS_SV + 65536;
constexpr size_t WS_H8 = 884 * MiB;
constexpr size_t WS_PART = 290 * MiB;
constexpr size_t WS_ACT = 554 * MiB;
constexpr size_t WS_H = 158 * MiB;
constexpr size_t WS_PA = 290 * MiB;
constexpr size_t WS_VT = 554 * MiB, WS_NVT = 620 * MiB;
constexpr size_t WS_DEC = 950 * MiB;
constexpr size_t WS_PG = 686 * MiB;
constexpr size_t WS_SC = 290 * MiB;
constexpr size_t WS_EI = 818 * MiB, WS_EG = 851 * MiB;
constexpr size_t WS_END = 953 * MiB;
static_assert(WS_SC + (size_t)R * 2048 * 4 <= WS_EI && WS_EG + (size_t)R * 128 * 4 <= WS_DEC && WS_PG + (size_t)R * PG_LD * 2 <= WS_DEC && WS_DEC + 64 * 132 * 64 * 4 <= WS_END, "ws map");
static_assert(WS_H + (size_t)R * 1024 * 2 <= WS_PA && WS_PA + (size_t)R * PA_LD * 2 <= WS_VT && WS_VT + (size_t)R * 512 * 2 <= WS_NVT && WS_NVT + (size_t)R * 512 * 2 <= WS_PG && WS_Z + (size_t)R * 32 * 4 <= WS_EU, "ws map");
constexpr int CW_BAR = 4096;

constexpr int RING_BYTES = 131072, LDSCTL_OFF = RING_BYTES, MISC_OFF = LDSCTL_OFF + 320, LDS_BYTES = 147456;

#define GAS __attribute__((address_space(1)))
#define LAS __attribute__((address_space(3)))
typedef unsigned short bf16;
typedef unsigned v4u __attribute__((ext_vector_type(4)));
typedef unsigned v2u __attribute__((ext_vector_type(2)));
typedef int v4i __attribute__((ext_vector_type(4)));
typedef float f32x4 __attribute__((ext_vector_type(4)));
typedef __bf16 bf16x2_t __attribute__((ext_vector_type(2)));
#define LDS_WAIT() asm volatile("s_waitcnt lgkmcnt(0)" ::: "memory")
#define VM_WAIT() asm volatile("s_waitcnt vmcnt(0)" ::: "memory")
__device__ __forceinline__ unsigned f2bf(float f) { unsigned u = __builtin_bit_cast(unsigned, f); return (u + 0x7fffu + ((u >> 16) & 1u)) >> 16; }
__device__ __forceinline__ unsigned pk2(float lo, float hi) { return f2bf(lo) | (f2bf(hi) << 16); }
__device__ __forceinline__ float bflo(unsigned w) { return __builtin_bit_cast(float, w << 16); }
__device__ __forceinline__ float bfhi(unsigned w) { return __builtin_bit_cast(float, w & 0xffff0000u); }
__device__ __forceinline__ float bf1(bf16 h) { return __builtin_bit_cast(float, ((unsigned)h) << 16); }
__device__ __forceinline__ float dot2(unsigned a, unsigned b, float acc) { return __builtin_amdgcn_fdot2_f32_bf16(__builtin_bit_cast(bf16x2_t, a), __builtin_bit_cast(bf16x2_t, b), acc, false); }
__device__ __forceinline__ float shx(float v, int mask, int lane) { return __builtin_bit_cast(float, __builtin_amdgcn_ds_bpermute((lane ^ mask) << 2, __builtin_bit_cast(int, v))); }
__device__ __forceinline__ float wave_sum(float v, int lane) {
#pragma unroll
    for (int o = 1; o < 64; o <<= 1) v += shx(v, o, lane);
    return v;
}
__device__ __forceinline__ float wave_max(float v, int lane) {
#pragma unroll
    for (int o = 1; o < 64; o <<= 1) v = fmaxf(v, shx(v, o, lane));
    return v;
}
__device__ __forceinline__ float sigmoidf_(float x) { return __builtin_amdgcn_rcpf(1.f + __expf(-x)); }

#define XB_TMO      128
#define XB_XCNT(j)  (256  + 64 * (j))
#define XB_XSUB(j)  (1280 + 64 * (j))
#define XB_XGEN(j)  (2304 + 64 * (j))
#define XB_TOP      3328
#define XB_TOPGEN   3392
#define XCD_BAR_WORDS 3456
#define XB_SPIN_CAP (1u << 18)
__device__ __forceinline__ unsigned xb_ld(unsigned* p)              { return __hip_atomic_load(p, __ATOMIC_RELAXED, __HIP_MEMORY_SCOPE_AGENT); }
__device__ __forceinline__ unsigned xb_add(unsigned* p, unsigned v) { return __hip_atomic_fetch_add(p, v, __ATOMIC_RELAXED, __HIP_MEMORY_SCOPE_AGENT); }
__device__ __forceinline__ unsigned xb_xcc_id() { return (unsigned)__builtin_amdgcn_s_getreg((3 << 11) | 20) & 0xFu; }
#define XB_SPIN(cond, bar) do { unsigned _sp = 0; while (cond) { __builtin_amdgcn_s_sleep(1); \
    if ((++_sp & 255u) == 0u) { if (xb_ld(&(bar)[XB_TMO])) break; if (_sp > XB_SPIN_CAP) { atomicAdd(&(bar)[XB_TMO], 1u); break; } } } } while (0)
struct XcdBarrier { unsigned* bar; unsigned x; volatile LAS unsigned* st; };
__device__ __forceinline__ XcdBarrier xcd_barrier_post(unsigned* bar, volatile LAS unsigned* st) {
    XcdBarrier b; b.bar = bar; b.x = xb_xcc_id(); b.st = st;
    if (threadIdx.x == 0) (void)xb_add(&bar[XB_XCNT(b.x)], 1u);
    return b;
}
__device__ __forceinline__ void xcd_barrier_complete(unsigned* bar, unsigned x, unsigned& nloc, unsigned& nx) {
    const unsigned G = gridDim.x * gridDim.y * gridDim.z;
    unsigned sum, cnt, mine, sp = 0u;
    for (;;) {
        sum = 0u; cnt = 0u; mine = 0u;
#pragma unroll
        for (unsigned j = 0; j < 16; ++j) { const unsigned c = xb_ld(&bar[XB_XCNT(j)]); sum += c; cnt += (c > 0u) ? 1u : 0u; mine = (j == x) ? c : mine; }
        if (sum == G) break;
        __builtin_amdgcn_s_sleep(1);
        if ((++sp & 255u) == 0u) { if (xb_ld(&bar[XB_TMO])) break; if (sp > XB_SPIN_CAP) { atomicAdd(&bar[XB_TMO], 1u); break; } }
    }
    nloc = mine > 0u ? mine : 1u; nx = cnt > 0u ? cnt : 1u;
}
__device__ __forceinline__ void xcd_barrier(const XcdBarrier& b) {
    asm volatile("s_waitcnt vmcnt(0)" ::: "memory");
    __syncthreads();
    int tid0_ = threadIdx.x; asm volatile("" : "+v"(tid0_));
    if (tid0_ == 0) {
        unsigned* bar = b.bar;
        __builtin_amdgcn_s_waitcnt(0);
        unsigned nloc = b.st[0], nx = b.st[1];
        if (nloc == 0u) { xcd_barrier_complete(bar, b.x, nloc, nx); b.st[0] = nloc; b.st[1] = nx; }
        const unsigned old = xb_add(&bar[XB_XSUB(b.x)], 1u);
        const unsigned gen = old / nloc;
        if (old + 1u == (gen + 1u) * nloc) {
            __builtin_amdgcn_fence(__ATOMIC_RELEASE, "agent");
            asm volatile("s_waitcnt vmcnt(0)" ::: "memory");
            const unsigned og = xb_add(&bar[XB_TOP], 1u);
            const unsigned tg = og / nx;
            if (og + 1u == (tg + 1u) * nx) xb_add(&bar[XB_TOPGEN], 1u);
            else XB_SPIN(xb_ld(&bar[XB_TOPGEN]) == tg, bar);
            __builtin_amdgcn_fence(__ATOMIC_ACQUIRE, "agent");
            xb_add(&bar[XB_XGEN(b.x)], 1u);
            asm volatile("s_waitcnt vmcnt(0)" ::: "memory");
        } else {
            XB_SPIN(xb_ld(&bar[XB_XGEN(b.x)]) == gen, bar);
            __builtin_amdgcn_fence(__ATOMIC_ACQUIRE, "agent");
            asm volatile("s_waitcnt vmcnt(0)" ::: "memory");
        }
    }
    __syncthreads();
}

struct Args { const float* in[23]; float* out; unsigned char* ws; int ph_lo, ph_hi, li, pad; };
enum { I_X = 0, I_C, I_CTX, I_CCTX, I_WMOD, I_BMOD, I_GN1, I_WIN, I_WAF, I_BAF, I_WAB, I_BAB, I_GGLA, I_RPB, I_WPG, I_WPN, I_WO, I_GN2, I_WQ, I_SK, I_EU, I_EV, I_GF };

struct Frame {
    LAS unsigned char* lds;
    int tid, lane, wave, vcu, G;
};
typedef const __attribute__((address_space(4))) Args* CArgsP;
__device__ __forceinline__ CArgsP kargs() { CArgsP p = (CArgsP)__builtin_amdgcn_kernarg_segment_ptr(); asm volatile("" : "+s"(p)); return p; }
__device__ __forceinline__ const float* xrow_in(CArgsP a, int r) { return r < NCTX ? a->in[I_CTX] + (size_t)r * D : a->in[I_X] + (size_t)(r - NCTX) * D; }
constexpr int XL_LD = 2048;
__device__ __forceinline__ float* xc_row(CArgsP a, int r) { return (float*)(a->ws + WS_XC) + (size_t)r * D; }
__device__ __forceinline__ bf16* xl_row(CArgsP a, int r) { return (bf16*)a->out + (size_t)(r - NCTX) * XL_LD; }
__device__ __forceinline__ int row_slot(int r) { return r < NCTX ? 8 : ((r - NCTX) >> 13); }

using pg8::f32x4; using pg8::u32x4; using pg8::Unit; using pg8::cvt_pk_bf16;
struct EpiIn {
    static constexpr bool HAS_MID = false, PERM = true;
    bf16* PA; bf16* PG; float* Z; const float* rope; bf16* VT; bf16* NVT;
    __device__ __forceinline__ void operator()(const f32x4 (&acc)[2][2][4][2], const Unit& u, int wr, int wc, int fr, int fq) const {
        const int pn = u.pn, row0 = u.pm * 256 + wr * 64 + fr;
        if (pn == 20) {
            if (wc == 0) {
#pragma unroll
                for (int ai = 0; ai < 2; ++ai)
#pragma unroll
                    for (int m = 0; m < 4; ++m) { float* zp = Z + (size_t)(row0 + ai * 128 + m * 16) * 32 + 8 * fq; *(f32x4*)zp = acc[ai][0][m][0]; *(f32x4*)(zp + 4) = acc[ai][0][m][1]; }
            }
            return;
        }
        if (pn >= 8 && pn < 12) {
            bf16* T = (pn < 10 ? VT : NVT) + (size_t)(((pn - 8) & 1) * 256 + wc * 32 + 8 * fq) * R;
#pragma unroll
            for (int ai = 0; ai < 2; ++ai)
#pragma unroll
                for (int m = 0; m < 4; ++m) {
                    const int row = row0 + ai * 128 + m * 16;
#pragma unroll
                    for (int bj = 0; bj < 2; ++bj) {
                        const f32x4 v0 = acc[ai][bj][m][0], v1 = acc[ai][bj][m][1];
                        bf16* tp = T + (size_t)(bj * 128) * R + row;
                        tp[0 * (size_t)R] = (bf16)f2bf(v0[0]); tp[1 * (size_t)R] = (bf16)f2bf(v0[1]); tp[2 * (size_t)R] = (bf16)f2bf(v0[2]); tp[3 * (size_t)R] = (bf16)f2bf(v0[3]);
                        tp[4 * (size_t)R] = (bf16)f2bf(v1[0]); tp[5 * (size_t)R] = (bf16)f2bf(v1[1]); tp[6 * (size_t)R] = (bf16)f2bf(v1[2]); tp[7 * (size_t)R] = (bf16)f2bf(v1[3]);
                    }
                }
            return;
        }
        bf16* base; int ldc, colt;
        if (pn < 8) { base = PA; ldc = PA_LD; colt = pn * 256; } else { base = PG; ldc = PG_LD; colt = (pn - 12) * 256; }
        const int col0 = colt + wc * 32 + 8 * fq;
        const bool do_rope = (pn < 2) && (u.pm >= 8);
        const float sc = (pn == 0 || pn == 4 || pn == 5) ? 0.125f : 1.f;
#pragma unroll
        for (int ai = 0; ai < 2; ++ai)
#pragma unroll
            for (int m = 0; m < 4; ++m) {
                const int row = row0 + ai * 128 + m * 16;
                bf16* rowp = base + (size_t)row * ldc + col0;
                f32x4 cs[4];
                if (do_rope) { const int t = (row - NCTX) & (SEQ - 1); const int pos = (wc & 1) ? (t & 63) : (t >> 6);
                    const f32x4* cp = (const f32x4*)(rope + (size_t)(pos * 16 + 8 * (fq & 1)) * 2);
                    cs[0] = cp[0]; cs[1] = cp[1]; cs[2] = cp[2]; cs[3] = cp[3]; }
#pragma unroll
                for (int bj = 0; bj < 2; ++bj) {
                    f32x4 v0 = acc[ai][bj][m][0], v1 = acc[ai][bj][m][1];
                    if (do_rope) {
                        float x[8] = {v0[0], v0[1], v0[2], v0[3], v1[0], v1[1], v1[2], v1[3]};
#pragma unroll
                        for (int e = 0; e < 8; ++e) { const float p = shx(x[e], 32, fr + 16 * fq); const float c = cs[e >> 1][(e & 1) * 2], s = cs[e >> 1][(e & 1) * 2 + 1];
                            x[e] = (fq < 2) ? (x[e] * c - p * s) : (p * s + x[e] * c); }
                        v0 = (f32x4){x[0], x[1], x[2], x[3]}; v1 = (f32x4){x[4], x[5], x[6], x[7]};
                    }
                    v0 = v0 * sc; v1 = v1 * sc;
                    u32x4 w; w.x = cvt_pk_bf16(v0[0], v0[1]); w.y = cvt_pk_bf16(v0[2], v0[3]); w.z = cvt_pk_bf16(v1[0], v1[1]); w.w = cvt_pk_bf16(v1[2], v1[3]);
                    *(u32x4*)(rowp + bj * 128) = w;
                }
                asm volatile("" ::: "memory");
            }
    }
};
struct EpiMergeK {
    static constexpr bool HAS_MID = true, PERM = true;
    bf16* MG; const bf16* PG;
    __device__ __forceinline__ void mid(f32x4 (&acc)[2][2][4][2], const Unit& u, int wr, int wc, int fr, int fq) const {
        int row0 = u.pm * 256 + wr * 64 + fr, col0 = u.pn * 256 + wc * 32 + 8 * fq;
        asm volatile("" : "+v"(row0), "+v"(col0));
#pragma unroll
        for (int ai = 0; ai < 2; ++ai)
#pragma unroll
            for (int m = 0; m < 4; ++m) {
                const bf16* gp = PG + (size_t)(row0 + ai * 128 + m * 16) * PG_LD + col0;
#pragma unroll
                for (int bj = 0; bj < 2; ++bj) {
                    const u32x4 g1 = *(const u32x4*)(gp + bj * 128), g2 = *(const u32x4*)(gp + 1024 + bj * 128);
                    const unsigned a1[4] = {g1.x, g1.y, g1.z, g1.w}, a2[4] = {g2.x, g2.y, g2.z, g2.w};
#pragma unroll
                    for (int q = 0; q < 4; ++q) {
                        const float r0 = (1.f + __expf(-bflo(a2[q]))) * __builtin_amdgcn_rcpf(1.f + __expf(-bflo(a1[q])));
                        const float r1 = (1.f + __expf(-bfhi(a2[q]))) * __builtin_amdgcn_rcpf(1.f + __expf(-bfhi(a1[q])));
                        acc[ai][bj][m][q >> 1][(q & 1) * 2] *= r0; acc[ai][bj][m][q >> 1][(q & 1) * 2 + 1] *= r1;
                    }
                }
                asm volatile("" ::: "memory");
            }
    }
    __device__ __forceinline__ void operator()(const f32x4 (&acc)[2][2][4][2], const Unit& u, int wr, int wc, int fr, int fq) const {
        int row0 = u.pm * 256 + wr * 64 + fr, col0 = u.pn * 256 + wc * 32 + 8 * fq;
        asm volatile("" : "+v"(row0), "+v"(col0));
#pragma unroll
        for (int ai = 0; ai < 2; ++ai)
#pragma unroll
            for (int m = 0; m < 4; ++m) {
                const int row = row0 + ai * 128 + m * 16;
#pragma unroll
                for (int bj = 0; bj < 2; ++bj) {
                    const int c = col0 + bj * 128;
                    const u32x4 g = *(const u32x4*)(PG + (size_t)row * PG_LD + 1024 + c);
                    const f32x4 v0 = acc[ai][bj][m][0], v1 = acc[ai][bj][m][1];
                    u32x4 w; w.x = cvt_pk_bf16(sigmoidf_(bflo(g.x)) * v0[0], sigmoidf_(bfhi(g.x)) * v0[1]); w.y = cvt_pk_bf16(sigmoidf_(bflo(g.y)) * v0[2], sigmoidf_(bfhi(g.y)) * v0[3]);
                    w.z = cvt_pk_bf16(sigmoidf_(bflo(g.z)) * v1[0], sigmoidf_(bfhi(g.z)) * v1[1]); w.w = cvt_pk_bf16(sigmoidf_(bflo(g.w)) * v1[2], sigmoidf_(bfhi(g.w)) * v1[3]);
                    *(u32x4*)(MG + (size_t)row * D + c) = w;
                }
                asm volatile("" ::: "memory");
            }
    }
};
struct EpiRes {
    static constexpr bool HAS_MID = false, PERM = true;
    const float* src_c; const float* src_l; float* dst_c; bf16* dst_l; const float* mod; int first;
    __device__ __forceinline__ void operator()(const f32x4 (&acc)[2][2][4][2], const Unit& u, int wr, int wc, int fr, int fq) const {
        const bool isctx = u.pm < 8;
        const int slot = isctx ? 8 : ((u.pm - 8) >> 5);
        int rbase = (isctx ? u.pm * 256 : (u.pm - 8) * 256) + wr * 64 + fr, col0 = u.pn * 256 + wc * 32 + 8 * fq;
        asm volatile("" : "+v"(rbase), "+v"(col0));
        const float* ga = mod + slot * 6144 + 2048;
        f32x4 gv[2][2];
#pragma unroll
        for (int bj = 0; bj < 2; ++bj)
#pragma unroll
            for (int n = 0; n < 2; ++n) gv[bj][n] = *(const f32x4*)(ga + col0 + bj * 128 + 4 * n);
#pragma unroll
        for (int ai = 0; ai < 2; ++ai)
#pragma unroll
            for (int m = 0; m < 4; ++m) {
                const int row = rbase + ai * 128 + m * 16;
#pragma unroll
                for (int bj = 0; bj < 2; ++bj) {
                    const int c = col0 + bj * 128;
                    f32x4 x0, x1;
                    if (isctx || first) { const float* sp = (isctx ? src_c : src_l) + (size_t)row * D + c; x0 = *(const f32x4*)sp; x1 = *(const f32x4*)(sp + 4); }
                    else { const u32x4 w = *(const u32x4*)(dst_l + (size_t)row * XL_LD + c); x0 = (f32x4){bflo(w.x), bfhi(w.x), bflo(w.y), bfhi(w.y)}; x1 = (f32x4){bflo(w.z), bfhi(w.z), bflo(w.w), bfhi(w.w)}; }
                    x0 = x0 + gv[bj][0] * acc[ai][bj][m][0]; x1 = x1 + gv[bj][1] * acc[ai][bj][m][1];
                    if (isctx) { float* dp = dst_c + (size_t)row * D + c; *(f32x4*)dp = x0; *(f32x4*)(dp + 4) = x1; }
                    else { u32x4 w; w.x = cvt_pk_bf16(x0[0], x0[1]); w.y = cvt_pk_bf16(x0[2], x0[3]); w.z = cvt_pk_bf16(x1[0], x1[1]); w.w = cvt_pk_bf16(x1[2], x1[3]); *(u32x4*)(dst_l + (size_t)row * XL_LD + c) = w; }
                }
                asm volatile("" ::: "memory");
            }
    }
};
struct EpiB16 {
    static constexpr bool HAS_MID = false, PERM = true;
    bf16* C; int ldc;
    __device__ __forceinline__ void operator()(const f32x4 (&acc)[2][2][4][2], const Unit& u, int wr, int wc, int fr, int fq) const {
        const int row0 = u.pm * 256 + wr * 64 + fr, col0 = u.pn * 256 + wc * 32 + 8 * fq;
#pragma unroll
        for (int ai = 0; ai < 2; ++ai)
#pragma unroll
            for (int m = 0; m < 4; ++m) { bf16* rowp = C + (size_t)(row0 + ai * 128 + m * 16) * ldc + col0;
#pragma unroll
                for (int bj = 0; bj < 2; ++bj) { const f32x4 v0 = acc[ai][bj][m][0], v1 = acc[ai][bj][m][1];
                    u32x4 w; w.x = cvt_pk_bf16(v0[0], v0[1]); w.y = cvt_pk_bf16(v0[2], v0[3]); w.z = cvt_pk_bf16(v1[0], v1[1]); w.w = cvt_pk_bf16(v1[2], v1[3]);
                    *(u32x4*)(rowp + bj * 128) = w; } }
    }
};
__device__ __forceinline__ void p0_transpose_item(const float* W, int K, int N, bf16* WT, int dst_row0, LAS float* scr, int k0, int n0, int lane) {
#pragma unroll 8
    for (int i = 0; i < 32; ++i) { const int kk = 2 * i + (lane >> 5); scr[kk * 33 + (lane & 31)] = W[(size_t)(k0 + kk) * N + n0 + (lane & 31)]; }
    LDS_WAIT(); asm volatile("" ::: "memory");
    const int c = lane & 7;
#pragma unroll
    for (int j = 0; j < 4; ++j) { const int n = (lane >> 3) + 8 * j; const LAS float* s = scr + (8 * c) * 33 + n;
        v4u o; o.x = pk2(s[0 * 33], s[1 * 33]); o.y = pk2(s[2 * 33], s[3 * 33]); o.z = pk2(s[4 * 33], s[5 * 33]); o.w = pk2(s[6 * 33], s[7 * 33]);
        *(v4u*)(WT + (size_t)(dst_row0 + n) * K + k0 + 8 * c) = o; }
    LDS_WAIT(); asm volatile("" ::: "memory");
}
__device__ __forceinline__ int win_map(int n0) {
    if (n0 < 512) return n0;
    if (n0 < 1024) return 2048 + (n0 - 512);
    if (n0 < 1056) return 5120 + (n0 - 1024);
    if (n0 < 1568) return 512 + (n0 - 1056);
    if (n0 < 2080) return 1024 + (n0 - 1568);
    if (n0 < 2592) return 1536 + (n0 - 2080);
    if (n0 < 3104) return 2560 + (n0 - 2592);
    return 3072 + (n0 - 3104);
}

__device__ __forceinline__ void p0_prologue(const Frame& F) {
    CArgsP a = kargs(); unsigned char* const ws = a->ws;
    const int gw = F.vcu * NWAVES + F.wave, NGW = F.G * NWAVES;
    const int gtid = F.vcu * NT + F.tid, GT = F.G * NT;
    {
        LAS float* scr = (LAS float*)(F.lds + F.wave * 16384);
        constexpr int I_IN = 16 * 161, I_P = 8 * 32, I_O = 16 * 32, PER_L = I_IN + 2 * I_P + I_O;
        for (int it = gw; it < DEPTH * PER_L; it += NGW) {
            const int l = it / PER_L; int r = it % PER_L;
            if (r < I_IN) { const int kb = r / 161, nb = r % 161; p0_transpose_item(a->in[I_WIN] + (size_t)l * D * IN_COLS, D, IN_COLS, (bf16*)(ws + WS_WIN) + (size_t)l * NPAD * D, win_map(nb * 32), scr, kb * 64, nb * 32, F.lane); continue; }
            r -= I_IN;
            if (r < I_P) { const int kb = r / 32, nb = r % 32; p0_transpose_item(a->in[I_WPG] + (size_t)l * 512 * D, D, D, (bf16*)(ws + WS_WPG) + (size_t)l * D * D, nb * 32, scr, kb * 64, nb * 32, F.lane); continue; }
            r -= I_P;
            if (r < I_P) { const int kb = r / 32, nb = r % 32; p0_transpose_item(a->in[I_WPN] + (size_t)l * 512 * D, D, D, (bf16*)(ws + WS_WPG) + (size_t)l * D * D + 512, nb * 32, scr, kb * 64, nb * 32, F.lane); continue; }
            r -= I_P;
            { const int kb = r / 32, nb = r % 32; p0_transpose_item(a->in[I_WO] + (size_t)l * D * D, D, D, (bf16*)(ws + WS_WO) + (size_t)l * D * D, nb * 32, scr, kb * 64, nb * 32, F.lane); }
        }
        constexpr int PADV = (NPAD - IN_COLS) * D / 8;
        for (int i = gtid; i < DEPTH * PADV; i += GT) { const int l = i / PADV, j = i % PADV; *((v4u*)((bf16*)(ws + WS_WIN) + ((size_t)l * NPAD + IN_COLS) * D) + j) = (v4u){0u, 0u, 0u, 0u}; }
    }
    __syncthreads();
    if (gtid < 128 * 16) { const int pos = gtid >> 4, j = gtid & 15; const float freq = powf(10000.f, -(float)j / 16.f); const float ang = (float)pos * freq;
        float* cs = (float*)(ws + WS_ROPE); cs[2 * gtid] = cosf(ang); cs[2 * gtid + 1] = sinf(ang); }
    {
        LAS float* LSK = (LAS float*)F.lds;
        LAS float* LQ = (LAS float*)(F.lds + 128 * 132 * 4);
        for (int unit = F.vcu; unit < DEPTH * 16 * 16; unit += F.G) {
            const int l = unit >> 8, hp = (unit >> 4) & 15, d0 = (unit & 15) * 64;
            const float* sk = a->in[I_SK] + ((size_t)l * 16 + hp) * 16384;
            const float* wq = a->in[I_WQ] + (size_t)l * D * 2048 + hp * 128;
            __syncthreads();
            for (int i = F.tid; i < 16384; i += NT) LSK[(i >> 7) * 132 + (i & 127)] = sk[i];
            for (int i = F.tid; i < 8192; i += NT) LQ[(i >> 7) * 132 + (i & 127)] = wq[(size_t)(d0 + (i >> 7)) * 2048 + (i & 127)];
            __syncthreads();
            const int dd = F.tid & 63, kg = F.tid >> 6;
            float acc[16];
#pragma unroll
            for (int k = 0; k < 16; ++k) acc[k] = 0.f;
            for (int j = 0; j < 128; j += 4) {
                const f32x4 q = *(const LAS f32x4*)(LQ + dd * 132 + j);
#pragma unroll
                for (int k = 0; k < 16; ++k) { const f32x4 s = *(const LAS f32x4*)(LSK + (kg * 16 + k) * 132 + j); acc[k] += q[0] * s[0] + q[1] * s[1] + q[2] * s[2] + q[3] * s[3]; }
            }
            bf16* o = (bf16*)(ws + WS_WS) + ((size_t)l * 2048 + hp * 128 + kg * 16) * D + d0 + dd;
#pragma unroll
            for (int k = 0; k < 16; ++k) o[(size_t)k * D] = (bf16)f2bf(acc[k]);
        }
    }
    __syncthreads();
    {
        LAS float* ca = (LAS float*)F.lds;
        LAS float* red = (LAS float*)(F.lds + 9 * D * 4);
        for (int i = F.tid; i < 9 * D; i += NT) { const float v = i < 8 * D ? a->in[I_C][i] : a->in[I_CCTX][i - 8 * D]; ca[i] = v / (1.f + __expf(-v)); }
        __syncthreads();
        float* MOD = (float*)(ws + WS_MOD);
        for (int unit = F.vcu; unit < DEPTH * 96; unit += F.G) {
            const int l = unit / 96, cb = unit % 96, dc = F.tid >> 6;
            const int col = cb * 64 + (F.tid & 63);
            const float* w = a->in[I_WMOD] + ((size_t)l * D + dc * 128) * 6144 + col;
            float acc[9];
#pragma unroll
            for (int b = 0; b < 9; ++b) acc[b] = 0.f;
#pragma unroll 8
            for (int d = 0; d < 128; ++d) { const float wv = w[(size_t)d * 6144];
#pragma unroll
                for (int b = 0; b < 9; ++b) acc[b] += ca[b * D + dc * 128 + d] * wv; }
#pragma unroll
            for (int b = 0; b < 9; ++b) red[(dc * 9 + b) * 64 + (F.tid & 63)] = acc[b];
            __syncthreads();
            for (int i = F.tid; i < 9 * 64; i += NT) { const int b = i >> 6, c = i & 63; float sum = a->in[I_BMOD][l * 6144 + cb * 64 + c];
#pragma unroll
                for (int k = 0; k < 8; ++k) sum += red[(k * 9 + b) * 64 + c];
                MOD[((size_t)l * 9 + b) * 6144 + cb * 64 + c] = sum; }
            __syncthreads();
        }
    }
    __syncthreads();
}

__device__ __forceinline__ unsigned pk4_fp8(float a, float b, float c, float d) { int p = __builtin_amdgcn_cvt_pk_fp8_f32(a, b, 0, false); p = __builtin_amdgcn_cvt_pk_fp8_f32(c, d, p, true); return (unsigned)p; }
__device__ __forceinline__ void convert_row_fp8(const float* src, unsigned char* dst_tab, float* scale_out, int e, int lane) {
    const f32x4* sp = (const f32x4*)(src + (size_t)e * D) + 4 * lane;
    const f32x4 a0 = sp[0], a1 = sp[1], a2 = sp[2], a3 = sp[3];
    float mx = fmaxf(fmaxf(fmaxf(fabsf(a0[0]), fabsf(a0[1])), fmaxf(fabsf(a0[2]), fabsf(a0[3]))), fmaxf(fmaxf(fabsf(a1[0]), fabsf(a1[1])), fmaxf(fabsf(a1[2]), fabsf(a1[3]))));
    mx = fmaxf(mx, fmaxf(fmaxf(fmaxf(fabsf(a2[0]), fabsf(a2[1])), fmaxf(fabsf(a2[2]), fabsf(a2[3]))), fmaxf(fmaxf(fabsf(a3[0]), fabsf(a3[1])), fmaxf(fabsf(a3[2]), fabsf(a3[3])))));
    mx = fmaxf(wave_max(mx, lane), 1e-30f);
    const float sc = 256.f / mx;
    const v4u w = (v4u){pk4_fp8(a0[0] * sc, a0[1] * sc, a0[2] * sc, a0[3] * sc), pk4_fp8(a1[0] * sc, a1[1] * sc, a1[2] * sc, a1[3] * sc), pk4_fp8(a2[0] * sc, a2[1] * sc, a2[2] * sc, a2[3] * sc), pk4_fp8(a3[0] * sc, a3[1] * sc, a3[2] * sc, a3[3] * sc)};
    *(v4u*)(dst_tab + ((size_t)(lane >> 3) * NEXP + e) * 128 + 16 * (lane & 7)) = w;
    if (lane == 0) scale_out[e] = mx * (1.f / 256.f);
}
__device__ __forceinline__ void convert_experts(const Frame& F, int layer) {
    CArgsP a = kargs(); unsigned char* const ws = a->ws;
    const int gw = F.vcu * NWAVES + F.wave, NGW = F.G * NWAVES;
    const float* su = a->in[I_EU] + (size_t)layer * NEXP * D; const float* sv = a->in[I_EV] + (size_t)layer * NEXP * D;
    for (int e = gw; e < NEXP; e += NGW) { convert_row_fp8(su, ws + WS_EU, (float*)(ws + WS_SU), e, F.lane); convert_row_fp8(sv, ws + WS_EV, (float*)(ws + WS_SV), e, F.lane); }
}

__device__ __forceinline__ void norm_phase(const Frame& F, int layer, int which, int rbeg) {
    CArgsP a = kargs(); unsigned char* const ws = a->ws;
    const int gw = F.vcu * NWAVES + F.wave, NGW = F.G * NWAVES;
    const float* g = (which ? a->in[I_GN2] : a->in[I_GN1]) + layer * D;
    const float* MOD = (const float*)(ws + WS_MOD) + (size_t)layer * 9 * 6144 + (which ? 3072 : 0);
    bf16* H = (bf16*)(ws + WS_H);
    f32x4 gv[4];
#pragma unroll
    for (int j = 0; j < 4; ++j) gv[j] = *((const f32x4*)g + F.lane + 64 * j);
    for (int r = rbeg + gw; r < R; r += NGW) {
        const float* sh = MOD + row_slot(r) * 6144; const float* sc = sh + D;
        f32x4 v[4]; float ss = 0.f;
        if ((which == 0 && layer == 0) || r < NCTX) {
            const float* xr = (which == 0 && layer == 0) ? xrow_in(a, r) : xc_row(a, r);
#pragma unroll
            for (int j = 0; j < 4; ++j) v[j] = *((const GAS f32x4*)xr + F.lane + 64 * j);
        } else {
            const v2u* xb = (const v2u*)xl_row(a, r) + F.lane;
#pragma unroll
            for (int j = 0; j < 4; ++j) { const v2u w = xb[64 * j]; v[j] = (f32x4){bflo(w.x), bfhi(w.x), bflo(w.y), bfhi(w.y)}; }
        }
#pragma unroll
        for (int j = 0; j < 4; ++j) ss += (v[j][0] * v[j][0] + v[j][1] * v[j][1]) + (v[j][2] * v[j][2] + v[j][3] * v[j][3]);
        const float rs = rsqrtf(wave_sum(ss, F.lane) * (1.f / D) + EPS);
        unsigned long long* o8 = (unsigned long long*)(H + (size_t)r * D) + F.lane;
        float mx = 0.f;
#pragma unroll
        for (int j = 0; j < 4; ++j) {
            const f32x4 s1 = *((const f32x4*)sc + F.lane + 64 * j), s0 = *((const f32x4*)sh + F.lane + 64 * j);
            const f32x4 y = v[j] * rs * gv[j] * (s1 + 1.f) + s0;
            o8[64 * j] = (unsigned long long)pk2(y[0], y[1]) | ((unsigned long long)pk2(y[2], y[3]) << 32);
            v[j] = y; mx = fmaxf(mx, fmaxf(fmaxf(fabsf(y[0]), fabsf(y[1])), fmaxf(fabsf(y[2]), fabsf(y[3]))));
        }
        if (which) {
            mx = fmaxf(wave_max(mx, F.lane), 1e-30f); const float q8 = 256.f / mx;
            unsigned* h8 = (unsigned*)(ws + WS_H8 + (size_t)r * D) + F.lane;
#pragma unroll
            for (int j = 0; j < 4; ++j) h8[64 * j] = pk4_fp8(v[j][0] * q8, v[j][1] * q8, v[j][2] * q8, v[j][3] * q8);
            if (F.lane == 0) ((float*)(ws + WS_SX))[r] = mx * (1.f / 256.f);
        }
    }
}

constexpr int GL_TOT = 0, GL_IMG = 4096, GL_PITCH = 144, GL_IMGB = 64 * GL_PITCH, GL_SSX = GL_IMG + 4 * GL_IMGB;
typedef short bf16x8_t __attribute__((ext_vector_type(8)));
__device__ __forceinline__ int chunk_row0(int b, int tc) { return tc < 4 ? b * CTXL + tc * 64 : NCTX + b * SEQ + (tc - 4) * 64; }
__device__ __forceinline__ int chunk_pos(int tc, int dir) { return dir == 0 ? tc : (tc < 4 ? 3 - tc : 135 - tc); }
__device__ __forceinline__ float logsig16(float x) { return (fminf(x, 0.f) - 0.69314718f * __builtin_amdgcn_logf(1.f + __builtin_amdgcn_exp2f(-1.44269504f * fabsf(x)))) * (1.f / 16.f); }
constexpr int GL_HALF = 40960;
__device__ __forceinline__ void gla_scan(LAS unsigned char* hl, int w4, int lane, CArgsP a, const float* Z, int layer, int h, int row0, int lz, float (&Bf)[16], float (&Bb)[16], float& endf, float& endb) {
    const float* waf = a->in[I_WAF] + layer * 4096 + h * 64 + lane; const float* wab = a->in[I_WAB] + layer * 4096 + h * 64 + lane;
    float wf[16], wb[16];
#pragma unroll
    for (int j = 0; j < 16; ++j) { wf[j] = waf[j * 256]; wb[j] = wab[j * 256]; }
    const float baf = a->in[I_BAF][layer * 256 + h * 64 + lane], bab = a->in[I_BAB][layer * 256 + h * 64 + lane];
    const int t0 = 16 * w4;
#pragma unroll
    for (int i = 0; i < 16; ++i) {
        const f32x4* zp = (const f32x4*)(Z + (size_t)(row0 + t0 + i) * 32 + lz);
        float zf = baf, zb = bab;
#pragma unroll
        for (int q = 0; q < 4; ++q) { const f32x4 z0 = zp[q], z1 = zp[4 + q];
            zf += z0[0] * wf[4 * q] + z0[1] * wf[4 * q + 1] + z0[2] * wf[4 * q + 2] + z0[3] * wf[4 * q + 3];
            zb += z1[0] * wb[4 * q] + z1[1] * wb[4 * q + 1] + z1[2] * wb[4 * q + 2] + z1[3] * wb[4 * q + 3]; }
        Bf[i] = logsig16(zf); Bb[i] = logsig16(zb);
    }
#pragma unroll
    for (int i = 1; i < 16; ++i) Bf[i] += Bf[i - 1];
#pragma unroll
    for (int i = 14; i >= 0; --i) Bb[i] += Bb[i + 1];
    LAS float* TOT = (LAS float*)(hl + GL_TOT);
    TOT[(0 * 4 + w4) * 64 + lane] = Bf[15]; TOT[(1 * 4 + w4) * 64 + lane] = Bb[0];
    __syncthreads();
    float offf = 0.f, offb = 0.f; endf = 0.f; endb = 0.f;
#pragma unroll
    for (int w = 0; w < 4; ++w) { const float tf = TOT[(0 * 4 + w) * 64 + lane], tb = TOT[(1 * 4 + w) * 64 + lane]; endf += tf; endb += tb; offf += (w < w4) ? tf : 0.f; offb += (w > w4) ? tb : 0.f; }
#pragma unroll
    for (int i = 0; i < 16; ++i) { Bf[i] += offf; Bb[i] += offb; }
}
constexpr int GLA_UNITS = BATCH * 4 * NCHUNK;
__device__ __forceinline__ void gla_a_phase(const Frame& F, int layer) {
    CArgsP a = kargs(); unsigned char* const ws = a->ws;
    const bf16* PA = (const bf16*)(ws + WS_PA); const bf16* VT = (const bf16*)(ws + WS_VT);
    const float* Z = (const float*)(ws + WS_Z); bf16* SST = (bf16*)(ws + WS_H); float* DEC = (float*)(ws + WS_DEC);
    int lz = 0; asm volatile("" : "+v"(lz));
    const int lane = F.lane, l16 = lane & 15, g = lane >> 4, hw = F.wave >> 2, w4 = F.wave & 3, t0 = 16 * w4;
    LAS unsigned char* hl = F.lds + hw * GL_HALF;
    for (int up = F.vcu; up < GLA_UNITS / 2; up += F.G) {
        const int unit = 2 * up + hw;
        const int b = unit / (4 * NCHUNK), h = (unit / NCHUNK) & 3, tc = unit % NCHUNK, row0 = chunk_row0(b, tc);
        float Bf[16], Bb[16], endf, endb;
        gla_scan(hl, w4, lane, a, Z, layer, h, row0, lz, Bf, Bb, endf, endb);
        float kf[16], kb[16];
#pragma unroll
        for (int i = 0; i < 16; ++i) { const float kk = bf1(PA[(size_t)(row0 + t0 + i) * PA_LD + PA_K + h * 64 + lane]); kf[i] = kk * __expf(endf - Bf[i]); kb[i] = kk * __expf(endb - Bb[i]); }
#pragma unroll
        for (int q = 0; q < 2; ++q) {
            *(LAS v4u*)(hl + GL_IMG + 0 * GL_IMGB + lane * GL_PITCH + (t0 + 8 * q) * 2) = (v4u){pk2(kf[8 * q], kf[8 * q + 1]), pk2(kf[8 * q + 2], kf[8 * q + 3]), pk2(kf[8 * q + 4], kf[8 * q + 5]), pk2(kf[8 * q + 6], kf[8 * q + 7])};
            *(LAS v4u*)(hl + GL_IMG + 1 * GL_IMGB + lane * GL_PITCH + (t0 + 8 * q) * 2) = (v4u){pk2(kb[8 * q], kb[8 * q + 1]), pk2(kb[8 * q + 2], kb[8 * q + 3]), pk2(kb[8 * q + 4], kb[8 * q + 5]), pk2(kb[8 * q + 6], kb[8 * q + 7])};
        }
        const int seq0 = (b * 4 + h) * 2;
        if (w4 == 0) { DEC[((size_t)(seq0 + 0) * NCHUNK + chunk_pos(tc, 0)) * 64 + lane] = __expf(endf); DEC[((size_t)(seq0 + 1) * NCHUNK + chunk_pos(tc, 1)) * 64 + lane] = __expf(endb); }
        __syncthreads();
        const int dir = w4 >> 1, nth = w4 & 1;
        const LAS unsigned char* img = hl + GL_IMG + dir * GL_IMGB;
        bf16x8_t afr[4][2];
#pragma unroll
        for (int mt = 0; mt < 4; ++mt)
#pragma unroll
            for (int kt = 0; kt < 2; ++kt) afr[mt][kt] = *(const LAS bf16x8_t*)(img + (16 * mt + l16) * GL_PITCH + (32 * kt + 8 * g) * 2);
        bf16* slot = SST + ((size_t)(seq0 + dir) * NCHUNK + chunk_pos(tc, dir)) * 8192;
#pragma unroll
        for (int n4 = 0; n4 < 4; ++n4) {
            const int nt = 4 * nth + n4;
            const bf16* vp = VT + (size_t)(h * 128 + 16 * nt + l16) * R + row0 + 8 * g;
            const bf16x8_t b0 = *(const bf16x8_t*)vp, b1 = *(const bf16x8_t*)(vp + 32);
#pragma unroll
            for (int mt = 0; mt < 4; ++mt) {
                f32x4 acc = (f32x4){0.f, 0.f, 0.f, 0.f};
                acc = __builtin_amdgcn_mfma_f32_16x16x32_bf16(afr[mt][0], b0, acc, 0, 0, 0);
                acc = __builtin_amdgcn_mfma_f32_16x16x32_bf16(afr[mt][1], b1, acc, 0, 0, 0);
                *(v2u*)(slot + (16 * nt + l16) * 64 + 16 * mt + 4 * g) = (v2u){pk2(acc[0], acc[1]), pk2(acc[2], acc[3])};
            }
        }
        __syncthreads();
    }
}
__device__ __forceinline__ void gla_b_phase(const Frame& F, bool dry) {
    CArgsP a = kargs(); unsigned char* const ws = a->ws; const bool wr = !dry || a->pad == 12345;
    bf16* SST = (bf16*)(ws + WS_H); const float* DEC = (const float*)(ws + WS_DEC);
    const int gtid = F.vcu * NT + F.tid, GT = F.G * NT;
    for (int id = gtid; id < 64 * 2048; id += GT) {
        const int seq = id >> 11, e = (id & 2047) * 4, k4 = e & 63;
        float s0 = 0.f, s1 = 0.f, s2 = 0.f, s3 = 0.f;
        bf16* p = SST + (size_t)seq * NCHUNK * 8192 + e; const float* dp = DEC + (size_t)seq * NCHUNK * 64 + k4;
#pragma unroll 4
        for (int c = 0; c < NCHUNK; ++c) {
            const v2u t = *(const v2u*)(p + (size_t)c * 8192); const f32x4 d = *(const f32x4*)(dp + c * 64);
            if (wr) *(v2u*)(p + (size_t)c * 8192) = (v2u){pk2(s0, s1), pk2(s2, s3)};
            s0 = d[0] * s0 + bflo(t.x); s1 = d[1] * s1 + bfhi(t.x); s2 = d[2] * s2 + bflo(t.y); s3 = d[3] * s3 + bfhi(t.y);
        }
    }
}
__device__ __forceinline__ void gla_c_phase(const Frame& F, int layer, bool dry) {
    CArgsP a = kargs(); unsigned char* const ws = a->ws; const bool wr = !dry || a->pad == 12345;
    bf16* PA = (bf16*)(ws + WS_PA); const bf16* VT = (const bf16*)(ws + WS_VT);
    const float* Z = (const float*)(ws + WS_Z); const bf16* SST = (const bf16*)(ws + WS_H);
    int lz = 0; asm volatile("" : "+v"(lz));
    const int lane = F.lane, l16 = lane & 15, g = lane >> 4, hw = F.wave >> 2, w4 = F.wave & 3, t0 = 16 * w4;
    LAS unsigned char* hl = F.lds + hw * GL_HALF;
    for (int up = F.vcu; up < GLA_UNITS / 2; up += F.G) {
        const int unit = 2 * up + hw;
        const int b = unit / (4 * NCHUNK), h = (unit / NCHUNK) & 3, tc = unit % NCHUNK, row0 = chunk_row0(b, tc);
        {
            float Bf[16], Bb[16], endf, endb;
            gla_scan(hl, w4, lane, a, Z, layer, h, row0, lz, Bf, Bb, endf, endb);
#pragma unroll
            for (int i = 0; i < 16; ++i) {
                const bf16* pr = PA + (size_t)(row0 + t0 + i) * PA_LD + h * 64 + lane;
                const float qq = bf1(pr[PA_Q]), kk = bf1(pr[PA_K]);
                const float ef = __expf(Bf[i]), eb = __expf(Bb[i]);
                LAS bf16* ip = (LAS bf16*)(hl + GL_IMG + (t0 + i) * GL_PITCH) + lane;
                ip[0] = (bf16)f2bf(qq * ef); ip[GL_IMGB / 2] = (bf16)f2bf(kk * __builtin_amdgcn_rcpf(ef)); ip[GL_IMGB] = (bf16)f2bf(qq * eb); ip[3 * GL_IMGB / 2] = (bf16)f2bf(kk * __builtin_amdgcn_rcpf(eb));
            }
        }
        __syncthreads();
        f32x4 O[8];
#pragma unroll
        for (int mt = 0; mt < 8; ++mt) O[mt] = (f32x4){0.f, 0.f, 0.f, 0.f};
        const int tq = 16 * w4 + l16;
#pragma unroll
        for (int dir = 0; dir < 2; ++dir) {
            const LAS unsigned char* Qimg = hl + GL_IMG + (2 * dir) * GL_IMGB; const LAS unsigned char* Kimg = Qimg + GL_IMGB;
            bf16x8_t qf[2];
#pragma unroll
            for (int kt = 0; kt < 2; ++kt) qf[kt] = *(const LAS bf16x8_t*)(Qimg + tq * GL_PITCH + (32 * kt + 8 * g) * 2);
            f32x4 P[4];
#pragma unroll
            for (int mt = 0; mt < 4; ++mt) {
                P[mt] = (f32x4){0.f, 0.f, 0.f, 0.f};
#pragma unroll
                for (int kt = 0; kt < 2; ++kt) { const bf16x8_t kf = *(const LAS bf16x8_t*)(Kimg + (16 * mt + l16) * GL_PITCH + (32 * kt + 8 * g) * 2); P[mt] = __builtin_amdgcn_mfma_f32_16x16x32_bf16(kf, qf[kt], P[mt], 0, 0, 0); }
#pragma unroll
                for (int rg = 0; rg < 4; ++rg) { const int tp = 16 * mt + 4 * g + rg; const bool valid = dir == 0 ? (tp <= tq) : (tp >= tq); P[mt][rg] = valid ? P[mt][rg] : 0.f; }
            }
            bf16x8_t pa[2];
#pragma unroll
            for (int k2 = 0; k2 < 2; ++k2) { const v4u w = (v4u){pk2(P[2 * k2][0], P[2 * k2][1]), pk2(P[2 * k2][2], P[2 * k2][3]), pk2(P[2 * k2 + 1][0], P[2 * k2 + 1][1]), pk2(P[2 * k2 + 1][2], P[2 * k2 + 1][3])}; pa[k2] = __builtin_bit_cast(bf16x8_t, w); }
            const bf16* slot = SST + ((size_t)((b * 4 + h) * 2 + dir) * NCHUNK + chunk_pos(tc, dir)) * 8192;
#pragma unroll
            for (int mt = 0; mt < 8; ++mt) {
                const int v = 16 * mt + l16;
                const bf16* vp = VT + (size_t)(h * 128 + v) * R + row0 + 4 * g;
#pragma unroll
                for (int k2 = 0; k2 < 2; ++k2) { const v2u lo = *(const v2u*)(vp + 32 * k2), hi = *(const v2u*)(vp + 32 * k2 + 16); const v4u w = (v4u){lo.x, lo.y, hi.x, hi.y};
                    O[mt] = __builtin_amdgcn_mfma_f32_16x16x32_bf16(__builtin_bit_cast(bf16x8_t, w), pa[k2], O[mt], 0, 0, 0); }
#pragma unroll
                for (int kt = 0; kt < 2; ++kt) { const bf16x8_t sf = *(const bf16x8_t*)(slot + v * 64 + 32 * kt + 8 * g); O[mt] = __builtin_amdgcn_mfma_f32_16x16x32_bf16(sf, qf[kt], O[mt], 0, 0, 0); }
            }
        }
        float ss = 0.f;
#pragma unroll
        for (int mt = 0; mt < 8; ++mt) ss += (O[mt][0] * O[mt][0] + O[mt][1] * O[mt][1]) + (O[mt][2] * O[mt][2] + O[mt][3] * O[mt][3]);
        ss += shx(ss, 16, lane); ss += shx(ss, 32, lane);
        const float rs = rsqrtf(ss * (1.f / 128.f) + EPS);
        bf16* rp0 = PA + (size_t)(row0 + tq) * PA_LD + PA_R + h * 128 + 4 * g;
        const float* gp = a->in[I_GGLA] + layer * 128 + 4 * g;
#pragma unroll
        for (int mt = 0; mt < 8; ++mt) {
            const f32x4 gg = *(const f32x4*)(gp + 16 * mt); const v2u rr = *(const v2u*)(rp0 + 16 * mt);
            const float r0 = bflo(rr.x), r1 = bfhi(rr.x), r2 = bflo(rr.y), r3 = bfhi(rr.y);
            const float y0 = O[mt][0] * rs * gg[0] * (r0 * sigmoidf_(r0)), y1 = O[mt][1] * rs * gg[1] * (r1 * sigmoidf_(r1));
            const float y2 = O[mt][2] * rs * gg[2] * (r2 * sigmoidf_(r2)), y3 = O[mt][3] * rs * gg[3] * (r3 * sigmoidf_(r3));
            if (wr) *(v2u*)(rp0 + 16 * mt) = (v2u){pk2(y0, y1), pk2(y2, y3)};
        }
        __syncthreads();
    }
}

__device__ __forceinline__ void na_unit4(bf16* PA, const bf16* NVT, const float* rpb_l, LAS float* lb, int b, int hd, bool lat, int qr0, int nt, int lane, bool wr) {
    const int l16 = lane & 15, g = lane >> 4;
    const int latbase = NCTX + b * SEQ, ctxbase = b * CTXL;
    bf16* qp[4]; bf16x8_t qf[4][2];
#pragma unroll
    for (int j = 0; j < 4; ++j) {
        const int row = lat ? latbase + (qr0 + j) * 64 + 16 * nt + l16 : ctxbase + 64 * nt + 16 * j + l16;
        qp[j] = PA + (size_t)row * PA_LD + PA_NQ + hd * 64;
        qf[j][0] = *(const bf16x8_t*)(qp[j] + 8 * g); qf[j][1] = *(const bf16x8_t*)(qp[j] + 32 + 8 * g);
    }
    const int qc = 16 * nt + l16, c0 = min(max(qc - 8, 0), 48), R0 = min(max(qr0 - 4, 0), 120);
    if (lat) {
#pragma unroll
        for (int i = 0; i < 8; ++i) { const int idx = lane + 64 * i; if (idx < 465) lb[idx] = rpb_l[hd * 465 + idx]; }
        LDS_WAIT();
    }
    const bf16* kbase = PA + PA_NK + hd * 64 + 8 * g;
    const bf16* vbase = NVT + (size_t)(hd * 64 + l16) * R + 4 * g;
    float mx[4] = {-3.0e38f, -3.0e38f, -3.0e38f, -3.0e38f};
    const int nrows = lat ? ((qr0 == 0 || qr0 == 124) ? 8 : 11) : 0, cs = (nt == 0) ? 0 : (nt == 1 ? 8 : (nt == 2 ? 24 : 32));
    const int nwin = nrows, nslot = nwin + 8;
#define NA_SLOT(si, jmask, krow, pr, base0, win) do { const int s_ = min((si), nslot - 1); win = s_ < nwin; pr = 0; \
        if (win) { krow = R0 + s_; jmask = 0u; \
            _Pragma("unroll") for (int j_ = 0; j_ < 4; ++j_) { const int r0j = min(max(qr0 + j_ - 4, 0), 120); if (krow >= r0j && krow < r0j + 8) jmask |= 1u << j_; } \
            base0 = latbase + krow * 64 + cs; } else { jmask = 15u; krow = 0; base0 = ctxbase + (s_ - nwin) * 32; } } while (0)
#define NA_LDK(dst, base0) do { _Pragma("unroll") for (int t_ = 0; t_ < 2; ++t_) { const bf16* kp_ = kbase + (size_t)((base0) + 16 * t_ + l16) * PA_LD; dst[t_][0] = *(const bf16x8_t*)kp_; dst[t_][1] = *(const bf16x8_t*)(kp_ + 32); } } while (0)
#define NA_LDV(dst, base0) do { _Pragma("unroll") for (int mt_ = 0; mt_ < 4; ++mt_) { const bf16* vp_ = vbase + (size_t)(16 * mt_) * R + (base0); const v2u lo_ = *(const v2u*)vp_, hi_ = *(const v2u*)(vp_ + 16); dst[mt_] = __builtin_bit_cast(bf16x8_t, (v4u){lo_.x, lo_.y, hi_.x, hi_.y}); } } while (0)
#pragma unroll 1
    for (int s0 = 0; s0 < nslot; s0 += 4) {
        bf16x8_t kc[4][2][2]; unsigned jm[4];
#pragma unroll
        for (int q = 0; q < 4; ++q) { int krow, pr, base0; bool win; NA_SLOT(s0 + q, jm[q], krow, pr, base0, win); if (s0 + q >= nslot) jm[q] = 0u; NA_LDK(kc[q], base0); }
#pragma unroll
        for (int q = 0; q < 4; ++q)
#pragma unroll
            for (int t = 0; t < 2; ++t)
#pragma unroll
                for (int j = 0; j < 4; ++j) {
                    f32x4 S = (f32x4){0.f, 0.f, 0.f, 0.f};
                    S = __builtin_amdgcn_mfma_f32_16x16x32_bf16(kc[q][t][0], qf[j][0], S, 0, 0, 0);
                    S = __builtin_amdgcn_mfma_f32_16x16x32_bf16(kc[q][t][1], qf[j][1], S, 0, 0, 0);
                    mx[j] = fmaxf(mx[j], fmaxf(fmaxf(S[0], S[1]), fmaxf(S[2], S[3])));
                }
    }
#pragma unroll
    for (int j = 0; j < 4; ++j) { mx[j] = fmaxf(mx[j], shx(mx[j], 16, lane)); mx[j] = fmaxf(mx[j], shx(mx[j], 32, lane)); }
    float ls[4] = {0.f, 0.f, 0.f, 0.f};
    f32x4 O[4][4];
#pragma unroll
    for (int j = 0; j < 4; ++j)
#pragma unroll
        for (int mt = 0; mt < 4; ++mt) O[j][mt] = (f32x4){0.f, 0.f, 0.f, 0.f};
#pragma unroll 1
    for (int s0 = 0; s0 < nslot; s0 += 2) {
        bf16x8_t kf[2][2][2], vf[2][4]; unsigned jm[2]; int krw[2], prr[2]; bool wn[2];
#pragma unroll
        for (int q = 0; q < 2; ++q) { int base0; NA_SLOT(s0 + q, jm[q], krw[q], prr[q], base0, wn[q]); if (s0 + q >= nslot) jm[q] = 0u; NA_LDK(kf[q], base0); NA_LDV(vf[q], base0); }
#pragma unroll
        for (int q = 0; q < 2; ++q) {
            const bool win = wn[q]; const int pr = prr[q], krow = krw[q];
            bool cv[2][4]; int co[2][4];
#pragma unroll
            for (int t = 0; t < 2; ++t)
#pragma unroll
                for (int rg = 0; rg < 4; ++rg) { const int kcol = cs + 16 * t + 4 * g + rg; cv[t][rg] = !win || ((kcol >= c0) && (kcol <= c0 + 15)); co[t][rg] = min(max(kcol - qc + 15, 0), 30); }
#pragma unroll
            for (int j = 0; j < 4; ++j) {
                const bool rv = (jm[q] >> j) & 1u;
                f32x4 S[2];
#pragma unroll
                for (int t = 0; t < 2; ++t) { S[t] = (f32x4){0.f, 0.f, 0.f, 0.f};
                    S[t] = __builtin_amdgcn_mfma_f32_16x16x32_bf16(kf[q][t][0], qf[j][0], S[t], 0, 0, 0);
                    S[t] = __builtin_amdgcn_mfma_f32_16x16x32_bf16(kf[q][t][1], qf[j][1], S[t], 0, 0, 0); }
                const LAS float* bp = lb + (win ? min(max(krow - (qr0 + j) + 7, 0), 14) * 31 : 0);
                float psum = 0.f;
#pragma unroll
                for (int t = 0; t < 2; ++t)
#pragma unroll
                    for (int rg = 0; rg < 4; ++rg) { const float bias = win ? bp[co[t][rg]] : 0.f; const float p = (cv[t][rg] && rv) ? __expf(S[t][rg] + bias - mx[j]) : 0.f; S[t][rg] = p; psum += p; }
                ls[j] += psum;
                const bf16x8_t pa = __builtin_bit_cast(bf16x8_t, (v4u){pk2(S[0][0], S[0][1]), pk2(S[0][2], S[0][3]), pk2(S[1][0], S[1][1]), pk2(S[1][2], S[1][3])});
#pragma unroll
                for (int mt = 0; mt < 4; ++mt) O[j][mt] = __builtin_amdgcn_mfma_f32_16x16x32_bf16(vf[q][mt], pa, O[j][mt], 0, 0, 0);
            }
        }
    }
#undef NA_SLOT
#undef NA_LDK
#undef NA_LDV
#pragma unroll
    for (int j = 0; j < 4; ++j) {
        float l = ls[j]; l += shx(l, 16, lane); l += shx(l, 32, lane);
        const float inv = 1.f / l;
#pragma unroll
        for (int mt = 0; mt < 4; ++mt) if (wr) *(v2u*)(qp[j] + 16 * mt + 4 * g) = (v2u){pk2(O[j][mt][0] * inv, O[j][mt][1] * inv), pk2(O[j][mt][2] * inv, O[j][mt][3] * inv)};
    }
}
__device__ __forceinline__ void na_phase(const Frame& F, int layer, bool dry, bool skip_ctx) {
    CArgsP a = kargs(); unsigned char* const ws = a->ws; const bool wr = !dry || a->pad == 12345;
    bf16* PA = (bf16*)(ws + WS_PA); const bf16* NVT = (const bf16*)(ws + WS_NVT);
    const float* rpb_l = a->in[I_RPB] + (size_t)layer * 8 * 465;
    const int gw = F.vcu * NWAVES + F.wave, NGW = F.G * NWAVES;
    LAS float* lb = (LAS float*)(F.lds + F.wave * 2048);
    for (int u = gw; u < BATCH * 8 * 32 * 4 + (skip_ctx ? 0 : BATCH * 8 * 4); u += NGW) {
        if (u < BATCH * 8 * 32 * 4) { const int nt = u & 3, qg = (u >> 2) & 31, hd = (u >> 7) & 7, b = u >> 10; na_unit4(PA, NVT, rpb_l, lb, b, hd, true, 4 * qg, nt, F.lane, wr); }
        else { const int v = u - BATCH * 8 * 32 * 4; const int nt = v & 3, hd = (v >> 2) & 7, b = v >> 5; na_unit4(PA, NVT, rpb_l, lb, b, hd, false, 0, nt, F.lane, wr); }
    }
}

__device__ __forceinline__ float pack_key(float v, int idx) { unsigned t = __builtin_bit_cast(unsigned, v) & ~127u; asm("" : "+v"(t)); return __builtin_bit_cast(float, t | (unsigned)idx); }
__device__ __forceinline__ void topk_phase(const Frame& F, int rbeg) {
    CArgsP a = kargs(); unsigned char* const ws = a->ws;
    const int gtid = F.vcu * NT + F.tid, GT = F.G * NT;
    const bf16* SC = (const bf16*)(ws + WS_SC);
    int* EI = (int*)(ws + WS_EI); float* EG = (float*)(ws + WS_EG);
    LAS unsigned* myl = (LAS unsigned*)F.lds + F.tid * 9;
    for (int id = rbeg * 8 + gtid; id < R * 8; id += GT) {
        const int r = id >> 3, hd = id & 7;
        const v4u* sp = (const v4u*)(SC + (size_t)r * 2048 + hd * 256);
        float t0[16], t1[16];
#pragma unroll
        for (int blk = 0; blk < 8; ++blk) {
            float n0[16], n1[16];
#pragma unroll
            for (int q = 0; q < 2; ++q) { const v4u va = sp[blk * 2 + q], vb = sp[16 + blk * 2 + q];
                const unsigned wa[4] = {va.x, va.y, va.z, va.w}, wb[4] = {vb.x, vb.y, vb.z, vb.w};
#pragma unroll
                for (int e = 0; e < 4; ++e) { const int i0 = blk * 16 + 8 * q + 2 * e;
                    n0[8 * q + 2 * e] = pack_key(bflo(wa[e]), i0); n0[8 * q + 2 * e + 1] = pack_key(bfhi(wa[e]), i0 + 1);
                    n1[8 * q + 2 * e] = pack_key(bflo(wb[e]), i0); n1[8 * q + 2 * e + 1] = pack_key(bfhi(wb[e]), i0 + 1); } }
#pragma unroll
            for (int k = 2; k <= 16; k <<= 1)
#pragma unroll
                for (int j = k >> 1; j > 0; j >>= 1)
#pragma unroll
                    for (int i = 0; i < 16; ++i) { const int l = i ^ j; if (l > i) { const bool desc = (i & k) == 0;
                        const float a0 = n0[i], b0 = n0[l], a1 = n1[i], b1 = n1[l];
                        n0[i] = desc ? fmaxf(a0, b0) : fminf(a0, b0); n0[l] = desc ? fminf(a0, b0) : fmaxf(a0, b0);
                        n1[i] = desc ? fmaxf(a1, b1) : fminf(a1, b1); n1[l] = desc ? fminf(a1, b1) : fmaxf(a1, b1); } }
            if (blk == 0) {
#pragma unroll
                for (int i = 0; i < 16; ++i) { t0[i] = n0[i]; t1[i] = n1[i]; }
            } else {
#pragma unroll
                for (int i = 0; i < 16; ++i) { t0[i] = fmaxf(t0[i], n0[15 - i]); t1[i] = fmaxf(t1[i], n1[15 - i]); }
#pragma unroll
                for (int j = 8; j > 0; j >>= 1)
#pragma unroll
                    for (int i = 0; i < 16; ++i) { const int l = i ^ j; if (l > i) { const float a0 = t0[i], b0 = t0[l], a1 = t1[i], b1 = t1[l];
                        t0[i] = fmaxf(a0, b0); t0[l] = fminf(a0, b0); t1[i] = fmaxf(a1, b1); t1[l] = fminf(a1, b1); } }
            }
        }
        float best[16];
#pragma unroll
        for (int j = 0; j < 16; ++j) best[j] = -3.0e38f;
#pragma unroll
        for (int ia = 0; ia < 16; ++ia)
#pragma unroll
            for (int ib = 0; ib < 16; ++ib)
                if ((ia + 1) * (ib + 1) <= 16) {
                    float x = __builtin_bit_cast(float, (__builtin_bit_cast(unsigned, t0[ia] + t1[ib]) & ~255u) | (unsigned)(ia * 16 + ib));
#pragma unroll
                    for (int j = 0; j < 16; ++j) { const float tb = fmaxf(best[j], x); x = fminf(best[j], x); best[j] = tb; }
                }
        {
            unsigned w0[4], w1[4];
#pragma unroll
            for (int q = 0; q < 4; ++q) {
                w0[q] = (__builtin_bit_cast(unsigned, t0[4 * q]) & 127u) | ((__builtin_bit_cast(unsigned, t0[4 * q + 1]) & 127u) << 8) | ((__builtin_bit_cast(unsigned, t0[4 * q + 2]) & 127u) << 16) | ((__builtin_bit_cast(unsigned, t0[4 * q + 3]) & 127u) << 24);
                w1[q] = (__builtin_bit_cast(unsigned, t1[4 * q]) & 127u) | ((__builtin_bit_cast(unsigned, t1[4 * q + 1]) & 127u) << 8) | ((__builtin_bit_cast(unsigned, t1[4 * q + 2]) & 127u) << 16) | ((__builtin_bit_cast(unsigned, t1[4 * q + 3]) & 127u) << 24);
            }
#pragma unroll
            for (int q = 0; q < 4; ++q) { myl[q] = w0[q]; myl[4 + q] = w1[q]; }
            LDS_WAIT();
        }
        int eid[16];
#pragma unroll
        for (int j = 0; j < 16; ++j) { const unsigned code = __builtin_bit_cast(unsigned, best[j]) & 255u; const LAS unsigned char* mb = (const LAS unsigned char*)myl;
            eid[j] = (int)mb[code >> 4] * 128 + (int)mb[16 + (code & 15u)]; }
        LDS_WAIT();
        float sum = 0.f; const float bmax = best[0];
#pragma unroll
        for (int j = 0; j < 16; ++j) { best[j] = __expf(best[j] - bmax); sum += best[j]; }
        const float inv = 1.f / sum;
        v4i* ei = (v4i*)(EI + (size_t)r * 128 + hd * 16); f32x4* eg = (f32x4*)(EG + (size_t)r * 128 + hd * 16);
#pragma unroll
        for (int j = 0; j < 4; ++j) { ei[j] = (v4i){eid[4 * j], eid[4 * j + 1], eid[4 * j + 2], eid[4 * j + 3]}; eg[j] = (f32x4){best[4 * j] * inv, best[4 * j + 1] * inv, best[4 * j + 2] * inv, best[4 * j + 3] * inv}; }
    }
}

__device__ __forceinline__ float gelu_tanh(float x) { const float u = 0.7978845608f * (x + 0.044715f * x * x * x); return x * __builtin_amdgcn_rcpf(1.f + __expf(-2.f * u)); }
typedef float f32x2_t __attribute__((ext_vector_type(2)));
__device__ __forceinline__ void peer1_phase(const Frame& F, int rbeg) {
    CArgsP a = kargs(); unsigned char* const ws = a->ws;
    const unsigned char* EU8 = ws + WS_EU; const unsigned char* H8 = ws + WS_H8;
    const int* EI = (const int*)(ws + WS_EI); bf16* PART = (bf16*)(ws + WS_PART);
    const int per = F.G >> 3, s = F.vcu / per, rank = F.vcu % per, stride = per * NWAVES;
    const int lane = F.lane, m = lane & 15, g = lane >> 4, row8 = lane >> 3, part = lane & 7;
    const unsigned char* tab = EU8 + (size_t)s * NEXP * 128 + 16 * part;
    LAS unsigned char* wl = F.lds + F.wave * 4608;
    const int wofs = row8 * 144 + part * 16, rofs = m * 144 + 16 * g;
    int r = rbeg + rank * NWAVES + F.wave;
    int id[2][16];
#pragma unroll
    for (int u = 0; u < 2; ++u)
#pragma unroll
        for (int j = 0; j < 16; ++j) id[u][j] = EI[(size_t)min(r + u * stride, R - 1) * 128 + 8 * j + row8];
    for (; r < R; r += 2 * stride) {
        v4u w[2][16]; v4u x[2][2];
#pragma unroll
        for (int u = 0; u < 2; ++u) {
            const int ru = min(r + u * stride, R - 1);
            const unsigned char* xp = H8 + (size_t)ru * D + 128 * s + 16 * g;
            x[u][0] = *(const v4u*)xp; x[u][1] = *(const v4u*)(xp + 64);
#pragma unroll
            for (int j = 0; j < 16; ++j) w[u][j] = *(const v4u*)(tab + (size_t)id[u][j] * 128);
        }
        const int rn = r + 2 * stride;
#pragma unroll
        for (int u = 0; u < 2; ++u)
#pragma unroll
            for (int j = 0; j < 16; ++j) id[u][j] = EI[(size_t)min(rn + u * stride, R - 1) * 128 + 8 * j + row8];
#pragma unroll
        for (int u = 0; u < 2; ++u) {
            f32x4 sel = (f32x4){0.f, 0.f, 0.f, 0.f};
#pragma unroll
            for (int T = 0; T < 8; ++T) {
                LAS unsigned char* buf = wl + (T & 1) * 2304;
                *(LAS v4u*)(buf + wofs) = w[u][2 * T]; *(LAS v4u*)(buf + 8 * 144 + wofs) = w[u][2 * T + 1];
                const v4u a0 = *(const LAS v4u*)(buf + rofs), a1 = *(const LAS v4u*)(buf + rofs + 64);
                f32x4 acc = (f32x4){0.f, 0.f, 0.f, 0.f};
                acc = __builtin_amdgcn_mfma_f32_16x16x32_fp8_fp8((long)(((unsigned long long)a0.y << 32) | a0.x), (long)(((unsigned long long)x[u][0].y << 32) | x[u][0].x), acc, 0, 0, 0);
                acc = __builtin_amdgcn_mfma_f32_16x16x32_fp8_fp8((long)(((unsigned long long)a0.w << 32) | a0.z), (long)(((unsigned long long)x[u][0].w << 32) | x[u][0].z), acc, 0, 0, 0);
                acc = __builtin_amdgcn_mfma_f32_16x16x32_fp8_fp8((long)(((unsigned long long)a1.y << 32) | a1.x), (long)(((unsigned long long)x[u][1].y << 32) | x[u][1].x), acc, 0, 0, 0);
                acc = __builtin_amdgcn_mfma_f32_16x16x32_fp8_fp8((long)(((unsigned long long)a1.w << 32) | a1.z), (long)(((unsigned long long)x[u][1].w << 32) | x[u][1].z), acc, 0, 0, 0);
                sel = (m == T) ? acc : sel;
            }
            const int ru = r + u * stride;
            if (m < 8 && ru < R) *(v2u*)(PART + ((size_t)s * R + ru) * 128 + 16 * m + 4 * g) = (v2u){pk2(sel[0], sel[1]), pk2(sel[2], sel[3])};
        }
    }
}
__device__ __forceinline__ void peer_act_phase(const Frame& F, int rbeg) {
    CArgsP a = kargs(); unsigned char* const ws = a->ws;
    const int gtid = F.vcu * NT + F.tid, GT = F.G * NT;
    const bf16* PART = (const bf16*)(ws + WS_PART); const int* EI = (const int*)(ws + WS_EI); const float* EG = (const float*)(ws + WS_EG);
    const float* SU = (const float*)(ws + WS_SU); const float* SV = (const float*)(ws + WS_SV); const float* SX = (const float*)(ws + WS_SX);
    float* ACT = (float*)(ws + WS_ACT);
    for (int i = rbeg * 32 + gtid; i < R * 32; i += GT) {
        const int r = i >> 5;
        f32x4 sum = (f32x4){0.f, 0.f, 0.f, 0.f};
#pragma unroll
        for (int q = 0; q < 8; ++q) { const v2u w = *(const v2u*)(PART + (size_t)q * R * 128 + (size_t)i * 4); sum += (f32x4){bflo(w.x), bfhi(w.x), bflo(w.y), bfhi(w.y)}; }
        const v4i id = *(const v4i*)(EI + (size_t)i * 4); const f32x4 gt = *(const f32x4*)(EG + (size_t)i * 4);
        const float sx = SX[r];
        f32x4 o;
#pragma unroll
        for (int k = 0; k < 4; ++k) o[k] = gelu_tanh(sum[k] * sx * SU[id[k]]) * gt[k] * SV[id[k]];
        *(f32x4*)(ACT + (size_t)i * 4) = o;
    }
}
__device__ __forceinline__ void peer2_phase(const Frame& F, int layer, bool dry, int rbeg) {
    CArgsP a = kargs(); unsigned char* const ws = a->ws; const bool wr = !dry || a->pad == 12345;
    const unsigned char* EV8 = ws + WS_EV; const int* EI = (const int*)(ws + WS_EI); const float* ACT = (const float*)(ws + WS_ACT);
    const float* MOD = (const float*)(ws + WS_MOD) + (size_t)layer * 9 * 6144 + 5 * D;
    const int per = F.G >> 3, s = F.vcu / per, rank = F.vcu % per, stride = per * NWAVES;
    const int lane = F.lane, part = lane & 7, e8 = lane >> 3;
    const unsigned char* tab = EV8 + (size_t)s * NEXP * 128 + 16 * part;
    const bool b5 = (lane & 32) != 0, b4 = (lane & 16) != 0, b3 = (lane & 8) != 0;
    const int dimoff = 128 * s + 16 * part + (b5 ? 8 : 0) + (b4 ? 4 : 0) + (b3 ? 2 : 0);
    int r = rbeg + rank * NWAVES + F.wave;
    v4i id4[2][4];
#pragma unroll
    for (int u = 0; u < 2; ++u)
#pragma unroll
        for (int q = 0; q < 4; ++q) id4[u][q] = *(const v4i*)(EI + (size_t)min(r + u * stride, R - 1) * 128 + 16 * e8 + 4 * q);
    for (; r < R; r += 2 * stride) {
        v4u w[2][16]; f32x4 a4[2][4];
#pragma unroll
        for (int u = 0; u < 2; ++u) {
            const int ru = min(r + u * stride, R - 1);
#pragma unroll
            for (int j = 0; j < 16; ++j) w[u][j] = *(const v4u*)(tab + (size_t)id4[u][j >> 2][j & 3] * 128);
#pragma unroll
            for (int q = 0; q < 4; ++q) a4[u][q] = *(const f32x4*)(ACT + (size_t)ru * 128 + 16 * e8 + 4 * q);
        }
        const int rn = r + 2 * stride;
#pragma unroll
        for (int u = 0; u < 2; ++u)
#pragma unroll
            for (int q = 0; q < 4; ++q) id4[u][q] = *(const v4i*)(EI + (size_t)min(rn + u * stride, R - 1) * 128 + 16 * e8 + 4 * q);
#pragma unroll
        for (int u = 0; u < 2; ++u) {
            f32x2_t o[8];
#pragma unroll
            for (int k = 0; k < 8; ++k) o[k] = (f32x2_t){0.f, 0.f};
#pragma unroll
            for (int j = 0; j < 16; ++j) {
                const v4u ww = w[u][j];
                const float av = a4[u][j >> 2][j & 3]; const f32x2_t av2 = (f32x2_t){av, av};
                o[0] += av2 * __builtin_amdgcn_cvt_pk_f32_fp8((int)ww.x, false); o[1] += av2 * __builtin_amdgcn_cvt_pk_f32_fp8((int)ww.x, true);
                o[2] += av2 * __builtin_amdgcn_cvt_pk_f32_fp8((int)ww.y, false); o[3] += av2 * __builtin_amdgcn_cvt_pk_f32_fp8((int)ww.y, true);
                o[4] += av2 * __builtin_amdgcn_cvt_pk_f32_fp8((int)ww.z, false); o[5] += av2 * __builtin_amdgcn_cvt_pk_f32_fp8((int)ww.z, true);
                o[6] += av2 * __builtin_amdgcn_cvt_pk_f32_fp8((int)ww.w, false); o[7] += av2 * __builtin_amdgcn_cvt_pk_f32_fp8((int)ww.w, true);
            }
            f32x2_t v4[4], v2[2], v1;
#pragma unroll
            for (int k = 0; k < 4; ++k) { const f32x2_t snd = b5 ? o[k] : o[k + 4], kp = b5 ? o[k + 4] : o[k]; f32x2_t rc; rc.x = shx(snd.x, 32, lane); rc.y = shx(snd.y, 32, lane); v4[k] = kp + rc; }
#pragma unroll
            for (int k = 0; k < 2; ++k) { const f32x2_t snd = b4 ? v4[k] : v4[k + 2], kp = b4 ? v4[k + 2] : v4[k]; f32x2_t rc; rc.x = shx(snd.x, 16, lane); rc.y = shx(snd.y, 16, lane); v2[k] = kp + rc; }
            { const f32x2_t snd = b3 ? v2[0] : v2[1], kp = b3 ? v2[1] : v2[0]; f32x2_t rc; rc.x = shx(snd.x, 8, lane); rc.y = shx(snd.y, 8, lane); v1 = kp + rc; }
            const int ru = r + u * stride;
            if (ru < R) {
                const f32x2_t ga = *(const f32x2_t*)(MOD + row_slot(ru) * 6144 + dimoff);
                if (ru < NCTX) { float* xq = xc_row(a, ru) + dimoff; const f32x2_t xx = *(const f32x2_t*)xq; if (wr) *(f32x2_t*)xq = xx + ga * v1; }
                else { unsigned* xq = (unsigned*)(xl_row(a, ru) + dimoff); const unsigned w = *xq; const f32x2_t y = (f32x2_t){bflo(w), bfhi(w)} + ga * v1; if (wr) *xq = pk2(y.x, y.y); }
            }
        }
    }
}

__device__ __forceinline__ void final_phase(const Frame& F) {
    CArgsP a = kargs(); unsigned char* const ws = a->ws;
    const int gw = F.vcu * NWAVES + F.wave, NGW = F.G * NWAVES;
    f32x4 gv[4];
#pragma unroll
    for (int j = 0; j < 4; ++j) gv[j] = *((const f32x4*)a->in[I_GF] + F.lane + 64 * j);
    for (int r = gw; r < NLAT; r += NGW) {
        const v2u* xb = (const v2u*)((const bf16*)a->out + (size_t)r * XL_LD) + F.lane;
        f32x4* xr = (f32x4*)(a->out + (size_t)r * D) + F.lane;
        f32x4 v[4]; float ss = 0.f;
#pragma unroll
        for (int j = 0; j < 4; ++j) { const v2u w = xb[64 * j]; v[j] = (f32x4){bflo(w.x), bfhi(w.x), bflo(w.y), bfhi(w.y)}; ss += (v[j][0] * v[j][0] + v[j][1] * v[j][1]) + (v[j][2] * v[j][2] + v[j][3] * v[j][3]); }
        const float rs = rsqrtf(wave_sum(ss, F.lane) * (1.f / D) + EPS);
        asm volatile("s_waitcnt vmcnt(0)" ::: "memory");
#pragma unroll
        for (int j = 0; j < 4; ++j) xr[64 * j] = v[j] * rs * gv[j];
    }
}

__global__ void __launch_bounds__(NT, 2) fwd_kernel(Args args) {
    extern __shared__ __attribute__((aligned(16))) unsigned char lds[];
    Frame F;
    F.lds = (LAS unsigned char*)lds;
    F.tid = 0; F.lane = 0; F.wave = __builtin_amdgcn_readfirstlane((int)threadIdx.x >> 6);
    F.G = gridDim.x; { const int bx = blockIdx.x; F.vcu = (F.G % 8 == 0) ? (bx % 8) * (F.G / 8) + bx / 8 : bx; }
    volatile LAS unsigned* MISC = (volatile LAS unsigned*)(F.lds + MISC_OFF);
    for (int u = threadIdx.x; u < (LDS_BYTES - LDSCTL_OFF) / 4; u += NT) ((LAS unsigned*)(F.lds + LDSCTL_OFF))[u] = 0u;
    __syncthreads();
    XcdBarrier bar; bar.bar = (unsigned*)(args.ws + WS_CTL) + CW_BAR; bar.x = 0; bar.st = nullptr;
    if (MK_SINGLE) bar = xcd_barrier_post((unsigned*)(args.ws + WS_CTL) + CW_BAR, MISC + 8);
    const int lo = args.ph_lo, hi = args.ph_hi;
#define IN(k) (lo <= (k) && (k) < hi)
#define OPQ_BX ({ int bx_ = (int)blockIdx.x; asm volatile("" : "+s"(bx_)); bx_; })
#define PF Frame Fp = F; { int t_ = threadIdx.x; asm volatile("" : "+v"(t_), "+s"(Fp.vcu), "+s"(Fp.wave), "+s"(Fp.G)); Fp.tid = t_; Fp.lane = t_ & 63; }
#define SEAM(k) do { if (MK_SINGLE && IN(k) && IN((k) + 1)) { XcdBarrier b2_ = bar; asm volatile("" : "+s"(b2_.bar));     \
        xcd_barrier(b2_); if (PROBE == 50) xcd_barrier(b2_); } } while (0)

    if (IN(0)) { if (PROBE == 99) { PF; p0_prologue(Fp); } { PF; p0_prologue(Fp); } SEAM(0); }

    for (int l = 0; l < DEPTH; ++l) {
        const int pb = 1 + l * NPL;
        const int pm0 = (l == DEPTH - 1) ? 8 : 0, rbeg = pm0 * 256;
        if (IN(pb + 0)) { { PF; norm_phase(Fp, l, 0, 0); } { PF; convert_experts(Fp, l); } if (PROBE == 30) { PF; convert_experts(Fp, l); } SEAM(pb + 0); }
        if (IN(pb + 1)) {
            CArgsP ap = kargs(); unsigned char* const ws = ap->ws; bf16* Hb = (bf16*)(ws + WS_H); bf16* PA = (bf16*)(ws + WS_PA); bf16* PG = (bf16*)(ws + WS_PG);
            pg8::Gemm g{Hb, (const bf16*)(ws + WS_WIN) + (size_t)l * NPAD * D, R, NPAD, D, D}; pg8::StaticOrder S; S.init(R, NPAD, F.G, OPQ_BX);
            EpiIn E{PA, PG, (float*)(ws + WS_Z), (const float*)(ws + WS_ROPE), (bf16*)(ws + WS_VT), (bf16*)(ws + WS_NVT)};
            for (int rep = 0; rep < (PROBE == 1 ? 2 : 1); ++rep) pg8::gemm_phase<EpiIn, pg8::StaticOrder, true, true>(F.lds, g, S, E);
            SEAM(pb + 1);
        }
        if (IN(pb + 2)) { { PF; gla_a_phase(Fp, l); } if (PROBE == 2) { PF; gla_a_phase(Fp, l); } { const int nrep = (PROBE == 20 ? 2 : 1) + (kargs()->pad != 0 ? 1 : 0); for (int rep = 0; rep < nrep; ++rep) { PF; na_phase(Fp, l, rep + 1 < nrep, l == DEPTH - 1); } } SEAM(pb + 2); }
        if (IN(pb + 3)) { if (PROBE == 3) { PF; gla_b_phase(Fp, true); } { PF; gla_b_phase(Fp, false); } SEAM(pb + 3); }
        if (IN(pb + 4)) { if (PROBE == 4) { PF; gla_c_phase(Fp, l, true); } { PF; gla_c_phase(Fp, l, false); } SEAM(pb + 4); }
        if (IN(pb + 5)) {
            CArgsP ap = kargs(); unsigned char* const ws = ap->ws; bf16* Hb = (bf16*)(ws + WS_H); bf16* PA = (bf16*)(ws + WS_PA); bf16* PG = (bf16*)(ws + WS_PG);
            pg8::ShiftOrder S; S.init(R - rbeg, D, F.G, OPQ_BX); S.pm0 = pm0;
            { pg8::Gemm g{PA + PA_R, (const bf16*)(ws + WS_WPG) + (size_t)l * D * D, R, D, D, PA_LD}; EpiMergeK E{Hb, PG}; for (int rep = 0; rep < (PROBE == 5 ? 2 : 1); ++rep) pg8::gemm_phase<EpiMergeK, pg8::ShiftOrder, true, true>(F.lds, g, S, E); }
            SEAM(pb + 5);
        }
        if (IN(pb + 6)) {
            CArgsP ap = kargs(); unsigned char* const ws = ap->ws; bf16* Hb = (bf16*)(ws + WS_H);
            pg8::Gemm g{Hb, (const bf16*)(ws + WS_WO) + (size_t)l * D * D, R, D, D, D}; pg8::ShiftOrder S; S.init(R - rbeg, D, F.G, OPQ_BX); S.pm0 = pm0;
            EpiRes E{l == 0 ? ap->in[I_CTX] : (const float*)(ws + WS_XC), ap->in[I_X], (float*)(ws + WS_XC), (bf16*)ap->out, (const float*)(ws + WS_MOD) + (size_t)l * 9 * 6144, l == 0 ? 1 : 0};
            pg8::gemm_phase<EpiRes, pg8::ShiftOrder, true, true>(F.lds, g, S, E);
            SEAM(pb + 6);
        }
        if (IN(pb + 7)) { if (PROBE == 7) { PF; norm_phase(Fp, l, 1, rbeg); } { PF; norm_phase(Fp, l, 1, rbeg); } SEAM(pb + 7); }
        if (IN(pb + 8)) {
            CArgsP ap = kargs(); unsigned char* const ws = ap->ws; bf16* Hb = (bf16*)(ws + WS_H);
            pg8::Gemm g{Hb, (const bf16*)(ws + WS_WS) + (size_t)l * 2048 * D, R, 2048, D, D}; pg8::ShiftOrder S; S.init(R - rbeg, 2048, F.G, OPQ_BX); S.pm0 = pm0;
            EpiB16 E{(bf16*)(ws + WS_SC), 2048};
            for (int rep = 0; rep < (PROBE == 8 ? 2 : 1); ++rep) pg8::gemm_phase<EpiB16, pg8::ShiftOrder, true, true>(F.lds, g, S, E);
            SEAM(pb + 8);
        }
        if (IN(pb + 9)) { if (PROBE == 9) { PF; topk_phase(Fp, rbeg); } { PF; topk_phase(Fp, rbeg); } SEAM(pb + 9); }
        if (IN(pb + 10)) { if (PROBE == 10) { PF; peer1_phase(Fp, rbeg); } { PF; peer1_phase(Fp, rbeg); } SEAM(pb + 10); }
        if (IN(pb + 11)) { if (PROBE == 11) { PF; peer_act_phase(Fp, rbeg); } { PF; peer_act_phase(Fp, rbeg); } SEAM(pb + 11); }
        if (IN(pb + 12)) { if (PROBE == 12) { PF; peer2_phase(Fp, l, true, rbeg); } { PF; peer2_phase(Fp, l, false, rbeg); } SEAM(pb + 12); }
    }
    if (IN(NPHASE - 1)) { PF; final_phase(Fp); }
#undef IN
#undef SEAM
}

extern "C" void kernel_launch(void* const* d_in, const int* in_sizes, int n_in, void* d_out, int out_size, void* d_ws, size_t ws_size, hipStream_t stream) {
    static int grid = 0;
    if (grid == 0) {
        if (n_in != 23 || in_sizes[0] != NLAT * D || out_size != NLAT * D || ws_size < WS_END) { fprintf(stderr, "kernel_launch: unexpected shapes (n_in %d, in0 %d, out %d, ws %zu); nothing launched\n", n_in, n_in > 0 ? in_sizes[0] : -1, out_size, ws_size); grid = -1; return; }
        int dev = 0, cus = 0, per_cu = 0;
        if (hipGetDevice(&dev) != hipSuccess || hipDeviceGetAttribute(&cus, hipDeviceAttributeMultiprocessorCount, dev) != hipSuccess) { grid = -1; return; }
        if (hipFuncSetAttribute((const void*)fwd_kernel, hipFuncAttributeMaxDynamicSharedMemorySize, LDS_BYTES) != hipSuccess) { fprintf(stderr, "kernel_launch: hipFuncSetAttribute failed\n"); grid = -1; return; }
        if (hipOccupancyMaxActiveBlocksPerMultiprocessor(&per_cu, (const void*)fwd_kernel, NT, LDS_BYTES) != hipSuccess || per_cu < 1) { fprintf(stderr, "kernel_launch: occupancy query says %d blocks per CU\n", per_cu); }
        (void)hipGetLastError();
        grid = cus;
    }
    if (grid < 0) return;
    if (hipMemsetAsync((char*)d_ws + WS_CTL, 0, CTL_ZERO_BYTES, stream) != hipSuccess) return;
    Args a{};
    for (int i = 0; i < 23; ++i) a.in[i] = (const float*)d_in[i];
    a.out = (float*)d_out; a.ws = (unsigned char*)d_ws; a.pad = 0;
    if (MK_SINGLE) {
        a.ph_lo = 0; a.ph_hi = NPHASE; a.li = 0;
        hipLaunchKernelGGL(fwd_kernel, dim3(grid), dim3(NT), LDS_BYTES, stream, a);
    } else {
        for (int p = 0; p < NPHASE; ++p) { a.ph_lo = p; a.ph_hi = p + 1; a.li = p; hipLaunchKernelGGL(fwd_kernel, dim3(grid), dim3(NT), LDS_BYTES, stream, a); }
    }
}
```

```cpp
#include <hip/hip_runtime.h>
#include <cstdio>
#include <cstdint>

#ifndef PROBE
#define PROBE 0
#endif
#ifndef MK_SINGLE
#define MK_SINGLE 1
#endif

namespace pg8 {
#define PG8_LAS __attribute__((address_space(3)))
typedef unsigned short bf16_t;
typedef short bf16x8 __attribute__((ext_vector_type(8)));
typedef float f32x4 __attribute__((ext_vector_type(4)));
typedef unsigned u32x4 __attribute__((ext_vector_type(4)));
constexpr int BM = 256, BK = 64, HALF = 128, HTB = HALF * BK * 2, STAGE_BYTES = 8 * HTB, NXCD = 8, WGM = 8;

__host__ __device__ __forceinline__ int lds_byte(int r, int c) { const int st = (r >> 4) * 2 + (c >> 5), rr = r & 15, cc = c & 31, ob = rr * 64 + cc * 2; return st * 1024 + (ob ^ (((ob >> 9) & 1) << 5)); }
__host__ __device__ __forceinline__ void stage_rc(int b, int& R, int& C) { const int st = b / 1024, sb = b % 1024, swz = sb ^ (((sb >> 9) & 1) << 5); R = (st >> 1) * 16 + swz / 64; C = (st & 1) * 32 + (swz % 64) / 2; }
__host__ __device__ __forceinline__ int perm32(int rho) { const int n = rho >> 4, i = rho & 15; return 8 * (i >> 2) + 4 * n + (i & 3); }

struct Unit { int pm, pn; };
struct Gemm { const bf16_t* A; const bf16_t* Bt; int M, N, K, lda; };

struct StaticOrder {
    int nM, nN, nwg, G, c;
    __host__ __device__ void init(int M, int N, int G_, int c_) { nM = M / BM; nN = N / BM; nwg = nM * nN; G = G_; c = c_; }
    __host__ __device__ bool next(int i, Unit& u) const {
        const long L = (long)i * G + c; if (L >= nwg) return false;
        int wgid = (int)L; { const int q = nwg / NXCD, r = nwg % NXCD, xcd = wgid % NXCD, off = wgid / NXCD; wgid = (xcd < r ? xcd * (q + 1) : r * (q + 1) + (xcd - r) * q) + off; }
        const int nig = WGM * nN, gid = wgid / nig, fm = gid * WGM, gsz = (nM - fm) < WGM ? (nM - fm) : WGM;
        u.pm = fm + ((wgid % nig) % gsz); u.pn = (wgid % nig) / gsz; return true;
    }
    __device__ __forceinline__ void a_ready(const Unit&) const {}
    __device__ __forceinline__ void done(const Unit&) const {}
};
struct ShiftOrder : StaticOrder { int pm0; __host__ __device__ bool next(int i, Unit& u) const { if (!StaticOrder::next(i, u)) return false; u.pm += pm0; return true; } };

__device__ __forceinline__ unsigned cvt_pk_bf16(float lo, float hi) { unsigned r; asm volatile("v_cvt_pk_bf16_f32 %0, %1, %2" : "=v"(r) : "v"(lo), "v"(hi)); return r; }

template <class Epi, class Sched, bool ALIGN_EPI = false, bool SP2 = false>
__device__ __forceinline__ void gemm_phase(PG8_LAS unsigned char* lds, const Gemm g, const Sched& S, const Epi& E) {
    int tid_ = threadIdx.x; asm volatile("" : "+v"(tid_));
    const int tid = tid_, wid = __builtin_amdgcn_readfirstlane(tid >> 6), lane = tid & 63, wr = wid >> 2, wc = wid & 3, fr = lane & 15, fq = lane >> 4;
    const int K = g.K, nt = K / BK, lda = g.lda;
    unsigned voffA[2], voffB[2];
#pragma unroll
    for (int i = 0; i < 2; ++i) { int R, C; stage_rc(tid * 16 + i * 8192, R, C); const int Rb = Epi::PERM ? ((R & ~31) + perm32(R & 31)) : R;
        voffA[i] = (unsigned)(R * lda + C) * 2u; voffB[i] = (unsigned)(Rb * K + C) * 2u; }
    const size_t kstep = (size_t)(BK * 2);
    const size_t hstepA = (size_t)HALF * lda * 2, hstepB = (size_t)HALF * K * 2;
    const size_t tstepA = 2 * hstepA, tstepB = 2 * hstepB;
    const unsigned ldsw = (unsigned)wid * 1024u;
    const int aoff = lds_byte(wr * 64 + fr, fq * 8), boff = lds_byte(wc * 32 + fr, fq * 8);
#define PG8_SA(b, h) (((b) * 2 + (h)) * HTB)
#define PG8_SB(b, h) ((4 + (b) * 2 + (h)) * HTB)
#define PG8_STAGE(bufoff, gbase, voff) do { _Pragma("unroll") for (int _i = 0; _i < 2; ++_i) \
        __builtin_amdgcn_global_load_lds((const unsigned*)((const char*)(gbase) + (voff)[_i]), (PG8_LAS unsigned*)(lds + (bufoff) + ldsw + _i * 8192), 16, 0, 0); } while (0)
#define PG8_LDA(dst, b, h) do { _Pragma("unroll") for (int m = 0; m < 4; ++m) _Pragma("unroll") for (int k = 0; k < 2; ++k) dst[m][k] = *(const PG8_LAS bf16x8*)(lds + PG8_SA(b, h) + aoff + m * 2048 + k * 1024); } while (0)
#define PG8_LDB(dst, b, h) do { _Pragma("unroll") for (int n = 0; n < 2; ++n) _Pragma("unroll") for (int k = 0; k < 2; ++k) dst[n][k] = *(const PG8_LAS bf16x8*)(lds + PG8_SB(b, h) + boff + n * 2048 + k * 1024); } while (0)
#define PG8_MMA(ai, bj, At, Bt) do { __builtin_amdgcn_s_setprio(1); _Pragma("unroll") for (int m = 0; m < 4; ++m) _Pragma("unroll") for (int n = 0; n < 2; ++n) _Pragma("unroll") for (int k = 0; k < 2; ++k) \
        acc[ai][bj][m][n] = __builtin_amdgcn_mfma_f32_16x16x32_bf16(Bt[n][k], At[m][k], acc[ai][bj][m][n], 0, 0, 0); __builtin_amdgcn_s_setprio(0); } while (0)
#define PG8_WAIT_V(n) asm volatile("s_waitcnt vmcnt(" #n ")" ::: "memory")
#define PG8_WAIT_L(n) asm volatile("s_waitcnt lgkmcnt(" #n ")" ::: "memory")
#define PG8_BAR __builtin_amdgcn_s_barrier()
#define PG8_SCHED __builtin_amdgcn_sched_barrier(0)
    Unit cur, nxt; int ui = 0;
    if (!S.next(0, cur)) return;
    f32x4 acc[2][2][4][2];
#pragma unroll
    for (int a = 0; a < 2; ++a)
#pragma unroll
        for (int b = 0; b < 2; ++b)
#pragma unroll
            for (int m = 0; m < 4; ++m)
#pragma unroll
                for (int n = 0; n < 2; ++n) acc[a][b][m][n] = (f32x4){0.f, 0.f, 0.f, 0.f};
    bf16x8 At[4][2], B0[2][2], B1[2][2];
    const char* cA = (const char*)g.A + (size_t)cur.pm * tstepA; const char* cB = (const char*)g.Bt + (size_t)cur.pn * tstepB;
    S.a_ready(cur);
    if constexpr (SP2) {
        PG8_STAGE(PG8_SB(0, 0), cB, voffB); PG8_STAGE(PG8_SB(0, 1), cB + hstepB, voffB); PG8_STAGE(PG8_SA(0, 0), cA, voffA); PG8_STAGE(PG8_SA(0, 1), cA + hstepA, voffA);
        if (wr == 1) PG8_BAR;
        PG8_WAIT_V(2); PG8_BAR;
        PG8_STAGE(PG8_SB(1, 0), cB + kstep, voffB); PG8_STAGE(PG8_SA(1, 0), cA + kstep, voffA); PG8_STAGE(PG8_SB(1, 1), cB + hstepB + kstep, voffB);
        PG8_WAIT_V(6); PG8_BAR;
    } else {
        PG8_STAGE(PG8_SB(0, 0), cB, voffB); PG8_STAGE(PG8_SA(0, 0), cA, voffA); PG8_STAGE(PG8_SB(0, 1), cB + hstepB, voffB); PG8_STAGE(PG8_SA(0, 1), cA + hstepA, voffA);
        if (wr == 1) PG8_BAR;
        PG8_WAIT_V(4); PG8_BAR;
        PG8_STAGE(PG8_SB(1, 0), cB + kstep, voffB); PG8_STAGE(PG8_SA(1, 0), cA + kstep, voffA); PG8_STAGE(PG8_SB(1, 1), cB + hstepB + kstep, voffB);
        PG8_WAIT_V(6); PG8_BAR;
    }
    for (;;) {
        const bool has_next = S.next(ui + 1, nxt);
        const char* nA = has_next ? (const char*)g.A + (size_t)nxt.pm * tstepA : cA; const char* nB = has_next ? (const char*)g.Bt + (size_t)nxt.pn * tstepB : cB;
        for (int t = 0; t < nt; t += 2) {
            const bool last = (t == nt - 2);
            const char* a1 = cA + (size_t)(t + 1) * kstep;
            const char* a2 = last ? nA : cA + (size_t)(t + 2) * kstep; const char* b2 = last ? nB : cB + (size_t)(t + 2) * kstep;
            const char* a3 = a2 + kstep; const char* b3 = b2 + kstep;
            if (last && has_next) S.a_ready(nxt);
            if constexpr (Epi::HAS_MID) { if (t == nt / 2) E.mid(acc, cur, wr, wc, fr, fq); }
            if constexpr (SP2) {
            PG8_LDB(B0, 0, 0); PG8_LDB(B1, 0, 1); PG8_SCHED; PG8_LDA(At, 0, 0); PG8_STAGE(PG8_SA(1, 1), a1 + hstepA, voffA);
            PG8_WAIT_V(8); PG8_WAIT_L(0); PG8_BAR; PG8_MMA(0, 0, At, B0); PG8_MMA(0, 1, At, B1); PG8_BAR; PG8_SCHED;
            PG8_LDA(At, 0, 1); PG8_STAGE(PG8_SB(0, 0), b2, voffB); PG8_STAGE(PG8_SB(0, 1), b2 + hstepB, voffB); PG8_STAGE(PG8_SA(0, 0), a2, voffA);
            PG8_WAIT_V(8); PG8_WAIT_L(0); PG8_BAR; PG8_MMA(1, 0, At, B0); PG8_MMA(1, 1, At, B1); PG8_BAR; PG8_SCHED;
            PG8_LDB(B0, 1, 0); PG8_LDB(B1, 1, 1); PG8_SCHED; PG8_LDA(At, 1, 0); PG8_STAGE(PG8_SA(0, 1), a2 + hstepA, voffA);
            PG8_WAIT_V(8); PG8_WAIT_L(0); PG8_BAR; PG8_MMA(0, 0, At, B0); PG8_MMA(0, 1, At, B1); PG8_BAR; PG8_SCHED;
            PG8_LDA(At, 1, 1); PG8_STAGE(PG8_SB(1, 0), b3, voffB); PG8_STAGE(PG8_SB(1, 1), b3 + hstepB, voffB); PG8_STAGE(PG8_SA(1, 0), a3, voffA);
            PG8_WAIT_V(8); PG8_WAIT_L(0); PG8_BAR; PG8_MMA(1, 0, At, B0); PG8_MMA(1, 1, At, B1); PG8_BAR; PG8_SCHED;
            } else {
            PG8_LDB(B0, 0, 0); PG8_SCHED; PG8_LDA(At, 0, 0); PG8_STAGE(PG8_SA(1, 1), a1 + hstepA, voffA);
            PG8_WAIT_L(8); PG8_BAR; PG8_WAIT_L(0); PG8_MMA(0, 0, At, B0); PG8_BAR; PG8_SCHED;
            PG8_LDB(B1, 0, 1); PG8_STAGE(PG8_SB(0, 0), b2, voffB);
            PG8_BAR; PG8_WAIT_L(0); PG8_MMA(0, 1, At, B1); PG8_BAR;
            PG8_LDA(At, 0, 1); PG8_STAGE(PG8_SA(0, 0), a2, voffA);
            PG8_BAR; PG8_WAIT_L(0); PG8_MMA(1, 0, At, B0); PG8_BAR; PG8_SCHED;
            PG8_STAGE(PG8_SB(0, 1), b2 + hstepB, voffB);
            PG8_WAIT_V(6); PG8_BAR; PG8_MMA(1, 1, At, B1); PG8_BAR;
            PG8_LDB(B0, 1, 0); PG8_SCHED; PG8_LDA(At, 1, 0); PG8_STAGE(PG8_SA(0, 1), a2 + hstepA, voffA);
            PG8_WAIT_L(8); PG8_BAR; PG8_WAIT_L(0); PG8_MMA(0, 0, At, B0); PG8_BAR; PG8_SCHED;
            PG8_LDB(B1, 1, 1); PG8_STAGE(PG8_SB(1, 0), b3, voffB);
            PG8_BAR; PG8_WAIT_L(0); PG8_MMA(0, 1, At, B1); PG8_BAR;
            PG8_LDA(At, 1, 1); PG8_STAGE(PG8_SA(1, 0), a3, voffA);
            PG8_BAR; PG8_WAIT_L(0); PG8_MMA(1, 0, At, B0); PG8_BAR; PG8_SCHED;
            PG8_STAGE(PG8_SB(1, 1), b3 + hstepB, voffB);
            PG8_WAIT_V(6); PG8_BAR; PG8_MMA(1, 1, At, B1); PG8_BAR;
            }
        }
        if constexpr (ALIGN_EPI) { if (wr == 0) PG8_BAR; }
        E(acc, cur, wr, wc, fr, fq); S.done(cur);
        if (!has_next) break;
#pragma unroll
        for (int a = 0; a < 2; ++a)
#pragma unroll
            for (int b = 0; b < 2; ++b)
#pragma unroll
                for (int m = 0; m < 4; ++m)
#pragma unroll
                    for (int n = 0; n < 2; ++n) acc[a][b][m][n] = (f32x4){0.f, 0.f, 0.f, 0.f};
        cur = nxt; cA = nA; cB = nB; ++ui;
        if constexpr (ALIGN_EPI) { if (wr == 1) PG8_BAR; }
    }
    PG8_WAIT_V(0);
    if constexpr (!ALIGN_EPI) { if (wr == 0) PG8_BAR; }
    PG8_BAR;
#undef PG8_SA
#undef PG8_SB
#undef PG8_STAGE
#undef PG8_LDA
#undef PG8_LDB
#undef PG8_MMA
#undef PG8_WAIT_V
#undef PG8_WAIT_L
#undef PG8_BAR
#undef PG8_SCHED
}
}

constexpr int D = 1024, BATCH = 8, SEQ = 8192, DEPTH = 4, CTXL = 256, GRIDW = 64;
constexpr int NCTX = BATCH * CTXL;
constexpr int NLAT = BATCH * SEQ;
constexpr int R = NCTX + NLAT;
constexpr int IN_COLS = 5152, NPAD = 5376;
constexpr int PA_LD = 2048, PG_LD = 2048;
constexpr int PA_Q = 0, PA_K = 256, PA_R = 512, PA_NQ = 1024, PA_NK = 1536;
constexpr int NCHUNK = 132;
constexpr int NEXP = 16384;
constexpr float EPS = 1e-6f;
constexpr int NWAVES = 8, NT = 512;
constexpr int NPL = 13;
constexpr int NPHASE = 1 + DEPTH * NPL + 1;

constexpr size_t MiB = 1u << 20;
constexpr size_t WS_CTL = 0, CTL_ZERO_BYTES = 2 * MiB;
constexpr size_t WS_MOD = 1 * MiB;
constexpr size_t WS_ROPE = 2 * MiB;
constexpr size_t WS_WIN = 3 * MiB;
constexpr size_t WS_WPG = 45 * MiB, WS_WPN = 49 * MiB;
constexpr size_t WS_WO = 53 * MiB;
constexpr size_t WS_WS = 61 * MiB;
constexpr size_t WS_XC = 77 * MiB;
constexpr size_t WS_Z = 85 * MiB;
constexpr size_t WS_EU = 94 * MiB, WS_EV = 110 * MiB;
constexpr size_t WS_SU = 126 * MiB, WS_SV = WS_SU + 65536, WS_SX = WS_SV + 65536;
constexpr size_t WS_H8 = 884 * MiB;
constexpr size_t WS_PART = 290 * MiB;
constexpr size_t WS_ACT = 554 * MiB;
constexpr size_t WS_H = 158 * MiB;
constexpr size_t WS_PA = 290 * MiB;
constexpr size_t WS_VT = 554 * MiB, WS_NVT = 620 * MiB;
constexpr size_t WS_DEC = 950 * MiB;
constexpr size_t WS_PG = 686 * MiB;
constexpr size_t WS_SC = 290 * MiB;
constexpr size_t WS_EI = 818 * MiB, WS_EG = 851 * MiB;
constexpr size_t WS_END = 953 * MiB;
static_assert(WS_SC + (size_t)R * 2048 * 4 <= WS_EI && WS_EG + (size_t)R * 128 * 4 <= WS_DEC && WS_PG + (size_t)R * PG_LD * 2 <= WS_DEC && WS_DEC + 64 * 132 * 64 * 4 <= WS_END, "ws map");
static_assert(WS_H + (size_t)R * 1024 * 2 <= WS_PA && WS_PA + (size_t)R * PA_LD * 2 <= WS_VT && WS_VT + (size_t)R * 512 * 2 <= WS_NVT && WS_NVT + (size_t)R * 512 * 2 <= WS_PG && WS_Z + (size_t)R * 32 * 4 <= WS_EU, "ws map");
constexpr int CW_BAR = 4096;

constexpr int RING_BYTES = 131072, LDSCTL_OFF = RING_BYTES, MISC_OFF = LDSCTL_OFF + 320, LDS_BYTES = 147456;

#define GAS __attribute__((address_space(1)))
#define LAS __attribute__((address_space(3)))
typedef unsigned short bf16;
typedef unsigned v4u __attribute__((ext_vector_type(4)));
typedef unsigned v2u __attribute__((ext_vector_type(2)));
typedef int v4i __attribute__((ext_vector_type(4)));
typedef float f32x4 __attribute__((ext_vector_type(4)));
typedef __bf16 bf16x2_t __attribute__((ext_vector_type(2)));
#define LDS_WAIT() asm volatile("s_waitcnt lgkmcnt(0)" ::: "memory")
#define VM_WAIT() asm volatile("s_waitcnt vmcnt(0)" ::: "memory")
__device__ __forceinline__ unsigned f2bf(float f) { unsigned u = __builtin_bit_cast(unsigned, f); return (u + 0x7fffu + ((u >> 16) & 1u)) >> 16; }
__device__ __forceinline__ unsigned pk2(float lo, float hi) { return f2bf(lo) | (f2bf(hi) << 16); }
__device__ __forceinline__ float bflo(unsigned w) { return __builtin_bit_cast(float, w << 16); }
__device__ __forceinline__ float bfhi(unsigned w) { return __builtin_bit_cast(float, w & 0xffff0000u); }
__device__ __forceinline__ float bf1(bf16 h) { return __builtin_bit_cast(float, ((unsigned)h) << 16); }
__device__ __forceinline__ float dot2(unsigned a, unsigned b, float acc) { return __builtin_amdgcn_fdot2_f32_bf16(__builtin_bit_cast(bf16x2_t, a), __builtin_bit_cast(bf16x2_t, b), acc, false); }
__device__ __forceinline__ float shx(float v, int mask, int lane) { return __builtin_bit_cast(float, __builtin_amdgcn_ds_bpermute((lane ^ mask) << 2, __builtin_bit_cast(int, v))); }
__device__ __forceinline__ float wave_sum(float v, int lane) {
#pragma unroll
    for (int o = 1; o < 64; o <<= 1) v += shx(v, o, lane);
    return v;
}
__device__ __forceinline__ float wave_max(float v, int lane) {
#pragma unroll
    for (int o = 1; o < 64; o <<= 1) v = fmaxf(v, shx(v, o, lane));
    return v;
}
__device__ __forceinline__ float sigmoidf_(float x) { return __builtin_amdgcn_rcpf(1.f + __expf(-x)); }

#define XB_TMO      128
#define XB_XCNT(j)  (256  + 64 * (j))
#define XB_XSUB(j)  (1280 + 64 * (j))
#define XB_XGEN(j)  (2304 + 64 * (j))
#define XB_TOP      3328
#define XB_TOPGEN   3392
#define XCD_BAR_WORDS 3456
#define XB_SPIN_CAP (1u << 18)
__device__ __forceinline__ unsigned xb_ld(unsigned* p)              { return __hip_atomic_load(p, __ATOMIC_RELAXED, __HIP_MEMORY_SCOPE_AGENT); }
__device__ __forceinline__ unsigned xb_add(unsigned* p, unsigned v) { return __hip_atomic_fetch_add(p, v, __ATOMIC_RELAXED, __HIP_MEMORY_SCOPE_AGENT); }
__device__ __forceinline__ unsigned xb_xcc_id() { return (unsigned)__builtin_amdgcn_s_getreg((3 << 11) | 20) & 0xFu; }
#define XB_SPIN(cond, bar) do { unsigned _sp = 0; while (cond) { __builtin_amdgcn_s_sleep(1); \
    if ((++_sp & 255u) == 0u) { if (xb_ld(&(bar)[XB_TMO])) break; if (_sp > XB_SPIN_CAP) { atomicAdd(&(bar)[XB_TMO], 1u); break; } } } } while (0)
struct XcdBarrier { unsigned* bar; unsigned x; volatile LAS unsigned* st; };
__device__ __forceinline__ XcdBarrier xcd_barrier_post(unsigned* bar, volatile LAS unsigned* st) {
    XcdBarrier b; b.bar = bar; b.x = xb_xcc_id(); b.st = st;
    if (threadIdx.x == 0) (void)xb_add(&bar[XB_XCNT(b.x)], 1u);
    return b;
}
__device__ __forceinline__ void xcd_barrier_complete(unsigned* bar, unsigned x, unsigned& nloc, unsigned& nx) {
    const unsigned G = gridDim.x * gridDim.y * gridDim.z;
    unsigned sum, cnt, mine, sp = 0u;
    for (;;) {
        sum = 0u; cnt = 0u; mine = 0u;
#pragma unroll
        for (unsigned j = 0; j < 16; ++j) { const unsigned c = xb_ld(&bar[XB_XCNT(j)]); sum += c; cnt += (c > 0u) ? 1u : 0u; mine = (j == x) ? c : mine; }
        if (sum == G) break;
        __builtin_amdgcn_s_sleep(1);
        if ((++sp & 255u) == 0u) { if (xb_ld(&bar[XB_TMO])) break; if (sp > XB_SPIN_CAP) { atomicAdd(&bar[XB_TMO], 1u); break; } }
    }
    nloc = mine > 0u ? mine : 1u; nx = cnt > 0u ? cnt : 1u;
}
__device__ __forceinline__ void xcd_barrier(const XcdBarrier& b) {
    asm volatile("s_waitcnt vmcnt(0)" ::: "memory");
    __syncthreads();
    int tid0_ = threadIdx.x; asm volatile("" : "+v"(tid0_));
    if (tid0_ == 0) {
        unsigned* bar = b.bar;
        __builtin_amdgcn_s_waitcnt(0);
        unsigned nloc = b.st[0], nx = b.st[1];
        if (nloc == 0u) { xcd_barrier_complete(bar, b.x, nloc, nx); b.st[0] = nloc; b.st[1] = nx; }
        const unsigned old = xb_add(&bar[XB_XSUB(b.x)], 1u);
        const unsigned gen = old / nloc;
        if (old + 1u == (gen + 1u) * nloc) {
            __builtin_amdgcn_fence(__ATOMIC_RELEASE, "agent");
            asm volatile("s_waitcnt vmcnt(0)" ::: "memory");
            const unsigned og = xb_add(&bar[XB_TOP], 1u);
            const unsigned tg = og / nx;
            if (og + 1u == (tg + 1u) * nx) xb_add(&bar[XB_TOPGEN], 1u);
            else XB_SPIN(xb_ld(&bar[XB_TOPGEN]) == tg, bar);
            __builtin_amdgcn_fence(__ATOMIC_ACQUIRE, "agent");
            xb_add(&bar[XB_XGEN(b.x)], 1u);
            asm volatile("s_waitcnt vmcnt(0)" ::: "memory");
        } else {
            XB_SPIN(xb_ld(&bar[XB_XGEN(b.x)]) == gen, bar);
            __builtin_amdgcn_fence(__ATOMIC_ACQUIRE, "agent");
            asm volatile("s_waitcnt vmcnt(0)" ::: "memory");
        }
    }
    __syncthreads();
}

struct Args { const float* in[23]; float* out; unsigned char* ws; int ph_lo, ph_hi, li, pad; };
enum { I_X = 0, I_C, I_CTX, I_CCTX, I_WMOD, I_BMOD, I_GN1, I_WIN, I_WAF, I_BAF, I_WAB, I_BAB, I_GGLA, I_RPB, I_WPG, I_WPN, I_WO, I_GN2, I_WQ, I_SK, I_EU, I_EV, I_GF };

struct Frame {
    LAS unsigned char* lds;
    int tid, lane, wave, vcu, G;
};
typedef const __attribute__((address_space(4))) Args* CArgsP;
__device__ __forceinline__ CArgsP kargs() { CArgsP p = (CArgsP)__builtin_amdgcn_kernarg_segment_ptr(); asm volatile("" : "+s"(p)); return p; }
__device__ __forceinline__ const float* xrow_in(CArgsP a, int r) { return r < NCTX ? a->in[I_CTX] + (size_t)r * D : a->in[I_X] + (size_t)(r - NCTX) * D; }
constexpr int XL_LD = 2048;
__device__ __forceinline__ float* xc_row(CArgsP a, int r) { return (float*)(a->ws + WS_XC) + (size_t)r * D; }
__device__ __forceinline__ bf16* xl_row(CArgsP a, int r) { return (bf16*)a->out + (size_t)(r - NCTX) * XL_LD; }
__device__ __forceinline__ int row_slot(int r) { return r < NCTX ? 8 : ((r - NCTX) >> 13); }

using pg8::f32x4; using pg8::u32x4; using pg8::Unit; using pg8::cvt_pk_bf16;
struct EpiIn {
    static constexpr bool HAS_MID = false, PERM = true;
    bf16* PA; bf16* PG; float* Z; const float* rope; bf16* VT; bf16* NVT;
    __device__ __forceinline__ void operator()(const f32x4 (&acc)[2][2][4][2], const Unit& u, int wr, int wc, int fr, int fq) const {
        const int pn = u.pn, row0 = u.pm * 256 + wr * 64 + fr;
        if (pn == 20) {
            if (wc == 0) {
#pragma unroll
                for (int ai = 0; ai < 2; ++ai)
#pragma unroll
                    for (int m = 0; m < 4; ++m) { float* zp = Z + (size_t)(row0 + ai * 128 + m * 16) * 32 + 8 * fq; *(f32x4*)zp = acc[ai][0][m][0]; *(f32x4*)(zp + 4) = acc[ai][0][m][1]; }
            }
            return;
        }
        if (pn >= 8 && pn < 12) {
            bf16* T = (pn < 10 ? VT : NVT) + (size_t)(((pn - 8) & 1) * 256 + wc * 32 + 8 * fq) * R;
#pragma unroll
            for (int ai = 0; ai < 2; ++ai)
#pragma unroll
                for (int m = 0; m < 4; ++m) {
                    const int row = row0 + ai * 128 + m * 16;
#pragma unroll
                    for (int bj = 0; bj < 2; ++bj) {
                        const f32x4 v0 = acc[ai][bj][m][0], v1 = acc[ai][bj][m][1];
                        bf16* tp = T + (size_t)(bj * 128) * R + row;
                        tp[0 * (size_t)R] = (bf16)f2bf(v0[0]); tp[1 * (size_t)R] = (bf16)f2bf(v0[1]); tp[2 * (size_t)R] = (bf16)f2bf(v0[2]); tp[3 * (size_t)R] = (bf16)f2bf(v0[3]);
                        tp[4 * (size_t)R] = (bf16)f2bf(v1[0]); tp[5 * (size_t)R] = (bf16)f2bf(v1[1]); tp[6 * (size_t)R] = (bf16)f2bf(v1[2]); tp[7 * (size_t)R] = (bf16)f2bf(v1[3]);
                    }
                }
            return;
        }
        bf16* base; int ldc, colt;
        if (pn < 8) { base = PA; ldc = PA_LD; colt = pn * 256; } else { base = PG; ldc = PG_LD; colt = (pn - 12) * 256; }
        const int col0 = colt + wc * 32 + 8 * fq;
        const bool do_rope = (pn < 2) && (u.pm >= 8);
        const float sc = (pn == 0 || pn == 4 || pn == 5) ? 0.125f : 1.f;
#pragma unroll
        for (int ai = 0; ai < 2; ++ai)
#pragma unroll
            for (int m = 0; m < 4; ++m) {
                const int row = row0 + ai * 128 + m * 16;
                bf16* rowp = base + (size_t)row * ldc + col0;
                f32x4 cs[4];
                if (do_rope) { const int t = (row - NCTX) & (SEQ - 1); const int pos = (wc & 1) ? (t & 63) : (t >> 6);
                    const f32x4* cp = (const f32x4*)(rope + (size_t)(pos * 16 + 8 * (fq & 1)) * 2);
                    cs[0] = cp[0]; cs[1] = cp[1]; cs[2] = cp[2]; cs[3] = cp[3]; }
#pragma unroll
                for (int bj = 0; bj < 2; ++bj) {
                    f32x4 v0 = acc[ai][bj][m][0], v1 = acc[ai][bj][m][1];
                    if (do_rope) {
                        float x[8] = {v0[0], v0[1], v0[2], v0[3], v1[0], v1[1], v1[2], v1[3]};
#pragma unroll
                        for (int e = 0; e < 8; ++e) { const float p = shx(x[e], 32, fr + 16 * fq); const float c = cs[e >> 1][(e & 1) * 2], s = cs[e >> 1][(e & 1) * 2 + 1];
                            x[e] = (fq < 2) ? (x[e] * c - p * s) : (p * s + x[e] * c); }
                        v0 = (f32x4){x[0], x[1], x[2], x[3]}; v1 = (f32x4){x[4], x[5], x[6], x[7]};
                    }
                    v0 = v0 * sc; v1 = v1 * sc;
                    u32x4 w; w.x = cvt_pk_bf16(v0[0], v0[1]); w.y = cvt_pk_bf16(v0[2], v0[3]); w.z = cvt_pk_bf16(v1[0], v1[1]); w.w = cvt_pk_bf16(v1[2], v1[3]);
                    *(u32x4*)(rowp + bj * 128) = w;
                }
                asm volatile("" ::: "memory");
            }
    }
};
struct EpiMergeK {
    static constexpr bool HAS_MID = true, PERM = true;
    bf16* MG; const bf16* PG;
    __device__ __forceinline__ void mid(f32x4 (&acc)[2][2][4][2], const Unit& u, int wr, int wc, int fr, int fq) const {
        int row0 = u.pm * 256 + wr * 64 + fr, col0 = u.pn * 256 + wc * 32 + 8 * fq;
        asm volatile("" : "+v"(row0), "+v"(col0));
#pragma unroll
        for (int ai = 0; ai < 2; ++ai)
#pragma unroll
            for (int m = 0; m < 4; ++m) {
                const bf16* gp = PG + (size_t)(row0 + ai * 128 + m * 16) * PG_LD + col0;
#pragma unroll
                for (int bj = 0; bj < 2; ++bj) {
                    const u32x4 g1 = *(const u32x4*)(gp + bj * 128), g2 = *(const u32x4*)(gp + 1024 + bj * 128);
                    const unsigned a1[4] = {g1.x, g1.y, g1.z, g1.w}, a2[4] = {g2.x, g2.y, g2.z, g2.w};
#pragma unroll
                    for (int q = 0; q < 4; ++q) {
                        const float r0 = (1.f + __expf(-bflo(a2[q]))) * __builtin_amdgcn_rcpf(1.f + __expf(-bflo(a1[q])));
                        const float r1 = (1.f + __expf(-bfhi(a2[q]))) * __builtin_amdgcn_rcpf(1.f + __expf(-bfhi(a1[q])));
                        acc[ai][bj][m][q >> 1][(q & 1) * 2] *= r0; acc[ai][bj][m][q >> 1][(q & 1) * 2 + 1] *= r1;
                    }
                }
                asm volatile("" ::: "memory");
            }
    }
    __device__ __forceinline__ void operator()(const f32x4 (&acc)[2][2][4][2], const Unit& u, int wr, int wc, int fr, int fq) const {
        int row0 = u.pm * 256 + wr * 64 + fr, col0 = u.pn * 256 + wc * 32 + 8 * fq;
        asm volatile("" : "+v"(row0), "+v"(col0));
#pragma unroll
        for (int ai = 0; ai < 2; ++ai)
#pragma unroll
            for (int m = 0; m < 4; ++m) {
                const int row = row0 + ai * 128 + m * 16;
#pragma unroll
                for (int bj = 0; bj < 2; ++bj) {
                    const int c = col0 + bj * 128;
                    const u32x4 g = *(const u32x4*)(PG + (size_t)row * PG_LD + 1024 + c);
                    const f32x4 v0 = acc[ai][bj][m][0], v1 = acc[ai][bj][m][1];
                    u32x4 w; w.x = cvt_pk_bf16(sigmoidf_(bflo(g.x)) * v0[0], sigmoidf_(bfhi(g.x)) * v0[1]); w.y = cvt_pk_bf16(sigmoidf_(bflo(g.y)) * v0[2], sigmoidf_(bfhi(g.y)) * v0[3]);
                    w.z = cvt_pk_bf16(sigmoidf_(bflo(g.z)) * v1[0], sigmoidf_(bfhi(g.z)) * v1[1]); w.w = cvt_pk_bf16(sigmoidf_(bflo(g.w)) * v1[2], sigmoidf_(bfhi(g.w)) * v1[3]);
                    *(u32x4*)(MG + (size_t)row * D + c) = w;
                }
                asm volatile("" ::: "memory");
            }
    }
};
struct EpiRes {
    static constexpr bool HAS_MID = false, PERM = true;
    const float* src_c; const float* src_l; float* dst_c; bf16* dst_l; const float* mod; int first;
    __device__ __forceinline__ void operator()(const f32x4 (&acc)[2][2][4][2], const Unit& u, int wr, int wc, int fr, int fq) const {
        const bool isctx = u.pm < 8;
        const int slot = isctx ? 8 : ((u.pm - 8) >> 5);
        int rbase = (isctx ? u.pm * 256 : (u.pm - 8) * 256) + wr * 64 + fr, col0 = u.pn * 256 + wc * 32 + 8 * fq;
        asm volatile("" : "+v"(rbase), "+v"(col0));
        const float* ga = mod + slot * 6144 + 2048;
        f32x4 gv[2][2];
#pragma unroll
        for (int bj = 0; bj < 2; ++bj)
#pragma unroll
            for (int n = 0; n < 2; ++n) gv[bj][n] = *(const f32x4*)(ga + col0 + bj * 128 + 4 * n);
#pragma unroll
        for (int ai = 0; ai < 2; ++ai)
#pragma unroll
            for (int m = 0; m < 4; ++m) {
                const int row = rbase + ai * 128 + m * 16;
#pragma unroll
                for (int bj = 0; bj < 2; ++bj) {
                    const int c = col0 + bj * 128;
                    f32x4 x0, x1;
                    if (isctx || first) { const float* sp = (isctx ? src_c : src_l) + (size_t)row * D + c; x0 = *(const f32x4*)sp; x1 = *(const f32x4*)(sp + 4); }
                    else { const u32x4 w = *(const u32x4*)(dst_l + (size_t)row * XL_LD + c); x0 = (f32x4){bflo(w.x), bfhi(w.x), bflo(w.y), bfhi(w.y)}; x1 = (f32x4){bflo(w.z), bfhi(w.z), bflo(w.w), bfhi(w.w)}; }
                    x0 = x0 + gv[bj][0] * acc[ai][bj][m][0]; x1 = x1 + gv[bj][1] * acc[ai][bj][m][1];
                    if (isctx) { float* dp = dst_c + (size_t)row * D + c; *(f32x4*)dp = x0; *(f32x4*)(dp + 4) = x1; }
                    else { u32x4 w; w.x = cvt_pk_bf16(x0[0], x0[1]); w.y = cvt_pk_bf16(x0[2], x0[3]); w.z = cvt_pk_bf16(x1[0], x1[1]); w.w = cvt_pk_bf16(x1[2], x1[3]); *(u32x4*)(dst_l + (size_t)row * XL_LD + c) = w; }
                }
                asm volatile("" ::: "memory");
            }
    }
};
struct EpiB16 {
    static constexpr bool HAS_MID = false, PERM = true;
    bf16* C; int ldc;
    __device__ __forceinline__ void operator()(const f32x4 (&acc)[2][2][4][2], const Unit& u, int wr, int wc, int fr, int fq) const {
        const int row0 = u.pm * 256 + wr * 64 + fr, col0 = u.pn * 256 + wc * 32 + 8 * fq;
#pragma unroll
        for (int ai = 0; ai < 2; ++ai)
#pragma unroll
            for (int m = 0; m < 4; ++m) { bf16* rowp = C + (size_t)(row0 + ai * 128 + m * 16) * ldc + col0;
#pragma unroll
                for (int bj = 0; bj < 2; ++bj) { const f32x4 v0 = acc[ai][bj][m][0], v1 = acc[ai][bj][m][1];
                    u32x4 w; w.x = pk2(v0[0], v0[1]); w.y = pk2(v0[2], v0[3]); w.z = pk2(v1[0], v1[1]); w.w = pk2(v1[2], v1[3]);
                    *(u32x4*)(rowp + bj * 128) = w; } }
    }
};
__device__ __forceinline__ void p0_transpose_item(const float* W, int K, int N, bf16* WT, int dst_row0, LAS float* scr, int k0, int n0, int lane) {
#pragma unroll 8
    for (int i = 0; i < 32; ++i) { const int kk = 2 * i + (lane >> 5); scr[kk * 33 + (lane & 31)] = W[(size_t)(k0 + kk) * N + n0 + (lane & 31)]; }
    LDS_WAIT(); asm volatile("" ::: "memory");
    const int c = lane & 7;
#pragma unroll
    for (int j = 0; j < 4; ++j) { const int n = (lane >> 3) + 8 * j; const LAS float* s = scr + (8 * c) * 33 + n;
        v4u o; o.x = pk2(s[0 * 33], s[1 * 33]); o.y = pk2(s[2 * 33], s[3 * 33]); o.z = pk2(s[4 * 33], s[5 * 33]); o.w = pk2(s[6 * 33], s[7 * 33]);
        *(v4u*)(WT + (size_t)(dst_row0 + n) * K + k0 + 8 * c) = o; }
    LDS_WAIT(); asm volatile("" ::: "memory");
}
__device__ __forceinline__ int win_map(int n0) {
    if (n0 < 512) return n0;
    if (n0 < 1024) return 2048 + (n0 - 512);
    if (n0 < 1056) return 5120 + (n0 - 1024);
    if (n0 < 1568) return 512 + (n0 - 1056);
    if (n0 < 2080) return 1024 + (n0 - 1568);
    if (n0 < 2592) return 1536 + (n0 - 2080);
    if (n0 < 3104) return 2560 + (n0 - 2592);
    return 3072 + (n0 - 3104);
}

__device__ __forceinline__ void p0_prologue(const Frame& F) {
    CArgsP a = kargs(); unsigned char* const ws = a->ws;
    const int gw = F.vcu * NWAVES + F.wave, NGW = F.G * NWAVES;
    const int gtid = F.vcu * NT + F.tid, GT = F.G * NT;
    {
        LAS float* scr = (LAS float*)(F.lds + F.wave * 16384);
        constexpr int I_IN = 16 * 161, I_P = 8 * 32, I_O = 16 * 32, PER_L = I_IN + 2 * I_P + I_O;
        for (int it = gw; it < DEPTH * PER_L; it += NGW) {
            const int l = it / PER_L; int r = it % PER_L;
            if (r < I_IN) { const int kb = r / 161, nb = r % 161; p0_transpose_item(a->in[I_WIN] + (size_t)l * D * IN_COLS, D, IN_COLS, (bf16*)(ws + WS_WIN) + (size_t)l * NPAD * D, win_map(nb * 32), scr, kb * 64, nb * 32, F.lane); continue; }
            r -= I_IN;
            if (r < I_P) { const int kb = r / 32, nb = r % 32; p0_transpose_item(a->in[I_WPG] + (size_t)l * 512 * D, D, D, (bf16*)(ws + WS_WPG) + (size_t)l * D * D, nb * 32, scr, kb * 64, nb * 32, F.lane); continue; }
            r -= I_P;
            if (r < I_P) { const int kb = r / 32, nb = r % 32; p0_transpose_item(a->in[I_WPN] + (size_t)l * 512 * D, D, D, (bf16*)(ws + WS_WPG) + (size_t)l * D * D + 512, nb * 32, scr, kb * 64, nb * 32, F.lane); continue; }
            r -= I_P;
            { const int kb = r / 32, nb = r % 32; p0_transpose_item(a->in[I_WO] + (size_t)l * D * D, D, D, (bf16*)(ws + WS_WO) + (size_t)l * D * D, nb * 32, scr, kb * 64, nb * 32, F.lane); }
        }
        constexpr int PADV = (NPAD - IN_COLS) * D / 8;
        for (int i = gtid; i < DEPTH * PADV; i += GT) { const int l = i / PADV, j = i % PADV; *((v4u*)((bf16*)(ws + WS_WIN) + ((size_t)l * NPAD + IN_COLS) * D) + j) = (v4u){0u, 0u, 0u, 0u}; }
    }
    __syncthreads();
    if (gtid < 128 * 16) { const int pos = gtid >> 4, j = gtid & 15; const float freq = powf(10000.f, -(float)j / 16.f); const float ang = (float)pos * freq;
        float* cs = (float*)(ws + WS_ROPE); cs[2 * gtid] = cosf(ang); cs[2 * gtid + 1] = sinf(ang); }
    {
        LAS float* LSK = (LAS float*)F.lds;
        LAS float* LQ = (LAS float*)(F.lds + 128 * 132 * 4);
        for (int unit = F.vcu; unit < DEPTH * 16 * 16; unit += F.G) {
            const int l = unit >> 8, hp = (unit >> 4) & 15, d0 = (unit & 15) * 64;
            const float* sk = a->in[I_SK] + ((size_t)l * 16 + hp) * 16384;
            const float* wq = a->in[I_WQ] + (size_t)l * D * 2048 + hp * 128;
            __syncthreads();
            for (int i = F.tid; i < 16384; i += NT) LSK[(i >> 7) * 132 + (i & 127)] = sk[i];
            for (int i = F.tid; i < 8192; i += NT) LQ[(i >> 7) * 132 + (i & 127)] = wq[(size_t)(d0 + (i >> 7)) * 2048 + (i & 127)];
            __syncthreads();
            const int dd = F.tid & 63, kg = F.tid >> 6;
            float acc[16];
#pragma unroll
            for (int k = 0; k < 16; ++k) acc[k] = 0.f;
            for (int j = 0; j < 128; j += 4) {
                const f32x4 q = *(const LAS f32x4*)(LQ + dd * 132 + j);
#pragma unroll
                for (int k = 0; k < 16; ++k) { const f32x4 s = *(const LAS f32x4*)(LSK + (kg * 16 + k) * 132 + j); acc[k] += q[0] * s[0] + q[1] * s[1] + q[2] * s[2] + q[3] * s[3]; }
            }
            bf16* o = (bf16*)(ws + WS_WS) + ((size_t)l * 2048 + hp * 128 + kg * 16) * D + d0 + dd;
#pragma unroll
            for (int k = 0; k < 16; ++k) o[(size_t)k * D] = (bf16)f2bf(acc[k]);
        }
    }
    __syncthreads();
    {
        LAS float* ca = (LAS float*)F.lds;
        LAS float* red = (LAS float*)(F.lds + 9 * D * 4);
        for (int i = F.tid; i < 9 * D; i += NT) { const float v = i < 8 * D ? a->in[I_C][i] : a->in[I_CCTX][i - 8 * D]; ca[i] = v / (1.f + __expf(-v)); }
        __syncthreads();
        float* MOD = (float*)(ws + WS_MOD);
        for (int unit = F.vcu; unit < DEPTH * 96; unit += F.G) {
            const int l = unit / 96, cb = unit % 96, dc = F.tid >> 6;
            const int col = cb * 64 + (F.tid & 63);
            const float* w = a->in[I_WMOD] + ((size_t)l * D + dc * 128) * 6144 + col;
            float acc[9];
#pragma unroll
            for (int b = 0; b < 9; ++b) acc[b] = 0.f;
#pragma unroll 8
            for (int d = 0; d < 128; ++d) { const float wv = w[(size_t)d * 6144];
#pragma unroll
                for (int b = 0; b < 9; ++b) acc[b] += ca[b * D + dc * 128 + d] * wv; }
#pragma unroll
            for (int b = 0; b < 9; ++b) red[(dc * 9 + b) * 64 + (F.tid & 63)] = acc[b];
            __syncthreads();
            for (int i = F.tid; i < 9 * 64; i += NT) { const int b = i >> 6, c = i & 63; float sum = a->in[I_BMOD][l * 6144 + cb * 64 + c];
#pragma unroll
                for (int k = 0; k < 8; ++k) sum += red[(k * 9 + b) * 64 + c];
                MOD[((size_t)l * 9 + b) * 6144 + cb * 64 + c] = sum; }
            __syncthreads();
        }
    }
    __syncthreads();
}

__device__ __forceinline__ unsigned pk4_fp8(float a, float b, float c, float d) { int p = __builtin_amdgcn_cvt_pk_fp8_f32(a, b, 0, false); p = __builtin_amdgcn_cvt_pk_fp8_f32(c, d, p, true); return (unsigned)p; }
__device__ __forceinline__ void convert_row_fp8(const float* src, unsigned char* dst_tab, float* scale_out, int e, int lane) {
    const f32x4* sp = (const f32x4*)(src + (size_t)e * D) + 4 * lane;
    const f32x4 a0 = sp[0], a1 = sp[1], a2 = sp[2], a3 = sp[3];
    float mx = fmaxf(fmaxf(fmaxf(fabsf(a0[0]), fabsf(a0[1])), fmaxf(fabsf(a0[2]), fabsf(a0[3]))), fmaxf(fmaxf(fabsf(a1[0]), fabsf(a1[1])), fmaxf(fabsf(a1[2]), fabsf(a1[3]))));
    mx = fmaxf(mx, fmaxf(fmaxf(fmaxf(fabsf(a2[0]), fabsf(a2[1])), fmaxf(fabsf(a2[2]), fabsf(a2[3]))), fmaxf(fmaxf(fabsf(a3[0]), fabsf(a3[1])), fmaxf(fabsf(a3[2]), fabsf(a3[3])))));
    mx = fmaxf(wave_max(mx, lane), 1e-30f);
    const float sc = 256.f / mx;
    const v4u w = (v4u){pk4_fp8(a0[0] * sc, a0[1] * sc, a0[2] * sc, a0[3] * sc), pk4_fp8(a1[0] * sc, a1[1] * sc, a1[2] * sc, a1[3] * sc), pk4_fp8(a2[0] * sc, a2[1] * sc, a2[2] * sc, a2[3] * sc), pk4_fp8(a3[0] * sc, a3[1] * sc, a3[2] * sc, a3[3] * sc)};
    *(v4u*)(dst_tab + ((size_t)(lane >> 3) * NEXP + e) * 128 + 16 * (lane & 7)) = w;
    if (lane == 0) scale_out[e] = mx * (1.f / 256.f);
}
__device__ __forceinline__ void convert_experts(const Frame& F, int layer) {
    CArgsP a = kargs(); unsigned char* const ws = a->ws;
    const int gw = F.vcu * NWAVES + F.wave, NGW = F.G * NWAVES;
    const float* su = a->in[I_EU] + (size_t)layer * NEXP * D; const float* sv = a->in[I_EV] + (size_t)layer * NEXP * D;
    for (int e = gw; e < NEXP; e += NGW) { convert_row_fp8(su, ws + WS_EU, (float*)(ws + WS_SU), e, F.lane); convert_row_fp8(sv, ws + WS_EV, (float*)(ws + WS_SV), e, F.lane); }
}

__device__ __forceinline__ void norm_phase(const Frame& F, int layer, int which, int rbeg) {
    CArgsP a = kargs(); unsigned char* const ws = a->ws;
    const int gw = F.vcu * NWAVES + F.wave, NGW = F.G * NWAVES;
    const float* g = (which ? a->in[I_GN2] : a->in[I_GN1]) + layer * D;
    const float* MOD = (const float*)(ws + WS_MOD) + (size_t)layer * 9 * 6144 + (which ? 3072 : 0);
    bf16* H = (bf16*)(ws + WS_H);
    f32x4 gv[4];
#pragma unroll
    for (int j = 0; j < 4; ++j) gv[j] = *((const f32x4*)g + F.lane + 64 * j);
    for (int r = rbeg + gw; r < R; r += NGW) {
        const float* sh = MOD + row_slot(r) * 6144; const float* sc = sh + D;
        f32x4 v[4]; float ss = 0.f;
        if ((which == 0 && layer == 0) || r < NCTX) {
            const float* xr = (which == 0 && layer == 0) ? xrow_in(a, r) : xc_row(a, r);
#pragma unroll
            for (int j = 0; j < 4; ++j) v[j] = *((const GAS f32x4*)xr + F.lane + 64 * j);
        } else {
            const v2u* xb = (const v2u*)xl_row(a, r) + F.lane;
#pragma unroll
            for (int j = 0; j < 4; ++j) { const v2u w = xb[64 * j]; v[j] = (f32x4){bflo(w.x), bfhi(w.x), bflo(w.y), bfhi(w.y)}; }
        }
#pragma unroll
        for (int j = 0; j < 4; ++j) ss += (v[j][0] * v[j][0] + v[j][1] * v[j][1]) + (v[j][2] * v[j][2] + v[j][3] * v[j][3]);
        const float rs = rsqrtf(wave_sum(ss, F.lane) * (1.f / D) + EPS);
        unsigned long long* o8 = (unsigned long long*)(H + (size_t)r * D) + F.lane;
        float mx = 0.f;
#pragma unroll
        for (int j = 0; j < 4; ++j) {
            const f32x4 s1 = *((const f32x4*)sc + F.lane + 64 * j), s0 = *((const f32x4*)sh + F.lane + 64 * j);
            const f32x4 y = v[j] * rs * gv[j] * (s1 + 1.f) + s0;
            o8[64 * j] = (unsigned long long)pk2(y[0], y[1]) | ((unsigned long long)pk2(y[2], y[3]) << 32);
            v[j] = y; mx = fmaxf(mx, fmaxf(fmaxf(fabsf(y[0]), fabsf(y[1])), fmaxf(fabsf(y[2]), fabsf(y[3]))));
        }
        if (which) {
            mx = fmaxf(wave_max(mx, F.lane), 1e-30f); const float q8 = 256.f / mx;
            unsigned* h8 = (unsigned*)(ws + WS_H8 + (size_t)r * D) + F.lane;
#pragma unroll
            for (int j = 0; j < 4; ++j) h8[64 * j] = pk4_fp8(v[j][0] * q8, v[j][1] * q8, v[j][2] * q8, v[j][3] * q8);
            if (F.lane == 0) ((float*)(ws + WS_SX))[r] = mx * (1.f / 256.f);
        }
    }
}

constexpr int GL_TOT = 0, GL_IMG = 4096, GL_PITCH = 144, GL_IMGB = 64 * GL_PITCH, GL_SSX = GL_IMG + 4 * GL_IMGB;
typedef short bf16x8_t __attribute__((ext_vector_type(8)));
__device__ __forceinline__ int chunk_row0(int b, int tc) { return tc < 4 ? b * CTXL + tc * 64 : NCTX + b * SEQ + (tc - 4) * 64; }
__device__ __forceinline__ int chunk_pos(int tc, int dir) { return dir == 0 ? tc : (tc < 4 ? 3 - tc : 135 - tc); }
__device__ __forceinline__ float logsig16(float x) { return (fminf(x, 0.f) - 0.69314718f * __builtin_amdgcn_logf(1.f + __builtin_amdgcn_exp2f(-1.44269504f * fabsf(x)))) * (1.f / 16.f); }
constexpr int GL_HALF = 65536, GL_Z = 40960, GL_QK = 49152;
struct GlaW { float wf[16], wb[16], baf, bab; };
__device__ __forceinline__ void gla_load_w(GlaW& w, CArgsP a, int layer, int h, int lane) {
    const float* waf = a->in[I_WAF] + layer * 4096 + h * 64 + lane; const float* wab = a->in[I_WAB] + layer * 4096 + h * 64 + lane;
#pragma unroll
    for (int j = 0; j < 16; ++j) { w.wf[j] = waf[j * 256]; w.wb[j] = wab[j * 256]; }
    w.baf = a->in[I_BAF][layer * 256 + h * 64 + lane]; w.bab = a->in[I_BAB][layer * 256 + h * 64 + lane];
}
__device__ __forceinline__ void gla_scan(LAS unsigned char* hl, int w4, int lane, const GlaW& w, const float* Z, int row0, float (&Bf)[16], float (&Bb)[16], float& endf, float& endb) {
    const int t0 = 16 * w4;
    LAS float* ZL = (LAS float*)(hl + GL_Z) + t0 * 32;
    { const f32x4* zp = (const f32x4*)(Z + (size_t)(row0 + t0 + (lane >> 2)) * 32 + (lane & 3) * 8); const f32x4 z0 = zp[0], z1 = zp[1];
      *(LAS f32x4*)(ZL + (lane >> 2) * 32 + (lane & 3) * 8) = z0; *(LAS f32x4*)(ZL + (lane >> 2) * 32 + (lane & 3) * 8 + 4) = z1; }
    LDS_WAIT();
#pragma unroll
    for (int i = 0; i < 16; ++i) {
        const LAS f32x4* zp = (const LAS f32x4*)(ZL + i * 32);
        float zf = w.baf, zb = w.bab;
#pragma unroll
        for (int q = 0; q < 4; ++q) { const f32x4 z0 = zp[q], z1 = zp[4 + q];
            zf += z0[0] * w.wf[4 * q] + z0[1] * w.wf[4 * q + 1] + z0[2] * w.wf[4 * q + 2] + z0[3] * w.wf[4 * q + 3];
            zb += z1[0] * w.wb[4 * q] + z1[1] * w.wb[4 * q + 1] + z1[2] * w.wb[4 * q + 2] + z1[3] * w.wb[4 * q + 3]; }
        Bf[i] = logsig16(zf); Bb[i] = logsig16(zb);
    }
#pragma unroll
    for (int i = 1; i < 16; ++i) Bf[i] += Bf[i - 1];
#pragma unroll
    for (int i = 14; i >= 0; --i) Bb[i] += Bb[i + 1];
    LAS float* TOT = (LAS float*)(hl + GL_TOT);
    TOT[(0 * 4 + w4) * 64 + lane] = Bf[15]; TOT[(1 * 4 + w4) * 64 + lane] = Bb[0];
    __syncthreads();
    float offf = 0.f, offb = 0.f; endf = 0.f; endb = 0.f;
#pragma unroll
    for (int ww = 0; ww < 4; ++ww) { const float tf = TOT[(0 * 4 + ww) * 64 + lane], tb = TOT[(1 * 4 + ww) * 64 + lane]; endf += tf; endb += tb; offf += (ww < w4) ? tf : 0.f; offb += (ww > w4) ? tb : 0.f; }
#pragma unroll
    for (int i = 0; i < 16; ++i) { Bf[i] += offf; Bb[i] += offb; }
}
constexpr int GLA_UNITS = BATCH * 4 * NCHUNK;
__device__ __forceinline__ void gla_a_phase(const Frame& F, int layer) {
    CArgsP a = kargs(); unsigned char* const ws = a->ws;
    const bf16* PA = (const bf16*)(ws + WS_PA); const bf16* VT = (const bf16*)(ws + WS_VT);
    const float* Z = (const float*)(ws + WS_Z); bf16* SST = (bf16*)(ws + WS_H); float* DEC = (float*)(ws + WS_DEC);
    const int lane = F.lane, l16 = lane & 15, g = lane >> 4, hw = F.wave >> 2, w4 = F.wave & 3, t0 = 16 * w4;
    LAS unsigned char* hl = F.lds + hw * GL_HALF;
    const int h = F.vcu & 3;
    GlaW gw; gla_load_w(gw, a, layer, h, lane);
    for (int pp = F.vcu >> 2; pp < BATCH * NCHUNK / 2; pp += F.G >> 2) {
        const int unit = 2 * pp + hw;
        const int b = unit / NCHUNK, tc = unit % NCHUNK, row0 = chunk_row0(b, tc);
        LAS bf16* KL = (LAS bf16*)(hl + GL_QK + 8192) + t0 * 64;
        { const bf16* kp = PA + (size_t)(row0 + t0 + (lane >> 2)) * PA_LD + PA_K + h * 64 + (lane & 3) * 16; const v4u k0 = *(const v4u*)kp, k1 = *(const v4u*)(kp + 8);
          *(LAS v4u*)(KL + (lane >> 2) * 64 + (lane & 3) * 16) = k0; *(LAS v4u*)(KL + (lane >> 2) * 64 + (lane & 3) * 16 + 8) = k1; }
        float Bf[16], Bb[16], endf, endb;
        gla_scan(hl, w4, lane, gw, Z, row0, Bf, Bb, endf, endb);
        float kf[16], kb[16];
#pragma unroll
        for (int i = 0; i < 16; ++i) { const float kk = bf1(KL[i * 64 + lane]); kf[i] = kk * __expf(endf - Bf[i]); kb[i] = kk * __expf(endb - Bb[i]); }
#pragma unroll
        for (int q = 0; q < 2; ++q) {
            *(LAS v4u*)(hl + GL_IMG + 0 * GL_IMGB + lane * GL_PITCH + (t0 + 8 * q) * 2) = (v4u){pk2(kf[8 * q], kf[8 * q + 1]), pk2(kf[8 * q + 2], kf[8 * q + 3]), pk2(kf[8 * q + 4], kf[8 * q + 5]), pk2(kf[8 * q + 6], kf[8 * q + 7])};
            *(LAS v4u*)(hl + GL_IMG + 1 * GL_IMGB + lane * GL_PITCH + (t0 + 8 * q) * 2) = (v4u){pk2(kb[8 * q], kb[8 * q + 1]), pk2(kb[8 * q + 2], kb[8 * q + 3]), pk2(kb[8 * q + 4], kb[8 * q + 5]), pk2(kb[8 * q + 6], kb[8 * q + 7])};
        }
        const int seq0 = (b * 4 + h) * 2;
        if (w4 == 0) { DEC[((size_t)(seq0 + 0) * NCHUNK + chunk_pos(tc, 0)) * 64 + lane] = __expf(endf); DEC[((size_t)(seq0 + 1) * NCHUNK + chunk_pos(tc, 1)) * 64 + lane] = __expf(endb); }
        __syncthreads();
        const int dir = w4 >> 1, nth = w4 & 1;
        const LAS unsigned char* img = hl + GL_IMG + dir * GL_IMGB;
        bf16x8_t afr[4][2];
#pragma unroll
        for (int mt = 0; mt < 4; ++mt)
#pragma unroll
            for (int kt = 0; kt < 2; ++kt) afr[mt][kt] = *(const LAS bf16x8_t*)(img + (32 * (mt >> 1) + 8 * (l16 >> 2) + 4 * (mt & 1) + (l16 & 3)) * GL_PITCH + (32 * kt + 8 * g) * 2);
        bf16* slot = SST + ((size_t)(seq0 + dir) * NCHUNK + chunk_pos(tc, dir)) * 8192;
#pragma unroll
        for (int n4 = 0; n4 < 4; ++n4) {
            const int nt = 4 * nth + n4;
            const bf16* vp = VT + (size_t)(h * 128 + 16 * nt + l16) * R + row0 + 8 * g;
            const bf16x8_t b0 = *(const bf16x8_t*)vp, b1 = *(const bf16x8_t*)(vp + 32);
#pragma unroll
            for (int mp = 0; mp < 2; ++mp) {
                f32x4 a0 = (f32x4){0.f, 0.f, 0.f, 0.f}, a1 = (f32x4){0.f, 0.f, 0.f, 0.f};
                a0 = __builtin_amdgcn_mfma_f32_16x16x32_bf16(afr[2 * mp][0], b0, a0, 0, 0, 0); a0 = __builtin_amdgcn_mfma_f32_16x16x32_bf16(afr[2 * mp][1], b1, a0, 0, 0, 0);
                a1 = __builtin_amdgcn_mfma_f32_16x16x32_bf16(afr[2 * mp + 1][0], b0, a1, 0, 0, 0); a1 = __builtin_amdgcn_mfma_f32_16x16x32_bf16(afr[2 * mp + 1][1], b1, a1, 0, 0, 0);
                *(v4u*)(slot + (16 * nt + l16) * 64 + 32 * mp + 8 * g) = (v4u){pk2(a0[0], a0[1]), pk2(a0[2], a0[3]), pk2(a1[0], a1[1]), pk2(a1[2], a1[3])};
            }
        }
        __syncthreads();
    }
}
__device__ __forceinline__ void gla_b_phase(const Frame& F, bool dry) {
    CArgsP a = kargs(); unsigned char* const ws = a->ws; const bool wr = !dry || a->pad == 12345;
    bf16* SST = (bf16*)(ws + WS_H); const float* DEC = (const float*)(ws + WS_DEC);
    const int gtid = F.vcu * NT + F.tid, GT = F.G * NT;
    for (int id = gtid; id < 64 * 2048; id += GT) {
        const int seq = id >> 11, e = (id & 2047) * 4, k4 = e & 63;
        float s0 = 0.f, s1 = 0.f, s2 = 0.f, s3 = 0.f;
        bf16* p = SST + (size_t)seq * NCHUNK * 8192 + e; const float* dp = DEC + (size_t)seq * NCHUNK * 64 + k4;
#pragma unroll 4
        for (int c = 0; c < NCHUNK; ++c) {
            const v2u t = *(const v2u*)(p + (size_t)c * 8192); const f32x4 d = *(const f32x4*)(dp + c * 64);
            if (wr) *(v2u*)(p + (size_t)c * 8192) = (v2u){pk2(s0, s1), pk2(s2, s3)};
            s0 = d[0] * s0 + bflo(t.x); s1 = d[1] * s1 + bfhi(t.x); s2 = d[2] * s2 + bflo(t.y); s3 = d[3] * s3 + bfhi(t.y);
        }
    }
}
__device__ __forceinline__ void gla_c_phase(const Frame& F, int layer, bool dry) {
    CArgsP a = kargs(); unsigned char* const ws = a->ws; const bool wr = !dry || a->pad == 12345;
    bf16* PA = (bf16*)(ws + WS_PA); const bf16* VT = (const bf16*)(ws + WS_VT);
    const float* Z = (const float*)(ws + WS_Z); const bf16* SST = (const bf16*)(ws + WS_H);
    const int lane = F.lane, l16 = lane & 15, g = lane >> 4, hw = F.wave >> 2, w4 = F.wave & 3, t0 = 16 * w4;
    LAS unsigned char* hl = F.lds + hw * GL_HALF;
    const int h = F.vcu & 3;
    GlaW gw; gla_load_w(gw, a, layer, h, lane);
    for (int pp = F.vcu >> 2; pp < BATCH * NCHUNK / 2; pp += F.G >> 2) {
        const int unit = 2 * pp + hw;
        const int b = unit / NCHUNK, tc = unit % NCHUNK, row0 = chunk_row0(b, tc);
        {
            LAS bf16* QL = (LAS bf16*)(hl + GL_QK) + t0 * 64; LAS bf16* KL = QL + 4096;
            { const bf16* qp = PA + (size_t)(row0 + t0 + (lane >> 2)) * PA_LD + PA_Q + h * 64 + (lane & 3) * 16; const bf16* kp = qp + (PA_K - PA_Q);
              const v4u q0 = *(const v4u*)qp, q1 = *(const v4u*)(qp + 8), k0 = *(const v4u*)kp, k1 = *(const v4u*)(kp + 8);
              const int o = (lane >> 2) * 64 + (lane & 3) * 16;
              *(LAS v4u*)(QL + o) = q0; *(LAS v4u*)(QL + o + 8) = q1; *(LAS v4u*)(KL + o) = k0; *(LAS v4u*)(KL + o + 8) = k1; }
            float Bf[16], Bb[16], endf, endb;
            gla_scan(hl, w4, lane, gw, Z, row0, Bf, Bb, endf, endb);
#pragma unroll
            for (int i = 0; i < 16; ++i) {
                const float qq = bf1(QL[i * 64 + lane]), kk = bf1(KL[i * 64 + lane]);
                const float ef = __expf(Bf[i]), eb = __expf(Bb[i]);
                LAS bf16* ip = (LAS bf16*)(hl + GL_IMG + (t0 + i) * GL_PITCH) + lane;
                ip[0] = (bf16)f2bf(qq * ef); ip[GL_IMGB / 2] = (bf16)f2bf(kk * __builtin_amdgcn_rcpf(ef)); ip[GL_IMGB] = (bf16)f2bf(qq * eb); ip[3 * GL_IMGB / 2] = (bf16)f2bf(kk * __builtin_amdgcn_rcpf(eb));
            }
        }
        __syncthreads();
        f32x4 O[8];
#pragma unroll
        for (int mt = 0; mt < 8; ++mt) O[mt] = (f32x4){0.f, 0.f, 0.f, 0.f};
        const int tq = 16 * w4 + l16;
#pragma unroll
        for (int dir = 0; dir < 2; ++dir) {
            const LAS unsigned char* Qimg = hl + GL_IMG + (2 * dir) * GL_IMGB; const LAS unsigned char* Kimg = Qimg + GL_IMGB;
            bf16x8_t qf[2];
#pragma unroll
            for (int kt = 0; kt < 2; ++kt) qf[kt] = *(const LAS bf16x8_t*)(Qimg + tq * GL_PITCH + (32 * kt + 8 * g) * 2);
            f32x4 P[4];
#pragma unroll
            for (int mt = 0; mt < 4; ++mt) {
                P[mt] = (f32x4){0.f, 0.f, 0.f, 0.f};
                const int trow = 32 * (mt >> 1) + 8 * (l16 >> 2) + 4 * (mt & 1) + (l16 & 3);
#pragma unroll
                for (int kt = 0; kt < 2; ++kt) { const bf16x8_t kf = *(const LAS bf16x8_t*)(Kimg + trow * GL_PITCH + (32 * kt + 8 * g) * 2); P[mt] = __builtin_amdgcn_mfma_f32_16x16x32_bf16(kf, qf[kt], P[mt], 0, 0, 0); }
#pragma unroll
                for (int rg = 0; rg < 4; ++rg) { const int tp = 32 * (mt >> 1) + 8 * g + 4 * (mt & 1) + rg; const bool valid = dir == 0 ? (tp <= tq) : (tp >= tq); P[mt][rg] = valid ? P[mt][rg] : 0.f; }
            }
            bf16x8_t pa[2];
#pragma unroll
            for (int k2 = 0; k2 < 2; ++k2) { const v4u w = (v4u){pk2(P[2 * k2][0], P[2 * k2][1]), pk2(P[2 * k2][2], P[2 * k2][3]), pk2(P[2 * k2 + 1][0], P[2 * k2 + 1][1]), pk2(P[2 * k2 + 1][2], P[2 * k2 + 1][3])}; pa[k2] = __builtin_bit_cast(bf16x8_t, w); }
            const bf16* slot = SST + ((size_t)((b * 4 + h) * 2 + dir) * NCHUNK + chunk_pos(tc, dir)) * 8192;
#pragma unroll
            for (int mt = 0; mt < 8; ++mt) {
                const int v = 32 * (mt >> 1) + 8 * (l16 >> 2) + 4 * (mt & 1) + (l16 & 3);
                const bf16* vp = VT + (size_t)(h * 128 + v) * R + row0 + 8 * g;
#pragma unroll
                for (int k2 = 0; k2 < 2; ++k2) { const bf16x8_t vf = *(const bf16x8_t*)(vp + 32 * k2); O[mt] = __builtin_amdgcn_mfma_f32_16x16x32_bf16(vf, pa[k2], O[mt], 0, 0, 0); }
#pragma unroll
                for (int kt = 0; kt < 2; ++kt) { const bf16x8_t sf = *(const bf16x8_t*)(slot + v * 64 + 32 * kt + 8 * g); O[mt] = __builtin_amdgcn_mfma_f32_16x16x32_bf16(sf, qf[kt], O[mt], 0, 0, 0); }
            }
        }
        float ss = 0.f;
#pragma unroll
        for (int mt = 0; mt < 8; ++mt) ss += (O[mt][0] * O[mt][0] + O[mt][1] * O[mt][1]) + (O[mt][2] * O[mt][2] + O[mt][3] * O[mt][3]);
        ss += shx(ss, 16, lane); ss += shx(ss, 32, lane);
        const float rs = rsqrtf(ss * (1.f / 128.f) + EPS);
        bf16* rp0 = PA + (size_t)(row0 + tq) * PA_LD + PA_R + h * 128 + 8 * g;
#pragma unroll
        for (int mp = 0; mp < 4; ++mp) {
            const v4u rr = *(const v4u*)(rp0 + 32 * mp);
            const float* gp = a->in[I_GGLA] + layer * 128 + 32 * mp + 8 * g; const f32x4 ga = *(const f32x4*)gp, gb = *(const f32x4*)(gp + 4);
            const float r0 = bflo(rr.x), r1 = bfhi(rr.x), r2 = bflo(rr.y), r3 = bfhi(rr.y), r4 = bflo(rr.z), r5 = bfhi(rr.z), r6 = bflo(rr.w), r7 = bfhi(rr.w);
            const f32x4 oa = O[2 * mp], ob = O[2 * mp + 1];
            const float y0 = oa[0] * rs * ga[0] * (r0 * sigmoidf_(r0)), y1 = oa[1] * rs * ga[1] * (r1 * sigmoidf_(r1)), y2 = oa[2] * rs * ga[2] * (r2 * sigmoidf_(r2)), y3 = oa[3] * rs * ga[3] * (r3 * sigmoidf_(r3));
            const float y4 = ob[0] * rs * gb[0] * (r4 * sigmoidf_(r4)), y5 = ob[1] * rs * gb[1] * (r5 * sigmoidf_(r5)), y6 = ob[2] * rs * gb[2] * (r6 * sigmoidf_(r6)), y7 = ob[3] * rs * gb[3] * (r7 * sigmoidf_(r7));
            if (wr) *(v4u*)(rp0 + 32 * mp) = (v4u){pk2(y0, y1), pk2(y2, y3), pk2(y4, y5), pk2(y6, y7)};
        }
        __syncthreads();
    }
}

__device__ __forceinline__ void na_unit4(bf16* PA, const bf16* NVT, const float* rpb_l, LAS float* lb, int b, int hd, bool lat, int qr0, int nt, int lane, bool wr) {
    const int l16 = lane & 15, g = lane >> 4;
    const int latbase = NCTX + b * SEQ, ctxbase = b * CTXL;
    bf16* qp[4]; bf16x8_t qf[4][2];
#pragma unroll
    for (int j = 0; j < 4; ++j) {
        const int row = lat ? latbase + (qr0 + j) * 64 + 16 * nt + l16 : ctxbase + 64 * nt + 16 * j + l16;
        qp[j] = PA + (size_t)row * PA_LD + PA_NQ + hd * 64;
        qf[j][0] = *(const bf16x8_t*)(qp[j] + 8 * g); qf[j][1] = *(const bf16x8_t*)(qp[j] + 32 + 8 * g);
    }
    const int qc = 16 * nt + l16, c0 = min(max(qc - 8, 0), 48), R0 = min(max(qr0 - 4, 0), 120);
    if (lat) {
#pragma unroll
        for (int i = 0; i < 8; ++i) { const int idx = lane + 64 * i; if (idx < 465) lb[idx] = rpb_l[hd * 465 + idx]; }
        LDS_WAIT();
    }
    const bf16* kbase = PA + PA_NK + hd * 64 + 8 * g;
    const bf16* vbase = NVT + (size_t)(hd * 64 + l16) * R + 8 * g;
    float mx[4] = {-3.0e38f, -3.0e38f, -3.0e38f, -3.0e38f};
    const int nrows = lat ? ((qr0 == 0 || qr0 == 124) ? 8 : 11) : 0, cs = (nt == 0) ? 0 : (nt == 1 ? 8 : (nt == 2 ? 24 : 32));
    const int nwin = nrows, nslot = nwin + 8;
#define NA_SLOT(si, jmask, krow, pr, base0, win) do { const int s_ = min((si), nslot - 1); win = s_ < nwin; pr = 0; \
        if (win) { krow = R0 + s_; jmask = 0u; \
            _Pragma("unroll") for (int j_ = 0; j_ < 4; ++j_) { const int r0j = min(max(qr0 + j_ - 4, 0), 120); if (krow >= r0j && krow < r0j + 8) jmask |= 1u << j_; } \
            base0 = latbase + krow * 64 + cs; } else { jmask = 15u; krow = 0; base0 = ctxbase + (s_ - nwin) * 32; } } while (0)
#define NA_LDK(dst, base0) do { _Pragma("unroll") for (int t_ = 0; t_ < 2; ++t_) { const bf16* kp_ = kbase + (size_t)((base0) + 8 * (l16 >> 2) + 4 * t_ + (l16 & 3)) * PA_LD; dst[t_][0] = *(const bf16x8_t*)kp_; dst[t_][1] = *(const bf16x8_t*)(kp_ + 32); } } while (0)
#define NA_LDV(dst, base0) do { _Pragma("unroll") for (int mt_ = 0; mt_ < 4; ++mt_) dst[mt_] = *(const bf16x8_t*)(vbase + (size_t)(16 * mt_) * R + (base0)); } while (0)
#pragma unroll 1
    for (int s0 = 0; s0 < nslot; s0 += 4) {
        bf16x8_t kc[4][2][2]; unsigned jm[4];
#pragma unroll
        for (int q = 0; q < 4; ++q) { int krow, pr, base0; bool win; NA_SLOT(s0 + q, jm[q], krow, pr, base0, win); if (s0 + q >= nslot) jm[q] = 0u; NA_LDK(kc[q], base0); }
#pragma unroll
        for (int q = 0; q < 4; ++q)
#pragma unroll
            for (int t = 0; t < 2; ++t)
#pragma unroll
                for (int j = 0; j < 4; ++j) {
                    f32x4 S = (f32x4){0.f, 0.f, 0.f, 0.f};
                    S = __builtin_amdgcn_mfma_f32_16x16x32_bf16(kc[q][t][0], qf[j][0], S, 0, 0, 0);
                    S = __builtin_amdgcn_mfma_f32_16x16x32_bf16(kc[q][t][1], qf[j][1], S, 0, 0, 0);
                    mx[j] = fmaxf(mx[j], fmaxf(fmaxf(S[0], S[1]), fmaxf(S[2], S[3])));
                }
    }
#pragma unroll
    for (int j = 0; j < 4; ++j) { mx[j] = fmaxf(mx[j], shx(mx[j], 16, lane)); mx[j] = fmaxf(mx[j], shx(mx[j], 32, lane)); }
    float ls[4] = {0.f, 0.f, 0.f, 0.f};
    f32x4 O[4][4];
#pragma unroll
    for (int j = 0; j < 4; ++j)
#pragma unroll
        for (int mt = 0; mt < 4; ++mt) O[j][mt] = (f32x4){0.f, 0.f, 0.f, 0.f};
#pragma unroll 1
    for (int s0 = 0; s0 < nslot; s0 += 2) {
        bf16x8_t kf[2][2][2], vf[2][4]; unsigned jm[2]; int krw[2], prr[2]; bool wn[2];
#pragma unroll
        for (int q = 0; q < 2; ++q) { int base0; NA_SLOT(s0 + q, jm[q], krw[q], prr[q], base0, wn[q]); if (s0 + q >= nslot) jm[q] = 0u; NA_LDK(kf[q], base0); NA_LDV(vf[q], base0); }
#pragma unroll
        for (int q = 0; q < 2; ++q) {
            const bool win = wn[q]; const int pr = prr[q], krow = krw[q];
            bool cv[2][4]; int co[2][4];
#pragma unroll
            for (int t = 0; t < 2; ++t)
#pragma unroll
                for (int rg = 0; rg < 4; ++rg) { const int kcol = cs + 8 * g + 4 * t + rg; cv[t][rg] = !win || ((kcol >= c0) && (kcol <= c0 + 15)); co[t][rg] = min(max(kcol - qc + 15, 0), 30); }
#pragma unroll
            for (int j = 0; j < 4; ++j) {
                const bool rv = (jm[q] >> j) & 1u;
                f32x4 S[2];
#pragma unroll
                for (int t = 0; t < 2; ++t) { S[t] = (f32x4){0.f, 0.f, 0.f, 0.f};
                    S[t] = __builtin_amdgcn_mfma_f32_16x16x32_bf16(kf[q][t][0], qf[j][0], S[t], 0, 0, 0);
                    S[t] = __builtin_amdgcn_mfma_f32_16x16x32_bf16(kf[q][t][1], qf[j][1], S[t], 0, 0, 0); }
                const LAS float* bp = lb + (win ? min(max(krow - (qr0 + j) + 7, 0), 14) * 31 : 0);
                float psum = 0.f;
#pragma unroll
                for (int t = 0; t < 2; ++t)
#pragma unroll
                    for (int rg = 0; rg < 4; ++rg) { const float bias = win ? bp[co[t][rg]] : 0.f; const float p = (cv[t][rg] && rv) ? __expf(S[t][rg] + bias - mx[j]) : 0.f; S[t][rg] = p; psum += p; }
                ls[j] += psum;
                const bf16x8_t pa = __builtin_bit_cast(bf16x8_t, (v4u){pk2(S[0][0], S[0][1]), pk2(S[0][2], S[0][3]), pk2(S[1][0], S[1][1]), pk2(S[1][2], S[1][3])});
#pragma unroll
                for (int mt = 0; mt < 4; ++mt) O[j][mt] = __builtin_amdgcn_mfma_f32_16x16x32_bf16(vf[q][mt], pa, O[j][mt], 0, 0, 0);
            }
        }
    }
#undef NA_SLOT
#undef NA_LDK
#undef NA_LDV
#pragma unroll
    for (int j = 0; j < 4; ++j) {
        float l = ls[j]; l += shx(l, 16, lane); l += shx(l, 32, lane);
        const float inv = 1.f / l;
#pragma unroll
        for (int mt = 0; mt < 4; ++mt) if (wr) *(v2u*)(qp[j] + 16 * mt + 4 * g) = (v2u){pk2(O[j][mt][0] * inv, O[j][mt][1] * inv), pk2(O[j][mt][2] * inv, O[j][mt][3] * inv)};
    }
}
__device__ __forceinline__ void na_phase(const Frame& F, int layer, bool dry, bool skip_ctx) {
    CArgsP a = kargs(); unsigned char* const ws = a->ws; const bool wr = !dry || a->pad == 12345;
    bf16* PA = (bf16*)(ws + WS_PA); const bf16* NVT = (const bf16*)(ws + WS_NVT);
    const float* rpb_l = a->in[I_RPB] + (size_t)layer * 8 * 465;
    const int gw = F.vcu * NWAVES + F.wave, NGW = F.G * NWAVES;
    LAS float* lb = (LAS float*)(F.lds + F.wave * 2048);
    for (int u = gw; u < BATCH * 8 * 32 * 4 + (skip_ctx ? 0 : BATCH * 8 * 4); u += NGW) {
        if (u < BATCH * 8 * 32 * 4) { const int nt = u & 3, qg = (u >> 2) & 31, hd = (u >> 7) & 7, b = u >> 10; na_unit4(PA, NVT, rpb_l, lb, b, hd, true, 4 * qg, nt, F.lane, wr); }
        else { const int v = u - BATCH * 8 * 32 * 4; const int nt = v & 3, hd = (v >> 2) & 7, b = v >> 5; na_unit4(PA, NVT, rpb_l, lb, b, hd, false, 0, nt, F.lane, wr); }
    }
}

__device__ __forceinline__ float pack_key(float v, int idx) { unsigned t = __builtin_bit_cast(unsigned, v) & ~127u; asm("" : "+v"(t)); return __builtin_bit_cast(float, t | (unsigned)idx); }
__device__ __forceinline__ void topk_phase(const Frame& F, int rbeg) {
    CArgsP a = kargs(); unsigned char* const ws = a->ws;
    const int gtid = F.vcu * NT + F.tid, GT = F.G * NT;
    const bf16* SC = (const bf16*)(ws + WS_SC);
    int* EI = (int*)(ws + WS_EI); float* EG = (float*)(ws + WS_EG);
    LAS unsigned* myl = (LAS unsigned*)F.lds + F.tid * 9;
    for (int id = rbeg * 8 + gtid; id < R * 8; id += GT) {
        const int r = id >> 3, hd = id & 7;
        const v4u* sp = (const v4u*)(SC + (size_t)r * 2048 + hd * 256);
        float t0[16], t1[16];
#pragma unroll
        for (int blk = 0; blk < 8; ++blk) {
            float n0[16], n1[16];
#pragma unroll
            for (int q = 0; q < 2; ++q) { const v4u va = sp[blk * 2 + q], vb = sp[16 + blk * 2 + q];
                const unsigned wa[4] = {va.x, va.y, va.z, va.w}, wb[4] = {vb.x, vb.y, vb.z, vb.w};
#pragma unroll
                for (int e = 0; e < 4; ++e) { const int i0 = blk * 16 + 8 * q + 2 * e;
                    n0[8 * q + 2 * e] = pack_key(bflo(wa[e]), i0); n0[8 * q + 2 * e + 1] = pack_key(bfhi(wa[e]), i0 + 1);
                    n1[8 * q + 2 * e] = pack_key(bflo(wb[e]), i0); n1[8 * q + 2 * e + 1] = pack_key(bfhi(wb[e]), i0 + 1); } }
#pragma unroll
            for (int k = 2; k <= 16; k <<= 1)
#pragma unroll
                for (int j = k >> 1; j > 0; j >>= 1)
#pragma unroll
                    for (int i = 0; i < 16; ++i) { const int l = i ^ j; if (l > i) { const bool desc = (i & k) == 0;
                        const float a0 = n0[i], b0 = n0[l], a1 = n1[i], b1 = n1[l];
                        n0[i] = desc ? fmaxf(a0, b0) : fminf(a0, b0); n0[l] = desc ? fminf(a0, b0) : fmaxf(a0, b0);
                        n1[i] = desc ? fmaxf(a1, b1) : fminf(a1, b1); n1[l] = desc ? fminf(a1, b1) : fmaxf(a1, b1); } }
            if (blk == 0) {
#pragma unroll
                for (int i = 0; i < 16; ++i) { t0[i] = n0[i]; t1[i] = n1[i]; }
            } else {
#pragma unroll
                for (int i = 0; i < 16; ++i) { t0[i] = fmaxf(t0[i], n0[15 - i]); t1[i] = fmaxf(t1[i], n1[15 - i]); }
#pragma unroll
                for (int j = 8; j > 0; j >>= 1)
#pragma unroll
                    for (int i = 0; i < 16; ++i) { const int l = i ^ j; if (l > i) { const float a0 = t0[i], b0 = t0[l], a1 = t1[i], b1 = t1[l];
                        t0[i] = fmaxf(a0, b0); t0[l] = fminf(a0, b0); t1[i] = fmaxf(a1, b1); t1[l] = fminf(a1, b1); } }
            }
        }
        float best[16];
#pragma unroll
        for (int j = 0; j < 16; ++j) best[j] = -3.0e38f;
#pragma unroll
        for (int ia = 0; ia < 16; ++ia)
#pragma unroll
            for (int ib = 0; ib < 16; ++ib)
                if ((ia + 1) * (ib + 1) <= 16) {
                    float x = __builtin_bit_cast(float, (__builtin_bit_cast(unsigned, t0[ia] + t1[ib]) & ~255u) | (unsigned)(ia * 16 + ib));
#pragma unroll
                    for (int j = 0; j < 16; ++j) { const float tb = fmaxf(best[j], x); x = fminf(best[j], x); best[j] = tb; }
                }
        {
            unsigned w0[4], w1[4];
#pragma unroll
            for (int q = 0; q < 4; ++q) {
                w0[q] = (__builtin_bit_cast(unsigned, t0[4 * q]) & 127u) | ((__builtin_bit_cast(unsigned, t0[4 * q + 1]) & 127u) << 8) | ((__builtin_bit_cast(unsigned, t0[4 * q + 2]) & 127u) << 16) | ((__builtin_bit_cast(unsigned, t0[4 * q + 3]) & 127u) << 24);
                w1[q] = (__builtin_bit_cast(unsigned, t1[4 * q]) & 127u) | ((__builtin_bit_cast(unsigned, t1[4 * q + 1]) & 127u) << 8) | ((__builtin_bit_cast(unsigned, t1[4 * q + 2]) & 127u) << 16) | ((__builtin_bit_cast(unsigned, t1[4 * q + 3]) & 127u) << 24);
            }
#pragma unroll
            for (int q = 0; q < 4; ++q) { myl[q] = w0[q]; myl[4 + q] = w1[q]; }
            LDS_WAIT();
        }
        int eid[16];
#pragma unroll
        for (int j = 0; j < 16; ++j) { const unsigned code = __builtin_bit_cast(unsigned, best[j]) & 255u; const LAS unsigned char* mb = (const LAS unsigned char*)myl;
            eid[j] = (int)mb[code >> 4] * 128 + (int)mb[16 + (code & 15u)]; }
        LDS_WAIT();
        float sum = 0.f; const float bmax = best[0];
#pragma unroll
        for (int j = 0; j < 16; ++j) { best[j] = __expf(best[j] - bmax); sum += best[j]; }
        const float inv = 1.f / sum;
        v4i* ei = (v4i*)(EI + (size_t)r * 128 + hd * 16); f32x4* eg = (f32x4*)(EG + (size_t)r * 128 + hd * 16);
#pragma unroll
        for (int j = 0; j < 4; ++j) { ei[j] = (v4i){eid[4 * j], eid[4 * j + 1], eid[4 * j + 2], eid[4 * j + 3]}; eg[j] = (f32x4){best[4 * j] * inv, best[4 * j + 1] * inv, best[4 * j + 2] * inv, best[4 * j + 3] * inv}; }
    }
}

__device__ __forceinline__ float gelu_tanh(float x) { const float u = 0.7978845608f * (x + 0.044715f * x * x * x); return x * __builtin_amdgcn_rcpf(1.f + __expf(-2.f * u)); }
typedef float f32x2_t __attribute__((ext_vector_type(2)));
__device__ __forceinline__ void peer1_phase(const Frame& F, int rbeg) {
    CArgsP a = kargs(); unsigned char* const ws = a->ws;
    const unsigned char* EU8 = ws + WS_EU; const unsigned char* H8 = ws + WS_H8;
    const int* EI = (const int*)(ws + WS_EI); bf16* PART = (bf16*)(ws + WS_PART);
    const int per = F.G >> 3, s = F.vcu / per, rank = F.vcu % per, stride = per * NWAVES;
    const int lane = F.lane, m = lane & 15, g = lane >> 4, row8 = lane >> 3, part = lane & 7;
    const unsigned char* tab = EU8 + (size_t)s * NEXP * 128 + 16 * part;
    LAS unsigned char* wl = F.lds + F.wave * 5632;
    LAS int* idl = (LAS int*)(wl + 4608);
    const int wofs = row8 * 144 + part * 16, rofs = m * 144 + 16 * g;
    int r = rbeg + rank * NWAVES + F.wave;
    v2u idp[2];
#pragma unroll
    for (int u = 0; u < 2; ++u) idp[u] = *(const v2u*)(EI + (size_t)min(r + u * stride, R - 1) * 128 + 2 * lane);
    for (; r < R; r += 2 * stride) {
        v4u w[2][16]; v4u x[2][2];
#pragma unroll
        for (int u = 0; u < 2; ++u) *(LAS v2u*)(idl + u * 128 + 2 * lane) = idp[u];
        LDS_WAIT();
#pragma unroll
        for (int u = 0; u < 2; ++u) {
            const int ru = min(r + u * stride, R - 1);
            const unsigned char* xp = H8 + (size_t)ru * D + 128 * s + 16 * g;
            x[u][0] = *(const v4u*)xp; x[u][1] = *(const v4u*)(xp + 64);
#pragma unroll
            for (int j = 0; j < 16; ++j) w[u][j] = *(const v4u*)(tab + (size_t)idl[u * 128 + 8 * j + row8] * 128);
        }
        const int rn = r + 2 * stride;
#pragma unroll
        for (int u = 0; u < 2; ++u) idp[u] = *(const v2u*)(EI + (size_t)min(rn + u * stride, R - 1) * 128 + 2 * lane);
#pragma unroll
        for (int u = 0; u < 2; ++u) {
            f32x4 sel = (f32x4){0.f, 0.f, 0.f, 0.f};
#pragma unroll
            for (int T = 0; T < 8; ++T) {
                LAS unsigned char* buf = wl + (T & 1) * 2304;
                *(LAS v4u*)(buf + wofs) = w[u][2 * T]; *(LAS v4u*)(buf + 8 * 144 + wofs) = w[u][2 * T + 1];
                const v4u a0 = *(const LAS v4u*)(buf + rofs), a1 = *(const LAS v4u*)(buf + rofs + 64);
                f32x4 acc = (f32x4){0.f, 0.f, 0.f, 0.f};
                acc = __builtin_amdgcn_mfma_f32_16x16x32_fp8_fp8((long)(((unsigned long long)a0.y << 32) | a0.x), (long)(((unsigned long long)x[u][0].y << 32) | x[u][0].x), acc, 0, 0, 0);
                acc = __builtin_amdgcn_mfma_f32_16x16x32_fp8_fp8((long)(((unsigned long long)a0.w << 32) | a0.z), (long)(((unsigned long long)x[u][0].w << 32) | x[u][0].z), acc, 0, 0, 0);
                acc = __builtin_amdgcn_mfma_f32_16x16x32_fp8_fp8((long)(((unsigned long long)a1.y << 32) | a1.x), (long)(((unsigned long long)x[u][1].y << 32) | x[u][1].x), acc, 0, 0, 0);
                acc = __builtin_amdgcn_mfma_f32_16x16x32_fp8_fp8((long)(((unsigned long long)a1.w << 32) | a1.z), (long)(((unsigned long long)x[u][1].w << 32) | x[u][1].z), acc, 0, 0, 0);
                sel = (m == T) ? acc : sel;
            }
            const int ru = r + u * stride;
            if (m < 8 && ru < R) *(v2u*)(PART + ((size_t)s * R + ru) * 128 + 16 * m + 4 * g) = (v2u){pk2(sel[0], sel[1]), pk2(sel[2], sel[3])};
        }
    }
}
__device__ __forceinline__ void peer_act_phase(const Frame& F, int rbeg) {
    CArgsP a = kargs(); unsigned char* const ws = a->ws;
    const int gtid = F.vcu * NT + F.tid, GT = F.G * NT;
    const bf16* PART = (const bf16*)(ws + WS_PART); const int* EI = (const int*)(ws + WS_EI); const float* EG = (const float*)(ws + WS_EG);
    const float* SU = (const float*)(ws + WS_SU); const float* SV = (const float*)(ws + WS_SV); const float* SX = (const float*)(ws + WS_SX);
    float* ACT = (float*)(ws + WS_ACT);
    for (int i = rbeg * 32 + gtid; i < R * 32; i += GT) {
        const int r = i >> 5;
        f32x4 sum = (f32x4){0.f, 0.f, 0.f, 0.f};
#pragma unroll
        for (int q = 0; q < 8; ++q) { const v2u w = *(const v2u*)(PART + (size_t)q * R * 128 + (size_t)i * 4); sum += (f32x4){bflo(w.x), bfhi(w.x), bflo(w.y), bfhi(w.y)}; }
        const v4i id = *(const v4i*)(EI + (size_t)i * 4); const f32x4 gt = *(const f32x4*)(EG + (size_t)i * 4);
        const float sx = SX[r];
        f32x4 o;
#pragma unroll
        for (int k = 0; k < 4; ++k) o[k] = gelu_tanh(sum[k] * sx * SU[id[k]]) * gt[k] * SV[id[k]];
        *(f32x4*)(ACT + (size_t)i * 4) = o;
    }
}
__device__ __forceinline__ void peer2_phase(const Frame& F, int layer, bool dry, int rbeg) {
    CArgsP a = kargs(); unsigned char* const ws = a->ws; const bool wr = !dry || a->pad == 12345;
    const unsigned char* EV8 = ws + WS_EV; const int* EI = (const int*)(ws + WS_EI); const float* ACT = (const float*)(ws + WS_ACT);
    const float* MOD = (const float*)(ws + WS_MOD) + (size_t)layer * 9 * 6144 + 5 * D;
    const int per = F.G >> 3, s = F.vcu / per, rank = F.vcu % per, stride = per * NWAVES;
    const int lane = F.lane, part = lane & 7, e8 = lane >> 3;
    const unsigned char* tab = EV8 + (size_t)s * NEXP * 128 + 16 * part;
    const bool b5 = (lane & 32) != 0, b4 = (lane & 16) != 0, b3 = (lane & 8) != 0;
    const int dimoff = 128 * s + 16 * part + (b5 ? 8 : 0) + (b4 ? 4 : 0) + (b3 ? 2 : 0);
    int r = rbeg + rank * NWAVES + F.wave;
    v4i id4[2][4];
#pragma unroll
    for (int u = 0; u < 2; ++u)
#pragma unroll
        for (int q = 0; q < 4; ++q) id4[u][q] = *(const v4i*)(EI + (size_t)min(r + u * stride, R - 1) * 128 + 16 * e8 + 4 * q);
    for (; r < R; r += 2 * stride) {
        v4u w[2][16]; f32x4 a4[2][4];
#pragma unroll
        for (int u = 0; u < 2; ++u) {
            const int ru = min(r + u * stride, R - 1);
#pragma unroll
            for (int j = 0; j < 16; ++j) w[u][j] = *(const v4u*)(tab + (size_t)id4[u][j >> 2][j & 3] * 128);
#pragma unroll
            for (int q = 0; q < 4; ++q) a4[u][q] = *(const f32x4*)(ACT + (size_t)ru * 128 + 16 * e8 + 4 * q);
        }
        const int rn = r + 2 * stride;
#pragma unroll
        for (int u = 0; u < 2; ++u)
#pragma unroll
            for (int q = 0; q < 4; ++q) id4[u][q] = *(const v4i*)(EI + (size_t)min(rn + u * stride, R - 1) * 128 + 16 * e8 + 4 * q);
#pragma unroll
        for (int u = 0; u < 2; ++u) {
            f32x2_t o[8];
#pragma unroll
            for (int k = 0; k < 8; ++k) o[k] = (f32x2_t){0.f, 0.f};
#pragma unroll
            for (int j = 0; j < 16; ++j) {
                const v4u ww = w[u][j];
                const float av = a4[u][j >> 2][j & 3]; const f32x2_t av2 = (f32x2_t){av, av};
                o[0] += av2 * __builtin_amdgcn_cvt_pk_f32_fp8((int)ww.x, false); o[1] += av2 * __builtin_amdgcn_cvt_pk_f32_fp8((int)ww.x, true);
                o[2] += av2 * __builtin_amdgcn_cvt_pk_f32_fp8((int)ww.y, false); o[3] += av2 * __builtin_amdgcn_cvt_pk_f32_fp8((int)ww.y, true);
                o[4] += av2 * __builtin_amdgcn_cvt_pk_f32_fp8((int)ww.z, false); o[5] += av2 * __builtin_amdgcn_cvt_pk_f32_fp8((int)ww.z, true);
                o[6] += av2 * __builtin_amdgcn_cvt_pk_f32_fp8((int)ww.w, false); o[7] += av2 * __builtin_amdgcn_cvt_pk_f32_fp8((int)ww.w, true);
            }
            f32x2_t v4[4], v2[2], v1;
#pragma unroll
            for (int k = 0; k < 4; ++k) { const f32x2_t snd = b5 ? o[k] : o[k + 4], kp = b5 ? o[k + 4] : o[k]; f32x2_t rc; rc.x = shx(snd.x, 32, lane); rc.y = shx(snd.y, 32, lane); v4[k] = kp + rc; }
#pragma unroll
            for (int k = 0; k < 2; ++k) { const f32x2_t snd = b4 ? v4[k] : v4[k + 2], kp = b4 ? v4[k + 2] : v4[k]; f32x2_t rc; rc.x = shx(snd.x, 16, lane); rc.y = shx(snd.y, 16, lane); v2[k] = kp + rc; }
            { const f32x2_t snd = b3 ? v2[0] : v2[1], kp = b3 ? v2[1] : v2[0]; f32x2_t rc; rc.x = shx(snd.x, 8, lane); rc.y = shx(snd.y, 8, lane); v1 = kp + rc; }
            const int ru = r + u * stride;
            if (ru < R) {
                const f32x2_t ga = *(const f32x2_t*)(MOD + row_slot(ru) * 6144 + dimoff);
                if (ru < NCTX) { float* xq = xc_row(a, ru) + dimoff; const f32x2_t xx = *(const f32x2_t*)xq; if (wr) *(f32x2_t*)xq = xx + ga * v1; }
                else { unsigned* xq = (unsigned*)(xl_row(a, ru) + dimoff); const unsigned w = *xq; const f32x2_t y = (f32x2_t){bflo(w), bfhi(w)} + ga * v1; if (wr) *xq = pk2(y.x, y.y); }
            }
        }
    }
}

__device__ __forceinline__ void final_phase(const Frame& F) {
    CArgsP a = kargs(); unsigned char* const ws = a->ws;
    const int gw = F.vcu * NWAVES + F.wave, NGW = F.G * NWAVES;
    f32x4 gv[4];
#pragma unroll
    for (int j = 0; j < 4; ++j) gv[j] = *((const f32x4*)a->in[I_GF] + F.lane + 64 * j);
    for (int r = gw; r < NLAT; r += NGW) {
        const v2u* xb = (const v2u*)((const bf16*)a->out + (size_t)r * XL_LD) + F.lane;
        f32x4* xr = (f32x4*)(a->out + (size_t)r * D) + F.lane;
        f32x4 v[4]; float ss = 0.f;
#pragma unroll
        for (int j = 0; j < 4; ++j) { const v2u w = xb[64 * j]; v[j] = (f32x4){bflo(w.x), bfhi(w.x), bflo(w.y), bfhi(w.y)}; ss += (v[j][0] * v[j][0] + v[j][1] * v[j][1]) + (v[j][2] * v[j][2] + v[j][3] * v[j][3]); }
        const float rs = rsqrtf(wave_sum(ss, F.lane) * (1.f / D) + EPS);
        asm volatile("s_waitcnt vmcnt(0)" ::: "memory");
#pragma unroll
        for (int j = 0; j < 4; ++j) xr[64 * j] = v[j] * rs * gv[j];
    }
}

__global__ void __launch_bounds__(NT, 2) fwd_kernel(Args args) {
    extern __shared__ __attribute__((aligned(16))) unsigned char lds[];
    Frame F;
    F.lds = (LAS unsigned char*)lds;
    F.tid = 0; F.lane = 0; F.wave = __builtin_amdgcn_readfirstlane((int)threadIdx.x >> 6);
    F.G = gridDim.x; { const int bx = blockIdx.x; F.vcu = (F.G % 8 == 0) ? (bx % 8) * (F.G / 8) + bx / 8 : bx; }
    volatile LAS unsigned* MISC = (volatile LAS unsigned*)(F.lds + MISC_OFF);
    for (int u = threadIdx.x; u < (LDS_BYTES - LDSCTL_OFF) / 4; u += NT) ((LAS unsigned*)(F.lds + LDSCTL_OFF))[u] = 0u;
    __syncthreads();
    XcdBarrier bar; bar.bar = (unsigned*)(args.ws + WS_CTL) + CW_BAR; bar.x = 0; bar.st = nullptr;
    if (MK_SINGLE) bar = xcd_barrier_post((unsigned*)(args.ws + WS_CTL) + CW_BAR, MISC + 8);
    const int lo = args.ph_lo, hi = args.ph_hi;
#define IN(k) (lo <= (k) && (k) < hi)
#define OPQ_BX ({ int bx_ = (int)blockIdx.x; asm volatile("" : "+s"(bx_)); bx_; })
#define PF Frame Fp = F; { int t_ = threadIdx.x; asm volatile("" : "+v"(t_), "+s"(Fp.vcu), "+s"(Fp.wave), "+s"(Fp.G)); Fp.tid = t_; Fp.lane = t_ & 63; }
#define SEAM(k) do { if (MK_SINGLE && IN(k) && IN((k) + 1)) { XcdBarrier b2_ = bar; asm volatile("" : "+s"(b2_.bar));     \
        xcd_barrier(b2_); if (PROBE == 50) xcd_barrier(b2_); } } while (0)

    if (IN(0)) { if (PROBE == 99) { PF; p0_prologue(Fp); } { PF; p0_prologue(Fp); } SEAM(0); }

    for (int l = 0; l < DEPTH; ++l) {
        const int pb = 1 + l * NPL;
        const int pm0 = (l == DEPTH - 1) ? 8 : 0, rbeg = pm0 * 256;
        if (IN(pb + 0)) { { PF; norm_phase(Fp, l, 0, 0); } { PF; convert_experts(Fp, l); } if (PROBE == 30) { PF; convert_experts(Fp, l); } SEAM(pb + 0); }
        if (IN(pb + 1)) {
            CArgsP ap = kargs(); unsigned char* const ws = ap->ws; bf16* Hb = (bf16*)(ws + WS_H); bf16* PA = (bf16*)(ws + WS_PA); bf16* PG = (bf16*)(ws + WS_PG);
            pg8::Gemm g{Hb, (const bf16*)(ws + WS_WIN) + (size_t)l * NPAD * D, R, NPAD, D, D}; pg8::StaticOrder S; S.init(R, NPAD, F.G, OPQ_BX);
            EpiIn E{PA, PG, (float*)(ws + WS_Z), (const float*)(ws + WS_ROPE), (bf16*)(ws + WS_VT), (bf16*)(ws + WS_NVT)};
            for (int rep = 0; rep < (PROBE == 1 ? 2 : 1); ++rep) pg8::gemm_phase<EpiIn, pg8::StaticOrder, true, true>(F.lds, g, S, E);
            SEAM(pb + 1);
        }
        if (IN(pb + 2)) { { PF; gla_a_phase(Fp, l); } if (PROBE == 2) { PF; gla_a_phase(Fp, l); } { const int nrep = (PROBE == 20 ? 2 : 1) + (kargs()->pad != 0 ? 1 : 0); for (int rep = 0; rep < nrep; ++rep) { PF; na_phase(Fp, l, rep + 1 < nrep, l == DEPTH - 1); } } SEAM(pb + 2); }
        if (IN(pb + 3)) { if (PROBE == 3) { PF; gla_b_phase(Fp, true); } { PF; gla_b_phase(Fp, false); } SEAM(pb + 3); }
        if (IN(pb + 4)) { if (PROBE == 4) { PF; gla_c_phase(Fp, l, true); } { PF; gla_c_phase(Fp, l, false); } SEAM(pb + 4); }
        if (IN(pb + 5)) {
            CArgsP ap = kargs(); unsigned char* const ws = ap->ws; bf16* Hb = (bf16*)(ws + WS_H); bf16* PA = (bf16*)(ws + WS_PA); bf16* PG = (bf16*)(ws + WS_PG);
            pg8::ShiftOrder S; S.init(R - rbeg, D, F.G, OPQ_BX); S.pm0 = pm0;
            { pg8::Gemm g{PA + PA_R, (const bf16*)(ws + WS_WPG) + (size_t)l * D * D, R, D, D, PA_LD}; EpiMergeK E{Hb, PG}; for (int rep = 0; rep < (PROBE == 5 ? 2 : 1); ++rep) pg8::gemm_phase<EpiMergeK, pg8::ShiftOrder, true, true>(F.lds, g, S, E); }
            SEAM(pb + 5);
        }
        if (IN(pb + 6)) {
            CArgsP ap = kargs(); unsigned char* const ws = ap->ws; bf16* Hb = (bf16*)(ws + WS_H);
            pg8::Gemm g{Hb, (const bf16*)(ws + WS_WO) + (size_t)l * D * D, R, D, D, D}; pg8::ShiftOrder S; S.init(R - rbeg, D, F.G, OPQ_BX); S.pm0 = pm0;
            EpiRes E{l == 0 ? ap->in[I_CTX] : (const float*)(ws + WS_XC), ap->in[I_X], (float*)(ws + WS_XC), (bf16*)ap->out, (const float*)(ws + WS_MOD) + (size_t)l * 9 * 6144, l == 0 ? 1 : 0};
            pg8::gemm_phase<EpiRes, pg8::ShiftOrder, true, true>(F.lds, g, S, E);
            SEAM(pb + 6);
        }
        if (IN(pb + 7)) { if (PROBE == 7) { PF; norm_phase(Fp, l, 1, rbeg); } { PF; norm_phase(Fp, l, 1, rbeg); } SEAM(pb + 7); }
        if (IN(pb + 8)) {
            CArgsP ap = kargs(); unsigned char* const ws = ap->ws; bf16* Hb = (bf16*)(ws + WS_H);
            pg8::Gemm g{Hb, (const bf16*)(ws + WS_WS) + (size_t)l * 2048 * D, R, 2048, D, D}; pg8::ShiftOrder S; S.init(R - rbeg, 2048, F.G, OPQ_BX); S.pm0 = pm0;
            EpiB16 E{(bf16*)(ws + WS_SC), 2048};
            for (int rep = 0; rep < (PROBE == 8 ? 2 : 1); ++rep) pg8::gemm_phase<EpiB16, pg8::ShiftOrder, true, true>(F.lds, g, S, E);
            SEAM(pb + 8);
        }
        if (IN(pb + 9)) { if (PROBE == 9) { PF; topk_phase(Fp, rbeg); } { PF; topk_phase(Fp, rbeg); } SEAM(pb + 9); }
        if (IN(pb + 10)) { if (PROBE == 10) { PF; peer1_phase(Fp, rbeg); } { PF; peer1_phase(Fp, rbeg); } SEAM(pb + 10); }
        if (IN(pb + 11)) { if (PROBE == 11) { PF; peer_act_phase(Fp, rbeg); } { PF; peer_act_phase(Fp, rbeg); } SEAM(pb + 11); }
        if (IN(pb + 12)) { if (PROBE == 12) { PF; peer2_phase(Fp, l, true, rbeg); } { PF; peer2_phase(Fp, l, false, rbeg); } SEAM(pb + 12); }
    }
    if (IN(NPHASE - 1)) { PF; final_phase(Fp); }
#undef IN
#undef SEAM
}

extern "C" void kernel_launch(void* const* d_in, const int* in_sizes, int n_in, void* d_out, int out_size, void* d_ws, size_t ws_size, hipStream_t stream) {
    static int grid = 0;
    if (grid == 0) {
        if (n_in != 23 || in_sizes[0] != NLAT * D || out_size != NLAT * D || ws_size < WS_END) { fprintf(stderr, "kernel_launch: unexpected shapes (n_in %d, in0 %d, out %d, ws %zu); nothing launched\n", n_in, n_in > 0 ? in_sizes[0] : -1, out_size, ws_size); grid = -1; return; }
        int dev = 0, cus = 0, per_cu = 0;
        if (hipGetDevice(&dev) != hipSuccess || hipDeviceGetAttribute(&cus, hipDeviceAttributeMultiprocessorCount, dev) != hipSuccess) { grid = -1; return; }
        if (hipFuncSetAttribute((const void*)fwd_kernel, hipFuncAttributeMaxDynamicSharedMemorySize, LDS_BYTES) != hipSuccess) { fprintf(stderr, "kernel_launch: hipFuncSetAttribute failed\n"); grid = -1; return; }
        if (hipOccupancyMaxActiveBlocksPerMultiprocessor(&per_cu, (const void*)fwd_kernel, NT, LDS_BYTES) != hipSuccess || per_cu < 1) { fprintf(stderr, "kernel_launch: occupancy query says %d blocks per CU\n", per_cu); }
        (void)hipGetLastError();
        grid = cus;
    }
    if (grid < 0) return;
    if (hipMemsetAsync((char*)d_ws + WS_CTL, 0, CTL_ZERO_BYTES, stream) != hipSuccess) return;
    Args a{};
    for (int i = 0; i < 23; ++i) a.in[i] = (const float*)d_in[i];
    a.out = (float*)d_out; a.ws = (unsigned char*)d_ws; a.pad = 0;
    if (MK_SINGLE) {
        a.ph_lo = 0; a.ph_hi = NPHASE; a.li = 0;
        hipLaunchKernelGGL(fwd_kernel, dim3(grid), dim3(NT), LDS_BYTES, stream, a);
    } else {
        for (int p = 0; p < NPHASE; ++p) { a.ph_lo = p; a.ph_hi = p + 1; a.li = p; hipLaunchKernelGGL(fwd_kernel, dim3(grid), dim3(NT), LDS_BYTES, stream, a); }
    }
}
```

```cpp
#include <hip/hip_runtime.h>
#include <cstdio>
#include <cstdint>

#ifndef PROBE
#define PROBE 0
#endif
#ifndef MK_SINGLE
#define MK_SINGLE 1
#endif

namespace pg8 {
#define PG8_LAS __attribute__((address_space(3)))
typedef unsigned short bf16_t;
typedef short bf16x8 __attribute__((ext_vector_type(8)));
typedef float f32x4 __attribute__((ext_vector_type(4)));
typedef unsigned u32x4 __attribute__((ext_vector_type(4)));
constexpr int BM = 256, BK = 64, HALF = 128, HTB = HALF * BK * 2, STAGE_BYTES = 8 * HTB, NXCD = 8, WGM = 8;

__host__ __device__ __forceinline__ int lds_byte(int r, int c) { const int st = (r >> 4) * 2 + (c >> 5), rr = r & 15, cc = c & 31, ob = rr * 64 + cc * 2; return st * 1024 + (ob ^ (((ob >> 9) & 1) << 5)); }
__host__ __device__ __forceinline__ void stage_rc(int b, int& R, int& C) { const int st = b / 1024, sb = b % 1024, swz = sb ^ (((sb >> 9) & 1) << 5); R = (st >> 1) * 16 + swz / 64; C = (st & 1) * 32 + (swz % 64) / 2; }
__host__ __device__ __forceinline__ int perm32(int rho) { const int n = rho >> 4, i = rho & 15; return 8 * (i >> 2) + 4 * n + (i & 3); }

struct Unit { int pm, pn; };
struct Gemm { const bf16_t* A; const bf16_t* Bt; int M, N, K, lda; };

struct StaticOrder {
    int nM, nN, nwg, G, c;
    __host__ __device__ void init(int M, int N, int G_, int c_) { nM = M / BM; nN = N / BM; nwg = nM * nN; G = G_; c = c_; }
    __host__ __device__ bool next(int i, Unit& u) const {
        const long L = (long)i * G + c; if (L >= nwg) return false;
        int wgid = (int)L; { const int q = nwg / NXCD, r = nwg % NXCD, xcd = wgid % NXCD, off = wgid / NXCD; wgid = (xcd < r ? xcd * (q + 1) : r * (q + 1) + (xcd - r) * q) + off; }
        const int nig = WGM * nN, gid = wgid / nig, fm = gid * WGM, gsz = (nM - fm) < WGM ? (nM - fm) : WGM;
        u.pm = fm + ((wgid % nig) % gsz); u.pn = (wgid % nig) / gsz; return true;
    }
    __device__ __forceinline__ void a_ready(const Unit&) const {}
    __device__ __forceinline__ void done(const Unit&) const {}
};
struct ShiftOrder : StaticOrder { int pm0; __host__ __device__ bool next(int i, Unit& u) const { if (!StaticOrder::next(i, u)) return false; u.pm += pm0; return true; } };

__device__ __forceinline__ unsigned cvt_pk_bf16(float lo, float hi) { unsigned r; asm volatile("v_cvt_pk_bf16_f32 %0, %1, %2" : "=v"(r) : "v"(lo), "v"(hi)); return r; }

template <class Epi, class Sched, bool ALIGN_EPI = false, bool SP2 = false>
__device__ __forceinline__ void gemm_phase(PG8_LAS unsigned char* lds, const Gemm g, const Sched& S, const Epi& E) {
    int tid_ = threadIdx.x; asm volatile("" : "+v"(tid_));
    const int tid = tid_, wid = __builtin_amdgcn_readfirstlane(tid >> 6), lane = tid & 63, wr = wid >> 2, wc = wid & 3, fr = lane & 15, fq = lane >> 4;
    const int K = g.K, nt = K / BK, lda = g.lda;
    unsigned voffA[2], voffB[2];
#pragma unroll
    for (int i = 0; i < 2; ++i) { int R, C; stage_rc(tid * 16 + i * 8192, R, C); const int Rb = Epi::PERM ? ((R & ~31) + perm32(R & 31)) : R;
        voffA[i] = (unsigned)(R * lda + C) * 2u; voffB[i] = (unsigned)(Rb * K + C) * 2u; }
    const size_t kstep = (size_t)(BK * 2);
    const size_t hstepA = (size_t)HALF * lda * 2, hstepB = (size_t)HALF * K * 2;
    const size_t tstepA = 2 * hstepA, tstepB = 2 * hstepB;
    const unsigned ldsw = (unsigned)wid * 1024u;
    const int aoff = lds_byte(wr * 64 + fr, fq * 8), boff = lds_byte(wc * 32 + fr, fq * 8);
#define PG8_SA(b, h) (((b) * 2 + (h)) * HTB)
#define PG8_SB(b, h) ((4 + (b) * 2 + (h)) * HTB)
#define PG8_STAGE(bufoff, gbase, voff) do { _Pragma("unroll") for (int _i = 0; _i < 2; ++_i) \
        __builtin_amdgcn_global_load_lds((const unsigned*)((const char*)(gbase) + (voff)[_i]), (PG8_LAS unsigned*)(lds + (bufoff) + ldsw + _i * 8192), 16, 0, 0); } while (0)
#define PG8_LDA(dst, b, h) do { _Pragma("unroll") for (int m = 0; m < 4; ++m) _Pragma("unroll") for (int k = 0; k < 2; ++k) dst[m][k] = *(const PG8_LAS bf16x8*)(lds + PG8_SA(b, h) + aoff + m * 2048 + k * 1024); } while (0)
#define PG8_LDB(dst, b, h) do { _Pragma("unroll") for (int n = 0; n < 2; ++n) _Pragma("unroll") for (int k = 0; k < 2; ++k) dst[n][k] = *(const PG8_LAS bf16x8*)(lds + PG8_SB(b, h) + boff + n * 2048 + k * 1024); } while (0)
#define PG8_MMA(ai, bj, At, Bt) do { __builtin_amdgcn_s_setprio(1); _Pragma("unroll") for (int m = 0; m < 4; ++m) _Pragma("unroll") for (int n = 0; n < 2; ++n) _Pragma("unroll") for (int k = 0; k < 2; ++k) \
        acc[ai][bj][m][n] = __builtin_amdgcn_mfma_f32_16x16x32_bf16(Bt[n][k], At[m][k], acc[ai][bj][m][n], 0, 0, 0); __builtin_amdgcn_s_setprio(0); } while (0)
#define PG8_WAIT_V(n) asm volatile("s_waitcnt vmcnt(" #n ")" ::: "memory")
#define PG8_WAIT_L(n) asm volatile("s_waitcnt lgkmcnt(" #n ")" ::: "memory")
#define PG8_BAR __builtin_amdgcn_s_barrier()
#define PG8_SCHED __builtin_amdgcn_sched_barrier(0)
    Unit cur, nxt; int ui = 0;
    if (!S.next(0, cur)) return;
    f32x4 acc[2][2][4][2];
#pragma unroll
    for (int a = 0; a < 2; ++a)
#pragma unroll
        for (int b = 0; b < 2; ++b)
#pragma unroll
            for (int m = 0; m < 4; ++m)
#pragma unroll
                for (int n = 0; n < 2; ++n) acc[a][b][m][n] = (f32x4){0.f, 0.f, 0.f, 0.f};
    bf16x8 At[4][2], B0[2][2], B1[2][2];
    const char* cA = (const char*)g.A + (size_t)cur.pm * tstepA; const char* cB = (const char*)g.Bt + (size_t)cur.pn * tstepB;
    S.a_ready(cur);
    if constexpr (SP2) {
        PG8_STAGE(PG8_SB(0, 0), cB, voffB); PG8_STAGE(PG8_SB(0, 1), cB + hstepB, voffB); PG8_STAGE(PG8_SA(0, 0), cA, voffA); PG8_STAGE(PG8_SA(0, 1), cA + hstepA, voffA);
        if (wr == 1) PG8_BAR;
        PG8_WAIT_V(2); PG8_BAR;
        PG8_STAGE(PG8_SB(1, 0), cB + kstep, voffB); PG8_STAGE(PG8_SA(1, 0), cA + kstep, voffA); PG8_STAGE(PG8_SB(1, 1), cB + hstepB + kstep, voffB);
        PG8_WAIT_V(6); PG8_BAR;
    } else {
        PG8_STAGE(PG8_SB(0, 0), cB, voffB); PG8_STAGE(PG8_SA(0, 0), cA, voffA); PG8_STAGE(PG8_SB(0, 1), cB + hstepB, voffB); PG8_STAGE(PG8_SA(0, 1), cA + hstepA, voffA);
        if (wr == 1) PG8_BAR;
        PG8_WAIT_V(4); PG8_BAR;
        PG8_STAGE(PG8_SB(1, 0), cB + kstep, voffB); PG8_STAGE(PG8_SA(1, 0), cA + kstep, voffA); PG8_STAGE(PG8_SB(1, 1), cB + hstepB + kstep, voffB);
        PG8_WAIT_V(6); PG8_BAR;
    }
    for (;;) {
        const bool has_next = S.next(ui + 1, nxt);
        const char* nA = has_next ? (const char*)g.A + (size_t)nxt.pm * tstepA : cA; const char* nB = has_next ? (const char*)g.Bt + (size_t)nxt.pn * tstepB : cB;
        for (int t = 0; t < nt; t += 2) {
            const bool last = (t == nt - 2);
            const char* a1 = cA + (size_t)(t + 1) * kstep;
            const char* a2 = last ? nA : cA + (size_t)(t + 2) * kstep; const char* b2 = last ? nB : cB + (size_t)(t + 2) * kstep;
            const char* a3 = a2 + kstep; const char* b3 = b2 + kstep;
            if (last && has_next) S.a_ready(nxt);
            if constexpr (Epi::HAS_MID) { if (t == nt / 2) E.mid(acc, cur, wr, wc, fr, fq); }
            if constexpr (SP2) {
            PG8_LDB(B0, 0, 0); PG8_LDB(B1, 0, 1); PG8_SCHED; PG8_LDA(At, 0, 0); PG8_STAGE(PG8_SA(1, 1), a1 + hstepA, voffA);
            PG8_WAIT_V(8); PG8_WAIT_L(0); PG8_BAR; PG8_MMA(0, 0, At, B0); PG8_MMA(0, 1, At, B1); PG8_BAR; PG8_SCHED;
            PG8_LDA(At, 0, 1); PG8_STAGE(PG8_SB(0, 0), b2, voffB); PG8_STAGE(PG8_SB(0, 1), b2 + hstepB, voffB); PG8_STAGE(PG8_SA(0, 0), a2, voffA);
            PG8_WAIT_V(8); PG8_WAIT_L(0); PG8_BAR; PG8_MMA(1, 0, At, B0); PG8_MMA(1, 1, At, B1); PG8_BAR; PG8_SCHED;
            PG8_LDB(B0, 1, 0); PG8_LDB(B1, 1, 1); PG8_SCHED; PG8_LDA(At, 1, 0); PG8_STAGE(PG8_SA(0, 1), a2 + hstepA, voffA);
            PG8_WAIT_V(8); PG8_WAIT_L(0); PG8_BAR; PG8_MMA(0, 0, At, B0); PG8_MMA(0, 1, At, B1); PG8_BAR; PG8_SCHED;
            PG8_LDA(At, 1, 1); PG8_STAGE(PG8_SB(1, 0), b3, voffB); PG8_STAGE(PG8_SB(1, 1), b3 + hstepB, voffB); PG8_STAGE(PG8_SA(1, 0), a3, voffA);
            PG8_WAIT_V(8); PG8_WAIT_L(0); PG8_BAR; PG8_MMA(1, 0, At, B0); PG8_MMA(1, 1, At, B1); PG8_BAR; PG8_SCHED;
            } else {
            PG8_LDB(B0, 0, 0); PG8_SCHED; PG8_LDA(At, 0, 0); PG8_STAGE(PG8_SA(1, 1), a1 + hstepA, voffA);
            PG8_WAIT_L(8); PG8_BAR; PG8_WAIT_L(0); PG8_MMA(0, 0, At, B0); PG8_BAR; PG8_SCHED;
            PG8_LDB(B1, 0, 1); PG8_STAGE(PG8_SB(0, 0), b2, voffB);
            PG8_BAR; PG8_WAIT_L(0); PG8_MMA(0, 1, At, B1); PG8_BAR;
            PG8_LDA(At, 0, 1); PG8_STAGE(PG8_SA(0, 0), a2, voffA);
            PG8_BAR; PG8_WAIT_L(0); PG8_MMA(1, 0, At, B0); PG8_BAR; PG8_SCHED;
            PG8_STAGE(PG8_SB(0, 1), b2 + hstepB, voffB);
            PG8_WAIT_V(6); PG8_BAR; PG8_MMA(1, 1, At, B1); PG8_BAR;
            PG8_LDB(B0, 1, 0); PG8_SCHED; PG8_LDA(At, 1, 0); PG8_STAGE(PG8_SA(0, 1), a2 + hstepA, voffA);
            PG8_WAIT_L(8); PG8_BAR; PG8_WAIT_L(0); PG8_MMA(0, 0, At, B0); PG8_BAR; PG8_SCHED;
            PG8_LDB(B1, 1, 1); PG8_STAGE(PG8_SB(1, 0), b3, voffB);
            PG8_BAR; PG8_WAIT_L(0); PG8_MMA(0, 1, At, B1); PG8_BAR;
            PG8_LDA(At, 1, 1); PG8_STAGE(PG8_SA(1, 0), a3, voffA);
            PG8_BAR; PG8_WAIT_L(0); PG8_MMA(1, 0, At, B0); PG8_BAR; PG8_SCHED;
            PG8_STAGE(PG8_SB(1, 1), b3 + hstepB, voffB);
            PG8_WAIT_V(6); PG8_BAR; PG8_MMA(1, 1, At, B1); PG8_BAR;
            }
        }
        if constexpr (ALIGN_EPI) { if (wr == 0) PG8_BAR; }
        E(acc, cur, wr, wc, fr, fq); S.done(cur);
        if (!has_next) break;
#pragma unroll
        for (int a = 0; a < 2; ++a)
#pragma unroll
            for (int b = 0; b < 2; ++b)
#pragma unroll
                for (int m = 0; m < 4; ++m)
#pragma unroll
                    for (int n = 0; n < 2; ++n) acc[a][b][m][n] = (f32x4){0.f, 0.f, 0.f, 0.f};
        cur = nxt; cA = nA; cB = nB; ++ui;
        if constexpr (ALIGN_EPI) { if (wr == 1) PG8_BAR; }
    }
    PG8_WAIT_V(0);
    if constexpr (!ALIGN_EPI) { if (wr == 0) PG8_BAR; }
    PG8_BAR;
#undef PG8_SA
#undef PG8_SB
#undef PG8_STAGE
#undef PG8_LDA
#undef PG8_LDB
#undef PG8_MMA
#undef PG8_WAIT_V
#undef PG8_WAIT_L
#undef PG8_BAR
#undef PG8_SCHED
}
}

constexpr int D = 1024, BATCH = 8, SEQ = 8192, DEPTH = 4, CTXL = 256, GRIDW = 64;
constexpr int NCTX = BATCH * CTXL;
constexpr int NLAT = BATCH * SEQ;
constexpr int R = NCTX + NLAT;
constexpr int IN_COLS = 5152, NPAD = 5376;
constexpr int PA_LD = 2048, PG_LD = 2048;
constexpr int PA_Q = 0, PA_K = 256, PA_R = 512, PA_NQ = 1024, PA_NK = 1536;
constexpr int NCHUNK = 132;
constexpr int NEXP = 16384;
constexpr float EPS = 1e-6f;
constexpr int NWAVES = 8, NT = 512;
constexpr int NPL = 13;
constexpr int NPHASE = 1 + DEPTH * NPL + 1;

constexpr size_t MiB = 1u << 20;
constexpr size_t WS_CTL = 0, CTL_ZERO_BYTES = 2 * MiB;
constexpr size_t WS_MOD = 1 * MiB;
constexpr size_t WS_ROPE = 2 * MiB;
constexpr size_t WS_WIN = 3 * MiB;
constexpr size_t WS_WPG = 45 * MiB, WS_WPN = 49 * MiB;
constexpr size_t WS_WO = 53 * MiB;
constexpr size_t WS_WS = 61 * MiB;
constexpr size_t WS_XC = 77 * MiB;
constexpr size_t WS_Z = 85 * MiB;
constexpr size_t WS_EU = 94 * MiB, WS_EV = 110 * MiB;
constexpr size_t WS_SU = 126 * MiB, WS_SV = WS_SU + 65536, WS_SX = WS_SV + 65536;
constexpr size_t WS_H8 = 884 * MiB;
constexpr size_t WS_PART = 290 * MiB;
constexpr size_t WS_ACT = 554 * MiB;
constexpr size_t WS_H = 158 * MiB;
constexpr size_t WS_PA = 290 * MiB;
constexpr size_t WS_VT = 554 * MiB, WS_NVT = 620 * MiB;
constexpr size_t WS_DEC = 950 * MiB;
constexpr size_t WS_PG = 686 * MiB;
constexpr size_t WS_SC = 290 * MiB;
constexpr size_t WS_EI = 818 * MiB, WS_EG = 851 * MiB;
constexpr size_t WS_END = 953 * MiB;
static_assert(WS_SC + (size_t)R * 2048 * 4 <= WS_EI && WS_EG + (size_t)R * 128 * 4 <= WS_DEC && WS_PG + (size_t)R * PG_LD * 2 <= WS_DEC && WS_DEC + 64 * 132 * 64 * 4 <= WS_END, "ws map");
static_assert(WS_H + (size_t)R * 1024 * 2 <= WS_PA && WS_PA + (size_t)R * PA_LD * 2 <= WS_VT && WS_VT + (size_t)R * 512 * 2 <= WS_NVT && WS_NVT + (size_t)R * 512 * 2 <= WS_PG && WS_Z + (size_t)R * 32 * 4 <= WS_EU, "ws map");
constexpr int CW_BAR = 4096;

constexpr int RING_BYTES = 131072, LDSCTL_OFF = RING_BYTES, MISC_OFF = LDSCTL_OFF + 320, LDS_BYTES = 147456;

#define GAS __attribute__((address_space(1)))
#define LAS __attribute__((address_space(3)))
typedef unsigned short bf16;
typedef unsigned v4u __attribute__((ext_vector_type(4)));
typedef unsigned v2u __attribute__((ext_vector_type(2)));
typedef int v4i __attribute__((ext_vector_type(4)));
typedef float f32x4 __attribute__((ext_vector_type(4)));
typedef __bf16 bf16x2_t __attribute__((ext_vector_type(2)));
#define LDS_WAIT() asm volatile("s_waitcnt lgkmcnt(0)" ::: "memory")
#define VM_WAIT() asm volatile("s_waitcnt vmcnt(0)" ::: "memory")
__device__ __forceinline__ unsigned f2bf(float f) { unsigned u = __builtin_bit_cast(unsigned, f); return (u + 0x7fffu + ((u >> 16) & 1u)) >> 16; }
__device__ __forceinline__ unsigned pk2(float lo, float hi) { return f2bf(lo) | (f2bf(hi) << 16); }
__device__ __forceinline__ float bflo(unsigned w) { return __builtin_bit_cast(float, w << 16); }
__device__ __forceinline__ float bfhi(unsigned w) { return __builtin_bit_cast(float, w & 0xffff0000u); }
__device__ __forceinline__ float bf1(bf16 h) { return __builtin_bit_cast(float, ((unsigned)h) << 16); }
__device__ __forceinline__ float dot2(unsigned a, unsigned b, float acc) { return __builtin_amdgcn_fdot2_f32_bf16(__builtin_bit_cast(bf16x2_t, a), __builtin_bit_cast(bf16x2_t, b), acc, false); }
__device__ __forceinline__ float shx(float v, int mask, int lane) { return __builtin_bit_cast(float, __builtin_amdgcn_ds_bpermute((lane ^ mask) << 2, __builtin_bit_cast(int, v))); }
__device__ __forceinline__ float wave_sum(float v, int lane) {
#pragma unroll
    for (int o = 1; o < 64; o <<= 1) v += shx(v, o, lane);
    return v;
}
__device__ __forceinline__ float wave_max(float v, int lane) {
#pragma unroll
    for (int o = 1; o < 64; o <<= 1) v = fmaxf(v, shx(v, o, lane));
    return v;
}
__device__ __forceinline__ float sigmoidf_(float x) { return __builtin_amdgcn_rcpf(1.f + __expf(-x)); }

#define XB_TMO      128
#define XB_XCNT(j)  (256  + 64 * (j))
#define XB_XSUB(j)  (1280 + 64 * (j))
#define XB_XGEN(j)  (2304 + 64 * (j))
#define XB_TOP      3328
#define XB_TOPGEN   3392
#define XCD_BAR_WORDS 3456
#define XB_SPIN_CAP (1u << 18)
__device__ __forceinline__ unsigned xb_ld(unsigned* p)              { return __hip_atomic_load(p, __ATOMIC_RELAXED, __HIP_MEMORY_SCOPE_AGENT); }
__device__ __forceinline__ unsigned xb_add(unsigned* p, unsigned v) { return __hip_atomic_fetch_add(p, v, __ATOMIC_RELAXED, __HIP_MEMORY_SCOPE_AGENT); }
__device__ __forceinline__ unsigned xb_xcc_id() { return (unsigned)__builtin_amdgcn_s_getreg((3 << 11) | 20) & 0xFu; }
#define XB_SPIN(cond, bar) do { unsigned _sp = 0; while (cond) { __builtin_amdgcn_s_sleep(1); \
    if ((++_sp & 255u) == 0u) { if (xb_ld(&(bar)[XB_TMO])) break; if (_sp > XB_SPIN_CAP) { atomicAdd(&(bar)[XB_TMO], 1u); break; } } } } while (0)
struct XcdBarrier { unsigned* bar; unsigned x; volatile LAS unsigned* st; };
__device__ __forceinline__ XcdBarrier xcd_barrier_post(unsigned* bar, volatile LAS unsigned* st) {
    XcdBarrier b; b.bar = bar; b.x = xb_xcc_id(); b.st = st;
    if (threadIdx.x == 0) (void)xb_add(&bar[XB_XCNT(b.x)], 1u);
    return b;
}
__device__ __forceinline__ void xcd_barrier_complete(unsigned* bar, unsigned x, unsigned& nloc, unsigned& nx) {
    const unsigned G = gridDim.x * gridDim.y * gridDim.z;
    unsigned sum, cnt, mine, sp = 0u;
    for (;;) {
        sum = 0u; cnt = 0u; mine = 0u;
#pragma unroll
        for (unsigned j = 0; j < 16; ++j) { const unsigned c = xb_ld(&bar[XB_XCNT(j)]); sum += c; cnt += (c > 0u) ? 1u : 0u; mine = (j == x) ? c : mine; }
        if (sum == G) break;
        __builtin_amdgcn_s_sleep(1);
        if ((++sp & 255u) == 0u) { if (xb_ld(&bar[XB_TMO])) break; if (sp > XB_SPIN_CAP) { atomicAdd(&bar[XB_TMO], 1u); break; } }
    }
    nloc = mine > 0u ? mine : 1u; nx = cnt > 0u ? cnt : 1u;
}
__device__ __forceinline__ void xcd_barrier(const XcdBarrier& b) {
    asm volatile("s_waitcnt vmcnt(0)" ::: "memory");
    __syncthreads();
    int tid0_ = threadIdx.x; asm volatile("" : "+v"(tid0_));
    if (tid0_ == 0) {
        unsigned* bar = b.bar;
        __builtin_amdgcn_s_waitcnt(0);
        unsigned nloc = b.st[0], nx = b.st[1];
        if (nloc == 0u) { xcd_barrier_complete(bar, b.x, nloc, nx); b.st[0] = nloc; b.st[1] = nx; }
        const unsigned old = xb_add(&bar[XB_XSUB(b.x)], 1u);
        const unsigned gen = old / nloc;
        if (old + 1u == (gen + 1u) * nloc) {
            __builtin_amdgcn_fence(__ATOMIC_RELEASE, "agent");
            asm volatile("s_waitcnt vmcnt(0)" ::: "memory");
            const unsigned og = xb_add(&bar[XB_TOP], 1u);
            const unsigned tg = og / nx;
            if (og + 1u == (tg + 1u) * nx) xb_add(&bar[XB_TOPGEN], 1u);
            else XB_SPIN(xb_ld(&bar[XB_TOPGEN]) == tg, bar);
            __builtin_amdgcn_fence(__ATOMIC_ACQUIRE, "agent");
            xb_add(&bar[XB_XGEN(b.x)], 1u);
            asm volatile("s_waitcnt vmcnt(0)" ::: "memory");
        } else {
            XB_SPIN(xb_ld(&bar[XB_XGEN(b.x)]) == gen, bar);
            __builtin_amdgcn_fence(__ATOMIC_ACQUIRE, "agent");
            asm volatile("s_waitcnt vmcnt(0)" ::: "memory");
        }
    }
    __syncthreads();
}

struct Args { const float* in[23]; float* out; unsigned char* ws; int ph_lo, ph_hi, li, pad; };
enum { I_X = 0, I_C, I_CTX, I_CCTX, I_WMOD, I_BMOD, I_GN1, I_WIN, I_WAF, I_BAF, I_WAB, I_BAB, I_GGLA, I_RPB, I_WPG, I_WPN, I_WO, I_GN2, I_WQ, I_SK, I_EU, I_EV, I_GF };

struct Frame {
    LAS unsigned char* lds;
    int tid, lane, wave, vcu, G;
};
typedef const __attribute__((address_space(4))) Args* CArgsP;
__device__ __forceinline__ CArgsP kargs() { CArgsP p = (CArgsP)__builtin_amdgcn_kernarg_segment_ptr(); asm volatile("" : "+s"(p)); return p; }
__device__ __forceinline__ const float* xrow_in(CArgsP a, int r) { return r < NCTX ? a->in[I_CTX] + (size_t)r * D : a->in[I_X] + (size_t)(r - NCTX) * D; }
constexpr int XL_LD = 2048;
__device__ __forceinline__ float* xc_row(CArgsP a, int r) { return (float*)(a->ws + WS_XC) + (size_t)r * D; }
__device__ __forceinline__ bf16* xl_row(CArgsP a, int r) { return (bf16*)a->out + (size_t)(r - NCTX) * XL_LD; }
__device__ __forceinline__ int row_slot(int r) { return r < NCTX ? 8 : ((r - NCTX) >> 13); }

using pg8::f32x4; using pg8::u32x4; using pg8::Unit; using pg8::cvt_pk_bf16;
struct EpiIn {
    static constexpr bool HAS_MID = false, PERM = true;
    bf16* PA; bf16* PG; float* Z; const float* rope; bf16* VT; bf16* NVT;
    __device__ __forceinline__ void operator()(const f32x4 (&acc)[2][2][4][2], const Unit& u, int wr, int wc, int fr, int fq) const {
        const int pn = u.pn, row0 = u.pm * 256 + wr * 64 + fr;
        if (pn == 20) {
            if (wc == 0) {
#pragma unroll
                for (int ai = 0; ai < 2; ++ai)
#pragma unroll
                    for (int m = 0; m < 4; ++m) { float* zp = Z + (size_t)(row0 + ai * 128 + m * 16) * 32 + 8 * fq; *(f32x4*)zp = acc[ai][0][m][0]; *(f32x4*)(zp + 4) = acc[ai][0][m][1]; }
            }
            return;
        }
        if (pn >= 8 && pn < 12) {
            bf16* T = (pn < 10 ? VT : NVT) + (size_t)(((pn - 8) & 1) * 256 + wc * 32 + 8 * fq) * R;
#pragma unroll
            for (int ai = 0; ai < 2; ++ai)
#pragma unroll
                for (int m = 0; m < 4; ++m) {
                    const int row = row0 + ai * 128 + m * 16;
#pragma unroll
                    for (int bj = 0; bj < 2; ++bj) {
                        const f32x4 v0 = acc[ai][bj][m][0], v1 = acc[ai][bj][m][1];
                        bf16* tp = T + (size_t)(bj * 128) * R + row;
                        tp[0 * (size_t)R] = (bf16)f2bf(v0[0]); tp[1 * (size_t)R] = (bf16)f2bf(v0[1]); tp[2 * (size_t)R] = (bf16)f2bf(v0[2]); tp[3 * (size_t)R] = (bf16)f2bf(v0[3]);
                        tp[4 * (size_t)R] = (bf16)f2bf(v1[0]); tp[5 * (size_t)R] = (bf16)f2bf(v1[1]); tp[6 * (size_t)R] = (bf16)f2bf(v1[2]); tp[7 * (size_t)R] = (bf16)f2bf(v1[3]);
                    }
                }
            return;
        }
        bf16* base; int ldc, colt;
        if (pn < 8) { base = PA; ldc = PA_LD; colt = pn * 256; } else { base = PG; ldc = PG_LD; colt = (pn - 12) * 256; }
        const int col0 = colt + wc * 32 + 8 * fq;
        const bool do_rope = (pn < 2) && (u.pm >= 8);
        const float sc = (pn == 0 || pn == 4 || pn == 5) ? 0.125f : 1.f;
#pragma unroll
        for (int ai = 0; ai < 2; ++ai)
#pragma unroll
            for (int m = 0; m < 4; ++m) {
                const int row = row0 + ai * 128 + m * 16;
                bf16* rowp = base + (size_t)row * ldc + col0;
                f32x4 cs[4];
                if (do_rope) { const int t = (row - NCTX) & (SEQ - 1); const int pos = (wc & 1) ? (t & 63) : (t >> 6);
                    const f32x4* cp = (const f32x4*)(rope + (size_t)(pos * 16 + 8 * (fq & 1)) * 2);
                    cs[0] = cp[0]; cs[1] = cp[1]; cs[2] = cp[2]; cs[3] = cp[3]; }
#pragma unroll
                for (int bj = 0; bj < 2; ++bj) {
                    f32x4 v0 = acc[ai][bj][m][0], v1 = acc[ai][bj][m][1];
                    if (do_rope) {
                        float x[8] = {v0[0], v0[1], v0[2], v0[3], v1[0], v1[1], v1[2], v1[3]};
#pragma unroll
                        for (int e = 0; e < 8; ++e) { const float p = shx(x[e], 32, fr + 16 * fq); const float c = cs[e >> 1][(e & 1) * 2], s = cs[e >> 1][(e & 1) * 2 + 1];
                            x[e] = (fq < 2) ? (x[e] * c - p * s) : (p * s + x[e] * c); }
                        v0 = (f32x4){x[0], x[1], x[2], x[3]}; v1 = (f32x4){x[4], x[5], x[6], x[7]};
                    }
                    v0 = v0 * sc; v1 = v1 * sc;
                    u32x4 w; w.x = cvt_pk_bf16(v0[0], v0[1]); w.y = cvt_pk_bf16(v0[2], v0[3]); w.z = cvt_pk_bf16(v1[0], v1[1]); w.w = cvt_pk_bf16(v1[2], v1[3]);
                    *(u32x4*)(rowp + bj * 128) = w;
                }
                asm volatile("" ::: "memory");
            }
    }
};
struct EpiMergeK {
    static constexpr bool HAS_MID = true, PERM = true;
    bf16* MG; const bf16* PG;
    __device__ __forceinline__ void mid(f32x4 (&acc)[2][2][4][2], const Unit& u, int wr, int wc, int fr, int fq) const {
        int row0 = u.pm * 256 + wr * 64 + fr, col0 = u.pn * 256 + wc * 32 + 8 * fq;
        asm volatile("" : "+v"(row0), "+v"(col0));
#pragma unroll
        for (int ai = 0; ai < 2; ++ai)
#pragma unroll
            for (int m = 0; m < 4; ++m) {
                const bf16* gp = PG + (size_t)(row0 + ai * 128 + m * 16) * PG_LD + col0;
#pragma unroll
                for (int bj = 0; bj < 2; ++bj) {
                    const u32x4 g1 = *(const u32x4*)(gp + bj * 128), g2 = *(const u32x4*)(gp + 1024 + bj * 128);
                    const unsigned a1[4] = {g1.x, g1.y, g1.z, g1.w}, a2[4] = {g2.x, g2.y, g2.z, g2.w};
#pragma unroll
                    for (int q = 0; q < 4; ++q) {
                        const float r0 = (1.f + __expf(-bflo(a2[q]))) * __builtin_amdgcn_rcpf(1.f + __expf(-bflo(a1[q])));
                        const float r1 = (1.f + __expf(-bfhi(a2[q]))) * __builtin_amdgcn_rcpf(1.f + __expf(-bfhi(a1[q])));
                        acc[ai][bj][m][q >> 1][(q & 1) * 2] *= r0; acc[ai][bj][m][q >> 1][(q & 1) * 2 + 1] *= r1;
                    }
                }
                asm volatile("" ::: "memory");
            }
    }
    __device__ __forceinline__ void operator()(const f32x4 (&acc)[2][2][4][2], const Unit& u, int wr, int wc, int fr, int fq) const {
        int row0 = u.pm * 256 + wr * 64 + fr, col0 = u.pn * 256 + wc * 32 + 8 * fq;
        asm volatile("" : "+v"(row0), "+v"(col0));
#pragma unroll
        for (int ai = 0; ai < 2; ++ai)
#pragma unroll
            for (int m = 0; m < 4; ++m) {
                const int row = row0 + ai * 128 + m * 16;
#pragma unroll
                for (int bj = 0; bj < 2; ++bj) {
                    const int c = col0 + bj * 128;
                    const u32x4 g = *(const u32x4*)(PG + (size_t)row * PG_LD + 1024 + c);
                    const f32x4 v0 = acc[ai][bj][m][0], v1 = acc[ai][bj][m][1];
                    u32x4 w; w.x = cvt_pk_bf16(sigmoidf_(bflo(g.x)) * v0[0], sigmoidf_(bfhi(g.x)) * v0[1]); w.y = cvt_pk_bf16(sigmoidf_(bflo(g.y)) * v0[2], sigmoidf_(bfhi(g.y)) * v0[3]);
                    w.z = cvt_pk_bf16(sigmoidf_(bflo(g.z)) * v1[0], sigmoidf_(bfhi(g.z)) * v1[1]); w.w = cvt_pk_bf16(sigmoidf_(bflo(g.w)) * v1[2], sigmoidf_(bfhi(g.w)) * v1[3]);
                    *(u32x4*)(MG + (size_t)row * D + c) = w;
                }
                asm volatile("" ::: "memory");
            }
    }
};
struct EpiRes {
    static constexpr bool HAS_MID = false, PERM = true;
    const float* src_c; const float* src_l; float* dst_c; bf16* dst_l; const float* mod; int first;
    __device__ __forceinline__ void operator()(const f32x4 (&acc)[2][2][4][2], const Unit& u, int wr, int wc, int fr, int fq) const {
        const bool isctx = u.pm < 8;
        const int slot = isctx ? 8 : ((u.pm - 8) >> 5);
        int rbase = (isctx ? u.pm * 256 : (u.pm - 8) * 256) + wr * 64 + fr, col0 = u.pn * 256 + wc * 32 + 8 * fq;
        asm volatile("" : "+v"(rbase), "+v"(col0));
        const float* ga = mod + slot * 6144 + 2048;
        f32x4 gv[2][2];
#pragma unroll
        for (int bj = 0; bj < 2; ++bj)
#pragma unroll
            for (int n = 0; n < 2; ++n) gv[bj][n] = *(const f32x4*)(ga + col0 + bj * 128 + 4 * n);
#pragma unroll
        for (int ai = 0; ai < 2; ++ai)
#pragma unroll
            for (int m = 0; m < 4; ++m) {
                const int row = rbase + ai * 128 + m * 16;
#pragma unroll
                for (int bj = 0; bj < 2; ++bj) {
                    const int c = col0 + bj * 128;
                    f32x4 x0, x1;
                    if (isctx || first) { const float* sp = (isctx ? src_c : src_l) + (size_t)row * D + c; x0 = *(const f32x4*)sp; x1 = *(const f32x4*)(sp + 4); }
                    else { const u32x4 w = *(const u32x4*)(dst_l + (size_t)row * XL_LD + c); x0 = (f32x4){bflo(w.x), bfhi(w.x), bflo(w.y), bfhi(w.y)}; x1 = (f32x4){bflo(w.z), bfhi(w.z), bflo(w.w), bfhi(w.w)}; }
                    x0 = x0 + gv[bj][0] * acc[ai][bj][m][0]; x1 = x1 + gv[bj][1] * acc[ai][bj][m][1];
                    if (isctx) { float* dp = dst_c + (size_t)row * D + c; *(f32x4*)dp = x0; *(f32x4*)(dp + 4) = x1; }
                    else { u32x4 w; w.x = cvt_pk_bf16(x0[0], x0[1]); w.y = cvt_pk_bf16(x0[2], x0[3]); w.z = cvt_pk_bf16(x1[0], x1[1]); w.w = cvt_pk_bf16(x1[2], x1[3]); *(u32x4*)(dst_l + (size_t)row * XL_LD + c) = w; }
                }
                asm volatile("" ::: "memory");
            }
    }
};
struct EpiB16 {
    static constexpr bool HAS_MID = false, PERM = true;
    bf16* C; int ldc;
    __device__ __forceinline__ void operator()(const f32x4 (&acc)[2][2][4][2], const Unit& u, int wr, int wc, int fr, int fq) const {
        const int row0 = u.pm * 256 + wr * 64 + fr, col0 = u.pn * 256 + wc * 32 + 8 * fq;
#pragma unroll
        for (int ai = 0; ai < 2; ++ai)
#pragma unroll
            for (int m = 0; m < 4; ++m) { bf16* rowp = C + (size_t)(row0 + ai * 128 + m * 16) * ldc + col0;
#pragma unroll
                for (int bj = 0; bj < 2; ++bj) { const f32x4 v0 = acc[ai][bj][m][0], v1 = acc[ai][bj][m][1];
                    u32x4 w; w.x = pk2(v0[0], v0[1]); w.y = pk2(v0[2], v0[3]); w.z = pk2(v1[0], v1[1]); w.w = pk2(v1[2], v1[3]);
                    *(u32x4*)(rowp + bj * 128) = w; } }
    }
};
__device__ __forceinline__ void p0_transpose_item(const float* W, int K, int N, bf16* WT, int dst_row0, LAS float* scr, int k0, int n0, int lane) {
#pragma unroll 8
    for (int i = 0; i < 32; ++i) { const int kk = 2 * i + (lane >> 5); scr[kk * 33 + (lane & 31)] = W[(size_t)(k0 + kk) * N + n0 + (lane & 31)]; }
    LDS_WAIT(); asm volatile("" ::: "memory");
    const int c = lane & 7;
#pragma unroll
    for (int j = 0; j < 4; ++j) { const int n = (lane >> 3) + 8 * j; const LAS float* s = scr + (8 * c) * 33 + n;
        v4u o; o.x = pk2(s[0 * 33], s[1 * 33]); o.y = pk2(s[2 * 33], s[3 * 33]); o.z = pk2(s[4 * 33], s[5 * 33]); o.w = pk2(s[6 * 33], s[7 * 33]);
        *(v4u*)(WT + (size_t)(dst_row0 + n) * K + k0 + 8 * c) = o; }
    LDS_WAIT(); asm volatile("" ::: "memory");
}
__device__ __forceinline__ int win_map(int n0) {
    if (n0 < 512) return n0;
    if (n0 < 1024) return 2048 + (n0 - 512);
    if (n0 < 1056) return 5120 + (n0 - 1024);
    if (n0 < 1568) return 512 + (n0 - 1056);
    if (n0 < 2080) return 1024 + (n0 - 1568);
    if (n0 < 2592) return 1536 + (n0 - 2080);
    if (n0 < 3104) return 2560 + (n0 - 2592);
    return 3072 + (n0 - 3104);
}

__device__ __forceinline__ void p0_prologue(const Frame& F) {
    CArgsP a = kargs(); unsigned char* const ws = a->ws;
    const int gw = F.vcu * NWAVES + F.wave, NGW = F.G * NWAVES;
    const int gtid = F.vcu * NT + F.tid, GT = F.G * NT;
    {
        LAS float* scr = (LAS float*)(F.lds + F.wave * 16384);
        constexpr int I_IN = 16 * 161, I_P = 8 * 32, I_O = 16 * 32, PER_L = I_IN + 2 * I_P + I_O;
        for (int it = gw; it < DEPTH * PER_L; it += NGW) {
            const int l = it / PER_L; int r = it % PER_L;
            if (r < I_IN) { const int kb = r / 161, nb = r % 161; p0_transpose_item(a->in[I_WIN] + (size_t)l * D * IN_COLS, D, IN_COLS, (bf16*)(ws + WS_WIN) + (size_t)l * NPAD * D, win_map(nb * 32), scr, kb * 64, nb * 32, F.lane); continue; }
            r -= I_IN;
            if (r < I_P) { const int kb = r / 32, nb = r % 32; p0_transpose_item(a->in[I_WPG] + (size_t)l * 512 * D, D, D, (bf16*)(ws + WS_WPG) + (size_t)l * D * D, nb * 32, scr, kb * 64, nb * 32, F.lane); continue; }
            r -= I_P;
            if (r < I_P) { const int kb = r / 32, nb = r % 32; p0_transpose_item(a->in[I_WPN] + (size_t)l * 512 * D, D, D, (bf16*)(ws + WS_WPG) + (size_t)l * D * D + 512, nb * 32, scr, kb * 64, nb * 32, F.lane); continue; }
            r -= I_P;
            { const int kb = r / 32, nb = r % 32; p0_transpose_item(a->in[I_WO] + (size_t)l * D * D, D, D, (bf16*)(ws + WS_WO) + (size_t)l * D * D, nb * 32, scr, kb * 64, nb * 32, F.lane); }
        }
        constexpr int PADV = (NPAD - IN_COLS) * D / 8;
        for (int i = gtid; i < DEPTH * PADV; i += GT) { const int l = i / PADV, j = i % PADV; *((v4u*)((bf16*)(ws + WS_WIN) + ((size_t)l * NPAD + IN_COLS) * D) + j) = (v4u){0u, 0u, 0u, 0u}; }
    }
    __syncthreads();
    if (gtid < 128 * 16) { const int pos = gtid >> 4, j = gtid & 15; const float freq = powf(10000.f, -(float)j / 16.f); const float ang = (float)pos * freq;
        float* cs = (float*)(ws + WS_ROPE); cs[2 * gtid] = cosf(ang); cs[2 * gtid + 1] = sinf(ang); }
    {
        LAS float* LSK = (LAS float*)F.lds;
        LAS float* LQ = (LAS float*)(F.lds + 128 * 132 * 4);
        for (int unit = F.vcu; unit < DEPTH * 16 * 16; unit += F.G) {
            const int l = unit >> 8, hp = (unit >> 4) & 15, d0 = (unit & 15) * 64;
            const float* sk = a->in[I_SK] + ((size_t)l * 16 + hp) * 16384;
            const float* wq = a->in[I_WQ] + (size_t)l * D * 2048 + hp * 128;
            __syncthreads();
            for (int i = F.tid; i < 16384; i += NT) LSK[(i >> 7) * 132 + (i & 127)] = sk[i];
            for (int i = F.tid; i < 8192; i += NT) LQ[(i >> 7) * 132 + (i & 127)] = wq[(size_t)(d0 + (i >> 7)) * 2048 + (i & 127)];
            __syncthreads();
            const int dd = F.tid & 63, kg = F.tid >> 6;
            float acc[16];
#pragma unroll
            for (int k = 0; k < 16; ++k) acc[k] = 0.f;
            for (int j = 0; j < 128; j += 4) {
                const f32x4 q = *(const LAS f32x4*)(LQ + dd * 132 + j);
#pragma unroll
                for (int k = 0; k < 16; ++k) { const f32x4 s = *(const LAS f32x4*)(LSK + (kg * 16 + k) * 132 + j); acc[k] += q[0] * s[0] + q[1] * s[1] + q[2] * s[2] + q[3] * s[3]; }
            }
            bf16* o = (bf16*)(ws + WS_WS) + ((size_t)l * 2048 + hp * 128 + kg * 16) * D + d0 + dd;
#pragma unroll
            for (int k = 0; k < 16; ++k) o[(size_t)k * D] = (bf16)f2bf(acc[k]);
        }
    }
    __syncthreads();
    {
        LAS float* ca = (LAS float*)F.lds;
        LAS float* red = (LAS float*)(F.lds + 9 * D * 4);
        for (int i = F.tid; i < 9 * D; i += NT) { const float v = i < 8 * D ? a->in[I_C][i] : a->in[I_CCTX][i - 8 * D]; ca[i] = v / (1.f + __expf(-v)); }
        __syncthreads();
        float* MOD = (float*)(ws + WS_MOD);
        for (int unit = F.vcu; unit < DEPTH * 96; unit += F.G) {
            const int l = unit / 96, cb = unit % 96, dc = F.tid >> 6;
            const int col = cb * 64 + (F.tid & 63);
            const float* w = a->in[I_WMOD] + ((size_t)l * D + dc * 128) * 6144 + col;
            float acc[9];
#pragma unroll
            for (int b = 0; b < 9; ++b) acc[b] = 0.f;
#pragma unroll 8
            for (int d = 0; d < 128; ++d) { const float wv = w[(size_t)d * 6144];
#pragma unroll
                for (int b = 0; b < 9; ++b) acc[b] += ca[b * D + dc * 128 + d] * wv; }
#pragma unroll
            for (int b = 0; b < 9; ++b) red[(dc * 9 + b) * 64 + (F.tid & 63)] = acc[b];
            __syncthreads();
            for (int i = F.tid; i < 9 * 64; i += NT) { const int b = i >> 6, c = i & 63; float sum = a->in[I_BMOD][l * 6144 + cb * 64 + c];
#pragma unroll
                for (int k = 0; k < 8; ++k) sum += red[(k * 9 + b) * 64 + c];
                MOD[((size_t)l * 9 + b) * 6144 + cb * 64 + c] = sum; }
            __syncthreads();
        }
    }
    __syncthreads();
}

__device__ __forceinline__ unsigned pk4_fp8(float a, float b, float c, float d) { int p = __builtin_amdgcn_cvt_pk_fp8_f32(a, b, 0, false); p = __builtin_amdgcn_cvt_pk_fp8_f32(c, d, p, true); return (unsigned)p; }
__device__ __forceinline__ void convert_row_fp8(const float* src, unsigned char* dst_tab, float* scale_out, int e, int lane) {
    const f32x4* sp = (const f32x4*)(src + (size_t)e * D) + 4 * lane;
    const f32x4 a0 = sp[0], a1 = sp[1], a2 = sp[2], a3 = sp[3];
    float mx = fmaxf(fmaxf(fmaxf(fabsf(a0[0]), fabsf(a0[1])), fmaxf(fabsf(a0[2]), fabsf(a0[3]))), fmaxf(fmaxf(fabsf(a1[0]), fabsf(a1[1])), fmaxf(fabsf(a1[2]), fabsf(a1[3]))));
    mx = fmaxf(mx, fmaxf(fmaxf(fmaxf(fabsf(a2[0]), fabsf(a2[1])), fmaxf(fabsf(a2[2]), fabsf(a2[3]))), fmaxf(fmaxf(fabsf(a3[0]), fabsf(a3[1])), fmaxf(fabsf(a3[2]), fabsf(a3[3])))));
    mx = fmaxf(wave_max(mx, lane), 1e-30f);
    const float sc = 256.f / mx;
    const v4u w = (v4u){pk4_fp8(a0[0] * sc, a0[1] * sc, a0[2] * sc, a0[3] * sc), pk4_fp8(a1[0] * sc, a1[1] * sc, a1[2] * sc, a1[3] * sc), pk4_fp8(a2[0] * sc, a2[1] * sc, a2[2] * sc, a2[3] * sc), pk4_fp8(a3[0] * sc, a3[1] * sc, a3[2] * sc, a3[3] * sc)};
    *(v4u*)(dst_tab + ((size_t)(lane >> 3) * NEXP + e) * 128 + 16 * (lane & 7)) = w;
    if (lane == 0) scale_out[e] = mx * (1.f / 256.f);
}
__device__ __forceinline__ void convert_experts(const Frame& F, int layer) {
    CArgsP a = kargs(); unsigned char* const ws = a->ws;
    const int gw = F.vcu * NWAVES + F.wave, NGW = F.G * NWAVES;
    const float* su = a->in[I_EU] + (size_t)layer * NEXP * D; const float* sv = a->in[I_EV] + (size_t)layer * NEXP * D;
    for (int e = gw; e < NEXP; e += NGW) { convert_row_fp8(su, ws + WS_EU, (float*)(ws + WS_SU), e, F.lane); convert_row_fp8(sv, ws + WS_EV, (float*)(ws + WS_SV), e, F.lane); }
}

__device__ __forceinline__ void norm_phase(const Frame& F, int layer, int which, int rbeg) {
    CArgsP a = kargs(); unsigned char* const ws = a->ws;
    const int gw = F.vcu * NWAVES + F.wave, NGW = F.G * NWAVES;
    const float* g = (which ? a->in[I_GN2] : a->in[I_GN1]) + layer * D;
    const float* MOD = (const float*)(ws + WS_MOD) + (size_t)layer * 9 * 6144 + (which ? 3072 : 0);
    bf16* H = (bf16*)(ws + WS_H);
    f32x4 gv[4];
#pragma unroll
    for (int j = 0; j < 4; ++j) gv[j] = *((const f32x4*)g + F.lane + 64 * j);
    for (int r = rbeg + gw; r < R; r += NGW) {
        const float* sh = MOD + row_slot(r) * 6144; const float* sc = sh + D;
        f32x4 v[4]; float ss = 0.f;
        if ((which == 0 && layer == 0) || r < NCTX) {
            const float* xr = (which == 0 && layer == 0) ? xrow_in(a, r) : xc_row(a, r);
#pragma unroll
            for (int j = 0; j < 4; ++j) v[j] = *((const GAS f32x4*)xr + F.lane + 64 * j);
        } else {
            const v2u* xb = (const v2u*)xl_row(a, r) + F.lane;
#pragma unroll
            for (int j = 0; j < 4; ++j) { const v2u w = xb[64 * j]; v[j] = (f32x4){bflo(w.x), bfhi(w.x), bflo(w.y), bfhi(w.y)}; }
        }
#pragma unroll
        for (int j = 0; j < 4; ++j) ss += (v[j][0] * v[j][0] + v[j][1] * v[j][1]) + (v[j][2] * v[j][2] + v[j][3] * v[j][3]);
        const float rs = rsqrtf(wave_sum(ss, F.lane) * (1.f / D) + EPS);
        unsigned long long* o8 = (unsigned long long*)(H + (size_t)r * D) + F.lane;
        float mx = 0.f;
#pragma unroll
        for (int j = 0; j < 4; ++j) {
            const f32x4 s1 = *((const f32x4*)sc + F.lane + 64 * j), s0 = *((const f32x4*)sh + F.lane + 64 * j);
            const f32x4 y = v[j] * rs * gv[j] * (s1 + 1.f) + s0;
            o8[64 * j] = (unsigned long long)pk2(y[0], y[1]) | ((unsigned long long)pk2(y[2], y[3]) << 32);
            v[j] = y; mx = fmaxf(mx, fmaxf(fmaxf(fabsf(y[0]), fabsf(y[1])), fmaxf(fabsf(y[2]), fabsf(y[3]))));
        }
        if (which) {
            mx = fmaxf(wave_max(mx, F.lane), 1e-30f); const float q8 = 256.f / mx;
            unsigned* h8 = (unsigned*)(ws + WS_H8 + (size_t)r * D) + F.lane;
#pragma unroll
            for (int j = 0; j < 4; ++j) h8[64 * j] = pk4_fp8(v[j][0] * q8, v[j][1] * q8, v[j][2] * q8, v[j][3] * q8);
            if (F.lane == 0) ((float*)(ws + WS_SX))[r] = mx * (1.f / 256.f);
        }
    }
}

constexpr int GL_TOT = 0, GL_IMG = 4096, GL_PITCH = 144, GL_IMGB = 64 * GL_PITCH, GL_SSX = GL_IMG + 4 * GL_IMGB;
typedef short bf16x8_t __attribute__((ext_vector_type(8)));
__device__ __forceinline__ int chunk_row0(int b, int tc) { return tc < 4 ? b * CTXL + tc * 64 : NCTX + b * SEQ + (tc - 4) * 64; }
__device__ __forceinline__ int chunk_pos(int tc, int dir) { return dir == 0 ? tc : (tc < 4 ? 3 - tc : 135 - tc); }
__device__ __forceinline__ float logsig16(float x) { return (fminf(x, 0.f) - 0.69314718f * __builtin_amdgcn_logf(1.f + __builtin_amdgcn_exp2f(-1.44269504f * fabsf(x)))) * (1.f / 16.f); }
constexpr int GL_HALF = 65536, GL_Z = 40960, GL_QK = 49152;
struct GlaW { float wf[16], wb[16], baf, bab; };
__device__ __forceinline__ void gla_load_w(GlaW& w, CArgsP a, int layer, int h, int lane) {
    const float* waf = a->in[I_WAF] + layer * 4096 + h * 64 + lane; const float* wab = a->in[I_WAB] + layer * 4096 + h * 64 + lane;
#pragma unroll
    for (int j = 0; j < 16; ++j) { w.wf[j] = waf[j * 256]; w.wb[j] = wab[j * 256]; }
    w.baf = a->in[I_BAF][layer * 256 + h * 64 + lane]; w.bab = a->in[I_BAB][layer * 256 + h * 64 + lane];
}
__device__ __forceinline__ void gla_scan(LAS unsigned char* hl, int w4, int lane, const GlaW& w, const float* Z, int row0, float (&Bf)[16], float (&Bb)[16], float& endf, float& endb) {
    const int t0 = 16 * w4;
    LAS float* ZL = (LAS float*)(hl + GL_Z) + t0 * 32;
    { const f32x4* zp = (const f32x4*)(Z + (size_t)(row0 + t0 + (lane >> 2)) * 32 + (lane & 3) * 8); const f32x4 z0 = zp[0], z1 = zp[1];
      *(LAS f32x4*)(ZL + (lane >> 2) * 32 + (lane & 3) * 8) = z0; *(LAS f32x4*)(ZL + (lane >> 2) * 32 + (lane & 3) * 8 + 4) = z1; }
    LDS_WAIT();
#pragma unroll
    for (int i = 0; i < 16; ++i) {
        const LAS f32x4* zp = (const LAS f32x4*)(ZL + i * 32);
        float zf = w.baf, zb = w.bab;
#pragma unroll
        for (int q = 0; q < 4; ++q) { const f32x4 z0 = zp[q], z1 = zp[4 + q];
            zf += z0[0] * w.wf[4 * q] + z0[1] * w.wf[4 * q + 1] + z0[2] * w.wf[4 * q + 2] + z0[3] * w.wf[4 * q + 3];
            zb += z1[0] * w.wb[4 * q] + z1[1] * w.wb[4 * q + 1] + z1[2] * w.wb[4 * q + 2] + z1[3] * w.wb[4 * q + 3]; }
        Bf[i] = logsig16(zf); Bb[i] = logsig16(zb);
    }
#pragma unroll
    for (int i = 1; i < 16; ++i) Bf[i] += Bf[i - 1];
#pragma unroll
    for (int i = 14; i >= 0; --i) Bb[i] += Bb[i + 1];
    LAS float* TOT = (LAS float*)(hl + GL_TOT);
    TOT[(0 * 4 + w4) * 64 + lane] = Bf[15]; TOT[(1 * 4 + w4) * 64 + lane] = Bb[0];
    __syncthreads();
    float offf = 0.f, offb = 0.f; endf = 0.f; endb = 0.f;
#pragma unroll
    for (int ww = 0; ww < 4; ++ww) { const float tf = TOT[(0 * 4 + ww) * 64 + lane], tb = TOT[(1 * 4 + ww) * 64 + lane]; endf += tf; endb += tb; offf += (ww < w4) ? tf : 0.f; offb += (ww > w4) ? tb : 0.f; }
#pragma unroll
    for (int i = 0; i < 16; ++i) { Bf[i] += offf; Bb[i] += offb; }
}
constexpr int GLA_UNITS = BATCH * 4 * NCHUNK;
__device__ __forceinline__ void gla_a_phase(const Frame& F, int layer) {
    CArgsP a = kargs(); unsigned char* const ws = a->ws;
    const bf16* PA = (const bf16*)(ws + WS_PA); const bf16* VT = (const bf16*)(ws + WS_VT);
    const float* Z = (const float*)(ws + WS_Z); bf16* SST = (bf16*)(ws + WS_H); float* DEC = (float*)(ws + WS_DEC);
    const int lane = F.lane, l16 = lane & 15, g = lane >> 4, hw = F.wave >> 2, w4 = F.wave & 3, t0 = 16 * w4;
    LAS unsigned char* hl = F.lds + hw * GL_HALF;
    const int h = F.vcu & 3;
    GlaW gw; gla_load_w(gw, a, layer, h, lane);
    for (int pp = F.vcu >> 2; pp < BATCH * NCHUNK / 2; pp += F.G >> 2) {
        const int unit = 2 * pp + hw;
        const int b = unit / NCHUNK, tc = unit % NCHUNK, row0 = chunk_row0(b, tc);
        LAS bf16* KL = (LAS bf16*)(hl + GL_QK + 8192) + t0 * 64;
        { const bf16* kp = PA + (size_t)(row0 + t0 + (lane >> 2)) * PA_LD + PA_K + h * 64 + (lane & 3) * 16; const v4u k0 = *(const v4u*)kp, k1 = *(const v4u*)(kp + 8);
          *(LAS v4u*)(KL + (lane >> 2) * 64 + (lane & 3) * 16) = k0; *(LAS v4u*)(KL + (lane >> 2) * 64 + (lane & 3) * 16 + 8) = k1; }
        float Bf[16], Bb[16], endf, endb;
        gla_scan(hl, w4, lane, gw, Z, row0, Bf, Bb, endf, endb);
        float kf[16], kb[16];
#pragma unroll
        for (int i = 0; i < 16; ++i) { const float kk = bf1(KL[i * 64 + lane]); kf[i] = kk * __expf(endf - Bf[i]); kb[i] = kk * __expf(endb - Bb[i]); }
#pragma unroll
        for (int q = 0; q < 2; ++q) {
            *(LAS v4u*)(hl + GL_IMG + 0 * GL_IMGB + lane * GL_PITCH + (t0 + 8 * q) * 2) = (v4u){pk2(kf[8 * q], kf[8 * q + 1]), pk2(kf[8 * q + 2], kf[8 * q + 3]), pk2(kf[8 * q + 4], kf[8 * q + 5]), pk2(kf[8 * q + 6], kf[8 * q + 7])};
            *(LAS v4u*)(hl + GL_IMG + 1 * GL_IMGB + lane * GL_PITCH + (t0 + 8 * q) * 2) = (v4u){pk2(kb[8 * q], kb[8 * q + 1]), pk2(kb[8 * q + 2], kb[8 * q + 3]), pk2(kb[8 * q + 4], kb[8 * q + 5]), pk2(kb[8 * q + 6], kb[8 * q + 7])};
        }
        const int seq0 = (b * 4 + h) * 2;
        if (w4 == 0) { DEC[((size_t)(seq0 + 0) * NCHUNK + chunk_pos(tc, 0)) * 64 + lane] = __expf(endf); DEC[((size_t)(seq0 + 1) * NCHUNK + chunk_pos(tc, 1)) * 64 + lane] = __expf(endb); }
        __syncthreads();
        const int dir = w4 >> 1, nth = w4 & 1;
        const LAS unsigned char* img = hl + GL_IMG + dir * GL_IMGB;
        bf16x8_t afr[4][2];
#pragma unroll
        for (int mt = 0; mt < 4; ++mt)
#pragma unroll
            for (int kt = 0; kt < 2; ++kt) afr[mt][kt] = *(const LAS bf16x8_t*)(img + (32 * (mt >> 1) + 8 * (l16 >> 2) + 4 * (mt & 1) + (l16 & 3)) * GL_PITCH + (32 * kt + 8 * g) * 2);
        bf16* slot = SST + ((size_t)(seq0 + dir) * NCHUNK + chunk_pos(tc, dir)) * 8192;
#pragma unroll
        for (int n4 = 0; n4 < 4; ++n4) {
            const int nt = 4 * nth + n4;
            const bf16* vp = VT + (size_t)(h * 128 + 16 * nt + l16) * R + row0 + 8 * g;
            const bf16x8_t b0 = *(const bf16x8_t*)vp, b1 = *(const bf16x8_t*)(vp + 32);
#pragma unroll
            for (int mp = 0; mp < 2; ++mp) {
                f32x4 a0 = (f32x4){0.f, 0.f, 0.f, 0.f}, a1 = (f32x4){0.f, 0.f, 0.f, 0.f};
                a0 = __builtin_amdgcn_mfma_f32_16x16x32_bf16(afr[2 * mp][0], b0, a0, 0, 0, 0); a0 = __builtin_amdgcn_mfma_f32_16x16x32_bf16(afr[2 * mp][1], b1, a0, 0, 0, 0);
                a1 = __builtin_amdgcn_mfma_f32_16x16x32_bf16(afr[2 * mp + 1][0], b0, a1, 0, 0, 0); a1 = __builtin_amdgcn_mfma_f32_16x16x32_bf16(afr[2 * mp + 1][1], b1, a1, 0, 0, 0);
                *(v4u*)(slot + (16 * nt + l16) * 64 + 32 * mp + 8 * g) = (v4u){pk2(a0[0], a0[1]), pk2(a0[2], a0[3]), pk2(a1[0], a1[1]), pk2(a1[2], a1[3])};
            }
        }
        __syncthreads();
    }
}
__device__ __forceinline__ void gla_b_phase(const Frame& F, bool dry) {
    CArgsP a = kargs(); unsigned char* const ws = a->ws; const bool wr = !dry || a->pad == 12345;
    bf16* SST = (bf16*)(ws + WS_H); const float* DEC = (const float*)(ws + WS_DEC);
    const int gtid = F.vcu * NT + F.tid, GT = F.G * NT;
    for (int id = gtid; id < 64 * 2048; id += GT) {
        const int seq = id >> 11, e = (id & 2047) * 4, k4 = e & 63;
        float s0 = 0.f, s1 = 0.f, s2 = 0.f, s3 = 0.f;
        bf16* p = SST + (size_t)seq * NCHUNK * 8192 + e; const float* dp = DEC + (size_t)seq * NCHUNK * 64 + k4;
#pragma unroll 4
        for (int c = 0; c < NCHUNK; ++c) {
            const v2u t = *(const v2u*)(p + (size_t)c * 8192); const f32x4 d = *(const f32x4*)(dp + c * 64);
            if (wr) *(v2u*)(p + (size_t)c * 8192) = (v2u){pk2(s0, s1), pk2(s2, s3)};
            s0 = d[0] * s0 + bflo(t.x); s1 = d[1] * s1 + bfhi(t.x); s2 = d[2] * s2 + bflo(t.y); s3 = d[3] * s3 + bfhi(t.y);
        }
    }
}
__device__ __forceinline__ void gla_c_phase(const Frame& F, int layer, bool dry) {
    CArgsP a = kargs(); unsigned char* const ws = a->ws; const bool wr = !dry || a->pad == 12345;
    bf16* PA = (bf16*)(ws + WS_PA); const bf16* VT = (const bf16*)(ws + WS_VT);
    const float* Z = (const float*)(ws + WS_Z); const bf16* SST = (const bf16*)(ws + WS_H);
    const int lane = F.lane, l16 = lane & 15, g = lane >> 4, hw = F.wave >> 2, w4 = F.wave & 3, t0 = 16 * w4;
    LAS unsigned char* hl = F.lds + hw * GL_HALF;
    const int h = F.vcu & 3;
    GlaW gw; gla_load_w(gw, a, layer, h, lane);
    for (int pp = F.vcu >> 2; pp < BATCH * NCHUNK / 2; pp += F.G >> 2) {
        const int unit = 2 * pp + hw;
        const int b = unit / NCHUNK, tc = unit % NCHUNK, row0 = chunk_row0(b, tc);
        {
            LAS bf16* QL = (LAS bf16*)(hl + GL_QK) + t0 * 64; LAS bf16* KL = QL + 4096;
            { const bf16* qp = PA + (size_t)(row0 + t0 + (lane >> 2)) * PA_LD + PA_Q + h * 64 + (lane & 3) * 16; const bf16* kp = qp + (PA_K - PA_Q);
              const v4u q0 = *(const v4u*)qp, q1 = *(const v4u*)(qp + 8), k0 = *(const v4u*)kp, k1 = *(const v4u*)(kp + 8);
              const int o = (lane >> 2) * 64 + (lane & 3) * 16;
              *(LAS v4u*)(QL + o) = q0; *(LAS v4u*)(QL + o + 8) = q1; *(LAS v4u*)(KL + o) = k0; *(LAS v4u*)(KL + o + 8) = k1; }
            float Bf[16], Bb[16], endf, endb;
            gla_scan(hl, w4, lane, gw, Z, row0, Bf, Bb, endf, endb);
#pragma unroll
            for (int i = 0; i < 16; ++i) {
                const float qq = bf1(QL[i * 64 + lane]), kk = bf1(KL[i * 64 + lane]);
                const float ef = __expf(Bf[i]), eb = __expf(Bb[i]);
                LAS bf16* ip = (LAS bf16*)(hl + GL_IMG + (t0 + i) * GL_PITCH) + lane;
                ip[0] = (bf16)f2bf(qq * ef); ip[GL_IMGB / 2] = (bf16)f2bf(kk * __builtin_amdgcn_rcpf(ef)); ip[GL_IMGB] = (bf16)f2bf(qq * eb); ip[3 * GL_IMGB / 2] = (bf16)f2bf(kk * __builtin_amdgcn_rcpf(eb));
            }
        }
        __syncthreads();
        f32x4 O[8];
#pragma unroll
        for (int mt = 0; mt < 8; ++mt) O[mt] = (f32x4){0.f, 0.f, 0.f, 0.f};
        const int tq = 16 * w4 + l16;
#pragma unroll
        for (int dir = 0; dir < 2; ++dir) {
            const LAS unsigned char* Qimg = hl + GL_IMG + (2 * dir) * GL_IMGB; const LAS unsigned char* Kimg = Qimg + GL_IMGB;
            bf16x8_t qf[2];
#pragma unroll
            for (int kt = 0; kt < 2; ++kt) qf[kt] = *(const LAS bf16x8_t*)(Qimg + tq * GL_PITCH + (32 * kt + 8 * g) * 2);
            f32x4 P[4];
#pragma unroll
            for (int mt = 0; mt < 4; ++mt) {
                P[mt] = (f32x4){0.f, 0.f, 0.f, 0.f};
                const int trow = 32 * (mt >> 1) + 8 * (l16 >> 2) + 4 * (mt & 1) + (l16 & 3);
#pragma unroll
                for (int kt = 0; kt < 2; ++kt) { const bf16x8_t kf = *(const LAS bf16x8_t*)(Kimg + trow * GL_PITCH + (32 * kt + 8 * g) * 2); P[mt] = __builtin_amdgcn_mfma_f32_16x16x32_bf16(kf, qf[kt], P[mt], 0, 0, 0); }
#pragma unroll
                for (int rg = 0; rg < 4; ++rg) { const int tp = 32 * (mt >> 1) + 8 * g + 4 * (mt & 1) + rg; const bool valid = dir == 0 ? (tp <= tq) : (tp >= tq); P[mt][rg] = valid ? P[mt][rg] : 0.f; }
            }
            bf16x8_t pa[2];
#pragma unroll
            for (int k2 = 0; k2 < 2; ++k2) { const v4u w = (v4u){pk2(P[2 * k2][0], P[2 * k2][1]), pk2(P[2 * k2][2], P[2 * k2][3]), pk2(P[2 * k2 + 1][0], P[2 * k2 + 1][1]), pk2(P[2 * k2 + 1][2], P[2 * k2 + 1][3])}; pa[k2] = __builtin_bit_cast(bf16x8_t, w); }
            const bf16* slot = SST + ((size_t)((b * 4 + h) * 2 + dir) * NCHUNK + chunk_pos(tc, dir)) * 8192;
#pragma unroll
            for (int mt = 0; mt < 8; ++mt) {
                const int v = 32 * (mt >> 1) + 8 * (l16 >> 2) + 4 * (mt & 1) + (l16 & 3);
                const bf16* vp = VT + (size_t)(h * 128 + v) * R + row0 + 8 * g;
#pragma unroll
                for (int k2 = 0; k2 < 2; ++k2) { const bf16x8_t vf = *(const bf16x8_t*)(vp + 32 * k2); O[mt] = __builtin_amdgcn_mfma_f32_16x16x32_bf16(vf, pa[k2], O[mt], 0, 0, 0); }
#pragma unroll
                for (int kt = 0; kt < 2; ++kt) { const bf16x8_t sf = *(const bf16x8_t*)(slot + v * 64 + 32 * kt + 8 * g); O[mt] = __builtin_amdgcn_mfma_f32_16x16x32_bf16(sf, qf[kt], O[mt], 0, 0, 0); }
            }
        }
        float ss = 0.f;
#pragma unroll
        for (int mt = 0; mt < 8; ++mt) ss += (O[mt][0] * O[mt][0] + O[mt][1] * O[mt][1]) + (O[mt][2] * O[mt][2] + O[mt][3] * O[mt][3]);
        ss += shx(ss, 16, lane); ss += shx(ss, 32, lane);
        const float rs = rsqrtf(ss * (1.f / 128.f) + EPS);
        bf16* rp0 = PA + (size_t)(row0 + tq) * PA_LD + PA_R + h * 128 + 8 * g;
#pragma unroll
        for (int mp = 0; mp < 4; ++mp) {
            const v4u rr = *(const v4u*)(rp0 + 32 * mp);
            const float* gp = a->in[I_GGLA] + layer * 128 + 32 * mp + 8 * g; const f32x4 ga = *(const f32x4*)gp, gb = *(const f32x4*)(gp + 4);
            const float r0 = bflo(rr.x), r1 = bfhi(rr.x), r2 = bflo(rr.y), r3 = bfhi(rr.y), r4 = bflo(rr.z), r5 = bfhi(rr.z), r6 = bflo(rr.w), r7 = bfhi(rr.w);
            const f32x4 oa = O[2 * mp], ob = O[2 * mp + 1];
            const float y0 = oa[0] * rs * ga[0] * (r0 * sigmoidf_(r0)), y1 = oa[1] * rs * ga[1] * (r1 * sigmoidf_(r1)), y2 = oa[2] * rs * ga[2] * (r2 * sigmoidf_(r2)), y3 = oa[3] * rs * ga[3] * (r3 * sigmoidf_(r3));
            const float y4 = ob[0] * rs * gb[0] * (r4 * sigmoidf_(r4)), y5 = ob[1] * rs * gb[1] * (r5 * sigmoidf_(r5)), y6 = ob[2] * rs * gb[2] * (r6 * sigmoidf_(r6)), y7 = ob[3] * rs * gb[3] * (r7 * sigmoidf_(r7));
            if (wr) *(v4u*)(rp0 + 32 * mp) = (v4u){pk2(y0, y1), pk2(y2, y3), pk2(y4, y5), pk2(y6, y7)};
        }
        __syncthreads();
    }
}

__device__ __forceinline__ void na_unit4(bf16* PA, const bf16* NVT, const float* rpb_l, LAS float* lb, int b, int hd, bool lat, int qr0, int nt, int lane, bool wr) {
    const int l16 = lane & 15, g = lane >> 4;
    const int latbase = NCTX + b * SEQ, ctxbase = b * CTXL;
    bf16* qp[4]; bf16x8_t qf[4][2];
#pragma unroll
    for (int j = 0; j < 4; ++j) {
        const int row = lat ? latbase + (qr0 + j) * 64 + 16 * nt + l16 : ctxbase + 64 * nt + 16 * j + l16;
        qp[j] = PA + (size_t)row * PA_LD + PA_NQ + hd * 64;
        qf[j][0] = *(const bf16x8_t*)(qp[j] + 8 * g); qf[j][1] = *(const bf16x8_t*)(qp[j] + 32 + 8 * g);
    }
    const int qc = 16 * nt + l16, c0 = min(max(qc - 8, 0), 48), R0 = min(max(qr0 - 4, 0), 120);
    if (lat) {
#pragma unroll
        for (int i = 0; i < 8; ++i) { const int idx = lane + 64 * i; if (idx < 465) lb[idx] = rpb_l[hd * 465 + idx]; }
        LDS_WAIT();
    }
    const bf16* kbase = PA + PA_NK + hd * 64 + 8 * g;
    const bf16* vbase = NVT + (size_t)(hd * 64 + l16) * R + 8 * g;
    float mx[4] = {-3.0e38f, -3.0e38f, -3.0e38f, -3.0e38f};
    const int nrows = lat ? ((qr0 == 0 || qr0 == 124) ? 8 : 11) : 0, cs = (nt == 0) ? 0 : (nt == 1 ? 8 : (nt == 2 ? 24 : 32));
    const int nwin = nrows, nslot = nwin + 8;
#define NA_SLOT(si, jmask, krow, pr, base0, win) do { const int s_ = min((si), nslot - 1); win = s_ < nwin; pr = 0; \
        if (win) { krow = R0 + s_; jmask = 0u; \
            _Pragma("unroll") for (int j_ = 0; j_ < 4; ++j_) { const int r0j = min(max(qr0 + j_ - 4, 0), 120); if (krow >= r0j && krow < r0j + 8) jmask |= 1u << j_; } \
            base0 = latbase + krow * 64 + cs; } else { jmask = 15u; krow = 0; base0 = ctxbase + (s_ - nwin) * 32; } } while (0)
#define NA_LDK(dst, base0) do { _Pragma("unroll") for (int t_ = 0; t_ < 2; ++t_) { const bf16* kp_ = kbase + (size_t)((base0) + 8 * (l16 >> 2) + 4 * t_ + (l16 & 3)) * PA_LD; dst[t_][0] = *(const bf16x8_t*)kp_; dst[t_][1] = *(const bf16x8_t*)(kp_ + 32); } } while (0)
#define NA_LDV(dst, base0) do { _Pragma("unroll") for (int mt_ = 0; mt_ < 4; ++mt_) dst[mt_] = *(const bf16x8_t*)(vbase + (size_t)(16 * mt_) * R + (base0)); } while (0)
#pragma unroll 1
    for (int s0 = 0; s0 < nslot; s0 += 4) {
        bf16x8_t kc[4][2][2]; unsigned jm[4];
#pragma unroll
        for (int q = 0; q < 4; ++q) { int krow, pr, base0; bool win; NA_SLOT(s0 + q, jm[q], krow, pr, base0, win); if (s0 + q >= nslot) jm[q] = 0u; NA_LDK(kc[q], base0); }
#pragma unroll
        for (int q = 0; q < 4; ++q)
#pragma unroll
            for (int t = 0; t < 2; ++t)
#pragma unroll
                for (int j = 0; j < 4; ++j) {
                    f32x4 S = (f32x4){0.f, 0.f, 0.f, 0.f};
                    S = __builtin_amdgcn_mfma_f32_16x16x32_bf16(kc[q][t][0], qf[j][0], S, 0, 0, 0);
                    S = __builtin_amdgcn_mfma_f32_16x16x32_bf16(kc[q][t][1], qf[j][1], S, 0, 0, 0);
                    mx[j] = fmaxf(mx[j], fmaxf(fmaxf(S[0], S[1]), fmaxf(S[2], S[3])));
                }
    }
#pragma unroll
    for (int j = 0; j < 4; ++j) { mx[j] = fmaxf(mx[j], shx(mx[j], 16, lane)); mx[j] = fmaxf(mx[j], shx(mx[j], 32, lane)); }
    float ls[4] = {0.f, 0.f, 0.f, 0.f};
    f32x4 O[4][4];
#pragma unroll
    for (int j = 0; j < 4; ++j)
#pragma unroll
        for (int mt = 0; mt < 4; ++mt) O[j][mt] = (f32x4){0.f, 0.f, 0.f, 0.f};
#pragma unroll 1
    for (int s0 = 0; s0 < nslot; s0 += 2) {
        bf16x8_t kf[2][2][2], vf[2][4]; unsigned jm[2]; int krw[2], prr[2]; bool wn[2];
#pragma unroll
        for (int q = 0; q < 2; ++q) { int base0; NA_SLOT(s0 + q, jm[q], krw[q], prr[q], base0, wn[q]); if (s0 + q >= nslot) jm[q] = 0u; NA_LDK(kf[q], base0); NA_LDV(vf[q], base0); }
#pragma unroll
        for (int q = 0; q < 2; ++q) {
            const bool win = wn[q]; const int pr = prr[q], krow = krw[q];
            bool cv[2][4]; int co[2][4];
#pragma unroll
            for (int t = 0; t < 2; ++t)
#pragma unroll
                for (int rg = 0; rg < 4; ++rg) { const int kcol = cs + 8 * g + 4 * t + rg; cv[t][rg] = !win || ((kcol >= c0) && (kcol <= c0 + 15)); co[t][rg] = min(max(kcol - qc + 15, 0), 30); }
#pragma unroll
            for (int j = 0; j < 4; ++j) {
                const bool rv = (jm[q] >> j) & 1u;
                f32x4 S[2];
#pragma unroll
                for (int t = 0; t < 2; ++t) { S[t] = (f32x4){0.f, 0.f, 0.f, 0.f};
                    S[t] = __builtin_amdgcn_mfma_f32_16x16x32_bf16(kf[q][t][0], qf[j][0], S[t], 0, 0, 0);
                    S[t] = __builtin_amdgcn_mfma_f32_16x16x32_bf16(kf[q][t][1], qf[j][1], S[t], 0, 0, 0); }
                const LAS float* bp = lb + (win ? min(max(krow - (qr0 + j) + 7, 0), 14) * 31 : 0);
                float psum = 0.f;
#pragma unroll
                for (int t = 0; t < 2; ++t)
#pragma unroll
                    for (int rg = 0; rg < 4; ++rg) { const float bias = win ? bp[co[t][rg]] : 0.f; const float p = (cv[t][rg] && rv) ? __expf(S[t][rg] + bias - mx[j]) : 0.f; S[t][rg] = p; psum += p; }
                ls[j] += psum;
                const bf16x8_t pa = __builtin_bit_cast(bf16x8_t, (v4u){pk2(S[0][0], S[0][1]), pk2(S[0][2], S[0][3]), pk2(S[1][0], S[1][1]), pk2(S[1][2], S[1][3])});
#pragma unroll
                for (int mt = 0; mt < 4; ++mt) O[j][mt] = __builtin_amdgcn_mfma_f32_16x16x32_bf16(vf[q][mt], pa, O[j][mt], 0, 0, 0);
            }
        }
    }
#undef NA_SLOT
#undef NA_LDK
#undef NA_LDV
#pragma unroll
    for (int j = 0; j < 4; ++j) {
        float l = ls[j]; l += shx(l, 16, lane); l += shx(l, 32, lane);
        const float inv = 1.f / l;
#pragma unroll
        for (int mt = 0; mt < 4; ++mt) if (wr) *(v2u*)(qp[j] + 16 * mt + 4 * g) = (v2u){pk2(O[j][mt][0] * inv, O[j][mt][1] * inv), pk2(O[j][mt][2] * inv, O[j][mt][3] * inv)};
    }
}
__device__ __forceinline__ void na_phase(const Frame& F, int layer, bool dry, bool skip_ctx) {
    CArgsP a = kargs(); unsigned char* const ws = a->ws; const bool wr = !dry || a->pad == 12345;
    bf16* PA = (bf16*)(ws + WS_PA); const bf16* NVT = (const bf16*)(ws + WS_NVT);
    const float* rpb_l = a->in[I_RPB] + (size_t)layer * 8 * 465;
    const int gw = F.vcu * NWAVES + F.wave, NGW = F.G * NWAVES;
    LAS float* lb = (LAS float*)(F.lds + F.wave * 2048);
    for (int u = gw; u < BATCH * 8 * 32 * 4 + (skip_ctx ? 0 : BATCH * 8 * 4); u += NGW) {
        if (u < BATCH * 8 * 32 * 4) { const int nt = u & 3, qg = (u >> 2) & 31, hd = (u >> 7) & 7, b = u >> 10; na_unit4(PA, NVT, rpb_l, lb, b, hd, true, 4 * qg, nt, F.lane, wr); }
        else { const int v = u - BATCH * 8 * 32 * 4; const int nt = v & 3, hd = (v >> 2) & 7, b = v >> 5; na_unit4(PA, NVT, rpb_l, lb, b, hd, false, 0, nt, F.lane, wr); }
    }
}

__device__ __forceinline__ float pack_key(float v, int idx) { unsigned t = __builtin_bit_cast(unsigned, v) & ~127u; asm("" : "+v"(t)); return __builtin_bit_cast(float, t | (unsigned)idx); }
__device__ __forceinline__ void topk_phase(const Frame& F, int rbeg) {
    CArgsP a = kargs(); unsigned char* const ws = a->ws;
    const int gtid = F.vcu * NT + F.tid, GT = F.G * NT;
    const bf16* SC = (const bf16*)(ws + WS_SC);
    int* EI = (int*)(ws + WS_EI); float* EG = (float*)(ws + WS_EG);
    LAS unsigned* myl = (LAS unsigned*)F.lds + F.tid * 9;
    for (int id = rbeg * 8 + gtid; id < R * 8; id += GT) {
        const int r = id >> 3, hd = id & 7;
        const v4u* sp = (const v4u*)(SC + (size_t)r * 2048 + hd * 256);
        float t0[16], t1[16];
#pragma unroll
        for (int blk = 0; blk < 8; ++blk) {
            float n0[16], n1[16];
#pragma unroll
            for (int q = 0; q < 2; ++q) { const v4u va = sp[blk * 2 + q], vb = sp[16 + blk * 2 + q];
                const unsigned wa[4] = {va.x, va.y, va.z, va.w}, wb[4] = {vb.x, vb.y, vb.z, vb.w};
#pragma unroll
                for (int e = 0; e < 4; ++e) { const int i0 = blk * 16 + 8 * q + 2 * e;
                    n0[8 * q + 2 * e] = pack_key(bflo(wa[e]), i0); n0[8 * q + 2 * e + 1] = pack_key(bfhi(wa[e]), i0 + 1);
                    n1[8 * q + 2 * e] = pack_key(bflo(wb[e]), i0); n1[8 * q + 2 * e + 1] = pack_key(bfhi(wb[e]), i0 + 1); } }
#pragma unroll
            for (int k = 2; k <= 16; k <<= 1)
#pragma unroll
                for (int j = k >> 1; j > 0; j >>= 1)
#pragma unroll
                    for (int i = 0; i < 16; ++i) { const int l = i ^ j; if (l > i) { const bool desc = (i & k) == 0;
                        const float a0 = n0[i], b0 = n0[l], a1 = n1[i], b1 = n1[l];
                        n0[i] = desc ? fmaxf(a0, b0) : fminf(a0, b0); n0[l] = desc ? fminf(a0, b0) : fmaxf(a0, b0);
                        n1[i] = desc ? fmaxf(a1, b1) : fminf(a1, b1); n1[l] = desc ? fminf(a1, b1) : fmaxf(a1, b1); } }
            if (blk == 0) {
#pragma unroll
                for (int i = 0; i < 16; ++i) { t0[i] = n0[i]; t1[i] = n1[i]; }
            } else {
#pragma unroll
                for (int i = 0; i < 16; ++i) { t0[i] = fmaxf(t0[i], n0[15 - i]); t1[i] = fmaxf(t1[i], n1[15 - i]); }
#pragma unroll
                for (int j = 8; j > 0; j >>= 1)
#pragma unroll
                    for (int i = 0; i < 16; ++i) { const int l = i ^ j; if (l > i) { const float a0 = t0[i], b0 = t0[l], a1 = t1[i], b1 = t1[l];
                        t0[i] = fmaxf(a0, b0); t0[l] = fminf(a0, b0); t1[i] = fmaxf(a1, b1); t1[l] = fminf(a1, b1); } }
            }
        }
        float best[16];
#pragma unroll
        for (int j = 0; j < 16; ++j) best[j] = -3.0e38f;
#pragma unroll
        for (int ia = 0; ia < 16; ++ia)
#pragma unroll
            for (int ib = 0; ib < 16; ++ib)
                if ((ia + 1) * (ib + 1) <= 16) {
                    float x = __builtin_bit_cast(float, (__builtin_bit_cast(unsigned, t0[ia] + t1[ib]) & ~255u) | (unsigned)(ia * 16 + ib));
#pragma unroll
                    for (int j = 0; j < 16; ++j) { const float tb = fmaxf(best[j], x); x = fminf(best[j], x); best[j] = tb; }
                }
        {
            unsigned w0[4], w1[4];
#pragma unroll
            for (int q = 0; q < 4; ++q) {
                w0[q] = (__builtin_bit_cast(unsigned, t0[4 * q]) & 127u) | ((__builtin_bit_cast(unsigned, t0[4 * q + 1]) & 127u) << 8) | ((__builtin_bit_cast(unsigned, t0[4 * q + 2]) & 127u) << 16) | ((__builtin_bit_cast(unsigned, t0[4 * q + 3]) & 127u) << 24);
                w1[q] = (__builtin_bit_cast(unsigned, t1[4 * q]) & 127u) | ((__builtin_bit_cast(unsigned, t1[4 * q + 1]) & 127u) << 8) | ((__builtin_bit_cast(unsigned, t1[4 * q + 2]) & 127u) << 16) | ((__builtin_bit_cast(unsigned, t1[4 * q + 3]) & 127u) << 24);
            }
#pragma unroll
            for (int q = 0; q < 4; ++q) { myl[q] = w0[q]; myl[4 + q] = w1[q]; }
            LDS_WAIT();
        }
        int eid[16];
#pragma unroll
        for (int j = 0; j < 16; ++j) { const unsigned code = __builtin_bit_cast(unsigned, best[j]) & 255u; const LAS unsigned char* mb = (const LAS unsigned char*)myl;
            eid[j] = (int)mb[code >> 4] * 128 + (int)mb[16 + (code & 15u)]; }
        LDS_WAIT();
        float sum = 0.f; const float bmax = best[0];
#pragma unroll
        for (int j = 0; j < 16; ++j) { best[j] = __expf(best[j] - bmax); sum += best[j]; }
        const float inv = 1.f / sum;
        v4i* ei = (v4i*)(EI + (size_t)r * 128 + hd * 16); f32x4* eg = (f32x4*)(EG + (size_t)r * 128 + hd * 16);
#pragma unroll
        for (int j = 0; j < 4; ++j) { ei[j] = (v4i){eid[4 * j], eid[4 * j + 1], eid[4 * j + 2], eid[4 * j + 3]}; eg[j] = (f32x4){best[4 * j] * inv, best[4 * j + 1] * inv, best[4 * j + 2] * inv, best[4 * j + 3] * inv}; }
    }
}

__device__ __forceinline__ float gelu_tanh(float x) { const float u = 0.7978845608f * (x + 0.044715f * x * x * x); return x * __builtin_amdgcn_rcpf(1.f + __expf(-2.f * u)); }
typedef float f32x2_t __attribute__((ext_vector_type(2)));
__device__ __forceinline__ void peer1_phase(const Frame& F, int rbeg) {
    CArgsP a = kargs(); unsigned char* const ws = a->ws;
    const unsigned char* EU8 = ws + WS_EU; const unsigned char* H8 = ws + WS_H8;
    const int* EI = (const int*)(ws + WS_EI); bf16* PART = (bf16*)(ws + WS_PART);
    const int per = F.G >> 3, s = F.vcu / per, rank = F.vcu % per, stride = per * NWAVES;
    const int lane = F.lane, m = lane & 15, g = lane >> 4, row8 = lane >> 3, part = lane & 7;
    const unsigned char* tab = EU8 + (size_t)s * NEXP * 128 + 16 * part;
    LAS unsigned char* wl = F.lds + F.wave * 5632;
    LAS int* idl = (LAS int*)(wl + 4608);
    const int wofs = row8 * 144 + part * 16, rofs = m * 144 + 16 * g;
    int r = rbeg + rank * NWAVES + F.wave;
    v2u idp[2];
#pragma unroll
    for (int u = 0; u < 2; ++u) idp[u] = *(const v2u*)(EI + (size_t)min(r + u * stride, R - 1) * 128 + 2 * lane);
    for (; r < R; r += 2 * stride) {
        v4u w[2][16]; v4u x[2][2];
#pragma unroll
        for (int u = 0; u < 2; ++u) *(LAS v2u*)(idl + u * 128 + 2 * lane) = idp[u];
        LDS_WAIT();
#pragma unroll
        for (int u = 0; u < 2; ++u) {
            const int ru = min(r + u * stride, R - 1);
            const unsigned char* xp = H8 + (size_t)ru * D + 128 * s + 16 * g;
            x[u][0] = *(const v4u*)xp; x[u][1] = *(const v4u*)(xp + 64);
#pragma unroll
            for (int j = 0; j < 16; ++j) w[u][j] = *(const v4u*)(tab + (size_t)idl[u * 128 + 8 * j + row8] * 128);
        }
        const int rn = r + 2 * stride;
#pragma unroll
        for (int u = 0; u < 2; ++u) idp[u] = *(const v2u*)(EI + (size_t)min(rn + u * stride, R - 1) * 128 + 2 * lane);
#pragma unroll
        for (int u = 0; u < 2; ++u) {
            f32x4 sel = (f32x4){0.f, 0.f, 0.f, 0.f};
#pragma unroll
            for (int T = 0; T < 8; ++T) {
                LAS unsigned char* buf = wl + (T & 1) * 2304;
                *(LAS v4u*)(buf + wofs) = w[u][2 * T]; *(LAS v4u*)(buf + 8 * 144 + wofs) = w[u][2 * T + 1];
                const v4u a0 = *(const LAS v4u*)(buf + rofs), a1 = *(const LAS v4u*)(buf + rofs + 64);
                f32x4 acc = (f32x4){0.f, 0.f, 0.f, 0.f};
                acc = __builtin_amdgcn_mfma_f32_16x16x32_fp8_fp8((long)(((unsigned long long)a0.y << 32) | a0.x), (long)(((unsigned long long)x[u][0].y << 32) | x[u][0].x), acc, 0, 0, 0);
                acc = __builtin_amdgcn_mfma_f32_16x16x32_fp8_fp8((long)(((unsigned long long)a0.w << 32) | a0.z), (long)(((unsigned long long)x[u][0].w << 32) | x[u][0].z), acc, 0, 0, 0);
                acc = __builtin_amdgcn_mfma_f32_16x16x32_fp8_fp8((long)(((unsigned long long)a1.y << 32) | a1.x), (long)(((unsigned long long)x[u][1].y << 32) | x[u][1].x), acc, 0, 0, 0);
                acc = __builtin_amdgcn_mfma_f32_16x16x32_fp8_fp8((long)(((unsigned long long)a1.w << 32) | a1.z), (long)(((unsigned long long)x[u][1].w << 32) | x[u][1].z), acc, 0, 0, 0);
                sel = (m == T) ? acc : sel;
            }
            const int ru = r + u * stride;
            if (m < 8 && ru < R) *(v2u*)(PART + ((size_t)s * R + ru) * 128 + 16 * m + 4 * g) = (v2u){pk2(sel[0], sel[1]), pk2(sel[2], sel[3])};
        }
    }
}
__device__ __forceinline__ void peer_act_phase(const Frame& F, int rbeg) {
    CArgsP a = kargs(); unsigned char* const ws = a->ws;
    const int gtid = F.vcu * NT + F.tid, GT = F.G * NT;
    const bf16* PART = (const bf16*)(ws + WS_PART); const int* EI = (const int*)(ws + WS_EI); const float* EG = (const float*)(ws + WS_EG);
    const float* SU = (const float*)(ws + WS_SU); const float* SV = (const float*)(ws + WS_SV); const float* SX = (const float*)(ws + WS_SX);
    float* ACT = (float*)(ws + WS_ACT);
    for (int i = rbeg * 32 + gtid; i < R * 32; i += GT) {
        const int r = i >> 5;
        f32x4 sum = (f32x4){0.f, 0.f, 0.f, 0.f};
#pragma unroll
        for (int q = 0; q < 8; ++q) { const v2u w = *(const v2u*)(PART + (size_t)q * R * 128 + (size_t)i * 4); sum += (f32x4){bflo(w.x), bfhi(w.x), bflo(w.y), bfhi(w.y)}; }
        const v4i id = *(const v4i*)(EI + (size_t)i * 4); const f32x4 gt = *(const f32x4*)(EG + (size_t)i * 4);
        const float sx = SX[r];
        f32x4 o;
#pragma unroll
        for (int k = 0; k < 4; ++k) o[k] = gelu_tanh(sum[k] * sx * SU[id[k]]) * gt[k] * SV[id[k]];
        *(f32x4*)(ACT + (size_t)i * 4) = o;
    }
}
__device__ __forceinline__ void peer2_phase(const Frame& F, int layer, bool dry, int rbeg) {
    CArgsP a = kargs(); unsigned char* const ws = a->ws; const bool wr = !dry || a->pad == 12345;
    const unsigned char* EV8 = ws + WS_EV; const int* EI = (const int*)(ws + WS_EI); const float* ACT = (const float*)(ws + WS_ACT);
    const float* MOD = (const float*)(ws + WS_MOD) + (size_t)layer * 9 * 6144 + 5 * D;
    const int per = F.G >> 3, s = F.vcu / per, rank = F.vcu % per, stride = per * NWAVES;
    const int lane = F.lane, part = lane & 7, e8 = lane >> 3;
    const unsigned char* tab = EV8 + (size_t)s * NEXP * 128 + 16 * part;
    const bool b5 = (lane & 32) != 0, b4 = (lane & 16) != 0, b3 = (lane & 8) != 0;
    const int dimoff = 128 * s + 16 * part + (b5 ? 8 : 0) + (b4 ? 4 : 0) + (b3 ? 2 : 0);
    int r = rbeg + rank * NWAVES + F.wave;
    LAS int* idl = (LAS int*)(F.lds + F.wave * 2048); LAS float* acl = (LAS float*)(idl + 256);
    v2u idp[2], acp[2];
#pragma unroll
    for (int u = 0; u < 2; ++u) { idp[u] = *(const v2u*)(EI + (size_t)min(r + u * stride, R - 1) * 128 + 2 * lane); acp[u] = *(const v2u*)(ACT + (size_t)min(r + u * stride, R - 1) * 128 + 2 * lane); }
    for (; r < R; r += 2 * stride) {
        v4u w[2][16]; f32x4 a4[2][4]; v4i id4[2][4];
#pragma unroll
        for (int u = 0; u < 2; ++u) { *(LAS v2u*)(idl + u * 128 + 2 * lane) = idp[u]; *(LAS v2u*)(acl + u * 128 + 2 * lane) = acp[u]; }
        LDS_WAIT();
#pragma unroll
        for (int u = 0; u < 2; ++u) {
#pragma unroll
            for (int q = 0; q < 4; ++q) id4[u][q] = *(const LAS v4i*)(idl + u * 128 + 16 * e8 + 4 * q);
#pragma unroll
            for (int j = 0; j < 16; ++j) w[u][j] = *(const v4u*)(tab + (size_t)id4[u][j >> 2][j & 3] * 128);
        }
        const int rn = r + 2 * stride;
#pragma unroll
        for (int u = 0; u < 2; ++u) { idp[u] = *(const v2u*)(EI + (size_t)min(rn + u * stride, R - 1) * 128 + 2 * lane); acp[u] = *(const v2u*)(ACT + (size_t)min(rn + u * stride, R - 1) * 128 + 2 * lane); }
#pragma unroll
        for (int u = 0; u < 2; ++u)
#pragma unroll
            for (int q = 0; q < 4; ++q) a4[u][q] = *(const LAS f32x4*)(acl + u * 128 + 16 * e8 + 4 * q);
#pragma unroll
        for (int u = 0; u < 2; ++u) {
            f32x2_t o[8];
#pragma unroll
            for (int k = 0; k < 8; ++k) o[k] = (f32x2_t){0.f, 0.f};
#pragma unroll
            for (int j = 0; j < 16; ++j) {
                const v4u ww = w[u][j];
                const float av = a4[u][j >> 2][j & 3]; const f32x2_t av2 = (f32x2_t){av, av};
                o[0] += av2 * __builtin_amdgcn_cvt_pk_f32_fp8((int)ww.x, false); o[1] += av2 * __builtin_amdgcn_cvt_pk_f32_fp8((int)ww.x, true);
                o[2] += av2 * __builtin_amdgcn_cvt_pk_f32_fp8((int)ww.y, false); o[3] += av2 * __builtin_amdgcn_cvt_pk_f32_fp8((int)ww.y, true);
                o[4] += av2 * __builtin_amdgcn_cvt_pk_f32_fp8((int)ww.z, false); o[5] += av2 * __builtin_amdgcn_cvt_pk_f32_fp8((int)ww.z, true);
                o[6] += av2 * __builtin_amdgcn_cvt_pk_f32_fp8((int)ww.w, false); o[7] += av2 * __builtin_amdgcn_cvt_pk_f32_fp8((int)ww.w, true);
            }
            f32x2_t v4[4], v2[2], v1;
#pragma unroll
            for (int k = 0; k < 4; ++k) { const f32x2_t snd = b5 ? o[k] : o[k + 4], kp = b5 ? o[k + 4] : o[k]; f32x2_t rc; rc.x = shx(snd.x, 32, lane); rc.y = shx(snd.y, 32, lane); v4[k] = kp + rc; }
#pragma unroll
            for (int k = 0; k < 2; ++k) { const f32x2_t snd = b4 ? v4[k] : v4[k + 2], kp = b4 ? v4[k + 2] : v4[k]; f32x2_t rc; rc.x = shx(snd.x, 16, lane); rc.y = shx(snd.y, 16, lane); v2[k] = kp + rc; }
            { const f32x2_t snd = b3 ? v2[0] : v2[1], kp = b3 ? v2[1] : v2[0]; f32x2_t rc; rc.x = shx(snd.x, 8, lane); rc.y = shx(snd.y, 8, lane); v1 = kp + rc; }
            const int ru = r + u * stride;
            if (ru < R) {
                const f32x2_t ga = *(const f32x2_t*)(MOD + row_slot(ru) * 6144 + dimoff);
                if (ru < NCTX) { float* xq = xc_row(a, ru) + dimoff; const f32x2_t xx = *(const f32x2_t*)xq; if (wr) *(f32x2_t*)xq = xx + ga * v1; }
                else { unsigned* xq = (unsigned*)(xl_row(a, ru) + dimoff); const unsigned w = *xq; const f32x2_t y = (f32x2_t){bflo(w), bfhi(w)} + ga * v1; if (wr) *xq = pk2(y.x, y.y); }
            }
        }
    }
}

__device__ __forceinline__ void final_phase(const Frame& F) {
    CArgsP a = kargs(); unsigned char* const ws = a->ws;
    const int gw = F.vcu * NWAVES + F.wave, NGW = F.G * NWAVES;
    f32x4 gv[4];
#pragma unroll
    for (int j = 0; j < 4; ++j) gv[j] = *((const f32x4*)a->in[I_GF] + F.lane + 64 * j);
    for (int r = gw; r < NLAT; r += NGW) {
        const v2u* xb = (const v2u*)((const bf16*)a->out + (size_t)r * XL_LD) + F.lane;
        f32x4* xr = (f32x4*)(a->out + (size_t)r * D) + F.lane;
        f32x4 v[4]; float ss = 0.f;
#pragma unroll
        for (int j = 0; j < 4; ++j) { const v2u w = xb[64 * j]; v[j] = (f32x4){bflo(w.x), bfhi(w.x), bflo(w.y), bfhi(w.y)}; ss += (v[j][0] * v[j][0] + v[j][1] * v[j][1]) + (v[j][2] * v[j][2] + v[j][3] * v[j][3]); }
        const float rs = rsqrtf(wave_sum(ss, F.lane) * (1.f / D) + EPS);
        asm volatile("s_waitcnt vmcnt(0)" ::: "memory");
#pragma unroll
        for (int j = 0; j < 4; ++j) xr[64 * j] = v[j] * rs * gv[j];
    }
}

__global__ void __launch_bounds__(NT, 2) fwd_kernel(Args args) {
    extern __shared__ __attribute__((aligned(16))) unsigned char lds[];
    Frame F;
    F.lds = (LAS unsigned char*)lds;
    F.tid = 0; F.lane = 0; F.wave = __builtin_amdgcn_readfirstlane((int)threadIdx.x >> 6);
    F.G = gridDim.x; { const int bx = blockIdx.x; F.vcu = (F.G % 8 == 0) ? (bx % 8) * (F.G / 8) + bx / 8 : bx; }
    volatile LAS unsigned* MISC = (volatile LAS unsigned*)(F.lds + MISC_OFF);
    for (int u = threadIdx.x; u < (LDS_BYTES - LDSCTL_OFF) / 4; u += NT) ((LAS unsigned*)(F.lds + LDSCTL_OFF))[u] = 0u;
    __syncthreads();
    XcdBarrier bar; bar.bar = (unsigned*)(args.ws + WS_CTL) + CW_BAR; bar.x = 0; bar.st = nullptr;
    if (MK_SINGLE) bar = xcd_barrier_post((unsigned*)(args.ws + WS_CTL) + CW_BAR, MISC + 8);
    const int lo = args.ph_lo, hi = args.ph_hi;
#define IN(k) (lo <= (k) && (k) < hi)
#define OPQ_BX ({ int bx_ = (int)blockIdx.x; asm volatile("" : "+s"(bx_)); bx_; })
#define PF Frame Fp = F; { int t_ = threadIdx.x; asm volatile("" : "+v"(t_), "+s"(Fp.vcu), "+s"(Fp.wave), "+s"(Fp.G)); Fp.tid = t_; Fp.lane = t_ & 63; }
#define SEAM(k) do { if (MK_SINGLE && IN(k) && IN((k) + 1)) { XcdBarrier b2_ = bar; asm volatile("" : "+s"(b2_.bar));     \
        xcd_barrier(b2_); if (PROBE == 50) xcd_barrier(b2_); } } while (0)

    if (IN(0)) { if (PROBE == 99) { PF; p0_prologue(Fp); } { PF; p0_prologue(Fp); } SEAM(0); }

    for (int l = 0; l < DEPTH; ++l) {
        const int pb = 1 + l * NPL;
        const int pm0 = (l == DEPTH - 1) ? 8 : 0, rbeg = pm0 * 256;
        if (IN(pb + 0)) { { PF; norm_phase(Fp, l, 0, 0); } { PF; convert_experts(Fp, l); } if (PROBE == 30) { PF; convert_experts(Fp, l); } SEAM(pb + 0); }
        if (IN(pb + 1)) {
            CArgsP ap = kargs(); unsigned char* const ws = ap->ws; bf16* Hb = (bf16*)(ws + WS_H); bf16* PA = (bf16*)(ws + WS_PA); bf16* PG = (bf16*)(ws + WS_PG);
            pg8::Gemm g{Hb, (const bf16*)(ws + WS_WIN) + (size_t)l * NPAD * D, R, NPAD, D, D}; pg8::StaticOrder S; S.init(R, NPAD, F.G, OPQ_BX);
            EpiIn E{PA, PG, (float*)(ws + WS_Z), (const float*)(ws + WS_ROPE), (bf16*)(ws + WS_VT), (bf16*)(ws + WS_NVT)};
            for (int rep = 0; rep < (PROBE == 1 ? 2 : 1); ++rep) pg8::gemm_phase<EpiIn, pg8::StaticOrder, true, true>(F.lds, g, S, E);
            SEAM(pb + 1);
        }
        if (IN(pb + 2)) { { PF; gla_a_phase(Fp, l); } if (PROBE == 2) { PF; gla_a_phase(Fp, l); } { const int nrep = (PROBE == 20 ? 2 : 1) + (kargs()->pad != 0 ? 1 : 0); for (int rep = 0; rep < nrep; ++rep) { PF; na_phase(Fp, l, rep + 1 < nrep, l == DEPTH - 1); } } SEAM(pb + 2); }
        if (IN(pb + 3)) { if (PROBE == 3) { PF; gla_b_phase(Fp, true); } { PF; gla_b_phase(Fp, false); } SEAM(pb + 3); }
        if (IN(pb + 4)) { if (PROBE == 4) { PF; gla_c_phase(Fp, l, true); } { PF; gla_c_phase(Fp, l, false); } SEAM(pb + 4); }
        if (IN(pb + 5)) {
            CArgsP ap = kargs(); unsigned char* const ws = ap->ws; bf16* Hb = (bf16*)(ws + WS_H); bf16* PA = (bf16*)(ws + WS_PA); bf16* PG = (bf16*)(ws + WS_PG);
            pg8::ShiftOrder S; S.init(R - rbeg, D, F.G, OPQ_BX); S.pm0 = pm0;
            { pg8::Gemm g{PA + PA_R, (const bf16*)(ws + WS_WPG) + (size_t)l * D * D, R, D, D, PA_LD}; EpiMergeK E{Hb, PG}; for (int rep = 0; rep < (PROBE == 5 ? 2 : 1); ++rep) pg8::gemm_phase<EpiMergeK, pg8::ShiftOrder, true, true>(F.lds, g, S, E); }
            SEAM(pb + 5);
        }
        if (IN(pb + 6)) {
            CArgsP ap = kargs(); unsigned char* const ws = ap->ws; bf16* Hb = (bf16*)(ws + WS_H);
            pg8::Gemm g{Hb, (const bf16*)(ws + WS_WO) + (size_t)l * D * D, R, D, D, D}; pg8::ShiftOrder S; S.init(R - rbeg, D, F.G, OPQ_BX); S.pm0 = pm0;
            EpiRes E{l == 0 ? ap->in[I_CTX] : (const float*)(ws + WS_XC), ap->in[I_X], (float*)(ws + WS_XC), (bf16*)ap->out, (const float*)(ws + WS_MOD) + (size_t)l * 9 * 6144, l == 0 ? 1 : 0};
            pg8::gemm_phase<EpiRes, pg8::ShiftOrder, true, true>(F.lds, g, S, E);
            SEAM(pb + 6);
        }
        if (IN(pb + 7)) { if (PROBE == 7) { PF; norm_phase(Fp, l, 1, rbeg); } { PF; norm_phase(Fp, l, 1, rbeg); } SEAM(pb + 7); }
        if (IN(pb + 8)) {
            CArgsP ap = kargs(); unsigned char* const ws = ap->ws; bf16* Hb = (bf16*)(ws + WS_H);
            pg8::Gemm g{Hb, (const bf16*)(ws + WS_WS) + (size_t)l * 2048 * D, R, 2048, D, D}; pg8::ShiftOrder S; S.init(R - rbeg, 2048, F.G, OPQ_BX); S.pm0 = pm0;
            EpiB16 E{(bf16*)(ws + WS_SC), 2048};
            for (int rep = 0; rep < (PROBE == 8 ? 2 : 1); ++rep) pg8::gemm_phase<EpiB16, pg8::ShiftOrder, true, true>(F.lds, g, S, E);
            SEAM(pb + 8);
        }
        if (IN(pb + 9)) { if (PROBE == 9) { PF; topk_phase(Fp, rbeg); } { PF; topk_phase(Fp, rbeg); } SEAM(pb + 9); }
        if (IN(pb + 10)) { if (PROBE == 10) { PF; peer1_phase(Fp, rbeg); } { PF; peer1_phase(Fp, rbeg); } SEAM(pb + 10); }
        if (IN(pb + 11)) { if (PROBE == 11) { PF; peer_act_phase(Fp, rbeg); } { PF; peer_act_phase(Fp, rbeg); } SEAM(pb + 11); }
        if (IN(pb + 12)) { if (PROBE == 12) { PF; peer2_phase(Fp, l, true, rbeg); } { PF; peer2_phase(Fp, l, false, rbeg); } SEAM(pb + 12); }
    }
    if (IN(NPHASE - 1)) { PF; final_phase(Fp); }
#undef IN
#undef SEAM
}

extern "C" void kernel_launch(void* const* d_in, const int* in_sizes, int n_in, void* d_out, int out_size, void* d_ws, size_t ws_size, hipStream_t stream) {
    static int grid = 0;
    if (grid == 0) {
        if (n_in != 23 || in_sizes[0] != NLAT * D || out_size != NLAT * D || ws_size < WS_END) { fprintf(stderr, "kernel_launch: unexpected shapes (n_in %d, in0 %d, out %d, ws %zu); nothing launched\n", n_in, n_in > 0 ? in_sizes[0] : -1, out_size, ws_size); grid = -1; return; }
        int dev = 0, cus = 0, per_cu = 0;
        if (hipGetDevice(&dev) != hipSuccess || hipDeviceGetAttribute(&cus, hipDeviceAttributeMultiprocessorCount, dev) != hipSuccess) { grid = -1; return; }
        if (hipFuncSetAttribute((const void*)fwd_kernel, hipFuncAttributeMaxDynamicSharedMemorySize, LDS_BYTES) != hipSuccess) { fprintf(stderr, "kernel_launch: hipFuncSetAttribute failed\n"); grid = -1; return; }
        if (hipOccupancyMaxActiveBlocksPerMultiprocessor(&per_cu, (const void*)fwd_kernel, NT, LDS_BYTES) != hipSuccess || per_cu < 1) { fprintf(stderr, "kernel_launch: occupancy query says %d blocks per CU\n", per_cu); }
        (void)hipGetLastError();
        grid = cus;
    }
    if (grid < 0) return;
    if (hipMemsetAsync((char*)d_ws + WS_CTL, 0, CTL_ZERO_BYTES, stream) != hipSuccess) return;
    Args a{};
    for (int i = 0; i < 23; ++i) a.in[i] = (const float*)d_in[i];
    a.out = (float*)d_out; a.ws = (unsigned char*)d_ws; a.pad = 0;
    if (MK_SINGLE) {
        a.ph_lo = 0; a.ph_hi = NPHASE; a.li = 0;
        hipLaunchKernelGGL(fwd_kernel, dim3(grid), dim3(NT), LDS_BYTES, stream, a);
    } else {
        for (int p = 0; p < NPHASE; ++p) { a.ph_lo = p; a.ph_hi = p + 1; a.li = p; hipLaunchKernelGGL(fwd_kernel, dim3(grid), dim3(NT), LDS_BYTES, stream, a); }
    }
}
```

```cpp
#include <hip/hip_runtime.h>
#include <cstdio>
#include <cstdint>

#ifndef PROBE
#define PROBE 0
#endif
#ifndef MK_SINGLE
#define MK_SINGLE 1
#endif

namespace pg8 {
#define PG8_LAS __attribute__((address_space(3)))
typedef unsigned short bf16_t;
typedef short bf16x8 __attribute__((ext_vector_type(8)));
typedef float f32x4 __attribute__((ext_vector_type(4)));
typedef unsigned u32x4 __attribute__((ext_vector_type(4)));
constexpr int BM = 256, BK = 64, HALF = 128, HTB = HALF * BK * 2, STAGE_BYTES = 8 * HTB, NXCD = 8, WGM = 8;

__host__ __device__ __forceinline__ int lds_byte(int r, int c) { const int st = (r >> 4) * 2 + (c >> 5), rr = r & 15, cc = c & 31, ob = rr * 64 + cc * 2; return st * 1024 + (ob ^ (((ob >> 9) & 1) << 5)); }
__host__ __device__ __forceinline__ void stage_rc(int b, int& R, int& C) { const int st = b / 1024, sb = b % 1024, swz = sb ^ (((sb >> 9) & 1) << 5); R = (st >> 1) * 16 + swz / 64; C = (st & 1) * 32 + (swz % 64) / 2; }
__host__ __device__ __forceinline__ int perm32(int rho) { const int n = rho >> 4, i = rho & 15; return 8 * (i >> 2) + 4 * n + (i & 3); }

struct Unit { int pm, pn; };
struct Gemm { const bf16_t* A; const bf16_t* Bt; int M, N, K, lda; };

struct StaticOrder {
    int nM, nN, nwg, G, c;
    __host__ __device__ void init(int M, int N, int G_, int c_) { nM = M / BM; nN = N / BM; nwg = nM * nN; G = G_; c = c_; }
    __host__ __device__ bool next(int i, Unit& u) const {
        const long L = (long)i * G + c; if (L >= nwg) return false;
        int wgid = (int)L; { const int q = nwg / NXCD, r = nwg % NXCD, xcd = wgid % NXCD, off = wgid / NXCD; wgid = (xcd < r ? xcd * (q + 1) : r * (q + 1) + (xcd - r) * q) + off; }
        const int nig = WGM * nN, gid = wgid / nig, fm = gid * WGM, gsz = (nM - fm) < WGM ? (nM - fm) : WGM;
        u.pm = fm + ((wgid % nig) % gsz); u.pn = (wgid % nig) / gsz; return true;
    }
    __device__ __forceinline__ void a_ready(const Unit&) const {}
    __device__ __forceinline__ void done(const Unit&) const {}
};
struct ShiftOrder : StaticOrder { int pm0; __host__ __device__ bool next(int i, Unit& u) const { if (!StaticOrder::next(i, u)) return false; u.pm += pm0; return true; } };

__device__ __forceinline__ unsigned cvt_pk_bf16(float lo, float hi) { unsigned r; asm volatile("v_cvt_pk_bf16_f32 %0, %1, %2" : "=v"(r) : "v"(lo), "v"(hi)); return r; }

template <class Epi, class Sched, bool ALIGN_EPI = false, bool SP2 = false>
__device__ __forceinline__ void gemm_phase(PG8_LAS unsigned char* lds, const Gemm g, const Sched& S, const Epi& E) {
    int tid_ = threadIdx.x; asm volatile("" : "+v"(tid_));
    const int tid = tid_, wid = __builtin_amdgcn_readfirstlane(tid >> 6), lane = tid & 63, wr = wid >> 2, wc = wid & 3, fr = lane & 15, fq = lane >> 4;
    const int K = g.K, nt = K / BK, lda = g.lda;
    unsigned voffA[2], voffB[2];
#pragma unroll
    for (int i = 0; i < 2; ++i) { int R, C; stage_rc(tid * 16 + i * 8192, R, C); const int Rb = Epi::PERM ? ((R & ~31) + perm32(R & 31)) : R;
        voffA[i] = (unsigned)(R * lda + C) * 2u; voffB[i] = (unsigned)(Rb * K + C) * 2u; }
    const size_t kstep = (size_t)(BK * 2);
    const size_t hstepA = (size_t)HALF * lda * 2, hstepB = (size_t)HALF * K * 2;
    const size_t tstepA = 2 * hstepA, tstepB = 2 * hstepB;
    const unsigned ldsw = (unsigned)wid * 1024u;
    const int aoff = lds_byte(wr * 64 + fr, fq * 8), boff = lds_byte(wc * 32 + fr, fq * 8);
#define PG8_SA(b, h) (((b) * 2 + (h)) * HTB)
#define PG8_SB(b, h) ((4 + (b) * 2 + (h)) * HTB)
#define PG8_STAGE(bufoff, gbase, voff) do { _Pragma("unroll") for (int _i = 0; _i < 2; ++_i) \
        __builtin_amdgcn_global_load_lds((const unsigned*)((const char*)(gbase) + (voff)[_i]), (PG8_LAS unsigned*)(lds + (bufoff) + ldsw + _i * 8192), 16, 0, 0); } while (0)
#define PG8_LDA(dst, b, h) do { _Pragma("unroll") for (int m = 0; m < 4; ++m) _Pragma("unroll") for (int k = 0; k < 2; ++k) dst[m][k] = *(const PG8_LAS bf16x8*)(lds + PG8_SA(b, h) + aoff + m * 2048 + k * 1024); } while (0)
#define PG8_LDB(dst, b, h) do { _Pragma("unroll") for (int n = 0; n < 2; ++n) _Pragma("unroll") for (int k = 0; k < 2; ++k) dst[n][k] = *(const PG8_LAS bf16x8*)(lds + PG8_SB(b, h) + boff + n * 2048 + k * 1024); } while (0)
#define PG8_MMA(ai, bj, At, Bt) do { __builtin_amdgcn_s_setprio(1); _Pragma("unroll") for (int m = 0; m < 4; ++m) _Pragma("unroll") for (int n = 0; n < 2; ++n) _Pragma("unroll") for (int k = 0; k < 2; ++k) \
        acc[ai][bj][m][n] = __builtin_amdgcn_mfma_f32_16x16x32_bf16(Bt[n][k], At[m][k], acc[ai][bj][m][n], 0, 0, 0); __builtin_amdgcn_s_setprio(0); } while (0)
#define PG8_WAIT_V(n) asm volatile("s_waitcnt vmcnt(" #n ")" ::: "memory")
#define PG8_WAIT_L(n) asm volatile("s_waitcnt lgkmcnt(" #n ")" ::: "memory")
#define PG8_BAR __builtin_amdgcn_s_barrier()
#define PG8_SCHED __builtin_amdgcn_sched_barrier(0)
    Unit cur, nxt; int ui = 0;
    if (!S.next(0, cur)) return;
    f32x4 acc[2][2][4][2];
#pragma unroll
    for (int a = 0; a < 2; ++a)
#pragma unroll
        for (int b = 0; b < 2; ++b)
#pragma unroll
            for (int m = 0; m < 4; ++m)
#pragma unroll
                for (int n = 0; n < 2; ++n) acc[a][b][m][n] = (f32x4){0.f, 0.f, 0.f, 0.f};
    bf16x8 At[4][2], B0[2][2], B1[2][2];
    const char* cA = (const char*)g.A + (size_t)cur.pm * tstepA; const char* cB = (const char*)g.Bt + (size_t)cur.pn * tstepB;
    S.a_ready(cur);
    if constexpr (SP2) {
        PG8_STAGE(PG8_SB(0, 0), cB, voffB); PG8_STAGE(PG8_SB(0, 1), cB + hstepB, voffB); PG8_STAGE(PG8_SA(0, 0), cA, voffA); PG8_STAGE(PG8_SA(0, 1), cA + hstepA, voffA);
        if (wr == 1) PG8_BAR;
        PG8_WAIT_V(2); PG8_BAR;
        PG8_STAGE(PG8_SB(1, 0), cB + kstep, voffB); PG8_STAGE(PG8_SA(1, 0), cA + kstep, voffA); PG8_STAGE(PG8_SB(1, 1), cB + hstepB + kstep, voffB);
        PG8_WAIT_V(6); PG8_BAR;
    } else {
        PG8_STAGE(PG8_SB(0, 0), cB, voffB); PG8_STAGE(PG8_SA(0, 0), cA, voffA); PG8_STAGE(PG8_SB(0, 1), cB + hstepB, voffB); PG8_STAGE(PG8_SA(0, 1), cA + hstepA, voffA);
        if (wr == 1) PG8_BAR;
        PG8_WAIT_V(4); PG8_BAR;
        PG8_STAGE(PG8_SB(1, 0), cB + kstep, voffB); PG8_STAGE(PG8_SA(1, 0), cA + kstep, voffA); PG8_STAGE(PG8_SB(1, 1), cB + hstepB + kstep, voffB);
        PG8_WAIT_V(6); PG8_BAR;
    }
    for (;;) {
        const bool has_next = S.next(ui + 1, nxt);
        const char* nA = has_next ? (const char*)g.A + (size_t)nxt.pm * tstepA : cA; const char* nB = has_next ? (const char*)g.Bt + (size_t)nxt.pn * tstepB : cB;
        for (int t = 0; t < nt; t += 2) {
            const bool last = (t == nt - 2);
            const char* a1 = cA + (size_t)(t + 1) * kstep;
            const char* a2 = last ? nA : cA + (size_t)(t + 2) * kstep; const char* b2 = last ? nB : cB + (size_t)(t + 2) * kstep;
            const char* a3 = a2 + kstep; const char* b3 = b2 + kstep;
            if (last && has_next) S.a_ready(nxt);
            if constexpr (Epi::HAS_MID) { if (t == nt / 2) E.mid(acc, cur, wr, wc, fr, fq); }
            if constexpr (SP2) {
            PG8_LDB(B0, 0, 0); PG8_LDB(B1, 0, 1); PG8_SCHED; PG8_LDA(At, 0, 0); PG8_STAGE(PG8_SA(1, 1), a1 + hstepA, voffA);
            PG8_WAIT_V(8); PG8_WAIT_L(0); PG8_BAR; PG8_MMA(0, 0, At, B0); PG8_MMA(0, 1, At, B1); PG8_BAR; PG8_SCHED;
            PG8_LDA(At, 0, 1); PG8_STAGE(PG8_SB(0, 0), b2, voffB); PG8_STAGE(PG8_SB(0, 1), b2 + hstepB, voffB); PG8_STAGE(PG8_SA(0, 0), a2, voffA);
            PG8_WAIT_V(8); PG8_WAIT_L(0); PG8_BAR; PG8_MMA(1, 0, At, B0); PG8_MMA(1, 1, At, B1); PG8_BAR; PG8_SCHED;
            PG8_LDB(B0, 1, 0); PG8_LDB(B1, 1, 1); PG8_SCHED; PG8_LDA(At, 1, 0); PG8_STAGE(PG8_SA(0, 1), a2 + hstepA, voffA);
            PG8_WAIT_V(8); PG8_WAIT_L(0); PG8_BAR; PG8_MMA(0, 0, At, B0); PG8_MMA(0, 1, At, B1); PG8_BAR; PG8_SCHED;
            PG8_LDA(At, 1, 1); PG8_STAGE(PG8_SB(1, 0), b3, voffB); PG8_STAGE(PG8_SB(1, 1), b3 + hstepB, voffB); PG8_STAGE(PG8_SA(1, 0), a3, voffA);
            PG8_WAIT_V(8); PG8_WAIT_L(0); PG8_BAR; PG8_MMA(1, 0, At, B0); PG8_MMA(1, 1, At, B1); PG8_BAR; PG8_SCHED;
            } else {
            PG8_LDB(B0, 0, 0); PG8_SCHED; PG8_LDA(At, 0, 0); PG8_STAGE(PG8_SA(1, 1), a1 + hstepA, voffA);
            PG8_WAIT_L(8); PG8_BAR; PG8_WAIT_L(0); PG8_MMA(0, 0, At, B0); PG8_BAR; PG8_SCHED;
            PG8_LDB(B1, 0, 1); PG8_STAGE(PG8_SB(0, 0), b2, voffB);
            PG8_BAR; PG8_WAIT_L(0); PG8_MMA(0, 1, At, B1); PG8_BAR;
            PG8_LDA(At, 0, 1); PG8_STAGE(PG8_SA(0, 0), a2, voffA);
            PG8_BAR; PG8_WAIT_L(0); PG8_MMA(1, 0, At, B0); PG8_BAR; PG8_SCHED;
            PG8_STAGE(PG8_SB(0, 1), b2 + hstepB, voffB);
            PG8_WAIT_V(6); PG8_BAR; PG8_MMA(1, 1, At, B1); PG8_BAR;
            PG8_LDB(B0, 1, 0); PG8_SCHED; PG8_LDA(At, 1, 0); PG8_STAGE(PG8_SA(0, 1), a2 + hstepA, voffA);
            PG8_WAIT_L(8); PG8_BAR; PG8_WAIT_L(0); PG8_MMA(0, 0, At, B0); PG8_BAR; PG8_SCHED;
            PG8_LDB(B1, 1, 1); PG8_STAGE(PG8_SB(1, 0), b3, voffB);
            PG8_BAR; PG8_WAIT_L(0); PG8_MMA(0, 1, At, B1); PG8_BAR;
            PG8_LDA(At, 1, 1); PG8_STAGE(PG8_SA(1, 0), a3, voffA);
            PG8_BAR; PG8_WAIT_L(0); PG8_MMA(1, 0, At, B0); PG8_BAR; PG8_SCHED;
            PG8_STAGE(PG8_SB(1, 1), b3 + hstepB, voffB);
            PG8_WAIT_V(6); PG8_BAR; PG8_MMA(1, 1, At, B1); PG8_BAR;
            }
        }
        if constexpr (ALIGN_EPI) { if (wr == 0) PG8_BAR; }
        E(acc, cur, wr, wc, fr, fq); S.done(cur);
        if (!has_next) break;
#pragma unroll
        for (int a = 0; a < 2; ++a)
#pragma unroll
            for (int b = 0; b < 2; ++b)
#pragma unroll
                for (int m = 0; m < 4; ++m)
#pragma unroll
                    for (int n = 0; n < 2; ++n) acc[a][b][m][n] = (f32x4){0.f, 0.f, 0.f, 0.f};
        cur = nxt; cA = nA; cB = nB; ++ui;
        if constexpr (ALIGN_EPI) { if (wr == 1) PG8_BAR; }
    }
    PG8_WAIT_V(0);
    if constexpr (!ALIGN_EPI) { if (wr == 0) PG8_BAR; }
    PG8_BAR;
#undef PG8_SA
#undef PG8_SB
#undef PG8_STAGE
#undef PG8_LDA
#undef PG8_LDB
#undef PG8_MMA
#undef PG8_WAIT_V
#undef PG8_WAIT_L
#undef PG8_BAR
#undef PG8_SCHED
}
}

constexpr int D = 1024, BATCH = 8, SEQ = 8192, DEPTH = 4, CTXL = 256, GRIDW = 64;
constexpr int NCTX = BATCH * CTXL;
constexpr int NLAT = BATCH * SEQ;
constexpr int R = NCTX + NLAT;
constexpr int IN_COLS = 5152, NPAD = 5376;
constexpr int PA_LD = 2048, PG_LD = 2048;
constexpr int PA_Q = 0, PA_K = 256, PA_R = 512, PA_NQ = 1024, PA_NK = 1536;
constexpr int NCHUNK = 132;
constexpr int NEXP = 16384;
constexpr float EPS = 1e-6f;
constexpr int NWAVES = 8, NT = 512;
constexpr int NPL = 13;
constexpr int NPHASE = 1 + DEPTH * NPL + 1;

constexpr size_t MiB = 1u << 20;
constexpr size_t WS_CTL = 0, CTL_ZERO_BYTES = 2 * MiB;
constexpr size_t WS_MOD = 1 * MiB;
constexpr size_t WS_ROPE = 2 * MiB;
constexpr size_t WS_WIN = 3 * MiB;
constexpr size_t WS_WPG = 45 * MiB, WS_WPN = 49 * MiB;
constexpr size_t WS_WO = 53 * MiB;
constexpr size_t WS_WS = 61 * MiB;
constexpr size_t WS_XC = 77 * MiB;
constexpr size_t WS_Z = 85 * MiB;
constexpr size_t WS_EU = 94 * MiB, WS_EV = 110 * MiB;
constexpr size_t WS_SU = 126 * MiB, WS_SV = WS_SU + 65536, WS_SX = WS_SV + 65536;
constexpr size_t WS_H8 = 884 * MiB;
constexpr size_t WS_PART = 290 * MiB;
constexpr size_t WS_ACT = 554 * MiB;
constexpr size_t WS_H = 158 * MiB;
constexpr size_t WS_PA = 290 * MiB;
constexpr size_t WS_VT = 554 * MiB, WS_NVT = 620 * MiB;
constexpr size_t WS_DEC = 950 * MiB;
constexpr size_t WS_PG = 686 * MiB;
constexpr size_t WS_SC = 290 * MiB;
constexpr size_t WS_EI = 818 * MiB, WS_EG = 851 * MiB;
constexpr size_t WS_END = 953 * MiB;
static_assert(WS_SC + (size_t)R * 2048 * 4 <= WS_EI && WS_EG + (size_t)R * 128 * 4 <= WS_DEC && WS_PG + (size_t)R * PG_LD * 2 <= WS_DEC && WS_DEC + 64 * 132 * 64 * 4 <= WS_END, "ws map");
static_assert(WS_H + (size_t)R * 1024 * 2 <= WS_PA && WS_PA + (size_t)R * PA_LD * 2 <= WS_VT && WS_VT + (size_t)R * 512 * 2 <= WS_NVT && WS_NVT + (size_t)R * 512 * 2 <= WS_PG && WS_Z + (size_t)R * 32 * 4 <= WS_EU, "ws map");
constexpr int CW_BAR = 4096;

constexpr int RING_BYTES = 131072, LDSCTL_OFF = RING_BYTES, MISC_OFF = LDSCTL_OFF + 320, LDS_BYTES = 147456;

#define GAS __attribute__((address_space(1)))
#define LAS __attribute__((address_space(3)))
typedef unsigned short bf16;
typedef unsigned v4u __attribute__((ext_vector_type(4)));
typedef unsigned v2u __attribute__((ext_vector_type(2)));
typedef int v4i __attribute__((ext_vector_type(4)));
typedef float f32x4 __attribute__((ext_vector_type(4)));
typedef __bf16 bf16x2_t __attribute__((ext_vector_type(2)));
#define LDS_WAIT() asm volatile("s_waitcnt lgkmcnt(0)" ::: "memory")
#define VM_WAIT() asm volatile("s_waitcnt vmcnt(0)" ::: "memory")
__device__ __forceinline__ unsigned f2bf(float f) { unsigned u = __builtin_bit_cast(unsigned, f); return (u + 0x7fffu + ((u >> 16) & 1u)) >> 16; }
__device__ __forceinline__ unsigned pk2(float lo, float hi) { return f2bf(lo) | (f2bf(hi) << 16); }
__device__ __forceinline__ float bflo(unsigned w) { return __builtin_bit_cast(float, w << 16); }
__device__ __forceinline__ float bfhi(unsigned w) { return __builtin_bit_cast(float, w & 0xffff0000u); }
__device__ __forceinline__ float bf1(bf16 h) { return __builtin_bit_cast(float, ((unsigned)h) << 16); }
__device__ __forceinline__ float dot2(unsigned a, unsigned b, float acc) { return __builtin_amdgcn_fdot2_f32_bf16(__builtin_bit_cast(bf16x2_t, a), __builtin_bit_cast(bf16x2_t, b), acc, false); }
__device__ __forceinline__ float shx(float v, int mask, int lane) { return __builtin_bit_cast(float, __builtin_amdgcn_ds_bpermute((lane ^ mask) << 2, __builtin_bit_cast(int, v))); }
__device__ __forceinline__ float wave_sum(float v, int lane) {
#pragma unroll
    for (int o = 1; o < 64; o <<= 1) v += shx(v, o, lane);
    return v;
}
__device__ __forceinline__ float wave_max(float v, int lane) {
#pragma unroll
    for (int o = 1; o < 64; o <<= 1) v = fmaxf(v, shx(v, o, lane));
    return v;
}
__device__ __forceinline__ float sigmoidf_(float x) { return __builtin_amdgcn_rcpf(1.f + __expf(-x)); }

#define XB_TMO      128
#define XB_XCNT(j)  (256  + 64 * (j))
#define XB_XSUB(j)  (1280 + 64 * (j))
#define XB_XGEN(j)  (2304 + 64 * (j))
#define XB_TOP      3328
#define XB_TOPGEN   3392
#define XCD_BAR_WORDS 3456
#define XB_SPIN_CAP (1u << 18)
__device__ __forceinline__ unsigned xb_ld(unsigned* p)              { return __hip_atomic_load(p, __ATOMIC_RELAXED, __HIP_MEMORY_SCOPE_AGENT); }
__device__ __forceinline__ unsigned xb_add(unsigned* p, unsigned v) { return __hip_atomic_fetch_add(p, v, __ATOMIC_RELAXED, __HIP_MEMORY_SCOPE_AGENT); }
__device__ __forceinline__ unsigned xb_xcc_id() { return (unsigned)__builtin_amdgcn_s_getreg((3 << 11) | 20) & 0xFu; }
#define XB_SPIN(cond, bar) do { unsigned _sp = 0; while (cond) { __builtin_amdgcn_s_sleep(1); \
    if ((++_sp & 255u) == 0u) { if (xb_ld(&(bar)[XB_TMO])) break; if (_sp > XB_SPIN_CAP) { atomicAdd(&(bar)[XB_TMO], 1u); break; } } } } while (0)
struct XcdBarrier { unsigned* bar; unsigned x; volatile LAS unsigned* st; };
__device__ __forceinline__ XcdBarrier xcd_barrier_post(unsigned* bar, volatile LAS unsigned* st) {
    XcdBarrier b; b.bar = bar; b.x = xb_xcc_id(); b.st = st;
    if (threadIdx.x == 0) (void)xb_add(&bar[XB_XCNT(b.x)], 1u);
    return b;
}
__device__ __forceinline__ void xcd_barrier_complete(unsigned* bar, unsigned x, unsigned& nloc, unsigned& nx) {
    const unsigned G = gridDim.x * gridDim.y * gridDim.z;
    unsigned sum, cnt, mine, sp = 0u;
    for (;;) {
        sum = 0u; cnt = 0u; mine = 0u;
#pragma unroll
        for (unsigned j = 0; j < 16; ++j) { const unsigned c = xb_ld(&bar[XB_XCNT(j)]); sum += c; cnt += (c > 0u) ? 1u : 0u; mine = (j == x) ? c : mine; }
        if (sum == G) break;
        __builtin_amdgcn_s_sleep(1);
        if ((++sp & 255u) == 0u) { if (xb_ld(&bar[XB_TMO])) break; if (sp > XB_SPIN_CAP) { atomicAdd(&bar[XB_TMO], 1u); break; } }
    }
    nloc = mine > 0u ? mine : 1u; nx = cnt > 0u ? cnt : 1u;
}
__device__ __forceinline__ void xcd_barrier(const XcdBarrier& b) {
    asm volatile("s_waitcnt vmcnt(0)" ::: "memory");
    __syncthreads();
    int tid0_ = threadIdx.x; asm volatile("" : "+v"(tid0_));
    if (tid0_ == 0) {
        unsigned* bar = b.bar;
        __builtin_amdgcn_s_waitcnt(0);
        unsigned nloc = b.st[0], nx = b.st[1];
        if (nloc == 0u) { xcd_barrier_complete(bar, b.x, nloc, nx); b.st[0] = nloc; b.st[1] = nx; }
        const unsigned old = xb_add(&bar[XB_XSUB(b.x)], 1u);
        const unsigned gen = old / nloc;
        if (old + 1u == (gen + 1u) * nloc) {
            __builtin_amdgcn_fence(__ATOMIC_RELEASE, "agent");
            asm volatile("s_waitcnt vmcnt(0)" ::: "memory");
            const unsigned og = xb_add(&bar[XB_TOP], 1u);
            const unsigned tg = og / nx;
            if (og + 1u == (tg + 1u) * nx) xb_add(&bar[XB_TOPGEN], 1u);
            else XB_SPIN(xb_ld(&bar[XB_TOPGEN]) == tg, bar);
            __builtin_amdgcn_fence(__ATOMIC_ACQUIRE, "agent");
            xb_add(&bar[XB_XGEN(b.x)], 1u);
            asm volatile("s_waitcnt vmcnt(0)" ::: "memory");
        } else {
            XB_SPIN(xb_ld(&bar[XB_XGEN(b.x)]) == gen, bar);
            __builtin_amdgcn_fence(__ATOMIC_ACQUIRE, "agent");
            asm volatile("s_waitcnt vmcnt(0)" ::: "memory");
        }
    }
    __syncthreads();
}

struct Args { const float* in[23]; float* out; unsigned char* ws; int ph_lo, ph_hi, li, pad; };
enum { I_X = 0, I_C, I_CTX, I_CCTX, I_WMOD, I_BMOD, I_GN1, I_WIN, I_WAF, I_BAF, I_WAB, I_BAB, I_GGLA, I_RPB, I_WPG, I_WPN, I_WO, I_GN2, I_WQ, I_SK, I_EU, I_EV, I_GF };

struct Frame {
    LAS unsigned char* lds;
    int tid, lane, wave, vcu, G;
};
typedef const __attribute__((address_space(4))) Args* CArgsP;
__device__ __forceinline__ CArgsP kargs() { CArgsP p = (CArgsP)__builtin_amdgcn_kernarg_segment_ptr(); asm volatile("" : "+s"(p)); return p; }
__device__ __forceinline__ const float* xrow_in(CArgsP a, int r) { return r < NCTX ? a->in[I_CTX] + (size_t)r * D : a->in[I_X] + (size_t)(r - NCTX) * D; }
constexpr int XL_LD = 2048;
__device__ __forceinline__ float* xc_row(CArgsP a, int r) { return (float*)(a->ws + WS_XC) + (size_t)r * D; }
__device__ __forceinline__ bf16* xl_row(CArgsP a, int r) { return (bf16*)a->out + (size_t)(r - NCTX) * XL_LD; }
__device__ __forceinline__ int row_slot(int r) { return r < NCTX ? 8 : ((r - NCTX) >> 13); }

using pg8::f32x4; using pg8::u32x4; using pg8::Unit; using pg8::cvt_pk_bf16;
struct EpiIn {
    static constexpr bool HAS_MID = false, PERM = true;
    bf16* PA; bf16* PG; float* Z; const float* rope; bf16* VT; bf16* NVT;
    __device__ __forceinline__ void operator()(const f32x4 (&acc)[2][2][4][2], const Unit& u, int wr, int wc, int fr, int fq) const {
        const int pn = u.pn, row0 = u.pm * 256 + wr * 64 + fr;
        if (pn == 20) {
            if (wc == 0) {
#pragma unroll
                for (int ai = 0; ai < 2; ++ai)
#pragma unroll
                    for (int m = 0; m < 4; ++m) { float* zp = Z + (size_t)(row0 + ai * 128 + m * 16) * 32 + 8 * fq; *(f32x4*)zp = acc[ai][0][m][0]; *(f32x4*)(zp + 4) = acc[ai][0][m][1]; }
            }
            return;
        }
        if (pn >= 8 && pn < 12) {
            bf16* T = (pn < 10 ? VT : NVT) + (size_t)(((pn - 8) & 1) * 256 + wc * 32 + 8 * fq) * R;
#pragma unroll
            for (int ai = 0; ai < 2; ++ai)
#pragma unroll
                for (int m = 0; m < 4; ++m) {
                    const int row = row0 + ai * 128 + m * 16;
#pragma unroll
                    for (int bj = 0; bj < 2; ++bj) {
                        const f32x4 v0 = acc[ai][bj][m][0], v1 = acc[ai][bj][m][1];
                        bf16* tp = T + (size_t)(bj * 128) * R + row;
                        tp[0 * (size_t)R] = (bf16)f2bf(v0[0]); tp[1 * (size_t)R] = (bf16)f2bf(v0[1]); tp[2 * (size_t)R] = (bf16)f2bf(v0[2]); tp[3 * (size_t)R] = (bf16)f2bf(v0[3]);
                        tp[4 * (size_t)R] = (bf16)f2bf(v1[0]); tp[5 * (size_t)R] = (bf16)f2bf(v1[1]); tp[6 * (size_t)R] = (bf16)f2bf(v1[2]); tp[7 * (size_t)R] = (bf16)f2bf(v1[3]);
                    }
                }
            return;
        }
        bf16* base; int ldc, colt;
        if (pn < 8) { base = PA; ldc = PA_LD; colt = pn * 256; } else { base = PG; ldc = PG_LD; colt = (pn - 12) * 256; }
        const int col0 = colt + wc * 32 + 8 * fq;
        const bool do_rope = (pn < 2) && (u.pm >= 8);
        const float sc = (pn == 0 || pn == 4 || pn == 5) ? 0.125f : 1.f;
#pragma unroll
        for (int ai = 0; ai < 2; ++ai)
#pragma unroll
            for (int m = 0; m < 4; ++m) {
                const int row = row0 + ai * 128 + m * 16;
                bf16* rowp = base + (size_t)row * ldc + col0;
                f32x4 cs[4];
                if (do_rope) { const int t = (row - NCTX) & (SEQ - 1); const int pos = (wc & 1) ? (t & 63) : (t >> 6);
                    const f32x4* cp = (const f32x4*)(rope + (size_t)(pos * 16 + 8 * (fq & 1)) * 2);
                    cs[0] = cp[0]; cs[1] = cp[1]; cs[2] = cp[2]; cs[3] = cp[3]; }
#pragma unroll
                for (int bj = 0; bj < 2; ++bj) {
                    f32x4 v0 = acc[ai][bj][m][0], v1 = acc[ai][bj][m][1];
                    if (do_rope) {
                        float x[8] = {v0[0], v0[1], v0[2], v0[3], v1[0], v1[1], v1[2], v1[3]};
#pragma unroll
                        for (int e = 0; e < 8; ++e) { const float p = shx(x[e], 32, fr + 16 * fq); const float c = cs[e >> 1][(e & 1) * 2], s = cs[e >> 1][(e & 1) * 2 + 1];
                            x[e] = (fq < 2) ? (x[e] * c - p * s) : (p * s + x[e] * c); }
                        v0 = (f32x4){x[0], x[1], x[2], x[3]}; v1 = (f32x4){x[4], x[5], x[6], x[7]};
                    }
                    v0 = v0 * sc; v1 = v1 * sc;
                    u32x4 w; w.x = cvt_pk_bf16(v0[0], v0[1]); w.y = cvt_pk_bf16(v0[2], v0[3]); w.z = cvt_pk_bf16(v1[0], v1[1]); w.w = cvt_pk_bf16(v1[2], v1[3]);
                    *(u32x4*)(rowp + bj * 128) = w;
                }
                asm volatile("" ::: "memory");
            }
    }
};
struct EpiMergeK {
    static constexpr bool HAS_MID = true, PERM = true;
    bf16* MG; const bf16* PG;
    __device__ __forceinline__ void mid(f32x4 (&acc)[2][2][4][2], const Unit& u, int wr, int wc, int fr, int fq) const {
        int row0 = u.pm * 256 + wr * 64 + fr, col0 = u.pn * 256 + wc * 32 + 8 * fq;
        asm volatile("" : "+v"(row0), "+v"(col0));
#pragma unroll
        for (int ai = 0; ai < 2; ++ai)
#pragma unroll
            for (int m = 0; m < 4; ++m) {
                const bf16* gp = PG + (size_t)(row0 + ai * 128 + m * 16) * PG_LD + col0;
#pragma unroll
                for (int bj = 0; bj < 2; ++bj) {
                    const u32x4 g1 = *(const u32x4*)(gp + bj * 128), g2 = *(const u32x4*)(gp + 1024 + bj * 128);
                    const unsigned a1[4] = {g1.x, g1.y, g1.z, g1.w}, a2[4] = {g2.x, g2.y, g2.z, g2.w};
#pragma unroll
                    for (int q = 0; q < 4; ++q) {
                        const float r0 = (1.f + __expf(-bflo(a2[q]))) * __builtin_amdgcn_rcpf(1.f + __expf(-bflo(a1[q])));
                        const float r1 = (1.f + __expf(-bfhi(a2[q]))) * __builtin_amdgcn_rcpf(1.f + __expf(-bfhi(a1[q])));
                        acc[ai][bj][m][q >> 1][(q & 1) * 2] *= r0; acc[ai][bj][m][q >> 1][(q & 1) * 2 + 1] *= r1;
                    }
                }
                asm volatile("" ::: "memory");
            }
    }
    __device__ __forceinline__ void operator()(const f32x4 (&acc)[2][2][4][2], const Unit& u, int wr, int wc, int fr, int fq) const {
        int row0 = u.pm * 256 + wr * 64 + fr, col0 = u.pn * 256 + wc * 32 + 8 * fq;
        asm volatile("" : "+v"(row0), "+v"(col0));
#pragma unroll
        for (int ai = 0; ai < 2; ++ai)
#pragma unroll
            for (int m = 0; m < 4; ++m) {
                const int row = row0 + ai * 128 + m * 16;
#pragma unroll
                for (int bj = 0; bj < 2; ++bj) {
                    const int c = col0 + bj * 128;
                    const u32x4 g = *(const u32x4*)(PG + (size_t)row * PG_LD + 1024 + c);
                    const f32x4 v0 = acc[ai][bj][m][0], v1 = acc[ai][bj][m][1];
                    u32x4 w; w.x = cvt_pk_bf16(sigmoidf_(bflo(g.x)) * v0[0], sigmoidf_(bfhi(g.x)) * v0[1]); w.y = cvt_pk_bf16(sigmoidf_(bflo(g.y)) * v0[2], sigmoidf_(bfhi(g.y)) * v0[3]);
                    w.z = cvt_pk_bf16(sigmoidf_(bflo(g.z)) * v1[0], sigmoidf_(bfhi(g.z)) * v1[1]); w.w = cvt_pk_bf16(sigmoidf_(bflo(g.w)) * v1[2], sigmoidf_(bfhi(g.w)) * v1[3]);
                    *(u32x4*)(MG + (size_t)row * D + c) = w;
                }
                asm volatile("" ::: "memory");
            }
    }
};
struct EpiRes {
    static constexpr bool HAS_MID = false, PERM = true;
    const float* src_c; const float* src_l; float* dst_c; bf16* dst_l; const float* mod; int first;
    __device__ __forceinline__ void operator()(const f32x4 (&acc)[2][2][4][2], const Unit& u, int wr, int wc, int fr, int fq) const {
        const bool isctx = u.pm < 8;
        const int slot = isctx ? 8 : ((u.pm - 8) >> 5);
        int rbase = (isctx ? u.pm * 256 : (u.pm - 8) * 256) + wr * 64 + fr, col0 = u.pn * 256 + wc * 32 + 8 * fq;
        asm volatile("" : "+v"(rbase), "+v"(col0));
        const float* ga = mod + slot * 6144 + 2048;
        f32x4 gv[2][2];
#pragma unroll
        for (int bj = 0; bj < 2; ++bj)
#pragma unroll
            for (int n = 0; n < 2; ++n) gv[bj][n] = *(const f32x4*)(ga + col0 + bj * 128 + 4 * n);
#pragma unroll
        for (int ai = 0; ai < 2; ++ai)
#pragma unroll
            for (int m = 0; m < 4; ++m) {
                const int row = rbase + ai * 128 + m * 16;
#pragma unroll
                for (int bj = 0; bj < 2; ++bj) {
                    const int c = col0 + bj * 128;
                    f32x4 x0, x1;
                    if (isctx || first) { const float* sp = (isctx ? src_c : src_l) + (size_t)row * D + c; x0 = *(const f32x4*)sp; x1 = *(const f32x4*)(sp + 4); }
                    else { const u32x4 w = *(const u32x4*)(dst_l + (size_t)row * XL_LD + c); x0 = (f32x4){bflo(w.x), bfhi(w.x), bflo(w.y), bfhi(w.y)}; x1 = (f32x4){bflo(w.z), bfhi(w.z), bflo(w.w), bfhi(w.w)}; }
                    x0 = x0 + gv[bj][0] * acc[ai][bj][m][0]; x1 = x1 + gv[bj][1] * acc[ai][bj][m][1];
                    if (isctx) { float* dp = dst_c + (size_t)row * D + c; *(f32x4*)dp = x0; *(f32x4*)(dp + 4) = x1; }
                    else { u32x4 w; w.x = cvt_pk_bf16(x0[0], x0[1]); w.y = cvt_pk_bf16(x0[2], x0[3]); w.z = cvt_pk_bf16(x1[0], x1[1]); w.w = cvt_pk_bf16(x1[2], x1[3]); *(u32x4*)(dst_l + (size_t)row * XL_LD + c) = w; }
                }
                asm volatile("" ::: "memory");
            }
    }
};
struct EpiB16 {
    static constexpr bool HAS_MID = false, PERM = true;
    bf16* C; int ldc;
    __device__ __forceinline__ void operator()(const f32x4 (&acc)[2][2][4][2], const Unit& u, int wr, int wc, int fr, int fq) const {
        const int row0 = u.pm * 256 + wr * 64 + fr, col0 = u.pn * 256 + wc * 32 + 8 * fq;
#pragma unroll
        for (int ai = 0; ai < 2; ++ai)
#pragma unroll
            for (int m = 0; m < 4; ++m) { bf16* rowp = C + (size_t)(row0 + ai * 128 + m * 16) * ldc + col0;
#pragma unroll
                for (int bj = 0; bj < 2; ++bj) { const f32x4 v0 = acc[ai][bj][m][0], v1 = acc[ai][bj][m][1];
                    u32x4 w; w.x = pk2(v0[0], v0[1]); w.y = pk2(v0[2], v0[3]); w.z = pk2(v1[0], v1[1]); w.w = pk2(v1[2], v1[3]);
                    *(u32x4*)(rowp + bj * 128) = w; } }
    }
};
__device__ __forceinline__ void p0_transpose_item(const float* W, int K, int N, bf16* WT, int dst_row0, LAS float* scr, int k0, int n0, int lane) {
#pragma unroll 8
    for (int i = 0; i < 32; ++i) { const int kk = 2 * i + (lane >> 5); scr[kk * 33 + (lane & 31)] = W[(size_t)(k0 + kk) * N + n0 + (lane & 31)]; }
    LDS_WAIT(); asm volatile("" ::: "memory");
    const int c = lane & 7;
#pragma unroll
    for (int j = 0; j < 4; ++j) { const int n = (lane >> 3) + 8 * j; const LAS float* s = scr + (8 * c) * 33 + n;
        v4u o; o.x = pk2(s[0 * 33], s[1 * 33]); o.y = pk2(s[2 * 33], s[3 * 33]); o.z = pk2(s[4 * 33], s[5 * 33]); o.w = pk2(s[6 * 33], s[7 * 33]);
        *(v4u*)(WT + (size_t)(dst_row0 + n) * K + k0 + 8 * c) = o; }
    LDS_WAIT(); asm volatile("" ::: "memory");
}
__device__ __forceinline__ int win_map(int n0) {
    if (n0 < 512) return n0;
    if (n0 < 1024) return 2048 + (n0 - 512);
    if (n0 < 1056) return 5120 + (n0 - 1024);
    if (n0 < 1568) return 512 + (n0 - 1056);
    if (n0 < 2080) return 1024 + (n0 - 1568);
    if (n0 < 2592) return 1536 + (n0 - 2080);
    if (n0 < 3104) return 2560 + (n0 - 2592);
    return 3072 + (n0 - 3104);
}

__device__ __forceinline__ void p0_prologue(const Frame& F) {
    CArgsP a = kargs(); unsigned char* const ws = a->ws;
    const int gw = F.vcu * NWAVES + F.wave, NGW = F.G * NWAVES;
    const int gtid = F.vcu * NT + F.tid, GT = F.G * NT;
    {
        LAS float* scr = (LAS float*)(F.lds + F.wave * 16384);
        constexpr int I_IN = 16 * 161, I_P = 8 * 32, I_O = 16 * 32, PER_L = I_IN + 2 * I_P + I_O;
        for (int it = gw; it < DEPTH * PER_L; it += NGW) {
            const int l = it / PER_L; int r = it % PER_L;
            if (r < I_IN) { const int kb = r / 161, nb = r % 161; p0_transpose_item(a->in[I_WIN] + (size_t)l * D * IN_COLS, D, IN_COLS, (bf16*)(ws + WS_WIN) + (size_t)l * NPAD * D, win_map(nb * 32), scr, kb * 64, nb * 32, F.lane); continue; }
            r -= I_IN;
            if (r < I_P) { const int kb = r / 32, nb = r % 32; p0_transpose_item(a->in[I_WPG] + (size_t)l * 512 * D, D, D, (bf16*)(ws + WS_WPG) + (size_t)l * D * D, nb * 32, scr, kb * 64, nb * 32, F.lane); continue; }
            r -= I_P;
            if (r < I_P) { const int kb = r / 32, nb = r % 32; p0_transpose_item(a->in[I_WPN] + (size_t)l * 512 * D, D, D, (bf16*)(ws + WS_WPG) + (size_t)l * D * D + 512, nb * 32, scr, kb * 64, nb * 32, F.lane); continue; }
            r -= I_P;
            { const int kb = r / 32, nb = r % 32; p0_transpose_item(a->in[I_WO] + (size_t)l * D * D, D, D, (bf16*)(ws + WS_WO) + (size_t)l * D * D, nb * 32, scr, kb * 64, nb * 32, F.lane); }
        }
        constexpr int PADV = (NPAD - IN_COLS) * D / 8;
        for (int i = gtid; i < DEPTH * PADV; i += GT) { const int l = i / PADV, j = i % PADV; *((v4u*)((bf16*)(ws + WS_WIN) + ((size_t)l * NPAD + IN_COLS) * D) + j) = (v4u){0u, 0u, 0u, 0u}; }
    }
    __syncthreads();
    if (gtid < 128 * 16) { const int pos = gtid >> 4, j = gtid & 15; const float freq = powf(10000.f, -(float)j / 16.f); const float ang = (float)pos * freq;
        float* cs = (float*)(ws + WS_ROPE); cs[2 * gtid] = cosf(ang); cs[2 * gtid + 1] = sinf(ang); }
    {
        LAS float* LSK = (LAS float*)F.lds;
        LAS float* LQ = (LAS float*)(F.lds + 128 * 132 * 4);
        for (int unit = F.vcu; unit < DEPTH * 16 * 16; unit += F.G) {
            const int l = unit >> 8, hp = (unit >> 4) & 15, d0 = (unit & 15) * 64;
            const float* sk = a->in[I_SK] + ((size_t)l * 16 + hp) * 16384;
            const float* wq = a->in[I_WQ] + (size_t)l * D * 2048 + hp * 128;
            __syncthreads();
            for (int i = F.tid; i < 16384; i += NT) LSK[(i >> 7) * 132 + (i & 127)] = sk[i];
            for (int i = F.tid; i < 8192; i += NT) LQ[(i >> 7) * 132 + (i & 127)] = wq[(size_t)(d0 + (i >> 7)) * 2048 + (i & 127)];
            __syncthreads();
            const int dd = F.tid & 63, kg = F.tid >> 6;
            float acc[16];
#pragma unroll
            for (int k = 0; k < 16; ++k) acc[k] = 0.f;
            for (int j = 0; j < 128; j += 4) {
                const f32x4 q = *(const LAS f32x4*)(LQ + dd * 132 + j);
#pragma unroll
                for (int k = 0; k < 16; ++k) { const f32x4 s = *(const LAS f32x4*)(LSK + (kg * 16 + k) * 132 + j); acc[k] += q[0] * s[0] + q[1] * s[1] + q[2] * s[2] + q[3] * s[3]; }
            }
            bf16* o = (bf16*)(ws + WS_WS) + ((size_t)l * 2048 + hp * 128 + kg * 16) * D + d0 + dd;
#pragma unroll
            for (int k = 0; k < 16; ++k) o[(size_t)k * D] = (bf16)f2bf(acc[k]);
        }
    }
    __syncthreads();
    {
        LAS float* ca = (LAS float*)F.lds;
        LAS float* red = (LAS float*)(F.lds + 9 * D * 4);
        for (int i = F.tid; i < 9 * D; i += NT) { const float v = i < 8 * D ? a->in[I_C][i] : a->in[I_CCTX][i - 8 * D]; ca[i] = v / (1.f + __expf(-v)); }
        __syncthreads();
        float* MOD = (float*)(ws + WS_MOD);
        for (int unit = F.vcu; unit < DEPTH * 96; unit += F.G) {
            const int l = unit / 96, cb = unit % 96, dc = F.tid >> 6;
            const int col = cb * 64 + (F.tid & 63);
            const float* w = a->in[I_WMOD] + ((size_t)l * D + dc * 128) * 6144 + col;
            float acc[9];
#pragma unroll
            for (int b = 0; b < 9; ++b) acc[b] = 0.f;
#pragma unroll 8
            for (int d = 0; d < 128; ++d) { const float wv = w[(size_t)d * 6144];
#pragma unroll
                for (int b = 0; b < 9; ++b) acc[b] += ca[b * D + dc * 128 + d] * wv; }
#pragma unroll
            for (int b = 0; b < 9; ++b) red[(dc * 9 + b) * 64 + (F.tid & 63)] = acc[b];
            __syncthreads();
            for (int i = F.tid; i < 9 * 64; i += NT) { const int b = i >> 6, c = i & 63; float sum = a->in[I_BMOD][l * 6144 + cb * 64 + c];
#pragma unroll
                for (int k = 0; k < 8; ++k) sum += red[(k * 9 + b) * 64 + c];
                MOD[((size_t)l * 9 + b) * 6144 + cb * 64 + c] = sum; }
            __syncthreads();
        }
    }
    __syncthreads();
}

__device__ __forceinline__ unsigned pk4_fp8(float a, float b, float c, float d) { int p = __builtin_amdgcn_cvt_pk_fp8_f32(a, b, 0, false); p = __builtin_amdgcn_cvt_pk_fp8_f32(c, d, p, true); return (unsigned)p; }
__device__ __forceinline__ void convert_row_fp8(const f32x4 (&v)[4], unsigned char* dst_tab, float* scale_out, int e, int lane) {
    const f32x4 a0 = v[0], a1 = v[1], a2 = v[2], a3 = v[3];
    float mx = fmaxf(fmaxf(fmaxf(fabsf(a0[0]), fabsf(a0[1])), fmaxf(fabsf(a0[2]), fabsf(a0[3]))), fmaxf(fmaxf(fabsf(a1[0]), fabsf(a1[1])), fmaxf(fabsf(a1[2]), fabsf(a1[3]))));
    mx = fmaxf(mx, fmaxf(fmaxf(fmaxf(fabsf(a2[0]), fabsf(a2[1])), fmaxf(fabsf(a2[2]), fabsf(a2[3]))), fmaxf(fmaxf(fabsf(a3[0]), fabsf(a3[1])), fmaxf(fabsf(a3[2]), fabsf(a3[3])))));
    mx = fmaxf(wave_max(mx, lane), 1e-30f);
    const float sc = 256.f / mx;
    const v4u w = (v4u){pk4_fp8(a0[0] * sc, a0[1] * sc, a0[2] * sc, a0[3] * sc), pk4_fp8(a1[0] * sc, a1[1] * sc, a1[2] * sc, a1[3] * sc), pk4_fp8(a2[0] * sc, a2[1] * sc, a2[2] * sc, a2[3] * sc), pk4_fp8(a3[0] * sc, a3[1] * sc, a3[2] * sc, a3[3] * sc)};
    *(v4u*)(dst_tab + ((size_t)(lane >> 3) * NEXP + e) * 128 + 16 * (lane & 7)) = w;
    if (lane == 0) scale_out[e] = mx * (1.f / 256.f);
}
__device__ __forceinline__ void convert_experts(const Frame& F, int layer) {
    CArgsP a = kargs(); unsigned char* const ws = a->ws;
    const int gw = F.vcu * NWAVES + F.wave, NGW = F.G * NWAVES;
    const float* su = a->in[I_EU] + (size_t)layer * NEXP * D; const float* sv = a->in[I_EV] + (size_t)layer * NEXP * D;
    for (int e = gw; e < NEXP; e += 2 * NGW) {
        const int e1 = e + NGW < NEXP ? e + NGW : e;
        f32x4 ru[2][4], rv[2][4];
#pragma unroll
        for (int q = 0; q < 2; ++q) { const int eq = q ? e1 : e; const f32x4* pu = (const f32x4*)(su + (size_t)eq * D) + 4 * F.lane; const f32x4* pv = (const f32x4*)(sv + (size_t)eq * D) + 4 * F.lane;
#pragma unroll
            for (int j = 0; j < 4; ++j) { ru[q][j] = pu[j]; rv[q][j] = pv[j]; } }
        convert_row_fp8(ru[0], ws + WS_EU, (float*)(ws + WS_SU), e, F.lane); convert_row_fp8(rv[0], ws + WS_EV, (float*)(ws + WS_SV), e, F.lane);
        if (e + NGW < NEXP) { convert_row_fp8(ru[1], ws + WS_EU, (float*)(ws + WS_SU), e1, F.lane); convert_row_fp8(rv[1], ws + WS_EV, (float*)(ws + WS_SV), e1, F.lane); }
    }
}

__device__ __forceinline__ void norm_phase(const Frame& F, int layer, int which, int rbeg) {
    CArgsP a = kargs(); unsigned char* const ws = a->ws;
    const int gw = F.vcu * NWAVES + F.wave, NGW = F.G * NWAVES;
    const float* g = (which ? a->in[I_GN2] : a->in[I_GN1]) + layer * D;
    const float* MOD = (const float*)(ws + WS_MOD) + (size_t)layer * 9 * 6144 + (which ? 3072 : 0);
    bf16* H = (bf16*)(ws + WS_H);
    f32x4 gv[4];
#pragma unroll
    for (int j = 0; j < 4; ++j) gv[j] = *((const f32x4*)g + F.lane + 64 * j);
    for (int r = rbeg + gw; r < R; r += NGW) {
        const float* sh = MOD + row_slot(r) * 6144; const float* sc = sh + D;
        f32x4 v[4]; float ss = 0.f;
        if ((which == 0 && layer == 0) || r < NCTX) {
            const float* xr = (which == 0 && layer == 0) ? xrow_in(a, r) : xc_row(a, r);
#pragma unroll
            for (int j = 0; j < 4; ++j) v[j] = *((const GAS f32x4*)xr + F.lane + 64 * j);
        } else {
            const v2u* xb = (const v2u*)xl_row(a, r) + F.lane;
#pragma unroll
            for (int j = 0; j < 4; ++j) { const v2u w = xb[64 * j]; v[j] = (f32x4){bflo(w.x), bfhi(w.x), bflo(w.y), bfhi(w.y)}; }
        }
#pragma unroll
        for (int j = 0; j < 4; ++j) ss += (v[j][0] * v[j][0] + v[j][1] * v[j][1]) + (v[j][2] * v[j][2] + v[j][3] * v[j][3]);
        const float rs = rsqrtf(wave_sum(ss, F.lane) * (1.f / D) + EPS);
        unsigned long long* o8 = (unsigned long long*)(H + (size_t)r * D) + F.lane;
        float mx = 0.f;
#pragma unroll
        for (int j = 0; j < 4; ++j) {
            const f32x4 s1 = *((const f32x4*)sc + F.lane + 64 * j), s0 = *((const f32x4*)sh + F.lane + 64 * j);
            const f32x4 y = v[j] * rs * gv[j] * (s1 + 1.f) + s0;
            o8[64 * j] = (unsigned long long)pk2(y[0], y[1]) | ((unsigned long long)pk2(y[2], y[3]) << 32);
            v[j] = y; mx = fmaxf(mx, fmaxf(fmaxf(fabsf(y[0]), fabsf(y[1])), fmaxf(fabsf(y[2]), fabsf(y[3]))));
        }
        if (which) {
            mx = fmaxf(wave_max(mx, F.lane), 1e-30f); const float q8 = 256.f / mx;
            unsigned* h8 = (unsigned*)(ws + WS_H8 + (size_t)r * D) + F.lane;
#pragma unroll
            for (int j = 0; j < 4; ++j) h8[64 * j] = pk4_fp8(v[j][0] * q8, v[j][1] * q8, v[j][2] * q8, v[j][3] * q8);
            if (F.lane == 0) ((float*)(ws + WS_SX))[r] = mx * (1.f / 256.f);
        }
    }
}

constexpr int GL_TOT = 0, GL_IMG = 4096, GL_PITCH = 144, GL_IMGB = 64 * GL_PITCH, GL_SSX = GL_IMG + 4 * GL_IMGB;
typedef short bf16x8_t __attribute__((ext_vector_type(8)));
__device__ __forceinline__ int chunk_row0(int b, int tc) { return tc < 4 ? b * CTXL + tc * 64 : NCTX + b * SEQ + (tc - 4) * 64; }
__device__ __forceinline__ int chunk_pos(int tc, int dir) { return dir == 0 ? tc : (tc < 4 ? 3 - tc : 135 - tc); }
__device__ __forceinline__ float logsig16(float x) { return (fminf(x, 0.f) - 0.69314718f * __builtin_amdgcn_logf(1.f + __builtin_amdgcn_exp2f(-1.44269504f * fabsf(x)))) * (1.f / 16.f); }
constexpr int GL_HALF = 65536, GL_Z = 40960, GL_QK = 49152;
struct GlaW { float wf[16], wb[16], baf, bab; };
__device__ __forceinline__ void gla_load_w(GlaW& w, CArgsP a, int layer, int h, int lane) {
    const float* waf = a->in[I_WAF] + layer * 4096 + h * 64 + lane; const float* wab = a->in[I_WAB] + layer * 4096 + h * 64 + lane;
#pragma unroll
    for (int j = 0; j < 16; ++j) { w.wf[j] = waf[j * 256]; w.wb[j] = wab[j * 256]; }
    w.baf = a->in[I_BAF][layer * 256 + h * 64 + lane]; w.bab = a->in[I_BAB][layer * 256 + h * 64 + lane];
}
__device__ __forceinline__ void gla_scan(LAS unsigned char* hl, int w4, int lane, const GlaW& w, const float* Z, int row0, float (&Bf)[16], float (&Bb)[16], float& endf, float& endb) {
    const int t0 = 16 * w4;
    LAS float* ZL = (LAS float*)(hl + GL_Z) + t0 * 32;
    { const f32x4* zp = (const f32x4*)(Z + (size_t)(row0 + t0 + (lane >> 2)) * 32 + (lane & 3) * 8); const f32x4 z0 = zp[0], z1 = zp[1];
      *(LAS f32x4*)(ZL + (lane >> 2) * 32 + (lane & 3) * 8) = z0; *(LAS f32x4*)(ZL + (lane >> 2) * 32 + (lane & 3) * 8 + 4) = z1; }
    LDS_WAIT();
#pragma unroll
    for (int i = 0; i < 16; ++i) {
        const LAS f32x4* zp = (const LAS f32x4*)(ZL + i * 32);
        float zf = w.baf, zb = w.bab;
#pragma unroll
        for (int q = 0; q < 4; ++q) { const f32x4 z0 = zp[q], z1 = zp[4 + q];
            zf += z0[0] * w.wf[4 * q] + z0[1] * w.wf[4 * q + 1] + z0[2] * w.wf[4 * q + 2] + z0[3] * w.wf[4 * q + 3];
            zb += z1[0] * w.wb[4 * q] + z1[1] * w.wb[4 * q + 1] + z1[2] * w.wb[4 * q + 2] + z1[3] * w.wb[4 * q + 3]; }
        Bf[i] = logsig16(zf); Bb[i] = logsig16(zb);
    }
#pragma unroll
    for (int i = 1; i < 16; ++i) Bf[i] += Bf[i - 1];
#pragma unroll
    for (int i = 14; i >= 0; --i) Bb[i] += Bb[i + 1];
    LAS float* TOT = (LAS float*)(hl + GL_TOT);
    TOT[(0 * 4 + w4) * 64 + lane] = Bf[15]; TOT[(1 * 4 + w4) * 64 + lane] = Bb[0];
    __syncthreads();
    float offf = 0.f, offb = 0.f; endf = 0.f; endb = 0.f;
#pragma unroll
    for (int ww = 0; ww < 4; ++ww) { const float tf = TOT[(0 * 4 + ww) * 64 + lane], tb = TOT[(1 * 4 + ww) * 64 + lane]; endf += tf; endb += tb; offf += (ww < w4) ? tf : 0.f; offb += (ww > w4) ? tb : 0.f; }
#pragma unroll
    for (int i = 0; i < 16; ++i) { Bf[i] += offf; Bb[i] += offb; }
}
constexpr int GLA_UNITS = BATCH * 4 * NCHUNK;
__device__ __forceinline__ void gla_a_phase(const Frame& F, int layer) {
    CArgsP a = kargs(); unsigned char* const ws = a->ws;
    const bf16* PA = (const bf16*)(ws + WS_PA); const bf16* VT = (const bf16*)(ws + WS_VT);
    const float* Z = (const float*)(ws + WS_Z); bf16* SST = (bf16*)(ws + WS_H); float* DEC = (float*)(ws + WS_DEC);
    const int lane = F.lane, l16 = lane & 15, g = lane >> 4, hw = F.wave >> 2, w4 = F.wave & 3, t0 = 16 * w4;
    LAS unsigned char* hl = F.lds + hw * GL_HALF;
    const int h = F.vcu & 3;
    GlaW gw; gla_load_w(gw, a, layer, h, lane);
    for (int pp = F.vcu >> 2; pp < BATCH * NCHUNK / 2; pp += F.G >> 2) {
        const int unit = 2 * pp + hw;
        const int b = unit / NCHUNK, tc = unit % NCHUNK, row0 = chunk_row0(b, tc);
        LAS bf16* KL = (LAS bf16*)(hl + GL_QK + 8192) + t0 * 64;
        { const bf16* kp = PA + (size_t)(row0 + t0 + (lane >> 2)) * PA_LD + PA_K + h * 64 + (lane & 3) * 16; const v4u k0 = *(const v4u*)kp, k1 = *(const v4u*)(kp + 8);
          *(LAS v4u*)(KL + (lane >> 2) * 64 + (lane & 3) * 16) = k0; *(LAS v4u*)(KL + (lane >> 2) * 64 + (lane & 3) * 16 + 8) = k1; }
        float Bf[16], Bb[16], endf, endb;
        gla_scan(hl, w4, lane, gw, Z, row0, Bf, Bb, endf, endb);
        float kf[16], kb[16];
#pragma unroll
        for (int i = 0; i < 16; ++i) { const float kk = bf1(KL[i * 64 + lane]); kf[i] = kk * __expf(endf - Bf[i]); kb[i] = kk * __expf(endb - Bb[i]); }
#pragma unroll
        for (int q = 0; q < 2; ++q) {
            *(LAS v4u*)(hl + GL_IMG + 0 * GL_IMGB + lane * GL_PITCH + (t0 + 8 * q) * 2) = (v4u){pk2(kf[8 * q], kf[8 * q + 1]), pk2(kf[8 * q + 2], kf[8 * q + 3]), pk2(kf[8 * q + 4], kf[8 * q + 5]), pk2(kf[8 * q + 6], kf[8 * q + 7])};
            *(LAS v4u*)(hl + GL_IMG + 1 * GL_IMGB + lane * GL_PITCH + (t0 + 8 * q) * 2) = (v4u){pk2(kb[8 * q], kb[8 * q + 1]), pk2(kb[8 * q + 2], kb[8 * q + 3]), pk2(kb[8 * q + 4], kb[8 * q + 5]), pk2(kb[8 * q + 6], kb[8 * q + 7])};
        }
        const int seq0 = (b * 4 + h) * 2;
        if (w4 == 0) { DEC[((size_t)(seq0 + 0) * NCHUNK + chunk_pos(tc, 0)) * 64 + lane] = __expf(endf); DEC[((size_t)(seq0 + 1) * NCHUNK + chunk_pos(tc, 1)) * 64 + lane] = __expf(endb); }
        __syncthreads();
        const int dir = w4 >> 1, nth = w4 & 1;
        const LAS unsigned char* img = hl + GL_IMG + dir * GL_IMGB;
        bf16x8_t afr[4][2];
#pragma unroll
        for (int mt = 0; mt < 4; ++mt)
#pragma unroll
            for (int kt = 0; kt < 2; ++kt) afr[mt][kt] = *(const LAS bf16x8_t*)(img + (32 * (mt >> 1) + 8 * (l16 >> 2) + 4 * (mt & 1) + (l16 & 3)) * GL_PITCH + (32 * kt + 8 * g) * 2);
        bf16* slot = SST + ((size_t)(seq0 + dir) * NCHUNK + chunk_pos(tc, dir)) * 8192;
#pragma unroll
        for (int n4 = 0; n4 < 4; ++n4) {
            const int nt = 4 * nth + n4;
            const bf16* vp = VT + (size_t)(h * 128 + 16 * nt + l16) * R + row0 + 8 * g;
            const bf16x8_t b0 = *(const bf16x8_t*)vp, b1 = *(const bf16x8_t*)(vp + 32);
#pragma unroll
            for (int mp = 0; mp < 2; ++mp) {
                f32x4 a0 = (f32x4){0.f, 0.f, 0.f, 0.f}, a1 = (f32x4){0.f, 0.f, 0.f, 0.f};
                a0 = __builtin_amdgcn_mfma_f32_16x16x32_bf16(afr[2 * mp][0], b0, a0, 0, 0, 0); a0 = __builtin_amdgcn_mfma_f32_16x16x32_bf16(afr[2 * mp][1], b1, a0, 0, 0, 0);
                a1 = __builtin_amdgcn_mfma_f32_16x16x32_bf16(afr[2 * mp + 1][0], b0, a1, 0, 0, 0); a1 = __builtin_amdgcn_mfma_f32_16x16x32_bf16(afr[2 * mp + 1][1], b1, a1, 0, 0, 0);
                *(v4u*)(slot + (16 * nt + l16) * 64 + 32 * mp + 8 * g) = (v4u){pk2(a0[0], a0[1]), pk2(a0[2], a0[3]), pk2(a1[0], a1[1]), pk2(a1[2], a1[3])};
            }
        }
        __syncthreads();
    }
}
__device__ __forceinline__ void gla_b_phase(const Frame& F, bool dry) {
    CArgsP a = kargs(); unsigned char* const ws = a->ws; const bool wr = !dry || a->pad == 12345;
    bf16* SST = (bf16*)(ws + WS_H); const float* DEC = (const float*)(ws + WS_DEC);
    const int gtid = F.vcu * NT + F.tid, GT = F.G * NT;
    for (int id = gtid; id < 64 * 2048; id += GT) {
        const int seq = id >> 11, e = (id & 2047) * 4, k4 = e & 63;
        float s0 = 0.f, s1 = 0.f, s2 = 0.f, s3 = 0.f;
        bf16* p = SST + (size_t)seq * NCHUNK * 8192 + e; const float* dp = DEC + (size_t)seq * NCHUNK * 64 + k4;
        for (int c0 = 0; c0 < NCHUNK; c0 += 12) {
            v2u t[12]; f32x4 d[12];
#pragma unroll
            for (int q = 0; q < 12; ++q) { t[q] = *(const v2u*)(p + (size_t)(c0 + q) * 8192); d[q] = *(const f32x4*)(dp + (c0 + q) * 64); }
#pragma unroll
            for (int q = 0; q < 12; ++q) {
                if (wr) *(v2u*)(p + (size_t)(c0 + q) * 8192) = (v2u){pk2(s0, s1), pk2(s2, s3)};
                s0 = d[q][0] * s0 + bflo(t[q].x); s1 = d[q][1] * s1 + bfhi(t[q].x); s2 = d[q][2] * s2 + bflo(t[q].y); s3 = d[q][3] * s3 + bfhi(t[q].y);
            }
        }
    }
}
__device__ __forceinline__ void gla_c_phase(const Frame& F, int layer, bool dry) {
    CArgsP a = kargs(); unsigned char* const ws = a->ws; const bool wr = !dry || a->pad == 12345;
    bf16* PA = (bf16*)(ws + WS_PA); const bf16* VT = (const bf16*)(ws + WS_VT);
    const float* Z = (const float*)(ws + WS_Z); const bf16* SST = (const bf16*)(ws + WS_H);
    const int lane = F.lane, l16 = lane & 15, g = lane >> 4, hw = F.wave >> 2, w4 = F.wave & 3, t0 = 16 * w4;
    LAS unsigned char* hl = F.lds + hw * GL_HALF;
    const int h = F.vcu & 3;
    GlaW gw; gla_load_w(gw, a, layer, h, lane);
    for (int pp = F.vcu >> 2; pp < BATCH * NCHUNK / 2; pp += F.G >> 2) {
        const int unit = 2 * pp + hw;
        const int b = unit / NCHUNK, tc = unit % NCHUNK, row0 = chunk_row0(b, tc);
        {
            LAS bf16* QL = (LAS bf16*)(hl + GL_QK) + t0 * 64; LAS bf16* KL = QL + 4096;
            { const bf16* qp = PA + (size_t)(row0 + t0 + (lane >> 2)) * PA_LD + PA_Q + h * 64 + (lane & 3) * 16; const bf16* kp = qp + (PA_K - PA_Q);
              const v4u q0 = *(const v4u*)qp, q1 = *(const v4u*)(qp + 8), k0 = *(const v4u*)kp, k1 = *(const v4u*)(kp + 8);
              const int o = (lane >> 2) * 64 + (lane & 3) * 16;
              *(LAS v4u*)(QL + o) = q0; *(LAS v4u*)(QL + o + 8) = q1; *(LAS v4u*)(KL + o) = k0; *(LAS v4u*)(KL + o + 8) = k1; }
            float Bf[16], Bb[16], endf, endb;
            gla_scan(hl, w4, lane, gw, Z, row0, Bf, Bb, endf, endb);
#pragma unroll
            for (int i = 0; i < 16; ++i) {
                const float qq = bf1(QL[i * 64 + lane]), kk = bf1(KL[i * 64 + lane]);
                const float ef = __expf(Bf[i]), eb = __expf(Bb[i]);
                LAS bf16* ip = (LAS bf16*)(hl + GL_IMG + (t0 + i) * GL_PITCH) + lane;
                ip[0] = (bf16)f2bf(qq * ef); ip[GL_IMGB / 2] = (bf16)f2bf(kk * __builtin_amdgcn_rcpf(ef)); ip[GL_IMGB] = (bf16)f2bf(qq * eb); ip[3 * GL_IMGB / 2] = (bf16)f2bf(kk * __builtin_amdgcn_rcpf(eb));
            }
        }
        __syncthreads();
        f32x4 O[8];
#pragma unroll
        for (int mt = 0; mt < 8; ++mt) O[mt] = (f32x4){0.f, 0.f, 0.f, 0.f};
        const int tq = 16 * w4 + l16;
#pragma unroll
        for (int dir = 0; dir < 2; ++dir) {
            const LAS unsigned char* Qimg = hl + GL_IMG + (2 * dir) * GL_IMGB; const LAS unsigned char* Kimg = Qimg + GL_IMGB;
            bf16x8_t qf[2];
#pragma unroll
            for (int kt = 0; kt < 2; ++kt) qf[kt] = *(const LAS bf16x8_t*)(Qimg + tq * GL_PITCH + (32 * kt + 8 * g) * 2);
            f32x4 P[4];
#pragma unroll
            for (int mt = 0; mt < 4; ++mt) {
                P[mt] = (f32x4){0.f, 0.f, 0.f, 0.f};
                const int trow = 32 * (mt >> 1) + 8 * (l16 >> 2) + 4 * (mt & 1) + (l16 & 3);
#pragma unroll
                for (int kt = 0; kt < 2; ++kt) { const bf16x8_t kf = *(const LAS bf16x8_t*)(Kimg + trow * GL_PITCH + (32 * kt + 8 * g) * 2); P[mt] = __builtin_amdgcn_mfma_f32_16x16x32_bf16(kf, qf[kt], P[mt], 0, 0, 0); }
#pragma unroll
                for (int rg = 0; rg < 4; ++rg) { const int tp = 32 * (mt >> 1) + 8 * g + 4 * (mt & 1) + rg; const bool valid = dir == 0 ? (tp <= tq) : (tp >= tq); P[mt][rg] = valid ? P[mt][rg] : 0.f; }
            }
            bf16x8_t pa[2];
#pragma unroll
            for (int k2 = 0; k2 < 2; ++k2) { const v4u w = (v4u){pk2(P[2 * k2][0], P[2 * k2][1]), pk2(P[2 * k2][2], P[2 * k2][3]), pk2(P[2 * k2 + 1][0], P[2 * k2 + 1][1]), pk2(P[2 * k2 + 1][2], P[2 * k2 + 1][3])}; pa[k2] = __builtin_bit_cast(bf16x8_t, w); }
            const bf16* slot = SST + ((size_t)((b * 4 + h) * 2 + dir) * NCHUNK + chunk_pos(tc, dir)) * 8192;
#pragma unroll
            for (int mt = 0; mt < 8; ++mt) {
                const int v = 32 * (mt >> 1) + 8 * (l16 >> 2) + 4 * (mt & 1) + (l16 & 3);
                const bf16* vp = VT + (size_t)(h * 128 + v) * R + row0 + 8 * g;
#pragma unroll
                for (int k2 = 0; k2 < 2; ++k2) { const bf16x8_t vf = *(const bf16x8_t*)(vp + 32 * k2); O[mt] = __builtin_amdgcn_mfma_f32_16x16x32_bf16(vf, pa[k2], O[mt], 0, 0, 0); }
#pragma unroll
                for (int kt = 0; kt < 2; ++kt) { const bf16x8_t sf = *(const bf16x8_t*)(slot + v * 64 + 32 * kt + 8 * g); O[mt] = __builtin_amdgcn_mfma_f32_16x16x32_bf16(sf, qf[kt], O[mt], 0, 0, 0); }
            }
        }
        float ss = 0.f;
#pragma unroll
        for (int mt = 0; mt < 8; ++mt) ss += (O[mt][0] * O[mt][0] + O[mt][1] * O[mt][1]) + (O[mt][2] * O[mt][2] + O[mt][3] * O[mt][3]);
        ss += shx(ss, 16, lane); ss += shx(ss, 32, lane);
        const float rs = rsqrtf(ss * (1.f / 128.f) + EPS);
        bf16* rp0 = PA + (size_t)(row0 + tq) * PA_LD + PA_R + h * 128 + 8 * g;
#pragma unroll
        for (int mp = 0; mp < 4; ++mp) {
            const v4u rr = *(const v4u*)(rp0 + 32 * mp);
            const float* gp = a->in[I_GGLA] + layer * 128 + 32 * mp + 8 * g; const f32x4 ga = *(const f32x4*)gp, gb = *(const f32x4*)(gp + 4);
            const float r0 = bflo(rr.x), r1 = bfhi(rr.x), r2 = bflo(rr.y), r3 = bfhi(rr.y), r4 = bflo(rr.z), r5 = bfhi(rr.z), r6 = bflo(rr.w), r7 = bfhi(rr.w);
            const f32x4 oa = O[2 * mp], ob = O[2 * mp + 1];
            const float y0 = oa[0] * rs * ga[0] * (r0 * sigmoidf_(r0)), y1 = oa[1] * rs * ga[1] * (r1 * sigmoidf_(r1)), y2 = oa[2] * rs * ga[2] * (r2 * sigmoidf_(r2)), y3 = oa[3] * rs * ga[3] * (r3 * sigmoidf_(r3));
            const float y4 = ob[0] * rs * gb[0] * (r4 * sigmoidf_(r4)), y5 = ob[1] * rs * gb[1] * (r5 * sigmoidf_(r5)), y6 = ob[2] * rs * gb[2] * (r6 * sigmoidf_(r6)), y7 = ob[3] * rs * gb[3] * (r7 * sigmoidf_(r7));
            if (wr) *(v4u*)(rp0 + 32 * mp) = (v4u){pk2(y0, y1), pk2(y2, y3), pk2(y4, y5), pk2(y6, y7)};
        }
        __syncthreads();
    }
}

__device__ __forceinline__ void na_unit4(bf16* PA, const bf16* NVT, const float* rpb_l, LAS float* lb, int b, int hd, bool lat, int qr0, int nt, int lane, bool wr) {
    const int l16 = lane & 15, g = lane >> 4;
    const int latbase = NCTX + b * SEQ, ctxbase = b * CTXL;
    bf16* qp[4]; bf16x8_t qf[4][2];
#pragma unroll
    for (int j = 0; j < 4; ++j) {
        const int row = lat ? latbase + (qr0 + j) * 64 + 16 * nt + l16 : ctxbase + 64 * nt + 16 * j + l16;
        qp[j] = PA + (size_t)row * PA_LD + PA_NQ + hd * 64;
        qf[j][0] = *(const bf16x8_t*)(qp[j] + 8 * g); qf[j][1] = *(const bf16x8_t*)(qp[j] + 32 + 8 * g);
    }
    const int qc = 16 * nt + l16, c0 = min(max(qc - 8, 0), 48), R0 = min(max(qr0 - 4, 0), 120);
    if (lat) {
#pragma unroll
        for (int i = 0; i < 8; ++i) { const int idx = lane + 64 * i; if (idx < 465) lb[idx] = rpb_l[hd * 465 + idx]; }
        LDS_WAIT();
    }
    const bf16* kbase = PA + PA_NK + hd * 64 + 8 * g;
    const bf16* vbase = NVT + (size_t)(hd * 64 + l16) * R + 8 * g;
    float mx[4] = {-3.0e38f, -3.0e38f, -3.0e38f, -3.0e38f};
    const int nrows = lat ? ((qr0 == 0 || qr0 == 124) ? 8 : 11) : 0, cs = (nt == 0) ? 0 : (nt == 1 ? 8 : (nt == 2 ? 24 : 32));
    const int nwin = nrows, nslot = nwin + 8;
#define NA_SLOT(si, jmask, krow, pr, base0, win) do { const int s_ = min((si), nslot - 1); win = s_ < nwin; pr = 0; \
        if (win) { krow = R0 + s_; jmask = 0u; \
            _Pragma("unroll") for (int j_ = 0; j_ < 4; ++j_) { const int r0j = min(max(qr0 + j_ - 4, 0), 120); if (krow >= r0j && krow < r0j + 8) jmask |= 1u << j_; } \
            base0 = latbase + krow * 64 + cs; } else { jmask = 15u; krow = 0; base0 = ctxbase + (s_ - nwin) * 32; } } while (0)
#define NA_LDK(dst, base0) do { _Pragma("unroll") for (int t_ = 0; t_ < 2; ++t_) { const bf16* kp_ = kbase + (size_t)((base0) + 8 * (l16 >> 2) + 4 * t_ + (l16 & 3)) * PA_LD; dst[t_][0] = *(const bf16x8_t*)kp_; dst[t_][1] = *(const bf16x8_t*)(kp_ + 32); } } while (0)
#define NA_LDV(dst, base0) do { _Pragma("unroll") for (int mt_ = 0; mt_ < 4; ++mt_) dst[mt_] = *(const bf16x8_t*)(vbase + (size_t)(16 * mt_) * R + (base0)); } while (0)
#pragma unroll 1
    for (int s0 = 0; s0 < nslot; s0 += 4) {
        bf16x8_t kc[4][2][2]; unsigned jm[4];
#pragma unroll
        for (int q = 0; q < 4; ++q) { int krow, pr, base0; bool win; NA_SLOT(s0 + q, jm[q], krow, pr, base0, win); if (s0 + q >= nslot) jm[q] = 0u; NA_LDK(kc[q], base0); }
#pragma unroll
        for (int q = 0; q < 4; ++q)
#pragma unroll
            for (int t = 0; t < 2; ++t)
#pragma unroll
                for (int j = 0; j < 4; ++j) {
                    f32x4 S = (f32x4){0.f, 0.f, 0.f, 0.f};
                    S = __builtin_amdgcn_mfma_f32_16x16x32_bf16(kc[q][t][0], qf[j][0], S, 0, 0, 0);
                    S = __builtin_amdgcn_mfma_f32_16x16x32_bf16(kc[q][t][1], qf[j][1], S, 0, 0, 0);
                    mx[j] = fmaxf(mx[j], fmaxf(fmaxf(S[0], S[1]), fmaxf(S[2], S[3])));
                }
    }
#pragma unroll
    for (int j = 0; j < 4; ++j) { mx[j] = fmaxf(mx[j], shx(mx[j], 16, lane)); mx[j] = fmaxf(mx[j], shx(mx[j], 32, lane)); }
    float ls[4] = {0.f, 0.f, 0.f, 0.f};
    f32x4 O[4][4];
#pragma unroll
    for (int j = 0; j < 4; ++j)
#pragma unroll
        for (int mt = 0; mt < 4; ++mt) O[j][mt] = (f32x4){0.f, 0.f, 0.f, 0.f};
#pragma unroll 1
    for (int s0 = 0; s0 < nslot; s0 += 2) {
        bf16x8_t kf[2][2][2], vf[2][4]; unsigned jm[2]; int krw[2], prr[2]; bool wn[2];
#pragma unroll
        for (int q = 0; q < 2; ++q) { int base0; NA_SLOT(s0 + q, jm[q], krw[q], prr[q], base0, wn[q]); if (s0 + q >= nslot) jm[q] = 0u; NA_LDK(kf[q], base0); NA_LDV(vf[q], base0); }
#pragma unroll
        for (int q = 0; q < 2; ++q) {
            const bool win = wn[q]; const int pr = prr[q], krow = krw[q];
            bool cv[2][4]; int co[2][4];
#pragma unroll
            for (int t = 0; t < 2; ++t)
#pragma unroll
                for (int rg = 0; rg < 4; ++rg) { const int kcol = cs + 8 * g + 4 * t + rg; cv[t][rg] = !win || ((kcol >= c0) && (kcol <= c0 + 15)); co[t][rg] = min(max(kcol - qc + 15, 0), 30); }
#pragma unroll
            for (int j = 0; j < 4; ++j) {
                const bool rv = (jm[q] >> j) & 1u;
                f32x4 S[2];
#pragma unroll
                for (int t = 0; t < 2; ++t) { S[t] = (f32x4){0.f, 0.f, 0.f, 0.f};
                    S[t] = __builtin_amdgcn_mfma_f32_16x16x32_bf16(kf[q][t][0], qf[j][0], S[t], 0, 0, 0);
                    S[t] = __builtin_amdgcn_mfma_f32_16x16x32_bf16(kf[q][t][1], qf[j][1], S[t], 0, 0, 0); }
                const LAS float* bp = lb + (win ? min(max(krow - (qr0 + j) + 7, 0), 14) * 31 : 0);
                float psum = 0.f;
#pragma unroll
                for (int t = 0; t < 2; ++t)
#pragma unroll
                    for (int rg = 0; rg < 4; ++rg) { const float bias = win ? bp[co[t][rg]] : 0.f; const float p = (cv[t][rg] && rv) ? __expf(S[t][rg] + bias - mx[j]) : 0.f; S[t][rg] = p; psum += p; }
                ls[j] += psum;
                const bf16x8_t pa = __builtin_bit_cast(bf16x8_t, (v4u){pk2(S[0][0], S[0][1]), pk2(S[0][2], S[0][3]), pk2(S[1][0], S[1][1]), pk2(S[1][2], S[1][3])});
#pragma unroll
                for (int mt = 0; mt < 4; ++mt) O[j][mt] = __builtin_amdgcn_mfma_f32_16x16x32_bf16(vf[q][mt], pa, O[j][mt], 0, 0, 0);
            }
        }
    }
#undef NA_SLOT
#undef NA_LDK
#undef NA_LDV
#pragma unroll
    for (int j = 0; j < 4; ++j) {
        float l = ls[j]; l += shx(l, 16, lane); l += shx(l, 32, lane);
        const float inv = 1.f / l;
#pragma unroll
        for (int mt = 0; mt < 4; ++mt) if (wr) *(v2u*)(qp[j] + 16 * mt + 4 * g) = (v2u){pk2(O[j][mt][0] * inv, O[j][mt][1] * inv), pk2(O[j][mt][2] * inv, O[j][mt][3] * inv)};
    }
}
__device__ __forceinline__ void na_phase(const Frame& F, int layer, bool dry, bool skip_ctx) {
    CArgsP a = kargs(); unsigned char* const ws = a->ws; const bool wr = !dry || a->pad == 12345;
    bf16* PA = (bf16*)(ws + WS_PA); const bf16* NVT = (const bf16*)(ws + WS_NVT);
    const float* rpb_l = a->in[I_RPB] + (size_t)layer * 8 * 465;
    const int gw = F.vcu * NWAVES + F.wave, NGW = F.G * NWAVES;
    LAS float* lb = (LAS float*)(F.lds + F.wave * 2048);
    for (int u = gw; u < BATCH * 8 * 32 * 4 + (skip_ctx ? 0 : BATCH * 8 * 4); u += NGW) {
        if (u < BATCH * 8 * 32 * 4) { const int nt = u & 3, qg = (u >> 2) & 31, hd = (u >> 7) & 7, b = u >> 10; na_unit4(PA, NVT, rpb_l, lb, b, hd, true, 4 * qg, nt, F.lane, wr); }
        else { const int v = u - BATCH * 8 * 32 * 4; const int nt = v & 3, hd = (v >> 2) & 7, b = v >> 5; na_unit4(PA, NVT, rpb_l, lb, b, hd, false, 0, nt, F.lane, wr); }
    }
}

__device__ __forceinline__ float pack_key(float v, int idx) { unsigned t = __builtin_bit_cast(unsigned, v) & ~127u; asm("" : "+v"(t)); return __builtin_bit_cast(float, t | (unsigned)idx); }
__device__ __forceinline__ void topk_phase(const Frame& F, int rbeg) {
    CArgsP a = kargs(); unsigned char* const ws = a->ws;
    const int gtid = F.vcu * NT + F.tid, GT = F.G * NT;
    const bf16* SC = (const bf16*)(ws + WS_SC);
    int* EI = (int*)(ws + WS_EI); float* EG = (float*)(ws + WS_EG);
    LAS unsigned* myl = (LAS unsigned*)F.lds + F.tid * 9;
    for (int id = rbeg * 8 + gtid; id < R * 8; id += GT) {
        const int r = id >> 3, hd = id & 7;
        const v4u* sp = (const v4u*)(SC + (size_t)r * 2048 + hd * 256);
        float t0[16], t1[16];
#pragma unroll
        for (int blk = 0; blk < 8; ++blk) {
            float n0[16], n1[16];
#pragma unroll
            for (int q = 0; q < 2; ++q) { const v4u va = sp[blk * 2 + q], vb = sp[16 + blk * 2 + q];
                const unsigned wa[4] = {va.x, va.y, va.z, va.w}, wb[4] = {vb.x, vb.y, vb.z, vb.w};
#pragma unroll
                for (int e = 0; e < 4; ++e) { const int i0 = blk * 16 + 8 * q + 2 * e;
                    n0[8 * q + 2 * e] = pack_key(bflo(wa[e]), i0); n0[8 * q + 2 * e + 1] = pack_key(bfhi(wa[e]), i0 + 1);
                    n1[8 * q + 2 * e] = pack_key(bflo(wb[e]), i0); n1[8 * q + 2 * e + 1] = pack_key(bfhi(wb[e]), i0 + 1); } }
#pragma unroll
            for (int k = 2; k <= 16; k <<= 1)
#pragma unroll
                for (int j = k >> 1; j > 0; j >>= 1)
#pragma unroll
                    for (int i = 0; i < 16; ++i) { const int l = i ^ j; if (l > i) { const bool desc = (i & k) == 0;
                        const float a0 = n0[i], b0 = n0[l], a1 = n1[i], b1 = n1[l];
                        n0[i] = desc ? fmaxf(a0, b0) : fminf(a0, b0); n0[l] = desc ? fminf(a0, b0) : fmaxf(a0, b0);
                        n1[i] = desc ? fmaxf(a1, b1) : fminf(a1, b1); n1[l] = desc ? fminf(a1, b1) : fmaxf(a1, b1); } }
            if (blk == 0) {
#pragma unroll
                for (int i = 0; i < 16; ++i) { t0[i] = n0[i]; t1[i] = n1[i]; }
            } else {
#pragma unroll
                for (int i = 0; i < 16; ++i) { t0[i] = fmaxf(t0[i], n0[15 - i]); t1[i] = fmaxf(t1[i], n1[15 - i]); }
#pragma unroll
                for (int j = 8; j > 0; j >>= 1)
#pragma unroll
                    for (int i = 0; i < 16; ++i) { const int l = i ^ j; if (l > i) { const float a0 = t0[i], b0 = t0[l], a1 = t1[i], b1 = t1[l];
                        t0[i] = fmaxf(a0, b0); t0[l] = fminf(a0, b0); t1[i] = fmaxf(a1, b1); t1[l] = fminf(a1, b1); } }
            }
        }
        float best[16];
#pragma unroll
        for (int j = 0; j < 16; ++j) best[j] = -3.0e38f;
#pragma unroll
        for (int ia = 0; ia < 16; ++ia)
#pragma unroll
            for (int ib = 0; ib < 16; ++ib)
                if ((ia + 1) * (ib + 1) <= 16) {
                    float x = __builtin_bit_cast(float, (__builtin_bit_cast(unsigned, t0[ia] + t1[ib]) & ~255u) | (unsigned)(ia * 16 + ib));
#pragma unroll
                    for (int j = 0; j < 16; ++j) { const float tb = fmaxf(best[j], x); x = fminf(best[j], x); best[j] = tb; }
                }
        {
            unsigned w0[4], w1[4];
#pragma unroll
            for (int q = 0; q < 4; ++q) {
                w0[q] = (__builtin_bit_cast(unsigned, t0[4 * q]) & 127u) | ((__builtin_bit_cast(unsigned, t0[4 * q + 1]) & 127u) << 8) | ((__builtin_bit_cast(unsigned, t0[4 * q + 2]) & 127u) << 16) | ((__builtin_bit_cast(unsigned, t0[4 * q + 3]) & 127u) << 24);
                w1[q] = (__builtin_bit_cast(unsigned, t1[4 * q]) & 127u) | ((__builtin_bit_cast(unsigned, t1[4 * q + 1]) & 127u) << 8) | ((__builtin_bit_cast(unsigned, t1[4 * q + 2]) & 127u) << 16) | ((__builtin_bit_cast(unsigned, t1[4 * q + 3]) & 127u) << 24);
            }
#pragma unroll
            for (int q = 0; q < 4; ++q) { myl[q] = w0[q]; myl[4 + q] = w1[q]; }
            LDS_WAIT();
        }
        int eid[16];
#pragma unroll
        for (int j = 0; j < 16; ++j) { const unsigned code = __builtin_bit_cast(unsigned, best[j]) & 255u; const LAS unsigned char* mb = (const LAS unsigned char*)myl;
            eid[j] = (int)mb[code >> 4] * 128 + (int)mb[16 + (code & 15u)]; }
        LDS_WAIT();
        float sum = 0.f; const float bmax = best[0];
#pragma unroll
        for (int j = 0; j < 16; ++j) { best[j] = __expf(best[j] - bmax); sum += best[j]; }
        const float inv = 1.f / sum;
        v4i* ei = (v4i*)(EI + (size_t)r * 128 + hd * 16); f32x4* eg = (f32x4*)(EG + (size_t)r * 128 + hd * 16);
#pragma unroll
        for (int j = 0; j < 4; ++j) { ei[j] = (v4i){eid[4 * j], eid[4 * j + 1], eid[4 * j + 2], eid[4 * j + 3]}; eg[j] = (f32x4){best[4 * j] * inv, best[4 * j + 1] * inv, best[4 * j + 2] * inv, best[4 * j + 3] * inv}; }
    }
}

__device__ __forceinline__ float gelu_tanh(float x) { const float u = 0.7978845608f * (x + 0.044715f * x * x * x); return x * __builtin_amdgcn_rcpf(1.f + __expf(-2.f * u)); }
typedef float f32x2_t __attribute__((ext_vector_type(2)));
__device__ __forceinline__ void peer1_phase(const Frame& F, int rbeg) {
    CArgsP a = kargs(); unsigned char* const ws = a->ws;
    const unsigned char* EU8 = ws + WS_EU; const unsigned char* H8 = ws + WS_H8;
    const int* EI = (const int*)(ws + WS_EI); bf16* PART = (bf16*)(ws + WS_PART);
    const int per = F.G >> 3, s = F.vcu / per, rank = F.vcu % per, stride = per * NWAVES;
    const int lane = F.lane, m = lane & 15, g = lane >> 4, row8 = lane >> 3, part = lane & 7;
    const unsigned char* tab = EU8 + (size_t)s * NEXP * 128 + 16 * part;
    LAS unsigned char* wl = F.lds + F.wave * 5632;
    LAS int* idl = (LAS int*)(wl + 4608);
    const int wofs = row8 * 144 + part * 16, rofs = m * 144 + 16 * g;
    int r = rbeg + rank * NWAVES + F.wave;
    v2u idp[2];
#pragma unroll
    for (int u = 0; u < 2; ++u) idp[u] = *(const v2u*)(EI + (size_t)min(r + u * stride, R - 1) * 128 + 2 * lane);
    for (; r < R; r += 2 * stride) {
        v4u w[2][16]; v4u x[2][2];
#pragma unroll
        for (int u = 0; u < 2; ++u) *(LAS v2u*)(idl + u * 128 + 2 * lane) = idp[u];
        LDS_WAIT();
#pragma unroll
        for (int u = 0; u < 2; ++u) {
            const int ru = min(r + u * stride, R - 1);
            const unsigned char* xp = H8 + (size_t)ru * D + 128 * s + 16 * g;
            x[u][0] = *(const v4u*)xp; x[u][1] = *(const v4u*)(xp + 64);
#pragma unroll
            for (int j = 0; j < 16; ++j) w[u][j] = *(const v4u*)(tab + (size_t)idl[u * 128 + 8 * j + row8] * 128);
        }
        const int rn = r + 2 * stride;
#pragma unroll
        for (int u = 0; u < 2; ++u) idp[u] = *(const v2u*)(EI + (size_t)min(rn + u * stride, R - 1) * 128 + 2 * lane);
#pragma unroll
        for (int u = 0; u < 2; ++u) {
            f32x4 sel = (f32x4){0.f, 0.f, 0.f, 0.f};
#pragma unroll
            for (int T = 0; T < 8; ++T) {
                LAS unsigned char* buf = wl + (T & 1) * 2304;
                *(LAS v4u*)(buf + wofs) = w[u][2 * T]; *(LAS v4u*)(buf + 8 * 144 + wofs) = w[u][2 * T + 1];
                const v4u a0 = *(const LAS v4u*)(buf + rofs), a1 = *(const LAS v4u*)(buf + rofs + 64);
                f32x4 acc = (f32x4){0.f, 0.f, 0.f, 0.f};
                acc = __builtin_amdgcn_mfma_f32_16x16x32_fp8_fp8((long)(((unsigned long long)a0.y << 32) | a0.x), (long)(((unsigned long long)x[u][0].y << 32) | x[u][0].x), acc, 0, 0, 0);
                acc = __builtin_amdgcn_mfma_f32_16x16x32_fp8_fp8((long)(((unsigned long long)a0.w << 32) | a0.z), (long)(((unsigned long long)x[u][0].w << 32) | x[u][0].z), acc, 0, 0, 0);
                acc = __builtin_amdgcn_mfma_f32_16x16x32_fp8_fp8((long)(((unsigned long long)a1.y << 32) | a1.x), (long)(((unsigned long long)x[u][1].y << 32) | x[u][1].x), acc, 0, 0, 0);
                acc = __builtin_amdgcn_mfma_f32_16x16x32_fp8_fp8((long)(((unsigned long long)a1.w << 32) | a1.z), (long)(((unsigned long long)x[u][1].w << 32) | x[u][1].z), acc, 0, 0, 0);
                sel = (m == T) ? acc : sel;
            }
            const int ru = r + u * stride;
            if (m < 8 && ru < R) *(v2u*)(PART + ((size_t)s * R + ru) * 128 + 16 * m + 4 * g) = (v2u){pk2(sel[0], sel[1]), pk2(sel[2], sel[3])};
        }
    }
}
__device__ __forceinline__ void peer_act_phase(const Frame& F, int rbeg) {
    CArgsP a = kargs(); unsigned char* const ws = a->ws;
    const int gtid = F.vcu * NT + F.tid, GT = F.G * NT;
    const bf16* PART = (const bf16*)(ws + WS_PART); const int* EI = (const int*)(ws + WS_EI); const float* EG = (const float*)(ws + WS_EG);
    const float* SU = (const float*)(ws + WS_SU); const float* SV = (const float*)(ws + WS_SV); const float* SX = (const float*)(ws + WS_SX);
    float* ACT = (float*)(ws + WS_ACT);
    for (int i0 = rbeg * 32 + gtid; i0 < R * 32; i0 += 2 * GT) {
        const int i1 = i0 + GT < R * 32 ? i0 + GT : i0;
        v2u pw[2][8]; v4i id[2]; f32x4 gt[2]; float sx[2];
#pragma unroll
        for (int u = 0; u < 2; ++u) { const int i = u ? i1 : i0;
#pragma unroll
            for (int q = 0; q < 8; ++q) pw[u][q] = *(const v2u*)(PART + (size_t)q * R * 128 + (size_t)i * 4);
            id[u] = *(const v4i*)(EI + (size_t)i * 4); gt[u] = *(const f32x4*)(EG + (size_t)i * 4); sx[u] = SX[i >> 5]; }
        float su[2][4], sv[2][4];
#pragma unroll
        for (int u = 0; u < 2; ++u)
#pragma unroll
            for (int k = 0; k < 4; ++k) { su[u][k] = SU[id[u][k]]; sv[u][k] = SV[id[u][k]]; }
#pragma unroll
        for (int u = 0; u < 2; ++u) {
            f32x4 sum = (f32x4){0.f, 0.f, 0.f, 0.f};
#pragma unroll
            for (int q = 0; q < 8; ++q) sum += (f32x4){bflo(pw[u][q].x), bfhi(pw[u][q].x), bflo(pw[u][q].y), bfhi(pw[u][q].y)};
            f32x4 o;
#pragma unroll
            for (int k = 0; k < 4; ++k) o[k] = gelu_tanh(sum[k] * sx[u] * su[u][k]) * gt[u][k] * sv[u][k];
            if (u == 0 || i0 + GT < R * 32) *(f32x4*)(ACT + (size_t)(u ? i1 : i0) * 4) = o;
        }
    }
}
__device__ __forceinline__ void peer2_phase(const Frame& F, int layer, bool dry, int rbeg) {
    CArgsP a = kargs(); unsigned char* const ws = a->ws; const bool wr = !dry || a->pad == 12345;
    const unsigned char* EV8 = ws + WS_EV; const int* EI = (const int*)(ws + WS_EI); const float* ACT = (const float*)(ws + WS_ACT);
    const float* MOD = (const float*)(ws + WS_MOD) + (size_t)layer * 9 * 6144 + 5 * D;
    const int per = F.G >> 3, s = F.vcu / per, rank = F.vcu % per, stride = per * NWAVES;
    const int lane = F.lane, part = lane & 7, e8 = lane >> 3;
    const unsigned char* tab = EV8 + (size_t)s * NEXP * 128 + 16 * part;
    const bool b5 = (lane & 32) != 0, b4 = (lane & 16) != 0, b3 = (lane & 8) != 0;
    const int dimoff = 128 * s + 16 * part + (b5 ? 8 : 0) + (b4 ? 4 : 0) + (b3 ? 2 : 0);
    int r = rbeg + rank * NWAVES + F.wave;
    LAS int* idl = (LAS int*)(F.lds + F.wave * 2048); LAS float* acl = (LAS float*)(idl + 256);
    v2u idp[2], acp[2];
#pragma unroll
    for (int u = 0; u < 2; ++u) { idp[u] = *(const v2u*)(EI + (size_t)min(r + u * stride, R - 1) * 128 + 2 * lane); acp[u] = *(const v2u*)(ACT + (size_t)min(r + u * stride, R - 1) * 128 + 2 * lane); }
    for (; r < R; r += 2 * stride) {
        v4u w[2][16]; f32x4 a4[2][4]; v4i id4[2][4];
#pragma unroll
        for (int u = 0; u < 2; ++u) { *(LAS v2u*)(idl + u * 128 + 2 * lane) = idp[u]; *(LAS v2u*)(acl + u * 128 + 2 * lane) = acp[u]; }
        LDS_WAIT();
#pragma unroll
        for (int u = 0; u < 2; ++u) {
#pragma unroll
            for (int q = 0; q < 4; ++q) id4[u][q] = *(const LAS v4i*)(idl + u * 128 + 16 * e8 + 4 * q);
#pragma unroll
            for (int j = 0; j < 16; ++j) w[u][j] = *(const v4u*)(tab + (size_t)id4[u][j >> 2][j & 3] * 128);
        }
        const int rn = r + 2 * stride;
#pragma unroll
        for (int u = 0; u < 2; ++u) { idp[u] = *(const v2u*)(EI + (size_t)min(rn + u * stride, R - 1) * 128 + 2 * lane); acp[u] = *(const v2u*)(ACT + (size_t)min(rn + u * stride, R - 1) * 128 + 2 * lane); }
#pragma unroll
        for (int u = 0; u < 2; ++u)
#pragma unroll
            for (int q = 0; q < 4; ++q) a4[u][q] = *(const LAS f32x4*)(acl + u * 128 + 16 * e8 + 4 * q);
#pragma unroll
        for (int u = 0; u < 2; ++u) {
            f32x2_t o[8];
#pragma unroll
            for (int k = 0; k < 8; ++k) o[k] = (f32x2_t){0.f, 0.f};
#pragma unroll
            for (int j = 0; j < 16; ++j) {
                const v4u ww = w[u][j];
                const float av = a4[u][j >> 2][j & 3]; const f32x2_t av2 = (f32x2_t){av, av};
                o[0] += av2 * __builtin_amdgcn_cvt_pk_f32_fp8((int)ww.x, false); o[1] += av2 * __builtin_amdgcn_cvt_pk_f32_fp8((int)ww.x, true);
                o[2] += av2 * __builtin_amdgcn_cvt_pk_f32_fp8((int)ww.y, false); o[3] += av2 * __builtin_amdgcn_cvt_pk_f32_fp8((int)ww.y, true);
                o[4] += av2 * __builtin_amdgcn_cvt_pk_f32_fp8((int)ww.z, false); o[5] += av2 * __builtin_amdgcn_cvt_pk_f32_fp8((int)ww.z, true);
                o[6] += av2 * __builtin_amdgcn_cvt_pk_f32_fp8((int)ww.w, false); o[7] += av2 * __builtin_amdgcn_cvt_pk_f32_fp8((int)ww.w, true);
            }
            f32x2_t v4[4], v2[2], v1;
#pragma unroll
            for (int k = 0; k < 4; ++k) { const f32x2_t snd = b5 ? o[k] : o[k + 4], kp = b5 ? o[k + 4] : o[k]; f32x2_t rc; rc.x = shx(snd.x, 32, lane); rc.y = shx(snd.y, 32, lane); v4[k] = kp + rc; }
#pragma unroll
            for (int k = 0; k < 2; ++k) { const f32x2_t snd = b4 ? v4[k] : v4[k + 2], kp = b4 ? v4[k + 2] : v4[k]; f32x2_t rc; rc.x = shx(snd.x, 16, lane); rc.y = shx(snd.y, 16, lane); v2[k] = kp + rc; }
            { const f32x2_t snd = b3 ? v2[0] : v2[1], kp = b3 ? v2[1] : v2[0]; f32x2_t rc; rc.x = shx(snd.x, 8, lane); rc.y = shx(snd.y, 8, lane); v1 = kp + rc; }
            const int ru = r + u * stride;
            if (ru < R) {
                const f32x2_t ga = *(const f32x2_t*)(MOD + row_slot(ru) * 6144 + dimoff);
                if (ru < NCTX) { float* xq = xc_row(a, ru) + dimoff; const f32x2_t xx = *(const f32x2_t*)xq; if (wr) *(f32x2_t*)xq = xx + ga * v1; }
                else { unsigned* xq = (unsigned*)(xl_row(a, ru) + dimoff); const unsigned w = *xq; const f32x2_t y = (f32x2_t){bflo(w), bfhi(w)} + ga * v1; if (wr) *xq = pk2(y.x, y.y); }
            }
        }
    }
}

__device__ __forceinline__ void final_phase(const Frame& F) {
    CArgsP a = kargs(); unsigned char* const ws = a->ws;
    const int gw = F.vcu * NWAVES + F.wave, NGW = F.G * NWAVES;
    f32x4 gv[4];
#pragma unroll
    for (int j = 0; j < 4; ++j) gv[j] = *((const f32x4*)a->in[I_GF] + F.lane + 64 * j);
    for (int r = gw; r < NLAT; r += NGW) {
        const v2u* xb = (const v2u*)((const bf16*)a->out + (size_t)r * XL_LD) + F.lane;
        f32x4* xr = (f32x4*)(a->out + (size_t)r * D) + F.lane;
        f32x4 v[4]; float ss = 0.f;
#pragma unroll
        for (int j = 0; j < 4; ++j) { const v2u w = xb[64 * j]; v[j] = (f32x4){bflo(w.x), bfhi(w.x), bflo(w.y), bfhi(w.y)}; ss += (v[j][0] * v[j][0] + v[j][1] * v[j][1]) + (v[j][2] * v[j][2] + v[j][3] * v[j][3]); }
        const float rs = rsqrtf(wave_sum(ss, F.lane) * (1.f / D) + EPS);
        asm volatile("s_waitcnt vmcnt(0)" ::: "memory");
#pragma unroll
        for (int j = 0; j < 4; ++j) xr[64 * j] = v[j] * rs * gv[j];
    }
}

__global__ void __launch_bounds__(NT, 2) fwd_kernel(Args args) {
    extern __shared__ __attribute__((aligned(16))) unsigned char lds[];
    Frame F;
    F.lds = (LAS unsigned char*)lds;
    F.tid = 0; F.lane = 0; F.wave = __builtin_amdgcn_readfirstlane((int)threadIdx.x >> 6);
    F.G = gridDim.x; { const int bx = blockIdx.x; F.vcu = (F.G % 8 == 0) ? (bx % 8) * (F.G / 8) + bx / 8 : bx; }
    volatile LAS unsigned* MISC = (volatile LAS unsigned*)(F.lds + MISC_OFF);
    for (int u = threadIdx.x; u < (LDS_BYTES - LDSCTL_OFF) / 4; u += NT) ((LAS unsigned*)(F.lds + LDSCTL_OFF))[u] = 0u;
    __syncthreads();
    XcdBarrier bar; bar.bar = (unsigned*)(args.ws + WS_CTL) + CW_BAR; bar.x = 0; bar.st = nullptr;
    if (MK_SINGLE) bar = xcd_barrier_post((unsigned*)(args.ws + WS_CTL) + CW_BAR, MISC + 8);
    const int lo = args.ph_lo, hi = args.ph_hi;
#define IN(k) (lo <= (k) && (k) < hi)
#define OPQ_BX ({ int bx_ = (int)blockIdx.x; asm volatile("" : "+s"(bx_)); bx_; })
#define PF Frame Fp = F; { int t_ = threadIdx.x; asm volatile("" : "+v"(t_), "+s"(Fp.vcu), "+s"(Fp.wave), "+s"(Fp.G)); Fp.tid = t_; Fp.lane = t_ & 63; }
#define SEAM(k) do { if (MK_SINGLE && IN(k) && IN((k) + 1)) { XcdBarrier b2_ = bar; asm volatile("" : "+s"(b2_.bar));     \
        xcd_barrier(b2_); if (PROBE == 50) xcd_barrier(b2_); } } while (0)

    if (IN(0)) { if (PROBE == 99) { PF; p0_prologue(Fp); } { PF; p0_prologue(Fp); } SEAM(0); }

    for (int l = 0; l < DEPTH; ++l) {
        const int pb = 1 + l * NPL;
        const int pm0 = (l == DEPTH - 1) ? 8 : 0, rbeg = pm0 * 256;
        if (IN(pb + 0)) { { PF; norm_phase(Fp, l, 0, 0); } { PF; convert_experts(Fp, l); } if (PROBE == 30) { PF; convert_experts(Fp, l); } SEAM(pb + 0); }
        if (IN(pb + 1)) {
            CArgsP ap = kargs(); unsigned char* const ws = ap->ws; bf16* Hb = (bf16*)(ws + WS_H); bf16* PA = (bf16*)(ws + WS_PA); bf16* PG = (bf16*)(ws + WS_PG);
            pg8::Gemm g{Hb, (const bf16*)(ws + WS_WIN) + (size_t)l * NPAD * D, R, NPAD, D, D}; pg8::StaticOrder S; S.init(R, NPAD, F.G, OPQ_BX);
            EpiIn E{PA, PG, (float*)(ws + WS_Z), (const float*)(ws + WS_ROPE), (bf16*)(ws + WS_VT), (bf16*)(ws + WS_NVT)};
            for (int rep = 0; rep < (PROBE == 1 ? 2 : 1); ++rep) pg8::gemm_phase<EpiIn, pg8::StaticOrder, true, true>(F.lds, g, S, E);
            SEAM(pb + 1);
        }
        if (IN(pb + 2)) { { PF; gla_a_phase(Fp, l); } if (PROBE == 2) { PF; gla_a_phase(Fp, l); } { const int nrep = (PROBE == 20 ? 2 : 1) + (kargs()->pad != 0 ? 1 : 0); for (int rep = 0; rep < nrep; ++rep) { PF; na_phase(Fp, l, rep + 1 < nrep, l == DEPTH - 1); } } SEAM(pb + 2); }
        if (IN(pb + 3)) { if (PROBE == 3) { PF; gla_b_phase(Fp, true); } { PF; gla_b_phase(Fp, false); } SEAM(pb + 3); }
        if (IN(pb + 4)) { if (PROBE == 4) { PF; gla_c_phase(Fp, l, true); } { PF; gla_c_phase(Fp, l, false); } SEAM(pb + 4); }
        if (IN(pb + 5)) {
            CArgsP ap = kargs(); unsigned char* const ws = ap->ws; bf16* Hb = (bf16*)(ws + WS_H); bf16* PA = (bf16*)(ws + WS_PA); bf16* PG = (bf16*)(ws + WS_PG);
            pg8::ShiftOrder S; S.init(R - rbeg, D, F.G, OPQ_BX); S.pm0 = pm0;
            { pg8::Gemm g{PA + PA_R, (const bf16*)(ws + WS_WPG) + (size_t)l * D * D, R, D, D, PA_LD}; EpiMergeK E{Hb, PG}; for (int rep = 0; rep < (PROBE == 5 ? 2 : 1); ++rep) pg8::gemm_phase<EpiMergeK, pg8::ShiftOrder, true, true>(F.lds, g, S, E); }
            SEAM(pb + 5);
        }
        if (IN(pb + 6)) {
            CArgsP ap = kargs(); unsigned char* const ws = ap->ws; bf16* Hb = (bf16*)(ws + WS_H);
            pg8::Gemm g{Hb, (const bf16*)(ws + WS_WO) + (size_t)l * D * D, R, D, D, D}; pg8::ShiftOrder S; S.init(R - rbeg, D, F.G, OPQ_BX); S.pm0 = pm0;
            EpiRes E{l == 0 ? ap->in[I_CTX] : (const float*)(ws + WS_XC), ap->in[I_X], (float*)(ws + WS_XC), (bf16*)ap->out, (const float*)(ws + WS_MOD) + (size_t)l * 9 * 6144, l == 0 ? 1 : 0};
            pg8::gemm_phase<EpiRes, pg8::ShiftOrder, true, true>(F.lds, g, S, E);
            SEAM(pb + 6);
        }
        if (IN(pb + 7)) { if (PROBE == 7) { PF; norm_phase(Fp, l, 1, rbeg); } { PF; norm_phase(Fp, l, 1, rbeg); } SEAM(pb + 7); }
        if (IN(pb + 8)) {
            CArgsP ap = kargs(); unsigned char* const ws = ap->ws; bf16* Hb = (bf16*)(ws + WS_H);
            pg8::Gemm g{Hb, (const bf16*)(ws + WS_WS) + (size_t)l * 2048 * D, R, 2048, D, D}; pg8::ShiftOrder S; S.init(R - rbeg, 2048, F.G, OPQ_BX); S.pm0 = pm0;
            EpiB16 E{(bf16*)(ws + WS_SC), 2048};
            for (int rep = 0; rep < (PROBE == 8 ? 2 : 1); ++rep) pg8::gemm_phase<EpiB16, pg8::ShiftOrder, true, true>(F.lds, g, S, E);
            SEAM(pb + 8);
        }
        if (IN(pb + 9)) { if (PROBE == 9) { PF; topk_phase(Fp, rbeg); } { PF; topk_phase(Fp, rbeg); } SEAM(pb + 9); }
        if (IN(pb + 10)) { if (PROBE == 10) { PF; peer1_phase(Fp, rbeg); } { PF; peer1_phase(Fp, rbeg); } SEAM(pb + 10); }
        if (IN(pb + 11)) { if (PROBE == 11) { PF; peer_act_phase(Fp, rbeg); } { PF; peer_act_phase(Fp, rbeg); } SEAM(pb + 11); }
        if (IN(pb + 12)) { if (PROBE == 12) { PF; peer2_phase(Fp, l, true, rbeg); } { PF; peer2_phase(Fp, l, false, rbeg); } SEAM(pb + 12); }
    }
    if (IN(NPHASE - 1)) { PF; final_phase(Fp); }
#undef IN
#undef SEAM
}

extern "C" void kernel_launch(void* const* d_in, const int* in_sizes, int n_in, void* d_out, int out_size, void* d_ws, size_t ws_size, hipStream_t stream) {
    static int grid = 0;
    if (grid == 0) {
        if (n_in != 23 || in_sizes[0] != NLAT * D || out_size != NLAT * D || ws_size < WS_END) { fprintf(stderr, "kernel_launch: unexpected shapes (n_in %d, in0 %d, out %d, ws %zu); nothing launched\n", n_in, n_in > 0 ? in_sizes[0] : -1, out_size, ws_size); grid = -1; return; }
        int dev = 0, cus = 0, per_cu = 0;
        if (hipGetDevice(&dev) != hipSuccess || hipDeviceGetAttribute(&cus, hipDeviceAttributeMultiprocessorCount, dev) != hipSuccess) { grid = -1; return; }
        if (hipFuncSetAttribute((const void*)fwd_kernel, hipFuncAttributeMaxDynamicSharedMemorySize, LDS_BYTES) != hipSuccess) { fprintf(stderr, "kernel_launch: hipFuncSetAttribute failed\n"); grid = -1; return; }
        if (hipOccupancyMaxActiveBlocksPerMultiprocessor(&per_cu, (const void*)fwd_kernel, NT, LDS_BYTES) != hipSuccess || per_cu < 1) { fprintf(stderr, "kernel_launch: occupancy query says %d blocks per CU\n", per_cu); }
        (void)hipGetLastError();
        grid = cus;
    }
    if (grid < 0) return;
    if (hipMemsetAsync((char*)d_ws + WS_CTL, 0, CTL_ZERO_BYTES, stream) != hipSuccess) return;
    Args a{};
    for (int i = 0; i < 23; ++i) a.in[i] = (const float*)d_in[i];
    a.out = (float*)d_out; a.ws = (unsigned char*)d_ws; a.pad = 0;
    if (MK_SINGLE) {
        a.ph_lo = 0; a.ph_hi = NPHASE; a.li = 0;
        hipLaunchKernelGGL(fwd_kernel, dim3(grid), dim3(NT), LDS_BYTES, stream, a);
    } else {
        for (int p = 0; p < NPHASE; ++p) { a.ph_lo = p; a.ph_hi = p + 1; a.li = p; hipLaunchKernelGGL(fwd_kernel, dim3(grid), dim3(NT), LDS_BYTES, stream, a); }
    }
}
```

```cpp
#include <hip/hip_runtime.h>
#include <cstdio>
#include <cstdint>

#ifndef PROBE
#define PROBE 0
#endif
#ifndef MK_SINGLE
#define MK_SINGLE 1
#endif

namespace pg8 {
#define PG8_LAS __attribute__((address_space(3)))
typedef unsigned short bf16_t;
typedef short bf16x8 __attribute__((ext_vector_type(8)));
typedef float f32x4 __attribute__((ext_vector_type(4)));
typedef unsigned u32x4 __attribute__((ext_vector_type(4)));
constexpr int BM = 256, BK = 64, HALF = 128, HTB = HALF * BK * 2, STAGE_BYTES = 8 * HTB, NXCD = 8, WGM = 8;

__host__ __device__ __forceinline__ int lds_byte(int r, int c) { const int st = (r >> 4) * 2 + (c >> 5), rr = r & 15, cc = c & 31, ob = rr * 64 + cc * 2; return st * 1024 + (ob ^ (((ob >> 9) & 1) << 5)); }
__host__ __device__ __forceinline__ void stage_rc(int b, int& R, int& C) { const int st = b / 1024, sb = b % 1024, swz = sb ^ (((sb >> 9) & 1) << 5); R = (st >> 1) * 16 + swz / 64; C = (st & 1) * 32 + (swz % 64) / 2; }
__host__ __device__ __forceinline__ int perm32(int rho) { const int n = rho >> 4, i = rho & 15; return 8 * (i >> 2) + 4 * n + (i & 3); }

struct Unit { int pm, pn; };
struct Gemm { const bf16_t* A; const bf16_t* Bt; int M, N, K, lda; };

struct StaticOrder {
    int nM, nN, nwg, G, c;
    __host__ __device__ void init(int M, int N, int G_, int c_) { nM = M / BM; nN = N / BM; nwg = nM * nN; G = G_; c = c_; }
    __host__ __device__ bool next(int i, Unit& u) const {
        const long L = (long)i * G + c; if (L >= nwg) return false;
        int wgid = (int)L; { const int q = nwg / NXCD, r = nwg % NXCD, xcd = wgid % NXCD, off = wgid / NXCD; wgid = (xcd < r ? xcd * (q + 1) : r * (q + 1) + (xcd - r) * q) + off; }
        const int nig = WGM * nN, gid = wgid / nig, fm = gid * WGM, gsz = (nM - fm) < WGM ? (nM - fm) : WGM;
        u.pm = fm + ((wgid % nig) % gsz); u.pn = (wgid % nig) / gsz; return true;
    }
    __device__ __forceinline__ void a_ready(const Unit&) const {}
    __device__ __forceinline__ void done(const Unit&) const {}
};
struct ShiftOrder : StaticOrder { int pm0; __host__ __device__ bool next(int i, Unit& u) const { if (!StaticOrder::next(i, u)) return false; u.pm += pm0; return true; } };

__device__ __forceinline__ unsigned cvt_pk_bf16(float lo, float hi) { unsigned r; asm volatile("v_cvt_pk_bf16_f32 %0, %1, %2" : "=v"(r) : "v"(lo), "v"(hi)); return r; }

template <class Epi, class Sched, bool ALIGN_EPI = false, bool SP2 = false>
__device__ __forceinline__ void gemm_phase(PG8_LAS unsigned char* lds, const Gemm g, const Sched& S, const Epi& E) {
    int tid_ = threadIdx.x; asm volatile("" : "+v"(tid_));
    const int tid = tid_, wid = __builtin_amdgcn_readfirstlane(tid >> 6), lane = tid & 63, wr = wid >> 2, wc = wid & 3, fr = lane & 15, fq = lane >> 4;
    const int K = g.K, nt = K / BK, lda = g.lda;
    unsigned voffA[2], voffB[2];
#pragma unroll
    for (int i = 0; i < 2; ++i) { int R, C; stage_rc(tid * 16 + i * 8192, R, C); const int Rb = Epi::PERM ? ((R & ~31) + perm32(R & 31)) : R;
        voffA[i] = (unsigned)(R * lda + C) * 2u; voffB[i] = (unsigned)(Rb * K + C) * 2u; }
    const size_t kstep = (size_t)(BK * 2);
    const size_t hstepA = (size_t)HALF * lda * 2, hstepB = (size_t)HALF * K * 2;
    const size_t tstepA = 2 * hstepA, tstepB = 2 * hstepB;
    const unsigned ldsw = (unsigned)wid * 1024u;
    const int aoff = lds_byte(wr * 64 + fr, fq * 8), boff = lds_byte(wc * 32 + fr, fq * 8);
#define PG8_SA(b, h) (((b) * 2 + (h)) * HTB)
#define PG8_SB(b, h) ((4 + (b) * 2 + (h)) * HTB)
#define PG8_STAGE(bufoff, gbase, voff) do { _Pragma("unroll") for (int _i = 0; _i < 2; ++_i) \
        __builtin_amdgcn_global_load_lds((const unsigned*)((const char*)(gbase) + (voff)[_i]), (PG8_LAS unsigned*)(lds + (bufoff) + ldsw + _i * 8192), 16, 0, 0); } while (0)
#define PG8_LDA(dst, b, h) do { _Pragma("unroll") for (int m = 0; m < 4; ++m) _Pragma("unroll") for (int k = 0; k < 2; ++k) dst[m][k] = *(const PG8_LAS bf16x8*)(lds + PG8_SA(b, h) + aoff + m * 2048 + k * 1024); } while (0)
#define PG8_LDB(dst, b, h) do { _Pragma("unroll") for (int n = 0; n < 2; ++n) _Pragma("unroll") for (int k = 0; k < 2; ++k) dst[n][k] = *(const PG8_LAS bf16x8*)(lds + PG8_SB(b, h) + boff + n * 2048 + k * 1024); } while (0)
#define PG8_MMA(ai, bj, At, Bt) do { __builtin_amdgcn_s_setprio(1); _Pragma("unroll") for (int m = 0; m < 4; ++m) _Pragma("unroll") for (int n = 0; n < 2; ++n) _Pragma("unroll") for (int k = 0; k < 2; ++k) \
        acc[ai][bj][m][n] = __builtin_amdgcn_mfma_f32_16x16x32_bf16(Bt[n][k], At[m][k], acc[ai][bj][m][n], 0, 0, 0); __builtin_amdgcn_s_setprio(0); } while (0)
#define PG8_WAIT_V(n) asm volatile("s_waitcnt vmcnt(" #n ")" ::: "memory")
#define PG8_WAIT_L(n) asm volatile("s_waitcnt lgkmcnt(" #n ")" ::: "memory")
#define PG8_BAR __builtin_amdgcn_s_barrier()
#define PG8_SCHED __builtin_amdgcn_sched_barrier(0)
    Unit cur, nxt; int ui = 0;
    if (!S.next(0, cur)) return;
    f32x4 acc[2][2][4][2];
#pragma unroll
    for (int a = 0; a < 2; ++a)
#pragma unroll
        for (int b = 0; b < 2; ++b)
#pragma unroll
            for (int m = 0; m < 4; ++m)
#pragma unroll
                for (int n = 0; n < 2; ++n) acc[a][b][m][n] = (f32x4){0.f, 0.f, 0.f, 0.f};
    bf16x8 At[4][2], B0[2][2], B1[2][2];
    const char* cA = (const char*)g.A + (size_t)cur.pm * tstepA; const char* cB = (const char*)g.Bt + (size_t)cur.pn * tstepB;
    S.a_ready(cur);
    if constexpr (SP2) {
        PG8_STAGE(PG8_SB(0, 0), cB, voffB); PG8_STAGE(PG8_SB(0, 1), cB + hstepB, voffB); PG8_STAGE(PG8_SA(0, 0), cA, voffA); PG8_STAGE(PG8_SA(0, 1), cA + hstepA, voffA);
        if (wr == 1) PG8_BAR;
        PG8_WAIT_V(2); PG8_BAR;
        PG8_STAGE(PG8_SB(1, 0), cB + kstep, voffB); PG8_STAGE(PG8_SA(1, 0), cA + kstep, voffA); PG8_STAGE(PG8_SB(1, 1), cB + hstepB + kstep, voffB);
        PG8_WAIT_V(6); PG8_BAR;
    } else {
        PG8_STAGE(PG8_SB(0, 0), cB, voffB); PG8_STAGE(PG8_SA(0, 0), cA, voffA); PG8_STAGE(PG8_SB(0, 1), cB + hstepB, voffB); PG8_STAGE(PG8_SA(0, 1), cA + hstepA, voffA);
        if (wr == 1) PG8_BAR;
        PG8_WAIT_V(4); PG8_BAR;
        PG8_STAGE(PG8_SB(1, 0), cB + kstep, voffB); PG8_STAGE(PG8_SA(1, 0), cA + kstep, voffA); PG8_STAGE(PG8_SB(1, 1), cB + hstepB + kstep, voffB);
        PG8_WAIT_V(6); PG8_BAR;
    }
    for (;;) {
        const bool has_next = S.next(ui + 1, nxt);
        const char* nA = has_next ? (const char*)g.A + (size_t)nxt.pm * tstepA : cA; const char* nB = has_next ? (const char*)g.Bt + (size_t)nxt.pn * tstepB : cB;
        for (int t = 0; t < nt; t += 2) {
            const bool last = (t == nt - 2);
            const char* a1 = cA + (size_t)(t + 1) * kstep;
            const char* a2 = last ? nA : cA + (size_t)(t + 2) * kstep; const char* b2 = last ? nB : cB + (size_t)(t + 2) * kstep;
            const char* a3 = a2 + kstep; const char* b3 = b2 + kstep;
            if (last && has_next) S.a_ready(nxt);
            if constexpr (Epi::HAS_MID) { if (t == nt / 2) E.mid(acc, cur, wr, wc, fr, fq); }
            if constexpr (SP2) {
            PG8_LDB(B0, 0, 0); PG8_LDB(B1, 0, 1); PG8_SCHED; PG8_LDA(At, 0, 0); PG8_STAGE(PG8_SA(1, 1), a1 + hstepA, voffA);
            PG8_WAIT_V(8); PG8_WAIT_L(0); PG8_BAR; PG8_MMA(0, 0, At, B0); PG8_MMA(0, 1, At, B1); PG8_BAR; PG8_SCHED;
            PG8_LDA(At, 0, 1); PG8_STAGE(PG8_SB(0, 0), b2, voffB); PG8_STAGE(PG8_SB(0, 1), b2 + hstepB, voffB); PG8_STAGE(PG8_SA(0, 0), a2, voffA);
            PG8_WAIT_V(8); PG8_WAIT_L(0); PG8_BAR; PG8_MMA(1, 0, At, B0); PG8_MMA(1, 1, At, B1); PG8_BAR; PG8_SCHED;
            PG8_LDB(B0, 1, 0); PG8_LDB(B1, 1, 1); PG8_SCHED; PG8_LDA(At, 1, 0); PG8_STAGE(PG8_SA(0, 1), a2 + hstepA, voffA);
            PG8_WAIT_V(8); PG8_WAIT_L(0); PG8_BAR; PG8_MMA(0, 0, At, B0); PG8_MMA(0, 1, At, B1); PG8_BAR; PG8_SCHED;
            PG8_LDA(At, 1, 1); PG8_STAGE(PG8_SB(1, 0), b3, voffB); PG8_STAGE(PG8_SB(1, 1), b3 + hstepB, voffB); PG8_STAGE(PG8_SA(1, 0), a3, voffA);
            PG8_WAIT_V(8); PG8_WAIT_L(0); PG8_BAR; PG8_MMA(1, 0, At, B0); PG8_MMA(1, 1, At, B1); PG8_BAR; PG8_SCHED;
            } else {
            PG8_LDB(B0, 0, 0); PG8_SCHED; PG8_LDA(At, 0, 0); PG8_STAGE(PG8_SA(1, 1), a1 + hstepA, voffA);
            PG8_WAIT_L(8); PG8_BAR; PG8_WAIT_L(0); PG8_MMA(0, 0, At, B0); PG8_BAR; PG8_SCHED;
            PG8_LDB(B1, 0, 1); PG8_STAGE(PG8_SB(0, 0), b2, voffB);
            PG8_BAR; PG8_WAIT_L(0); PG8_MMA(0, 1, At, B1); PG8_BAR;
            PG8_LDA(At, 0, 1); PG8_STAGE(PG8_SA(0, 0), a2, voffA);
            PG8_BAR; PG8_WAIT_L(0); PG8_MMA(1, 0, At, B0); PG8_BAR; PG8_SCHED;
            PG8_STAGE(PG8_SB(0, 1), b2 + hstepB, voffB);
            PG8_WAIT_V(6); PG8_BAR; PG8_MMA(1, 1, At, B1); PG8_BAR;
            PG8_LDB(B0, 1, 0); PG8_SCHED; PG8_LDA(At, 1, 0); PG8_STAGE(PG8_SA(0, 1), a2 + hstepA, voffA);
            PG8_WAIT_L(8); PG8_BAR; PG8_WAIT_L(0); PG8_MMA(0, 0, At, B0); PG8_BAR; PG8_SCHED;
            PG8_LDB(B1, 1, 1); PG8_STAGE(PG8_SB(1, 0), b3, voffB);
            PG8_BAR; PG8_WAIT_L(0); PG8_MMA(0, 1, At, B1); PG8_BAR;
            PG8_LDA(At, 1, 1); PG8_STAGE(PG8_SA(1, 0), a3, voffA);
            PG8_BAR; PG8_WAIT_L(0); PG8_MMA(1, 0, At, B0); PG8_BAR; PG8_SCHED;
            PG8_STAGE(PG8_SB(1, 1), b3 + hstepB, voffB);
            PG8_WAIT_V(6); PG8_BAR; PG8_MMA(1, 1, At, B1); PG8_BAR;
            }
        }
        if constexpr (ALIGN_EPI) { if (wr == 0) PG8_BAR; }
        E(acc, cur, wr, wc, fr, fq); S.done(cur);
        if (!has_next) break;
#pragma unroll
        for (int a = 0; a < 2; ++a)
#pragma unroll
            for (int b = 0; b < 2; ++b)
#pragma unroll
                for (int m = 0; m < 4; ++m)
#pragma unroll
                    for (int n = 0; n < 2; ++n) acc[a][b][m][n] = (f32x4){0.f, 0.f, 0.f, 0.f};
        cur = nxt; cA = nA; cB = nB; ++ui;
        if constexpr (ALIGN_EPI) { if (wr == 1) PG8_BAR; }
    }
    PG8_WAIT_V(0);
    if constexpr (!ALIGN_EPI) { if (wr == 0) PG8_BAR; }
    PG8_BAR;
#undef PG8_SA
#undef PG8_SB
#undef PG8_STAGE
#undef PG8_LDA
#undef PG8_LDB
#undef PG8_MMA
#undef PG8_WAIT_V
#undef PG8_WAIT_L
#undef PG8_BAR
#undef PG8_SCHED
}
}

constexpr int D = 1024, BATCH = 8, SEQ = 8192, DEPTH = 4, CTXL = 256, GRIDW = 64;
constexpr int NCTX = BATCH * CTXL;
constexpr int NLAT = BATCH * SEQ;
constexpr int R = NCTX + NLAT;
constexpr int IN_COLS = 5152, NPAD = 5376;
constexpr int PA_LD = 2048, PG_LD = 2048;
constexpr int PA_Q = 0, PA_K = 256, PA_R = 512, PA_NQ = 1024, PA_NK = 1536;
constexpr int NCHUNK = 132;
constexpr int NEXP = 16384;
constexpr float EPS = 1e-6f;
constexpr int NWAVES = 8, NT = 512;
constexpr int NPL = 13;
constexpr int NPHASE = 1 + DEPTH * NPL + 1;

constexpr size_t MiB = 1u << 20;
constexpr size_t WS_CTL = 0, CTL_ZERO_BYTES = 2 * MiB;
constexpr size_t WS_MOD = 1 * MiB;
constexpr size_t WS_ROPE = 2 * MiB;
constexpr size_t WS_WIN = 3 * MiB;
constexpr size_t WS_WPG = 45 * MiB, WS_WPN = 49 * MiB;
constexpr size_t WS_WO = 53 * MiB;
constexpr size_t WS_WS = 61 * MiB;
constexpr size_t WS_XC = 77 * MiB;
constexpr size_t WS_Z = 85 * MiB;
constexpr size_t WS_EU = 94 * MiB, WS_EV = 110 * MiB;
constexpr size_t WS_SU = 126 * MiB, WS_SV = WS_SU + 65536, WS_SX = WS_SV + 65536;
constexpr size_t WS_H8 = 884 * MiB;
constexpr size_t WS_PART = 290 * MiB;
constexpr size_t WS_ACT = 554 * MiB;
constexpr size_t WS_H = 158 * MiB;
constexpr size_t WS_PA = 290 * MiB;
constexpr size_t WS_VT = 554 * MiB, WS_NVT = 620 * MiB;
constexpr size_t WS_DEC = 950 * MiB;
constexpr size_t WS_PG = 686 * MiB;
constexpr size_t WS_SC = 290 * MiB;
constexpr size_t WS_EI = 818 * MiB, WS_EG = 851 * MiB;
constexpr size_t WS_END = 953 * MiB;
static_assert(WS_SC + (size_t)R * 2048 * 4 <= WS_EI && WS_EG + (size_t)R * 128 * 4 <= WS_DEC && WS_PG + (size_t)R * PG_LD * 2 <= WS_DEC && WS_DEC + 64 * 132 * 64 * 4 <= WS_END, "ws map");
static_assert(WS_H + (size_t)R * 1024 * 2 <= WS_PA && WS_PA + (size_t)R * PA_LD * 2 <= WS_VT && WS_VT + (size_t)R * 512 * 2 <= WS_NVT && WS_NVT + (size_t)R * 512 * 2 <= WS_PG && WS_Z + (size_t)R * 32 * 4 <= WS_EU, "ws map");
constexpr int CW_BAR = 4096;

constexpr int RING_BYTES = 131072, LDSCTL_OFF = RING_BYTES, MISC_OFF = LDSCTL_OFF + 320, LDS_BYTES = 147456;

#define GAS __attribute__((address_space(1)))
#define LAS __attribute__((address_space(3)))
typedef unsigned short bf16;
typedef unsigned v4u __attribute__((ext_vector_type(4)));
typedef unsigned v2u __attribute__((ext_vector_type(2)));
typedef int v4i __attribute__((ext_vector_type(4)));
typedef float f32x4 __attribute__((ext_vector_type(4)));
typedef __bf16 bf16x2_t __attribute__((ext_vector_type(2)));
#define LDS_WAIT() asm volatile("s_waitcnt lgkmcnt(0)" ::: "memory")
#define VM_WAIT() asm volatile("s_waitcnt vmcnt(0)" ::: "memory")
__device__ __forceinline__ unsigned f2bf(float f) { unsigned u = __builtin_bit_cast(unsigned, f); return (u + 0x7fffu + ((u >> 16) & 1u)) >> 16; }
__device__ __forceinline__ unsigned pk2(float lo, float hi) { return f2bf(lo) | (f2bf(hi) << 16); }
__device__ __forceinline__ float bflo(unsigned w) { return __builtin_bit_cast(float, w << 16); }
__device__ __forceinline__ float bfhi(unsigned w) { return __builtin_bit_cast(float, w & 0xffff0000u); }
__device__ __forceinline__ float bf1(bf16 h) { return __builtin_bit_cast(float, ((unsigned)h) << 16); }
__device__ __forceinline__ float dot2(unsigned a, unsigned b, float acc) { return __builtin_amdgcn_fdot2_f32_bf16(__builtin_bit_cast(bf16x2_t, a), __builtin_bit_cast(bf16x2_t, b), acc, false); }
__device__ __forceinline__ float shx(float v, int mask, int lane) { return __builtin_bit_cast(float, __builtin_amdgcn_ds_bpermute((lane ^ mask) << 2, __builtin_bit_cast(int, v))); }
__device__ __forceinline__ float wave_sum(float v, int lane) {
#pragma unroll
    for (int o = 1; o < 64; o <<= 1) v += shx(v, o, lane);
    return v;
}
__device__ __forceinline__ float wave_max(float v, int lane) {
#pragma unroll
    for (int o = 1; o < 64; o <<= 1) v = fmaxf(v, shx(v, o, lane));
    return v;
}
__device__ __forceinline__ float sigmoidf_(float x) { return __builtin_amdgcn_rcpf(1.f + __expf(-x)); }

#define XB_TMO      128
#define XB_XCNT(j)  (256  + 64 * (j))
#define XB_XSUB(j)  (1280 + 64 * (j))
#define XB_XGEN(j)  (2304 + 64 * (j))
#define XB_TOP      3328
#define XB_TOPGEN   3392
#define XCD_BAR_WORDS 3456
#define XB_SPIN_CAP (1u << 18)
__device__ __forceinline__ unsigned xb_ld(unsigned* p)              { return __hip_atomic_load(p, __ATOMIC_RELAXED, __HIP_MEMORY_SCOPE_AGENT); }
__device__ __forceinline__ unsigned xb_add(unsigned* p, unsigned v) { return __hip_atomic_fetch_add(p, v, __ATOMIC_RELAXED, __HIP_MEMORY_SCOPE_AGENT); }
__device__ __forceinline__ unsigned xb_xcc_id() { return (unsigned)__builtin_amdgcn_s_getreg((3 << 11) | 20) & 0xFu; }
#define XB_SPIN(cond, bar) do { unsigned _sp = 0; while (cond) { __builtin_amdgcn_s_sleep(1); \
    if ((++_sp & 255u) == 0u) { if (xb_ld(&(bar)[XB_TMO])) break; if (_sp > XB_SPIN_CAP) { atomicAdd(&(bar)[XB_TMO], 1u); break; } } } } while (0)
struct XcdBarrier { unsigned* bar; unsigned x; volatile LAS unsigned* st; };
__device__ __forceinline__ XcdBarrier xcd_barrier_post(unsigned* bar, volatile LAS unsigned* st) {
    XcdBarrier b; b.bar = bar; b.x = xb_xcc_id(); b.st = st;
    if (threadIdx.x == 0) (void)xb_add(&bar[XB_XCNT(b.x)], 1u);
    return b;
}
__device__ __forceinline__ void xcd_barrier_complete(unsigned* bar, unsigned x, unsigned& nloc, unsigned& nx) {
    const unsigned G = gridDim.x * gridDim.y * gridDim.z;
    unsigned sum, cnt, mine, sp = 0u;
    for (;;) {
        sum = 0u; cnt = 0u; mine = 0u;
#pragma unroll
        for (unsigned j = 0; j < 16; ++j) { const unsigned c = xb_ld(&bar[XB_XCNT(j)]); sum += c; cnt += (c > 0u) ? 1u : 0u; mine = (j == x) ? c : mine; }
        if (sum == G) break;
        __builtin_amdgcn_s_sleep(1);
        if ((++sp & 255u) == 0u) { if (xb_ld(&bar[XB_TMO])) break; if (sp > XB_SPIN_CAP) { atomicAdd(&bar[XB_TMO], 1u); break; } }
    }
    nloc = mine > 0u ? mine : 1u; nx = cnt > 0u ? cnt : 1u;
}
__device__ __forceinline__ void xcd_barrier(const XcdBarrier& b) {
    asm volatile("s_waitcnt vmcnt(0)" ::: "memory");
    __syncthreads();
    int tid0_ = threadIdx.x; asm volatile("" : "+v"(tid0_));
    if (tid0_ == 0) {
        unsigned* bar = b.bar;
        __builtin_amdgcn_s_waitcnt(0);
        unsigned nloc = b.st[0], nx = b.st[1];
        if (nloc == 0u) { xcd_barrier_complete(bar, b.x, nloc, nx); b.st[0] = nloc; b.st[1] = nx; }
        const unsigned old = xb_add(&bar[XB_XSUB(b.x)], 1u);
        const unsigned gen = old / nloc;
        if (old + 1u == (gen + 1u) * nloc) {
            __builtin_amdgcn_fence(__ATOMIC_RELEASE, "agent");
            asm volatile("s_waitcnt vmcnt(0)" ::: "memory");
            const unsigned og = xb_add(&bar[XB_TOP], 1u);
            const unsigned tg = og / nx;
            if (og + 1u == (tg + 1u) * nx) xb_add(&bar[XB_TOPGEN], 1u);
            else XB_SPIN(xb_ld(&bar[XB_TOPGEN]) == tg, bar);
            __builtin_amdgcn_fence(__ATOMIC_ACQUIRE, "agent");
            xb_add(&bar[XB_XGEN(b.x)], 1u);
            asm volatile("s_waitcnt vmcnt(0)" ::: "memory");
        } else {
            XB_SPIN(xb_ld(&bar[XB_XGEN(b.x)]) == gen, bar);
            __builtin_amdgcn_fence(__ATOMIC_ACQUIRE, "agent");
            asm volatile("s_waitcnt vmcnt(0)" ::: "memory");
        }
    }
    __syncthreads();
}

struct Args { const float* in[23]; float* out; unsigned char* ws; int ph_lo, ph_hi, li, pad; };
enum { I_X = 0, I_C, I_CTX, I_CCTX, I_WMOD, I_BMOD, I_GN1, I_WIN, I_WAF, I_BAF, I_WAB, I_BAB, I_GGLA, I_RPB, I_WPG, I_WPN, I_WO, I_GN2, I_WQ, I_SK, I_EU, I_EV, I_GF };

struct Frame {
    LAS unsigned char* lds;
    int tid, lane, wave, vcu, G;
};
typedef const __attribute__((address_space(4))) Args* CArgsP;
__device__ __forceinline__ CArgsP kargs() { CArgsP p = (CArgsP)__builtin_amdgcn_kernarg_segment_ptr(); asm volatile("" : "+s"(p)); return p; }
__device__ __forceinline__ const float* xrow_in(CArgsP a, int r) { return r < NCTX ? a->in[I_CTX] + (size_t)r * D : a->in[I_X] + (size_t)(r - NCTX) * D; }
constexpr int XL_LD = 2048;
__device__ __forceinline__ float* xc_row(CArgsP a, int r) { return (float*)(a->ws + WS_XC) + (size_t)r * D; }
__device__ __forceinline__ bf16* xl_row(CArgsP a, int r) { return (bf16*)a->out + (size_t)(r - NCTX) * XL_LD; }
__device__ __forceinline__ int row_slot(int r) { return r < NCTX ? 8 : ((r - NCTX) >> 13); }

using pg8::f32x4; using pg8::u32x4; using pg8::Unit; using pg8::cvt_pk_bf16;
struct EpiIn {
    static constexpr bool HAS_MID = false, PERM = true;
    bf16* PA; bf16* PG; float* Z; const float* rope; bf16* VT; bf16* NVT;
    __device__ __forceinline__ void operator()(const f32x4 (&acc)[2][2][4][2], const Unit& u, int wr, int wc, int fr, int fq) const {
        const int pn = u.pn, row0 = u.pm * 256 + wr * 64 + fr;
        if (pn == 20) {
            if (wc == 0) {
#pragma unroll
                for (int ai = 0; ai < 2; ++ai)
#pragma unroll
                    for (int m = 0; m < 4; ++m) { float* zp = Z + (size_t)(row0 + ai * 128 + m * 16) * 32 + 8 * fq; *(f32x4*)zp = acc[ai][0][m][0]; *(f32x4*)(zp + 4) = acc[ai][0][m][1]; }
            }
            return;
        }
        if (pn >= 8 && pn < 12) {
            bf16* T = (pn < 10 ? VT : NVT) + (size_t)(((pn - 8) & 1) * 256 + wc * 32 + 8 * fq) * R;
#pragma unroll
            for (int ai = 0; ai < 2; ++ai)
#pragma unroll
                for (int m = 0; m < 4; ++m) {
                    const int row = row0 + ai * 128 + m * 16;
#pragma unroll
                    for (int bj = 0; bj < 2; ++bj) {
                        const f32x4 v0 = acc[ai][bj][m][0], v1 = acc[ai][bj][m][1];
                        bf16* tp = T + (size_t)(bj * 128) * R + row;
                        tp[0 * (size_t)R] = (bf16)f2bf(v0[0]); tp[1 * (size_t)R] = (bf16)f2bf(v0[1]); tp[2 * (size_t)R] = (bf16)f2bf(v0[2]); tp[3 * (size_t)R] = (bf16)f2bf(v0[3]);
                        tp[4 * (size_t)R] = (bf16)f2bf(v1[0]); tp[5 * (size_t)R] = (bf16)f2bf(v1[1]); tp[6 * (size_t)R] = (bf16)f2bf(v1[2]); tp[7 * (size_t)R] = (bf16)f2bf(v1[3]);
                    }
                }
            return;
        }
        bf16* base; int ldc, colt;
        if (pn < 8) { base = PA; ldc = PA_LD; colt = pn * 256; } else { base = PG; ldc = PG_LD; colt = (pn - 12) * 256; }
        const int col0 = colt + wc * 32 + 8 * fq;
        const bool do_rope = (pn < 2) && (u.pm >= 8);
        const float sc = (pn == 0 || pn == 4 || pn == 5) ? 0.125f : 1.f;
#pragma unroll
        for (int ai = 0; ai < 2; ++ai)
#pragma unroll
            for (int m = 0; m < 4; ++m) {
                const int row = row0 + ai * 128 + m * 16;
                bf16* rowp = base + (size_t)row * ldc + col0;
                f32x4 cs[4];
                if (do_rope) { const int t = (row - NCTX) & (SEQ - 1); const int pos = (wc & 1) ? (t & 63) : (t >> 6);
                    const f32x4* cp = (const f32x4*)(rope + (size_t)(pos * 16 + 8 * (fq & 1)) * 2);
                    cs[0] = cp[0]; cs[1] = cp[1]; cs[2] = cp[2]; cs[3] = cp[3]; }
#pragma unroll
                for (int bj = 0; bj < 2; ++bj) {
                    f32x4 v0 = acc[ai][bj][m][0], v1 = acc[ai][bj][m][1];
                    if (do_rope) {
                        float x[8] = {v0[0], v0[1], v0[2], v0[3], v1[0], v1[1], v1[2], v1[3]};
#pragma unroll
                        for (int e = 0; e < 8; ++e) { const float p = shx(x[e], 32, fr + 16 * fq); const float c = cs[e >> 1][(e & 1) * 2], s = cs[e >> 1][(e & 1) * 2 + 1];
                            x[e] = (fq < 2) ? (x[e] * c - p * s) : (p * s + x[e] * c); }
                        v0 = (f32x4){x[0], x[1], x[2], x[3]}; v1 = (f32x4){x[4], x[5], x[6], x[7]};
                    }
                    v0 = v0 * sc; v1 = v1 * sc;
                    u32x4 w; w.x = cvt_pk_bf16(v0[0], v0[1]); w.y = cvt_pk_bf16(v0[2], v0[3]); w.z = cvt_pk_bf16(v1[0], v1[1]); w.w = cvt_pk_bf16(v1[2], v1[3]);
                    *(u32x4*)(rowp + bj * 128) = w;
                }
                asm volatile("" ::: "memory");
            }
    }
};
struct EpiMergeK {
    static constexpr bool HAS_MID = true, PERM = true;
    bf16* MG; const bf16* PG;
    __device__ __forceinline__ void mid(f32x4 (&acc)[2][2][4][2], const Unit& u, int wr, int wc, int fr, int fq) const {
        int row0 = u.pm * 256 + wr * 64 + fr, col0 = u.pn * 256 + wc * 32 + 8 * fq;
        asm volatile("" : "+v"(row0), "+v"(col0));
#pragma unroll
        for (int ai = 0; ai < 2; ++ai) {
            u32x4 g1[4][2], g2[4][2];
#pragma unroll
            for (int m = 0; m < 4; ++m)
#pragma unroll
                for (int bj = 0; bj < 2; ++bj) { const bf16* gp = PG + (size_t)(row0 + ai * 128 + m * 16) * PG_LD + col0 + bj * 128; g1[m][bj] = *(const u32x4*)gp; g2[m][bj] = *(const u32x4*)(gp + 1024); }
#pragma unroll
            for (int m = 0; m < 4; ++m)
#pragma unroll
                for (int bj = 0; bj < 2; ++bj) {
                    const unsigned a1[4] = {g1[m][bj].x, g1[m][bj].y, g1[m][bj].z, g1[m][bj].w}, a2[4] = {g2[m][bj].x, g2[m][bj].y, g2[m][bj].z, g2[m][bj].w};
#pragma unroll
                    for (int q = 0; q < 4; ++q) {
                        const float r0 = (1.f + __expf(-bflo(a2[q]))) * __builtin_amdgcn_rcpf(1.f + __expf(-bflo(a1[q])));
                        const float r1 = (1.f + __expf(-bfhi(a2[q]))) * __builtin_amdgcn_rcpf(1.f + __expf(-bfhi(a1[q])));
                        acc[ai][bj][m][q >> 1][(q & 1) * 2] *= r0; acc[ai][bj][m][q >> 1][(q & 1) * 2 + 1] *= r1;
                    }
                }
        }
    }
    __device__ __forceinline__ void operator()(const f32x4 (&acc)[2][2][4][2], const Unit& u, int wr, int wc, int fr, int fq) const {
        int row0 = u.pm * 256 + wr * 64 + fr, col0 = u.pn * 256 + wc * 32 + 8 * fq;
        asm volatile("" : "+v"(row0), "+v"(col0));
        u32x4 gw[2][4][2];
#pragma unroll
        for (int ai = 0; ai < 2; ++ai)
#pragma unroll
            for (int m = 0; m < 4; ++m)
#pragma unroll
                for (int bj = 0; bj < 2; ++bj) gw[ai][m][bj] = *(const u32x4*)(PG + (size_t)(row0 + ai * 128 + m * 16) * PG_LD + 1024 + col0 + bj * 128);
#pragma unroll
        for (int ai = 0; ai < 2; ++ai)
#pragma unroll
            for (int m = 0; m < 4; ++m)
#pragma unroll
                for (int bj = 0; bj < 2; ++bj) {
                    const u32x4 g = gw[ai][m][bj];
                    const f32x4 v0 = acc[ai][bj][m][0], v1 = acc[ai][bj][m][1];
                    u32x4 w; w.x = cvt_pk_bf16(sigmoidf_(bflo(g.x)) * v0[0], sigmoidf_(bfhi(g.x)) * v0[1]); w.y = cvt_pk_bf16(sigmoidf_(bflo(g.y)) * v0[2], sigmoidf_(bfhi(g.y)) * v0[3]);
                    w.z = cvt_pk_bf16(sigmoidf_(bflo(g.z)) * v1[0], sigmoidf_(bfhi(g.z)) * v1[1]); w.w = cvt_pk_bf16(sigmoidf_(bflo(g.w)) * v1[2], sigmoidf_(bfhi(g.w)) * v1[3]);
                    *(u32x4*)(MG + (size_t)(row0 + ai * 128 + m * 16) * D + col0 + bj * 128) = w;
                }
    }
};
struct EpiRes {
    static constexpr bool HAS_MID = false, PERM = true;
    const float* src_c; const float* src_l; float* dst_c; bf16* dst_l; const float* mod; int first;
    __device__ __forceinline__ void operator()(const f32x4 (&acc)[2][2][4][2], const Unit& u, int wr, int wc, int fr, int fq) const {
        const bool isctx = u.pm < 8;
        const int slot = isctx ? 8 : ((u.pm - 8) >> 5);
        int rbase = (isctx ? u.pm * 256 : (u.pm - 8) * 256) + wr * 64 + fr, col0 = u.pn * 256 + wc * 32 + 8 * fq;
        asm volatile("" : "+v"(rbase), "+v"(col0));
        const float* ga = mod + slot * 6144 + 2048;
        f32x4 gv[2][2];
#pragma unroll
        for (int bj = 0; bj < 2; ++bj)
#pragma unroll
            for (int n = 0; n < 2; ++n) gv[bj][n] = *(const f32x4*)(ga + col0 + bj * 128 + 4 * n);
        if (isctx || first) {
#pragma unroll
            for (int ai = 0; ai < 2; ++ai) {
                f32x4 x0[4][2], x1[4][2];
#pragma unroll
                for (int m = 0; m < 4; ++m)
#pragma unroll
                    for (int bj = 0; bj < 2; ++bj) { const float* sp = (isctx ? src_c : src_l) + (size_t)(rbase + ai * 128 + m * 16) * D + col0 + bj * 128; x0[m][bj] = *(const f32x4*)sp; x1[m][bj] = *(const f32x4*)(sp + 4); }
#pragma unroll
                for (int m = 0; m < 4; ++m)
#pragma unroll
                    for (int bj = 0; bj < 2; ++bj) {
                        const int row = rbase + ai * 128 + m * 16, c = col0 + bj * 128;
                        const f32x4 y0 = x0[m][bj] + gv[bj][0] * acc[ai][bj][m][0], y1 = x1[m][bj] + gv[bj][1] * acc[ai][bj][m][1];
                        if (isctx) { float* dp = dst_c + (size_t)row * D + c; *(f32x4*)dp = y0; *(f32x4*)(dp + 4) = y1; }
                        else { u32x4 w; w.x = cvt_pk_bf16(y0[0], y0[1]); w.y = cvt_pk_bf16(y0[2], y0[3]); w.z = cvt_pk_bf16(y1[0], y1[1]); w.w = cvt_pk_bf16(y1[2], y1[3]); *(u32x4*)(dst_l + (size_t)row * XL_LD + c) = w; }
                    }
            }
        } else {
            u32x4 xw[2][4][2];
#pragma unroll
            for (int ai = 0; ai < 2; ++ai)
#pragma unroll
                for (int m = 0; m < 4; ++m)
#pragma unroll
                    for (int bj = 0; bj < 2; ++bj) xw[ai][m][bj] = *(const u32x4*)(dst_l + (size_t)(rbase + ai * 128 + m * 16) * XL_LD + col0 + bj * 128);
#pragma unroll
            for (int ai = 0; ai < 2; ++ai)
#pragma unroll
                for (int m = 0; m < 4; ++m)
#pragma unroll
                    for (int bj = 0; bj < 2; ++bj) {
                        const u32x4 w0 = xw[ai][m][bj];
                        const f32x4 y0 = (f32x4){bflo(w0.x), bfhi(w0.x), bflo(w0.y), bfhi(w0.y)} + gv[bj][0] * acc[ai][bj][m][0], y1 = (f32x4){bflo(w0.z), bfhi(w0.z), bflo(w0.w), bfhi(w0.w)} + gv[bj][1] * acc[ai][bj][m][1];
                        u32x4 w; w.x = cvt_pk_bf16(y0[0], y0[1]); w.y = cvt_pk_bf16(y0[2], y0[3]); w.z = cvt_pk_bf16(y1[0], y1[1]); w.w = cvt_pk_bf16(y1[2], y1[3]);
                        *(u32x4*)(dst_l + (size_t)(rbase + ai * 128 + m * 16) * XL_LD + col0 + bj * 128) = w;
                    }
        }
    }
};
struct EpiB16 {
    static constexpr bool HAS_MID = false, PERM = true;
    bf16* C; int ldc;
    __device__ __forceinline__ void operator()(const f32x4 (&acc)[2][2][4][2], const Unit& u, int wr, int wc, int fr, int fq) const {
        const int row0 = u.pm * 256 + wr * 64 + fr, col0 = u.pn * 256 + wc * 32 + 8 * fq;
#pragma unroll
        for (int ai = 0; ai < 2; ++ai)
#pragma unroll
            for (int m = 0; m < 4; ++m) { bf16* rowp = C + (size_t)(row0 + ai * 128 + m * 16) * ldc + col0;
#pragma unroll
                for (int bj = 0; bj < 2; ++bj) { const f32x4 v0 = acc[ai][bj][m][0], v1 = acc[ai][bj][m][1];
                    u32x4 w; w.x = pk2(v0[0], v0[1]); w.y = pk2(v0[2], v0[3]); w.z = pk2(v1[0], v1[1]); w.w = pk2(v1[2], v1[3]);
                    *(u32x4*)(rowp + bj * 128) = w; } }
    }
};
__device__ __forceinline__ void p0_transpose_item(const float* W, int K, int N, bf16* WT, int dst_row0, LAS float* scr, int k0, int n0, int lane) {
#pragma unroll 8
    for (int i = 0; i < 32; ++i) { const int kk = 2 * i + (lane >> 5); scr[kk * 33 + (lane & 31)] = W[(size_t)(k0 + kk) * N + n0 + (lane & 31)]; }
    LDS_WAIT(); asm volatile("" ::: "memory");
    const int c = lane & 7;
#pragma unroll
    for (int j = 0; j < 4; ++j) { const int n = (lane >> 3) + 8 * j; const LAS float* s = scr + (8 * c) * 33 + n;
        v4u o; o.x = pk2(s[0 * 33], s[1 * 33]); o.y = pk2(s[2 * 33], s[3 * 33]); o.z = pk2(s[4 * 33], s[5 * 33]); o.w = pk2(s[6 * 33], s[7 * 33]);
        *(v4u*)(WT + (size_t)(dst_row0 + n) * K + k0 + 8 * c) = o; }
    LDS_WAIT(); asm volatile("" ::: "memory");
}
__device__ __forceinline__ int win_map(int n0) {
    if (n0 < 512) return n0;
    if (n0 < 1024) return 2048 + (n0 - 512);
    if (n0 < 1056) return 5120 + (n0 - 1024);
    if (n0 < 1568) return 512 + (n0 - 1056);
    if (n0 < 2080) return 1024 + (n0 - 1568);
    if (n0 < 2592) return 1536 + (n0 - 2080);
    if (n0 < 3104) return 2560 + (n0 - 2592);
    return 3072 + (n0 - 3104);
}

__device__ __forceinline__ void p0_prologue(const Frame& F) {
    CArgsP a = kargs(); unsigned char* const ws = a->ws;
    const int gw = F.vcu * NWAVES + F.wave, NGW = F.G * NWAVES;
    const int gtid = F.vcu * NT + F.tid, GT = F.G * NT;
    {
        LAS float* scr = (LAS float*)(F.lds + F.wave * 16384);
        constexpr int I_IN = 16 * 161, I_P = 8 * 32, I_O = 16 * 32, PER_L = I_IN + 2 * I_P + I_O;
        for (int it = gw; it < DEPTH * PER_L; it += NGW) {
            const int l = it / PER_L; int r = it % PER_L;
            if (r < I_IN) { const int kb = r / 161, nb = r % 161; p0_transpose_item(a->in[I_WIN] + (size_t)l * D * IN_COLS, D, IN_COLS, (bf16*)(ws + WS_WIN) + (size_t)l * NPAD * D, win_map(nb * 32), scr, kb * 64, nb * 32, F.lane); continue; }
            r -= I_IN;
            if (r < I_P) { const int kb = r / 32, nb = r % 32; p0_transpose_item(a->in[I_WPG] + (size_t)l * 512 * D, D, D, (bf16*)(ws + WS_WPG) + (size_t)l * D * D, nb * 32, scr, kb * 64, nb * 32, F.lane); continue; }
            r -= I_P;
            if (r < I_P) { const int kb = r / 32, nb = r % 32; p0_transpose_item(a->in[I_WPN] + (size_t)l * 512 * D, D, D, (bf16*)(ws + WS_WPG) + (size_t)l * D * D + 512, nb * 32, scr, kb * 64, nb * 32, F.lane); continue; }
            r -= I_P;
            { const int kb = r / 32, nb = r % 32; p0_transpose_item(a->in[I_WO] + (size_t)l * D * D, D, D, (bf16*)(ws + WS_WO) + (size_t)l * D * D, nb * 32, scr, kb * 64, nb * 32, F.lane); }
        }
        constexpr int PADV = (NPAD - IN_COLS) * D / 8;
        for (int i = gtid; i < DEPTH * PADV; i += GT) { const int l = i / PADV, j = i % PADV; *((v4u*)((bf16*)(ws + WS_WIN) + ((size_t)l * NPAD + IN_COLS) * D) + j) = (v4u){0u, 0u, 0u, 0u}; }
    }
    __syncthreads();
    if (gtid < 128 * 16) { const int pos = gtid >> 4, j = gtid & 15; const float freq = powf(10000.f, -(float)j / 16.f); const float ang = (float)pos * freq;
        float* cs = (float*)(ws + WS_ROPE); cs[2 * gtid] = cosf(ang); cs[2 * gtid + 1] = sinf(ang); }
    {
        LAS float* LSK = (LAS float*)F.lds;
        LAS float* LQ = (LAS float*)(F.lds + 128 * 132 * 4);
        for (int unit = F.vcu; unit < DEPTH * 16 * 16; unit += F.G) {
            const int l = unit >> 8, hp = (unit >> 4) & 15, d0 = (unit & 15) * 64;
            const float* sk = a->in[I_SK] + ((size_t)l * 16 + hp) * 16384;
            const float* wq = a->in[I_WQ] + (size_t)l * D * 2048 + hp * 128;
            __syncthreads();
            for (int i = F.tid; i < 16384; i += NT) LSK[(i >> 7) * 132 + (i & 127)] = sk[i];
            for (int i = F.tid; i < 8192; i += NT) LQ[(i >> 7) * 132 + (i & 127)] = wq[(size_t)(d0 + (i >> 7)) * 2048 + (i & 127)];
            __syncthreads();
            const int dd = F.tid & 63, kg = F.tid >> 6;
            float acc[16];
#pragma unroll
            for (int k = 0; k < 16; ++k) acc[k] = 0.f;
            for (int j = 0; j < 128; j += 4) {
                const f32x4 q = *(const LAS f32x4*)(LQ + dd * 132 + j);
#pragma unroll
                for (int k = 0; k < 16; ++k) { const f32x4 s = *(const LAS f32x4*)(LSK + (kg * 16 + k) * 132 + j); acc[k] += q[0] * s[0] + q[1] * s[1] + q[2] * s[2] + q[3] * s[3]; }
            }
            bf16* o = (bf16*)(ws + WS_WS) + ((size_t)l * 2048 + hp * 128 + kg * 16) * D + d0 + dd;
#pragma unroll
            for (int k = 0; k < 16; ++k) o[(size_t)k * D] = (bf16)f2bf(acc[k]);
        }
    }
    __syncthreads();
    {
        LAS float* ca = (LAS float*)F.lds;
        LAS float* red = (LAS float*)(F.lds + 9 * D * 4);
        for (int i = F.tid; i < 9 * D; i += NT) { const float v = i < 8 * D ? a->in[I_C][i] : a->in[I_CCTX][i - 8 * D]; ca[i] = v / (1.f + __expf(-v)); }
        __syncthreads();
        float* MOD = (float*)(ws + WS_MOD);
        for (int unit = F.vcu; unit < DEPTH * 96; unit += F.G) {
            const int l = unit / 96, cb = unit % 96, dc = F.tid >> 6;
            const int col = cb * 64 + (F.tid & 63);
            const float* w = a->in[I_WMOD] + ((size_t)l * D + dc * 128) * 6144 + col;
            float acc[9];
#pragma unroll
            for (int b = 0; b < 9; ++b) acc[b] = 0.f;
#pragma unroll 8
            for (int d = 0; d < 128; ++d) { const float wv = w[(size_t)d * 6144];
#pragma unroll
                for (int b = 0; b < 9; ++b) acc[b] += ca[b * D + dc * 128 + d] * wv; }
#pragma unroll
            for (int b = 0; b < 9; ++b) red[(dc * 9 + b) * 64 + (F.tid & 63)] = acc[b];
            __syncthreads();
            for (int i = F.tid; i < 9 * 64; i += NT) { const int b = i >> 6, c = i & 63; float sum = a->in[I_BMOD][l * 6144 + cb * 64 + c];
#pragma unroll
                for (int k = 0; k < 8; ++k) sum += red[(k * 9 + b) * 64 + c];
                MOD[((size_t)l * 9 + b) * 6144 + cb * 64 + c] = sum; }
            __syncthreads();
        }
    }
    __syncthreads();
}

__device__ __forceinline__ unsigned pk4_fp8(float a, float b, float c, float d) { int p = __builtin_amdgcn_cvt_pk_fp8_f32(a, b, 0, false); p = __builtin_amdgcn_cvt_pk_fp8_f32(c, d, p, true); return (unsigned)p; }
__device__ __forceinline__ void convert_row_fp8(const f32x4 (&v)[4], unsigned char* dst_tab, float* scale_out, int e, int lane) {
    const f32x4 a0 = v[0], a1 = v[1], a2 = v[2], a3 = v[3];
    float mx = fmaxf(fmaxf(fmaxf(fabsf(a0[0]), fabsf(a0[1])), fmaxf(fabsf(a0[2]), fabsf(a0[3]))), fmaxf(fmaxf(fabsf(a1[0]), fabsf(a1[1])), fmaxf(fabsf(a1[2]), fabsf(a1[3]))));
    mx = fmaxf(mx, fmaxf(fmaxf(fmaxf(fabsf(a2[0]), fabsf(a2[1])), fmaxf(fabsf(a2[2]), fabsf(a2[3]))), fmaxf(fmaxf(fabsf(a3[0]), fabsf(a3[1])), fmaxf(fabsf(a3[2]), fabsf(a3[3])))));
    mx = fmaxf(wave_max(mx, lane), 1e-30f);
    const float sc = 256.f / mx;
    const v4u w = (v4u){pk4_fp8(a0[0] * sc, a0[1] * sc, a0[2] * sc, a0[3] * sc), pk4_fp8(a1[0] * sc, a1[1] * sc, a1[2] * sc, a1[3] * sc), pk4_fp8(a2[0] * sc, a2[1] * sc, a2[2] * sc, a2[3] * sc), pk4_fp8(a3[0] * sc, a3[1] * sc, a3[2] * sc, a3[3] * sc)};
    *(v4u*)(dst_tab + ((size_t)(lane >> 3) * NEXP + e) * 128 + 16 * (lane & 7)) = w;
    if (lane == 0) scale_out[e] = mx * (1.f / 256.f);
}
__device__ __forceinline__ void convert_experts(const Frame& F, int layer) {
    CArgsP a = kargs(); unsigned char* const ws = a->ws;
    const int gw = F.vcu * NWAVES + F.wave, NGW = F.G * NWAVES;
    const float* su = a->in[I_EU] + (size_t)layer * NEXP * D; const float* sv = a->in[I_EV] + (size_t)layer * NEXP * D;
    for (int e = gw; e < NEXP; e += 2 * NGW) {
        const int e1 = e + NGW < NEXP ? e + NGW : e;
        f32x4 ru[2][4], rv[2][4];
#pragma unroll
        for (int q = 0; q < 2; ++q) { const int eq = q ? e1 : e; const f32x4* pu = (const f32x4*)(su + (size_t)eq * D) + 4 * F.lane; const f32x4* pv = (const f32x4*)(sv + (size_t)eq * D) + 4 * F.lane;
#pragma unroll
            for (int j = 0; j < 4; ++j) { ru[q][j] = pu[j]; rv[q][j] = pv[j]; } }
        convert_row_fp8(ru[0], ws + WS_EU, (float*)(ws + WS_SU), e, F.lane); convert_row_fp8(rv[0], ws + WS_EV, (float*)(ws + WS_SV), e, F.lane);
        if (e + NGW < NEXP) { convert_row_fp8(ru[1], ws + WS_EU, (float*)(ws + WS_SU), e1, F.lane); convert_row_fp8(rv[1], ws + WS_EV, (float*)(ws + WS_SV), e1, F.lane); }
    }
}

__device__ __forceinline__ void norm_phase(const Frame& F, int layer, int which, int rbeg) {
    CArgsP a = kargs(); unsigned char* const ws = a->ws;
    const int gw = F.vcu * NWAVES + F.wave, NGW = F.G * NWAVES;
    const float* g = (which ? a->in[I_GN2] : a->in[I_GN1]) + layer * D;
    const float* MOD = (const float*)(ws + WS_MOD) + (size_t)layer * 9 * 6144 + (which ? 3072 : 0);
    bf16* H = (bf16*)(ws + WS_H);
    f32x4 gv[4];
#pragma unroll
    for (int j = 0; j < 4; ++j) gv[j] = *((const f32x4*)g + F.lane + 64 * j);
    for (int r = rbeg + gw; r < R; r += NGW) {
        const float* sh = MOD + row_slot(r) * 6144; const float* sc = sh + D;
        f32x4 v[4]; float ss = 0.f;
        if ((which == 0 && layer == 0) || r < NCTX) {
            const float* xr = (which == 0 && layer == 0) ? xrow_in(a, r) : xc_row(a, r);
#pragma unroll
            for (int j = 0; j < 4; ++j) v[j] = *((const GAS f32x4*)xr + F.lane + 64 * j);
        } else {
            const v2u* xb = (const v2u*)xl_row(a, r) + F.lane;
#pragma unroll
            for (int j = 0; j < 4; ++j) { const v2u w = xb[64 * j]; v[j] = (f32x4){bflo(w.x), bfhi(w.x), bflo(w.y), bfhi(w.y)}; }
        }
#pragma unroll
        for (int j = 0; j < 4; ++j) ss += (v[j][0] * v[j][0] + v[j][1] * v[j][1]) + (v[j][2] * v[j][2] + v[j][3] * v[j][3]);
        const float rs = rsqrtf(wave_sum(ss, F.lane) * (1.f / D) + EPS);
        unsigned long long* o8 = (unsigned long long*)(H + (size_t)r * D) + F.lane;
        float mx = 0.f;
#pragma unroll
        for (int j = 0; j < 4; ++j) {
            const f32x4 s1 = *((const f32x4*)sc + F.lane + 64 * j), s0 = *((const f32x4*)sh + F.lane + 64 * j);
            const f32x4 y = v[j] * rs * gv[j] * (s1 + 1.f) + s0;
            o8[64 * j] = (unsigned long long)pk2(y[0], y[1]) | ((unsigned long long)pk2(y[2], y[3]) << 32);
            v[j] = y; mx = fmaxf(mx, fmaxf(fmaxf(fabsf(y[0]), fabsf(y[1])), fmaxf(fabsf(y[2]), fabsf(y[3]))));
        }
        if (which) {
            mx = fmaxf(wave_max(mx, F.lane), 1e-30f); const float q8 = 256.f / mx;
            unsigned* h8 = (unsigned*)(ws + WS_H8 + (size_t)r * D) + F.lane;
#pragma unroll
            for (int j = 0; j < 4; ++j) h8[64 * j] = pk4_fp8(v[j][0] * q8, v[j][1] * q8, v[j][2] * q8, v[j][3] * q8);
            if (F.lane == 0) ((float*)(ws + WS_SX))[r] = mx * (1.f / 256.f);
        }
    }
}

constexpr int GL_TOT = 0, GL_IMG = 4096, GL_PITCH = 144, GL_IMGB = 64 * GL_PITCH, GL_SSX = GL_IMG + 4 * GL_IMGB;
typedef short bf16x8_t __attribute__((ext_vector_type(8)));
__device__ __forceinline__ int chunk_row0(int b, int tc) { return tc < 4 ? b * CTXL + tc * 64 : NCTX + b * SEQ + (tc - 4) * 64; }
__device__ __forceinline__ int chunk_pos(int tc, int dir) { return dir == 0 ? tc : (tc < 4 ? 3 - tc : 135 - tc); }
__device__ __forceinline__ float logsig16(float x) { return (fminf(x, 0.f) - 0.69314718f * __builtin_amdgcn_logf(1.f + __builtin_amdgcn_exp2f(-1.44269504f * fabsf(x)))) * (1.f / 16.f); }
constexpr int GL_HALF = 65536, GL_Z = 40960, GL_QK = 49152;
struct GlaW { float wf[16], wb[16], baf, bab; };
__device__ __forceinline__ void gla_load_w(GlaW& w, CArgsP a, int layer, int h, int lane) {
    const float* waf = a->in[I_WAF] + layer * 4096 + h * 64 + lane; const float* wab = a->in[I_WAB] + layer * 4096 + h * 64 + lane;
#pragma unroll
    for (int j = 0; j < 16; ++j) { w.wf[j] = waf[j * 256]; w.wb[j] = wab[j * 256]; }
    w.baf = a->in[I_BAF][layer * 256 + h * 64 + lane]; w.bab = a->in[I_BAB][layer * 256 + h * 64 + lane];
}
__device__ __forceinline__ void gla_scan(LAS unsigned char* hl, int w4, int lane, const GlaW& w, const float* Z, int row0, float (&Bf)[16], float (&Bb)[16], float& endf, float& endb) {
    const int t0 = 16 * w4;
    LAS float* ZL = (LAS float*)(hl + GL_Z) + t0 * 32;
    { const f32x4* zp = (const f32x4*)(Z + (size_t)(row0 + t0 + (lane >> 2)) * 32 + (lane & 3) * 8); const f32x4 z0 = zp[0], z1 = zp[1];
      *(LAS f32x4*)(ZL + (lane >> 2) * 32 + (lane & 3) * 8) = z0; *(LAS f32x4*)(ZL + (lane >> 2) * 32 + (lane & 3) * 8 + 4) = z1; }
    LDS_WAIT();
#pragma unroll
    for (int i = 0; i < 16; ++i) {
        const LAS f32x4* zp = (const LAS f32x4*)(ZL + i * 32);
        float zf = w.baf, zb = w.bab;
#pragma unroll
        for (int q = 0; q < 4; ++q) { const f32x4 z0 = zp[q], z1 = zp[4 + q];
            zf += z0[0] * w.wf[4 * q] + z0[1] * w.wf[4 * q + 1] + z0[2] * w.wf[4 * q + 2] + z0[3] * w.wf[4 * q + 3];
            zb += z1[0] * w.wb[4 * q] + z1[1] * w.wb[4 * q + 1] + z1[2] * w.wb[4 * q + 2] + z1[3] * w.wb[4 * q + 3]; }
        Bf[i] = logsig16(zf); Bb[i] = logsig16(zb);
    }
#pragma unroll
    for (int i = 1; i < 16; ++i) Bf[i] += Bf[i - 1];
#pragma unroll
    for (int i = 14; i >= 0; --i) Bb[i] += Bb[i + 1];
    LAS float* TOT = (LAS float*)(hl + GL_TOT);
    TOT[(0 * 4 + w4) * 64 + lane] = Bf[15]; TOT[(1 * 4 + w4) * 64 + lane] = Bb[0];
    __syncthreads();
    float offf = 0.f, offb = 0.f; endf = 0.f; endb = 0.f;
#pragma unroll
    for (int ww = 0; ww < 4; ++ww) { const float tf = TOT[(0 * 4 + ww) * 64 + lane], tb = TOT[(1 * 4 + ww) * 64 + lane]; endf += tf; endb += tb; offf += (ww < w4) ? tf : 0.f; offb += (ww > w4) ? tb : 0.f; }
#pragma unroll
    for (int i = 0; i < 16; ++i) { Bf[i] += offf; Bb[i] += offb; }
}
constexpr int GLA_UNITS = BATCH * 4 * NCHUNK;
__device__ __forceinline__ void gla_a_phase(const Frame& F, int layer) {
    CArgsP a = kargs(); unsigned char* const ws = a->ws;
    const bf16* PA = (const bf16*)(ws + WS_PA); const bf16* VT = (const bf16*)(ws + WS_VT);
    const float* Z = (const float*)(ws + WS_Z); bf16* SST = (bf16*)(ws + WS_H); float* DEC = (float*)(ws + WS_DEC);
    const int lane = F.lane, l16 = lane & 15, g = lane >> 4, hw = F.wave >> 2, w4 = F.wave & 3, t0 = 16 * w4;
    LAS unsigned char* hl = F.lds + hw * GL_HALF;
    const int h = F.vcu & 3;
    GlaW gw; gla_load_w(gw, a, layer, h, lane);
    for (int pp = F.vcu >> 2; pp < BATCH * NCHUNK / 2; pp += F.G >> 2) {
        const int unit = 2 * pp + hw;
        const int b = unit / NCHUNK, tc = unit % NCHUNK, row0 = chunk_row0(b, tc);
        LAS bf16* KL = (LAS bf16*)(hl + GL_QK + 8192) + t0 * 64;
        { const bf16* kp = PA + (size_t)(row0 + t0 + (lane >> 2)) * PA_LD + PA_K + h * 64 + (lane & 3) * 16; const v4u k0 = *(const v4u*)kp, k1 = *(const v4u*)(kp + 8);
          *(LAS v4u*)(KL + (lane >> 2) * 64 + (lane & 3) * 16) = k0; *(LAS v4u*)(KL + (lane >> 2) * 64 + (lane & 3) * 16 + 8) = k1; }
        float Bf[16], Bb[16], endf, endb;
        gla_scan(hl, w4, lane, gw, Z, row0, Bf, Bb, endf, endb);
        float kf[16], kb[16];
#pragma unroll
        for (int i = 0; i < 16; ++i) { const float kk = bf1(KL[i * 64 + lane]); kf[i] = kk * __expf(endf - Bf[i]); kb[i] = kk * __expf(endb - Bb[i]); }
#pragma unroll
        for (int q = 0; q < 2; ++q) {
            *(LAS v4u*)(hl + GL_IMG + 0 * GL_IMGB + lane * GL_PITCH + (t0 + 8 * q) * 2) = (v4u){pk2(kf[8 * q], kf[8 * q + 1]), pk2(kf[8 * q + 2], kf[8 * q + 3]), pk2(kf[8 * q + 4], kf[8 * q + 5]), pk2(kf[8 * q + 6], kf[8 * q + 7])};
            *(LAS v4u*)(hl + GL_IMG + 1 * GL_IMGB + lane * GL_PITCH + (t0 + 8 * q) * 2) = (v4u){pk2(kb[8 * q], kb[8 * q + 1]), pk2(kb[8 * q + 2], kb[8 * q + 3]), pk2(kb[8 * q + 4], kb[8 * q + 5]), pk2(kb[8 * q + 6], kb[8 * q + 7])};
        }
        const int seq0 = (b * 4 + h) * 2;
        if (w4 == 0) { DEC[((size_t)(seq0 + 0) * NCHUNK + chunk_pos(tc, 0)) * 64 + lane] = __expf(endf); DEC[((size_t)(seq0 + 1) * NCHUNK + chunk_pos(tc, 1)) * 64 + lane] = __expf(endb); }
        __syncthreads();
        const int dir = w4 >> 1, nth = w4 & 1;
        const LAS unsigned char* img = hl + GL_IMG + dir * GL_IMGB;
        bf16x8_t afr[4][2];
#pragma unroll
        for (int mt = 0; mt < 4; ++mt)
#pragma unroll
            for (int kt = 0; kt < 2; ++kt) afr[mt][kt] = *(const LAS bf16x8_t*)(img + (32 * (mt >> 1) + 8 * (l16 >> 2) + 4 * (mt & 1) + (l16 & 3)) * GL_PITCH + (32 * kt + 8 * g) * 2);
        bf16* slot = SST + ((size_t)(seq0 + dir) * NCHUNK + chunk_pos(tc, dir)) * 8192;
#pragma unroll
        for (int n4 = 0; n4 < 4; ++n4) {
            const int nt = 4 * nth + n4;
            const bf16* vp = VT + (size_t)(h * 128 + 16 * nt + l16) * R + row0 + 8 * g;
            const bf16x8_t b0 = *(const bf16x8_t*)vp, b1 = *(const bf16x8_t*)(vp + 32);
#pragma unroll
            for (int mp = 0; mp < 2; ++mp) {
                f32x4 a0 = (f32x4){0.f, 0.f, 0.f, 0.f}, a1 = (f32x4){0.f, 0.f, 0.f, 0.f};
                a0 = __builtin_amdgcn_mfma_f32_16x16x32_bf16(afr[2 * mp][0], b0, a0, 0, 0, 0); a0 = __builtin_amdgcn_mfma_f32_16x16x32_bf16(afr[2 * mp][1], b1, a0, 0, 0, 0);
                a1 = __builtin_amdgcn_mfma_f32_16x16x32_bf16(afr[2 * mp + 1][0], b0, a1, 0, 0, 0); a1 = __builtin_amdgcn_mfma_f32_16x16x32_bf16(afr[2 * mp + 1][1], b1, a1, 0, 0, 0);
                *(v4u*)(slot + (16 * nt + l16) * 64 + 32 * mp + 8 * g) = (v4u){pk2(a0[0], a0[1]), pk2(a0[2], a0[3]), pk2(a1[0], a1[1]), pk2(a1[2], a1[3])};
            }
        }
        __syncthreads();
    }
}
__device__ __forceinline__ void gla_b_phase(const Frame& F, bool dry) {
    CArgsP a = kargs(); unsigned char* const ws = a->ws; const bool wr = !dry || a->pad == 12345;
    bf16* SST = (bf16*)(ws + WS_H); const float* DEC = (const float*)(ws + WS_DEC);
    const int gtid = F.vcu * NT + F.tid, GT = F.G * NT;
    for (int id = gtid; id < 64 * 2048; id += GT) {
        const int seq = id >> 11, e = (id & 2047) * 4, k4 = e & 63;
        float s0 = 0.f, s1 = 0.f, s2 = 0.f, s3 = 0.f;
        bf16* p = SST + (size_t)seq * NCHUNK * 8192 + e; const float* dp = DEC + (size_t)seq * NCHUNK * 64 + k4;
        for (int c0 = 0; c0 < NCHUNK; c0 += 12) {
            v2u t[12]; f32x4 d[12];
#pragma unroll
            for (int q = 0; q < 12; ++q) { t[q] = *(const v2u*)(p + (size_t)(c0 + q) * 8192); d[q] = *(const f32x4*)(dp + (c0 + q) * 64); }
#pragma unroll
            for (int q = 0; q < 12; ++q) {
                if (wr) *(v2u*)(p + (size_t)(c0 + q) * 8192) = (v2u){pk2(s0, s1), pk2(s2, s3)};
                s0 = d[q][0] * s0 + bflo(t[q].x); s1 = d[q][1] * s1 + bfhi(t[q].x); s2 = d[q][2] * s2 + bflo(t[q].y); s3 = d[q][3] * s3 + bfhi(t[q].y);
            }
        }
    }
}
__device__ __forceinline__ void gla_c_phase(const Frame& F, int layer, bool dry) {
    CArgsP a = kargs(); unsigned char* const ws = a->ws; const bool wr = !dry || a->pad == 12345;
    bf16* PA = (bf16*)(ws + WS_PA); const bf16* VT = (const bf16*)(ws + WS_VT);
    const float* Z = (const float*)(ws + WS_Z); const bf16* SST = (const bf16*)(ws + WS_H);
    const int lane = F.lane, l16 = lane & 15, g = lane >> 4, hw = F.wave >> 2, w4 = F.wave & 3, t0 = 16 * w4;
    LAS unsigned char* hl = F.lds + hw * GL_HALF;
    const int h = F.vcu & 3;
    GlaW gw; gla_load_w(gw, a, layer, h, lane);
    for (int pp = F.vcu >> 2; pp < BATCH * NCHUNK / 2; pp += F.G >> 2) {
        const int unit = 2 * pp + hw;
        const int b = unit / NCHUNK, tc = unit % NCHUNK, row0 = chunk_row0(b, tc);
        {
            LAS bf16* QL = (LAS bf16*)(hl + GL_QK) + t0 * 64; LAS bf16* KL = QL + 4096;
            { const bf16* qp = PA + (size_t)(row0 + t0 + (lane >> 2)) * PA_LD + PA_Q + h * 64 + (lane & 3) * 16; const bf16* kp = qp + (PA_K - PA_Q);
              const v4u q0 = *(const v4u*)qp, q1 = *(const v4u*)(qp + 8), k0 = *(const v4u*)kp, k1 = *(const v4u*)(kp + 8);
              const int o = (lane >> 2) * 64 + (lane & 3) * 16;
              *(LAS v4u*)(QL + o) = q0; *(LAS v4u*)(QL + o + 8) = q1; *(LAS v4u*)(KL + o) = k0; *(LAS v4u*)(KL + o + 8) = k1; }
            float Bf[16], Bb[16], endf, endb;
            gla_scan(hl, w4, lane, gw, Z, row0, Bf, Bb, endf, endb);
#pragma unroll
            for (int i = 0; i < 16; ++i) {
                const float qq = bf1(QL[i * 64 + lane]), kk = bf1(KL[i * 64 + lane]);
                const float ef = __expf(Bf[i]), eb = __expf(Bb[i]);
                LAS bf16* ip = (LAS bf16*)(hl + GL_IMG + (t0 + i) * GL_PITCH) + lane;
                ip[0] = (bf16)f2bf(qq * ef); ip[GL_IMGB / 2] = (bf16)f2bf(kk * __builtin_amdgcn_rcpf(ef)); ip[GL_IMGB] = (bf16)f2bf(qq * eb); ip[3 * GL_IMGB / 2] = (bf16)f2bf(kk * __builtin_amdgcn_rcpf(eb));
            }
        }
        __syncthreads();
        f32x4 O[8];
#pragma unroll
        for (int mt = 0; mt < 8; ++mt) O[mt] = (f32x4){0.f, 0.f, 0.f, 0.f};
        const int tq = 16 * w4 + l16;
#pragma unroll
        for (int dir = 0; dir < 2; ++dir) {
            const LAS unsigned char* Qimg = hl + GL_IMG + (2 * dir) * GL_IMGB; const LAS unsigned char* Kimg = Qimg + GL_IMGB;
            bf16x8_t qf[2];
#pragma unroll
            for (int kt = 0; kt < 2; ++kt) qf[kt] = *(const LAS bf16x8_t*)(Qimg + tq * GL_PITCH + (32 * kt + 8 * g) * 2);
            f32x4 P[4];
#pragma unroll
            for (int mt = 0; mt < 4; ++mt) {
                P[mt] = (f32x4){0.f, 0.f, 0.f, 0.f};
                const int trow = 32 * (mt >> 1) + 8 * (l16 >> 2) + 4 * (mt & 1) + (l16 & 3);
#pragma unroll
                for (int kt = 0; kt < 2; ++kt) { const bf16x8_t kf = *(const LAS bf16x8_t*)(Kimg + trow * GL_PITCH + (32 * kt + 8 * g) * 2); P[mt] = __builtin_amdgcn_mfma_f32_16x16x32_bf16(kf, qf[kt], P[mt], 0, 0, 0); }
#pragma unroll
                for (int rg = 0; rg < 4; ++rg) { const int tp = 32 * (mt >> 1) + 8 * g + 4 * (mt & 1) + rg; const bool valid = dir == 0 ? (tp <= tq) : (tp >= tq); P[mt][rg] = valid ? P[mt][rg] : 0.f; }
            }
            bf16x8_t pa[2];
#pragma unroll
            for (int k2 = 0; k2 < 2; ++k2) { const v4u w = (v4u){pk2(P[2 * k2][0], P[2 * k2][1]), pk2(P[2 * k2][2], P[2 * k2][3]), pk2(P[2 * k2 + 1][0], P[2 * k2 + 1][1]), pk2(P[2 * k2 + 1][2], P[2 * k2 + 1][3])}; pa[k2] = __builtin_bit_cast(bf16x8_t, w); }
            const bf16* slot = SST + ((size_t)((b * 4 + h) * 2 + dir) * NCHUNK + chunk_pos(tc, dir)) * 8192;
#pragma unroll
            for (int mt = 0; mt < 8; ++mt) {
                const int v = 32 * (mt >> 1) + 8 * (l16 >> 2) + 4 * (mt & 1) + (l16 & 3);
                const bf16* vp = VT + (size_t)(h * 128 + v) * R + row0 + 8 * g;
#pragma unroll
                for (int k2 = 0; k2 < 2; ++k2) { const bf16x8_t vf = *(const bf16x8_t*)(vp + 32 * k2); O[mt] = __builtin_amdgcn_mfma_f32_16x16x32_bf16(vf, pa[k2], O[mt], 0, 0, 0); }
#pragma unroll
                for (int kt = 0; kt < 2; ++kt) { const bf16x8_t sf = *(const bf16x8_t*)(slot + v * 64 + 32 * kt + 8 * g); O[mt] = __builtin_amdgcn_mfma_f32_16x16x32_bf16(sf, qf[kt], O[mt], 0, 0, 0); }
            }
        }
        float ss = 0.f;
#pragma unroll
        for (int mt = 0; mt < 8; ++mt) ss += (O[mt][0] * O[mt][0] + O[mt][1] * O[mt][1]) + (O[mt][2] * O[mt][2] + O[mt][3] * O[mt][3]);
        ss += shx(ss, 16, lane); ss += shx(ss, 32, lane);
        const float rs = rsqrtf(ss * (1.f / 128.f) + EPS);
        bf16* rp0 = PA + (size_t)(row0 + tq) * PA_LD + PA_R + h * 128 + 8 * g;
#pragma unroll
        for (int mp = 0; mp < 4; ++mp) {
            const v4u rr = *(const v4u*)(rp0 + 32 * mp);
            const float* gp = a->in[I_GGLA] + layer * 128 + 32 * mp + 8 * g; const f32x4 ga = *(const f32x4*)gp, gb = *(const f32x4*)(gp + 4);
            const float r0 = bflo(rr.x), r1 = bfhi(rr.x), r2 = bflo(rr.y), r3 = bfhi(rr.y), r4 = bflo(rr.z), r5 = bfhi(rr.z), r6 = bflo(rr.w), r7 = bfhi(rr.w);
            const f32x4 oa = O[2 * mp], ob = O[2 * mp + 1];
            const float y0 = oa[0] * rs * ga[0] * (r0 * sigmoidf_(r0)), y1 = oa[1] * rs * ga[1] * (r1 * sigmoidf_(r1)), y2 = oa[2] * rs * ga[2] * (r2 * sigmoidf_(r2)), y3 = oa[3] * rs * ga[3] * (r3 * sigmoidf_(r3));
            const float y4 = ob[0] * rs * gb[0] * (r4 * sigmoidf_(r4)), y5 = ob[1] * rs * gb[1] * (r5 * sigmoidf_(r5)), y6 = ob[2] * rs * gb[2] * (r6 * sigmoidf_(r6)), y7 = ob[3] * rs * gb[3] * (r7 * sigmoidf_(r7));
            if (wr) *(v4u*)(rp0 + 32 * mp) = (v4u){pk2(y0, y1), pk2(y2, y3), pk2(y4, y5), pk2(y6, y7)};
        }
        __syncthreads();
    }
}

__device__ __forceinline__ void na_unit4(bf16* PA, const bf16* NVT, const float* rpb_l, LAS float* lb, int b, int hd, bool lat, int qr0, int nt, int lane, bool wr) {
    const int l16 = lane & 15, g = lane >> 4;
    const int latbase = NCTX + b * SEQ, ctxbase = b * CTXL;
    bf16* qp[4]; bf16x8_t qf[4][2];
#pragma unroll
    for (int j = 0; j < 4; ++j) {
        const int row = lat ? latbase + (qr0 + j) * 64 + 16 * nt + l16 : ctxbase + 64 * nt + 16 * j + l16;
        qp[j] = PA + (size_t)row * PA_LD + PA_NQ + hd * 64;
        qf[j][0] = *(const bf16x8_t*)(qp[j] + 8 * g); qf[j][1] = *(const bf16x8_t*)(qp[j] + 32 + 8 * g);
    }
    const int qc = 16 * nt + l16, c0 = min(max(qc - 8, 0), 48), R0 = min(max(qr0 - 4, 0), 120);
    if (lat) {
#pragma unroll
        for (int i = 0; i < 8; ++i) { const int idx = lane + 64 * i; if (idx < 465) lb[idx] = rpb_l[hd * 465 + idx]; }
        LDS_WAIT();
    }
    const bf16* kbase = PA + PA_NK + hd * 64 + 8 * g;
    const bf16* vbase = NVT + (size_t)(hd * 64 + l16) * R + 8 * g;
    float mx[4] = {-3.0e38f, -3.0e38f, -3.0e38f, -3.0e38f};
    const int nrows = lat ? ((qr0 == 0 || qr0 == 124) ? 8 : 11) : 0, cs = (nt == 0) ? 0 : (nt == 1 ? 8 : (nt == 2 ? 24 : 32));
    const int nwin = nrows, nslot = nwin + 8;
#define NA_SLOT(si, jmask, krow, pr, base0, win) do { const int s_ = min((si), nslot - 1); win = s_ < nwin; pr = 0; \
        if (win) { krow = R0 + s_; jmask = 0u; \
            _Pragma("unroll") for (int j_ = 0; j_ < 4; ++j_) { const int r0j = min(max(qr0 + j_ - 4, 0), 120); if (krow >= r0j && krow < r0j + 8) jmask |= 1u << j_; } \
            base0 = latbase + krow * 64 + cs; } else { jmask = 15u; krow = 0; base0 = ctxbase + (s_ - nwin) * 32; } } while (0)
#define NA_LDK(dst, base0) do { _Pragma("unroll") for (int t_ = 0; t_ < 2; ++t_) { const bf16* kp_ = kbase + (size_t)((base0) + 8 * (l16 >> 2) + 4 * t_ + (l16 & 3)) * PA_LD; dst[t_][0] = *(const bf16x8_t*)kp_; dst[t_][1] = *(const bf16x8_t*)(kp_ + 32); } } while (0)
#define NA_LDV(dst, base0) do { _Pragma("unroll") for (int mt_ = 0; mt_ < 4; ++mt_) dst[mt_] = *(const bf16x8_t*)(vbase + (size_t)(16 * mt_) * R + (base0)); } while (0)
#pragma unroll 1
    for (int s0 = 0; s0 < nslot; s0 += 4) {
        bf16x8_t kc[4][2][2]; unsigned jm[4];
#pragma unroll
        for (int q = 0; q < 4; ++q) { int krow, pr, base0; bool win; NA_SLOT(s0 + q, jm[q], krow, pr, base0, win); if (s0 + q >= nslot) jm[q] = 0u; NA_LDK(kc[q], base0); }
#pragma unroll
        for (int q = 0; q < 4; ++q)
#pragma unroll
            for (int t = 0; t < 2; ++t)
#pragma unroll
                for (int j = 0; j < 4; ++j) {
                    f32x4 S = (f32x4){0.f, 0.f, 0.f, 0.f};
                    S = __builtin_amdgcn_mfma_f32_16x16x32_bf16(kc[q][t][0], qf[j][0], S, 0, 0, 0);
                    S = __builtin_amdgcn_mfma_f32_16x16x32_bf16(kc[q][t][1], qf[j][1], S, 0, 0, 0);
                    mx[j] = fmaxf(mx[j], fmaxf(fmaxf(S[0], S[1]), fmaxf(S[2], S[3])));
                }
    }
#pragma unroll
    for (int j = 0; j < 4; ++j) { mx[j] = fmaxf(mx[j], shx(mx[j], 16, lane)); mx[j] = fmaxf(mx[j], shx(mx[j], 32, lane)); }
    float ls[4] = {0.f, 0.f, 0.f, 0.f};
    f32x4 O[4][4];
#pragma unroll
    for (int j = 0; j < 4; ++j)
#pragma unroll
        for (int mt = 0; mt < 4; ++mt) O[j][mt] = (f32x4){0.f, 0.f, 0.f, 0.f};
#pragma unroll 1
    for (int s0 = 0; s0 < nslot; s0 += 2) {
        bf16x8_t kf[2][2][2], vf[2][4]; unsigned jm[2]; int krw[2], prr[2]; bool wn[2];
#pragma unroll
        for (int q = 0; q < 2; ++q) { int base0; NA_SLOT(s0 + q, jm[q], krw[q], prr[q], base0, wn[q]); if (s0 + q >= nslot) jm[q] = 0u; NA_LDK(kf[q], base0); NA_LDV(vf[q], base0); }
#pragma unroll
        for (int q = 0; q < 2; ++q) {
            const bool win = wn[q]; const int pr = prr[q], krow = krw[q];
            bool cv[2][4]; int co[2][4];
#pragma unroll
            for (int t = 0; t < 2; ++t)
#pragma unroll
                for (int rg = 0; rg < 4; ++rg) { const int kcol = cs + 8 * g + 4 * t + rg; cv[t][rg] = !win || ((kcol >= c0) && (kcol <= c0 + 15)); co[t][rg] = min(max(kcol - qc + 15, 0), 30); }
#pragma unroll
            for (int j = 0; j < 4; ++j) {
                const bool rv = (jm[q] >> j) & 1u;
                f32x4 S[2];
#pragma unroll
                for (int t = 0; t < 2; ++t) { S[t] = (f32x4){0.f, 0.f, 0.f, 0.f};
                    S[t] = __builtin_amdgcn_mfma_f32_16x16x32_bf16(kf[q][t][0], qf[j][0], S[t], 0, 0, 0);
                    S[t] = __builtin_amdgcn_mfma_f32_16x16x32_bf16(kf[q][t][1], qf[j][1], S[t], 0, 0, 0); }
                const LAS float* bp = lb + (win ? min(max(krow - (qr0 + j) + 7, 0), 14) * 31 : 0);
                float psum = 0.f;
#pragma unroll
                for (int t = 0; t < 2; ++t)
#pragma unroll
                    for (int rg = 0; rg < 4; ++rg) { const float bias = win ? bp[co[t][rg]] : 0.f; const float p = (cv[t][rg] && rv) ? __expf(S[t][rg] + bias - mx[j]) : 0.f; S[t][rg] = p; psum += p; }
                ls[j] += psum;
                const bf16x8_t pa = __builtin_bit_cast(bf16x8_t, (v4u){pk2(S[0][0], S[0][1]), pk2(S[0][2], S[0][3]), pk2(S[1][0], S[1][1]), pk2(S[1][2], S[1][3])});
#pragma unroll
                for (int mt = 0; mt < 4; ++mt) O[j][mt] = __builtin_amdgcn_mfma_f32_16x16x32_bf16(vf[q][mt], pa, O[j][mt], 0, 0, 0);
            }
        }
    }
#undef NA_SLOT
#undef NA_LDK
#undef NA_LDV
#pragma unroll
    for (int j = 0; j < 4; ++j) {
        float l = ls[j]; l += shx(l, 16, lane); l += shx(l, 32, lane);
        const float inv = 1.f / l;
#pragma unroll
        for (int mt = 0; mt < 4; ++mt) if (wr) *(v2u*)(qp[j] + 16 * mt + 4 * g) = (v2u){pk2(O[j][mt][0] * inv, O[j][mt][1] * inv), pk2(O[j][mt][2] * inv, O[j][mt][3] * inv)};
    }
}
__device__ __forceinline__ void na_phase(const Frame& F, int layer, bool dry, bool skip_ctx) {
    CArgsP a = kargs(); unsigned char* const ws = a->ws; const bool wr = !dry || a->pad == 12345;
    bf16* PA = (bf16*)(ws + WS_PA); const bf16* NVT = (const bf16*)(ws + WS_NVT);
    const float* rpb_l = a->in[I_RPB] + (size_t)layer * 8 * 465;
    const int gw = F.vcu * NWAVES + F.wave, NGW = F.G * NWAVES;
    LAS float* lb = (LAS float*)(F.lds + F.wave * 2048);
    for (int u = gw; u < BATCH * 8 * 32 * 4 + (skip_ctx ? 0 : BATCH * 8 * 4); u += NGW) {
        if (u < BATCH * 8 * 32 * 4) { const int nt = u & 3, qg = (u >> 2) & 31, hd = (u >> 7) & 7, b = u >> 10; na_unit4(PA, NVT, rpb_l, lb, b, hd, true, 4 * qg, nt, F.lane, wr); }
        else { const int v = u - BATCH * 8 * 32 * 4; const int nt = v & 3, hd = (v >> 2) & 7, b = v >> 5; na_unit4(PA, NVT, rpb_l, lb, b, hd, false, 0, nt, F.lane, wr); }
    }
}

__device__ __forceinline__ float pack_key(float v, int idx) { unsigned t = __builtin_bit_cast(unsigned, v) & ~127u; asm("" : "+v"(t)); return __builtin_bit_cast(float, t | (unsigned)idx); }
__device__ __forceinline__ void topk_phase(const Frame& F, int rbeg) {
    CArgsP a = kargs(); unsigned char* const ws = a->ws;
    const int gtid = F.vcu * NT + F.tid, GT = F.G * NT;
    const bf16* SC = (const bf16*)(ws + WS_SC);
    int* EI = (int*)(ws + WS_EI); float* EG = (float*)(ws + WS_EG);
    LAS unsigned* myl = (LAS unsigned*)F.lds + F.tid * 9;
    for (int id = rbeg * 8 + gtid; id < R * 8; id += GT) {
        const int r = id >> 3, hd = id & 7;
        const v4u* sp = (const v4u*)(SC + (size_t)r * 2048 + hd * 256);
        float t0[16], t1[16];
#pragma unroll
        for (int blk = 0; blk < 8; ++blk) {
            float n0[16], n1[16];
#pragma unroll
            for (int q = 0; q < 2; ++q) { const v4u va = sp[blk * 2 + q], vb = sp[16 + blk * 2 + q];
                const unsigned wa[4] = {va.x, va.y, va.z, va.w}, wb[4] = {vb.x, vb.y, vb.z, vb.w};
#pragma unroll
                for (int e = 0; e < 4; ++e) { const int i0 = blk * 16 + 8 * q + 2 * e;
                    n0[8 * q + 2 * e] = pack_key(bflo(wa[e]), i0); n0[8 * q + 2 * e + 1] = pack_key(bfhi(wa[e]), i0 + 1);
                    n1[8 * q + 2 * e] = pack_key(bflo(wb[e]), i0); n1[8 * q + 2 * e + 1] = pack_key(bfhi(wb[e]), i0 + 1); } }
#pragma unroll
            for (int k = 2; k <= 16; k <<= 1)
#pragma unroll
                for (int j = k >> 1; j > 0; j >>= 1)
#pragma unroll
                    for (int i = 0; i < 16; ++i) { const int l = i ^ j; if (l > i) { const bool desc = (i & k) == 0;
                        const float a0 = n0[i], b0 = n0[l], a1 = n1[i], b1 = n1[l];
                        n0[i] = desc ? fmaxf(a0, b0) : fminf(a0, b0); n0[l] = desc ? fminf(a0, b0) : fmaxf(a0, b0);
                        n1[i] = desc ? fmaxf(a1, b1) : fminf(a1, b1); n1[l] = desc ? fminf(a1, b1) : fmaxf(a1, b1); } }
            if (blk == 0) {
#pragma unroll
                for (int i = 0; i < 16; ++i) { t0[i] = n0[i]; t1[i] = n1[i]; }
            } else {
#pragma unroll
                for (int i = 0; i < 16; ++i) { t0[i] = fmaxf(t0[i], n0[15 - i]); t1[i] = fmaxf(t1[i], n1[15 - i]); }
#pragma unroll
                for (int j = 8; j > 0; j >>= 1)
#pragma unroll
                    for (int i = 0; i < 16; ++i) { const int l = i ^ j; if (l > i) { const float a0 = t0[i], b0 = t0[l], a1 = t1[i], b1 = t1[l];
                        t0[i] = fmaxf(a0, b0); t0[l] = fminf(a0, b0); t1[i] = fmaxf(a1, b1); t1[l] = fminf(a1, b1); } }
            }
        }
        float best[16];
#pragma unroll
        for (int j = 0; j < 16; ++j) best[j] = -3.0e38f;
#pragma unroll
        for (int ia = 0; ia < 16; ++ia)
#pragma unroll
            for (int ib = 0; ib < 16; ++ib)
                if ((ia + 1) * (ib + 1) <= 16) {
                    float x = __builtin_bit_cast(float, (__builtin_bit_cast(unsigned, t0[ia] + t1[ib]) & ~255u) | (unsigned)(ia * 16 + ib));
#pragma unroll
                    for (int j = 0; j < 16; ++j) { const float tb = fmaxf(best[j], x); x = fminf(best[j], x); best[j] = tb; }
                }
        {
            unsigned w0[4], w1[4];
#pragma unroll
            for (int q = 0; q < 4; ++q) {
                w0[q] = (__builtin_bit_cast(unsigned, t0[4 * q]) & 127u) | ((__builtin_bit_cast(unsigned, t0[4 * q + 1]) & 127u) << 8) | ((__builtin_bit_cast(unsigned, t0[4 * q + 2]) & 127u) << 16) | ((__builtin_bit_cast(unsigned, t0[4 * q + 3]) & 127u) << 24);
                w1[q] = (__builtin_bit_cast(unsigned, t1[4 * q]) & 127u) | ((__builtin_bit_cast(unsigned, t1[4 * q + 1]) & 127u) << 8) | ((__builtin_bit_cast(unsigned, t1[4 * q + 2]) & 127u) << 16) | ((__builtin_bit_cast(unsigned, t1[4 * q + 3]) & 127u) << 24);
            }
#pragma unroll
            for (int q = 0; q < 4; ++q) { myl[q] = w0[q]; myl[4 + q] = w1[q]; }
            LDS_WAIT();
        }
        int eid[16];
#pragma unroll
        for (int j = 0; j < 16; ++j) { const unsigned code = __builtin_bit_cast(unsigned, best[j]) & 255u; const LAS unsigned char* mb = (const LAS unsigned char*)myl;
            eid[j] = (int)mb[code >> 4] * 128 + (int)mb[16 + (code & 15u)]; }
        LDS_WAIT();
        float sum = 0.f; const float bmax = best[0];
#pragma unroll
        for (int j = 0; j < 16; ++j) { best[j] = __expf(best[j] - bmax); sum += best[j]; }
        const float inv = 1.f / sum;
        v4i* ei = (v4i*)(EI + (size_t)r * 128 + hd * 16); f32x4* eg = (f32x4*)(EG + (size_t)r * 128 + hd * 16);
#pragma unroll
        for (int j = 0; j < 4; ++j) { ei[j] = (v4i){eid[4 * j], eid[4 * j + 1], eid[4 * j + 2], eid[4 * j + 3]}; eg[j] = (f32x4){best[4 * j] * inv, best[4 * j + 1] * inv, best[4 * j + 2] * inv, best[4 * j + 3] * inv}; }
    }
}

__device__ __forceinline__ float gelu_tanh(float x) { const float u = 0.7978845608f * (x + 0.044715f * x * x * x); return x * __builtin_amdgcn_rcpf(1.f + __expf(-2.f * u)); }
typedef float f32x2_t __attribute__((ext_vector_type(2)));
__device__ __forceinline__ void peer1_phase(const Frame& F, int rbeg) {
    CArgsP a = kargs(); unsigned char* const ws = a->ws;
    const unsigned char* EU8 = ws + WS_EU; const unsigned char* H8 = ws + WS_H8;
    const int* EI = (const int*)(ws + WS_EI); bf16* PART = (bf16*)(ws + WS_PART);
    const int per = F.G >> 3, s = F.vcu / per, rank = F.vcu % per, stride = per * NWAVES;
    const int lane = F.lane, m = lane & 15, g = lane >> 4, row8 = lane >> 3, part = lane & 7;
    const unsigned char* tab = EU8 + (size_t)s * NEXP * 128 + 16 * part;
    LAS unsigned char* wl = F.lds + F.wave * 5632;
    LAS int* idl = (LAS int*)(wl + 4608);
    const int wofs = row8 * 144 + part * 16, rofs = m * 144 + 16 * g;
    int r = rbeg + rank * NWAVES + F.wave;
    v2u idp[2];
#pragma unroll
    for (int u = 0; u < 2; ++u) idp[u] = *(const v2u*)(EI + (size_t)min(r + u * stride, R - 1) * 128 + 2 * lane);
    for (; r < R; r += 2 * stride) {
        v4u w[2][16]; v4u x[2][2];
#pragma unroll
        for (int u = 0; u < 2; ++u) *(LAS v2u*)(idl + u * 128 + 2 * lane) = idp[u];
        LDS_WAIT();
#pragma unroll
        for (int u = 0; u < 2; ++u) {
            const int ru = min(r + u * stride, R - 1);
            const unsigned char* xp = H8 + (size_t)ru * D + 128 * s + 16 * g;
            x[u][0] = *(const v4u*)xp; x[u][1] = *(const v4u*)(xp + 64);
#pragma unroll
            for (int j = 0; j < 16; ++j) w[u][j] = *(const v4u*)(tab + (size_t)idl[u * 128 + 8 * j + row8] * 128);
        }
        const int rn = r + 2 * stride;
#pragma unroll
        for (int u = 0; u < 2; ++u) idp[u] = *(const v2u*)(EI + (size_t)min(rn + u * stride, R - 1) * 128 + 2 * lane);
#pragma unroll
        for (int u = 0; u < 2; ++u) {
            f32x4 sel = (f32x4){0.f, 0.f, 0.f, 0.f};
#pragma unroll
            for (int T = 0; T < 8; ++T) {
                LAS unsigned char* buf = wl + (T & 1) * 2304;
                *(LAS v4u*)(buf + wofs) = w[u][2 * T]; *(LAS v4u*)(buf + 8 * 144 + wofs) = w[u][2 * T + 1];
                const v4u a0 = *(const LAS v4u*)(buf + rofs), a1 = *(const LAS v4u*)(buf + rofs + 64);
                f32x4 acc = (f32x4){0.f, 0.f, 0.f, 0.f};
                acc = __builtin_amdgcn_mfma_f32_16x16x32_fp8_fp8((long)(((unsigned long long)a0.y << 32) | a0.x), (long)(((unsigned long long)x[u][0].y << 32) | x[u][0].x), acc, 0, 0, 0);
                acc = __builtin_amdgcn_mfma_f32_16x16x32_fp8_fp8((long)(((unsigned long long)a0.w << 32) | a0.z), (long)(((unsigned long long)x[u][0].w << 32) | x[u][0].z), acc, 0, 0, 0);
                acc = __builtin_amdgcn_mfma_f32_16x16x32_fp8_fp8((long)(((unsigned long long)a1.y << 32) | a1.x), (long)(((unsigned long long)x[u][1].y << 32) | x[u][1].x), acc, 0, 0, 0);
                acc = __builtin_amdgcn_mfma_f32_16x16x32_fp8_fp8((long)(((unsigned long long)a1.w << 32) | a1.z), (long)(((unsigned long long)x[u][1].w << 32) | x[u][1].z), acc, 0, 0, 0);
                sel = (m == T) ? acc : sel;
            }
            const int ru = r + u * stride;
            if (m < 8 && ru < R) *(v2u*)(PART + ((size_t)s * R + ru) * 128 + 16 * m + 4 * g) = (v2u){pk2(sel[0], sel[1]), pk2(sel[2], sel[3])};
        }
    }
}
__device__ __forceinline__ void peer_act_phase(const Frame& F, int rbeg) {
    CArgsP a = kargs(); unsigned char* const ws = a->ws;
    const int gtid = F.vcu * NT + F.tid, GT = F.G * NT;
    const bf16* PART = (const bf16*)(ws + WS_PART); const int* EI = (const int*)(ws + WS_EI); const float* EG = (const float*)(ws + WS_EG);
    const float* SU = (const float*)(ws + WS_SU); const float* SV = (const float*)(ws + WS_SV); const float* SX = (const float*)(ws + WS_SX);
    float* ACT = (float*)(ws + WS_ACT);
    for (int i0 = rbeg * 32 + gtid; i0 < R * 32; i0 += 2 * GT) {
        const int i1 = i0 + GT < R * 32 ? i0 + GT : i0;
        v2u pw[2][8]; v4i id[2]; f32x4 gt[2]; float sx[2];
#pragma unroll
        for (int u = 0; u < 2; ++u) { const int i = u ? i1 : i0;
#pragma unroll
            for (int q = 0; q < 8; ++q) pw[u][q] = *(const v2u*)(PART + (size_t)q * R * 128 + (size_t)i * 4);
            id[u] = *(const v4i*)(EI + (size_t)i * 4); gt[u] = *(const f32x4*)(EG + (size_t)i * 4); sx[u] = SX[i >> 5]; }
        float su[2][4], sv[2][4];
#pragma unroll
        for (int u = 0; u < 2; ++u)
#pragma unroll
            for (int k = 0; k < 4; ++k) { su[u][k] = SU[id[u][k]]; sv[u][k] = SV[id[u][k]]; }
#pragma unroll
        for (int u = 0; u < 2; ++u) {
            f32x4 sum = (f32x4){0.f, 0.f, 0.f, 0.f};
#pragma unroll
            for (int q = 0; q < 8; ++q) sum += (f32x4){bflo(pw[u][q].x), bfhi(pw[u][q].x), bflo(pw[u][q].y), bfhi(pw[u][q].y)};
            f32x4 o;
#pragma unroll
            for (int k = 0; k < 4; ++k) o[k] = gelu_tanh(sum[k] * sx[u] * su[u][k]) * gt[u][k] * sv[u][k];
            if (u == 0 || i0 + GT < R * 32) *(f32x4*)(ACT + (size_t)(u ? i1 : i0) * 4) = o;
        }
    }
}
__device__ __forceinline__ void peer2_phase(const Frame& F, int layer, bool dry, int rbeg) {
    CArgsP a = kargs(); unsigned char* const ws = a->ws; const bool wr = !dry || a->pad == 12345;
    const unsigned char* EV8 = ws + WS_EV; const int* EI = (const int*)(ws + WS_EI); const float* ACT = (const float*)(ws + WS_ACT);
    const float* MOD = (const float*)(ws + WS_MOD) + (size_t)layer * 9 * 6144 + 5 * D;
    const int per = F.G >> 3, s = F.vcu / per, rank = F.vcu % per, stride = per * NWAVES;
    const int lane = F.lane, part = lane & 7, e8 = lane >> 3;
    const unsigned char* tab = EV8 + (size_t)s * NEXP * 128 + 16 * part;
    const bool b5 = (lane & 32) != 0, b4 = (lane & 16) != 0, b3 = (lane & 8) != 0;
    const int dimoff = 128 * s + 16 * part + (b5 ? 8 : 0) + (b4 ? 4 : 0) + (b3 ? 2 : 0);
    int r = rbeg + rank * NWAVES + F.wave;
    LAS int* idl = (LAS int*)(F.lds + F.wave * 2048); LAS float* acl = (LAS float*)(idl + 256);
    v2u idp[2], acp[2];
#pragma unroll
    for (int u = 0; u < 2; ++u) { idp[u] = *(const v2u*)(EI + (size_t)min(r + u * stride, R - 1) * 128 + 2 * lane); acp[u] = *(const v2u*)(ACT + (size_t)min(r + u * stride, R - 1) * 128 + 2 * lane); }
    for (; r < R; r += 2 * stride) {
        v4u w[2][16]; f32x4 a4[2][4]; v4i id4[2][4];
#pragma unroll
        for (int u = 0; u < 2; ++u) { *(LAS v2u*)(idl + u * 128 + 2 * lane) = idp[u]; *(LAS v2u*)(acl + u * 128 + 2 * lane) = acp[u]; }
        LDS_WAIT();
#pragma unroll
        for (int u = 0; u < 2; ++u) {
#pragma unroll
            for (int q = 0; q < 4; ++q) id4[u][q] = *(const LAS v4i*)(idl + u * 128 + 16 * e8 + 4 * q);
#pragma unroll
            for (int j = 0; j < 16; ++j) w[u][j] = *(const v4u*)(tab + (size_t)id4[u][j >> 2][j & 3] * 128);
        }
        const int rn = r + 2 * stride;
#pragma unroll
        for (int u = 0; u < 2; ++u) { idp[u] = *(const v2u*)(EI + (size_t)min(rn + u * stride, R - 1) * 128 + 2 * lane); acp[u] = *(const v2u*)(ACT + (size_t)min(rn + u * stride, R - 1) * 128 + 2 * lane); }
#pragma unroll
        for (int u = 0; u < 2; ++u)
#pragma unroll
            for (int q = 0; q < 4; ++q) a4[u][q] = *(const LAS f32x4*)(acl + u * 128 + 16 * e8 + 4 * q);
#pragma unroll
        for (int u = 0; u < 2; ++u) {
            f32x2_t o[8];
#pragma unroll
            for (int k = 0; k < 8; ++k) o[k] = (f32x2_t){0.f, 0.f};
#pragma unroll
            for (int j = 0; j < 16; ++j) {
                const v4u ww = w[u][j];
                const float av = a4[u][j >> 2][j & 3]; const f32x2_t av2 = (f32x2_t){av, av};
                o[0] += av2 * __builtin_amdgcn_cvt_pk_f32_fp8((int)ww.x, false); o[1] += av2 * __builtin_amdgcn_cvt_pk_f32_fp8((int)ww.x, true);
                o[2] += av2 * __builtin_amdgcn_cvt_pk_f32_fp8((int)ww.y, false); o[3] += av2 * __builtin_amdgcn_cvt_pk_f32_fp8((int)ww.y, true);
                o[4] += av2 * __builtin_amdgcn_cvt_pk_f32_fp8((int)ww.z, false); o[5] += av2 * __builtin_amdgcn_cvt_pk_f32_fp8((int)ww.z, true);
                o[6] += av2 * __builtin_amdgcn_cvt_pk_f32_fp8((int)ww.w, false); o[7] += av2 * __builtin_amdgcn_cvt_pk_f32_fp8((int)ww.w, true);
            }
            f32x2_t v4[4], v2[2], v1;
#pragma unroll
            for (int k = 0; k < 4; ++k) { const f32x2_t snd = b5 ? o[k] : o[k + 4], kp = b5 ? o[k + 4] : o[k]; f32x2_t rc; rc.x = shx(snd.x, 32, lane); rc.y = shx(snd.y, 32, lane); v4[k] = kp + rc; }
#pragma unroll
            for (int k = 0; k < 2; ++k) { const f32x2_t snd = b4 ? v4[k] : v4[k + 2], kp = b4 ? v4[k + 2] : v4[k]; f32x2_t rc; rc.x = shx(snd.x, 16, lane); rc.y = shx(snd.y, 16, lane); v2[k] = kp + rc; }
            { const f32x2_t snd = b3 ? v2[0] : v2[1], kp = b3 ? v2[1] : v2[0]; f32x2_t rc; rc.x = shx(snd.x, 8, lane); rc.y = shx(snd.y, 8, lane); v1 = kp + rc; }
            const int ru = r + u * stride;
            if (ru < R) {
                const f32x2_t ga = *(const f32x2_t*)(MOD + row_slot(ru) * 6144 + dimoff);
                if (ru < NCTX) { float* xq = xc_row(a, ru) + dimoff; const f32x2_t xx = *(const f32x2_t*)xq; if (wr) *(f32x2_t*)xq = xx + ga * v1; }
                else { unsigned* xq = (unsigned*)(xl_row(a, ru) + dimoff); const unsigned w = *xq; const f32x2_t y = (f32x2_t){bflo(w), bfhi(w)} + ga * v1; if (wr) *xq = pk2(y.x, y.y); }
            }
        }
    }
}

__device__ __forceinline__ void final_phase(const Frame& F) {
    CArgsP a = kargs(); unsigned char* const ws = a->ws;
    const int gw = F.vcu * NWAVES + F.wave, NGW = F.G * NWAVES;
    f32x4 gv[4];
#pragma unroll
    for (int j = 0; j < 4; ++j) gv[j] = *((const f32x4*)a->in[I_GF] + F.lane + 64 * j);
    for (int r = gw; r < NLAT; r += NGW) {
        const v2u* xb = (const v2u*)((const bf16*)a->out + (size_t)r * XL_LD) + F.lane;
        f32x4* xr = (f32x4*)(a->out + (size_t)r * D) + F.lane;
        f32x4 v[4]; float ss = 0.f;
#pragma unroll
        for (int j = 0; j < 4; ++j) { const v2u w = xb[64 * j]; v[j] = (f32x4){bflo(w.x), bfhi(w.x), bflo(w.y), bfhi(w.y)}; ss += (v[j][0] * v[j][0] + v[j][1] * v[j][1]) + (v[j][2] * v[j][2] + v[j][3] * v[j][3]); }
        const float rs = rsqrtf(wave_sum(ss, F.lane) * (1.f / D) + EPS);
        asm volatile("s_waitcnt vmcnt(0)" ::: "memory");
#pragma unroll
        for (int j = 0; j < 4; ++j) xr[64 * j] = v[j] * rs * gv[j];
    }
}

__global__ void __launch_bounds__(NT, 2) fwd_kernel(Args args) {
    extern __shared__ __attribute__((aligned(16))) unsigned char lds[];
    Frame F;
    F.lds = (LAS unsigned char*)lds;
    F.tid = 0; F.lane = 0; F.wave = __builtin_amdgcn_readfirstlane((int)threadIdx.x >> 6);
    F.G = gridDim.x; { const int bx = blockIdx.x; F.vcu = (F.G % 8 == 0) ? (bx % 8) * (F.G / 8) + bx / 8 : bx; }
    volatile LAS unsigned* MISC = (volatile LAS unsigned*)(F.lds + MISC_OFF);
    for (int u = threadIdx.x; u < (LDS_BYTES - LDSCTL_OFF) / 4; u += NT) ((LAS unsigned*)(F.lds + LDSCTL_OFF))[u] = 0u;
    __syncthreads();
    XcdBarrier bar; bar.bar = (unsigned*)(args.ws + WS_CTL) + CW_BAR; bar.x = 0; bar.st = nullptr;
    if (MK_SINGLE) bar = xcd_barrier_post((unsigned*)(args.ws + WS_CTL) + CW_BAR, MISC + 8);
    const int lo = args.ph_lo, hi = args.ph_hi;
#define IN(k) (lo <= (k) && (k) < hi)
#define OPQ_BX ({ int bx_ = (int)blockIdx.x; asm volatile("" : "+s"(bx_)); bx_; })
#define PF Frame Fp = F; { int t_ = threadIdx.x; asm volatile("" : "+v"(t_), "+s"(Fp.vcu), "+s"(Fp.wave), "+s"(Fp.G)); Fp.tid = t_; Fp.lane = t_ & 63; }
#define SEAM(k) do { if (MK_SINGLE && IN(k) && IN((k) + 1)) { XcdBarrier b2_ = bar; asm volatile("" : "+s"(b2_.bar));     \
        xcd_barrier(b2_); if (PROBE == 50) xcd_barrier(b2_); } } while (0)

    if (IN(0)) { if (PROBE == 99) { PF; p0_prologue(Fp); } { PF; p0_prologue(Fp); } SEAM(0); }

    for (int l = 0; l < DEPTH; ++l) {
        const int pb = 1 + l * NPL;
        const int pm0 = (l == DEPTH - 1) ? 8 : 0, rbeg = pm0 * 256;
        if (IN(pb + 0)) { { PF; norm_phase(Fp, l, 0, 0); } { PF; convert_experts(Fp, l); } if (PROBE == 30) { PF; convert_experts(Fp, l); } SEAM(pb + 0); }
        if (IN(pb + 1)) {
            CArgsP ap = kargs(); unsigned char* const ws = ap->ws; bf16* Hb = (bf16*)(ws + WS_H); bf16* PA = (bf16*)(ws + WS_PA); bf16* PG = (bf16*)(ws + WS_PG);
            pg8::Gemm g{Hb, (const bf16*)(ws + WS_WIN) + (size_t)l * NPAD * D, R, NPAD, D, D}; pg8::StaticOrder S; S.init(R, NPAD, F.G, OPQ_BX);
            EpiIn E{PA, PG, (float*)(ws + WS_Z), (const float*)(ws + WS_ROPE), (bf16*)(ws + WS_VT), (bf16*)(ws + WS_NVT)};
            for (int rep = 0; rep < (PROBE == 1 ? 2 : 1); ++rep) pg8::gemm_phase<EpiIn, pg8::StaticOrder, true, true>(F.lds, g, S, E);
            SEAM(pb + 1);
        }
        if (IN(pb + 2)) { { PF; gla_a_phase(Fp, l); } if (PROBE == 2) { PF; gla_a_phase(Fp, l); } { const int nrep = (PROBE == 20 ? 2 : 1) + (kargs()->pad != 0 ? 1 : 0); for (int rep = 0; rep < nrep; ++rep) { PF; na_phase(Fp, l, rep + 1 < nrep, l == DEPTH - 1); } } SEAM(pb + 2); }
        if (IN(pb + 3)) { if (PROBE == 3) { PF; gla_b_phase(Fp, true); } { PF; gla_b_phase(Fp, false); } SEAM(pb + 3); }
        if (IN(pb + 4)) { if (PROBE == 4) { PF; gla_c_phase(Fp, l, true); } { PF; gla_c_phase(Fp, l, false); } SEAM(pb + 4); }
        if (IN(pb + 5)) {
            CArgsP ap = kargs(); unsigned char* const ws = ap->ws; bf16* Hb = (bf16*)(ws + WS_H); bf16* PA = (bf16*)(ws + WS_PA); bf16* PG = (bf16*)(ws + WS_PG);
            pg8::ShiftOrder S; S.init(R - rbeg, D, F.G, OPQ_BX); S.pm0 = pm0;
            { pg8::Gemm g{PA + PA_R, (const bf16*)(ws + WS_WPG) + (size_t)l * D * D, R, D, D, PA_LD}; EpiMergeK E{Hb, PG}; for (int rep = 0; rep < (PROBE == 5 ? 2 : 1); ++rep) pg8::gemm_phase<EpiMergeK, pg8::ShiftOrder, true, true>(F.lds, g, S, E); }
            SEAM(pb + 5);
        }
        if (IN(pb + 6)) {
            CArgsP ap = kargs(); unsigned char* const ws = ap->ws; bf16* Hb = (bf16*)(ws + WS_H);
            pg8::Gemm g{Hb, (const bf16*)(ws + WS_WO) + (size_t)l * D * D, R, D, D, D}; pg8::ShiftOrder S; S.init(R - rbeg, D, F.G, OPQ_BX); S.pm0 = pm0;
            EpiRes E{l == 0 ? ap->in[I_CTX] : (const float*)(ws + WS_XC), ap->in[I_X], (float*)(ws + WS_XC), (bf16*)ap->out, (const float*)(ws + WS_MOD) + (size_t)l * 9 * 6144, l == 0 ? 1 : 0};
            pg8::gemm_phase<EpiRes, pg8::ShiftOrder, true, true>(F.lds, g, S, E);
            SEAM(pb + 6);
        }
        if (IN(pb + 7)) { if (PROBE == 7) { PF; norm_phase(Fp, l, 1, rbeg); } { PF; norm_phase(Fp, l, 1, rbeg); } SEAM(pb + 7); }
        if (IN(pb + 8)) {
            CArgsP ap = kargs(); unsigned char* const ws = ap->ws; bf16* Hb = (bf16*)(ws + WS_H);
            pg8::Gemm g{Hb, (const bf16*)(ws + WS_WS) + (size_t)l * 2048 * D, R, 2048, D, D}; pg8::ShiftOrder S; S.init(R - rbeg, 2048, F.G, OPQ_BX); S.pm0 = pm0;
            EpiB16 E{(bf16*)(ws + WS_SC), 2048};
            for (int rep = 0; rep < (PROBE == 8 ? 2 : 1); ++rep) pg8::gemm_phase<EpiB16, pg8::ShiftOrder, true, true>(F.lds, g, S, E);
            SEAM(pb + 8);
        }
        if (IN(pb + 9)) { if (PROBE == 9) { PF; topk_phase(Fp, rbeg); } { PF; topk_phase(Fp, rbeg); } SEAM(pb + 9); }
        if (IN(pb + 10)) { if (PROBE == 10) { PF; peer1_phase(Fp, rbeg); } { PF; peer1_phase(Fp, rbeg); } SEAM(pb + 10); }
        if (IN(pb + 11)) { if (PROBE == 11) { PF; peer_act_phase(Fp, rbeg); } { PF; peer_act_phase(Fp, rbeg); } SEAM(pb + 11); }
        if (IN(pb + 12)) { if (PROBE == 12) { PF; peer2_phase(Fp, l, true, rbeg); } { PF; peer2_phase(Fp, l, false, rbeg); } SEAM(pb + 12); }
    }
    if (IN(NPHASE - 1)) { PF; final_phase(Fp); }
#undef IN
#undef SEAM
}

extern "C" void kernel_launch(void* const* d_in, const int* in_sizes, int n_in, void* d_out, int out_size, void* d_ws, size_t ws_size, hipStream_t stream) {
    static int grid = 0;
    if (grid == 0) {
        if (n_in != 23 || in_sizes[0] != NLAT * D || out_size != NLAT * D || ws_size < WS_END) { fprintf(stderr, "kernel_launch: unexpected shapes (n_in %d, in0 %d, out %d, ws %zu); nothing launched\n", n_in, n_in > 0 ? in_sizes[0] : -1, out_size, ws_size); grid = -1; return; }
        int dev = 0, cus = 0, per_cu = 0;
        if (hipGetDevice(&dev) != hipSuccess || hipDeviceGetAttribute(&cus, hipDeviceAttributeMultiprocessorCount, dev) != hipSuccess) { grid = -1; return; }
        if (hipFuncSetAttribute((const void*)fwd_kernel, hipFuncAttributeMaxDynamicSharedMemorySize, LDS_BYTES) != hipSuccess) { fprintf(stderr, "kernel_launch: hipFuncSetAttribute failed\n"); grid = -1; return; }
        if (hipOccupancyMaxActiveBlocksPerMultiprocessor(&per_cu, (const void*)fwd_kernel, NT, LDS_BYTES) != hipSuccess || per_cu < 1) { fprintf(stderr, "kernel_launch: occupancy query says %d blocks per CU\n", per_cu); }
        (void)hipGetLastError();
        grid = cus;
    }
    if (grid < 0) return;
    if (hipMemsetAsync((char*)d_ws + WS_CTL, 0, CTL_ZERO_BYTES, stream) != hipSuccess) return;
    Args a{};
    for (int i = 0; i < 23; ++i) a.in[i] = (const float*)d_in[i];
    a.out = (float*)d_out; a.ws = (unsigned char*)d_ws; a.pad = 0;
    if (MK_SINGLE) {
        a.ph_lo = 0; a.ph_hi = NPHASE; a.li = 0;
        hipLaunchKernelGGL(fwd_kernel, dim3(grid), dim3(NT), LDS_BYTES, stream, a);
    } else {
        for (int p = 0; p < NPHASE; ++p) { a.ph_lo = p; a.ph_hi = p + 1; a.li = p; hipLaunchKernelGGL(fwd_kernel, dim3(grid), dim3(NT), LDS_BYTES, stream, a); }
    }
}
```

```cpp
#include <hip/hip_runtime.h>
#include <cstdio>
#include <cstdint>

#ifndef PROBE
#define PROBE 0
#endif
#ifndef MK_SINGLE
#define MK_SINGLE 1
#endif

namespace pg8 {
#define PG8_LAS __attribute__((address_space(3)))
typedef unsigned short bf16_t;
typedef short bf16x8 __attribute__((ext_vector_type(8)));
typedef float f32x4 __attribute__((ext_vector_type(4)));
typedef unsigned u32x4 __attribute__((ext_vector_type(4)));
constexpr int BM = 256, BK = 64, HALF = 128, HTB = HALF * BK * 2, STAGE_BYTES = 8 * HTB, NXCD = 8, WGM = 8;

__host__ __device__ __forceinline__ int lds_byte(int r, int c) { const int st = (r >> 4) * 2 + (c >> 5), rr = r & 15, cc = c & 31, ob = rr * 64 + cc * 2; return st * 1024 + (ob ^ (((ob >> 9) & 1) << 5)); }
__host__ __device__ __forceinline__ void stage_rc(int b, int& R, int& C) { const int st = b / 1024, sb = b % 1024, swz = sb ^ (((sb >> 9) & 1) << 5); R = (st >> 1) * 16 + swz / 64; C = (st & 1) * 32 + (swz % 64) / 2; }
__host__ __device__ __forceinline__ int perm32(int rho) { const int n = rho >> 4, i = rho & 15; return 8 * (i >> 2) + 4 * n + (i & 3); }

struct Unit { int pm, pn; };
struct Gemm { const bf16_t* A; const bf16_t* Bt; int M, N, K, lda; };

struct StaticOrder {
    int nM, nN, nwg, G, c;
    __host__ __device__ void init(int M, int N, int G_, int c_) { nM = M / BM; nN = N / BM; nwg = nM * nN; G = G_; c = c_; }
    __host__ __device__ bool next(int i, Unit& u) const {
        const long L = (long)i * G + c; if (L >= nwg) return false;
        int wgid = (int)L; { const int q = nwg / NXCD, r = nwg % NXCD, xcd = wgid % NXCD, off = wgid / NXCD; wgid = (xcd < r ? xcd * (q + 1) : r * (q + 1) + (xcd - r) * q) + off; }
        const int nig = WGM * nN, gid = wgid / nig, fm = gid * WGM, gsz = (nM - fm) < WGM ? (nM - fm) : WGM;
        u.pm = fm + ((wgid % nig) % gsz); u.pn = (wgid % nig) / gsz; return true;
    }
    __device__ __forceinline__ void a_ready(const Unit&) const {}
    __device__ __forceinline__ void done(const Unit&) const {}
};
struct ShiftOrder : StaticOrder { int pm0; __host__ __device__ bool next(int i, Unit& u) const { if (!StaticOrder::next(i, u)) return false; u.pm += pm0; return true; } };

__device__ __forceinline__ unsigned cvt_pk_bf16(float lo, float hi) { unsigned r; asm volatile("v_cvt_pk_bf16_f32 %0, %1, %2" : "=v"(r) : "v"(lo), "v"(hi)); return r; }

template <class Epi, class Sched, bool ALIGN_EPI = false, bool SP2 = false>
__device__ __forceinline__ void gemm_phase(PG8_LAS unsigned char* lds, const Gemm g, const Sched& S, const Epi& E) {
    int tid_ = threadIdx.x; asm volatile("" : "+v"(tid_));
    const int tid = tid_, wid = __builtin_amdgcn_readfirstlane(tid >> 6), lane = tid & 63, wr = wid >> 2, wc = wid & 3, fr = lane & 15, fq = lane >> 4;
    const int K = g.K, nt = K / BK, lda = g.lda;
    unsigned voffA[2], voffB[2];
#pragma unroll
    for (int i = 0; i < 2; ++i) { int R, C; stage_rc(tid * 16 + i * 8192, R, C); const int Rb = Epi::PERM ? ((R & ~31) + perm32(R & 31)) : R;
        voffA[i] = (unsigned)(R * lda + C) * 2u; voffB[i] = (unsigned)(Rb * K + C) * 2u; }
    const size_t kstep = (size_t)(BK * 2);
    const size_t hstepA = (size_t)HALF * lda * 2, hstepB = (size_t)HALF * K * 2;
    const size_t tstepA = 2 * hstepA, tstepB = 2 * hstepB;
    const unsigned ldsw = (unsigned)wid * 1024u;
    const int aoff = lds_byte(wr * 64 + fr, fq * 8), boff = lds_byte(wc * 32 + fr, fq * 8);
#define PG8_SA(b, h) (((b) * 2 + (h)) * HTB)
#define PG8_SB(b, h) ((4 + (b) * 2 + (h)) * HTB)
#define PG8_STAGE(bufoff, gbase, voff) do { _Pragma("unroll") for (int _i = 0; _i < 2; ++_i) \
        __builtin_amdgcn_global_load_lds((const unsigned*)((const char*)(gbase) + (voff)[_i]), (PG8_LAS unsigned*)(lds + (bufoff) + ldsw + _i * 8192), 16, 0, 0); } while (0)
#define PG8_LDA(dst, b, h) do { _Pragma("unroll") for (int m = 0; m < 4; ++m) _Pragma("unroll") for (int k = 0; k < 2; ++k) dst[m][k] = *(const PG8_LAS bf16x8*)(lds + PG8_SA(b, h) + aoff + m * 2048 + k * 1024); } while (0)
#define PG8_LDB(dst, b, h) do { _Pragma("unroll") for (int n = 0; n < 2; ++n) _Pragma("unroll") for (int k = 0; k < 2; ++k) dst[n][k] = *(const PG8_LAS bf16x8*)(lds + PG8_SB(b, h) + boff + n * 2048 + k * 1024); } while (0)
#define PG8_MMA(ai, bj, At, Bt) do { __builtin_amdgcn_s_setprio(1); _Pragma("unroll") for (int m = 0; m < 4; ++m) _Pragma("unroll") for (int n = 0; n < 2; ++n) _Pragma("unroll") for (int k = 0; k < 2; ++k) \
        acc[ai][bj][m][n] = __builtin_amdgcn_mfma_f32_16x16x32_bf16(Bt[n][k], At[m][k], acc[ai][bj][m][n], 0, 0, 0); __builtin_amdgcn_s_setprio(0); } while (0)
#define PG8_WAIT_V(n) asm volatile("s_waitcnt vmcnt(" #n ")" ::: "memory")
#define PG8_WAIT_L(n) asm volatile("s_waitcnt lgkmcnt(" #n ")" ::: "memory")
#define PG8_BAR __builtin_amdgcn_s_barrier()
#define PG8_SCHED __builtin_amdgcn_sched_barrier(0)
    Unit cur, nxt; int ui = 0;
    if (!S.next(0, cur)) return;
    f32x4 acc[2][2][4][2];
#pragma unroll
    for (int a = 0; a < 2; ++a)
#pragma unroll
        for (int b = 0; b < 2; ++b)
#pragma unroll
            for (int m = 0; m < 4; ++m)
#pragma unroll
                for (int n = 0; n < 2; ++n) acc[a][b][m][n] = (f32x4){0.f, 0.f, 0.f, 0.f};
    bf16x8 At[4][2], B0[2][2], B1[2][2];
    const char* cA = (const char*)g.A + (size_t)cur.pm * tstepA; const char* cB = (const char*)g.Bt + (size_t)cur.pn * tstepB;
    S.a_ready(cur);
    if constexpr (SP2) {
        PG8_STAGE(PG8_SB(0, 0), cB, voffB); PG8_STAGE(PG8_SB(0, 1), cB + hstepB, voffB); PG8_STAGE(PG8_SA(0, 0), cA, voffA); PG8_STAGE(PG8_SA(0, 1), cA + hstepA, voffA);
        if (wr == 1) PG8_BAR;
        PG8_WAIT_V(2); PG8_BAR;
        PG8_STAGE(PG8_SB(1, 0), cB + kstep, voffB); PG8_STAGE(PG8_SA(1, 0), cA + kstep, voffA); PG8_STAGE(PG8_SB(1, 1), cB + hstepB + kstep, voffB);
        PG8_WAIT_V(6); PG8_BAR;
    } else {
        PG8_STAGE(PG8_SB(0, 0), cB, voffB); PG8_STAGE(PG8_SA(0, 0), cA, voffA); PG8_STAGE(PG8_SB(0, 1), cB + hstepB, voffB); PG8_STAGE(PG8_SA(0, 1), cA + hstepA, voffA);
        if (wr == 1) PG8_BAR;
        PG8_WAIT_V(4); PG8_BAR;
        PG8_STAGE(PG8_SB(1, 0), cB + kstep, voffB); PG8_STAGE(PG8_SA(1, 0), cA + kstep, voffA); PG8_STAGE(PG8_SB(1, 1), cB + hstepB + kstep, voffB);
        PG8_WAIT_V(6); PG8_BAR;
    }
    for (;;) {
        const bool has_next = S.next(ui + 1, nxt);
        const char* nA = has_next ? (const char*)g.A + (size_t)nxt.pm * tstepA : cA; const char* nB = has_next ? (const char*)g.Bt + (size_t)nxt.pn * tstepB : cB;
        for (int t = 0; t < nt; t += 2) {
            const bool last = (t == nt - 2);
            const char* a1 = cA + (size_t)(t + 1) * kstep;
            const char* a2 = last ? nA : cA + (size_t)(t + 2) * kstep; const char* b2 = last ? nB : cB + (size_t)(t + 2) * kstep;
            const char* a3 = a2 + kstep; const char* b3 = b2 + kstep;
            if (last && has_next) S.a_ready(nxt);
            if constexpr (Epi::HAS_MID) { if (t == nt / 2) E.mid(acc, cur, wr, wc, fr, fq); }
            if constexpr (SP2) {
            PG8_LDB(B0, 0, 0); PG8_LDB(B1, 0, 1); PG8_SCHED; PG8_LDA(At, 0, 0); PG8_STAGE(PG8_SA(1, 1), a1 + hstepA, voffA);
            PG8_WAIT_V(8); PG8_WAIT_L(0); PG8_BAR; PG8_MMA(0, 0, At, B0); PG8_MMA(0, 1, At, B1); PG8_BAR; PG8_SCHED;
            PG8_LDA(At, 0, 1); PG8_STAGE(PG8_SB(0, 0), b2, voffB); PG8_STAGE(PG8_SB(0, 1), b2 + hstepB, voffB); PG8_STAGE(PG8_SA(0, 0), a2, voffA);
            PG8_WAIT_V(8); PG8_WAIT_L(0); PG8_BAR; PG8_MMA(1, 0, At, B0); PG8_MMA(1, 1, At, B1); PG8_BAR; PG8_SCHED;
            PG8_LDB(B0, 1, 0); PG8_LDB(B1, 1, 1); PG8_SCHED; PG8_LDA(At, 1, 0); PG8_STAGE(PG8_SA(0, 1), a2 + hstepA, voffA);
            PG8_WAIT_V(8); PG8_WAIT_L(0); PG8_BAR; PG8_MMA(0, 0, At, B0); PG8_MMA(0, 1, At, B1); PG8_BAR; PG8_SCHED;
            PG8_LDA(At, 1, 1); PG8_STAGE(PG8_SB(1, 0), b3, voffB); PG8_STAGE(PG8_SB(1, 1), b3 + hstepB, voffB); PG8_STAGE(PG8_SA(1, 0), a3, voffA);
            PG8_WAIT_V(8); PG8_WAIT_L(0); PG8_BAR; PG8_MMA(1, 0, At, B0); PG8_MMA(1, 1, At, B1); PG8_BAR; PG8_SCHED;
            } else {
            PG8_LDB(B0, 0, 0); PG8_SCHED; PG8_LDA(At, 0, 0); PG8_STAGE(PG8_SA(1, 1), a1 + hstepA, voffA);
            PG8_WAIT_L(8); PG8_BAR; PG8_WAIT_L(0); PG8_MMA(0, 0, At, B0); PG8_BAR; PG8_SCHED;
            PG8_LDB(B1, 0, 1); PG8_STAGE(PG8_SB(0, 0), b2, voffB);
            PG8_BAR; PG8_WAIT_L(0); PG8_MMA(0, 1, At, B1); PG8_BAR;
            PG8_LDA(At, 0, 1); PG8_STAGE(PG8_SA(0, 0), a2, voffA);
            PG8_BAR; PG8_WAIT_L(0); PG8_MMA(1, 0, At, B0); PG8_BAR; PG8_SCHED;
            PG8_STAGE(PG8_SB(0, 1), b2 + hstepB, voffB);
            PG8_WAIT_V(6); PG8_BAR; PG8_MMA(1, 1, At, B1); PG8_BAR;
            PG8_LDB(B0, 1, 0); PG8_SCHED; PG8_LDA(At, 1, 0); PG8_STAGE(PG8_SA(0, 1), a2 + hstepA, voffA);
            PG8_WAIT_L(8); PG8_BAR; PG8_WAIT_L(0); PG8_MMA(0, 0, At, B0); PG8_BAR; PG8_SCHED;
            PG8_LDB(B1, 1, 1); PG8_STAGE(PG8_SB(1, 0), b3, voffB);
            PG8_BAR; PG8_WAIT_L(0); PG8_MMA(0, 1, At, B1); PG8_BAR;
            PG8_LDA(At, 1, 1); PG8_STAGE(PG8_SA(1, 0), a3, voffA);
            PG8_BAR; PG8_WAIT_L(0); PG8_MMA(1, 0, At, B0); PG8_BAR; PG8_SCHED;
            PG8_STAGE(PG8_SB(1, 1), b3 + hstepB, voffB);
            PG8_WAIT_V(6); PG8_BAR; PG8_MMA(1, 1, At, B1); PG8_BAR;
            }
        }
        if constexpr (ALIGN_EPI) { if (wr == 0) PG8_BAR; }
        E(acc, cur, wr, wc, fr, fq); S.done(cur);
        if (!has_next) break;
#pragma unroll
        for (int a = 0; a < 2; ++a)
#pragma unroll
            for (int b = 0; b < 2; ++b)
#pragma unroll
                for (int m = 0; m < 4; ++m)
#pragma unroll
                    for (int n = 0; n < 2; ++n) acc[a][b][m][n] = (f32x4){0.f, 0.f, 0.f, 0.f};
        cur = nxt; cA = nA; cB = nB; ++ui;
        if constexpr (ALIGN_EPI) { if (wr == 1) PG8_BAR; }
    }
    PG8_WAIT_V(0);
    if constexpr (!ALIGN_EPI) { if (wr == 0) PG8_BAR; }
    PG8_BAR;
#undef PG8_SA
#undef PG8_SB
#undef PG8_STAGE
#undef PG8_LDA
#undef PG8_LDB
#undef PG8_MMA
#undef PG8_WAIT_V
#undef PG8_WAIT_L
#undef PG8_BAR
#undef PG8_SCHED
}
}

constexpr int D = 1024, BATCH = 8, SEQ = 8192, DEPTH = 4, CTXL = 256, GRIDW = 64;
constexpr int NCTX = BATCH * CTXL;
constexpr int NLAT = BATCH * SEQ;
constexpr int R = NCTX + NLAT;
constexpr int IN_COLS = 5152, NPAD = 5376;
constexpr int PA_LD = 2048, PG_LD = 2048;
constexpr int PA_Q = 0, PA_K = 256, PA_R = 512, PA_NQ = 1024, PA_NK = 1536;
constexpr int NCHUNK = 132;
constexpr int NEXP = 16384;
constexpr float EPS = 1e-6f;
constexpr int NWAVES = 8, NT = 512;
constexpr int NPL = 13;
constexpr int NPHASE = 1 + DEPTH * NPL + 1;

constexpr size_t MiB = 1u << 20;
constexpr size_t WS_CTL = 0, CTL_ZERO_BYTES = 2 * MiB;
constexpr size_t WS_MOD = 1 * MiB;
constexpr size_t WS_ROPE = 2 * MiB;
constexpr size_t WS_WIN = 3 * MiB;
constexpr size_t WS_WPG = 45 * MiB, WS_WPN = 49 * MiB;
constexpr size_t WS_WO = 53 * MiB;
constexpr size_t WS_WS = 61 * MiB;
constexpr size_t WS_XC = 77 * MiB;
constexpr size_t WS_Z = 85 * MiB;
constexpr size_t WS_EU = 94 * MiB, WS_EV = 110 * MiB;
constexpr size_t WS_SU = 126 * MiB, WS_SV = WS_SU + 65536, WS_SX = WS_SV + 65536;
constexpr size_t WS_H8 = 884 * MiB;
constexpr size_t WS_PART = 290 * MiB;
constexpr size_t WS_ACT = 554 * MiB;
constexpr size_t WS_H = 158 * MiB;
constexpr size_t WS_PA = 290 * MiB;
constexpr size_t WS_VT = 554 * MiB, WS_NVT = 620 * MiB;
constexpr size_t WS_DEC = 950 * MiB;
constexpr size_t WS_PG = 686 * MiB;
constexpr size_t WS_SC = 290 * MiB;
constexpr size_t WS_EI = 818 * MiB, WS_EG = 851 * MiB;
constexpr size_t WS_END = 953 * MiB;
static_assert(WS_SC + (size_t)R * 2048 * 4 <= WS_EI && WS_EG + (size_t)R * 128 * 4 <= WS_DEC && WS_PG + (size_t)R * PG_LD * 2 <= WS_DEC && WS_DEC + 64 * 132 * 64 * 4 <= WS_END, "ws map");
static_assert(WS_H + (size_t)R * 1024 * 2 <= WS_PA && WS_PA + (size_t)R * PA_LD * 2 <= WS_VT && WS_VT + (size_t)R * 512 * 2 <= WS_NVT && WS_NVT + (size_t)R * 512 * 2 <= WS_PG && WS_Z + (size_t)R * 32 * 4 <= WS_EU, "ws map");
constexpr int CW_BAR = 4096;

constexpr int RING_BYTES = 131072, LDSCTL_OFF = RING_BYTES, MISC_OFF = LDSCTL_OFF + 320, LDS_BYTES = 147456;

#define GAS __attribute__((address_space(1)))
#define LAS __attribute__((address_space(3)))
typedef unsigned short bf16;
typedef unsigned v4u __attribute__((ext_vector_type(4)));
typedef unsigned v2u __attribute__((ext_vector_type(2)));
typedef int v4i __attribute__((ext_vector_type(4)));
typedef float f32x4 __attribute__((ext_vector_type(4)));
typedef __bf16 bf16x2_t __attribute__((ext_vector_type(2)));
#define LDS_WAIT() asm volatile("s_waitcnt lgkmcnt(0)" ::: "memory")
#define VM_WAIT() asm volatile("s_waitcnt vmcnt(0)" ::: "memory")
__device__ __forceinline__ unsigned f2bf(float f) { unsigned u = __builtin_bit_cast(unsigned, f); return (u + 0x7fffu + ((u >> 16) & 1u)) >> 16; }
__device__ __forceinline__ unsigned pk2(float lo, float hi) { return f2bf(lo) | (f2bf(hi) << 16); }
__device__ __forceinline__ float bflo(unsigned w) { return __builtin_bit_cast(float, w << 16); }
__device__ __forceinline__ float bfhi(unsigned w) { return __builtin_bit_cast(float, w & 0xffff0000u); }
__device__ __forceinline__ float bf1(bf16 h) { return __builtin_bit_cast(float, ((unsigned)h) << 16); }
__device__ __forceinline__ float dot2(unsigned a, unsigned b, float acc) { return __builtin_amdgcn_fdot2_f32_bf16(__builtin_bit_cast(bf16x2_t, a), __builtin_bit_cast(bf16x2_t, b), acc, false); }
__device__ __forceinline__ float shx(float v, int mask, int lane) { return __builtin_bit_cast(float, __builtin_amdgcn_ds_bpermute((lane ^ mask) << 2, __builtin_bit_cast(int, v))); }
__device__ __forceinline__ float wave_sum(float v, int lane) {
#pragma unroll
    for (int o = 1; o < 64; o <<= 1) v += shx(v, o, lane);
    return v;
}
__device__ __forceinline__ float wave_max(float v, int lane) {
#pragma unroll
    for (int o = 1; o < 64; o <<= 1) v = fmaxf(v, shx(v, o, lane));
    return v;
}
__device__ __forceinline__ float sigmoidf_(float x) { return __builtin_amdgcn_rcpf(1.f + __expf(-x)); }

#define XB_TMO      128
#define XB_XCNT(j)  (256  + 64 * (j))
#define XB_XSUB(j)  (1280 + 64 * (j))
#define XB_XGEN(j)  (2304 + 64 * (j))
#define XB_TOP      3328
#define XB_TOPGEN   3392
#define XCD_BAR_WORDS 3456
#define XB_SPIN_CAP (1u << 18)
__device__ __forceinline__ unsigned xb_ld(unsigned* p)              { return __hip_atomic_load(p, __ATOMIC_RELAXED, __HIP_MEMORY_SCOPE_AGENT); }
__device__ __forceinline__ unsigned xb_add(unsigned* p, unsigned v) { return __hip_atomic_fetch_add(p, v, __ATOMIC_RELAXED, __HIP_MEMORY_SCOPE_AGENT); }
__device__ __forceinline__ unsigned xb_xcc_id() { return (unsigned)__builtin_amdgcn_s_getreg((3 << 11) | 20) & 0xFu; }
#define XB_SPIN(cond, bar) do { unsigned _sp = 0; while (cond) { __builtin_amdgcn_s_sleep(1); \
    if ((++_sp & 255u) == 0u) { if (xb_ld(&(bar)[XB_TMO])) break; if (_sp > XB_SPIN_CAP) { atomicAdd(&(bar)[XB_TMO], 1u); break; } } } } while (0)
struct XcdBarrier { unsigned* bar; unsigned x; volatile LAS unsigned* st; };
__device__ __forceinline__ XcdBarrier xcd_barrier_post(unsigned* bar, volatile LAS unsigned* st) {
    XcdBarrier b; b.bar = bar; b.x = xb_xcc_id(); b.st = st;
    if (threadIdx.x == 0) (void)xb_add(&bar[XB_XCNT(b.x)], 1u);
    return b;
}
__device__ __forceinline__ void xcd_barrier_complete(unsigned* bar, unsigned x, unsigned& nloc, unsigned& nx) {
    const unsigned G = gridDim.x * gridDim.y * gridDim.z;
    unsigned sum, cnt, mine, sp = 0u;
    for (;;) {
        sum = 0u; cnt = 0u; mine = 0u;
#pragma unroll
        for (unsigned j = 0; j < 16; ++j) { const unsigned c = xb_ld(&bar[XB_XCNT(j)]); sum += c; cnt += (c > 0u) ? 1u : 0u; mine = (j == x) ? c : mine; }
        if (sum == G) break;
        __builtin_amdgcn_s_sleep(1);
        if ((++sp & 255u) == 0u) { if (xb_ld(&bar[XB_TMO])) break; if (sp > XB_SPIN_CAP) { atomicAdd(&bar[XB_TMO], 1u); break; } }
    }
    nloc = mine > 0u ? mine : 1u; nx = cnt > 0u ? cnt : 1u;
}
__device__ __forceinline__ void xcd_barrier(const XcdBarrier& b) {
    asm volatile("s_waitcnt vmcnt(0)" ::: "memory");
    __syncthreads();
    int tid0_ = threadIdx.x; asm volatile("" : "+v"(tid0_));
    if (tid0_ == 0) {
        unsigned* bar = b.bar;
        __builtin_amdgcn_s_waitcnt(0);
        unsigned nloc = b.st[0], nx = b.st[1];
        if (nloc == 0u) { xcd_barrier_complete(bar, b.x, nloc, nx); b.st[0] = nloc; b.st[1] = nx; }
        const unsigned old = xb_add(&bar[XB_XSUB(b.x)], 1u);
        const unsigned gen = old / nloc;
        if (old + 1u == (gen + 1u) * nloc) {
            __builtin_amdgcn_fence(__ATOMIC_RELEASE, "agent");
            asm volatile("s_waitcnt vmcnt(0)" ::: "memory");
            const unsigned og = xb_add(&bar[XB_TOP], 1u);
            const unsigned tg = og / nx;
            if (og + 1u == (tg + 1u) * nx) xb_add(&bar[XB_TOPGEN], 1u);
            else XB_SPIN(xb_ld(&bar[XB_TOPGEN]) == tg, bar);
            __builtin_amdgcn_fence(__ATOMIC_ACQUIRE, "agent");
            xb_add(&bar[XB_XGEN(b.x)], 1u);
            asm volatile("s_waitcnt vmcnt(0)" ::: "memory");
        } else {
            XB_SPIN(xb_ld(&bar[XB_XGEN(b.x)]) == gen, bar);
            __builtin_amdgcn_fence(__ATOMIC_ACQUIRE, "agent");
            asm volatile("s_waitcnt vmcnt(0)" ::: "memory");
        }
    }
    __syncthreads();
}

struct Args { const float* in[23]; float* out; unsigned char* ws; int ph_lo, ph_hi, li, pad; };
enum { I_X = 0, I_C, I_CTX, I_CCTX, I_WMOD, I_BMOD, I_GN1, I_WIN, I_WAF, I_BAF, I_WAB, I_BAB, I_GGLA, I_RPB, I_WPG, I_WPN, I_WO, I_GN2, I_WQ, I_SK, I_EU, I_EV, I_GF };

struct Frame {
    LAS unsigned char* lds;
    int tid, lane, wave, vcu, G;
};
typedef const __attribute__((address_space(4))) Args* CArgsP;
__device__ __forceinline__ CArgsP kargs() { CArgsP p = (CArgsP)__builtin_amdgcn_kernarg_segment_ptr(); asm volatile("" : "+s"(p)); return p; }
__device__ __forceinline__ const float* xrow_in(CArgsP a, int r) { return r < NCTX ? a->in[I_CTX] + (size_t)r * D : a->in[I_X] + (size_t)(r - NCTX) * D; }
constexpr int XL_LD = 2048;
__device__ __forceinline__ float* xc_row(CArgsP a, int r) { return (float*)(a->ws + WS_XC) + (size_t)r * D; }
__device__ __forceinline__ bf16* xl_row(CArgsP a, int r) { return (bf16*)a->out + (size_t)(r - NCTX) * XL_LD; }
__device__ __forceinline__ int row_slot(int r) { return r < NCTX ? 8 : ((r - NCTX) >> 13); }

using pg8::f32x4; using pg8::u32x4; using pg8::Unit; using pg8::cvt_pk_bf16;
struct EpiIn {
    static constexpr bool HAS_MID = false, PERM = true;
    bf16* PA; bf16* PG; float* Z; const float* rope; bf16* VT; bf16* NVT;
    __device__ __forceinline__ void operator()(const f32x4 (&acc)[2][2][4][2], const Unit& u, int wr, int wc, int fr, int fq) const {
        const int pn = u.pn, row0 = u.pm * 256 + wr * 64 + fr;
        if (pn == 20) {
            if (wc == 0) {
#pragma unroll
                for (int ai = 0; ai < 2; ++ai)
#pragma unroll
                    for (int m = 0; m < 4; ++m) { float* zp = Z + (size_t)(row0 + ai * 128 + m * 16) * 32 + 8 * fq; *(f32x4*)zp = acc[ai][0][m][0]; *(f32x4*)(zp + 4) = acc[ai][0][m][1]; }
            }
            return;
        }
        if (pn >= 8 && pn < 12) {
            bf16* T = (pn < 10 ? VT : NVT) + (size_t)(((pn - 8) & 1) * 256 + wc * 32 + 8 * fq) * R;
#pragma unroll
            for (int ai = 0; ai < 2; ++ai)
#pragma unroll
                for (int m = 0; m < 4; ++m) {
                    const int row = row0 + ai * 128 + m * 16;
#pragma unroll
                    for (int bj = 0; bj < 2; ++bj) {
                        const f32x4 v0 = acc[ai][bj][m][0], v1 = acc[ai][bj][m][1];
                        bf16* tp = T + (size_t)(bj * 128) * R + row;
                        tp[0 * (size_t)R] = (bf16)f2bf(v0[0]); tp[1 * (size_t)R] = (bf16)f2bf(v0[1]); tp[2 * (size_t)R] = (bf16)f2bf(v0[2]); tp[3 * (size_t)R] = (bf16)f2bf(v0[3]);
                        tp[4 * (size_t)R] = (bf16)f2bf(v1[0]); tp[5 * (size_t)R] = (bf16)f2bf(v1[1]); tp[6 * (size_t)R] = (bf16)f2bf(v1[2]); tp[7 * (size_t)R] = (bf16)f2bf(v1[3]);
                    }
                }
            return;
        }
        bf16* base; int ldc, colt;
        if (pn < 8) { base = PA; ldc = PA_LD; colt = pn * 256; } else { base = PG; ldc = PG_LD; colt = (pn - 12) * 256; }
        const int col0 = colt + wc * 32 + 8 * fq;
        const bool do_rope = (pn < 2) && (u.pm >= 8);
        const float sc = (pn == 0 || pn == 4 || pn == 5) ? 0.125f : 1.f;
#pragma unroll
        for (int ai = 0; ai < 2; ++ai)
#pragma unroll
            for (int m = 0; m < 4; ++m) {
                const int row = row0 + ai * 128 + m * 16;
                bf16* rowp = base + (size_t)row * ldc + col0;
                f32x4 cs[4];
                if (do_rope) { const int t = (row - NCTX) & (SEQ - 1); const int pos = (wc & 1) ? (t & 63) : (t >> 6);
                    const f32x4* cp = (const f32x4*)(rope + (size_t)(pos * 16 + 8 * (fq & 1)) * 2);
                    cs[0] = cp[0]; cs[1] = cp[1]; cs[2] = cp[2]; cs[3] = cp[3]; }
#pragma unroll
                for (int bj = 0; bj < 2; ++bj) {
                    f32x4 v0 = acc[ai][bj][m][0], v1 = acc[ai][bj][m][1];
                    if (do_rope) {
                        float x[8] = {v0[0], v0[1], v0[2], v0[3], v1[0], v1[1], v1[2], v1[3]};
#pragma unroll
                        for (int e = 0; e < 8; ++e) { const float p = shx(x[e], 32, fr + 16 * fq); const float c = cs[e >> 1][(e & 1) * 2], s = cs[e >> 1][(e & 1) * 2 + 1];
                            x[e] = (fq < 2) ? (x[e] * c - p * s) : (p * s + x[e] * c); }
                        v0 = (f32x4){x[0], x[1], x[2], x[3]}; v1 = (f32x4){x[4], x[5], x[6], x[7]};
                    }
                    v0 = v0 * sc; v1 = v1 * sc;
                    u32x4 w; w.x = cvt_pk_bf16(v0[0], v0[1]); w.y = cvt_pk_bf16(v0[2], v0[3]); w.z = cvt_pk_bf16(v1[0], v1[1]); w.w = cvt_pk_bf16(v1[2], v1[3]);
                    *(u32x4*)(rowp + bj * 128) = w;
                }
                asm volatile("" ::: "memory");
            }
    }
};
struct EpiMergeK {
    static constexpr bool HAS_MID = true, PERM = true;
    bf16* MG; const bf16* PG;
    __device__ __forceinline__ void mid(f32x4 (&acc)[2][2][4][2], const Unit& u, int wr, int wc, int fr, int fq) const {
        int row0 = u.pm * 256 + wr * 64 + fr, col0 = u.pn * 256 + wc * 32 + 8 * fq;
        asm volatile("" : "+v"(row0), "+v"(col0));
#pragma unroll
        for (int ai = 0; ai < 2; ++ai) {
            u32x4 g1[4][2], g2[4][2];
#pragma unroll
            for (int m = 0; m < 4; ++m)
#pragma unroll
                for (int bj = 0; bj < 2; ++bj) { const bf16* gp = PG + (size_t)(row0 + ai * 128 + m * 16) * PG_LD + col0 + bj * 128; g1[m][bj] = *(const u32x4*)gp; g2[m][bj] = *(const u32x4*)(gp + 1024); }
#pragma unroll
            for (int m = 0; m < 4; ++m)
#pragma unroll
                for (int bj = 0; bj < 2; ++bj) {
                    const unsigned a1[4] = {g1[m][bj].x, g1[m][bj].y, g1[m][bj].z, g1[m][bj].w}, a2[4] = {g2[m][bj].x, g2[m][bj].y, g2[m][bj].z, g2[m][bj].w};
#pragma unroll
                    for (int q = 0; q < 4; ++q) {
                        const float r0 = (1.f + __expf(-bflo(a2[q]))) * __builtin_amdgcn_rcpf(1.f + __expf(-bflo(a1[q])));
                        const float r1 = (1.f + __expf(-bfhi(a2[q]))) * __builtin_amdgcn_rcpf(1.f + __expf(-bfhi(a1[q])));
                        acc[ai][bj][m][q >> 1][(q & 1) * 2] *= r0; acc[ai][bj][m][q >> 1][(q & 1) * 2 + 1] *= r1;
                    }
                }
        }
    }
    __device__ __forceinline__ void operator()(const f32x4 (&acc)[2][2][4][2], const Unit& u, int wr, int wc, int fr, int fq) const {
        int row0 = u.pm * 256 + wr * 64 + fr, col0 = u.pn * 256 + wc * 32 + 8 * fq;
        asm volatile("" : "+v"(row0), "+v"(col0));
        u32x4 gw[2][4][2];
#pragma unroll
        for (int ai = 0; ai < 2; ++ai)
#pragma unroll
            for (int m = 0; m < 4; ++m)
#pragma unroll
                for (int bj = 0; bj < 2; ++bj) gw[ai][m][bj] = *(const u32x4*)(PG + (size_t)(row0 + ai * 128 + m * 16) * PG_LD + 1024 + col0 + bj * 128);
#pragma unroll
        for (int ai = 0; ai < 2; ++ai)
#pragma unroll
            for (int m = 0; m < 4; ++m)
#pragma unroll
                for (int bj = 0; bj < 2; ++bj) {
                    const u32x4 g = gw[ai][m][bj];
                    const f32x4 v0 = acc[ai][bj][m][0], v1 = acc[ai][bj][m][1];
                    u32x4 w; w.x = cvt_pk_bf16(sigmoidf_(bflo(g.x)) * v0[0], sigmoidf_(bfhi(g.x)) * v0[1]); w.y = cvt_pk_bf16(sigmoidf_(bflo(g.y)) * v0[2], sigmoidf_(bfhi(g.y)) * v0[3]);
                    w.z = cvt_pk_bf16(sigmoidf_(bflo(g.z)) * v1[0], sigmoidf_(bfhi(g.z)) * v1[1]); w.w = cvt_pk_bf16(sigmoidf_(bflo(g.w)) * v1[2], sigmoidf_(bfhi(g.w)) * v1[3]);
                    *(u32x4*)(MG + (size_t)(row0 + ai * 128 + m * 16) * D + col0 + bj * 128) = w;
                }
    }
};
struct EpiRes {
    static constexpr bool HAS_MID = false, PERM = true;
    const float* src_c; const float* src_l; float* dst_c; bf16* dst_l; const float* mod; int first;
    __device__ __forceinline__ void operator()(const f32x4 (&acc)[2][2][4][2], const Unit& u, int wr, int wc, int fr, int fq) const {
        const bool isctx = u.pm < 8;
        const int slot = isctx ? 8 : ((u.pm - 8) >> 5);
        int rbase = (isctx ? u.pm * 256 : (u.pm - 8) * 256) + wr * 64 + fr, col0 = u.pn * 256 + wc * 32 + 8 * fq;
        asm volatile("" : "+v"(rbase), "+v"(col0));
        const float* ga = mod + slot * 6144 + 2048;
        f32x4 gv[2][2];
#pragma unroll
        for (int bj = 0; bj < 2; ++bj)
#pragma unroll
            for (int n = 0; n < 2; ++n) gv[bj][n] = *(const f32x4*)(ga + col0 + bj * 128 + 4 * n);
        if (isctx || first) {
#pragma unroll
            for (int ai = 0; ai < 2; ++ai) {
                f32x4 x0[4][2], x1[4][2];
#pragma unroll
                for (int m = 0; m < 4; ++m)
#pragma unroll
                    for (int bj = 0; bj < 2; ++bj) { const float* sp = (isctx ? src_c : src_l) + (size_t)(rbase + ai * 128 + m * 16) * D + col0 + bj * 128; x0[m][bj] = *(const f32x4*)sp; x1[m][bj] = *(const f32x4*)(sp + 4); }
#pragma unroll
                for (int m = 0; m < 4; ++m)
#pragma unroll
                    for (int bj = 0; bj < 2; ++bj) {
                        const int row = rbase + ai * 128 + m * 16, c = col0 + bj * 128;
                        const f32x4 y0 = x0[m][bj] + gv[bj][0] * acc[ai][bj][m][0], y1 = x1[m][bj] + gv[bj][1] * acc[ai][bj][m][1];
                        if (isctx) { float* dp = dst_c + (size_t)row * D + c; *(f32x4*)dp = y0; *(f32x4*)(dp + 4) = y1; }
                        else { u32x4 w; w.x = cvt_pk_bf16(y0[0], y0[1]); w.y = cvt_pk_bf16(y0[2], y0[3]); w.z = cvt_pk_bf16(y1[0], y1[1]); w.w = cvt_pk_bf16(y1[2], y1[3]); *(u32x4*)(dst_l + (size_t)row * XL_LD + c) = w; }
                    }
            }
        } else {
            u32x4 xw[2][4][2];
#pragma unroll
            for (int ai = 0; ai < 2; ++ai)
#pragma unroll
                for (int m = 0; m < 4; ++m)
#pragma unroll
                    for (int bj = 0; bj < 2; ++bj) xw[ai][m][bj] = *(const u32x4*)(dst_l + (size_t)(rbase + ai * 128 + m * 16) * XL_LD + col0 + bj * 128);
#pragma unroll
            for (int ai = 0; ai < 2; ++ai)
#pragma unroll
                for (int m = 0; m < 4; ++m)
#pragma unroll
                    for (int bj = 0; bj < 2; ++bj) {
                        const u32x4 w0 = xw[ai][m][bj];
                        const f32x4 y0 = (f32x4){bflo(w0.x), bfhi(w0.x), bflo(w0.y), bfhi(w0.y)} + gv[bj][0] * acc[ai][bj][m][0], y1 = (f32x4){bflo(w0.z), bfhi(w0.z), bflo(w0.w), bfhi(w0.w)} + gv[bj][1] * acc[ai][bj][m][1];
                        u32x4 w; w.x = cvt_pk_bf16(y0[0], y0[1]); w.y = cvt_pk_bf16(y0[2], y0[3]); w.z = cvt_pk_bf16(y1[0], y1[1]); w.w = cvt_pk_bf16(y1[2], y1[3]);
                        *(u32x4*)(dst_l + (size_t)(rbase + ai * 128 + m * 16) * XL_LD + col0 + bj * 128) = w;
                    }
        }
    }
};
struct EpiB16 {
    static constexpr bool HAS_MID = false, PERM = true;
    bf16* C; int ldc;
    __device__ __forceinline__ void operator()(const f32x4 (&acc)[2][2][4][2], const Unit& u, int wr, int wc, int fr, int fq) const {
        const int row0 = u.pm * 256 + wr * 64 + fr, col0 = u.pn * 256 + wc * 32 + 8 * fq;
#pragma unroll
        for (int ai = 0; ai < 2; ++ai)
#pragma unroll
            for (int m = 0; m < 4; ++m) { bf16* rowp = C + (size_t)(row0 + ai * 128 + m * 16) * ldc + col0;
#pragma unroll
                for (int bj = 0; bj < 2; ++bj) { const f32x4 v0 = acc[ai][bj][m][0], v1 = acc[ai][bj][m][1];
                    u32x4 w; w.x = pk2(v0[0], v0[1]); w.y = pk2(v0[2], v0[3]); w.z = pk2(v1[0], v1[1]); w.w = pk2(v1[2], v1[3]);
                    *(u32x4*)(rowp + bj * 128) = w; } }
    }
};
__device__ __forceinline__ void p0_transpose_item(const float* W, int K, int N, bf16* WT, int dst_row0, LAS float* scr, int k0, int n0, int lane) {
#pragma unroll 8
    for (int i = 0; i < 32; ++i) { const int kk = 2 * i + (lane >> 5); scr[kk * 33 + (lane & 31)] = W[(size_t)(k0 + kk) * N + n0 + (lane & 31)]; }
    LDS_WAIT(); asm volatile("" ::: "memory");
    const int c = lane & 7;
#pragma unroll
    for (int j = 0; j < 4; ++j) { const int n = (lane >> 3) + 8 * j; const LAS float* s = scr + (8 * c) * 33 + n;
        v4u o; o.x = pk2(s[0 * 33], s[1 * 33]); o.y = pk2(s[2 * 33], s[3 * 33]); o.z = pk2(s[4 * 33], s[5 * 33]); o.w = pk2(s[6 * 33], s[7 * 33]);
        *(v4u*)(WT + (size_t)(dst_row0 + n) * K + k0 + 8 * c) = o; }
    LDS_WAIT(); asm volatile("" ::: "memory");
}
__device__ __forceinline__ int win_map(int n0) {
    if (n0 < 512) return n0;
    if (n0 < 1024) return 2048 + (n0 - 512);
    if (n0 < 1056) return 5120 + (n0 - 1024);
    if (n0 < 1568) return 512 + (n0 - 1056);
    if (n0 < 2080) return 1024 + (n0 - 1568);
    if (n0 < 2592) return 1536 + (n0 - 2080);
    if (n0 < 3104) return 2560 + (n0 - 2592);
    return 3072 + (n0 - 3104);
}

__device__ __forceinline__ void p0_prologue(const Frame& F) {
    CArgsP a = kargs(); unsigned char* const ws = a->ws;
    const int gw = F.vcu * NWAVES + F.wave, NGW = F.G * NWAVES;
    const int gtid = F.vcu * NT + F.tid, GT = F.G * NT;
    {
        LAS float* scr = (LAS float*)(F.lds + F.wave * 16384);
        constexpr int I_IN = 16 * 161, I_P = 8 * 32, I_O = 16 * 32, PER_L = I_IN + 2 * I_P + I_O;
        for (int it = gw; it < DEPTH * PER_L; it += NGW) {
            const int l = it / PER_L; int r = it % PER_L;
            if (r < I_IN) { const int kb = r / 161, nb = r % 161; p0_transpose_item(a->in[I_WIN] + (size_t)l * D * IN_COLS, D, IN_COLS, (bf16*)(ws + WS_WIN) + (size_t)l * NPAD * D, win_map(nb * 32), scr, kb * 64, nb * 32, F.lane); continue; }
            r -= I_IN;
            if (r < I_P) { const int kb = r / 32, nb = r % 32; p0_transpose_item(a->in[I_WPG] + (size_t)l * 512 * D, D, D, (bf16*)(ws + WS_WPG) + (size_t)l * D * D, nb * 32, scr, kb * 64, nb * 32, F.lane); continue; }
            r -= I_P;
            if (r < I_P) { const int kb = r / 32, nb = r % 32; p0_transpose_item(a->in[I_WPN] + (size_t)l * 512 * D, D, D, (bf16*)(ws + WS_WPG) + (size_t)l * D * D + 512, nb * 32, scr, kb * 64, nb * 32, F.lane); continue; }
            r -= I_P;
            { const int kb = r / 32, nb = r % 32; p0_transpose_item(a->in[I_WO] + (size_t)l * D * D, D, D, (bf16*)(ws + WS_WO) + (size_t)l * D * D, nb * 32, scr, kb * 64, nb * 32, F.lane); }
        }
        constexpr int PADV = (NPAD - IN_COLS) * D / 8;
        for (int i = gtid; i < DEPTH * PADV; i += GT) { const int l = i / PADV, j = i % PADV; *((v4u*)((bf16*)(ws + WS_WIN) + ((size_t)l * NPAD + IN_COLS) * D) + j) = (v4u){0u, 0u, 0u, 0u}; }
    }
    __syncthreads();
    if (gtid < 128 * 16) { const int pos = gtid >> 4, j = gtid & 15; const float freq = powf(10000.f, -(float)j / 16.f); const float ang = (float)pos * freq;
        float* cs = (float*)(ws + WS_ROPE); cs[2 * gtid] = cosf(ang); cs[2 * gtid + 1] = sinf(ang); }
    {
        LAS float* LSK = (LAS float*)F.lds;
        LAS float* LQ = (LAS float*)(F.lds + 128 * 132 * 4);
        for (int unit = F.vcu; unit < DEPTH * 16 * 16; unit += F.G) {
            const int l = unit >> 8, hp = (unit >> 4) & 15, d0 = (unit & 15) * 64;
            const float* sk = a->in[I_SK] + ((size_t)l * 16 + hp) * 16384;
            const float* wq = a->in[I_WQ] + (size_t)l * D * 2048 + hp * 128;
            __syncthreads();
            for (int i = F.tid; i < 16384; i += NT) LSK[(i >> 7) * 132 + (i & 127)] = sk[i];
            for (int i = F.tid; i < 8192; i += NT) LQ[(i >> 7) * 132 + (i & 127)] = wq[(size_t)(d0 + (i >> 7)) * 2048 + (i & 127)];
            __syncthreads();
            const int dd = F.tid & 63, kg = F.tid >> 6;
            float acc[16];
#pragma unroll
            for (int k = 0; k < 16; ++k) acc[k] = 0.f;
            for (int j = 0; j < 128; j += 4) {
                const f32x4 q = *(const LAS f32x4*)(LQ + dd * 132 + j);
#pragma unroll
                for (int k = 0; k < 16; ++k) { const f32x4 s = *(const LAS f32x4*)(LSK + (kg * 16 + k) * 132 + j); acc[k] += q[0] * s[0] + q[1] * s[1] + q[2] * s[2] + q[3] * s[3]; }
            }
            bf16* o = (bf16*)(ws + WS_WS) + ((size_t)l * 2048 + hp * 128 + kg * 16) * D + d0 + dd;
#pragma unroll
            for (int k = 0; k < 16; ++k) o[(size_t)k * D] = (bf16)f2bf(acc[k]);
        }
    }
    __syncthreads();
    {
        LAS float* ca = (LAS float*)F.lds;
        LAS float* red = (LAS float*)(F.lds + 9 * D * 4);
        for (int i = F.tid; i < 9 * D; i += NT) { const float v = i < 8 * D ? a->in[I_C][i] : a->in[I_CCTX][i - 8 * D]; ca[i] = v / (1.f + __expf(-v)); }
        __syncthreads();
        float* MOD = (float*)(ws + WS_MOD);
        for (int unit = F.vcu; unit < DEPTH * 96; unit += F.G) {
            const int l = unit / 96, cb = unit % 96, dc = F.tid >> 6;
            const int col = cb * 64 + (F.tid & 63);
            const float* w = a->in[I_WMOD] + ((size_t)l * D + dc * 128) * 6144 + col;
            float acc[9];
#pragma unroll
            for (int b = 0; b < 9; ++b) acc[b] = 0.f;
#pragma unroll 8
            for (int d = 0; d < 128; ++d) { const float wv = w[(size_t)d * 6144];
#pragma unroll
                for (int b = 0; b < 9; ++b) acc[b] += ca[b * D + dc * 128 + d] * wv; }
#pragma unroll
            for (int b = 0; b < 9; ++b) red[(dc * 9 + b) * 64 + (F.tid & 63)] = acc[b];
            __syncthreads();
            for (int i = F.tid; i < 9 * 64; i += NT) { const int b = i >> 6, c = i & 63; float sum = a->in[I_BMOD][l * 6144 + cb * 64 + c];
#pragma unroll
                for (int k = 0; k < 8; ++k) sum += red[(k * 9 + b) * 64 + c];
                MOD[((size_t)l * 9 + b) * 6144 + cb * 64 + c] = sum; }
            __syncthreads();
        }
    }
    __syncthreads();
}

__device__ __forceinline__ unsigned pk4_fp8(float a, float b, float c, float d) { int p = __builtin_amdgcn_cvt_pk_fp8_f32(a, b, 0, false); p = __builtin_amdgcn_cvt_pk_fp8_f32(c, d, p, true); return (unsigned)p; }
__device__ __forceinline__ void convert_row_fp8(const f32x4 (&v)[4], unsigned char* dst_tab, float* scale_out, int e, int lane) {
    const f32x4 a0 = v[0], a1 = v[1], a2 = v[2], a3 = v[3];
    float mx = fmaxf(fmaxf(fmaxf(fabsf(a0[0]), fabsf(a0[1])), fmaxf(fabsf(a0[2]), fabsf(a0[3]))), fmaxf(fmaxf(fabsf(a1[0]), fabsf(a1[1])), fmaxf(fabsf(a1[2]), fabsf(a1[3]))));
    mx = fmaxf(mx, fmaxf(fmaxf(fmaxf(fabsf(a2[0]), fabsf(a2[1])), fmaxf(fabsf(a2[2]), fabsf(a2[3]))), fmaxf(fmaxf(fabsf(a3[0]), fabsf(a3[1])), fmaxf(fabsf(a3[2]), fabsf(a3[3])))));
    mx = fmaxf(wave_max(mx, lane), 1e-30f);
    const float sc = 256.f / mx;
    const v4u w = (v4u){pk4_fp8(a0[0] * sc, a0[1] * sc, a0[2] * sc, a0[3] * sc), pk4_fp8(a1[0] * sc, a1[1] * sc, a1[2] * sc, a1[3] * sc), pk4_fp8(a2[0] * sc, a2[1] * sc, a2[2] * sc, a2[3] * sc), pk4_fp8(a3[0] * sc, a3[1] * sc, a3[2] * sc, a3[3] * sc)};
    *(v4u*)(dst_tab + ((size_t)(lane >> 3) * NEXP + e) * 128 + 16 * (lane & 7)) = w;
    if (lane == 0) scale_out[e] = mx * (1.f / 256.f);
}
__device__ __forceinline__ void convert_experts(const Frame& F, int layer) {
    CArgsP a = kargs(); unsigned char* const ws = a->ws;
    const int gw = F.vcu * NWAVES + F.wave, NGW = F.G * NWAVES;
    const float* su = a->in[I_EU] + (size_t)layer * NEXP * D; const float* sv = a->in[I_EV] + (size_t)layer * NEXP * D;
    for (int e = gw; e < NEXP; e += 2 * NGW) {
        const int e1 = e + NGW < NEXP ? e + NGW : e;
        f32x4 ru[2][4], rv[2][4];
#pragma unroll
        for (int q = 0; q < 2; ++q) { const int eq = q ? e1 : e; const f32x4* pu = (const f32x4*)(su + (size_t)eq * D) + 4 * F.lane; const f32x4* pv = (const f32x4*)(sv + (size_t)eq * D) + 4 * F.lane;
#pragma unroll
            for (int j = 0; j < 4; ++j) { ru[q][j] = pu[j]; rv[q][j] = pv[j]; } }
        convert_row_fp8(ru[0], ws + WS_EU, (float*)(ws + WS_SU), e, F.lane); convert_row_fp8(rv[0], ws + WS_EV, (float*)(ws + WS_SV), e, F.lane);
        if (e + NGW < NEXP) { convert_row_fp8(ru[1], ws + WS_EU, (float*)(ws + WS_SU), e1, F.lane); convert_row_fp8(rv[1], ws + WS_EV, (float*)(ws + WS_SV), e1, F.lane); }
    }
}

__device__ __forceinline__ void norm_phase(const Frame& F, int layer, int which, int rbeg) {
    CArgsP a = kargs(); unsigned char* const ws = a->ws;
    const int gw = F.vcu * NWAVES + F.wave, NGW = F.G * NWAVES;
    const float* g = (which ? a->in[I_GN2] : a->in[I_GN1]) + layer * D;
    const float* MOD = (const float*)(ws + WS_MOD) + (size_t)layer * 9 * 6144 + (which ? 3072 : 0);
    bf16* H = (bf16*)(ws + WS_H);
    f32x4 gv[4];
#pragma unroll
    for (int j = 0; j < 4; ++j) gv[j] = *((const f32x4*)g + F.lane + 64 * j);
    for (int r = rbeg + gw; r < R; r += NGW) {
        const float* sh = MOD + row_slot(r) * 6144; const float* sc = sh + D;
        f32x4 v[4]; float ss = 0.f;
        if ((which == 0 && layer == 0) || r < NCTX) {
            const float* xr = (which == 0 && layer == 0) ? xrow_in(a, r) : xc_row(a, r);
#pragma unroll
            for (int j = 0; j < 4; ++j) v[j] = *((const GAS f32x4*)xr + F.lane + 64 * j);
        } else {
            const v2u* xb = (const v2u*)xl_row(a, r) + F.lane;
#pragma unroll
            for (int j = 0; j < 4; ++j) { const v2u w = xb[64 * j]; v[j] = (f32x4){bflo(w.x), bfhi(w.x), bflo(w.y), bfhi(w.y)}; }
        }
#pragma unroll
        for (int j = 0; j < 4; ++j) ss += (v[j][0] * v[j][0] + v[j][1] * v[j][1]) + (v[j][2] * v[j][2] + v[j][3] * v[j][3]);
        const float rs = rsqrtf(wave_sum(ss, F.lane) * (1.f / D) + EPS);
        unsigned long long* o8 = (unsigned long long*)(H + (size_t)r * D) + F.lane;
        float mx = 0.f;
#pragma unroll
        for (int j = 0; j < 4; ++j) {
            const f32x4 s1 = *((const f32x4*)sc + F.lane + 64 * j), s0 = *((const f32x4*)sh + F.lane + 64 * j);
            const f32x4 y = v[j] * rs * gv[j] * (s1 + 1.f) + s0;
            o8[64 * j] = (unsigned long long)pk2(y[0], y[1]) | ((unsigned long long)pk2(y[2], y[3]) << 32);
            v[j] = y; mx = fmaxf(mx, fmaxf(fmaxf(fabsf(y[0]), fabsf(y[1])), fmaxf(fabsf(y[2]), fabsf(y[3]))));
        }
        if (which) {
            mx = fmaxf(wave_max(mx, F.lane), 1e-30f); const float q8 = 256.f / mx;
            unsigned* h8 = (unsigned*)(ws + WS_H8 + (size_t)r * D) + F.lane;
#pragma unroll
            for (int j = 0; j < 4; ++j) h8[64 * j] = pk4_fp8(v[j][0] * q8, v[j][1] * q8, v[j][2] * q8, v[j][3] * q8);
            if (F.lane == 0) ((float*)(ws + WS_SX))[r] = mx * (1.f / 256.f);
        }
    }
}

constexpr int GL_TOT = 0, GL_IMG = 4096, GL_PITCH = 144, GL_IMGB = 64 * GL_PITCH, GL_SSX = GL_IMG + 4 * GL_IMGB;
typedef short bf16x8_t __attribute__((ext_vector_type(8)));
__device__ __forceinline__ int chunk_row0(int b, int tc) { return tc < 4 ? b * CTXL + tc * 64 : NCTX + b * SEQ + (tc - 4) * 64; }
__device__ __forceinline__ int chunk_pos(int tc, int dir) { return dir == 0 ? tc : (tc < 4 ? 3 - tc : 135 - tc); }
__device__ __forceinline__ float logsig16(float x) { return (fminf(x, 0.f) - 0.69314718f * __builtin_amdgcn_logf(1.f + __builtin_amdgcn_exp2f(-1.44269504f * fabsf(x)))) * (1.f / 16.f); }
constexpr int GL_HALF = 65536, GL_Z = 40960, GL_QK = 49152;
struct GlaW { float wf[16], wb[16], baf, bab; };
__device__ __forceinline__ void gla_load_w(GlaW& w, CArgsP a, int layer, int h, int lane) {
    const float* waf = a->in[I_WAF] + layer * 4096 + h * 64 + lane; const float* wab = a->in[I_WAB] + layer * 4096 + h * 64 + lane;
#pragma unroll
    for (int j = 0; j < 16; ++j) { w.wf[j] = waf[j * 256]; w.wb[j] = wab[j * 256]; }
    w.baf = a->in[I_BAF][layer * 256 + h * 64 + lane]; w.bab = a->in[I_BAB][layer * 256 + h * 64 + lane];
}
__device__ __forceinline__ void gla_scan(LAS unsigned char* hl, int w4, int lane, const GlaW& w, const float* Z, int row0, float (&Bf)[16], float (&Bb)[16], float& endf, float& endb) {
    const int t0 = 16 * w4;
    LAS float* ZL = (LAS float*)(hl + GL_Z) + t0 * 32;
    { const f32x4* zp = (const f32x4*)(Z + (size_t)(row0 + t0 + (lane >> 2)) * 32 + (lane & 3) * 8); const f32x4 z0 = zp[0], z1 = zp[1];
      *(LAS f32x4*)(ZL + (lane >> 2) * 32 + (lane & 3) * 8) = z0; *(LAS f32x4*)(ZL + (lane >> 2) * 32 + (lane & 3) * 8 + 4) = z1; }
    LDS_WAIT();
#pragma unroll
    for (int i = 0; i < 16; ++i) {
        const LAS f32x4* zp = (const LAS f32x4*)(ZL + i * 32);
        float zf = w.baf, zb = w.bab;
#pragma unroll
        for (int q = 0; q < 4; ++q) { const f32x4 z0 = zp[q], z1 = zp[4 + q];
            zf += z0[0] * w.wf[4 * q] + z0[1] * w.wf[4 * q + 1] + z0[2] * w.wf[4 * q + 2] + z0[3] * w.wf[4 * q + 3];
            zb += z1[0] * w.wb[4 * q] + z1[1] * w.wb[4 * q + 1] + z1[2] * w.wb[4 * q + 2] + z1[3] * w.wb[4 * q + 3]; }
        Bf[i] = logsig16(zf); Bb[i] = logsig16(zb);
    }
#pragma unroll
    for (int i = 1; i < 16; ++i) Bf[i] += Bf[i - 1];
#pragma unroll
    for (int i = 14; i >= 0; --i) Bb[i] += Bb[i + 1];
    LAS float* TOT = (LAS float*)(hl + GL_TOT);
    TOT[(0 * 4 + w4) * 64 + lane] = Bf[15]; TOT[(1 * 4 + w4) * 64 + lane] = Bb[0];
    __syncthreads();
    float offf = 0.f, offb = 0.f; endf = 0.f; endb = 0.f;
#pragma unroll
    for (int ww = 0; ww < 4; ++ww) { const float tf = TOT[(0 * 4 + ww) * 64 + lane], tb = TOT[(1 * 4 + ww) * 64 + lane]; endf += tf; endb += tb; offf += (ww < w4) ? tf : 0.f; offb += (ww > w4) ? tb : 0.f; }
#pragma unroll
    for (int i = 0; i < 16; ++i) { Bf[i] += offf; Bb[i] += offb; }
}
constexpr int GLA_UNITS = BATCH * 4 * NCHUNK;
__device__ __forceinline__ void gla_a_phase(const Frame& F, int layer) {
    CArgsP a = kargs(); unsigned char* const ws = a->ws;
    const bf16* PA = (const bf16*)(ws + WS_PA); const bf16* VT = (const bf16*)(ws + WS_VT);
    const float* Z = (const float*)(ws + WS_Z); bf16* SST = (bf16*)(ws + WS_H); float* DEC = (float*)(ws + WS_DEC);
    const int lane = F.lane, l16 = lane & 15, g = lane >> 4, hw = F.wave >> 2, w4 = F.wave & 3, t0 = 16 * w4;
    LAS unsigned char* hl = F.lds + hw * GL_HALF;
    const int h = F.vcu & 3;
    GlaW gw; gla_load_w(gw, a, layer, h, lane);
    for (int pp = F.vcu >> 2; pp < BATCH * NCHUNK / 2; pp += F.G >> 2) {
        const int unit = 2 * pp + hw;
        const int b = unit / NCHUNK, tc = unit % NCHUNK, row0 = chunk_row0(b, tc);
        LAS bf16* KL = (LAS bf16*)(hl + GL_QK + 8192) + t0 * 64;
        { const bf16* kp = PA + (size_t)(row0 + t0 + (lane >> 2)) * PA_LD + PA_K + h * 64 + (lane & 3) * 16; const v4u k0 = *(const v4u*)kp, k1 = *(const v4u*)(kp + 8);
          *(LAS v4u*)(KL + (lane >> 2) * 64 + (lane & 3) * 16) = k0; *(LAS v4u*)(KL + (lane >> 2) * 64 + (lane & 3) * 16 + 8) = k1; }
        float Bf[16], Bb[16], endf, endb;
        gla_scan(hl, w4, lane, gw, Z, row0, Bf, Bb, endf, endb);
        float kf[16], kb[16];
#pragma unroll
        for (int i = 0; i < 16; ++i) { const float kk = bf1(KL[i * 64 + lane]); kf[i] = kk * __expf(endf - Bf[i]); kb[i] = kk * __expf(endb - Bb[i]); }
#pragma unroll
        for (int q = 0; q < 2; ++q) {
            *(LAS v4u*)(hl + GL_IMG + 0 * GL_IMGB + lane * GL_PITCH + (t0 + 8 * q) * 2) = (v4u){pk2(kf[8 * q], kf[8 * q + 1]), pk2(kf[8 * q + 2], kf[8 * q + 3]), pk2(kf[8 * q + 4], kf[8 * q + 5]), pk2(kf[8 * q + 6], kf[8 * q + 7])};
            *(LAS v4u*)(hl + GL_IMG + 1 * GL_IMGB + lane * GL_PITCH + (t0 + 8 * q) * 2) = (v4u){pk2(kb[8 * q], kb[8 * q + 1]), pk2(kb[8 * q + 2], kb[8 * q + 3]), pk2(kb[8 * q + 4], kb[8 * q + 5]), pk2(kb[8 * q + 6], kb[8 * q + 7])};
        }
        const int seq0 = (b * 4 + h) * 2;
        if (w4 == 0) { DEC[((size_t)(seq0 + 0) * NCHUNK + chunk_pos(tc, 0)) * 64 + lane] = __expf(endf); DEC[((size_t)(seq0 + 1) * NCHUNK + chunk_pos(tc, 1)) * 64 + lane] = __expf(endb); }
        __syncthreads();
        const int dir = w4 >> 1, nth = w4 & 1;
        const LAS unsigned char* img = hl + GL_IMG + dir * GL_IMGB;
        bf16x8_t afr[4][2];
#pragma unroll
        for (int mt = 0; mt < 4; ++mt)
#pragma unroll
            for (int kt = 0; kt < 2; ++kt) afr[mt][kt] = *(const LAS bf16x8_t*)(img + (32 * (mt >> 1) + 8 * (l16 >> 2) + 4 * (mt & 1) + (l16 & 3)) * GL_PITCH + (32 * kt + 8 * g) * 2);
        bf16* slot = SST + ((size_t)(seq0 + dir) * NCHUNK + chunk_pos(tc, dir)) * 8192;
        bf16x8_t vb[4][2];
#pragma unroll
        for (int n4 = 0; n4 < 4; ++n4) { const bf16* vp = VT + (size_t)(h * 128 + 16 * (4 * nth + n4) + l16) * R + row0 + 8 * g; vb[n4][0] = *(const bf16x8_t*)vp; vb[n4][1] = *(const bf16x8_t*)(vp + 32); }
#pragma unroll
        for (int n4 = 0; n4 < 4; ++n4) {
            const int nt = 4 * nth + n4;
            const bf16x8_t b0 = vb[n4][0], b1 = vb[n4][1];
#pragma unroll
            for (int mp = 0; mp < 2; ++mp) {
                f32x4 a0 = (f32x4){0.f, 0.f, 0.f, 0.f}, a1 = (f32x4){0.f, 0.f, 0.f, 0.f};
                a0 = __builtin_amdgcn_mfma_f32_16x16x32_bf16(afr[2 * mp][0], b0, a0, 0, 0, 0); a0 = __builtin_amdgcn_mfma_f32_16x16x32_bf16(afr[2 * mp][1], b1, a0, 0, 0, 0);
                a1 = __builtin_amdgcn_mfma_f32_16x16x32_bf16(afr[2 * mp + 1][0], b0, a1, 0, 0, 0); a1 = __builtin_amdgcn_mfma_f32_16x16x32_bf16(afr[2 * mp + 1][1], b1, a1, 0, 0, 0);
                *(v4u*)(slot + (16 * nt + l16) * 64 + 32 * mp + 8 * g) = (v4u){pk2(a0[0], a0[1]), pk2(a0[2], a0[3]), pk2(a1[0], a1[1]), pk2(a1[2], a1[3])};
            }
        }
        __syncthreads();
    }
}
__device__ __forceinline__ void gla_b_phase(const Frame& F, bool dry) {
    CArgsP a = kargs(); unsigned char* const ws = a->ws; const bool wr = !dry || a->pad == 12345;
    bf16* SST = (bf16*)(ws + WS_H); const float* DEC = (const float*)(ws + WS_DEC);
    const int gtid = F.vcu * NT + F.tid, GT = F.G * NT;
    for (int id = gtid; id < 64 * 2048; id += GT) {
        const int seq = id >> 11, e = (id & 2047) * 4, k4 = e & 63;
        float s0 = 0.f, s1 = 0.f, s2 = 0.f, s3 = 0.f;
        bf16* p = SST + (size_t)seq * NCHUNK * 8192 + e; const float* dp = DEC + (size_t)seq * NCHUNK * 64 + k4;
        for (int c0 = 0; c0 < NCHUNK; c0 += 12) {
            v2u t[12]; f32x4 d[12];
#pragma unroll
            for (int q = 0; q < 12; ++q) { t[q] = *(const v2u*)(p + (size_t)(c0 + q) * 8192); d[q] = *(const f32x4*)(dp + (c0 + q) * 64); }
#pragma unroll
            for (int q = 0; q < 12; ++q) {
                if (wr) *(v2u*)(p + (size_t)(c0 + q) * 8192) = (v2u){pk2(s0, s1), pk2(s2, s3)};
                s0 = d[q][0] * s0 + bflo(t[q].x); s1 = d[q][1] * s1 + bfhi(t[q].x); s2 = d[q][2] * s2 + bflo(t[q].y); s3 = d[q][3] * s3 + bfhi(t[q].y);
            }
        }
    }
}
__device__ __forceinline__ void gla_c_phase(const Frame& F, int layer, bool dry) {
    CArgsP a = kargs(); unsigned char* const ws = a->ws; const bool wr = !dry || a->pad == 12345;
    bf16* PA = (bf16*)(ws + WS_PA); const bf16* VT = (const bf16*)(ws + WS_VT);
    const float* Z = (const float*)(ws + WS_Z); const bf16* SST = (const bf16*)(ws + WS_H);
    const int lane = F.lane, l16 = lane & 15, g = lane >> 4, hw = F.wave >> 2, w4 = F.wave & 3, t0 = 16 * w4;
    LAS unsigned char* hl = F.lds + hw * GL_HALF;
    const int h = F.vcu & 3;
    GlaW gw; gla_load_w(gw, a, layer, h, lane);
    for (int pp = F.vcu >> 2; pp < BATCH * NCHUNK / 2; pp += F.G >> 2) {
        const int unit = 2 * pp + hw;
        const int b = unit / NCHUNK, tc = unit % NCHUNK, row0 = chunk_row0(b, tc);
        {
            LAS bf16* QL = (LAS bf16*)(hl + GL_QK) + t0 * 64; LAS bf16* KL = QL + 4096;
            { const bf16* qp = PA + (size_t)(row0 + t0 + (lane >> 2)) * PA_LD + PA_Q + h * 64 + (lane & 3) * 16; const bf16* kp = qp + (PA_K - PA_Q);
              const v4u q0 = *(const v4u*)qp, q1 = *(const v4u*)(qp + 8), k0 = *(const v4u*)kp, k1 = *(const v4u*)(kp + 8);
              const int o = (lane >> 2) * 64 + (lane & 3) * 16;
              *(LAS v4u*)(QL + o) = q0; *(LAS v4u*)(QL + o + 8) = q1; *(LAS v4u*)(KL + o) = k0; *(LAS v4u*)(KL + o + 8) = k1; }
            float Bf[16], Bb[16], endf, endb;
            gla_scan(hl, w4, lane, gw, Z, row0, Bf, Bb, endf, endb);
#pragma unroll
            for (int i = 0; i < 16; ++i) {
                const float qq = bf1(QL[i * 64 + lane]), kk = bf1(KL[i * 64 + lane]);
                const float ef = __expf(Bf[i]), eb = __expf(Bb[i]);
                LAS bf16* ip = (LAS bf16*)(hl + GL_IMG + (t0 + i) * GL_PITCH) + lane;
                ip[0] = (bf16)f2bf(qq * ef); ip[GL_IMGB / 2] = (bf16)f2bf(kk * __builtin_amdgcn_rcpf(ef)); ip[GL_IMGB] = (bf16)f2bf(qq * eb); ip[3 * GL_IMGB / 2] = (bf16)f2bf(kk * __builtin_amdgcn_rcpf(eb));
            }
        }
        __syncthreads();
        f32x4 O[8];
#pragma unroll
        for (int mt = 0; mt < 8; ++mt) O[mt] = (f32x4){0.f, 0.f, 0.f, 0.f};
        const int tq = 16 * w4 + l16;
#pragma unroll
        for (int dir = 0; dir < 2; ++dir) {
            const LAS unsigned char* Qimg = hl + GL_IMG + (2 * dir) * GL_IMGB; const LAS unsigned char* Kimg = Qimg + GL_IMGB;
            bf16x8_t qf[2];
#pragma unroll
            for (int kt = 0; kt < 2; ++kt) qf[kt] = *(const LAS bf16x8_t*)(Qimg + tq * GL_PITCH + (32 * kt + 8 * g) * 2);
            f32x4 P[4];
#pragma unroll
            for (int mt = 0; mt < 4; ++mt) {
                P[mt] = (f32x4){0.f, 0.f, 0.f, 0.f};
                const int trow = 32 * (mt >> 1) + 8 * (l16 >> 2) + 4 * (mt & 1) + (l16 & 3);
#pragma unroll
                for (int kt = 0; kt < 2; ++kt) { const bf16x8_t kf = *(const LAS bf16x8_t*)(Kimg + trow * GL_PITCH + (32 * kt + 8 * g) * 2); P[mt] = __builtin_amdgcn_mfma_f32_16x16x32_bf16(kf, qf[kt], P[mt], 0, 0, 0); }
#pragma unroll
                for (int rg = 0; rg < 4; ++rg) { const int tp = 32 * (mt >> 1) + 8 * g + 4 * (mt & 1) + rg; const bool valid = dir == 0 ? (tp <= tq) : (tp >= tq); P[mt][rg] = valid ? P[mt][rg] : 0.f; }
            }
            bf16x8_t pa[2];
#pragma unroll
            for (int k2 = 0; k2 < 2; ++k2) { const v4u w = (v4u){pk2(P[2 * k2][0], P[2 * k2][1]), pk2(P[2 * k2][2], P[2 * k2][3]), pk2(P[2 * k2 + 1][0], P[2 * k2 + 1][1]), pk2(P[2 * k2 + 1][2], P[2 * k2 + 1][3])}; pa[k2] = __builtin_bit_cast(bf16x8_t, w); }
            const bf16* slot = SST + ((size_t)((b * 4 + h) * 2 + dir) * NCHUNK + chunk_pos(tc, dir)) * 8192;
#pragma unroll
            for (int mt = 0; mt < 8; ++mt) {
                const int v = 32 * (mt >> 1) + 8 * (l16 >> 2) + 4 * (mt & 1) + (l16 & 3);
                const bf16* vp = VT + (size_t)(h * 128 + v) * R + row0 + 8 * g;
#pragma unroll
                for (int k2 = 0; k2 < 2; ++k2) { const bf16x8_t vf = *(const bf16x8_t*)(vp + 32 * k2); O[mt] = __builtin_amdgcn_mfma_f32_16x16x32_bf16(vf, pa[k2], O[mt], 0, 0, 0); }
#pragma unroll
                for (int kt = 0; kt < 2; ++kt) { const bf16x8_t sf = *(const bf16x8_t*)(slot + v * 64 + 32 * kt + 8 * g); O[mt] = __builtin_amdgcn_mfma_f32_16x16x32_bf16(sf, qf[kt], O[mt], 0, 0, 0); }
            }
        }
        float ss = 0.f;
#pragma unroll
        for (int mt = 0; mt < 8; ++mt) ss += (O[mt][0] * O[mt][0] + O[mt][1] * O[mt][1]) + (O[mt][2] * O[mt][2] + O[mt][3] * O[mt][3]);
        ss += shx(ss, 16, lane); ss += shx(ss, 32, lane);
        const float rs = rsqrtf(ss * (1.f / 128.f) + EPS);
        bf16* rp0 = PA + (size_t)(row0 + tq) * PA_LD + PA_R + h * 128 + 8 * g;
#pragma unroll
        for (int mp = 0; mp < 4; ++mp) {
            const v4u rr = *(const v4u*)(rp0 + 32 * mp);
            const float* gp = a->in[I_GGLA] + layer * 128 + 32 * mp + 8 * g; const f32x4 ga = *(const f32x4*)gp, gb = *(const f32x4*)(gp + 4);
            const float r0 = bflo(rr.x), r1 = bfhi(rr.x), r2 = bflo(rr.y), r3 = bfhi(rr.y), r4 = bflo(rr.z), r5 = bfhi(rr.z), r6 = bflo(rr.w), r7 = bfhi(rr.w);
            const f32x4 oa = O[2 * mp], ob = O[2 * mp + 1];
            const float y0 = oa[0] * rs * ga[0] * (r0 * sigmoidf_(r0)), y1 = oa[1] * rs * ga[1] * (r1 * sigmoidf_(r1)), y2 = oa[2] * rs * ga[2] * (r2 * sigmoidf_(r2)), y3 = oa[3] * rs * ga[3] * (r3 * sigmoidf_(r3));
            const float y4 = ob[0] * rs * gb[0] * (r4 * sigmoidf_(r4)), y5 = ob[1] * rs * gb[1] * (r5 * sigmoidf_(r5)), y6 = ob[2] * rs * gb[2] * (r6 * sigmoidf_(r6)), y7 = ob[3] * rs * gb[3] * (r7 * sigmoidf_(r7));
            if (wr) *(v4u*)(rp0 + 32 * mp) = (v4u){pk2(y0, y1), pk2(y2, y3), pk2(y4, y5), pk2(y6, y7)};
        }
        __syncthreads();
    }
}

__device__ __forceinline__ void na_unit4(bf16* PA, const bf16* NVT, const float* rpb_l, LAS float* lb, int b, int hd, bool lat, int qr0, int nt, int lane, bool wr) {
    const int l16 = lane & 15, g = lane >> 4;
    const int latbase = NCTX + b * SEQ, ctxbase = b * CTXL;
    bf16* qp[4]; bf16x8_t qf[4][2];
#pragma unroll
    for (int j = 0; j < 4; ++j) {
        const int row = lat ? latbase + (qr0 + j) * 64 + 16 * nt + l16 : ctxbase + 64 * nt + 16 * j + l16;
        qp[j] = PA + (size_t)row * PA_LD + PA_NQ + hd * 64;
        qf[j][0] = *(const bf16x8_t*)(qp[j] + 8 * g); qf[j][1] = *(const bf16x8_t*)(qp[j] + 32 + 8 * g);
    }
    const int qc = 16 * nt + l16, c0 = min(max(qc - 8, 0), 48), R0 = min(max(qr0 - 4, 0), 120);
    if (lat) {
#pragma unroll
        for (int i = 0; i < 8; ++i) { const int idx = lane + 64 * i; if (idx < 465) lb[idx] = rpb_l[hd * 465 + idx]; }
        LDS_WAIT();
    }
    const bf16* kbase = PA + PA_NK + hd * 64 + 8 * g;
    const bf16* vbase = NVT + (size_t)(hd * 64 + l16) * R + 8 * g;
    float mx[4] = {-3.0e38f, -3.0e38f, -3.0e38f, -3.0e38f};
    const int nrows = lat ? ((qr0 == 0 || qr0 == 124) ? 8 : 11) : 0, cs = (nt == 0) ? 0 : (nt == 1 ? 8 : (nt == 2 ? 24 : 32));
    const int nwin = nrows, nslot = nwin + 8;
#define NA_SLOT(si, jmask, krow, pr, base0, win) do { const int s_ = min((si), nslot - 1); win = s_ < nwin; pr = 0; \
        if (win) { krow = R0 + s_; jmask = 0u; \
            _Pragma("unroll") for (int j_ = 0; j_ < 4; ++j_) { const int r0j = min(max(qr0 + j_ - 4, 0), 120); if (krow >= r0j && krow < r0j + 8) jmask |= 1u << j_; } \
            base0 = latbase + krow * 64 + cs; } else { jmask = 15u; krow = 0; base0 = ctxbase + (s_ - nwin) * 32; } } while (0)
#define NA_LDK(dst, base0) do { _Pragma("unroll") for (int t_ = 0; t_ < 2; ++t_) { const bf16* kp_ = kbase + (size_t)((base0) + 8 * (l16 >> 2) + 4 * t_ + (l16 & 3)) * PA_LD; dst[t_][0] = *(const bf16x8_t*)kp_; dst[t_][1] = *(const bf16x8_t*)(kp_ + 32); } } while (0)
#define NA_LDV(dst, base0) do { _Pragma("unroll") for (int mt_ = 0; mt_ < 4; ++mt_) dst[mt_] = *(const bf16x8_t*)(vbase + (size_t)(16 * mt_) * R + (base0)); } while (0)
#pragma unroll 1
    for (int s0 = 0; s0 < nslot; s0 += 4) {
        bf16x8_t kc[4][2][2]; unsigned jm[4];
#pragma unroll
        for (int q = 0; q < 4; ++q) { int krow, pr, base0; bool win; NA_SLOT(s0 + q, jm[q], krow, pr, base0, win); if (s0 + q >= nslot) jm[q] = 0u; NA_LDK(kc[q], base0); }
#pragma unroll
        for (int q = 0; q < 4; ++q)
#pragma unroll
            for (int t = 0; t < 2; ++t)
#pragma unroll
                for (int j = 0; j < 4; ++j) {
                    f32x4 S = (f32x4){0.f, 0.f, 0.f, 0.f};
                    S = __builtin_amdgcn_mfma_f32_16x16x32_bf16(kc[q][t][0], qf[j][0], S, 0, 0, 0);
                    S = __builtin_amdgcn_mfma_f32_16x16x32_bf16(kc[q][t][1], qf[j][1], S, 0, 0, 0);
                    mx[j] = fmaxf(mx[j], fmaxf(fmaxf(S[0], S[1]), fmaxf(S[2], S[3])));
                }
    }
#pragma unroll
    for (int j = 0; j < 4; ++j) { mx[j] = fmaxf(mx[j], shx(mx[j], 16, lane)); mx[j] = fmaxf(mx[j], shx(mx[j], 32, lane)); }
    float ls[4] = {0.f, 0.f, 0.f, 0.f};
    f32x4 O[4][4];
#pragma unroll
    for (int j = 0; j < 4; ++j)
#pragma unroll
        for (int mt = 0; mt < 4; ++mt) O[j][mt] = (f32x4){0.f, 0.f, 0.f, 0.f};
#pragma unroll 1
    for (int s0 = 0; s0 < nslot; s0 += 2) {
        bf16x8_t kf[2][2][2], vf[2][4]; unsigned jm[2]; int krw[2], prr[2]; bool wn[2];
#pragma unroll
        for (int q = 0; q < 2; ++q) { int base0; NA_SLOT(s0 + q, jm[q], krw[q], prr[q], base0, wn[q]); if (s0 + q >= nslot) jm[q] = 0u; NA_LDK(kf[q], base0); NA_LDV(vf[q], base0); }
#pragma unroll
        for (int q = 0; q < 2; ++q) {
            const bool win = wn[q]; const int pr = prr[q], krow = krw[q];
            bool cv[2][4]; int co[2][4];
#pragma unroll
            for (int t = 0; t < 2; ++t)
#pragma unroll
                for (int rg = 0; rg < 4; ++rg) { const int kcol = cs + 8 * g + 4 * t + rg; cv[t][rg] = !win || ((kcol >= c0) && (kcol <= c0 + 15)); co[t][rg] = min(max(kcol - qc + 15, 0), 30); }
#pragma unroll
            for (int j = 0; j < 4; ++j) {
                const bool rv = (jm[q] >> j) & 1u;
                f32x4 S[2];
#pragma unroll
                for (int t = 0; t < 2; ++t) { S[t] = (f32x4){0.f, 0.f, 0.f, 0.f};
                    S[t] = __builtin_amdgcn_mfma_f32_16x16x32_bf16(kf[q][t][0], qf[j][0], S[t], 0, 0, 0);
                    S[t] = __builtin_amdgcn_mfma_f32_16x16x32_bf16(kf[q][t][1], qf[j][1], S[t], 0, 0, 0); }
                const LAS float* bp = lb + (win ? min(max(krow - (qr0 + j) + 7, 0), 14) * 31 : 0);
                float psum = 0.f;
#pragma unroll
                for (int t = 0; t < 2; ++t)
#pragma unroll
                    for (int rg = 0; rg < 4; ++rg) { const float bias = win ? bp[co[t][rg]] : 0.f; const float p = (cv[t][rg] && rv) ? __expf(S[t][rg] + bias - mx[j]) : 0.f; S[t][rg] = p; psum += p; }
                ls[j] += psum;
                const bf16x8_t pa = __builtin_bit_cast(bf16x8_t, (v4u){pk2(S[0][0], S[0][1]), pk2(S[0][2], S[0][3]), pk2(S[1][0], S[1][1]), pk2(S[1][2], S[1][3])});
#pragma unroll
                for (int mt = 0; mt < 4; ++mt) O[j][mt] = __builtin_amdgcn_mfma_f32_16x16x32_bf16(vf[q][mt], pa, O[j][mt], 0, 0, 0);
            }
        }
    }
#undef NA_SLOT
#undef NA_LDK
#undef NA_LDV
#pragma unroll
    for (int j = 0; j < 4; ++j) {
        float l = ls[j]; l += shx(l, 16, lane); l += shx(l, 32, lane);
        const float inv = 1.f / l;
#pragma unroll
        for (int mt = 0; mt < 4; ++mt) if (wr) *(v2u*)(qp[j] + 16 * mt + 4 * g) = (v2u){pk2(O[j][mt][0] * inv, O[j][mt][1] * inv), pk2(O[j][mt][2] * inv, O[j][mt][3] * inv)};
    }
}
__device__ __forceinline__ void na_phase(const Frame& F, int layer, bool dry, bool skip_ctx) {
    CArgsP a = kargs(); unsigned char* const ws = a->ws; const bool wr = !dry || a->pad == 12345;
    bf16* PA = (bf16*)(ws + WS_PA); const bf16* NVT = (const bf16*)(ws + WS_NVT);
    const float* rpb_l = a->in[I_RPB] + (size_t)layer * 8 * 465;
    const int gw = F.vcu * NWAVES + F.wave, NGW = F.G * NWAVES;
    LAS float* lb = (LAS float*)(F.lds + F.wave * 2048);
    for (int u = gw; u < BATCH * 8 * 32 * 4 + (skip_ctx ? 0 : BATCH * 8 * 4); u += NGW) {
        if (u < BATCH * 8 * 32 * 4) { const int nt = u & 3, qg = (u >> 2) & 31, hd = (u >> 7) & 7, b = u >> 10; na_unit4(PA, NVT, rpb_l, lb, b, hd, true, 4 * qg, nt, F.lane, wr); }
        else { const int v = u - BATCH * 8 * 32 * 4; const int nt = v & 3, hd = (v >> 2) & 7, b = v >> 5; na_unit4(PA, NVT, rpb_l, lb, b, hd, false, 0, nt, F.lane, wr); }
    }
}

__device__ __forceinline__ float pack_key(float v, int idx) { unsigned t = __builtin_bit_cast(unsigned, v) & ~127u; asm("" : "+v"(t)); return __builtin_bit_cast(float, t | (unsigned)idx); }
__device__ __forceinline__ void topk_phase(const Frame& F, int rbeg) {
    CArgsP a = kargs(); unsigned char* const ws = a->ws;
    const int gtid = F.vcu * NT + F.tid, GT = F.G * NT;
    const bf16* SC = (const bf16*)(ws + WS_SC);
    int* EI = (int*)(ws + WS_EI); float* EG = (float*)(ws + WS_EG);
    LAS unsigned* myl = (LAS unsigned*)F.lds + F.tid * 9;
    for (int id = rbeg * 8 + gtid; id < R * 8; id += GT) {
        const int r = id >> 3, hd = id & 7;
        const v4u* sp = (const v4u*)(SC + (size_t)r * 2048 + hd * 256);
        float t0[16], t1[16];
#pragma unroll
        for (int blk = 0; blk < 8; ++blk) {
            float n0[16], n1[16];
#pragma unroll
            for (int q = 0; q < 2; ++q) { const v4u va = sp[blk * 2 + q], vb = sp[16 + blk * 2 + q];
                const unsigned wa[4] = {va.x, va.y, va.z, va.w}, wb[4] = {vb.x, vb.y, vb.z, vb.w};
#pragma unroll
                for (int e = 0; e < 4; ++e) { const int i0 = blk * 16 + 8 * q + 2 * e;
                    n0[8 * q + 2 * e] = pack_key(bflo(wa[e]), i0); n0[8 * q + 2 * e + 1] = pack_key(bfhi(wa[e]), i0 + 1);
                    n1[8 * q + 2 * e] = pack_key(bflo(wb[e]), i0); n1[8 * q + 2 * e + 1] = pack_key(bfhi(wb[e]), i0 + 1); } }
#pragma unroll
            for (int k = 2; k <= 16; k <<= 1)
#pragma unroll
                for (int j = k >> 1; j > 0; j >>= 1)
#pragma unroll
                    for (int i = 0; i < 16; ++i) { const int l = i ^ j; if (l > i) { const bool desc = (i & k) == 0;
                        const float a0 = n0[i], b0 = n0[l], a1 = n1[i], b1 = n1[l];
                        n0[i] = desc ? fmaxf(a0, b0) : fminf(a0, b0); n0[l] = desc ? fminf(a0, b0) : fmaxf(a0, b0);
                        n1[i] = desc ? fmaxf(a1, b1) : fminf(a1, b1); n1[l] = desc ? fminf(a1, b1) : fmaxf(a1, b1); } }
            if (blk == 0) {
#pragma unroll
                for (int i = 0; i < 16; ++i) { t0[i] = n0[i]; t1[i] = n1[i]; }
            } else {
#pragma unroll
                for (int i = 0; i < 16; ++i) { t0[i] = fmaxf(t0[i], n0[15 - i]); t1[i] = fmaxf(t1[i], n1[15 - i]); }
#pragma unroll
                for (int j = 8; j > 0; j >>= 1)
#pragma unroll
                    for (int i = 0; i < 16; ++i) { const int l = i ^ j; if (l > i) { const float a0 = t0[i], b0 = t0[l], a1 = t1[i], b1 = t1[l];
                        t0[i] = fmaxf(a0, b0); t0[l] = fminf(a0, b0); t1[i] = fmaxf(a1, b1); t1[l] = fminf(a1, b1); } }
            }
        }
        float best[16];
#pragma unroll
        for (int j = 0; j < 16; ++j) best[j] = -3.0e38f;
#pragma unroll
        for (int ia = 0; ia < 16; ++ia)
#pragma unroll
            for (int ib = 0; ib < 16; ++ib)
                if ((ia + 1) * (ib + 1) <= 16) {
                    float x = __builtin_bit_cast(float, (__builtin_bit_cast(unsigned, t0[ia] + t1[ib]) & ~255u) | (unsigned)(ia * 16 + ib));
#pragma unroll
                    for (int j = 0; j < 16; ++j) { const float tb = fmaxf(best[j], x); x = fminf(best[j], x); best[j] = tb; }
                }
        {
            unsigned w0[4], w1[4];
#pragma unroll
            for (int q = 0; q < 4; ++q) {
                w0[q] = (__builtin_bit_cast(unsigned, t0[4 * q]) & 127u) | ((__builtin_bit_cast(unsigned, t0[4 * q + 1]) & 127u) << 8) | ((__builtin_bit_cast(unsigned, t0[4 * q + 2]) & 127u) << 16) | ((__builtin_bit_cast(unsigned, t0[4 * q + 3]) & 127u) << 24);
                w1[q] = (__builtin_bit_cast(unsigned, t1[4 * q]) & 127u) | ((__builtin_bit_cast(unsigned, t1[4 * q + 1]) & 127u) << 8) | ((__builtin_bit_cast(unsigned, t1[4 * q + 2]) & 127u) << 16) | ((__builtin_bit_cast(unsigned, t1[4 * q + 3]) & 127u) << 24);
            }
#pragma unroll
            for (int q = 0; q < 4; ++q) { myl[q] = w0[q]; myl[4 + q] = w1[q]; }
            LDS_WAIT();
        }
        int eid[16];
#pragma unroll
        for (int j = 0; j < 16; ++j) { const unsigned code = __builtin_bit_cast(unsigned, best[j]) & 255u; const LAS unsigned char* mb = (const LAS unsigned char*)myl;
            eid[j] = (int)mb[code >> 4] * 128 + (int)mb[16 + (code & 15u)]; }
        LDS_WAIT();
        float sum = 0.f; const float bmax = best[0];
#pragma unroll
        for (int j = 0; j < 16; ++j) { best[j] = __expf(best[j] - bmax); sum += best[j]; }
        const float inv = 1.f / sum;
        v4i* ei = (v4i*)(EI + (size_t)r * 128 + hd * 16); f32x4* eg = (f32x4*)(EG + (size_t)r * 128 + hd * 16);
#pragma unroll
        for (int j = 0; j < 4; ++j) { ei[j] = (v4i){eid[4 * j], eid[4 * j + 1], eid[4 * j + 2], eid[4 * j + 3]}; eg[j] = (f32x4){best[4 * j] * inv, best[4 * j + 1] * inv, best[4 * j + 2] * inv, best[4 * j + 3] * inv}; }
    }
}

__device__ __forceinline__ float gelu_tanh(float x) { const float u = 0.7978845608f * (x + 0.044715f * x * x * x); return x * __builtin_amdgcn_rcpf(1.f + __expf(-2.f * u)); }
typedef float f32x2_t __attribute__((ext_vector_type(2)));
__device__ __forceinline__ void peer1_phase(const Frame& F, int rbeg) {
    CArgsP a = kargs(); unsigned char* const ws = a->ws;
    const unsigned char* EU8 = ws + WS_EU; const unsigned char* H8 = ws + WS_H8;
    const int* EI = (const int*)(ws + WS_EI); bf16* PART = (bf16*)(ws + WS_PART);
    const int per = F.G >> 3, s = F.vcu / per, rank = F.vcu % per, stride = per * NWAVES;
    const int lane = F.lane, m = lane & 15, g = lane >> 4, row8 = lane >> 3, part = lane & 7;
    const unsigned char* tab = EU8 + (size_t)s * NEXP * 128 + 16 * part;
    LAS unsigned char* wl = F.lds + F.wave * 5632;
    LAS int* idl = (LAS int*)(wl + 4608);
    const int wofs = row8 * 144 + part * 16, rofs = m * 144 + 16 * g;
    int r = rbeg + rank * NWAVES + F.wave;
    v2u idp[2];
#pragma unroll
    for (int u = 0; u < 2; ++u) idp[u] = *(const v2u*)(EI + (size_t)min(r + u * stride, R - 1) * 128 + 2 * lane);
    for (; r < R; r += 2 * stride) {
        v4u w[2][16]; v4u x[2][2];
#pragma unroll
        for (int u = 0; u < 2; ++u) *(LAS v2u*)(idl + u * 128 + 2 * lane) = idp[u];
        LDS_WAIT();
#pragma unroll
        for (int u = 0; u < 2; ++u) {
            const int ru = min(r + u * stride, R - 1);
            const unsigned char* xp = H8 + (size_t)ru * D + 128 * s + 16 * g;
            x[u][0] = *(const v4u*)xp; x[u][1] = *(const v4u*)(xp + 64);
#pragma unroll
            for (int j = 0; j < 16; ++j) w[u][j] = *(const v4u*)(tab + (size_t)idl[u * 128 + 8 * j + row8] * 128);
        }
        const int rn = r + 2 * stride;
#pragma unroll
        for (int u = 0; u < 2; ++u) idp[u] = *(const v2u*)(EI + (size_t)min(rn + u * stride, R - 1) * 128 + 2 * lane);
#pragma unroll
        for (int u = 0; u < 2; ++u) {
            f32x4 sel = (f32x4){0.f, 0.f, 0.f, 0.f};
#pragma unroll
            for (int T = 0; T < 8; ++T) {
                LAS unsigned char* buf = wl + (T & 1) * 2304;
                *(LAS v4u*)(buf + wofs) = w[u][2 * T]; *(LAS v4u*)(buf + 8 * 144 + wofs) = w[u][2 * T + 1];
                const v4u a0 = *(const LAS v4u*)(buf + rofs), a1 = *(const LAS v4u*)(buf + rofs + 64);
                f32x4 acc = (f32x4){0.f, 0.f, 0.f, 0.f};
                acc = __builtin_amdgcn_mfma_f32_16x16x32_fp8_fp8((long)(((unsigned long long)a0.y << 32) | a0.x), (long)(((unsigned long long)x[u][0].y << 32) | x[u][0].x), acc, 0, 0, 0);
                acc = __builtin_amdgcn_mfma_f32_16x16x32_fp8_fp8((long)(((unsigned long long)a0.w << 32) | a0.z), (long)(((unsigned long long)x[u][0].w << 32) | x[u][0].z), acc, 0, 0, 0);
                acc = __builtin_amdgcn_mfma_f32_16x16x32_fp8_fp8((long)(((unsigned long long)a1.y << 32) | a1.x), (long)(((unsigned long long)x[u][1].y << 32) | x[u][1].x), acc, 0, 0, 0);
                acc = __builtin_amdgcn_mfma_f32_16x16x32_fp8_fp8((long)(((unsigned long long)a1.w << 32) | a1.z), (long)(((unsigned long long)x[u][1].w << 32) | x[u][1].z), acc, 0, 0, 0);
                sel = (m == T) ? acc : sel;
            }
            const int ru = r + u * stride;
            if (m < 8 && ru < R) *(v2u*)(PART + ((size_t)s * R + ru) * 128 + 16 * m + 4 * g) = (v2u){pk2(sel[0], sel[1]), pk2(sel[2], sel[3])};
        }
    }
}
__device__ __forceinline__ void peer_act_phase(const Frame& F, int rbeg) {
    CArgsP a = kargs(); unsigned char* const ws = a->ws;
    const int gtid = F.vcu * NT + F.tid, GT = F.G * NT;
    const bf16* PART = (const bf16*)(ws + WS_PART); const int* EI = (const int*)(ws + WS_EI); const float* EG = (const float*)(ws + WS_EG);
    const float* SU = (const float*)(ws + WS_SU); const float* SV = (const float*)(ws + WS_SV); const float* SX = (const float*)(ws + WS_SX);
    float* ACT = (float*)(ws + WS_ACT);
    for (int i0 = rbeg * 32 + gtid; i0 < R * 32; i0 += 2 * GT) {
        const int i1 = i0 + GT < R * 32 ? i0 + GT : i0;
        v2u pw[2][8]; v4i id[2]; f32x4 gt[2]; float sx[2];
#pragma unroll
        for (int u = 0; u < 2; ++u) { const int i = u ? i1 : i0;
#pragma unroll
            for (int q = 0; q < 8; ++q) pw[u][q] = *(const v2u*)(PART + (size_t)q * R * 128 + (size_t)i * 4);
            id[u] = *(const v4i*)(EI + (size_t)i * 4); gt[u] = *(const f32x4*)(EG + (size_t)i * 4); sx[u] = SX[i >> 5]; }
        float su[2][4], sv[2][4];
#pragma unroll
        for (int u = 0; u < 2; ++u)
#pragma unroll
            for (int k = 0; k < 4; ++k) { su[u][k] = SU[id[u][k]]; sv[u][k] = SV[id[u][k]]; }
#pragma unroll
        for (int u = 0; u < 2; ++u) {
            f32x4 sum = (f32x4){0.f, 0.f, 0.f, 0.f};
#pragma unroll
            for (int q = 0; q < 8; ++q) sum += (f32x4){bflo(pw[u][q].x), bfhi(pw[u][q].x), bflo(pw[u][q].y), bfhi(pw[u][q].y)};
            f32x4 o;
#pragma unroll
            for (int k = 0; k < 4; ++k) o[k] = gelu_tanh(sum[k] * sx[u] * su[u][k]) * gt[u][k] * sv[u][k];
            if (u == 0 || i0 + GT < R * 32) *(f32x4*)(ACT + (size_t)(u ? i1 : i0) * 4) = o;
        }
    }
}
__device__ __forceinline__ void peer2_phase(const Frame& F, int layer, bool dry, int rbeg) {
    CArgsP a = kargs(); unsigned char* const ws = a->ws; const bool wr = !dry || a->pad == 12345;
    const unsigned char* EV8 = ws + WS_EV; const int* EI = (const int*)(ws + WS_EI); const float* ACT = (const float*)(ws + WS_ACT);
    const float* MOD = (const float*)(ws + WS_MOD) + (size_t)layer * 9 * 6144 + 5 * D;
    const int per = F.G >> 3, s = F.vcu / per, rank = F.vcu % per, stride = per * NWAVES;
    const int lane = F.lane, part = lane & 7, e8 = lane >> 3;
    const unsigned char* tab = EV8 + (size_t)s * NEXP * 128 + 16 * part;
    const bool b5 = (lane & 32) != 0, b4 = (lane & 16) != 0, b3 = (lane & 8) != 0;
    const int dimoff = 128 * s + 16 * part + (b5 ? 8 : 0) + (b4 ? 4 : 0) + (b3 ? 2 : 0);
    int r = rbeg + rank * NWAVES + F.wave;
    LAS int* idl = (LAS int*)(F.lds + F.wave * 2048); LAS float* acl = (LAS float*)(idl + 256);
    v2u idp[2], acp[2];
#pragma unroll
    for (int u = 0; u < 2; ++u) { idp[u] = *(const v2u*)(EI + (size_t)min(r + u * stride, R - 1) * 128 + 2 * lane); acp[u] = *(const v2u*)(ACT + (size_t)min(r + u * stride, R - 1) * 128 + 2 * lane); }
    for (; r < R; r += 2 * stride) {
        v4u w[2][16]; f32x4 a4[2][4]; v4i id4[2][4];
#pragma unroll
        for (int u = 0; u < 2; ++u) { *(LAS v2u*)(idl + u * 128 + 2 * lane) = idp[u]; *(LAS v2u*)(acl + u * 128 + 2 * lane) = acp[u]; }
        LDS_WAIT();
#pragma unroll
        for (int u = 0; u < 2; ++u) {
#pragma unroll
            for (int q = 0; q < 4; ++q) id4[u][q] = *(const LAS v4i*)(idl + u * 128 + 16 * e8 + 4 * q);
#pragma unroll
            for (int j = 0; j < 16; ++j) w[u][j] = *(const v4u*)(tab + (size_t)id4[u][j >> 2][j & 3] * 128);
        }
        const int rn = r + 2 * stride;
#pragma unroll
        for (int u = 0; u < 2; ++u) { idp[u] = *(const v2u*)(EI + (size_t)min(rn + u * stride, R - 1) * 128 + 2 * lane); acp[u] = *(const v2u*)(ACT + (size_t)min(rn + u * stride, R - 1) * 128 + 2 * lane); }
#pragma unroll
        for (int u = 0; u < 2; ++u)
#pragma unroll
            for (int q = 0; q < 4; ++q) a4[u][q] = *(const LAS f32x4*)(acl + u * 128 + 16 * e8 + 4 * q);
#pragma unroll
        for (int u = 0; u < 2; ++u) {
            f32x2_t o[8];
#pragma unroll
            for (int k = 0; k < 8; ++k) o[k] = (f32x2_t){0.f, 0.f};
#pragma unroll
            for (int j = 0; j < 16; ++j) {
                const v4u ww = w[u][j];
                const float av = a4[u][j >> 2][j & 3]; const f32x2_t av2 = (f32x2_t){av, av};
                o[0] += av2 * __builtin_amdgcn_cvt_pk_f32_fp8((int)ww.x, false); o[1] += av2 * __builtin_amdgcn_cvt_pk_f32_fp8((int)ww.x, true);
                o[2] += av2 * __builtin_amdgcn_cvt_pk_f32_fp8((int)ww.y, false); o[3] += av2 * __builtin_amdgcn_cvt_pk_f32_fp8((int)ww.y, true);
                o[4] += av2 * __builtin_amdgcn_cvt_pk_f32_fp8((int)ww.z, false); o[5] += av2 * __builtin_amdgcn_cvt_pk_f32_fp8((int)ww.z, true);
                o[6] += av2 * __builtin_amdgcn_cvt_pk_f32_fp8((int)ww.w, false); o[7] += av2 * __builtin_amdgcn_cvt_pk_f32_fp8((int)ww.w, true);
            }
            f32x2_t v4[4], v2[2], v1;
#pragma unroll
            for (int k = 0; k < 4; ++k) { const f32x2_t snd = b5 ? o[k] : o[k + 4], kp = b5 ? o[k + 4] : o[k]; f32x2_t rc; rc.x = shx(snd.x, 32, lane); rc.y = shx(snd.y, 32, lane); v4[k] = kp + rc; }
#pragma unroll
            for (int k = 0; k < 2; ++k) { const f32x2_t snd = b4 ? v4[k] : v4[k + 2], kp = b4 ? v4[k + 2] : v4[k]; f32x2_t rc; rc.x = shx(snd.x, 16, lane); rc.y = shx(snd.y, 16, lane); v2[k] = kp + rc; }
            { const f32x2_t snd = b3 ? v2[0] : v2[1], kp = b3 ? v2[1] : v2[0]; f32x2_t rc; rc.x = shx(snd.x, 8, lane); rc.y = shx(snd.y, 8, lane); v1 = kp + rc; }
            const int ru = r + u * stride;
            if (ru < R) {
                const f32x2_t ga = *(const f32x2_t*)(MOD + row_slot(ru) * 6144 + dimoff);
                if (ru < NCTX) { float* xq = xc_row(a, ru) + dimoff; const f32x2_t xx = *(const f32x2_t*)xq; if (wr) *(f32x2_t*)xq = xx + ga * v1; }
                else { unsigned* xq = (unsigned*)(xl_row(a, ru) + dimoff); const unsigned w = *xq; const f32x2_t y = (f32x2_t){bflo(w), bfhi(w)} + ga * v1; if (wr) *xq = pk2(y.x, y.y); }
            }
        }
    }
}

__device__ __forceinline__ void final_phase(const Frame& F) {
    CArgsP a = kargs(); unsigned char* const ws = a->ws;
    const int gw = F.vcu * NWAVES + F.wave, NGW = F.G * NWAVES;
    f32x4 gv[4];
#pragma unroll
    for (int j = 0; j < 4; ++j) gv[j] = *((const f32x4*)a->in[I_GF] + F.lane + 64 * j);
    for (int r = gw; r < NLAT; r += NGW) {
        const v2u* xb = (const v2u*)((const bf16*)a->out + (size_t)r * XL_LD) + F.lane;
        f32x4* xr = (f32x4*)(a->out + (size_t)r * D) + F.lane;
        f32x4 v[4]; float ss = 0.f;
#pragma unroll
        for (int j = 0; j < 4; ++j) { const v2u w = xb[64 * j]; v[j] = (f32x4){bflo(w.x), bfhi(w.x), bflo(w.y), bfhi(w.y)}; ss += (v[j][0] * v[j][0] + v[j][1] * v[j][1]) + (v[j][2] * v[j][2] + v[j][3] * v[j][3]); }
        const float rs = rsqrtf(wave_sum(ss, F.lane) * (1.f / D) + EPS);
        asm volatile("s_waitcnt vmcnt(0)" ::: "memory");
#pragma unroll
        for (int j = 0; j < 4; ++j) xr[64 * j] = v[j] * rs * gv[j];
    }
}

__global__ void __launch_bounds__(NT, 2) fwd_kernel(Args args) {
    extern __shared__ __attribute__((aligned(16))) unsigned char lds[];
    Frame F;
    F.lds = (LAS unsigned char*)lds;
    F.tid = 0; F.lane = 0; F.wave = __builtin_amdgcn_readfirstlane((int)threadIdx.x >> 6);
    F.G = gridDim.x; { const int bx = blockIdx.x; F.vcu = (F.G % 8 == 0) ? (bx % 8) * (F.G / 8) + bx / 8 : bx; }
    volatile LAS unsigned* MISC = (volatile LAS unsigned*)(F.lds + MISC_OFF);
    for (int u = threadIdx.x; u < (LDS_BYTES - LDSCTL_OFF) / 4; u += NT) ((LAS unsigned*)(F.lds + LDSCTL_OFF))[u] = 0u;
    __syncthreads();
    XcdBarrier bar; bar.bar = (unsigned*)(args.ws + WS_CTL) + CW_BAR; bar.x = 0; bar.st = nullptr;
    if (MK_SINGLE) bar = xcd_barrier_post((unsigned*)(args.ws + WS_CTL) + CW_BAR, MISC + 8);
    const int lo = args.ph_lo, hi = args.ph_hi;
#define IN(k) (lo <= (k) && (k) < hi)
#define OPQ_BX ({ int bx_ = (int)blockIdx.x; asm volatile("" : "+s"(bx_)); bx_; })
#define PF Frame Fp = F; { int t_ = threadIdx.x; asm volatile("" : "+v"(t_), "+s"(Fp.vcu), "+s"(Fp.wave), "+s"(Fp.G)); Fp.tid = t_; Fp.lane = t_ & 63; }
#define SEAM(k) do { if (MK_SINGLE && IN(k) && IN((k) + 1)) { XcdBarrier b2_ = bar; asm volatile("" : "+s"(b2_.bar));     \
        xcd_barrier(b2_); if (PROBE == 50) xcd_barrier(b2_); } } while (0)

    if (IN(0)) { if (PROBE == 99) { PF; p0_prologue(Fp); } { PF; p0_prologue(Fp); } SEAM(0); }

    for (int l = 0; l < DEPTH; ++l) {
        const int pb = 1 + l * NPL;
        const int pm0 = (l == DEPTH - 1) ? 8 : 0, rbeg = pm0 * 256;
        if (IN(pb + 0)) { { PF; norm_phase(Fp, l, 0, 0); } { PF; convert_experts(Fp, l); } if (PROBE == 30) { PF; convert_experts(Fp, l); } SEAM(pb + 0); }
        if (IN(pb + 1)) {
            CArgsP ap = kargs(); unsigned char* const ws = ap->ws; bf16* Hb = (bf16*)(ws + WS_H); bf16* PA = (bf16*)(ws + WS_PA); bf16* PG = (bf16*)(ws + WS_PG);
            pg8::Gemm g{Hb, (const bf16*)(ws + WS_WIN) + (size_t)l * NPAD * D, R, NPAD, D, D}; pg8::StaticOrder S; S.init(R, NPAD, F.G, OPQ_BX);
            EpiIn E{PA, PG, (float*)(ws + WS_Z), (const float*)(ws + WS_ROPE), (bf16*)(ws + WS_VT), (bf16*)(ws + WS_NVT)};
            for (int rep = 0; rep < (PROBE == 1 ? 2 : 1); ++rep) pg8::gemm_phase<EpiIn, pg8::StaticOrder, true, true>(F.lds, g, S, E);
            SEAM(pb + 1);
        }
        if (IN(pb + 2)) { { PF; gla_a_phase(Fp, l); } if (PROBE == 2) { PF; gla_a_phase(Fp, l); } { const int nrep = (PROBE == 20 ? 2 : 1) + (kargs()->pad != 0 ? 1 : 0); for (int rep = 0; rep < nrep; ++rep) { PF; na_phase(Fp, l, rep + 1 < nrep, l == DEPTH - 1); } } SEAM(pb + 2); }
        if (IN(pb + 3)) { if (PROBE == 3) { PF; gla_b_phase(Fp, true); } { PF; gla_b_phase(Fp, false); } SEAM(pb + 3); }
        if (IN(pb + 4)) { if (PROBE == 4) { PF; gla_c_phase(Fp, l, true); } { PF; gla_c_phase(Fp, l, false); } SEAM(pb + 4); }
        if (IN(pb + 5)) {
            CArgsP ap = kargs(); unsigned char* const ws = ap->ws; bf16* Hb = (bf16*)(ws + WS_H); bf16* PA = (bf16*)(ws + WS_PA); bf16* PG = (bf16*)(ws + WS_PG);
            pg8::ShiftOrder S; S.init(R - rbeg, D, F.G, OPQ_BX); S.pm0 = pm0;
            { pg8::Gemm g{PA + PA_R, (const bf16*)(ws + WS_WPG) + (size_t)l * D * D, R, D, D, PA_LD}; EpiMergeK E{Hb, PG}; for (int rep = 0; rep < (PROBE == 5 ? 2 : 1); ++rep) pg8::gemm_phase<EpiMergeK, pg8::ShiftOrder, true, true>(F.lds, g, S, E); }
            SEAM(pb + 5);
        }
        if (IN(pb + 6)) {
            CArgsP ap = kargs(); unsigned char* const ws = ap->ws; bf16* Hb = (bf16*)(ws + WS_H);
            pg8::Gemm g{Hb, (const bf16*)(ws + WS_WO) + (size_t)l * D * D, R, D, D, D}; pg8::ShiftOrder S; S.init(R - rbeg, D, F.G, OPQ_BX); S.pm0 = pm0;
            EpiRes E{l == 0 ? ap->in[I_CTX] : (const float*)(ws + WS_XC), ap->in[I_X], (float*)(ws + WS_XC), (bf16*)ap->out, (const float*)(ws + WS_MOD) + (size_t)l * 9 * 6144, l == 0 ? 1 : 0};
            pg8::gemm_phase<EpiRes, pg8::ShiftOrder, true, true>(F.lds, g, S, E);
            SEAM(pb + 6);
        }
        if (IN(pb + 7)) { if (PROBE == 7) { PF; norm_phase(Fp, l, 1, rbeg); } { PF; norm_phase(Fp, l, 1, rbeg); } SEAM(pb + 7); }
        if (IN(pb + 8)) {
            CArgsP ap = kargs(); unsigned char* const ws = ap->ws; bf16* Hb = (bf16*)(ws + WS_H);
            pg8::Gemm g{Hb, (const bf16*)(ws + WS_WS) + (size_t)l * 2048 * D, R, 2048, D, D}; pg8::ShiftOrder S; S.init(R - rbeg, 2048, F.G, OPQ_BX); S.pm0 = pm0;
            EpiB16 E{(bf16*)(ws + WS_SC), 2048};
            for (int rep = 0; rep < (PROBE == 8 ? 2 : 1); ++rep) pg8::gemm_phase<EpiB16, pg8::ShiftOrder, true, true>(F.lds, g, S, E);
            SEAM(pb + 8);
        }
        if (IN(pb + 9)) { if (PROBE == 9) { PF; topk_phase(Fp, rbeg); } { PF; topk_phase(Fp, rbeg); } SEAM(pb + 9); }
        if (IN(pb + 10)) { if (PROBE == 10) { PF; peer1_phase(Fp, rbeg); } { PF; peer1_phase(Fp, rbeg); } SEAM(pb + 10); }
        if (IN(pb + 11)) { if (PROBE == 11) { PF; peer_act_phase(Fp, rbeg); } { PF; peer_act_phase(Fp, rbeg); } SEAM(pb + 11); }
        if (IN(pb + 12)) { if (PROBE == 12) { PF; peer2_phase(Fp, l, true, rbeg); } { PF; peer2_phase(Fp, l, false, rbeg); } SEAM(pb + 12); }
    }
    if (IN(NPHASE - 1)) { PF; final_phase(Fp); }
#undef IN
#undef SEAM
}

extern "C" void kernel_launch(void* const* d_in, const int* in_sizes, int n_in, void* d_out, int out_size, void* d_ws, size_t ws_size, hipStream_t stream) {
    static int grid = 0;
    if (grid == 0) {
        if (n_in != 23 || in_sizes[0] != NLAT * D || out_size != NLAT * D || ws_size < WS_END) { fprintf(stderr, "kernel_launch: unexpected shapes (n_in %d, in0 %d, out %d, ws %zu); nothing launched\n", n_in, n_in > 0 ? in_sizes[0] : -1, out_size, ws_size); grid = -1; return; }
        int dev = 0, cus = 0, per_cu = 0;
        if (hipGetDevice(&dev) != hipSuccess || hipDeviceGetAttribute(&cus, hipDeviceAttributeMultiprocessorCount, dev) != hipSuccess) { grid = -1; return; }
        if (hipFuncSetAttribute((const void*)fwd_kernel, hipFuncAttributeMaxDynamicSharedMemorySize, LDS_BYTES) != hipSuccess) { fprintf(stderr, "kernel_launch: hipFuncSetAttribute failed\n"); grid = -1; return; }
        if (hipOccupancyMaxActiveBlocksPerMultiprocessor(&per_cu, (const void*)fwd_kernel, NT, LDS_BYTES) != hipSuccess || per_cu < 1) { fprintf(stderr, "kernel_launch: occupancy query says %d blocks per CU\n", per_cu); }
        (void)hipGetLastError();
        grid = cus;
    }
    if (grid < 0) return;
    if (hipMemsetAsync((char*)d_ws + WS_CTL, 0, CTL_ZERO_BYTES, stream) != hipSuccess) return;
    Args a{};
    for (int i = 0; i < 23; ++i) a.in[i] = (const float*)d_in[i];
    a.out = (float*)d_out; a.ws = (unsigned char*)d_ws; a.pad = 0;
    if (MK_SINGLE) {
        a.ph_lo = 0; a.ph_hi = NPHASE; a.li = 0;
        hipLaunchKernelGGL(fwd_kernel, dim3(grid), dim3(NT), LDS_BYTES, stream, a);
    } else {
        for (int p = 0; p < NPHASE; ++p) { a.ph_lo = p; a.ph_hi = p + 1; a.li = p; hipLaunchKernelGGL(fwd_kernel, dim3(grid), dim3(NT), LDS_BYTES, stream, a); }
    }
}
```
